# Optimizing an MI355X kernel written in HIP

```python
import jax, jax.numpy as jnp
from jax import lax
import numpy as np

D_MODEL = 1024
BATCH = 8
SEQ = 4096
DEPTH = 2

D_MIX = D_MODEL
GMLP_HEADS = 8
FNET_GROUPS = 8
GMLP_WIDTH = D_MIX // 2
FNET_WIDTH = D_MIX - GMLP_WIDTH
GMLP_HEAD_DIM = GMLP_WIDTH // GMLP_HEADS
FNET_GROUP_DIM = FNET_WIDTH // FNET_GROUPS
CHUNK = 128
IN_COLS = 2 * GMLP_WIDTH + FNET_WIDTH
PEER_HEADS = 8
PEER_KEYS = 128
PEER_EXPERTS = PEER_KEYS * PEER_KEYS
PEER_TOPK = 16
PEER_QDIM = 256
PEER_HALF = PEER_QDIM // 2
PEER_BLOCK = 128
N_MOD = 6
EPS = 1e-6

kernel_name = 'hybrid_gmlp_fnet_peer_adaln'


def rms_norm(x, g):
    xf = x.astype(jnp.float32)
    y = xf * lax.rsqrt(jnp.mean(xf * xf, axis=-1, keepdims=True) + EPS)
    return (y * g.astype(jnp.float32)).astype(x.dtype)


def layer_norm_noaffine(x):
    xf = x.astype(jnp.float32)
    mu = jnp.mean(xf, axis=-1, keepdims=True)
    var = jnp.mean(jnp.square(xf - mu), axis=-1, keepdims=True)
    return ((xf - mu) * lax.rsqrt(var + EPS)).astype(x.dtype)


def modulate(h, shift, scale):
    return h * (1 + scale[:, None, :]) + shift[:, None, :]


def hybrid_mixer(h, w_in, ws, bs, fw, fb, gain_a, gain_b, w_out):
    B, S, _ = h.shape
    z = h @ w_in
    zu = z[..., :GMLP_WIDTH]
    zv = z[..., GMLP_WIDTH:2 * GMLP_WIDTH]
    zf = z[..., 2 * GMLP_WIDTH:]
    u = jax.nn.gelu(zu, approximate=False).reshape(B, S, GMLP_HEADS, GMLP_HEAD_DIM)
    v = layer_norm_noaffine(jax.nn.gelu(zv, approximate=False).reshape(B, S, GMLP_HEADS, GMLP_HEAD_DIM))
    v = v.reshape(B, S // CHUNK, CHUNK, GMLP_HEADS, GMLP_HEAD_DIM)
    sv = jnp.einsum('hpq,bcqhd->bcphd', ws, v) + bs.T[None, None, :, :, None]
    y_a = (u * sv.reshape(B, S, GMLP_HEADS, GMLP_HEAD_DIM)).reshape(B, S, GMLP_WIDTH)
    f = zf.reshape(B, S, FNET_GROUPS, FNET_GROUP_DIM).astype(jnp.float32)
    fr = jnp.fft.fft2(f, axes=(1, 3), norm='ortho').real.astype(h.dtype)
    y_b = (jnp.einsum('bsgd,gde->bsge', fr, fw) + fb[None, None]).reshape(B, S, FNET_WIDTH)
    y = jnp.concatenate([rms_norm(y_a, gain_a), rms_norm(y_b, gain_b)], axis=-1)
    return y @ w_out


def peer_ffn(h, wq, k1, k2, U, V):
    B, S, D = h.shape
    hb = h.reshape(B * S // PEER_BLOCK, PEER_BLOCK, D)

    def block(hc):
        q = (hc @ wq).reshape(PEER_BLOCK, PEER_HEADS, 2, PEER_HALF)
        s1 = jnp.einsum('thd,hnd->thn', q[:, :, 0], k1).astype(jnp.float32)
        s2 = jnp.einsum('thd,hnd->thn', q[:, :, 1], k2).astype(jnp.float32)
        v1, i1 = lax.top_k(s1, PEER_TOPK)
        v2, i2 = lax.top_k(s2, PEER_TOPK)
        cand = (v1[..., :, None] + v2[..., None, :]).reshape(PEER_BLOCK, PEER_HEADS, PEER_TOPK * PEER_TOPK)
        cidx = (i1[..., :, None] * PEER_KEYS + i2[..., None, :]).reshape(PEER_BLOCK, PEER_HEADS, PEER_TOPK * PEER_TOPK)
        sc, pos = lax.top_k(cand, PEER_TOPK)
        eidx = jnp.take_along_axis(cidx, pos, axis=-1).reshape(PEER_BLOCK, PEER_HEADS * PEER_TOPK)
        g = jax.nn.softmax(sc, axis=-1).reshape(PEER_BLOCK, PEER_HEADS * PEER_TOPK).astype(hc.dtype)
        u_sel = jnp.take(U, eidx, axis=0)
        a = jax.nn.gelu(jnp.einsum('td,tkd->tk', hc, u_sel), approximate=False)
        v_sel = jnp.take(V, eidx, axis=0)
        return jnp.einsum('tk,tkd->td', g * a, v_sel)

    return lax.map(block, hb).reshape(B, S, D)


def setup_inputs(seed: int = 0) -> dict:
    key = jax.random.key(seed)
    ks = jax.random.split(key, 22)

    def nrm(k, shape, scale):
        return jax.random.normal(k, shape, jnp.float32) * scale

    L, D = DEPTH, D_MODEL
    return {
        'x': nrm(ks[0], (BATCH, SEQ, D), 1.0),
        'c': nrm(ks[1], (BATCH, D), 1.0),
        'mod_w': nrm(ks[2], (L, D, N_MOD * D), D ** -0.5),
        'mod_b': nrm(ks[3], (L, N_MOD * D), 0.02),
        'norm1_g': 1.0 + nrm(ks[4], (L, D), 0.02),
        'w_in': nrm(ks[5], (L, D, IN_COLS), D ** -0.5),
        'gmlp_ws': nrm(ks[6], (L, GMLP_HEADS, CHUNK, CHUNK), CHUNK ** -0.5),
        'gmlp_bs': 1.0 + nrm(ks[7], (L, GMLP_HEADS, CHUNK), 0.02),
        'fnet_w': nrm(ks[8], (L, FNET_GROUPS, FNET_GROUP_DIM, FNET_GROUP_DIM), FNET_GROUP_DIM ** -0.5),
        'fnet_b': nrm(ks[9], (L, FNET_GROUPS, FNET_GROUP_DIM), 0.02),
        'gain_a': 1.0 + nrm(ks[10], (L, GMLP_WIDTH), 0.02),
        'gain_b': 1.0 + nrm(ks[11], (L, FNET_WIDTH), 0.02),
        'w_out': nrm(ks[12], (L, D_MIX, D), D_MIX ** -0.5),
        'norm2_g': 1.0 + nrm(ks[13], (L, D), 0.02),
        'peer_wq': nrm(ks[14], (L, D, PEER_HEADS * PEER_QDIM), D ** -0.5),
        'peer_k1': nrm(ks[15], (L, PEER_HEADS, PEER_KEYS, PEER_HALF), PEER_HALF ** -0.5),
        'peer_k2': nrm(ks[16], (L, PEER_HEADS, PEER_KEYS, PEER_HALF), PEER_HALF ** -0.5),
        'peer_u': nrm(ks[17], (L, PEER_EXPERTS, D), D ** -0.5),
        'peer_v': nrm(ks[18], (L, PEER_EXPERTS, D), PEER_HEADS ** -0.5),
        'final_g': 1.0 + nrm(ks[19], (D,), 0.02),
    }


def reference(x, c, mod_w, mod_b, norm1_g, w_in, gmlp_ws, gmlp_bs, fnet_w, fnet_b,
              gain_a, gain_b, w_out, norm2_g, peer_wq, peer_k1, peer_k2, peer_u, peer_v, final_g):
    sc_in = jax.nn.silu(c)
    for l in range(DEPTH):
        mod = sc_in @ mod_w[l] + mod_b[l]
        sh1, scl1, g1, sh2, scl2, g2 = jnp.split(mod, N_MOD, axis=-1)
        h = modulate(rms_norm(x, norm1_g[l]), sh1, scl1)
        x = x + g1[:, None, :] * hybrid_mixer(h, w_in[l], gmlp_ws[l], gmlp_bs[l], fnet_w[l], fnet_b[l],
                                              gain_a[l], gain_b[l], w_out[l])
        h = modulate(rms_norm(x, norm2_g[l]), sh2, scl2)
        x = x + g2[:, None, :] * peer_ffn(h, peer_wq[l], peer_k1[l], peer_k2[l], peer_u[l], peer_v[l])
    return rms_norm(x, final_g)
```

```cpp
#include <hip/hip_runtime.h>
#include <hip/hip_cooperative_groups.h>
#include <cstdio>
#include <cstdint>
namespace cg = cooperative_groups;

#ifndef MEGA
#define MEGA 1
#endif
#ifndef STOP_AFTER
#define STOP_AFTER 99
#define DIGEST 0
#endif

typedef unsigned short bf16_t;
typedef short bf16x8 __attribute__((ext_vector_type(8)));
typedef float f32x4 __attribute__((ext_vector_type(4)));
typedef __bf16 bf16x2_t __attribute__((ext_vector_type(2)));

constexpr int D = 1024, NB = 8, SEQ = 4096, T = NB * SEQ, NL = 2;
constexpr int NZ = 2048;
constexpr int NE = 16384;
constexpr float EPS = 1e-6f;

constexpr size_t OFF_MOD  = 0;
constexpr size_t OFF_W1T  = OFF_MOD  + (size_t)NL * NB * 6144 * 4;
constexpr size_t OFF_W2T  = OFF_W1T  + (size_t)NL * 2048 * 1024 * 2;
constexpr size_t OFF_WQT  = OFF_W2T  + (size_t)NL * 1024 * 1024 * 2;
constexpr size_t OFF_K12  = OFF_WQT  + (size_t)NL * 2048 * 1024 * 2;
constexpr size_t OFF_WSB  = OFF_K12  + (size_t)NL * 8 * 256 * 128 * 2;
constexpr size_t OFF_DA   = OFF_WSB  + (size_t)NL * 8 * 128 * 128 * 2;
constexpr size_t OFF_DB   = OFF_DA   + 128 * 128 * 2;
constexpr size_t OFF_TW   = OFF_DB   + 64 * 128 * 2;
constexpr size_t OFF_SSQA = OFF_TW   + 64 * 64 * 8;
constexpr size_t OFF_SSQB = OFF_SSQA + (size_t)T * 8 * 4;
constexpr size_t OFF_UB   = OFF_SSQB + (size_t)T * 8 * 4;
constexpr size_t OFF_VB   = OFF_UB   + (size_t)NL * NE * 1024 * 2;
constexpr size_t OFF_H    = OFF_VB   + (size_t)NL * NE * 1024 * 2;
constexpr size_t OFF_Z    = OFF_H    + (size_t)T * 1024 * 2;
constexpr size_t OFF_Y    = OFF_Z    + (size_t)T * 2048 * 2;
constexpr size_t OFF_END  = OFF_Y    + (size_t)T * 1024 * 2;

struct Params {
    const float* x; const float* c; const float* mod_w; const float* mod_b; const float* norm1_g; const float* w_in;
    const float* gmlp_ws; const float* gmlp_bs; const float* fnet_w; const float* fnet_b; const float* gain_a; const float* gain_b;
    const float* w_out; const float* norm2_g; const float* wq; const float* k1; const float* k2; const float* pu; const float* pv; const float* final_g;
    float* out; char* ws;
};

constexpr int SMEM_BYTES = 73984;

__device__ __forceinline__ float bf2f(unsigned v) { return __uint_as_float(v << 16); }
typedef float f32x2_t __attribute__((ext_vector_type(2)));
__device__ __forceinline__ unsigned pk_bf16(float lo, float hi) { const f32x2_t v = {lo, hi}; return __builtin_bit_cast(unsigned, __builtin_convertvector(v, bf16x2_t)); }
__device__ __forceinline__ bf16_t f2bf(float f) { return (bf16_t)(pk_bf16(f, 0.f) & 0xffffu); }
__device__ __forceinline__ float gelu_f(float v) { return 0.5f * v * (1.0f + erff(v * 0.70710678118f)); }
__device__ __forceinline__ int med3i(int a, int b, int c) { return max(min(a, b), min(max(a, b), c)); }
__device__ __forceinline__ int f2key(float f) { int b = __float_as_int(f); return b ^ ((b >> 31) & 0x7fffffff); }
__device__ __forceinline__ float key2f(int k) { return __int_as_float(k ^ ((k >> 31) & 0x7fffffff)); }
__device__ __forceinline__ float wave_sum(float v) {
#pragma unroll
    for (int o = 32; o >= 1; o >>= 1) v += __shfl_xor(v, o);
    return v;
}
__device__ __forceinline__ int otid() { int t = threadIdx.x; asm volatile("" : "+v"(t)); return t; }
#define MFMA16(a, b, c) __builtin_amdgcn_mfma_f32_16x16x32_bf16((a), (b), (c), 0, 0, 0)

__device__ void transpose_tile(const float* __restrict__ src, int ld, int k0, int n0, bf16_t* __restrict__ dst  , int dn0,
                               const float* __restrict__ kscale, float* tile  ) {
    const int tid = otid();
#pragma unroll
    for (int i = 0; i < 4; ++i) {
        const int r = (tid >> 4) + 16 * i, c4 = (tid & 15) * 4;
        const float4 v = *(const float4*)(src + (size_t)(k0 + r) * ld + n0 + c4);
        const float s = kscale ? kscale[k0 + r] : 1.0f;
        tile[r * 65 + c4 + 0] = v.x * s; tile[r * 65 + c4 + 1] = v.y * s; tile[r * 65 + c4 + 2] = v.z * s; tile[r * 65 + c4 + 3] = v.w * s;
    }
    __syncthreads();
    {
        const int n = tid >> 2, ks = (tid & 3) * 16;
        unsigned w[8];
#pragma unroll
        for (int j = 0; j < 8; ++j) w[j] = pk_bf16(tile[(ks + 2 * j) * 65 + n], tile[(ks + 2 * j + 1) * 65 + n]);
        uint4* d = (uint4*)(dst + (size_t)(dn0 + n) * 1024 + k0 + ks);
        d[0] = make_uint4(w[0], w[1], w[2], w[3]); d[1] = make_uint4(w[4], w[5], w[6], w[7]);
    }
    __syncthreads();
}

__device__ void phase_prep(const Params& p, char* smem, int bid, int nb) {
    const int tid = otid();
    const int gtid = bid * 256 + tid, gsz = nb * 256;
    char* ws = p.ws;
    {
        float* sc = (float*)smem;
        float* red = (float*)(smem + 32768);
        for (int i = tid; i < 8192; i += 256) { const float v = p.c[i]; sc[i] = v / (1.0f + __expf(-v)); }
        __syncthreads();
        float* mod = (float*)(ws + OFF_MOD);
        for (int item = bid; item < NL * 192; item += nb) {
            const int l = item / 192, n0 = (item % 192) * 32, nn = tid & 31, kq = tid >> 5;
            float acc[8];
#pragma unroll
            for (int b = 0; b < 8; ++b) acc[b] = 0.f;
            const float* W = p.mod_w + (size_t)l * 1024 * 6144 + n0 + nn;
            for (int k = kq; k < 1024; k += 8) {
                const float w = W[(size_t)k * 6144];
#pragma unroll
                for (int b = 0; b < 8; ++b) acc[b] += sc[b * 1024 + k] * w;
            }
#pragma unroll
            for (int b = 0; b < 8; ++b) red[(kq * 8 + b) * 32 + nn] = acc[b];
            __syncthreads();
            {
                const int b = tid >> 5;
                float s = 0.f;
#pragma unroll
                for (int q = 0; q < 8; ++q) s += red[(q * 8 + b) * 32 + nn];
                mod[((size_t)l * NB + b) * 6144 + n0 + nn] = s + p.mod_b[l * 6144 + n0 + nn];
            }
            __syncthreads();
        }
    }
    {
        float* tile = (float*)smem;
        for (int item = bid; item < NL * 1024; item += nb) {
            const int l = item / 1024, r = item % 1024;
            if (r < 256) {
                const int kt = r / 16, nt = r % 16;
                transpose_tile(p.w_in + (size_t)l * 1024 * 1536, 1536, kt * 64, nt * 64, (bf16_t*)(ws + OFF_W1T) + (size_t)l * 2048 * 1024, nt * 64, nullptr, tile);
            } else if (r < 512) {
                const int rr = r - 256, kt = rr / 16, nt = rr % 16;
                const float* gk = (kt < 8) ? (p.gain_a + l * 512) : (p.gain_b + l * 512 - 512);
                transpose_tile(p.w_out + (size_t)l * 1024 * 1024, 1024, kt * 64, nt * 64, (bf16_t*)(ws + OFF_W2T) + (size_t)l * 1024 * 1024, nt * 64, gk, tile);
            } else {
                const int rr = r - 512, kt = rr / 32, nt = rr % 32;
                transpose_tile(p.wq + (size_t)l * 1024 * 2048, 2048, kt * 64, nt * 64, (bf16_t*)(ws + OFF_WQT) + (size_t)l * 2048 * 1024, nt * 64, nullptr, tile);
            }
        }
    }
    {
        float* fws = (float*)smem;
        float* Ms  = (float*)(smem + 16384);
        float* wt  = (float*)(smem + 49152);
        float* cs  = (float*)(smem + 49152 + 16640);
        for (int item = bid; item < NL * 8 * 16; item += nb) {
            const int l = item / 128, g = (item % 128) / 16, kt = item % 16;
            if (tid < 64) { float s, c; sincospif((float)tid / 32.0f, &s, &c); cs[tid] = c; cs[64 + tid] = s; }
            for (int i = tid; i < 4096; i += 256) fws[i] = p.fnet_w[((size_t)l * 8 + g) * 4096 + i];
#pragma unroll
            for (int i = 0; i < 4; ++i) {
                const int r = (tid >> 4) + 16 * i, c4 = (tid & 15) * 4;
                const float4 v = *(const float4*)(p.w_in + (size_t)l * 1024 * 1536 + (size_t)(kt * 64 + r) * 1536 + 1024 + g * 64 + c4);
                wt[r * 65 + c4] = v.x; wt[r * 65 + c4 + 1] = v.y; wt[r * 65 + c4 + 2] = v.z; wt[r * 65 + c4 + 3] = v.w;
            }
            __syncthreads();
            {
                const int d = tid >> 2, r0 = (tid & 3) * 32;
                const bool im = r0 >= 64; const int e0 = r0 & 63;
                float acc[32];
#pragma unroll
                for (int e = 0; e < 32; ++e) acc[e] = 0.f;
                for (int j = 0; j < 64; ++j) {
                    const int ph = (d * j) & 63;
                    const float t = im ? -cs[64 + ph] : cs[ph];
#pragma unroll
                    for (int e = 0; e < 32; ++e) acc[e] += t * fws[j * 64 + e0 + e];
                }
#pragma unroll
                for (int e = 0; e < 32; ++e) Ms[d * 128 + r0 + e] = acc[e];
            }
            __syncthreads();
            {
                const int r = tid >> 1, kk0 = (tid & 1) * 32;
                float acc[32];
#pragma unroll
                for (int k = 0; k < 32; ++k) acc[k] = 0.f;
                for (int d = 0; d < 64; ++d) {
                    const float m = Ms[d * 128 + r];
#pragma unroll
                    for (int k = 0; k < 32; ++k) acc[k] += wt[(kk0 + k) * 65 + d] * m;
                }
                bf16_t* dst = (bf16_t*)(ws + OFF_W1T) + (size_t)l * 2048 * 1024 + (size_t)(1024 + g * 128 + r) * 1024 + kt * 64 + kk0;
#pragma unroll
                for (int q = 0; q < 4; ++q)
                    ((uint4*)dst)[q] = make_uint4(pk_bf16(acc[q * 8], acc[q * 8 + 1]), pk_bf16(acc[q * 8 + 2], acc[q * 8 + 3]), pk_bf16(acc[q * 8 + 4], acc[q * 8 + 5]), pk_bf16(acc[q * 8 + 6], acc[q * 8 + 7]));
            }
            __syncthreads();
        }
    }
    {
        bf16_t* k12 = (bf16_t*)(ws + OFF_K12);
        for (int i = gtid; i < NL * 8 * 256 * 128; i += gsz) {
            const int d = i & 127, n = (i >> 7) & 255, h = (i >> 15) & 7, l = i >> 18;
            const float* src = (n < 128) ? p.k1 : p.k2;
            k12[i] = f2bf(src[(((size_t)l * 8 + h) * 128 + (n & 127)) * 128 + d]);
        }
        bf16_t* wsb = (bf16_t*)(ws + OFF_WSB);
        for (int i = gtid; i < NL * 8 * 128 * 128; i += gsz) wsb[i] = f2bf(p.gmlp_ws[i]);
        bf16_t* DA = (bf16_t*)(ws + OFF_DA);
        for (int i = gtid; i < 128 * 128; i += gsz) {
            const int m = i >> 7, kk = i & 127, ro = m >> 6, k1 = m & 63, ri = kk >> 6, a = kk & 63;
            float s, c; sincospif((float)((a * k1) & 63) / 32.0f, &s, &c);
            const float v = (ro == ri) ? c : (ro == 0 ? s : -s);
            DA[i] = f2bf(v);
        }
        bf16_t* DB = (bf16_t*)(ws + OFF_DB);
        for (int i = gtid; i < 64 * 128; i += gsz) {
            const int k2 = i >> 7, kk = i & 127, ri = kk >> 6, b = kk & 63;
            float s, c; sincospif((float)((b * k2) & 63) / 32.0f, &s, &c);
            DB[i] = f2bf(ri ? s : c);
        }
        float2* tw = (float2*)(ws + OFF_TW);
        for (int i = gtid; i < 64 * 64; i += gsz) {
            const int bp = i >> 6, k1 = i & 63;
            float s, c; sincospif((float)(bp * k1) / 2048.0f, &s, &c);
            tw[i] = make_float2(c, s);
        }
        const size_t n4 = (size_t)NL * NE * 1024 / 4;
        uint2* ub = (uint2*)(ws + OFF_UB); uint2* vb = (uint2*)(ws + OFF_VB);
        for (size_t i = gtid; i < n4; i += gsz) {
            const float4 u = ((const float4*)p.pu)[i]; const float4 v = ((const float4*)p.pv)[i];
            ub[i] = make_uint2(pk_bf16(u.x, u.y), pk_bf16(u.z, u.w));
            vb[i] = make_uint2(pk_bf16(v.x, v.y), pk_bf16(v.z, v.w));
        }
    }
}

__device__ void phase_norm(const float* __restrict__ xsrc, const float* __restrict__ g, const float* __restrict__ modl  , int sh_off, int scl_off,
                           bf16_t* __restrict__ hout, int bid, int nb) {
    const int tid_ = otid(); const int lane = tid_ & 63, wid = tid_ >> 6;
    for (int tok = bid * 4 + wid; tok < T; tok += nb * 4) {
        const int b = tok / SEQ;
        const float* xr = xsrc + (size_t)tok * D;
        float4 v[4];
        float ss = 0.f;
#pragma unroll
        for (int i = 0; i < 4; ++i) { v[i] = *(const float4*)(xr + i * 256 + lane * 4); ss += v[i].x * v[i].x + v[i].y * v[i].y + v[i].z * v[i].z + v[i].w * v[i].w; }
        ss = wave_sum(ss);
        const float rstd = rsqrtf(ss * (1.0f / D) + EPS);
        const float* mb = modl + (size_t)b * 6144;
#pragma unroll
        for (int i = 0; i < 4; ++i) {
            const int cidx = i * 256 + lane * 4;
            const float4 gg = *(const float4*)(g + cidx), sh = *(const float4*)(mb + sh_off + cidx), sc = *(const float4*)(mb + scl_off + cidx);
            const float o0 = v[i].x * rstd * gg.x * (1.0f + sc.x) + sh.x, o1 = v[i].y * rstd * gg.y * (1.0f + sc.y) + sh.y;
            const float o2 = v[i].z * rstd * gg.z * (1.0f + sc.z) + sh.z, o3 = v[i].w * rstd * gg.w * (1.0f + sc.w) + sh.w;
            *(uint2*)(hout + (size_t)tok * D + cidx) = make_uint2(pk_bf16(o0, o1), pk_bf16(o2, o3));
        }
    }
}

constexpr int GP = 72;
template <class Epi, class MidK>
__device__ __forceinline__ void gemm_tile(const bf16_t* __restrict__ A, int lda, const bf16_t* __restrict__ Bt, int ldb, int K, int m0, int n0,
                                          char* smem, const Epi& epi, const MidK& midk, int kmid) {
    const int tid = otid(), lane = tid & 63, wid = tid >> 6, wr = wid >> 1, wc = wid & 1, fr = lane & 15, fq = lane >> 4;
    bf16_t* sa = (bf16_t*)smem;
    bf16_t* sb = (bf16_t*)(smem + 2 * 128 * GP * 2);
    f32x4 acc[4][4];
#pragma unroll
    for (int i = 0; i < 4; ++i)
#pragma unroll
        for (int j = 0; j < 4; ++j) acc[i][j] = (f32x4){0.f, 0.f, 0.f, 0.f};
    uint4 ra[4], rb[4];
    const int lrow = tid >> 3, lkc = (tid & 7) * 8;
    const bf16_t* ga = A + (size_t)(m0 + lrow) * lda + lkc;
    const bf16_t* gb = Bt + (size_t)(n0 + lrow) * ldb + lkc;
    const int nk = K / 64;
#pragma unroll
    for (int i = 0; i < 4; ++i) { ra[i] = *(const uint4*)(ga + (size_t)(32 * i) * lda); rb[i] = *(const uint4*)(gb + (size_t)(32 * i) * ldb); }
#pragma unroll
    for (int i = 0; i < 4; ++i) { *(uint4*)(sa + (lrow + 32 * i) * GP + lkc) = ra[i]; *(uint4*)(sb + (lrow + 32 * i) * GP + lkc) = rb[i]; }
    __syncthreads();
    for (int kt = 0; kt < nk; ++kt) {
        const int cur = kt & 1;
        if (kt + 1 < nk) {
#pragma unroll
            for (int i = 0; i < 4; ++i) { ra[i] = *(const uint4*)(ga + (size_t)(32 * i) * lda + (kt + 1) * 64); rb[i] = *(const uint4*)(gb + (size_t)(32 * i) * ldb + (kt + 1) * 64); }
        }
        if (kt == kmid) {
#pragma unroll
            for (int i = 0; i < 4; ++i) { const float s = midk(m0 + wr * 64 + i * 16 + fr);
#pragma unroll
                for (int j = 0; j < 4; ++j) acc[i][j] *= s; }
        }
        const bf16_t* ca = sa + cur * 128 * GP; const bf16_t* cb = sb + cur * 128 * GP;
#pragma unroll
        for (int ks = 0; ks < 2; ++ks) {
            bf16x8 af[4], bfr[4];
#pragma unroll
            for (int i = 0; i < 4; ++i) af[i] = *(const bf16x8*)(ca + (wr * 64 + i * 16 + fr) * GP + ks * 32 + fq * 8);
#pragma unroll
            for (int j = 0; j < 4; ++j) bfr[j] = *(const bf16x8*)(cb + (wc * 64 + j * 16 + fr) * GP + ks * 32 + fq * 8);
#pragma unroll
            for (int i = 0; i < 4; ++i)
#pragma unroll
                for (int j = 0; j < 4; ++j) acc[i][j] = MFMA16(bfr[j], af[i], acc[i][j]);
        }
        if (kt + 1 < nk) {
            bf16_t* na = sa + (cur ^ 1) * 128 * GP; bf16_t* nbp = sb + (cur ^ 1) * 128 * GP;
#pragma unroll
            for (int i = 0; i < 4; ++i) { *(uint4*)(na + (lrow + 32 * i) * GP + lkc) = ra[i]; *(uint4*)(nbp + (lrow + 32 * i) * GP + lkc) = rb[i]; }
        }
        __syncthreads();
    }
#pragma unroll
    for (int i = 0; i < 4; ++i)
#pragma unroll
        for (int j = 0; j < 4; ++j) { epi(m0 + wr * 64 + i * 16 + fr, n0 + wc * 64 + j * 16 + fq * 4, acc[i][j]); __builtin_amdgcn_sched_barrier(0); }
}
struct NoMid { __device__ __forceinline__ float operator()(int) const { return 1.0f; } };

__device__ void phase_gemm1(const Params& p, int l, char* smem, int bid, int nb) {
    const bf16_t* A = (const bf16_t*)(p.ws + OFF_H);
    const bf16_t* Bt = (const bf16_t*)(p.ws + OFF_W1T) + (size_t)l * 2048 * 1024;
    bf16_t* Z = (bf16_t*)(p.ws + OFF_Z);
    auto epi = [&](int row, int col, const f32x4& v) {
        float a = v[0], b = v[1], c = v[2], d = v[3];
        if (col < 1024) { a = gelu_f(a); b = gelu_f(b); c = gelu_f(c); d = gelu_f(d); }
        *(uint2*)(Z + (size_t)row * NZ + col) = make_uint2(pk_bf16(a, b), pk_bf16(c, d));
    };
    const int NT = NZ / 128, MT = T / 128;
    for (int item = bid; item < MT * NT; item += nb) gemm_tile(A, D, Bt, D, D, (item / NT) * 128, (item % NT) * 128, smem, epi, NoMid(), -1);
}
__device__ void phase_gemm2(const Params& p, int l, char* smem, int bid, int nb) {
    const bf16_t* A = (const bf16_t*)(p.ws + OFF_Y);
    const bf16_t* Bt = (const bf16_t*)(p.ws + OFF_W2T) + (size_t)l * 1024 * 1024;
    const float* ssa = (const float*)(p.ws + OFF_SSQA); const float* ssb = (const float*)(p.ws + OFF_SSQB);
    const float* mod = (const float*)(p.ws + OFF_MOD) + (size_t)l * NB * 6144;
    const float* xin = (l == 0) ? p.x : p.out;
    float* xout = p.out;
    auto rstd_of = [&](const float* s, int row) {
        const float4 a = *(const float4*)(s + (size_t)row * 8), b = *(const float4*)(s + (size_t)row * 8 + 4);
        return rsqrtf(((a.x + a.y) + (a.z + a.w) + (b.x + b.y) + (b.z + b.w)) * (1.0f / 512.0f) + EPS);
    };
    auto midk = [&](int row) { return rstd_of(ssa, row) / rstd_of(ssb, row); };
    auto epi = [&](int row, int col, const f32x4& v) {
        const float rb = rstd_of(ssb, row);
        const int b = row / SEQ;
        const float4 g = *(const float4*)(mod + (size_t)b * 6144 + 2 * D + col);
        const float4 xi = *(const float4*)(xin + (size_t)row * D + col);
        float4 o; o.x = xi.x + g.x * rb * v[0]; o.y = xi.y + g.y * rb * v[1]; o.z = xi.z + g.z * rb * v[2]; o.w = xi.w + g.w * rb * v[3];
        *(float4*)(xout + (size_t)row * D + col) = o;
    };
    const int NT = D / 128, MT = T / 128;
    for (int item = bid; item < MT * NT; item += nb) gemm_tile(A, D, Bt, D, D, (item / NT) * 128, (item % NT) * 128, smem, epi, midk, 8);
}
__device__ void phase_gemm3(const Params& p, int l, char* smem, int bid, int nb) {
    const bf16_t* A = (const bf16_t*)(p.ws + OFF_H);
    const bf16_t* Bt = (const bf16_t*)(p.ws + OFF_WQT) + (size_t)l * 2048 * 1024;
    bf16_t* Q = (bf16_t*)(p.ws + OFF_Z);
    auto epi = [&](int row, int col, const f32x4& v) { *(uint2*)(Q + (size_t)row * 2048 + col) = make_uint2(pk_bf16(v[0], v[1]), pk_bf16(v[2], v[3])); };
    const int NT = 2048 / 128, MT = T / 128;
    for (int item = bid; item < MT * NT; item += nb) gemm_tile(A, D, Bt, D, D, (item / NT) * 128, (item % NT) * 128, smem, epi, NoMid(), -1);
}

constexpr int TP = 136;
__device__ __forceinline__ void stage_transposed(const bf16_t* __restrict__ base, size_t row_stride, bf16_t* dT) {
    const int tid = otid(), r = tid >> 2, part = tid & 3, ri = part >> 1, c0 = (part & 1) * 32;
    const uint4* src = (const uint4*)(base + (size_t)r * row_stride + ri * 64 + c0);
    uint4 v[4];
#pragma unroll
    for (int i = 0; i < 4; ++i) v[i] = src[i];
#pragma unroll
    for (int i = 0; i < 4; ++i) {
        const unsigned w[4] = {v[i].x, v[i].y, v[i].z, v[i].w};
#pragma unroll
        for (int j = 0; j < 4; ++j) {
            dT[(c0 + i * 8 + j * 2) * TP + ri * 64 + r] = (bf16_t)(w[j] & 0xffffu);
            dT[(c0 + i * 8 + j * 2 + 1) * TP + ri * 64 + r] = (bf16_t)(w[j] >> 16);
        }
    }
}

__device__ void gmlp_item(const Params& p, int l, int item, char* smem) {
    const int tid = otid(), lane = tid & 63, wid = tid >> 6, fr = lane & 15, fq = lane >> 4;
    const int h = item & 7, c = (item >> 3) & 31, b = item >> 8;
    const int tok0 = b * SEQ + c * 128;
    bf16_t* vnT = (bf16_t*)smem;
    const bf16_t* Z = (const bf16_t*)(p.ws + OFF_Z);
    {
        const int q = tid >> 1, half = tid & 1, d0 = half * 32;
        const uint4* src = (const uint4*)(Z + (size_t)(tok0 + q) * NZ + 512 + h * 64 + d0);
        float f[32];
#pragma unroll
        for (int i = 0; i < 4; ++i) { const uint4 v = src[i]; const unsigned w[4] = {v.x, v.y, v.z, v.w};
#pragma unroll
            for (int j = 0; j < 4; ++j) { f[i * 8 + j * 2] = bf2f(w[j] & 0xffffu); f[i * 8 + j * 2 + 1] = bf2f(w[j] >> 16); } }
        float s = 0.f;
#pragma unroll
        for (int i = 0; i < 32; ++i) s += f[i];
        s += __shfl_xor(s, 1);
        const float mean = s * (1.0f / 64.0f);
        float qv = 0.f;
#pragma unroll
        for (int i = 0; i < 32; ++i) { f[i] -= mean; qv += f[i] * f[i]; }
        qv += __shfl_xor(qv, 1);
        const float rstd = rsqrtf(qv * (1.0f / 64.0f) + EPS);
#pragma unroll
        for (int i = 0; i < 32; ++i) vnT[(d0 + i) * TP + q] = f2bf(f[i] * rstd);
    }
    __syncthreads();
    const bf16_t* Wsb = (const bf16_t*)(p.ws + OFF_WSB) + ((size_t)l * 8 + h) * 128 * 128;
    f32x4 acc[2][4];
#pragma unroll
    for (int i = 0; i < 2; ++i)
#pragma unroll
        for (int j = 0; j < 4; ++j) acc[i][j] = (f32x4){0.f, 0.f, 0.f, 0.f};
    const int p0 = wid * 32;
#pragma unroll
    for (int ks = 0; ks < 4; ++ks) {
        bf16x8 af[2], bfr[4];
#pragma unroll
        for (int i = 0; i < 2; ++i) af[i] = *(const bf16x8*)(Wsb + (size_t)(p0 + i * 16 + fr) * 128 + ks * 32 + fq * 8);
#pragma unroll
        for (int j = 0; j < 4; ++j) bfr[j] = *(const bf16x8*)(vnT + (j * 16 + fr) * TP + ks * 32 + fq * 8);
#pragma unroll
        for (int i = 0; i < 2; ++i)
#pragma unroll
            for (int j = 0; j < 4; ++j) acc[i][j] = MFMA16(bfr[j], af[i], acc[i][j]);
    }
    bf16_t* Y = (bf16_t*)(p.ws + OFF_Y);
    float* ssa = (float*)(p.ws + OFF_SSQA);
#pragma unroll
    for (int i = 0; i < 2; ++i) {
        const int pp = p0 + i * 16 + fr, tok = tok0 + pp;
        const float bsv = p.gmlp_bs[((size_t)l * 8 + h) * 128 + pp];
        float ss = 0.f;
#pragma unroll
        for (int j = 0; j < 4; ++j) {
            const int d = j * 16 + fq * 4;
            const uint2 uu = *(const uint2*)(Z + (size_t)tok * NZ + h * 64 + d);
            const float y0 = bf2f(uu.x & 0xffffu) * (acc[i][j][0] + bsv), y1 = bf2f(uu.x >> 16) * (acc[i][j][1] + bsv);
            const float y2 = bf2f(uu.y & 0xffffu) * (acc[i][j][2] + bsv), y3 = bf2f(uu.y >> 16) * (acc[i][j][3] + bsv);
            ss += y0 * y0 + y1 * y1 + y2 * y2 + y3 * y3;
            *(uint2*)(Y + (size_t)tok * D + h * 64 + d) = make_uint2(pk_bf16(y0, y1), pk_bf16(y2, y3));
        }
        ss += __shfl_xor(ss, 16); ss += __shfl_xor(ss, 32);
        if (fq == 0) ssa[(size_t)tok * 8 + h] = ss;
    }
    __syncthreads();
}

__device__ void ffta_item(const Params& p, int item, char* smem) {
    const int tid = otid(), lane = tid & 63, wid = tid >> 6, fr = lane & 15, fq = lane >> 4;
    const int bp = item & 63, g = (item >> 6) & 7, b = item >> 9;
    bf16_t* dT = (bf16_t*)smem;
    const bf16_t* Z = (const bf16_t*)(p.ws + OFF_Z);
    stage_transposed(Z + (size_t)(b * SEQ + bp) * NZ + 1024 + g * 128, (size_t)64 * NZ, dT);
    __syncthreads();
    const bf16_t* DA = (const bf16_t*)(p.ws + OFF_DA);
    f32x4 acc[2][4];
#pragma unroll
    for (int i = 0; i < 2; ++i)
#pragma unroll
        for (int j = 0; j < 4; ++j) acc[i][j] = (f32x4){0.f, 0.f, 0.f, 0.f};
#pragma unroll
    for (int ks = 0; ks < 4; ++ks) {
        bf16x8 af[2], bfr[4];
#pragma unroll
        for (int i = 0; i < 2; ++i) af[i] = *(const bf16x8*)(DA + (size_t)(i * 64 + wid * 16 + fr) * 128 + ks * 32 + fq * 8);
#pragma unroll
        for (int j = 0; j < 4; ++j) bfr[j] = *(const bf16x8*)(dT + (j * 16 + fr) * TP + ks * 32 + fq * 8);
#pragma unroll
        for (int i = 0; i < 2; ++i)
#pragma unroll
            for (int j = 0; j < 4; ++j) acc[i][j] = MFMA16(bfr[j], af[i], acc[i][j]);
    }
    const int k1 = wid * 16 + fr;
    const float2 cs = ((const float2*)(p.ws + OFF_TW))[bp * 64 + k1];
    bf16_t* Yb = (bf16_t*)(p.ws + OFF_H) + ((((size_t)(b * 8 + g) * 64 + k1) * 64 + bp) * 128);
#pragma unroll
    for (int j = 0; j < 4; ++j) {
        const int ch = j * 16 + fq * 4;
        float yr[4], yi[4];
#pragma unroll
        for (int e = 0; e < 4; ++e) { const float r = acc[0][j][e], im = acc[1][j][e]; yr[e] = r * cs.x + im * cs.y; yi[e] = im * cs.x - r * cs.y; }
        *(uint2*)(Yb + ch) = make_uint2(pk_bf16(yr[0], yr[1]), pk_bf16(yr[2], yr[3]));
        *(uint2*)(Yb + 64 + ch) = make_uint2(pk_bf16(yi[0], yi[1]), pk_bf16(yi[2], yi[3]));
    }
    __syncthreads();
}

__device__ void phase_mix(const Params& p, int l, char* smem, int bid, int nb) {
    for (int item = bid; item < 2048 + 4096; item += nb) {
        if (item < 2048) gmlp_item(p, l, item, smem); else ffta_item(p, item - 2048, smem);
    }
}

__device__ void phase_fftb(const Params& p, int l, char* smem, int bid, int nb) {
    const int tid = otid(), lane = tid & 63, wid = tid >> 6, fr = lane & 15, fq = lane >> 4;
    bf16_t* dT = (bf16_t*)smem;
    const bf16_t* DB = (const bf16_t*)(p.ws + OFF_DB);
    bf16_t* Y = (bf16_t*)(p.ws + OFF_Y);
    float* ssb = (float*)(p.ws + OFF_SSQB);
    for (int item = bid; item < 4096; item += nb) {
        const int k1 = item & 63, g = (item >> 6) & 7, b = item >> 9;
        stage_transposed((const bf16_t*)(p.ws + OFF_H) + (((size_t)(b * 8 + g) * 64 + k1) * 64) * 128, 128, dT);
        __syncthreads();
        f32x4 acc[4];
#pragma unroll
        for (int j = 0; j < 4; ++j) acc[j] = (f32x4){0.f, 0.f, 0.f, 0.f};
#pragma unroll
        for (int ks = 0; ks < 4; ++ks) {
            const bf16x8 af = *(const bf16x8*)(DB + (size_t)(wid * 16 + fr) * 128 + ks * 32 + fq * 8);
#pragma unroll
            for (int j = 0; j < 4; ++j) { const bf16x8 bfr = *(const bf16x8*)(dT + (j * 16 + fr) * TP + ks * 32 + fq * 8); acc[j] = MFMA16(bfr, af, acc[j]); }
        }
        const int k2 = wid * 16 + fr, tok = b * SEQ + k1 + 64 * k2;
        float ss = 0.f;
#pragma unroll
        for (int j = 0; j < 4; ++j) {
            const int ch = j * 16 + fq * 4;
            const float4 fb = *(const float4*)(p.fnet_b + ((size_t)l * 8 + g) * 64 + ch);
            const float y0 = acc[j][0] * (1.0f / 512.0f) + fb.x, y1 = acc[j][1] * (1.0f / 512.0f) + fb.y, y2 = acc[j][2] * (1.0f / 512.0f) + fb.z, y3 = acc[j][3] * (1.0f / 512.0f) + fb.w;
            ss += y0 * y0 + y1 * y1 + y2 * y2 + y3 * y3;
            *(uint2*)(Y + (size_t)tok * D + 512 + g * 64 + ch) = make_uint2(pk_bf16(y0, y1), pk_bf16(y2, y3));
        }
        ss += __shfl_xor(ss, 16); ss += __shfl_xor(ss, 32);
        if (fq == 0) ssb[(size_t)tok * 8 + g] = ss;
        __syncthreads();
    }
}

#define INS16(a, v) do { a[15] = med3i(a[14], a[15], v); a[14] = med3i(a[13], a[14], v); a[13] = med3i(a[12], a[13], v); a[12] = med3i(a[11], a[12], v); \
    a[11] = med3i(a[10], a[11], v); a[10] = med3i(a[9], a[10], v); a[9] = med3i(a[8], a[9], v); a[8] = med3i(a[7], a[8], v); a[7] = med3i(a[6], a[7], v); \
    a[6] = med3i(a[5], a[6], v); a[5] = med3i(a[4], a[5], v); a[4] = med3i(a[3], a[4], v); a[3] = med3i(a[2], a[3], v); a[2] = med3i(a[1], a[2], v); \
    a[1] = med3i(a[0], a[1], v); a[0] = max(a[0], v); } while (0)

template <int I, int J> struct CandLoop {
    static __device__ __forceinline__ void run(int (&a)[16], const float (&f1)[16], const float (&f2)[16]) {
        if constexpr ((I + 1) * (J + 1) <= 16) { const int key = (f2key(f1[I] + f2[J]) & ~255) | (I * 16 + J); INS16(a, key); }
        if constexpr (J + 1 < 16) CandLoop<I, J + 1>::run(a, f1, f2);
        else if constexpr (I + 1 < 16) CandLoop<I + 1, 0>::run(a, f1, f2);
    }
};

__device__ void phase_topk(const Params& p, int l, char* smem, int bid, int nb) {
    const int tid = otid(), lane = tid & 63, wid = tid >> 6, fr = lane & 15, fq = lane >> 4;
    float* S = (float*)smem;
    int* TT = (int*)(smem + 64 * 257 * 4);
    const bf16_t* Q = (const bf16_t*)(p.ws + OFF_Z);
    int* eidx = (int*)(p.ws + OFF_Y); float* gw = (float*)(p.ws + OFF_Y + (size_t)T * 128 * 4);
    for (int item = bid; item < (T / 64) * 8; item += nb) {
        const int h = item & 7, tok0 = (item >> 3) * 64;
        const bf16_t* K12 = (const bf16_t*)(p.ws + OFF_K12) + ((size_t)l * 8 + h) * 256 * 128;
        {
            const int half = wid >> 1;
            f32x4 acc[4][4];
#pragma unroll
            for (int i = 0; i < 4; ++i)
#pragma unroll
                for (int j = 0; j < 4; ++j) acc[i][j] = (f32x4){0.f, 0.f, 0.f, 0.f};
#pragma unroll
            for (int ks = 0; ks < 4; ++ks) {
                bf16x8 af[4], bfr[4];
#pragma unroll
                for (int i = 0; i < 4; ++i) af[i] = *(const bf16x8*)(Q + (size_t)(tok0 + i * 16 + fr) * 2048 + h * 256 + half * 128 + ks * 32 + fq * 8);
#pragma unroll
                for (int j = 0; j < 4; ++j) bfr[j] = *(const bf16x8*)(K12 + (size_t)((wid * 4 + j) * 16 + fr) * 128 + ks * 32 + fq * 8);
#pragma unroll
                for (int i = 0; i < 4; ++i)
#pragma unroll
                    for (int j = 0; j < 4; ++j) acc[i][j] = MFMA16(bfr[j], af[i], acc[i][j]);
            }
#pragma unroll
            for (int i = 0; i < 4; ++i)
#pragma unroll
                for (int j = 0; j < 4; ++j)
#pragma unroll
                    for (int e = 0; e < 4; ++e) S[(i * 16 + fr) * 257 + (wid * 4 + j) * 16 + fq * 4 + e] = acc[i][j][e];
        }
        __syncthreads();
        if (tid < 128) {
            const int tk = tid & 63, half = tid >> 6;
            int a[16];
#pragma unroll
            for (int i = 0; i < 16; ++i) a[i] = (int)0x80000000;
            const float* sr = S + tk * 257 + half * 128;
#pragma unroll 4
            for (int i = 0; i < 128; ++i) { const int key = (f2key(sr[i]) & ~127) | i; INS16(a, key); }
#pragma unroll
            for (int i = 0; i < 16; ++i) TT[(tk * 2 + half) * 16 + i] = a[i];
        }
        __syncthreads();
        if (tid < 64) {
            const int tk = tid;
            float f1[16], f2[16];
#pragma unroll
            for (int i = 0; i < 16; ++i) { f1[i] = key2f(TT[(tk * 2) * 16 + i] & ~127); f2[i] = key2f(TT[(tk * 2 + 1) * 16 + i] & ~127); }
            int a[16];
#pragma unroll
            for (int i = 0; i < 16; ++i) a[i] = (int)0x80000000;
            CandLoop<0, 0>::run(a, f1, f2);
            float sc[16], e[16], sum = 0.f; int ex[16];
#pragma unroll
            for (int i = 0; i < 16; ++i) {
                sc[i] = key2f(a[i] & ~255);
                const int code = a[i] & 255;
                const int e1 = TT[(tk * 2) * 16 + (code >> 4)] & 127, e2 = TT[(tk * 2 + 1) * 16 + (code & 15)] & 127;
                ex[i] = e1 * 128 + e2;
            }
#pragma unroll
            for (int i = 0; i < 16; ++i) { e[i] = __expf(sc[i] - sc[0]); sum += e[i]; }
            const float inv = 1.0f / sum;
            int4* ep = (int4*)(eidx + (size_t)(tok0 + tk) * 128 + h * 16); float4* gp = (float4*)(gw + (size_t)(tok0 + tk) * 128 + h * 16);
#pragma unroll
            for (int i = 0; i < 4; ++i) { ep[i] = make_int4(ex[4 * i], ex[4 * i + 1], ex[4 * i + 2], ex[4 * i + 3]); gp[i] = make_float4(e[4 * i] * inv, e[4 * i + 1] * inv, e[4 * i + 2] * inv, e[4 * i + 3] * inv); }
        }
        __syncthreads();
    }
}

__device__ __forceinline__ float dot8(const uint4& a, const uint4& b, float acc) {
    acc = __builtin_amdgcn_fdot2_f32_bf16(__builtin_bit_cast(bf16x2_t, a.x), __builtin_bit_cast(bf16x2_t, b.x), acc, false);
    acc = __builtin_amdgcn_fdot2_f32_bf16(__builtin_bit_cast(bf16x2_t, a.y), __builtin_bit_cast(bf16x2_t, b.y), acc, false);
    acc = __builtin_amdgcn_fdot2_f32_bf16(__builtin_bit_cast(bf16x2_t, a.z), __builtin_bit_cast(bf16x2_t, b.z), acc, false);
    acc = __builtin_amdgcn_fdot2_f32_bf16(__builtin_bit_cast(bf16x2_t, a.w), __builtin_bit_cast(bf16x2_t, b.w), acc, false);
    return acc;
}
__device__ __forceinline__ void axpy8(float (&o)[8], float c, const uint4& v) {
    o[0] += c * bf2f(v.x & 0xffffu); o[1] += c * bf2f(v.x >> 16); o[2] += c * bf2f(v.y & 0xffffu); o[3] += c * bf2f(v.y >> 16);
    o[4] += c * bf2f(v.z & 0xffffu); o[5] += c * bf2f(v.z >> 16); o[6] += c * bf2f(v.w & 0xffffu); o[7] += c * bf2f(v.w >> 16);
}

__device__ void phase_peer(const Params& p, int l, int bid, int nb) {
    const int tid_ = otid(); const int lane = tid_ & 63, wid = tid_ >> 6;
    const bf16_t* H = (const bf16_t*)(p.ws + OFF_H);
    const bf16_t* Ub = (const bf16_t*)(p.ws + OFF_UB) + (size_t)l * NE * 1024;
    const bf16_t* Vb = (const bf16_t*)(p.ws + OFF_VB) + (size_t)l * NE * 1024;
    const int* eidx = (const int*)(p.ws + OFF_Y); const float* gw = (const float*)(p.ws + OFF_Y + (size_t)T * 128 * 4);
    const float* mod = (const float*)(p.ws + OFF_MOD) + (size_t)l * NB * 6144;
    const bool last = (l == NL - 1);
    const float* gnext = last ? p.final_g : (p.norm1_g + (l + 1) * D);
    const float* modn = (const float*)(p.ws + OFF_MOD) + (size_t)(last ? l : l + 1) * NB * 6144;
    for (int tok = bid * 4 + wid; tok < T; tok += nb * 4) {
        const int b = tok / SEQ;
        const uint4 h0 = *(const uint4*)(H + (size_t)tok * D + lane * 8), h1 = *(const uint4*)(H + (size_t)tok * D + 512 + lane * 8);
        float o0[8], o1[8];
#pragma unroll
        for (int i = 0; i < 8; ++i) { o0[i] = 0.f; o1[i] = 0.f; }
        for (int h = 0; h < 8; ++h) {
            const int my_e = eidx[(size_t)tok * 128 + h * 16 + (lane & 15)];
            const float my_g = gw[(size_t)tok * 128 + h * 16 + (lane >> 2)];
            float pp[16];
#pragma unroll
            for (int k = 0; k < 16; ++k) {
                const int e = __builtin_amdgcn_readlane(my_e, k);
                const bf16_t* ur = Ub + (size_t)e * 1024;
                const uint4 u0 = *(const uint4*)(ur + lane * 8), u1 = *(const uint4*)(ur + 512 + lane * 8);
                pp[k] = dot8(h1, u1, dot8(h0, u0, 0.f));
            }
            float r8[8], r4[4], r2[2], r1;
            { const bool hi = (lane & 32) != 0;
#pragma unroll
              for (int j = 0; j < 8; ++j) { const float send = hi ? pp[j] : pp[j + 8], keep = hi ? pp[j + 8] : pp[j]; r8[j] = keep + __shfl_xor(send, 32); } }
            { const bool hi = (lane & 16) != 0;
#pragma unroll
              for (int j = 0; j < 4; ++j) { const float send = hi ? r8[j] : r8[j + 4], keep = hi ? r8[j + 4] : r8[j]; r4[j] = keep + __shfl_xor(send, 16); } }
            { const bool hi = (lane & 8) != 0;
#pragma unroll
              for (int j = 0; j < 2; ++j) { const float send = hi ? r4[j] : r4[j + 2], keep = hi ? r4[j + 2] : r4[j]; r2[j] = keep + __shfl_xor(send, 8); } }
            { const bool hi = (lane & 4) != 0; const float send = hi ? r2[0] : r2[1], keep = hi ? r2[1] : r2[0]; r1 = keep + __shfl_xor(send, 4); }
            r1 += __shfl_xor(r1, 2); r1 += __shfl_xor(r1, 1);
            const float coef = my_g * gelu_f(r1);
#pragma unroll
            for (int k = 0; k < 16; ++k) {
                const int e = __builtin_amdgcn_readlane(my_e, k);
                const float ck = __builtin_bit_cast(float, __builtin_amdgcn_readlane(__builtin_bit_cast(int, coef), 4 * k));
                const bf16_t* vr = Vb + (size_t)e * 1024;
                const uint4 v0 = *(const uint4*)(vr + lane * 8), v1 = *(const uint4*)(vr + 512 + lane * 8);
                axpy8(o0, ck, v0); axpy8(o1, ck, v1);
            }
        }
        float* xr = p.out + (size_t)tok * D;
        const float* g2 = mod + (size_t)b * 6144 + 5 * D;
        float xn0[8], xn1[8]; float ss = 0.f;
#pragma unroll
        for (int q = 0; q < 2; ++q) {
            const float4 xa = *(const float4*)(xr + lane * 8 + q * 4), ga = *(const float4*)(g2 + lane * 8 + q * 4);
            const float4 xb = *(const float4*)(xr + 512 + lane * 8 + q * 4), gb = *(const float4*)(g2 + 512 + lane * 8 + q * 4);
            xn0[q * 4 + 0] = xa.x + ga.x * o0[q * 4 + 0]; xn0[q * 4 + 1] = xa.y + ga.y * o0[q * 4 + 1]; xn0[q * 4 + 2] = xa.z + ga.z * o0[q * 4 + 2]; xn0[q * 4 + 3] = xa.w + ga.w * o0[q * 4 + 3];
            xn1[q * 4 + 0] = xb.x + gb.x * o1[q * 4 + 0]; xn1[q * 4 + 1] = xb.y + gb.y * o1[q * 4 + 1]; xn1[q * 4 + 2] = xb.z + gb.z * o1[q * 4 + 2]; xn1[q * 4 + 3] = xb.w + gb.w * o1[q * 4 + 3];
        }
#pragma unroll
        for (int i = 0; i < 8; ++i) ss += xn0[i] * xn0[i] + xn1[i] * xn1[i];
        ss = wave_sum(ss);
        const float rstd = rsqrtf(ss * (1.0f / D) + EPS);
        if (last) {
#pragma unroll
            for (int q = 0; q < 2; ++q) {
                const float4 ga = *(const float4*)(gnext + lane * 8 + q * 4), gb = *(const float4*)(gnext + 512 + lane * 8 + q * 4);
                *(float4*)(xr + lane * 8 + q * 4) = make_float4(xn0[q * 4] * rstd * ga.x, xn0[q * 4 + 1] * rstd * ga.y, xn0[q * 4 + 2] * rstd * ga.z, xn0[q * 4 + 3] * rstd * ga.w);
                *(float4*)(xr + 512 + lane * 8 + q * 4) = make_float4(xn1[q * 4] * rstd * gb.x, xn1[q * 4 + 1] * rstd * gb.y, xn1[q * 4 + 2] * rstd * gb.z, xn1[q * 4 + 3] * rstd * gb.w);
            }
        } else {
            const float* shn = modn + (size_t)b * 6144; const float* scn = shn + D;
            unsigned w0[4], w1[4];
#pragma unroll
            for (int q = 0; q < 2; ++q) {
                *(float4*)(xr + lane * 8 + q * 4) = make_float4(xn0[q * 4], xn0[q * 4 + 1], xn0[q * 4 + 2], xn0[q * 4 + 3]);
                *(float4*)(xr + 512 + lane * 8 + q * 4) = make_float4(xn1[q * 4], xn1[q * 4 + 1], xn1[q * 4 + 2], xn1[q * 4 + 3]);
                const float4 ga = *(const float4*)(gnext + lane * 8 + q * 4), gb = *(const float4*)(gnext + 512 + lane * 8 + q * 4);
                const float4 sa = *(const float4*)(shn + lane * 8 + q * 4), sb = *(const float4*)(shn + 512 + lane * 8 + q * 4);
                const float4 ca = *(const float4*)(scn + lane * 8 + q * 4), cb = *(const float4*)(scn + 512 + lane * 8 + q * 4);
                w0[q * 2]     = pk_bf16(xn0[q * 4] * rstd * ga.x * (1.f + ca.x) + sa.x, xn0[q * 4 + 1] * rstd * ga.y * (1.f + ca.y) + sa.y);
                w0[q * 2 + 1] = pk_bf16(xn0[q * 4 + 2] * rstd * ga.z * (1.f + ca.z) + sa.z, xn0[q * 4 + 3] * rstd * ga.w * (1.f + ca.w) + sa.w);
                w1[q * 2]     = pk_bf16(xn1[q * 4] * rstd * gb.x * (1.f + cb.x) + sb.x, xn1[q * 4 + 1] * rstd * gb.y * (1.f + cb.y) + sb.y);
                w1[q * 2 + 1] = pk_bf16(xn1[q * 4 + 2] * rstd * gb.z * (1.f + cb.z) + sb.z, xn1[q * 4 + 3] * rstd * gb.w * (1.f + cb.w) + sb.w);
            }
            bf16_t* hr = (bf16_t*)(p.ws + OFF_H) + (size_t)tok * D;
            *(uint4*)(hr + lane * 8) = make_uint4(w0[0], w0[1], w0[2], w0[3]);
            *(uint4*)(hr + 512 + lane * 8) = make_uint4(w1[0], w1[1], w1[2], w1[3]);
        }
    }
}

constexpr int NPHASE = 2 + 8 * NL;
__device__ __forceinline__ void run_phase(const Params& p, int ph, char* smem, int bid, int nb) {
    if (ph == 0) { phase_prep(p, smem, bid, nb); return; }
    if (ph == 1) { phase_norm(p.x, p.norm1_g, (const float*)(p.ws + OFF_MOD), 0, D, (bf16_t*)(p.ws + OFF_H), bid, nb); return; }
    const int l = (ph - 2) / 8, s = (ph - 2) % 8;
    switch (s) {
        case 0: phase_gemm1(p, l, smem, bid, nb); break;
        case 1: phase_mix(p, l, smem, bid, nb); break;
        case 2: phase_fftb(p, l, smem, bid, nb); break;
        case 3: phase_gemm2(p, l, smem, bid, nb); break;
        case 4: phase_norm(p.out, p.norm2_g + l * D, (const float*)(p.ws + OFF_MOD) + (size_t)l * NB * 6144, 3 * D, 4 * D, (bf16_t*)(p.ws + OFF_H), bid, nb); break;
        case 5: phase_gemm3(p, l, smem, bid, nb); break;
        case 6: phase_topk(p, l, smem, bid, nb); break;
        default: phase_peer(p, l, bid, nb); break;
    }
}

#if MEGA
__global__ void __launch_bounds__(256, 2) mega_kernel(Params p) {
    __shared__ __attribute__((aligned(16))) char smem[SMEM_BYTES];
    cg::grid_group grid = cg::this_grid();
    const int bid = blockIdx.x, nb = gridDim.x;
    phase_prep(p, smem, bid, nb); grid.sync();
    phase_norm(p.x, p.norm1_g, (const float*)(p.ws + OFF_MOD), 0, D, (bf16_t*)(p.ws + OFF_H), bid, nb); grid.sync();
#pragma nounroll
    for (int l = 0; l < NL; ++l) {
        phase_gemm1(p, l, smem, bid, nb); grid.sync();
        phase_mix(p, l, smem, bid, nb); grid.sync();
        phase_fftb(p, l, smem, bid, nb); grid.sync();
        phase_gemm2(p, l, smem, bid, nb); grid.sync();
        phase_norm(p.out, p.norm2_g + l * D, (const float*)(p.ws + OFF_MOD) + (size_t)l * NB * 6144, 3 * D, 4 * D, (bf16_t*)(p.ws + OFF_H), bid, nb); grid.sync();
        phase_gemm3(p, l, smem, bid, nb); grid.sync();
        phase_topk(p, l, smem, bid, nb); grid.sync();
        phase_peer(p, l, bid, nb);
        if (l + 1 < NL) grid.sync();
    }
}
#else
__global__ void __launch_bounds__(256, 2) phase_kernel(Params p, int ph) {
    __shared__ __attribute__((aligned(16))) char smem[SMEM_BYTES];
    run_phase(p, ph, smem, blockIdx.x, gridDim.x);
}
#endif

__global__ void digest_kernel(Params p) {
    const int* eidx = (const int*)(p.ws + OFF_Y); const float* gw = (const float*)(p.ws + OFF_Y + (size_t)T * 128 * 4);
    for (size_t i = (size_t)blockIdx.x * 256 + threadIdx.x; i < (size_t)T * D; i += (size_t)gridDim.x * 256) {
        const size_t j = i % ((size_t)T * 128);
        p.out[i] = (float)eidx[j] * 1e-3f + gw[j];
    }
}
extern "C" void kernel_launch(void* const* d_in, const int* in_sizes, int n_in, void* d_out, int out_size, void* d_ws, size_t ws_size, hipStream_t stream) {
    (void)in_sizes; (void)n_in; (void)out_size;
    if (ws_size < OFF_END) { fprintf(stderr, "workspace too small: %zu < %zu\n", ws_size, (size_t)OFF_END); return; }
    Params p{};
    p.x = (const float*)d_in[0]; p.c = (const float*)d_in[1]; p.mod_w = (const float*)d_in[2]; p.mod_b = (const float*)d_in[3]; p.norm1_g = (const float*)d_in[4];
    p.w_in = (const float*)d_in[5]; p.gmlp_ws = (const float*)d_in[6]; p.gmlp_bs = (const float*)d_in[7]; p.fnet_w = (const float*)d_in[8]; p.fnet_b = (const float*)d_in[9];
    p.gain_a = (const float*)d_in[10]; p.gain_b = (const float*)d_in[11]; p.w_out = (const float*)d_in[12]; p.norm2_g = (const float*)d_in[13]; p.wq = (const float*)d_in[14];
    p.k1 = (const float*)d_in[15]; p.k2 = (const float*)d_in[16]; p.pu = (const float*)d_in[17]; p.pv = (const float*)d_in[18]; p.final_g = (const float*)d_in[19];
    p.out = (float*)d_out; p.ws = (char*)d_ws;
#if MEGA
    static int grid_blocks = 0;
    if (!grid_blocks) {
        int dev = 0, cus = 0, per_cu = 0;
        hipGetDevice(&dev);
        hipDeviceGetAttribute(&cus, hipDeviceAttributeMultiprocessorCount, dev);
        hipOccupancyMaxActiveBlocksPerMultiprocessor(&per_cu, mega_kernel, 256, 0);
        if (per_cu > 2) per_cu = 2;
        grid_blocks = cus * per_cu;
    }
    void* args[] = {&p};
    hipError_t e = hipLaunchCooperativeKernel((void*)mega_kernel, dim3(grid_blocks), dim3(256), args, 0, stream);
    if (e != hipSuccess) fprintf(stderr, "cooperative launch failed: %s (grid %d)\n", hipGetErrorString(e), grid_blocks);
#else
    for (int ph = 0; ph < NPHASE && ph <= STOP_AFTER; ++ph) phase_kernel<<<512, 256, 0, stream>>>(p, ph);
    if (DIGEST) digest_kernel<<<1024, 256, 0, stream>>>(p);
#endif
}
```

```cpp
#include <hip/hip_runtime.h>
#include <hip/hip_cooperative_groups.h>
#include <cstdio>
#include <cstdint>
namespace cg = cooperative_groups;

#ifndef MEGA
#define MEGA 1
#endif
#ifndef STOP_AFTER
#define STOP_AFTER 99
#define DIGEST 0
#endif

typedef unsigned short bf16_t;
typedef short bf16x8 __attribute__((ext_vector_type(8)));
typedef float f32x4 __attribute__((ext_vector_type(4)));
typedef __bf16 bf16x2_t __attribute__((ext_vector_type(2)));

constexpr int D = 1024, NB = 8, SEQ = 4096, T = NB * SEQ, NL = 2;
constexpr int NZ = 2048;
constexpr int NE = 16384;
constexpr float EPS = 1e-6f;

constexpr size_t OFF_MOD  = 0;
constexpr size_t OFF_W1T  = OFF_MOD  + (size_t)NL * NB * 6144 * 4;
constexpr size_t OFF_W2T  = OFF_W1T  + (size_t)NL * 2048 * 1024 * 2;
constexpr size_t OFF_WQT  = OFF_W2T  + (size_t)NL * 1024 * 1024 * 2;
constexpr size_t OFF_K12  = OFF_WQT  + (size_t)NL * 2048 * 1024 * 2;
constexpr size_t OFF_WSB  = OFF_K12  + (size_t)NL * 8 * 256 * 128 * 2;
constexpr size_t OFF_DA   = OFF_WSB  + (size_t)NL * 8 * 128 * 128 * 2;
constexpr size_t OFF_DB   = OFF_DA   + 128 * 128 * 2;
constexpr size_t OFF_TW   = OFF_DB   + 64 * 128 * 2;
constexpr size_t OFF_SSQA = OFF_TW   + 64 * 64 * 8;
constexpr size_t OFF_SSQB = OFF_SSQA + (size_t)T * 8 * 4;
constexpr size_t OFF_UB   = OFF_SSQB + (size_t)T * 8 * 4;
constexpr size_t OFF_VB   = OFF_UB   + (size_t)NL * NE * 1024 * 2;
constexpr size_t OFF_H    = OFF_VB   + (size_t)NL * NE * 1024 * 2;
constexpr size_t OFF_Z    = OFF_H    + (size_t)T * 1024 * 2;
constexpr size_t OFF_Y    = OFF_Z    + (size_t)T * 2048 * 2;
constexpr size_t OFF_BAR  = OFF_Y    + (size_t)T * 1024 * 2;
constexpr size_t OFF_END  = OFF_BAR  + 16384;

struct Params {
    const float* x; const float* c; const float* mod_w; const float* mod_b; const float* norm1_g; const float* w_in;
    const float* gmlp_ws; const float* gmlp_bs; const float* fnet_w; const float* fnet_b; const float* gain_a; const float* gain_b;
    const float* w_out; const float* norm2_g; const float* wq; const float* k1; const float* k2; const float* pu; const float* pv; const float* final_g;
    float* out; char* ws;
};

constexpr int SMEM_BYTES = 73984;

__device__ __forceinline__ float bf2f(unsigned v) { return __uint_as_float(v << 16); }
typedef float f32x2_t __attribute__((ext_vector_type(2)));
__device__ __forceinline__ unsigned pk_bf16(float lo, float hi) { const f32x2_t v = {lo, hi}; return __builtin_bit_cast(unsigned, __builtin_convertvector(v, bf16x2_t)); }
__device__ __forceinline__ bf16_t f2bf(float f) { return (bf16_t)(pk_bf16(f, 0.f) & 0xffffu); }
__device__ __forceinline__ float gelu_f(float v) { return 0.5f * v * (1.0f + erff(v * 0.70710678118f)); }
__device__ __forceinline__ int med3i(int a, int b, int c) { return max(min(a, b), min(max(a, b), c)); }
__device__ __forceinline__ int f2key(float f) { int b = __float_as_int(f); return b ^ ((b >> 31) & 0x7fffffff); }
__device__ __forceinline__ float key2f(int k) { return __int_as_float(k ^ ((k >> 31) & 0x7fffffff)); }
__device__ __forceinline__ float wave_sum(float v) {
#pragma unroll
    for (int o = 32; o >= 1; o >>= 1) v += __shfl_xor(v, o);
    return v;
}
__device__ __forceinline__ int otid() { int t = threadIdx.x; asm volatile("" : "+v"(t)); return t; }
#define MFMA16(a, b, c) __builtin_amdgcn_mfma_f32_16x16x32_bf16((a), (b), (c), 0, 0, 0)

__device__ void transpose_tile(const float* __restrict__ src, int ld, int k0, int n0, bf16_t* __restrict__ dst  , int dn0,
                               const float* __restrict__ kscale, float* tile  ) {
    const int tid = otid();
#pragma unroll
    for (int i = 0; i < 4; ++i) {
        const int r = (tid >> 4) + 16 * i, c4 = (tid & 15) * 4;
        const float4 v = *(const float4*)(src + (size_t)(k0 + r) * ld + n0 + c4);
        const float s = kscale ? kscale[k0 + r] : 1.0f;
        tile[r * 65 + c4 + 0] = v.x * s; tile[r * 65 + c4 + 1] = v.y * s; tile[r * 65 + c4 + 2] = v.z * s; tile[r * 65 + c4 + 3] = v.w * s;
    }
    __syncthreads();
    {
        const int n = tid >> 2, ks = (tid & 3) * 16;
        unsigned w[8];
#pragma unroll
        for (int j = 0; j < 8; ++j) w[j] = pk_bf16(tile[(ks + 2 * j) * 65 + n], tile[(ks + 2 * j + 1) * 65 + n]);
        uint4* d = (uint4*)(dst + (size_t)(dn0 + n) * 1024 + k0 + ks);
        d[0] = make_uint4(w[0], w[1], w[2], w[3]); d[1] = make_uint4(w[4], w[5], w[6], w[7]);
    }
    __syncthreads();
}

__device__ void phase_prep(const Params& p, char* smem, int bid, int nb) {
    const int tid = otid();
    const int gtid = bid * 256 + tid, gsz = nb * 256;
    char* ws = p.ws;
    {
        float* sc = (float*)smem;
        float* red = (float*)(smem + 32768);
        for (int i = tid; i < 8192; i += 256) { const float v = p.c[i]; sc[i] = v / (1.0f + __expf(-v)); }
        __syncthreads();
        float* mod = (float*)(ws + OFF_MOD);
        for (int item = bid; item < NL * 192; item += nb) {
            const int l = item / 192, n0 = (item % 192) * 32, nn = tid & 31, kq = tid >> 5;
            float acc[8];
#pragma unroll
            for (int b = 0; b < 8; ++b) acc[b] = 0.f;
            const float* W = p.mod_w + (size_t)l * 1024 * 6144 + n0 + nn;
            for (int k = kq; k < 1024; k += 8) {
                const float w = W[(size_t)k * 6144];
#pragma unroll
                for (int b = 0; b < 8; ++b) acc[b] += sc[b * 1024 + k] * w;
            }
#pragma unroll
            for (int b = 0; b < 8; ++b) red[(kq * 8 + b) * 32 + nn] = acc[b];
            __syncthreads();
            {
                const int b = tid >> 5;
                float s = 0.f;
#pragma unroll
                for (int q = 0; q < 8; ++q) s += red[(q * 8 + b) * 32 + nn];
                mod[((size_t)l * NB + b) * 6144 + n0 + nn] = s + p.mod_b[l * 6144 + n0 + nn];
            }
            __syncthreads();
        }
    }
    {
        float* tile = (float*)smem;
        for (int item = bid; item < NL * 1024; item += nb) {
            const int l = item / 1024, r = item % 1024;
            if (r < 256) {
                const int kt = r / 16, nt = r % 16;
                transpose_tile(p.w_in + (size_t)l * 1024 * 1536, 1536, kt * 64, nt * 64, (bf16_t*)(ws + OFF_W1T) + (size_t)l * 2048 * 1024, nt * 64, nullptr, tile);
            } else if (r < 512) {
                const int rr = r - 256, kt = rr / 16, nt = rr % 16;
                const float* gk = (kt < 8) ? (p.gain_a + l * 512) : (p.gain_b + l * 512 - 512);
                transpose_tile(p.w_out + (size_t)l * 1024 * 1024, 1024, kt * 64, nt * 64, (bf16_t*)(ws + OFF_W2T) + (size_t)l * 1024 * 1024, nt * 64, gk, tile);
            } else {
                const int rr = r - 512, kt = rr / 32, nt = rr % 32;
                transpose_tile(p.wq + (size_t)l * 1024 * 2048, 2048, kt * 64, nt * 64, (bf16_t*)(ws + OFF_WQT) + (size_t)l * 2048 * 1024, nt * 64, nullptr, tile);
            }
        }
    }
    {
        float* fws = (float*)smem;
        float* Ms  = (float*)(smem + 16384);
        float* wt  = (float*)(smem + 49152);
        float* cs  = (float*)(smem + 49152 + 16640);
        for (int item = bid; item < NL * 8 * 16; item += nb) {
            const int l = item / 128, g = (item % 128) / 16, kt = item % 16;
            if (tid < 64) { float s, c; sincospif((float)tid / 32.0f, &s, &c); cs[tid] = c; cs[64 + tid] = s; }
            for (int i = tid; i < 4096; i += 256) fws[i] = p.fnet_w[((size_t)l * 8 + g) * 4096 + i];
#pragma unroll
            for (int i = 0; i < 4; ++i) {
                const int r = (tid >> 4) + 16 * i, c4 = (tid & 15) * 4;
                const float4 v = *(const float4*)(p.w_in + (size_t)l * 1024 * 1536 + (size_t)(kt * 64 + r) * 1536 + 1024 + g * 64 + c4);
                wt[r * 65 + c4] = v.x; wt[r * 65 + c4 + 1] = v.y; wt[r * 65 + c4 + 2] = v.z; wt[r * 65 + c4 + 3] = v.w;
            }
            __syncthreads();
            {
                const int d = tid >> 2, r0 = (tid & 3) * 32;
                const bool im = r0 >= 64; const int e0 = r0 & 63;
                float acc[32];
#pragma unroll
                for (int e = 0; e < 32; ++e) acc[e] = 0.f;
                for (int j = 0; j < 64; ++j) {
                    const int ph = (d * j) & 63;
                    const float t = im ? -cs[64 + ph] : cs[ph];
#pragma unroll
                    for (int e = 0; e < 32; ++e) acc[e] += t * fws[j * 64 + e0 + e];
                }
#pragma unroll
                for (int e = 0; e < 32; ++e) Ms[d * 128 + r0 + e] = acc[e];
            }
            __syncthreads();
            {
                const int r = tid >> 1, kk0 = (tid & 1) * 32;
                float acc[32];
#pragma unroll
                for (int k = 0; k < 32; ++k) acc[k] = 0.f;
                for (int d = 0; d < 64; ++d) {
                    const float m = Ms[d * 128 + r];
#pragma unroll
                    for (int k = 0; k < 32; ++k) acc[k] += wt[(kk0 + k) * 65 + d] * m;
                }
                bf16_t* dst = (bf16_t*)(ws + OFF_W1T) + (size_t)l * 2048 * 1024 + (size_t)(1024 + g * 128 + r) * 1024 + kt * 64 + kk0;
#pragma unroll
                for (int q = 0; q < 4; ++q)
                    ((uint4*)dst)[q] = make_uint4(pk_bf16(acc[q * 8], acc[q * 8 + 1]), pk_bf16(acc[q * 8 + 2], acc[q * 8 + 3]), pk_bf16(acc[q * 8 + 4], acc[q * 8 + 5]), pk_bf16(acc[q * 8 + 6], acc[q * 8 + 7]));
            }
            __syncthreads();
        }
    }
    {
        bf16_t* k12 = (bf16_t*)(ws + OFF_K12);
        for (int i = gtid; i < NL * 8 * 256 * 128; i += gsz) {
            const int d = i & 127, n = (i >> 7) & 255, h = (i >> 15) & 7, l = i >> 18;
            const float* src = (n < 128) ? p.k1 : p.k2;
            k12[i] = f2bf(src[(((size_t)l * 8 + h) * 128 + (n & 127)) * 128 + d]);
        }
        bf16_t* wsb = (bf16_t*)(ws + OFF_WSB);
        for (int i = gtid; i < NL * 8 * 128 * 128; i += gsz) wsb[i] = f2bf(p.gmlp_ws[i]);
        bf16_t* DA = (bf16_t*)(ws + OFF_DA);
        for (int i = gtid; i < 128 * 128; i += gsz) {
            const int m = i >> 7, kk = i & 127, ro = m >> 6, k1 = m & 63, ri = kk >> 6, a = kk & 63;
            float s, c; sincospif((float)((a * k1) & 63) / 32.0f, &s, &c);
            const float v = (ro == ri) ? c : (ro == 0 ? s : -s);
            DA[i] = f2bf(v);
        }
        bf16_t* DB = (bf16_t*)(ws + OFF_DB);
        for (int i = gtid; i < 64 * 128; i += gsz) {
            const int k2 = i >> 7, kk = i & 127, ri = kk >> 6, b = kk & 63;
            float s, c; sincospif((float)((b * k2) & 63) / 32.0f, &s, &c);
            DB[i] = f2bf(ri ? s : c);
        }
        float2* tw = (float2*)(ws + OFF_TW);
        for (int i = gtid; i < 64 * 64; i += gsz) {
            const int bp = i >> 6, k1 = i & 63;
            float s, c; sincospif((float)(bp * k1) / 2048.0f, &s, &c);
            tw[i] = make_float2(c, s);
        }
        const size_t n4 = (size_t)NL * NE * 1024 / 4;
        uint2* ub = (uint2*)(ws + OFF_UB); uint2* vb = (uint2*)(ws + OFF_VB);
        for (size_t i = gtid; i < n4; i += gsz) {
            const float4 u = ((const float4*)p.pu)[i]; const float4 v = ((const float4*)p.pv)[i];
            ub[i] = make_uint2(pk_bf16(u.x, u.y), pk_bf16(u.z, u.w));
            vb[i] = make_uint2(pk_bf16(v.x, v.y), pk_bf16(v.z, v.w));
        }
    }
}

__device__ void phase_norm(const float* __restrict__ xsrc, const float* __restrict__ g, const float* __restrict__ modl  , int sh_off, int scl_off,
                           bf16_t* __restrict__ hout, int bid, int nb) {
    const int tid_ = otid(); const int lane = tid_ & 63, wid = tid_ >> 6;
    for (int tok = bid * 4 + wid; tok < T; tok += nb * 4) {
        const int b = tok / SEQ;
        const float* xr = xsrc + (size_t)tok * D;
        float4 v[4];
        float ss = 0.f;
#pragma unroll
        for (int i = 0; i < 4; ++i) { v[i] = *(const float4*)(xr + i * 256 + lane * 4); ss += v[i].x * v[i].x + v[i].y * v[i].y + v[i].z * v[i].z + v[i].w * v[i].w; }
        ss = wave_sum(ss);
        const float rstd = rsqrtf(ss * (1.0f / D) + EPS);
        const float* mb = modl + (size_t)b * 6144;
#pragma unroll
        for (int i = 0; i < 4; ++i) {
            const int cidx = i * 256 + lane * 4;
            const float4 gg = *(const float4*)(g + cidx), sh = *(const float4*)(mb + sh_off + cidx), sc = *(const float4*)(mb + scl_off + cidx);
            const float o0 = v[i].x * rstd * gg.x * (1.0f + sc.x) + sh.x, o1 = v[i].y * rstd * gg.y * (1.0f + sc.y) + sh.y;
            const float o2 = v[i].z * rstd * gg.z * (1.0f + sc.z) + sh.z, o3 = v[i].w * rstd * gg.w * (1.0f + sc.w) + sh.w;
            *(uint2*)(hout + (size_t)tok * D + cidx) = make_uint2(pk_bf16(o0, o1), pk_bf16(o2, o3));
        }
    }
}

constexpr int GP = 72;
template <class Epi, class MidK>
__device__ __forceinline__ void gemm_tile(const bf16_t* __restrict__ A, int lda, const bf16_t* __restrict__ Bt, int ldb, int K, int m0, int n0,
                                          char* smem, const Epi& epi, const MidK& midk, int kmid) {
    const int tid = otid(), lane = tid & 63, wid = tid >> 6, wr = wid >> 1, wc = wid & 1, fr = lane & 15, fq = lane >> 4;
    bf16_t* sa = (bf16_t*)smem;
    bf16_t* sb = (bf16_t*)(smem + 2 * 128 * GP * 2);
    f32x4 acc[4][4];
#pragma unroll
    for (int i = 0; i < 4; ++i)
#pragma unroll
        for (int j = 0; j < 4; ++j) acc[i][j] = (f32x4){0.f, 0.f, 0.f, 0.f};
    uint4 ra[4], rb[4];
    const int lrow = tid >> 3, lkc = (tid & 7) * 8;
    const bf16_t* ga = A + (size_t)(m0 + lrow) * lda + lkc;
    const bf16_t* gb = Bt + (size_t)(n0 + lrow) * ldb + lkc;
    const int nk = K / 64;
#pragma unroll
    for (int i = 0; i < 4; ++i) { ra[i] = *(const uint4*)(ga + (size_t)(32 * i) * lda); rb[i] = *(const uint4*)(gb + (size_t)(32 * i) * ldb); }
#pragma unroll
    for (int i = 0; i < 4; ++i) { *(uint4*)(sa + (lrow + 32 * i) * GP + lkc) = ra[i]; *(uint4*)(sb + (lrow + 32 * i) * GP + lkc) = rb[i]; }
    __syncthreads();
    for (int kt = 0; kt < nk; ++kt) {
        const int cur = kt & 1;
        if (kt + 1 < nk) {
#pragma unroll
            for (int i = 0; i < 4; ++i) { ra[i] = *(const uint4*)(ga + (size_t)(32 * i) * lda + (kt + 1) * 64); rb[i] = *(const uint4*)(gb + (size_t)(32 * i) * ldb + (kt + 1) * 64); }
        }
        if (kt == kmid) {
#pragma unroll
            for (int i = 0; i < 4; ++i) { const float s = midk(m0 + wr * 64 + i * 16 + fr);
#pragma unroll
                for (int j = 0; j < 4; ++j) acc[i][j] *= s; }
        }
        const bf16_t* ca = sa + cur * 128 * GP; const bf16_t* cb = sb + cur * 128 * GP;
#pragma unroll
        for (int ks = 0; ks < 2; ++ks) {
            bf16x8 af[4], bfr[4];
#pragma unroll
            for (int i = 0; i < 4; ++i) af[i] = *(const bf16x8*)(ca + (wr * 64 + i * 16 + fr) * GP + ks * 32 + fq * 8);
#pragma unroll
            for (int j = 0; j < 4; ++j) bfr[j] = *(const bf16x8*)(cb + (wc * 64 + j * 16 + fr) * GP + ks * 32 + fq * 8);
#pragma unroll
            for (int i = 0; i < 4; ++i)
#pragma unroll
                for (int j = 0; j < 4; ++j) acc[i][j] = MFMA16(bfr[j], af[i], acc[i][j]);
        }
        if (kt + 1 < nk) {
            bf16_t* na = sa + (cur ^ 1) * 128 * GP; bf16_t* nbp = sb + (cur ^ 1) * 128 * GP;
#pragma unroll
            for (int i = 0; i < 4; ++i) { *(uint4*)(na + (lrow + 32 * i) * GP + lkc) = ra[i]; *(uint4*)(nbp + (lrow + 32 * i) * GP + lkc) = rb[i]; }
        }
        __syncthreads();
    }
#pragma unroll
    for (int i = 0; i < 4; ++i)
#pragma unroll
        for (int j = 0; j < 4; ++j) { epi(m0 + wr * 64 + i * 16 + fr, n0 + wc * 64 + j * 16 + fq * 4, acc[i][j]); __builtin_amdgcn_sched_barrier(0); }
}
struct NoMid { __device__ __forceinline__ float operator()(int) const { return 1.0f; } };

__device__ void phase_gemm1(const Params& p, int l, char* smem, int bid, int nb) {
    const bf16_t* A = (const bf16_t*)(p.ws + OFF_H);
    const bf16_t* Bt = (const bf16_t*)(p.ws + OFF_W1T) + (size_t)l * 2048 * 1024;
    bf16_t* Z = (bf16_t*)(p.ws + OFF_Z);
    auto epi = [&](int row, int col, const f32x4& v) {
        float a = v[0], b = v[1], c = v[2], d = v[3];
        if (col < 1024) { a = gelu_f(a); b = gelu_f(b); c = gelu_f(c); d = gelu_f(d); }
        *(uint2*)(Z + (size_t)row * NZ + col) = make_uint2(pk_bf16(a, b), pk_bf16(c, d));
    };
    const int NT = NZ / 128, MT = T / 128;
    for (int item = bid; item < MT * NT; item += nb) gemm_tile(A, D, Bt, D, D, (item / NT) * 128, (item % NT) * 128, smem, epi, NoMid(), -1);
}
__device__ void phase_gemm2(const Params& p, int l, char* smem, int bid, int nb) {
    const bf16_t* A = (const bf16_t*)(p.ws + OFF_Y);
    const bf16_t* Bt = (const bf16_t*)(p.ws + OFF_W2T) + (size_t)l * 1024 * 1024;
    const float* ssa = (const float*)(p.ws + OFF_SSQA); const float* ssb = (const float*)(p.ws + OFF_SSQB);
    const float* mod = (const float*)(p.ws + OFF_MOD) + (size_t)l * NB * 6144;
    const float* xin = (l == 0) ? p.x : p.out;
    float* xout = p.out;
    auto rstd_of = [&](const float* s, int row) {
        const float4 a = *(const float4*)(s + (size_t)row * 8), b = *(const float4*)(s + (size_t)row * 8 + 4);
        return rsqrtf(((a.x + a.y) + (a.z + a.w) + (b.x + b.y) + (b.z + b.w)) * (1.0f / 512.0f) + EPS);
    };
    auto midk = [&](int row) { return rstd_of(ssa, row) / rstd_of(ssb, row); };
    auto epi = [&](int row, int col, const f32x4& v) {
        const float rb = rstd_of(ssb, row);
        const int b = row / SEQ;
        const float4 g = *(const float4*)(mod + (size_t)b * 6144 + 2 * D + col);
        const float4 xi = *(const float4*)(xin + (size_t)row * D + col);
        float4 o; o.x = xi.x + g.x * rb * v[0]; o.y = xi.y + g.y * rb * v[1]; o.z = xi.z + g.z * rb * v[2]; o.w = xi.w + g.w * rb * v[3];
        *(float4*)(xout + (size_t)row * D + col) = o;
    };
    const int NT = D / 128, MT = T / 128;
    for (int item = bid; item < MT * NT; item += nb) gemm_tile(A, D, Bt, D, D, (item / NT) * 128, (item % NT) * 128, smem, epi, midk, 8);
}
__device__ void phase_gemm3(const Params& p, int l, char* smem, int bid, int nb) {
    const bf16_t* A = (const bf16_t*)(p.ws + OFF_H);
    const bf16_t* Bt = (const bf16_t*)(p.ws + OFF_WQT) + (size_t)l * 2048 * 1024;
    bf16_t* Q = (bf16_t*)(p.ws + OFF_Z);
    auto epi = [&](int row, int col, const f32x4& v) { *(uint2*)(Q + (size_t)row * 2048 + col) = make_uint2(pk_bf16(v[0], v[1]), pk_bf16(v[2], v[3])); };
    const int NT = 2048 / 128, MT = T / 128;
    for (int item = bid; item < MT * NT; item += nb) gemm_tile(A, D, Bt, D, D, (item / NT) * 128, (item % NT) * 128, smem, epi, NoMid(), -1);
}

constexpr int TP = 136;
__device__ __forceinline__ void stage_transposed(const bf16_t* __restrict__ base, size_t row_stride, bf16_t* dT) {
    const int tid = otid(), r = tid >> 2, part = tid & 3, ri = part >> 1, c0 = (part & 1) * 32;
    const uint4* src = (const uint4*)(base + (size_t)r * row_stride + ri * 64 + c0);
    uint4 v[4];
#pragma unroll
    for (int i = 0; i < 4; ++i) v[i] = src[i];
#pragma unroll
    for (int i = 0; i < 4; ++i) {
        const unsigned w[4] = {v[i].x, v[i].y, v[i].z, v[i].w};
#pragma unroll
        for (int j = 0; j < 4; ++j) {
            dT[(c0 + i * 8 + j * 2) * TP + ri * 64 + r] = (bf16_t)(w[j] & 0xffffu);
            dT[(c0 + i * 8 + j * 2 + 1) * TP + ri * 64 + r] = (bf16_t)(w[j] >> 16);
        }
    }
}

__device__ void gmlp_item(const Params& p, int l, int item, char* smem) {
    const int tid = otid(), lane = tid & 63, wid = tid >> 6, fr = lane & 15, fq = lane >> 4;
    const int h = item & 7, c = (item >> 3) & 31, b = item >> 8;
    const int tok0 = b * SEQ + c * 128;
    bf16_t* vnT = (bf16_t*)smem;
    const bf16_t* Z = (const bf16_t*)(p.ws + OFF_Z);
    {
        const int q = tid >> 1, half = tid & 1, d0 = half * 32;
        const uint4* src = (const uint4*)(Z + (size_t)(tok0 + q) * NZ + 512 + h * 64 + d0);
        float f[32];
#pragma unroll
        for (int i = 0; i < 4; ++i) { const uint4 v = src[i]; const unsigned w[4] = {v.x, v.y, v.z, v.w};
#pragma unroll
            for (int j = 0; j < 4; ++j) { f[i * 8 + j * 2] = bf2f(w[j] & 0xffffu); f[i * 8 + j * 2 + 1] = bf2f(w[j] >> 16); } }
        float s = 0.f;
#pragma unroll
        for (int i = 0; i < 32; ++i) s += f[i];
        s += __shfl_xor(s, 1);
        const float mean = s * (1.0f / 64.0f);
        float qv = 0.f;
#pragma unroll
        for (int i = 0; i < 32; ++i) { f[i] -= mean; qv += f[i] * f[i]; }
        qv += __shfl_xor(qv, 1);
        const float rstd = rsqrtf(qv * (1.0f / 64.0f) + EPS);
#pragma unroll
        for (int i = 0; i < 32; ++i) vnT[(d0 + i) * TP + q] = f2bf(f[i] * rstd);
    }
    __syncthreads();
    const bf16_t* Wsb = (const bf16_t*)(p.ws + OFF_WSB) + ((size_t)l * 8 + h) * 128 * 128;
    f32x4 acc[2][4];
#pragma unroll
    for (int i = 0; i < 2; ++i)
#pragma unroll
        for (int j = 0; j < 4; ++j) acc[i][j] = (f32x4){0.f, 0.f, 0.f, 0.f};
    const int p0 = wid * 32;
#pragma unroll
    for (int ks = 0; ks < 4; ++ks) {
        bf16x8 af[2], bfr[4];
#pragma unroll
        for (int i = 0; i < 2; ++i) af[i] = *(const bf16x8*)(Wsb + (size_t)(p0 + i * 16 + fr) * 128 + ks * 32 + fq * 8);
#pragma unroll
        for (int j = 0; j < 4; ++j) bfr[j] = *(const bf16x8*)(vnT + (j * 16 + fr) * TP + ks * 32 + fq * 8);
#pragma unroll
        for (int i = 0; i < 2; ++i)
#pragma unroll
            for (int j = 0; j < 4; ++j) acc[i][j] = MFMA16(bfr[j], af[i], acc[i][j]);
    }
    bf16_t* Y = (bf16_t*)(p.ws + OFF_Y);
    float* ssa = (float*)(p.ws + OFF_SSQA);
#pragma unroll
    for (int i = 0; i < 2; ++i) {
        const int pp = p0 + i * 16 + fr, tok = tok0 + pp;
        const float bsv = p.gmlp_bs[((size_t)l * 8 + h) * 128 + pp];
        float ss = 0.f;
#pragma unroll
        for (int j = 0; j < 4; ++j) {
            const int d = j * 16 + fq * 4;
            const uint2 uu = *(const uint2*)(Z + (size_t)tok * NZ + h * 64 + d);
            const float y0 = bf2f(uu.x & 0xffffu) * (acc[i][j][0] + bsv), y1 = bf2f(uu.x >> 16) * (acc[i][j][1] + bsv);
            const float y2 = bf2f(uu.y & 0xffffu) * (acc[i][j][2] + bsv), y3 = bf2f(uu.y >> 16) * (acc[i][j][3] + bsv);
            ss += y0 * y0 + y1 * y1 + y2 * y2 + y3 * y3;
            *(uint2*)(Y + (size_t)tok * D + h * 64 + d) = make_uint2(pk_bf16(y0, y1), pk_bf16(y2, y3));
        }
        ss += __shfl_xor(ss, 16); ss += __shfl_xor(ss, 32);
        if (fq == 0) ssa[(size_t)tok * 8 + h] = ss;
    }
    __syncthreads();
}

__device__ void ffta_item(const Params& p, int item, char* smem) {
    const int tid = otid(), lane = tid & 63, wid = tid >> 6, fr = lane & 15, fq = lane >> 4;
    const int bp = item & 63, g = (item >> 6) & 7, b = item >> 9;
    bf16_t* dT = (bf16_t*)smem;
    const bf16_t* Z = (const bf16_t*)(p.ws + OFF_Z);
    stage_transposed(Z + (size_t)(b * SEQ + bp) * NZ + 1024 + g * 128, (size_t)64 * NZ, dT);
    __syncthreads();
    const bf16_t* DA = (const bf16_t*)(p.ws + OFF_DA);
    f32x4 acc[2][4];
#pragma unroll
    for (int i = 0; i < 2; ++i)
#pragma unroll
        for (int j = 0; j < 4; ++j) acc[i][j] = (f32x4){0.f, 0.f, 0.f, 0.f};
#pragma unroll
    for (int ks = 0; ks < 4; ++ks) {
        bf16x8 af[2], bfr[4];
#pragma unroll
        for (int i = 0; i < 2; ++i) af[i] = *(const bf16x8*)(DA + (size_t)(i * 64 + wid * 16 + fr) * 128 + ks * 32 + fq * 8);
#pragma unroll
        for (int j = 0; j < 4; ++j) bfr[j] = *(const bf16x8*)(dT + (j * 16 + fr) * TP + ks * 32 + fq * 8);
#pragma unroll
        for (int i = 0; i < 2; ++i)
#pragma unroll
            for (int j = 0; j < 4; ++j) acc[i][j] = MFMA16(bfr[j], af[i], acc[i][j]);
    }
    const int k1 = wid * 16 + fr;
    const float2 cs = ((const float2*)(p.ws + OFF_TW))[bp * 64 + k1];
    bf16_t* Yb = (bf16_t*)(p.ws + OFF_H) + ((((size_t)(b * 8 + g) * 64 + k1) * 64 + bp) * 128);
#pragma unroll
    for (int j = 0; j < 4; ++j) {
        const int ch = j * 16 + fq * 4;
        float yr[4], yi[4];
#pragma unroll
        for (int e = 0; e < 4; ++e) { const float r = acc[0][j][e], im = acc[1][j][e]; yr[e] = r * cs.x + im * cs.y; yi[e] = im * cs.x - r * cs.y; }
        *(uint2*)(Yb + ch) = make_uint2(pk_bf16(yr[0], yr[1]), pk_bf16(yr[2], yr[3]));
        *(uint2*)(Yb + 64 + ch) = make_uint2(pk_bf16(yi[0], yi[1]), pk_bf16(yi[2], yi[3]));
    }
    __syncthreads();
}

__device__ void phase_mix(const Params& p, int l, char* smem, int bid, int nb) {
    for (int item = bid; item < 2048 + 4096; item += nb) {
        if (item < 2048) gmlp_item(p, l, item, smem); else ffta_item(p, item - 2048, smem);
    }
}

__device__ void phase_fftb(const Params& p, int l, char* smem, int bid, int nb) {
    const int tid = otid(), lane = tid & 63, wid = tid >> 6, fr = lane & 15, fq = lane >> 4;
    bf16_t* dT = (bf16_t*)smem;
    const bf16_t* DB = (const bf16_t*)(p.ws + OFF_DB);
    bf16_t* Y = (bf16_t*)(p.ws + OFF_Y);
    float* ssb = (float*)(p.ws + OFF_SSQB);
    for (int item = bid; item < 4096; item += nb) {
        const int k1 = item & 63, g = (item >> 6) & 7, b = item >> 9;
        stage_transposed((const bf16_t*)(p.ws + OFF_H) + (((size_t)(b * 8 + g) * 64 + k1) * 64) * 128, 128, dT);
        __syncthreads();
        f32x4 acc[4];
#pragma unroll
        for (int j = 0; j < 4; ++j) acc[j] = (f32x4){0.f, 0.f, 0.f, 0.f};
#pragma unroll
        for (int ks = 0; ks < 4; ++ks) {
            const bf16x8 af = *(const bf16x8*)(DB + (size_t)(wid * 16 + fr) * 128 + ks * 32 + fq * 8);
#pragma unroll
            for (int j = 0; j < 4; ++j) { const bf16x8 bfr = *(const bf16x8*)(dT + (j * 16 + fr) * TP + ks * 32 + fq * 8); acc[j] = MFMA16(bfr, af, acc[j]); }
        }
        const int k2 = wid * 16 + fr, tok = b * SEQ + k1 + 64 * k2;
        float ss = 0.f;
#pragma unroll
        for (int j = 0; j < 4; ++j) {
            const int ch = j * 16 + fq * 4;
            const float4 fb = *(const float4*)(p.fnet_b + ((size_t)l * 8 + g) * 64 + ch);
            const float y0 = acc[j][0] * (1.0f / 512.0f) + fb.x, y1 = acc[j][1] * (1.0f / 512.0f) + fb.y, y2 = acc[j][2] * (1.0f / 512.0f) + fb.z, y3 = acc[j][3] * (1.0f / 512.0f) + fb.w;
            ss += y0 * y0 + y1 * y1 + y2 * y2 + y3 * y3;
            *(uint2*)(Y + (size_t)tok * D + 512 + g * 64 + ch) = make_uint2(pk_bf16(y0, y1), pk_bf16(y2, y3));
        }
        ss += __shfl_xor(ss, 16); ss += __shfl_xor(ss, 32);
        if (fq == 0) ssb[(size_t)tok * 8 + g] = ss;
        __syncthreads();
    }
}

#define INS16(a, v) do { a[15] = med3i(a[14], a[15], v); a[14] = med3i(a[13], a[14], v); a[13] = med3i(a[12], a[13], v); a[12] = med3i(a[11], a[12], v); \
    a[11] = med3i(a[10], a[11], v); a[10] = med3i(a[9], a[10], v); a[9] = med3i(a[8], a[9], v); a[8] = med3i(a[7], a[8], v); a[7] = med3i(a[6], a[7], v); \
    a[6] = med3i(a[5], a[6], v); a[5] = med3i(a[4], a[5], v); a[4] = med3i(a[3], a[4], v); a[3] = med3i(a[2], a[3], v); a[2] = med3i(a[1], a[2], v); \
    a[1] = med3i(a[0], a[1], v); a[0] = max(a[0], v); } while (0)

template <int I, int J> struct CandLoop {
    static __device__ __forceinline__ void run(int (&a)[16], const float (&f1)[16], const float (&f2)[16]) {
        if constexpr ((I + 1) * (J + 1) <= 16) { const int key = (f2key(f1[I] + f2[J]) & ~255) | (I * 16 + J); INS16(a, key); }
        if constexpr (J + 1 < 16) CandLoop<I, J + 1>::run(a, f1, f2);
        else if constexpr (I + 1 < 16) CandLoop<I + 1, 0>::run(a, f1, f2);
    }
};

__device__ void phase_topk(const Params& p, int l, char* smem, int bid, int nb) {
    const int tid = otid(), lane = tid & 63, wid = tid >> 6, fr = lane & 15, fq = lane >> 4;
    float* S = (float*)smem;
    int* TT = (int*)(smem + 64 * 257 * 4);
    const bf16_t* Q = (const bf16_t*)(p.ws + OFF_Z);
    int* eidx = (int*)(p.ws + OFF_Y); float* gw = (float*)(p.ws + OFF_Y + (size_t)T * 128 * 4);
    for (int item = bid; item < (T / 64) * 8; item += nb) {
        const int h = item & 7, tok0 = (item >> 3) * 64;
        const bf16_t* K12 = (const bf16_t*)(p.ws + OFF_K12) + ((size_t)l * 8 + h) * 256 * 128;
        {
            const int half = wid >> 1;
            f32x4 acc[4][4];
#pragma unroll
            for (int i = 0; i < 4; ++i)
#pragma unroll
                for (int j = 0; j < 4; ++j) acc[i][j] = (f32x4){0.f, 0.f, 0.f, 0.f};
#pragma unroll
            for (int ks = 0; ks < 4; ++ks) {
                bf16x8 af[4], bfr[4];
#pragma unroll
                for (int i = 0; i < 4; ++i) af[i] = *(const bf16x8*)(Q + (size_t)(tok0 + i * 16 + fr) * 2048 + h * 256 + half * 128 + ks * 32 + fq * 8);
#pragma unroll
                for (int j = 0; j < 4; ++j) bfr[j] = *(const bf16x8*)(K12 + (size_t)((wid * 4 + j) * 16 + fr) * 128 + ks * 32 + fq * 8);
#pragma unroll
                for (int i = 0; i < 4; ++i)
#pragma unroll
                    for (int j = 0; j < 4; ++j) acc[i][j] = MFMA16(bfr[j], af[i], acc[i][j]);
            }
#pragma unroll
            for (int i = 0; i < 4; ++i)
#pragma unroll
                for (int j = 0; j < 4; ++j)
#pragma unroll
                    for (int e = 0; e < 4; ++e) S[(i * 16 + fr) * 257 + (wid * 4 + j) * 16 + fq * 4 + e] = acc[i][j][e];
        }
        __syncthreads();
        if (tid < 128) {
            const int tk = tid & 63, half = tid >> 6;
            int a[16];
#pragma unroll
            for (int i = 0; i < 16; ++i) a[i] = (int)0x80000000;
            const float* sr = S + tk * 257 + half * 128;
#pragma unroll 4
            for (int i = 0; i < 128; ++i) { const int key = (f2key(sr[i]) & ~127) | i; INS16(a, key); }
#pragma unroll
            for (int i = 0; i < 16; ++i) TT[(tk * 2 + half) * 16 + i] = a[i];
        }
        __syncthreads();
        if (tid < 64) {
            const int tk = tid;
            float f1[16], f2[16];
#pragma unroll
            for (int i = 0; i < 16; ++i) { f1[i] = key2f(TT[(tk * 2) * 16 + i] & ~127); f2[i] = key2f(TT[(tk * 2 + 1) * 16 + i] & ~127); }
            int a[16];
#pragma unroll
            for (int i = 0; i < 16; ++i) a[i] = (int)0x80000000;
            CandLoop<0, 0>::run(a, f1, f2);
            float sc[16], e[16], sum = 0.f; int ex[16];
#pragma unroll
            for (int i = 0; i < 16; ++i) {
                sc[i] = key2f(a[i] & ~255);
                const int code = a[i] & 255;
                const int e1 = TT[(tk * 2) * 16 + (code >> 4)] & 127, e2 = TT[(tk * 2 + 1) * 16 + (code & 15)] & 127;
                ex[i] = e1 * 128 + e2;
            }
#pragma unroll
            for (int i = 0; i < 16; ++i) { e[i] = __expf(sc[i] - sc[0]); sum += e[i]; }
            const float inv = 1.0f / sum;
            int4* ep = (int4*)(eidx + (size_t)(tok0 + tk) * 128 + h * 16); float4* gp = (float4*)(gw + (size_t)(tok0 + tk) * 128 + h * 16);
#pragma unroll
            for (int i = 0; i < 4; ++i) { ep[i] = make_int4(ex[4 * i], ex[4 * i + 1], ex[4 * i + 2], ex[4 * i + 3]); gp[i] = make_float4(e[4 * i] * inv, e[4 * i + 1] * inv, e[4 * i + 2] * inv, e[4 * i + 3] * inv); }
        }
        __syncthreads();
    }
}

__device__ __forceinline__ float dot8(const uint4& a, const uint4& b, float acc) {
    acc = __builtin_amdgcn_fdot2_f32_bf16(__builtin_bit_cast(bf16x2_t, a.x), __builtin_bit_cast(bf16x2_t, b.x), acc, false);
    acc = __builtin_amdgcn_fdot2_f32_bf16(__builtin_bit_cast(bf16x2_t, a.y), __builtin_bit_cast(bf16x2_t, b.y), acc, false);
    acc = __builtin_amdgcn_fdot2_f32_bf16(__builtin_bit_cast(bf16x2_t, a.z), __builtin_bit_cast(bf16x2_t, b.z), acc, false);
    acc = __builtin_amdgcn_fdot2_f32_bf16(__builtin_bit_cast(bf16x2_t, a.w), __builtin_bit_cast(bf16x2_t, b.w), acc, false);
    return acc;
}
__device__ __forceinline__ void axpy8(float (&o)[8], float c, const uint4& v) {
    o[0] += c * bf2f(v.x & 0xffffu); o[1] += c * bf2f(v.x >> 16); o[2] += c * bf2f(v.y & 0xffffu); o[3] += c * bf2f(v.y >> 16);
    o[4] += c * bf2f(v.z & 0xffffu); o[5] += c * bf2f(v.z >> 16); o[6] += c * bf2f(v.w & 0xffffu); o[7] += c * bf2f(v.w >> 16);
}

__device__ void phase_peer(const Params& p, int l, int bid, int nb) {
    const int tid_ = otid(); const int lane = tid_ & 63, wid = tid_ >> 6;
    const bf16_t* H = (const bf16_t*)(p.ws + OFF_H);
    const bf16_t* Ub = (const bf16_t*)(p.ws + OFF_UB) + (size_t)l * NE * 1024;
    const bf16_t* Vb = (const bf16_t*)(p.ws + OFF_VB) + (size_t)l * NE * 1024;
    const int* eidx = (const int*)(p.ws + OFF_Y); const float* gw = (const float*)(p.ws + OFF_Y + (size_t)T * 128 * 4);
    const float* mod = (const float*)(p.ws + OFF_MOD) + (size_t)l * NB * 6144;
    const bool last = (l == NL - 1);
    const float* gnext = last ? p.final_g : (p.norm1_g + (l + 1) * D);
    const float* modn = (const float*)(p.ws + OFF_MOD) + (size_t)(last ? l : l + 1) * NB * 6144;
    for (int tok = bid * 4 + wid; tok < T; tok += nb * 4) {
        const int b = tok / SEQ;
        const uint4 h0 = *(const uint4*)(H + (size_t)tok * D + lane * 8), h1 = *(const uint4*)(H + (size_t)tok * D + 512 + lane * 8);
        float o0[8], o1[8];
#pragma unroll
        for (int i = 0; i < 8; ++i) { o0[i] = 0.f; o1[i] = 0.f; }
        for (int h = 0; h < 8; ++h) {
            const int my_e = eidx[(size_t)tok * 128 + h * 16 + (lane & 15)];
            const float my_g = gw[(size_t)tok * 128 + h * 16 + (lane >> 2)];
            float pp[16];
#pragma unroll
            for (int k = 0; k < 16; ++k) {
                const int e = __builtin_amdgcn_readlane(my_e, k);
                const bf16_t* ur = Ub + (size_t)e * 1024;
                const uint4 u0 = *(const uint4*)(ur + lane * 8), u1 = *(const uint4*)(ur + 512 + lane * 8);
                pp[k] = dot8(h1, u1, dot8(h0, u0, 0.f));
            }
            float r8[8], r4[4], r2[2], r1;
            { const bool hi = (lane & 32) != 0;
#pragma unroll
              for (int j = 0; j < 8; ++j) { const float send = hi ? pp[j] : pp[j + 8], keep = hi ? pp[j + 8] : pp[j]; r8[j] = keep + __shfl_xor(send, 32); } }
            { const bool hi = (lane & 16) != 0;
#pragma unroll
              for (int j = 0; j < 4; ++j) { const float send = hi ? r8[j] : r8[j + 4], keep = hi ? r8[j + 4] : r8[j]; r4[j] = keep + __shfl_xor(send, 16); } }
            { const bool hi = (lane & 8) != 0;
#pragma unroll
              for (int j = 0; j < 2; ++j) { const float send = hi ? r4[j] : r4[j + 2], keep = hi ? r4[j + 2] : r4[j]; r2[j] = keep + __shfl_xor(send, 8); } }
            { const bool hi = (lane & 4) != 0; const float send = hi ? r2[0] : r2[1], keep = hi ? r2[1] : r2[0]; r1 = keep + __shfl_xor(send, 4); }
            r1 += __shfl_xor(r1, 2); r1 += __shfl_xor(r1, 1);
            const float coef = my_g * gelu_f(r1);
#pragma unroll
            for (int k = 0; k < 16; ++k) {
                const int e = __builtin_amdgcn_readlane(my_e, k);
                const float ck = __builtin_bit_cast(float, __builtin_amdgcn_readlane(__builtin_bit_cast(int, coef), 4 * k));
                const bf16_t* vr = Vb + (size_t)e * 1024;
                const uint4 v0 = *(const uint4*)(vr + lane * 8), v1 = *(const uint4*)(vr + 512 + lane * 8);
                axpy8(o0, ck, v0); axpy8(o1, ck, v1);
            }
        }
        float* xr = p.out + (size_t)tok * D;
        const float* g2 = mod + (size_t)b * 6144 + 5 * D;
        float xn0[8], xn1[8]; float ss = 0.f;
#pragma unroll
        for (int q = 0; q < 2; ++q) {
            const float4 xa = *(const float4*)(xr + lane * 8 + q * 4), ga = *(const float4*)(g2 + lane * 8 + q * 4);
            const float4 xb = *(const float4*)(xr + 512 + lane * 8 + q * 4), gb = *(const float4*)(g2 + 512 + lane * 8 + q * 4);
            xn0[q * 4 + 0] = xa.x + ga.x * o0[q * 4 + 0]; xn0[q * 4 + 1] = xa.y + ga.y * o0[q * 4 + 1]; xn0[q * 4 + 2] = xa.z + ga.z * o0[q * 4 + 2]; xn0[q * 4 + 3] = xa.w + ga.w * o0[q * 4 + 3];
            xn1[q * 4 + 0] = xb.x + gb.x * o1[q * 4 + 0]; xn1[q * 4 + 1] = xb.y + gb.y * o1[q * 4 + 1]; xn1[q * 4 + 2] = xb.z + gb.z * o1[q * 4 + 2]; xn1[q * 4 + 3] = xb.w + gb.w * o1[q * 4 + 3];
        }
#pragma unroll
        for (int i = 0; i < 8; ++i) ss += xn0[i] * xn0[i] + xn1[i] * xn1[i];
        ss = wave_sum(ss);
        const float rstd = rsqrtf(ss * (1.0f / D) + EPS);
        if (last) {
#pragma unroll
            for (int q = 0; q < 2; ++q) {
                const float4 ga = *(const float4*)(gnext + lane * 8 + q * 4), gb = *(const float4*)(gnext + 512 + lane * 8 + q * 4);
                *(float4*)(xr + lane * 8 + q * 4) = make_float4(xn0[q * 4] * rstd * ga.x, xn0[q * 4 + 1] * rstd * ga.y, xn0[q * 4 + 2] * rstd * ga.z, xn0[q * 4 + 3] * rstd * ga.w);
                *(float4*)(xr + 512 + lane * 8 + q * 4) = make_float4(xn1[q * 4] * rstd * gb.x, xn1[q * 4 + 1] * rstd * gb.y, xn1[q * 4 + 2] * rstd * gb.z, xn1[q * 4 + 3] * rstd * gb.w);
            }
        } else {
            const float* shn = modn + (size_t)b * 6144; const float* scn = shn + D;
            unsigned w0[4], w1[4];
#pragma unroll
            for (int q = 0; q < 2; ++q) {
                *(float4*)(xr + lane * 8 + q * 4) = make_float4(xn0[q * 4], xn0[q * 4 + 1], xn0[q * 4 + 2], xn0[q * 4 + 3]);
                *(float4*)(xr + 512 + lane * 8 + q * 4) = make_float4(xn1[q * 4], xn1[q * 4 + 1], xn1[q * 4 + 2], xn1[q * 4 + 3]);
                const float4 ga = *(const float4*)(gnext + lane * 8 + q * 4), gb = *(const float4*)(gnext + 512 + lane * 8 + q * 4);
                const float4 sa = *(const float4*)(shn + lane * 8 + q * 4), sb = *(const float4*)(shn + 512 + lane * 8 + q * 4);
                const float4 ca = *(const float4*)(scn + lane * 8 + q * 4), cb = *(const float4*)(scn + 512 + lane * 8 + q * 4);
                w0[q * 2]     = pk_bf16(xn0[q * 4] * rstd * ga.x * (1.f + ca.x) + sa.x, xn0[q * 4 + 1] * rstd * ga.y * (1.f + ca.y) + sa.y);
                w0[q * 2 + 1] = pk_bf16(xn0[q * 4 + 2] * rstd * ga.z * (1.f + ca.z) + sa.z, xn0[q * 4 + 3] * rstd * ga.w * (1.f + ca.w) + sa.w);
                w1[q * 2]     = pk_bf16(xn1[q * 4] * rstd * gb.x * (1.f + cb.x) + sb.x, xn1[q * 4 + 1] * rstd * gb.y * (1.f + cb.y) + sb.y);
                w1[q * 2 + 1] = pk_bf16(xn1[q * 4 + 2] * rstd * gb.z * (1.f + cb.z) + sb.z, xn1[q * 4 + 3] * rstd * gb.w * (1.f + cb.w) + sb.w);
            }
            bf16_t* hr = (bf16_t*)(p.ws + OFF_H) + (size_t)tok * D;
            *(uint4*)(hr + lane * 8) = make_uint4(w0[0], w0[1], w0[2], w0[3]);
            *(uint4*)(hr + 512 + lane * 8) = make_uint4(w1[0], w1[1], w1[2], w1[3]);
        }
    }
}


#define XB_TMO      128
#define XB_XCNT(j)  (256  + 64 * (j))
#define XB_XSUB(j)  (1280 + 64 * (j))
#define XB_XGEN(j)  (2304 + 64 * (j))
#define XB_TOP      3328
#define XB_TOPGEN   3392
#define XCD_BAR_WORDS 3456
#define XB_SPIN_CAP (1u << 22)
#define LAS __attribute__((address_space(3)))
__device__ __forceinline__ unsigned xb_ld(unsigned* p)              { return __hip_atomic_load(p, __ATOMIC_RELAXED, __HIP_MEMORY_SCOPE_AGENT); }
__device__ __forceinline__ unsigned xb_add(unsigned* p, unsigned v) { return __hip_atomic_fetch_add(p, v, __ATOMIC_RELAXED, __HIP_MEMORY_SCOPE_AGENT); }
__device__ __forceinline__ unsigned xb_xcc_id() { return (unsigned)__builtin_amdgcn_s_getreg((3 << 11) | 20) & 0xFu; }
#define XB_SPIN(cond, bar) do { unsigned _sp = 0; while (cond) { __builtin_amdgcn_s_sleep(1); \
    if ((++_sp & 255u) == 0u) { if (xb_ld(&(bar)[XB_TMO])) break; if (_sp > XB_SPIN_CAP) { atomicAdd(&(bar)[XB_TMO], 1u); break; } } } } while (0)
struct XcdBarrier { unsigned* bar; unsigned x; volatile LAS unsigned* st; };
__device__ __forceinline__ XcdBarrier xcd_barrier_post(unsigned* bar, volatile LAS unsigned* st) {
    XcdBarrier b; b.bar = bar; b.x = xb_xcc_id(); b.st = st;
    if (threadIdx.x == 0) (void)xb_add(&bar[XB_XCNT(b.x)], 1u);
    return b;
}
__device__ __forceinline__ void xcd_barrier_complete(unsigned* bar, unsigned x, unsigned& nloc, unsigned& nx) {
    const unsigned G = gridDim.x * gridDim.y * gridDim.z;
    unsigned sum, cnt, mine, sp = 0u;
    for (;;) {
        sum = 0u; cnt = 0u; mine = 0u;
#pragma unroll
        for (unsigned j = 0; j < 16; ++j) { const unsigned c = xb_ld(&bar[XB_XCNT(j)]); sum += c; cnt += (c > 0u) ? 1u : 0u; mine = (j == x) ? c : mine; }
        if (sum == G) break;
        __builtin_amdgcn_s_sleep(1);
        if ((++sp & 255u) == 0u) { if (xb_ld(&bar[XB_TMO])) break; if (sp > XB_SPIN_CAP) { atomicAdd(&bar[XB_TMO], 1u); break; } }
    }
    nloc = mine > 0u ? mine : 1u; nx = cnt > 0u ? cnt : 1u;
}
__device__ __forceinline__ void xcd_barrier(const XcdBarrier& b) {
    asm volatile("s_waitcnt vmcnt(0)" ::: "memory");
    __syncthreads();
    if (threadIdx.x == 0) {
        unsigned* bar = b.bar;
        __builtin_amdgcn_s_waitcnt(0);
        unsigned nloc = b.st[0], nx = b.st[1];
        if (nloc == 0u) { xcd_barrier_complete(bar, b.x, nloc, nx); b.st[0] = nloc; b.st[1] = nx; }
        const unsigned old = xb_add(&bar[XB_XSUB(b.x)], 1u);
        const unsigned gen = old / nloc;
        if (old + 1u == (gen + 1u) * nloc) {
            __builtin_amdgcn_fence(__ATOMIC_RELEASE, "agent");
            asm volatile("s_waitcnt vmcnt(0)" ::: "memory");
            const unsigned og = xb_add(&bar[XB_TOP], 1u);
            const unsigned tg = og / nx;
            if (og + 1u == (tg + 1u) * nx) xb_add(&bar[XB_TOPGEN], 1u);
            else XB_SPIN(xb_ld(&bar[XB_TOPGEN]) == tg, bar);
            __builtin_amdgcn_fence(__ATOMIC_ACQUIRE, "agent");
            xb_add(&bar[XB_XGEN(b.x)], 1u);
            asm volatile("s_waitcnt vmcnt(0)" ::: "memory");
        } else {
            XB_SPIN(xb_ld(&bar[XB_XGEN(b.x)]) == gen, bar);
            __builtin_amdgcn_fence(__ATOMIC_ACQUIRE, "agent");
            asm volatile("s_waitcnt vmcnt(0)" ::: "memory");
        }
    }
    __syncthreads();
}

constexpr int NPHASE = 2 + 8 * NL;
__device__ __forceinline__ void run_phase(const Params& p, int ph, char* smem, int bid, int nb) {
    if (ph == 0) { phase_prep(p, smem, bid, nb); return; }
    if (ph == 1) { phase_norm(p.x, p.norm1_g, (const float*)(p.ws + OFF_MOD), 0, D, (bf16_t*)(p.ws + OFF_H), bid, nb); return; }
    const int l = (ph - 2) / 8, s = (ph - 2) % 8;
    switch (s) {
        case 0: phase_gemm1(p, l, smem, bid, nb); break;
        case 1: phase_mix(p, l, smem, bid, nb); break;
        case 2: phase_fftb(p, l, smem, bid, nb); break;
        case 3: phase_gemm2(p, l, smem, bid, nb); break;
        case 4: phase_norm(p.out, p.norm2_g + l * D, (const float*)(p.ws + OFF_MOD) + (size_t)l * NB * 6144, 3 * D, 4 * D, (bf16_t*)(p.ws + OFF_H), bid, nb); break;
        case 5: phase_gemm3(p, l, smem, bid, nb); break;
        case 6: phase_topk(p, l, smem, bid, nb); break;
        default: phase_peer(p, l, bid, nb); break;
    }
}

#if MEGA
__global__ void __launch_bounds__(256, 2) mega_kernel(Params p) {
    __shared__ __attribute__((aligned(16))) char smem[SMEM_BYTES];
    __shared__ uint4 xb_words;
    cg::grid_group grid = cg::this_grid();
    const int bid = blockIdx.x, nb = gridDim.x;
    unsigned* bar = (unsigned*)(p.ws + OFF_BAR);
    if (threadIdx.x == 0) xb_words = make_uint4(0u, 0u, 0u, 0u);
    if (bid == 0) for (int i = threadIdx.x; i < XCD_BAR_WORDS; i += 256) bar[i] = 0u;
    phase_prep(p, smem, bid, nb);
    grid.sync();
    const XcdBarrier xb = xcd_barrier_post(bar, (volatile LAS unsigned*)&xb_words);
    phase_norm(p.x, p.norm1_g, (const float*)(p.ws + OFF_MOD), 0, D, (bf16_t*)(p.ws + OFF_H), bid, nb); xcd_barrier(xb);
#pragma nounroll
    for (int l = 0; l < NL; ++l) {
        phase_gemm1(p, l, smem, bid, nb); xcd_barrier(xb);
        phase_mix(p, l, smem, bid, nb); xcd_barrier(xb);
        phase_fftb(p, l, smem, bid, nb); xcd_barrier(xb);
        phase_gemm2(p, l, smem, bid, nb); xcd_barrier(xb);
        phase_norm(p.out, p.norm2_g + l * D, (const float*)(p.ws + OFF_MOD) + (size_t)l * NB * 6144, 3 * D, 4 * D, (bf16_t*)(p.ws + OFF_H), bid, nb); xcd_barrier(xb);
        phase_gemm3(p, l, smem, bid, nb); xcd_barrier(xb);
        phase_topk(p, l, smem, bid, nb); xcd_barrier(xb);
        phase_peer(p, l, bid, nb);
        if (l + 1 < NL) xcd_barrier(xb);
    }
}
#else
__global__ void __launch_bounds__(256, 2) phase_kernel(Params p, int ph) {
    __shared__ __attribute__((aligned(16))) char smem[SMEM_BYTES];
    run_phase(p, ph, smem, blockIdx.x, gridDim.x);
}
#endif

__global__ void digest_kernel(Params p) {
    const int* eidx = (const int*)(p.ws + OFF_Y); const float* gw = (const float*)(p.ws + OFF_Y + (size_t)T * 128 * 4);
    for (size_t i = (size_t)blockIdx.x * 256 + threadIdx.x; i < (size_t)T * D; i += (size_t)gridDim.x * 256) {
        const size_t j = i % ((size_t)T * 128);
        p.out[i] = (float)eidx[j] * 1e-3f + gw[j];
    }
}
extern "C" void kernel_launch(void* const* d_in, const int* in_sizes, int n_in, void* d_out, int out_size, void* d_ws, size_t ws_size, hipStream_t stream) {
    (void)in_sizes; (void)n_in; (void)out_size;
    if (ws_size < OFF_END) { fprintf(stderr, "workspace too small: %zu < %zu\n", ws_size, (size_t)OFF_END); return; }
    Params p{};
    p.x = (const float*)d_in[0]; p.c = (const float*)d_in[1]; p.mod_w = (const float*)d_in[2]; p.mod_b = (const float*)d_in[3]; p.norm1_g = (const float*)d_in[4];
    p.w_in = (const float*)d_in[5]; p.gmlp_ws = (const float*)d_in[6]; p.gmlp_bs = (const float*)d_in[7]; p.fnet_w = (const float*)d_in[8]; p.fnet_b = (const float*)d_in[9];
    p.gain_a = (const float*)d_in[10]; p.gain_b = (const float*)d_in[11]; p.w_out = (const float*)d_in[12]; p.norm2_g = (const float*)d_in[13]; p.wq = (const float*)d_in[14];
    p.k1 = (const float*)d_in[15]; p.k2 = (const float*)d_in[16]; p.pu = (const float*)d_in[17]; p.pv = (const float*)d_in[18]; p.final_g = (const float*)d_in[19];
    p.out = (float*)d_out; p.ws = (char*)d_ws;
#if MEGA
    static int grid_blocks = 0;
    if (!grid_blocks) {
        int dev = 0, cus = 0, per_cu = 0;
        hipGetDevice(&dev);
        hipDeviceGetAttribute(&cus, hipDeviceAttributeMultiprocessorCount, dev);
        hipOccupancyMaxActiveBlocksPerMultiprocessor(&per_cu, mega_kernel, 256, 0);
        if (per_cu > 2) per_cu = 2;
        grid_blocks = cus * per_cu;
    }
    void* args[] = {&p};
    hipError_t e = hipLaunchCooperativeKernel((void*)mega_kernel, dim3(grid_blocks), dim3(256), args, 0, stream);
    if (e != hipSuccess) fprintf(stderr, "cooperative launch failed: %s (grid %d)\n", hipGetErrorString(e), grid_blocks);
#else
    for (int ph = 0; ph < NPHASE && ph <= STOP_AFTER; ++ph) phase_kernel<<<512, 256, 0, stream>>>(p, ph);
    if (DIGEST) digest_kernel<<<1024, 256, 0, stream>>>(p);
#endif
}
```

```cpp
#include <hip/hip_runtime.h>
#include <hip/hip_cooperative_groups.h>
#include <cstdio>
#include <cstdint>
namespace cg = cooperative_groups;

#ifndef MEGA
#define MEGA 1
#endif
#ifndef PROBE_A
#define PROBE_A -1
#define PROBE_B 0
#define PROBE_DIV 10.0f
#endif
#ifndef STOP_AFTER
#define STOP_AFTER 99
#define DIGEST 0
#endif

typedef unsigned short bf16_t;
typedef short bf16x8 __attribute__((ext_vector_type(8)));
typedef float f32x4 __attribute__((ext_vector_type(4)));
typedef __bf16 bf16x2_t __attribute__((ext_vector_type(2)));

constexpr int D = 1024, NB = 8, SEQ = 4096, T = NB * SEQ, NL = 2;
constexpr int NZ = 2048;
constexpr int NE = 16384;
constexpr float EPS = 1e-6f;

constexpr size_t OFF_MOD  = 0;
constexpr size_t OFF_W1T  = OFF_MOD  + (size_t)NL * NB * 6144 * 4;
constexpr size_t OFF_W2T  = OFF_W1T  + (size_t)NL * 2048 * 1024 * 2;
constexpr size_t OFF_WQT  = OFF_W2T  + (size_t)NL * 1024 * 1024 * 2;
constexpr size_t OFF_K12  = OFF_WQT  + (size_t)NL * 2048 * 1024 * 2;
constexpr size_t OFF_WSB  = OFF_K12  + (size_t)NL * 8 * 256 * 128 * 2;
constexpr size_t OFF_DA   = OFF_WSB  + (size_t)NL * 8 * 128 * 128 * 2;
constexpr size_t OFF_DB   = OFF_DA   + 128 * 128 * 2;
constexpr size_t OFF_TW   = OFF_DB   + 64 * 128 * 2;
constexpr size_t OFF_SSQA = OFF_TW   + 64 * 64 * 8;
constexpr size_t OFF_SSQB = OFF_SSQA + (size_t)T * 8 * 4;
constexpr size_t OFF_UB   = OFF_SSQB + (size_t)T * 8 * 4;
constexpr size_t OFF_VB   = OFF_UB   + (size_t)NL * NE * 1024;
constexpr size_t OFF_USC  = OFF_VB   + (size_t)NL * NE * 1024;
constexpr size_t OFF_VSC  = OFF_USC  + (size_t)NL * NE * 4;
constexpr size_t OFF_H    = OFF_VSC  + (size_t)NL * NE * 4;
constexpr size_t OFF_Z    = OFF_H    + (size_t)T * 1024 * 2;
constexpr size_t OFF_Y    = OFF_Z    + (size_t)T * 2048 * 2;
constexpr size_t OFF_BAR  = OFF_Y    + (size_t)T * 1024 * 2;
constexpr size_t OFF_END  = OFF_BAR  + 16384;

struct Params {
    const float* x; const float* c; const float* mod_w; const float* mod_b; const float* norm1_g; const float* w_in;
    const float* gmlp_ws; const float* gmlp_bs; const float* fnet_w; const float* fnet_b; const float* gain_a; const float* gain_b;
    const float* w_out; const float* norm2_g; const float* wq; const float* k1; const float* k2; const float* pu; const float* pv; const float* final_g;
    float* out; char* ws;
};

constexpr int SMEM_BYTES = 73984;

__device__ __forceinline__ float bf2f(unsigned v) { return __uint_as_float(v << 16); }
typedef float f32x2_t __attribute__((ext_vector_type(2)));
__device__ __forceinline__ unsigned pk_bf16(float lo, float hi) { const f32x2_t v = {lo, hi}; return __builtin_bit_cast(unsigned, __builtin_convertvector(v, bf16x2_t)); }
__device__ __forceinline__ bf16_t f2bf(float f) { return (bf16_t)(pk_bf16(f, 0.f) & 0xffffu); }
__device__ __forceinline__ float gelu_f(float v) { return 0.5f * v * (1.0f + erff(v * 0.70710678118f)); }
__device__ __forceinline__ int med3i(int a, int b, int c) { return max(min(a, b), min(max(a, b), c)); }
__device__ __forceinline__ int f2key(float f) { int b = __float_as_int(f); return b ^ ((b >> 31) & 0x7fffffff); }
__device__ __forceinline__ float key2f(int k) { return __int_as_float(k ^ ((k >> 31) & 0x7fffffff)); }
__device__ __forceinline__ float wave_sum(float v) {
#pragma unroll
    for (int o = 32; o >= 1; o >>= 1) v += __shfl_xor(v, o);
    return v;
}
__device__ __forceinline__ int otid() { int t = threadIdx.x; asm volatile("" : "+v"(t)); return t; }
#define MFMA16(a, b, c) __builtin_amdgcn_mfma_f32_16x16x32_bf16((a), (b), (c), 0, 0, 0)

__device__ void transpose_tile(const float* __restrict__ src, int ld, int k0, int n0, bf16_t* __restrict__ dst  , int dn0,
                               const float* __restrict__ kscale, float* tile  ) {
    const int tid = otid();
#pragma unroll
    for (int i = 0; i < 4; ++i) {
        const int r = (tid >> 4) + 16 * i, c4 = (tid & 15) * 4;
        const float4 v = *(const float4*)(src + (size_t)(k0 + r) * ld + n0 + c4);
        const float s = kscale ? kscale[k0 + r] : 1.0f;
        tile[r * 65 + c4 + 0] = v.x * s; tile[r * 65 + c4 + 1] = v.y * s; tile[r * 65 + c4 + 2] = v.z * s; tile[r * 65 + c4 + 3] = v.w * s;
    }
    __syncthreads();
    {
        const int n = tid >> 2, ks = (tid & 3) * 16;
        unsigned w[8];
#pragma unroll
        for (int j = 0; j < 8; ++j) w[j] = pk_bf16(tile[(ks + 2 * j) * 65 + n], tile[(ks + 2 * j + 1) * 65 + n]);
        uint4* d = (uint4*)(dst + (size_t)(dn0 + n) * 1024 + k0 + ks);
        d[0] = make_uint4(w[0], w[1], w[2], w[3]); d[1] = make_uint4(w[4], w[5], w[6], w[7]);
    }
    __syncthreads();
}

__device__ void phase_prep(const Params& p, char* smem, int bid, int nb) {
    const int tid = otid();
    const int gtid = bid * 256 + tid, gsz = nb * 256;
    char* ws = p.ws;
    {
        float* sc = (float*)smem;
        float* red = (float*)(smem + 32768);
        for (int i = tid; i < 8192; i += 256) { const float v = p.c[i]; sc[i] = v / (1.0f + __expf(-v)); }
        __syncthreads();
        float* mod = (float*)(ws + OFF_MOD);
        for (int item = bid; item < NL * 192; item += nb) {
            const int l = item / 192, n0 = (item % 192) * 32, nn = tid & 31, kq = tid >> 5;
            float acc[8];
#pragma unroll
            for (int b = 0; b < 8; ++b) acc[b] = 0.f;
            const float* W = p.mod_w + (size_t)l * 1024 * 6144 + n0 + nn;
            for (int k = kq; k < 1024; k += 8) {
                const float w = W[(size_t)k * 6144];
#pragma unroll
                for (int b = 0; b < 8; ++b) acc[b] += sc[b * 1024 + k] * w;
            }
#pragma unroll
            for (int b = 0; b < 8; ++b) red[(kq * 8 + b) * 32 + nn] = acc[b];
            __syncthreads();
            {
                const int b = tid >> 5;
                float s = 0.f;
#pragma unroll
                for (int q = 0; q < 8; ++q) s += red[(q * 8 + b) * 32 + nn];
                mod[((size_t)l * NB + b) * 6144 + n0 + nn] = s + p.mod_b[l * 6144 + n0 + nn];
            }
            __syncthreads();
        }
    }
    {
        float* tile = (float*)smem;
        for (int item = bid; item < NL * 1024; item += nb) {
            const int l = item / 1024, r = item % 1024;
            if (r < 256) {
                const int kt = r / 16, nt = r % 16;
                transpose_tile(p.w_in + (size_t)l * 1024 * 1536, 1536, kt * 64, nt * 64, (bf16_t*)(ws + OFF_W1T) + (size_t)l * 2048 * 1024, nt * 64, nullptr, tile);
            } else if (r < 512) {
                const int rr = r - 256, kt = rr / 16, nt = rr % 16;
                const float* gk = (kt < 8) ? (p.gain_a + l * 512) : (p.gain_b + l * 512 - 512);
                transpose_tile(p.w_out + (size_t)l * 1024 * 1024, 1024, kt * 64, nt * 64, (bf16_t*)(ws + OFF_W2T) + (size_t)l * 1024 * 1024, nt * 64, gk, tile);
            } else {
                const int rr = r - 512, kt = rr / 32, nt = rr % 32;
                transpose_tile(p.wq + (size_t)l * 1024 * 2048, 2048, kt * 64, nt * 64, (bf16_t*)(ws + OFF_WQT) + (size_t)l * 2048 * 1024, nt * 64, nullptr, tile);
            }
        }
    }
    {
        float* fws = (float*)smem;
        float* Ms  = (float*)(smem + 16384);
        float* wt  = (float*)(smem + 49152);
        float* cs  = (float*)(smem + 49152 + 16640);
        for (int item = bid; item < NL * 8 * 16; item += nb) {
            const int l = item / 128, g = (item % 128) / 16, kt = item % 16;
            if (tid < 64) { float s, c; sincospif((float)tid / 32.0f, &s, &c); cs[tid] = c; cs[64 + tid] = s; }
            for (int i = tid; i < 4096; i += 256) fws[i] = p.fnet_w[((size_t)l * 8 + g) * 4096 + i];
#pragma unroll
            for (int i = 0; i < 4; ++i) {
                const int r = (tid >> 4) + 16 * i, c4 = (tid & 15) * 4;
                const float4 v = *(const float4*)(p.w_in + (size_t)l * 1024 * 1536 + (size_t)(kt * 64 + r) * 1536 + 1024 + g * 64 + c4);
                wt[r * 65 + c4] = v.x; wt[r * 65 + c4 + 1] = v.y; wt[r * 65 + c4 + 2] = v.z; wt[r * 65 + c4 + 3] = v.w;
            }
            __syncthreads();
            {
                const int d = tid >> 2, r0 = (tid & 3) * 32;
                const bool im = r0 >= 64; const int e0 = r0 & 63;
                float acc[32];
#pragma unroll
                for (int e = 0; e < 32; ++e) acc[e] = 0.f;
                for (int j = 0; j < 64; ++j) {
                    const int ph = (d * j) & 63;
                    const float t = im ? -cs[64 + ph] : cs[ph];
#pragma unroll
                    for (int e = 0; e < 32; ++e) acc[e] += t * fws[j * 64 + e0 + e];
                }
#pragma unroll
                for (int e = 0; e < 32; ++e) Ms[d * 128 + r0 + e] = acc[e];
            }
            __syncthreads();
            {
                const int r = tid >> 1, kk0 = (tid & 1) * 32;
                float acc[32];
#pragma unroll
                for (int k = 0; k < 32; ++k) acc[k] = 0.f;
                for (int d = 0; d < 64; ++d) {
                    const float m = Ms[d * 128 + r];
#pragma unroll
                    for (int k = 0; k < 32; ++k) acc[k] += wt[(kk0 + k) * 65 + d] * m;
                }
                bf16_t* dst = (bf16_t*)(ws + OFF_W1T) + (size_t)l * 2048 * 1024 + (size_t)(1024 + g * 128 + r) * 1024 + kt * 64 + kk0;
#pragma unroll
                for (int q = 0; q < 4; ++q)
                    ((uint4*)dst)[q] = make_uint4(pk_bf16(acc[q * 8], acc[q * 8 + 1]), pk_bf16(acc[q * 8 + 2], acc[q * 8 + 3]), pk_bf16(acc[q * 8 + 4], acc[q * 8 + 5]), pk_bf16(acc[q * 8 + 6], acc[q * 8 + 7]));
            }
            __syncthreads();
        }
    }
    {
        bf16_t* k12 = (bf16_t*)(ws + OFF_K12);
        for (int i = gtid; i < NL * 8 * 256 * 128; i += gsz) {
            const int d = i & 127, n = (i >> 7) & 255, h = (i >> 15) & 7, l = i >> 18;
            const float* src = (n < 128) ? p.k1 : p.k2;
            k12[i] = f2bf(src[(((size_t)l * 8 + h) * 128 + (n & 127)) * 128 + d]);
        }
        bf16_t* wsb = (bf16_t*)(ws + OFF_WSB);
        for (int i = gtid; i < NL * 8 * 128 * 128; i += gsz) wsb[i] = f2bf(p.gmlp_ws[i]);
        bf16_t* DA = (bf16_t*)(ws + OFF_DA);
        for (int i = gtid; i < 128 * 128; i += gsz) {
            const int m = i >> 7, kk = i & 127, ro = m >> 6, k1 = m & 63, ri = kk >> 6, a = kk & 63;
            float s, c; sincospif((float)((a * k1) & 63) / 32.0f, &s, &c);
            const float v = (ro == ri) ? c : (ro == 0 ? s : -s);
            DA[i] = f2bf(v);
        }
        bf16_t* DB = (bf16_t*)(ws + OFF_DB);
        for (int i = gtid; i < 64 * 128; i += gsz) {
            const int k2 = i >> 7, kk = i & 127, ri = kk >> 6, b = kk & 63;
            float s, c; sincospif((float)((b * k2) & 63) / 32.0f, &s, &c);
            DB[i] = f2bf(ri ? s : c);
        }
        float2* tw = (float2*)(ws + OFF_TW);
        for (int i = gtid; i < 64 * 64; i += gsz) {
            const int bp = i >> 6, k1 = i & 63;
            float s, c; sincospif((float)(bp * k1) / 2048.0f, &s, &c);
            tw[i] = make_float2(c, s);
        }
        {
            const int lane = tid & 63, wv = gtid >> 6, nwv = gsz >> 6;
            for (int r = wv; r < 2 * NL * NE; r += nwv) {
                const int tbl = r / (NL * NE), row = r % (NL * NE);
                const float* src = (tbl ? p.pv : p.pu) + (size_t)row * 1024 + lane * 16;
                float4 v[4]; float m = 0.f;
#pragma unroll
                for (int i = 0; i < 4; ++i) { v[i] = ((const float4*)src)[i]; m = fmaxf(m, fmaxf(fmaxf(fabsf(v[i].x), fabsf(v[i].y)), fmaxf(fabsf(v[i].z), fabsf(v[i].w)))); }
#pragma unroll
                for (int o = 32; o >= 1; o >>= 1) m = fmaxf(m, __shfl_xor(m, o));
                const float sc = (m > 0.f) ? 256.0f / m : 1.0f, inv = (m > 0.f) ? m * (1.0f / 256.0f) : 1.0f;
                int w[4];
#pragma unroll
                for (int i = 0; i < 4; ++i) { w[i] = __builtin_amdgcn_cvt_pk_fp8_f32(v[i].x * sc, v[i].y * sc, 0, false); w[i] = __builtin_amdgcn_cvt_pk_fp8_f32(v[i].z * sc, v[i].w * sc, w[i], true); }
                *(int4*)(ws + (tbl ? OFF_VB : OFF_UB) + (size_t)row * 1024 + lane * 16) = make_int4(w[0], w[1], w[2], w[3]);
                if (lane == 0) ((float*)(ws + (tbl ? OFF_VSC : OFF_USC)))[row] = inv;
            }
        }
    }
}

__device__ void phase_norm(const float* __restrict__ xsrc, const float* __restrict__ g, const float* __restrict__ modl  , int sh_off, int scl_off,
                           bf16_t* __restrict__ hout, int bid, int nb) {
    const int tid_ = otid(); const int lane = tid_ & 63, wid = tid_ >> 6;
    for (int tok = bid * 4 + wid; tok < T; tok += nb * 4) {
        const int b = tok / SEQ;
        const float* xr = xsrc + (size_t)tok * D;
        float4 v[4];
        float ss = 0.f;
#pragma unroll
        for (int i = 0; i < 4; ++i) { v[i] = *(const float4*)(xr + i * 256 + lane * 4); ss += v[i].x * v[i].x + v[i].y * v[i].y + v[i].z * v[i].z + v[i].w * v[i].w; }
        ss = wave_sum(ss);
        const float rstd = rsqrtf(ss * (1.0f / D) + EPS);
        const float* mb = modl + (size_t)b * 6144;
#pragma unroll
        for (int i = 0; i < 4; ++i) {
            const int cidx = i * 256 + lane * 4;
            const float4 gg = *(const float4*)(g + cidx), sh = *(const float4*)(mb + sh_off + cidx), sc = *(const float4*)(mb + scl_off + cidx);
            const float o0 = v[i].x * rstd * gg.x * (1.0f + sc.x) + sh.x, o1 = v[i].y * rstd * gg.y * (1.0f + sc.y) + sh.y;
            const float o2 = v[i].z * rstd * gg.z * (1.0f + sc.z) + sh.z, o3 = v[i].w * rstd * gg.w * (1.0f + sc.w) + sh.w;
            *(uint2*)(hout + (size_t)tok * D + cidx) = make_uint2(pk_bf16(o0, o1), pk_bf16(o2, o3));
        }
    }
}

constexpr int GP = 72;
template <class Epi, class MidK>
__device__ __forceinline__ void gemm_tile(const bf16_t* __restrict__ A, int lda, const bf16_t* __restrict__ Bt, int ldb, int K, int m0, int n0,
                                          char* smem, const Epi& epi, const MidK& midk, int kmid) {
    const int tid = otid(), lane = tid & 63, wid = tid >> 6, wr = wid >> 1, wc = wid & 1, fr = lane & 15, fq = lane >> 4;
    bf16_t* sa = (bf16_t*)smem;
    bf16_t* sb = (bf16_t*)(smem + 2 * 128 * GP * 2);
    f32x4 acc[4][4];
#pragma unroll
    for (int i = 0; i < 4; ++i)
#pragma unroll
        for (int j = 0; j < 4; ++j) acc[i][j] = (f32x4){0.f, 0.f, 0.f, 0.f};
    uint4 ra[4], rb[4];
    const int lrow = tid >> 3, lkc = (tid & 7) * 8;
    const bf16_t* ga = A + (size_t)(m0 + lrow) * lda + lkc;
    const bf16_t* gb = Bt + (size_t)(n0 + lrow) * ldb + lkc;
    const int nk = K / 64;
#pragma unroll
    for (int i = 0; i < 4; ++i) { ra[i] = *(const uint4*)(ga + (size_t)(32 * i) * lda); rb[i] = *(const uint4*)(gb + (size_t)(32 * i) * ldb); }
#pragma unroll
    for (int i = 0; i < 4; ++i) { *(uint4*)(sa + (lrow + 32 * i) * GP + lkc) = ra[i]; *(uint4*)(sb + (lrow + 32 * i) * GP + lkc) = rb[i]; }
    __syncthreads();
    for (int kt = 0; kt < nk; ++kt) {
        const int cur = kt & 1;
        if (kt + 1 < nk) {
#pragma unroll
            for (int i = 0; i < 4; ++i) { ra[i] = *(const uint4*)(ga + (size_t)(32 * i) * lda + (kt + 1) * 64); rb[i] = *(const uint4*)(gb + (size_t)(32 * i) * ldb + (kt + 1) * 64); }
        }
        if (kt == kmid) {
#pragma unroll
            for (int i = 0; i < 4; ++i) { const float s = midk(m0 + wr * 64 + i * 16 + fr);
#pragma unroll
                for (int j = 0; j < 4; ++j) acc[i][j] *= s; }
        }
        const bf16_t* ca = sa + cur * 128 * GP; const bf16_t* cb = sb + cur * 128 * GP;
#pragma unroll
        for (int ks = 0; ks < 2; ++ks) {
            bf16x8 af[4], bfr[4];
#pragma unroll
            for (int i = 0; i < 4; ++i) af[i] = *(const bf16x8*)(ca + (wr * 64 + i * 16 + fr) * GP + ks * 32 + fq * 8);
#pragma unroll
            for (int j = 0; j < 4; ++j) bfr[j] = *(const bf16x8*)(cb + (wc * 64 + j * 16 + fr) * GP + ks * 32 + fq * 8);
#pragma unroll
            for (int i = 0; i < 4; ++i)
#pragma unroll
                for (int j = 0; j < 4; ++j) acc[i][j] = MFMA16(bfr[j], af[i], acc[i][j]);
        }
        if (kt + 1 < nk) {
            bf16_t* na = sa + (cur ^ 1) * 128 * GP; bf16_t* nbp = sb + (cur ^ 1) * 128 * GP;
#pragma unroll
            for (int i = 0; i < 4; ++i) { *(uint4*)(na + (lrow + 32 * i) * GP + lkc) = ra[i]; *(uint4*)(nbp + (lrow + 32 * i) * GP + lkc) = rb[i]; }
        }
        __syncthreads();
    }
#pragma unroll
    for (int i = 0; i < 4; ++i)
#pragma unroll
        for (int j = 0; j < 4; ++j) { epi(m0 + wr * 64 + i * 16 + fr, n0 + wc * 64 + j * 16 + fq * 4, acc[i][j]); __builtin_amdgcn_sched_barrier(0); }
}
struct NoMid { __device__ __forceinline__ float operator()(int) const { return 1.0f; } };

__device__ void phase_gemm1(const Params& p, int l, char* smem, int bid, int nb) {
    const bf16_t* A = (const bf16_t*)(p.ws + OFF_H);
    const bf16_t* Bt = (const bf16_t*)(p.ws + OFF_W1T) + (size_t)l * 2048 * 1024;
    bf16_t* Z = (bf16_t*)(p.ws + OFF_Z);
    auto epi = [&](int row, int col, const f32x4& v) {
        float a = v[0], b = v[1], c = v[2], d = v[3];
        if (col < 1024) { a = gelu_f(a); b = gelu_f(b); c = gelu_f(c); d = gelu_f(d); }
        *(uint2*)(Z + (size_t)row * NZ + col) = make_uint2(pk_bf16(a, b), pk_bf16(c, d));
    };
    const int NT = NZ / 128, MT = T / 128;
    for (int item = bid; item < MT * NT; item += nb) gemm_tile(A, D, Bt, D, D, (item / NT) * 128, (item % NT) * 128, smem, epi, NoMid(), -1);
}
__device__ void phase_gemm2(const Params& p, int l, char* smem, int bid, int nb) {
    const bf16_t* A = (const bf16_t*)(p.ws + OFF_Y);
    const bf16_t* Bt = (const bf16_t*)(p.ws + OFF_W2T) + (size_t)l * 1024 * 1024;
    const float* ssa = (const float*)(p.ws + OFF_SSQA); const float* ssb = (const float*)(p.ws + OFF_SSQB);
    const float* mod = (const float*)(p.ws + OFF_MOD) + (size_t)l * NB * 6144;
    const float* xin = (l == 0) ? p.x : p.out;
    float* xout = p.out;
    auto rstd_of = [&](const float* s, int row) {
        const float4 a = *(const float4*)(s + (size_t)row * 8), b = *(const float4*)(s + (size_t)row * 8 + 4);
        return rsqrtf(((a.x + a.y) + (a.z + a.w) + (b.x + b.y) + (b.z + b.w)) * (1.0f / 512.0f) + EPS);
    };
    auto midk = [&](int row) { return rstd_of(ssa, row) / rstd_of(ssb, row); };
    auto epi = [&](int row, int col, const f32x4& v) {
        const float rb = rstd_of(ssb, row);
        const int b = row / SEQ;
        const float4 g = *(const float4*)(mod + (size_t)b * 6144 + 2 * D + col);
        const float4 xi = *(const float4*)(xin + (size_t)row * D + col);
        float4 o; o.x = xi.x + g.x * rb * v[0]; o.y = xi.y + g.y * rb * v[1]; o.z = xi.z + g.z * rb * v[2]; o.w = xi.w + g.w * rb * v[3];
        *(float4*)(xout + (size_t)row * D + col) = o;
    };
    const int NT = D / 128, MT = T / 128;
    for (int item = bid; item < MT * NT; item += nb) gemm_tile(A, D, Bt, D, D, (item / NT) * 128, (item % NT) * 128, smem, epi, midk, 8);
}
__device__ void phase_gemm3(const Params& p, int l, char* smem, int bid, int nb) {
    const bf16_t* A = (const bf16_t*)(p.ws + OFF_H);
    const bf16_t* Bt = (const bf16_t*)(p.ws + OFF_WQT) + (size_t)l * 2048 * 1024;
    bf16_t* Q = (bf16_t*)(p.ws + OFF_Z);
    auto epi = [&](int row, int col, const f32x4& v) { *(uint2*)(Q + (size_t)row * 2048 + col) = make_uint2(pk_bf16(v[0], v[1]), pk_bf16(v[2], v[3])); };
    const int NT = 2048 / 128, MT = T / 128;
    for (int item = bid; item < MT * NT; item += nb) gemm_tile(A, D, Bt, D, D, (item / NT) * 128, (item % NT) * 128, smem, epi, NoMid(), -1);
}

constexpr int TP = 136;
__device__ __forceinline__ void stage_transposed(const bf16_t* __restrict__ base, size_t row_stride, bf16_t* dT) {
    const int tid = otid(), r = tid >> 2, part = tid & 3, ri = part >> 1, c0 = (part & 1) * 32;
    const uint4* src = (const uint4*)(base + (size_t)r * row_stride + ri * 64 + c0);
    uint4 v[4];
#pragma unroll
    for (int i = 0; i < 4; ++i) v[i] = src[i];
#pragma unroll
    for (int i = 0; i < 4; ++i) {
        const unsigned w[4] = {v[i].x, v[i].y, v[i].z, v[i].w};
#pragma unroll
        for (int j = 0; j < 4; ++j) {
            dT[(c0 + i * 8 + j * 2) * TP + ri * 64 + r] = (bf16_t)(w[j] & 0xffffu);
            dT[(c0 + i * 8 + j * 2 + 1) * TP + ri * 64 + r] = (bf16_t)(w[j] >> 16);
        }
    }
}

__device__ void gmlp_item(const Params& p, int l, int item, char* smem) {
    const int tid = otid(), lane = tid & 63, wid = tid >> 6, fr = lane & 15, fq = lane >> 4;
    const int h = item & 7, c = (item >> 3) & 31, b = item >> 8;
    const int tok0 = b * SEQ + c * 128;
    bf16_t* vnT = (bf16_t*)smem;
    const bf16_t* Z = (const bf16_t*)(p.ws + OFF_Z);
    {
        const int q = tid >> 1, half = tid & 1, d0 = half * 32;
        const uint4* src = (const uint4*)(Z + (size_t)(tok0 + q) * NZ + 512 + h * 64 + d0);
        float f[32];
#pragma unroll
        for (int i = 0; i < 4; ++i) { const uint4 v = src[i]; const unsigned w[4] = {v.x, v.y, v.z, v.w};
#pragma unroll
            for (int j = 0; j < 4; ++j) { f[i * 8 + j * 2] = bf2f(w[j] & 0xffffu); f[i * 8 + j * 2 + 1] = bf2f(w[j] >> 16); } }
        float s = 0.f;
#pragma unroll
        for (int i = 0; i < 32; ++i) s += f[i];
        s += __shfl_xor(s, 1);
        const float mean = s * (1.0f / 64.0f);
        float qv = 0.f;
#pragma unroll
        for (int i = 0; i < 32; ++i) { f[i] -= mean; qv += f[i] * f[i]; }
        qv += __shfl_xor(qv, 1);
        const float rstd = rsqrtf(qv * (1.0f / 64.0f) + EPS);
#pragma unroll
        for (int i = 0; i < 32; ++i) vnT[(d0 + i) * TP + q] = f2bf(f[i] * rstd);
    }
    __syncthreads();
    const bf16_t* Wsb = (const bf16_t*)(p.ws + OFF_WSB) + ((size_t)l * 8 + h) * 128 * 128;
    f32x4 acc[2][4];
#pragma unroll
    for (int i = 0; i < 2; ++i)
#pragma unroll
        for (int j = 0; j < 4; ++j) acc[i][j] = (f32x4){0.f, 0.f, 0.f, 0.f};
    const int p0 = wid * 32;
#pragma unroll
    for (int ks = 0; ks < 4; ++ks) {
        bf16x8 af[2], bfr[4];
#pragma unroll
        for (int i = 0; i < 2; ++i) af[i] = *(const bf16x8*)(Wsb + (size_t)(p0 + i * 16 + fr) * 128 + ks * 32 + fq * 8);
#pragma unroll
        for (int j = 0; j < 4; ++j) bfr[j] = *(const bf16x8*)(vnT + (j * 16 + fr) * TP + ks * 32 + fq * 8);
#pragma unroll
        for (int i = 0; i < 2; ++i)
#pragma unroll
            for (int j = 0; j < 4; ++j) acc[i][j] = MFMA16(bfr[j], af[i], acc[i][j]);
    }
    bf16_t* Y = (bf16_t*)(p.ws + OFF_Y);
    float* ssa = (float*)(p.ws + OFF_SSQA);
#pragma unroll
    for (int i = 0; i < 2; ++i) {
        const int pp = p0 + i * 16 + fr, tok = tok0 + pp;
        const float bsv = p.gmlp_bs[((size_t)l * 8 + h) * 128 + pp];
        float ss = 0.f;
#pragma unroll
        for (int j = 0; j < 4; ++j) {
            const int d = j * 16 + fq * 4;
            const uint2 uu = *(const uint2*)(Z + (size_t)tok * NZ + h * 64 + d);
            const float y0 = bf2f(uu.x & 0xffffu) * (acc[i][j][0] + bsv), y1 = bf2f(uu.x >> 16) * (acc[i][j][1] + bsv);
            const float y2 = bf2f(uu.y & 0xffffu) * (acc[i][j][2] + bsv), y3 = bf2f(uu.y >> 16) * (acc[i][j][3] + bsv);
            ss += y0 * y0 + y1 * y1 + y2 * y2 + y3 * y3;
            *(uint2*)(Y + (size_t)tok * D + h * 64 + d) = make_uint2(pk_bf16(y0, y1), pk_bf16(y2, y3));
        }
        ss += __shfl_xor(ss, 16); ss += __shfl_xor(ss, 32);
        if (fq == 0) ssa[(size_t)tok * 8 + h] = ss;
    }
    __syncthreads();
}

__device__ void ffta_item(const Params& p, int item, char* smem) {
    const int tid = otid(), lane = tid & 63, wid = tid >> 6, fr = lane & 15, fq = lane >> 4;
    const int bp = item & 63, g = (item >> 6) & 7, b = item >> 9;
    bf16_t* dT = (bf16_t*)smem;
    const bf16_t* Z = (const bf16_t*)(p.ws + OFF_Z);
    stage_transposed(Z + (size_t)(b * SEQ + bp) * NZ + 1024 + g * 128, (size_t)64 * NZ, dT);
    __syncthreads();
    const bf16_t* DA = (const bf16_t*)(p.ws + OFF_DA);
    f32x4 acc[2][4];
#pragma unroll
    for (int i = 0; i < 2; ++i)
#pragma unroll
        for (int j = 0; j < 4; ++j) acc[i][j] = (f32x4){0.f, 0.f, 0.f, 0.f};
#pragma unroll
    for (int ks = 0; ks < 4; ++ks) {
        bf16x8 af[2], bfr[4];
#pragma unroll
        for (int i = 0; i < 2; ++i) af[i] = *(const bf16x8*)(DA + (size_t)(i * 64 + wid * 16 + fr) * 128 + ks * 32 + fq * 8);
#pragma unroll
        for (int j = 0; j < 4; ++j) bfr[j] = *(const bf16x8*)(dT + (j * 16 + fr) * TP + ks * 32 + fq * 8);
#pragma unroll
        for (int i = 0; i < 2; ++i)
#pragma unroll
            for (int j = 0; j < 4; ++j) acc[i][j] = MFMA16(bfr[j], af[i], acc[i][j]);
    }
    const int k1 = wid * 16 + fr;
    const float2 cs = ((const float2*)(p.ws + OFF_TW))[bp * 64 + k1];
    bf16_t* Yb = (bf16_t*)(p.ws + OFF_H) + ((((size_t)(b * 8 + g) * 64 + k1) * 64 + bp) * 128);
#pragma unroll
    for (int j = 0; j < 4; ++j) {
        const int ch = j * 16 + fq * 4;
        float yr[4], yi[4];
#pragma unroll
        for (int e = 0; e < 4; ++e) { const float r = acc[0][j][e], im = acc[1][j][e]; yr[e] = r * cs.x + im * cs.y; yi[e] = im * cs.x - r * cs.y; }
        *(uint2*)(Yb + ch) = make_uint2(pk_bf16(yr[0], yr[1]), pk_bf16(yr[2], yr[3]));
        *(uint2*)(Yb + 64 + ch) = make_uint2(pk_bf16(yi[0], yi[1]), pk_bf16(yi[2], yi[3]));
    }
    __syncthreads();
}

__device__ void phase_mix(const Params& p, int l, char* smem, int bid, int nb) {
    for (int item = bid; item < 2048 + 4096; item += nb) {
        if (item < 2048) gmlp_item(p, l, item, smem); else ffta_item(p, item - 2048, smem);
    }
}

__device__ void phase_fftb(const Params& p, int l, char* smem, int bid, int nb) {
    const int tid = otid(), lane = tid & 63, wid = tid >> 6, fr = lane & 15, fq = lane >> 4;
    bf16_t* dT = (bf16_t*)smem;
    const bf16_t* DB = (const bf16_t*)(p.ws + OFF_DB);
    bf16_t* Y = (bf16_t*)(p.ws + OFF_Y);
    float* ssb = (float*)(p.ws + OFF_SSQB);
    for (int item = bid; item < 4096; item += nb) {
        const int k1 = item & 63, g = (item >> 6) & 7, b = item >> 9;
        stage_transposed((const bf16_t*)(p.ws + OFF_H) + (((size_t)(b * 8 + g) * 64 + k1) * 64) * 128, 128, dT);
        __syncthreads();
        f32x4 acc[4];
#pragma unroll
        for (int j = 0; j < 4; ++j) acc[j] = (f32x4){0.f, 0.f, 0.f, 0.f};
#pragma unroll
        for (int ks = 0; ks < 4; ++ks) {
            const bf16x8 af = *(const bf16x8*)(DB + (size_t)(wid * 16 + fr) * 128 + ks * 32 + fq * 8);
#pragma unroll
            for (int j = 0; j < 4; ++j) { const bf16x8 bfr = *(const bf16x8*)(dT + (j * 16 + fr) * TP + ks * 32 + fq * 8); acc[j] = MFMA16(bfr, af, acc[j]); }
        }
        const int k2 = wid * 16 + fr, tok = b * SEQ + k1 + 64 * k2;
        float ss = 0.f;
#pragma unroll
        for (int j = 0; j < 4; ++j) {
            const int ch = j * 16 + fq * 4;
            const float4 fb = *(const float4*)(p.fnet_b + ((size_t)l * 8 + g) * 64 + ch);
            const float y0 = acc[j][0] * (1.0f / 512.0f) + fb.x, y1 = acc[j][1] * (1.0f / 512.0f) + fb.y, y2 = acc[j][2] * (1.0f / 512.0f) + fb.z, y3 = acc[j][3] * (1.0f / 512.0f) + fb.w;
            ss += y0 * y0 + y1 * y1 + y2 * y2 + y3 * y3;
            *(uint2*)(Y + (size_t)tok * D + 512 + g * 64 + ch) = make_uint2(pk_bf16(y0, y1), pk_bf16(y2, y3));
        }
        ss += __shfl_xor(ss, 16); ss += __shfl_xor(ss, 32);
        if (fq == 0) ssb[(size_t)tok * 8 + g] = ss;
        __syncthreads();
    }
}

#define INS16(a, v) do { a[15] = med3i(a[14], a[15], v); a[14] = med3i(a[13], a[14], v); a[13] = med3i(a[12], a[13], v); a[12] = med3i(a[11], a[12], v); \
    a[11] = med3i(a[10], a[11], v); a[10] = med3i(a[9], a[10], v); a[9] = med3i(a[8], a[9], v); a[8] = med3i(a[7], a[8], v); a[7] = med3i(a[6], a[7], v); \
    a[6] = med3i(a[5], a[6], v); a[5] = med3i(a[4], a[5], v); a[4] = med3i(a[3], a[4], v); a[3] = med3i(a[2], a[3], v); a[2] = med3i(a[1], a[2], v); \
    a[1] = med3i(a[0], a[1], v); a[0] = max(a[0], v); } while (0)

template <int I, int J> struct CandLoop {
    static __device__ __forceinline__ void run(int (&a)[16], const float (&f1)[16], const float (&f2)[16]) {
        if constexpr ((I + 1) * (J + 1) <= 16) { const int key = (f2key(f1[I] + f2[J]) & ~255) | (I * 16 + J); INS16(a, key); }
        if constexpr (J + 1 < 16) CandLoop<I, J + 1>::run(a, f1, f2);
        else if constexpr (I + 1 < 16) CandLoop<I + 1, 0>::run(a, f1, f2);
    }
};

__device__ void phase_topk(const Params& p, int l, char* smem, int bid, int nb) {
    const int tid = otid(), lane = tid & 63, wid = tid >> 6, fr = lane & 15, fq = lane >> 4;
    float* S = (float*)smem;
    int* TT = (int*)(smem + 64 * 257 * 4);
    const bf16_t* Q = (const bf16_t*)(p.ws + OFF_Z);
    int* eidx = (int*)(p.ws + OFF_Y); float* gw = (float*)(p.ws + OFF_Y + (size_t)T * 128 * 4);
    for (int item = bid; item < (T / 64) * 8; item += nb) {
        const int h = item & 7, tok0 = (item >> 3) * 64;
        const bf16_t* K12 = (const bf16_t*)(p.ws + OFF_K12) + ((size_t)l * 8 + h) * 256 * 128;
        {
            const int half = wid >> 1;
            f32x4 acc[4][4];
#pragma unroll
            for (int i = 0; i < 4; ++i)
#pragma unroll
                for (int j = 0; j < 4; ++j) acc[i][j] = (f32x4){0.f, 0.f, 0.f, 0.f};
#pragma unroll
            for (int ks = 0; ks < 4; ++ks) {
                bf16x8 af[4], bfr[4];
#pragma unroll
                for (int i = 0; i < 4; ++i) af[i] = *(const bf16x8*)(Q + (size_t)(tok0 + i * 16 + fr) * 2048 + h * 256 + half * 128 + ks * 32 + fq * 8);
#pragma unroll
                for (int j = 0; j < 4; ++j) bfr[j] = *(const bf16x8*)(K12 + (size_t)((wid * 4 + j) * 16 + fr) * 128 + ks * 32 + fq * 8);
#pragma unroll
                for (int i = 0; i < 4; ++i)
#pragma unroll
                    for (int j = 0; j < 4; ++j) acc[i][j] = MFMA16(bfr[j], af[i], acc[i][j]);
            }
#pragma unroll
            for (int i = 0; i < 4; ++i)
#pragma unroll
                for (int j = 0; j < 4; ++j)
#pragma unroll
                    for (int e = 0; e < 4; ++e) S[(i * 16 + fr) * 257 + (wid * 4 + j) * 16 + fq * 4 + e] = acc[i][j][e];
        }
        __syncthreads();
        if (tid < 128) {
            const int tk = tid & 63, half = tid >> 6;
            int a[16];
#pragma unroll
            for (int i = 0; i < 16; ++i) a[i] = (int)0x80000000;
            const float* sr = S + tk * 257 + half * 128;
#pragma unroll 4
            for (int i = 0; i < 128; ++i) { const int key = (f2key(sr[i]) & ~127) | i; INS16(a, key); }
#pragma unroll
            for (int i = 0; i < 16; ++i) TT[(tk * 2 + half) * 16 + i] = a[i];
        }
        __syncthreads();
        if (tid < 64) {
            const int tk = tid;
            float f1[16], f2[16];
#pragma unroll
            for (int i = 0; i < 16; ++i) { f1[i] = key2f(TT[(tk * 2) * 16 + i] & ~127); f2[i] = key2f(TT[(tk * 2 + 1) * 16 + i] & ~127); }
            int a[16];
#pragma unroll
            for (int i = 0; i < 16; ++i) a[i] = (int)0x80000000;
            CandLoop<0, 0>::run(a, f1, f2);
            float sc[16], e[16], sum = 0.f; int ex[16];
#pragma unroll
            for (int i = 0; i < 16; ++i) {
                sc[i] = key2f(a[i] & ~255);
                const int code = a[i] & 255;
                const int e1 = TT[(tk * 2) * 16 + (code >> 4)] & 127, e2 = TT[(tk * 2 + 1) * 16 + (code & 15)] & 127;
                ex[i] = e1 * 128 + e2;
            }
#pragma unroll
            for (int i = 0; i < 16; ++i) { e[i] = __expf(sc[i] - sc[0]); sum += e[i]; }
            const float inv = 1.0f / sum;
            int4* ep = (int4*)(eidx + (size_t)(tok0 + tk) * 128 + h * 16); float4* gp = (float4*)(gw + (size_t)(tok0 + tk) * 128 + h * 16);
#pragma unroll
            for (int i = 0; i < 4; ++i) { ep[i] = make_int4(ex[4 * i], ex[4 * i + 1], ex[4 * i + 2], ex[4 * i + 3]); gp[i] = make_float4(e[4 * i] * inv, e[4 * i + 1] * inv, e[4 * i + 2] * inv, e[4 * i + 3] * inv); }
        }
        __syncthreads();
    }
}

__device__ __forceinline__ float dot16_fp8(const float (&h)[16], const int4& u) {
    const int w[4] = {u.x, u.y, u.z, u.w};
    float a0 = 0.f, a1 = 0.f;
#pragma unroll
    for (int i = 0; i < 4; ++i) {
        const f32x2_t lo = __builtin_amdgcn_cvt_pk_f32_fp8(w[i], false), hi = __builtin_amdgcn_cvt_pk_f32_fp8(w[i], true);
        a0 += lo.x * h[4 * i] + lo.y * h[4 * i + 1]; a1 += hi.x * h[4 * i + 2] + hi.y * h[4 * i + 3];
    }
    return a0 + a1;
}
__device__ __forceinline__ void axpy16_fp8(float (&o)[16], float c, const int4& v) {
    const int w[4] = {v.x, v.y, v.z, v.w};
#pragma unroll
    for (int i = 0; i < 4; ++i) {
        const f32x2_t lo = __builtin_amdgcn_cvt_pk_f32_fp8(w[i], false), hi = __builtin_amdgcn_cvt_pk_f32_fp8(w[i], true);
        o[4 * i] += c * lo.x; o[4 * i + 1] += c * lo.y; o[4 * i + 2] += c * hi.x; o[4 * i + 3] += c * hi.y;
    }
}

__device__ void phase_peer(const Params& p, int l, int bid, int nb) {
    const int tid_ = otid(); const int lane = tid_ & 63, wid = tid_ >> 6;
    const bf16_t* H = (const bf16_t*)(p.ws + OFF_H);
    const char* U8 = p.ws + OFF_UB + (size_t)l * NE * 1024;
    const char* V8 = p.ws + OFF_VB + (size_t)l * NE * 1024;
    const float* usc = (const float*)(p.ws + OFF_USC) + (size_t)l * NE; const float* vsc = (const float*)(p.ws + OFF_VSC) + (size_t)l * NE;
    const int* eidx = (const int*)(p.ws + OFF_Y); const float* gw = (const float*)(p.ws + OFF_Y + (size_t)T * 128 * 4);
    const float* mod = (const float*)(p.ws + OFF_MOD) + (size_t)l * NB * 6144;
    const bool last = (l == NL - 1);
    const float* gnext = last ? p.final_g : (p.norm1_g + (l + 1) * D);
    const float* modn = (const float*)(p.ws + OFF_MOD) + (size_t)(last ? l : l + 1) * NB * 6144;
    for (int tok = bid * 4 + wid; tok < T; tok += nb * 4) {
        const int b = tok / SEQ;
        float hf[16], o[16];
        {
            const uint4 h0 = *(const uint4*)(H + (size_t)tok * D + lane * 16), h1 = *(const uint4*)(H + (size_t)tok * D + lane * 16 + 8);
            const unsigned w[8] = {h0.x, h0.y, h0.z, h0.w, h1.x, h1.y, h1.z, h1.w};
#pragma unroll
            for (int i = 0; i < 8; ++i) { hf[2 * i] = bf2f(w[i] & 0xffffu); hf[2 * i + 1] = bf2f(w[i] >> 16); }
        }
#pragma unroll
        for (int i = 0; i < 16; ++i) o[i] = 0.f;
        for (int h = 0; h < 8; ++h) {
            const int my_e = eidx[(size_t)tok * 128 + h * 16 + (lane & 15)];
            const int e2 = eidx[(size_t)tok * 128 + h * 16 + (lane >> 2)];
            const float my_g = gw[(size_t)tok * 128 + h * 16 + (lane >> 2)];
            const float us = usc[e2], vs = vsc[e2];
            float pp[16];
#pragma unroll
            for (int k = 0; k < 16; ++k) {
                const int e = __builtin_amdgcn_readlane(my_e, k);
                const int4 u = *(const int4*)(U8 + (size_t)e * 1024 + lane * 16);
                pp[k] = dot16_fp8(hf, u);
            }
            float r8[8], r4[4], r2[2], r1;
            { const bool hi = (lane & 32) != 0;
#pragma unroll
              for (int j = 0; j < 8; ++j) { const float send = hi ? pp[j] : pp[j + 8], keep = hi ? pp[j + 8] : pp[j]; r8[j] = keep + __shfl_xor(send, 32); } }
            { const bool hi = (lane & 16) != 0;
#pragma unroll
              for (int j = 0; j < 4; ++j) { const float send = hi ? r8[j] : r8[j + 4], keep = hi ? r8[j + 4] : r8[j]; r4[j] = keep + __shfl_xor(send, 16); } }
            { const bool hi = (lane & 8) != 0;
#pragma unroll
              for (int j = 0; j < 2; ++j) { const float send = hi ? r4[j] : r4[j + 2], keep = hi ? r4[j + 2] : r4[j]; r2[j] = keep + __shfl_xor(send, 8); } }
            { const bool hi = (lane & 4) != 0; const float send = hi ? r2[0] : r2[1], keep = hi ? r2[1] : r2[0]; r1 = keep + __shfl_xor(send, 4); }
            r1 += __shfl_xor(r1, 2); r1 += __shfl_xor(r1, 1);
            const float coef = my_g * gelu_f(r1 * us) * vs;
#pragma unroll
            for (int k = 0; k < 16; ++k) {
                const int e = __builtin_amdgcn_readlane(my_e, k);
                const float ck = __builtin_bit_cast(float, __builtin_amdgcn_readlane(__builtin_bit_cast(int, coef), 4 * k));
                const int4 v = *(const int4*)(V8 + (size_t)e * 1024 + lane * 16);
                axpy16_fp8(o, ck, v);
            }
        }
        float* xr = p.out + (size_t)tok * D + lane * 16;
        const float* g2 = mod + (size_t)b * 6144 + 5 * D + lane * 16;
        float xn[16]; float ss = 0.f;
#pragma unroll
        for (int q = 0; q < 4; ++q) {
            const float4 xa = *(const float4*)(xr + q * 4), ga = *(const float4*)(g2 + q * 4);
            xn[q * 4 + 0] = xa.x + ga.x * o[q * 4 + 0]; xn[q * 4 + 1] = xa.y + ga.y * o[q * 4 + 1]; xn[q * 4 + 2] = xa.z + ga.z * o[q * 4 + 2]; xn[q * 4 + 3] = xa.w + ga.w * o[q * 4 + 3];
        }
#pragma unroll
        for (int i = 0; i < 16; ++i) ss += xn[i] * xn[i];
        ss = wave_sum(ss);
        const float rstd = rsqrtf(ss * (1.0f / D) + EPS);
        const float* gn = gnext + lane * 16;
        if (last) {
#pragma unroll
            for (int q = 0; q < 4; ++q) {
                const float4 ga = *(const float4*)(gn + q * 4);
                *(float4*)(xr + q * 4) = make_float4(xn[q * 4] * rstd * ga.x, xn[q * 4 + 1] * rstd * ga.y, xn[q * 4 + 2] * rstd * ga.z, xn[q * 4 + 3] * rstd * ga.w);
            }
        } else {
            const float* shn = modn + (size_t)b * 6144 + lane * 16; const float* scn = shn + D;
            unsigned w[8];
#pragma unroll
            for (int q = 0; q < 4; ++q) {
                *(float4*)(xr + q * 4) = make_float4(xn[q * 4], xn[q * 4 + 1], xn[q * 4 + 2], xn[q * 4 + 3]);
                const float4 ga = *(const float4*)(gn + q * 4), sa = *(const float4*)(shn + q * 4), ca = *(const float4*)(scn + q * 4);
                w[q * 2]     = pk_bf16(xn[q * 4] * rstd * ga.x * (1.f + ca.x) + sa.x, xn[q * 4 + 1] * rstd * ga.y * (1.f + ca.y) + sa.y);
                w[q * 2 + 1] = pk_bf16(xn[q * 4 + 2] * rstd * ga.z * (1.f + ca.z) + sa.z, xn[q * 4 + 3] * rstd * ga.w * (1.f + ca.w) + sa.w);
            }
            bf16_t* hr = (bf16_t*)(p.ws + OFF_H) + (size_t)tok * D + lane * 16;
            *(uint4*)(hr) = make_uint4(w[0], w[1], w[2], w[3]);
            *(uint4*)(hr + 8) = make_uint4(w[4], w[5], w[6], w[7]);
        }
    }
}

#define XB_TMO      128
#define XB_XCNT(j)  (256  + 64 * (j))
#define XB_XSUB(j)  (1280 + 64 * (j))
#define XB_XGEN(j)  (2304 + 64 * (j))
#define XB_TOP      3328
#define XB_TOPGEN   3392
#define XCD_BAR_WORDS 3456
#define XB_SPIN_CAP (1u << 22)
#define LAS __attribute__((address_space(3)))
__device__ __forceinline__ unsigned xb_ld(unsigned* p)              { return __hip_atomic_load(p, __ATOMIC_RELAXED, __HIP_MEMORY_SCOPE_AGENT); }
__device__ __forceinline__ unsigned xb_add(unsigned* p, unsigned v) { return __hip_atomic_fetch_add(p, v, __ATOMIC_RELAXED, __HIP_MEMORY_SCOPE_AGENT); }
__device__ __forceinline__ unsigned xb_xcc_id() { return (unsigned)__builtin_amdgcn_s_getreg((3 << 11) | 20) & 0xFu; }
#define XB_SPIN(cond, bar) do { unsigned _sp = 0; while (cond) { __builtin_amdgcn_s_sleep(1); \
    if ((++_sp & 255u) == 0u) { if (xb_ld(&(bar)[XB_TMO])) break; if (_sp > XB_SPIN_CAP) { atomicAdd(&(bar)[XB_TMO], 1u); break; } } } } while (0)
struct XcdBarrier { unsigned* bar; unsigned x; volatile LAS unsigned* st; };
__device__ __forceinline__ XcdBarrier xcd_barrier_post(unsigned* bar, volatile LAS unsigned* st) {
    XcdBarrier b; b.bar = bar; b.x = xb_xcc_id(); b.st = st;
    if (threadIdx.x == 0) (void)xb_add(&bar[XB_XCNT(b.x)], 1u);
    return b;
}
__device__ __forceinline__ void xcd_barrier_complete(unsigned* bar, unsigned x, unsigned& nloc, unsigned& nx) {
    const unsigned G = gridDim.x * gridDim.y * gridDim.z;
    unsigned sum, cnt, mine, sp = 0u;
    for (;;) {
        sum = 0u; cnt = 0u; mine = 0u;
#pragma unroll
        for (unsigned j = 0; j < 16; ++j) { const unsigned c = xb_ld(&bar[XB_XCNT(j)]); sum += c; cnt += (c > 0u) ? 1u : 0u; mine = (j == x) ? c : mine; }
        if (sum == G) break;
        __builtin_amdgcn_s_sleep(1);
        if ((++sp & 255u) == 0u) { if (xb_ld(&bar[XB_TMO])) break; if (sp > XB_SPIN_CAP) { atomicAdd(&bar[XB_TMO], 1u); break; } }
    }
    nloc = mine > 0u ? mine : 1u; nx = cnt > 0u ? cnt : 1u;
}
__device__ __forceinline__ void xcd_barrier(const XcdBarrier& b) {
    asm volatile("s_waitcnt vmcnt(0)" ::: "memory");
    __syncthreads();
    if (threadIdx.x == 0) {
        unsigned* bar = b.bar;
        __builtin_amdgcn_s_waitcnt(0);
        unsigned nloc = b.st[0], nx = b.st[1];
        if (nloc == 0u) { xcd_barrier_complete(bar, b.x, nloc, nx); b.st[0] = nloc; b.st[1] = nx; }
        const unsigned old = xb_add(&bar[XB_XSUB(b.x)], 1u);
        const unsigned gen = old / nloc;
        if (old + 1u == (gen + 1u) * nloc) {
            __builtin_amdgcn_fence(__ATOMIC_RELEASE, "agent");
            asm volatile("s_waitcnt vmcnt(0)" ::: "memory");
            const unsigned og = xb_add(&bar[XB_TOP], 1u);
            const unsigned tg = og / nx;
            if (og + 1u == (tg + 1u) * nx) xb_add(&bar[XB_TOPGEN], 1u);
            else XB_SPIN(xb_ld(&bar[XB_TOPGEN]) == tg, bar);
            __builtin_amdgcn_fence(__ATOMIC_ACQUIRE, "agent");
            xb_add(&bar[XB_XGEN(b.x)], 1u);
            asm volatile("s_waitcnt vmcnt(0)" ::: "memory");
        } else {
            XB_SPIN(xb_ld(&bar[XB_XGEN(b.x)]) == gen, bar);
            __builtin_amdgcn_fence(__ATOMIC_ACQUIRE, "agent");
            asm volatile("s_waitcnt vmcnt(0)" ::: "memory");
        }
    }
    __syncthreads();
}

constexpr int NPHASE = 2 + 8 * NL;
__device__ __forceinline__ void run_phase(const Params& p, int ph, char* smem, int bid, int nb) {
    if (ph == 0) { phase_prep(p, smem, bid, nb); return; }
    if (ph == 1) { phase_norm(p.x, p.norm1_g, (const float*)(p.ws + OFF_MOD), 0, D, (bf16_t*)(p.ws + OFF_H), bid, nb); return; }
    const int l = (ph - 2) / 8, s = (ph - 2) % 8;
    switch (s) {
        case 0: phase_gemm1(p, l, smem, bid, nb); break;
        case 1: phase_mix(p, l, smem, bid, nb); break;
        case 2: phase_fftb(p, l, smem, bid, nb); break;
        case 3: phase_gemm2(p, l, smem, bid, nb); break;
        case 4: phase_norm(p.out, p.norm2_g + l * D, (const float*)(p.ws + OFF_MOD) + (size_t)l * NB * 6144, 3 * D, 4 * D, (bf16_t*)(p.ws + OFF_H), bid, nb); break;
        case 5: phase_gemm3(p, l, smem, bid, nb); break;
        case 6: phase_topk(p, l, smem, bid, nb); break;
        default: phase_peer(p, l, bid, nb); break;
    }
}

#if MEGA
#if PROBE_A >= 0
#define TSTAMP(i) do { if (blockIdx.x == 0 && threadIdx.x == 0) ts[i] = __builtin_amdgcn_s_memrealtime(); } while (0)
#else
#define TSTAMP(i) do { } while (0)
#endif
__global__ void __launch_bounds__(256, 2) mega_kernel(Params p) {
    __shared__ __attribute__((aligned(16))) char smem[SMEM_BYTES];
    __shared__ uint4 xb_words;
#if PROBE_A >= 0
    __shared__ unsigned long long ts[24];
#endif
    cg::grid_group grid = cg::this_grid();
    const int bid = blockIdx.x, nb = gridDim.x;
    unsigned* bar = (unsigned*)(p.ws + OFF_BAR);
    if (threadIdx.x == 0) xb_words = make_uint4(0u, 0u, 0u, 0u);
    if (bid == 0) for (int i = threadIdx.x; i < XCD_BAR_WORDS; i += 256) bar[i] = 0u;
    TSTAMP(0);
    phase_prep(p, smem, bid, nb);
    grid.sync();
    const XcdBarrier xb = xcd_barrier_post(bar, (volatile LAS unsigned*)&xb_words);
    TSTAMP(1);
    phase_norm(p.x, p.norm1_g, (const float*)(p.ws + OFF_MOD), 0, D, (bf16_t*)(p.ws + OFF_H), bid, nb); xcd_barrier(xb);
#pragma nounroll
    for (int l = 0; l < NL; ++l) {
        TSTAMP(2 + 8 * l); phase_gemm1(p, l, smem, bid, nb); xcd_barrier(xb);
        TSTAMP(3 + 8 * l); phase_mix(p, l, smem, bid, nb); xcd_barrier(xb);
        TSTAMP(4 + 8 * l); phase_fftb(p, l, smem, bid, nb); xcd_barrier(xb);
        TSTAMP(5 + 8 * l); phase_gemm2(p, l, smem, bid, nb); xcd_barrier(xb);
        TSTAMP(6 + 8 * l); phase_norm(p.out, p.norm2_g + l * D, (const float*)(p.ws + OFF_MOD) + (size_t)l * NB * 6144, 3 * D, 4 * D, (bf16_t*)(p.ws + OFF_H), bid, nb); xcd_barrier(xb);
        TSTAMP(7 + 8 * l); phase_gemm3(p, l, smem, bid, nb); xcd_barrier(xb);
        TSTAMP(8 + 8 * l); phase_topk(p, l, smem, bid, nb); xcd_barrier(xb);
        TSTAMP(9 + 8 * l); phase_peer(p, l, bid, nb);
        if (l + 1 < NL) xcd_barrier(xb);
    }
    TSTAMP(18);
#if PROBE_A >= 0
    if (bid == 0 && threadIdx.x == 0) p.out[0] += (float)(ts[PROBE_B] - ts[PROBE_A]) * 0.01f / PROBE_DIV;
#endif
}
#else
__global__ void __launch_bounds__(256, 2) phase_kernel(Params p, int ph) {
    __shared__ __attribute__((aligned(16))) char smem[SMEM_BYTES];
    run_phase(p, ph, smem, blockIdx.x, gridDim.x);
}
#endif

__global__ void digest_kernel(Params p) {
    const int* eidx = (const int*)(p.ws + OFF_Y); const float* gw = (const float*)(p.ws + OFF_Y + (size_t)T * 128 * 4);
    for (size_t i = (size_t)blockIdx.x * 256 + threadIdx.x; i < (size_t)T * D; i += (size_t)gridDim.x * 256) {
        const size_t j = i % ((size_t)T * 128);
        p.out[i] = (float)eidx[j] * 1e-3f + gw[j];
    }
}
extern "C" void kernel_launch(void* const* d_in, const int* in_sizes, int n_in, void* d_out, int out_size, void* d_ws, size_t ws_size, hipStream_t stream) {
    (void)in_sizes; (void)n_in; (void)out_size;
    if (ws_size < OFF_END) { fprintf(stderr, "workspace too small: %zu < %zu\n", ws_size, (size_t)OFF_END); return; }
    Params p{};
    p.x = (const float*)d_in[0]; p.c = (const float*)d_in[1]; p.mod_w = (const float*)d_in[2]; p.mod_b = (const float*)d_in[3]; p.norm1_g = (const float*)d_in[4];
    p.w_in = (const float*)d_in[5]; p.gmlp_ws = (const float*)d_in[6]; p.gmlp_bs = (const float*)d_in[7]; p.fnet_w = (const float*)d_in[8]; p.fnet_b = (const float*)d_in[9];
    p.gain_a = (const float*)d_in[10]; p.gain_b = (const float*)d_in[11]; p.w_out = (const float*)d_in[12]; p.norm2_g = (const float*)d_in[13]; p.wq = (const float*)d_in[14];
    p.k1 = (const float*)d_in[15]; p.k2 = (const float*)d_in[16]; p.pu = (const float*)d_in[17]; p.pv = (const float*)d_in[18]; p.final_g = (const float*)d_in[19];
    p.out = (float*)d_out; p.ws = (char*)d_ws;
#if MEGA
    static int grid_blocks = 0;
    if (!grid_blocks) {
        int dev = 0, cus = 0, per_cu = 0;
        hipGetDevice(&dev);
        hipDeviceGetAttribute(&cus, hipDeviceAttributeMultiprocessorCount, dev);
        hipOccupancyMaxActiveBlocksPerMultiprocessor(&per_cu, mega_kernel, 256, 0);
        if (per_cu > 2) per_cu = 2;
        grid_blocks = cus * per_cu;
    }
    void* args[] = {&p};
    hipError_t e = hipLaunchCooperativeKernel((void*)mega_kernel, dim3(grid_blocks), dim3(256), args, 0, stream);
    if (e != hipSuccess) fprintf(stderr, "cooperative launch failed: %s (grid %d)\n", hipGetErrorString(e), grid_blocks);
#else
    for (int ph = 0; ph < NPHASE && ph <= STOP_AFTER; ++ph) phase_kernel<<<512, 256, 0, stream>>>(p, ph);
    if (DIGEST) digest_kernel<<<1024, 256, 0, stream>>>(p);
#endif
}
```

```cpp
#include <hip/hip_runtime.h>
#include <hip/hip_cooperative_groups.h>
#include <cstdio>
#include <cstdint>
namespace cg = cooperative_groups;

#ifndef MEGA
#define MEGA 1
#endif
#ifndef PROBE_A
#define PROBE_A -1
#define PROBE_B 0
#define PROBE_DIV 10.0f
#endif
#ifndef STOP_AFTER
#define STOP_AFTER 99
#define DIGEST 0
#endif

typedef unsigned short bf16_t;
typedef short bf16x8 __attribute__((ext_vector_type(8)));
typedef float f32x4 __attribute__((ext_vector_type(4)));
typedef __bf16 bf16x2_t __attribute__((ext_vector_type(2)));

constexpr int D = 1024, NB = 8, SEQ = 4096, T = NB * SEQ, NL = 2;
constexpr int NZ = 2048;
constexpr int NE = 16384;
constexpr float EPS = 1e-6f;

constexpr size_t OFF_MOD  = 0;
constexpr size_t OFF_W1T  = OFF_MOD  + (size_t)NL * NB * 6144 * 4;
constexpr size_t OFF_W2T  = OFF_W1T  + (size_t)NL * 2048 * 1024 * 2;
constexpr size_t OFF_WQT  = OFF_W2T  + (size_t)NL * 1024 * 1024 * 2;
constexpr size_t OFF_K12  = OFF_WQT  + (size_t)NL * 2048 * 1024 * 2;
constexpr size_t OFF_WSB  = OFF_K12  + (size_t)NL * 8 * 256 * 128 * 2;
constexpr size_t OFF_DA   = OFF_WSB  + (size_t)NL * 8 * 128 * 128 * 2;
constexpr size_t OFF_DB   = OFF_DA   + 128 * 128 * 2;
constexpr size_t OFF_TW   = OFF_DB   + 64 * 128 * 2;
constexpr size_t OFF_SSQA = OFF_TW   + 64 * 64 * 8;
constexpr size_t OFF_SSQB = OFF_SSQA + (size_t)T * 8 * 4;
constexpr size_t OFF_UB   = OFF_SSQB + (size_t)T * 8 * 4;
constexpr size_t OFF_VB   = OFF_UB   + (size_t)NL * NE * 1024;
constexpr size_t OFF_USC  = OFF_VB   + (size_t)NL * NE * 1024;
constexpr size_t OFF_VSC  = OFF_USC  + (size_t)NL * NE * 4;
constexpr size_t OFF_H    = OFF_VSC  + (size_t)NL * NE * 4;
constexpr size_t OFF_Z    = OFF_H    + (size_t)T * 1024 * 2;
constexpr size_t OFF_Y    = OFF_Z    + (size_t)T * 2048 * 2;
constexpr size_t OFF_BAR  = OFF_Y    + (size_t)T * 1024 * 2;
constexpr size_t OFF_END  = OFF_BAR  + 16384;

struct Params {
    const float* x; const float* c; const float* mod_w; const float* mod_b; const float* norm1_g; const float* w_in;
    const float* gmlp_ws; const float* gmlp_bs; const float* fnet_w; const float* fnet_b; const float* gain_a; const float* gain_b;
    const float* w_out; const float* norm2_g; const float* wq; const float* k1; const float* k2; const float* pu; const float* pv; const float* final_g;
    float* out; char* ws;
};

constexpr int SMEM_BYTES = 73984;

__device__ __forceinline__ float bf2f(unsigned v) { return __uint_as_float(v << 16); }
typedef float f32x2_t __attribute__((ext_vector_type(2)));
__device__ __forceinline__ unsigned pk_bf16(float lo, float hi) { const f32x2_t v = {lo, hi}; return __builtin_bit_cast(unsigned, __builtin_convertvector(v, bf16x2_t)); }
__device__ __forceinline__ bf16_t f2bf(float f) { return (bf16_t)(pk_bf16(f, 0.f) & 0xffffu); }
__device__ __forceinline__ float gelu_f(float v) { return 0.5f * v * (1.0f + erff(v * 0.70710678118f)); }
__device__ __forceinline__ int med3i(int a, int b, int c) { return max(min(a, b), min(max(a, b), c)); }
__device__ __forceinline__ int f2key(float f) { int b = __float_as_int(f); return b ^ ((b >> 31) & 0x7fffffff); }
__device__ __forceinline__ float key2f(int k) { return __int_as_float(k ^ ((k >> 31) & 0x7fffffff)); }
__device__ __forceinline__ float wave_sum(float v) {
#pragma unroll
    for (int o = 32; o >= 1; o >>= 1) v += __shfl_xor(v, o);
    return v;
}
__device__ __forceinline__ int otid() { int t = threadIdx.x; asm volatile("" : "+v"(t)); return t; }
#define MFMA16(a, b, c) __builtin_amdgcn_mfma_f32_16x16x32_bf16((a), (b), (c), 0, 0, 0)

__device__ void transpose_tile(const float* __restrict__ src, int ld, int k0, int n0, bf16_t* __restrict__ dst  , int dn0,
                               const float* __restrict__ kscale, float* tile  ) {
    const int tid = otid();
#pragma unroll
    for (int i = 0; i < 4; ++i) {
        const int r = (tid >> 4) + 16 * i, c4 = (tid & 15) * 4;
        const float4 v = *(const float4*)(src + (size_t)(k0 + r) * ld + n0 + c4);
        const float s = kscale ? kscale[k0 + r] : 1.0f;
        tile[r * 65 + c4 + 0] = v.x * s; tile[r * 65 + c4 + 1] = v.y * s; tile[r * 65 + c4 + 2] = v.z * s; tile[r * 65 + c4 + 3] = v.w * s;
    }
    __syncthreads();
    {
        const int n = tid >> 2, ks = (tid & 3) * 16;
        unsigned w[8];
#pragma unroll
        for (int j = 0; j < 8; ++j) w[j] = pk_bf16(tile[(ks + 2 * j) * 65 + n], tile[(ks + 2 * j + 1) * 65 + n]);
        uint4* d = (uint4*)(dst + (size_t)(dn0 + n) * 1024 + k0 + ks);
        d[0] = make_uint4(w[0], w[1], w[2], w[3]); d[1] = make_uint4(w[4], w[5], w[6], w[7]);
    }
    __syncthreads();
}

__device__ void phase_prep(const Params& p, char* smem, int bid, int nb) {
    const int tid = otid();
    const int gtid = bid * 256 + tid, gsz = nb * 256;
    char* ws = p.ws;
    {
        float* sc = (float*)smem;
        float* red = (float*)(smem + 32768);
        for (int i = tid; i < 8192; i += 256) { const float v = p.c[i]; sc[i] = v / (1.0f + __expf(-v)); }
        __syncthreads();
        float* mod = (float*)(ws + OFF_MOD);
        for (int item = bid; item < NL * 192; item += nb) {
            const int l = item / 192, n0 = (item % 192) * 32, nn = tid & 31, kq = tid >> 5;
            float acc[8];
#pragma unroll
            for (int b = 0; b < 8; ++b) acc[b] = 0.f;
            const float* W = p.mod_w + (size_t)l * 1024 * 6144 + n0 + nn;
            for (int k = kq; k < 1024; k += 8) {
                const float w = W[(size_t)k * 6144];
#pragma unroll
                for (int b = 0; b < 8; ++b) acc[b] += sc[b * 1024 + k] * w;
            }
#pragma unroll
            for (int b = 0; b < 8; ++b) red[(kq * 8 + b) * 32 + nn] = acc[b];
            __syncthreads();
            {
                const int b = tid >> 5;
                float s = 0.f;
#pragma unroll
                for (int q = 0; q < 8; ++q) s += red[(q * 8 + b) * 32 + nn];
                mod[((size_t)l * NB + b) * 6144 + n0 + nn] = s + p.mod_b[l * 6144 + n0 + nn];
            }
            __syncthreads();
        }
    }
    {
        float* tile = (float*)smem;
        for (int item = bid; item < NL * 1024; item += nb) {
            const int l = item / 1024, r = item % 1024;
            if (r < 256) {
                const int kt = r / 16, nt = r % 16;
                transpose_tile(p.w_in + (size_t)l * 1024 * 1536, 1536, kt * 64, nt * 64, (bf16_t*)(ws + OFF_W1T) + (size_t)l * 2048 * 1024, nt * 64, nullptr, tile);
            } else if (r < 512) {
                const int rr = r - 256, kt = rr / 16, nt = rr % 16;
                const float* gk = (kt < 8) ? (p.gain_a + l * 512) : (p.gain_b + l * 512 - 512);
                transpose_tile(p.w_out + (size_t)l * 1024 * 1024, 1024, kt * 64, nt * 64, (bf16_t*)(ws + OFF_W2T) + (size_t)l * 1024 * 1024, nt * 64, gk, tile);
            } else {
                const int rr = r - 512, kt = rr / 32, nt = rr % 32;
                transpose_tile(p.wq + (size_t)l * 1024 * 2048, 2048, kt * 64, nt * 64, (bf16_t*)(ws + OFF_WQT) + (size_t)l * 2048 * 1024, nt * 64, nullptr, tile);
            }
        }
    }
    {
        float* fws = (float*)smem;
        float* Ms  = (float*)(smem + 16384);
        float* wt  = (float*)(smem + 49152);
        float* cs  = (float*)(smem + 49152 + 16640);
        for (int item = bid; item < NL * 8 * 16; item += nb) {
            const int l = item / 128, g = (item % 128) / 16, kt = item % 16;
            if (tid < 64) { float s, c; sincospif((float)tid / 32.0f, &s, &c); cs[tid] = c; cs[64 + tid] = s; }
            for (int i = tid; i < 4096; i += 256) fws[i] = p.fnet_w[((size_t)l * 8 + g) * 4096 + i];
#pragma unroll
            for (int i = 0; i < 4; ++i) {
                const int r = (tid >> 4) + 16 * i, c4 = (tid & 15) * 4;
                const float4 v = *(const float4*)(p.w_in + (size_t)l * 1024 * 1536 + (size_t)(kt * 64 + r) * 1536 + 1024 + g * 64 + c4);
                wt[r * 65 + c4] = v.x; wt[r * 65 + c4 + 1] = v.y; wt[r * 65 + c4 + 2] = v.z; wt[r * 65 + c4 + 3] = v.w;
            }
            __syncthreads();
            {
                const int d = tid >> 2, r0 = (tid & 3) * 32;
                const bool im = r0 >= 64; const int e0 = r0 & 63;
                float acc[32];
#pragma unroll
                for (int e = 0; e < 32; ++e) acc[e] = 0.f;
                for (int j = 0; j < 64; ++j) {
                    const int ph = (d * j) & 63;
                    const float t = im ? -cs[64 + ph] : cs[ph];
#pragma unroll
                    for (int e = 0; e < 32; ++e) acc[e] += t * fws[j * 64 + e0 + e];
                }
#pragma unroll
                for (int e = 0; e < 32; ++e) Ms[d * 128 + r0 + e] = acc[e];
            }
            __syncthreads();
            {
                const int r = tid >> 1, kk0 = (tid & 1) * 32;
                float acc[32];
#pragma unroll
                for (int k = 0; k < 32; ++k) acc[k] = 0.f;
                for (int d = 0; d < 64; ++d) {
                    const float m = Ms[d * 128 + r];
#pragma unroll
                    for (int k = 0; k < 32; ++k) acc[k] += wt[(kk0 + k) * 65 + d] * m;
                }
                bf16_t* dst = (bf16_t*)(ws + OFF_W1T) + (size_t)l * 2048 * 1024 + (size_t)(1024 + g * 128 + r) * 1024 + kt * 64 + kk0;
#pragma unroll
                for (int q = 0; q < 4; ++q)
                    ((uint4*)dst)[q] = make_uint4(pk_bf16(acc[q * 8], acc[q * 8 + 1]), pk_bf16(acc[q * 8 + 2], acc[q * 8 + 3]), pk_bf16(acc[q * 8 + 4], acc[q * 8 + 5]), pk_bf16(acc[q * 8 + 6], acc[q * 8 + 7]));
            }
            __syncthreads();
        }
    }
    {
        bf16_t* k12 = (bf16_t*)(ws + OFF_K12);
        for (int i = gtid; i < NL * 8 * 256 * 128; i += gsz) {
            const int d = i & 127, n = (i >> 7) & 255, h = (i >> 15) & 7, l = i >> 18;
            const float* src = (n < 128) ? p.k1 : p.k2;
            k12[i] = f2bf(src[(((size_t)l * 8 + h) * 128 + (n & 127)) * 128 + d]);
        }
        bf16_t* wsb = (bf16_t*)(ws + OFF_WSB);
        for (int i = gtid; i < NL * 8 * 128 * 128; i += gsz) wsb[i] = f2bf(p.gmlp_ws[i]);
        bf16_t* DA = (bf16_t*)(ws + OFF_DA);
        for (int i = gtid; i < 128 * 128; i += gsz) {
            const int m = i >> 7, kk = i & 127, ro = m >> 6, k1 = m & 63, ri = kk >> 6, a = kk & 63;
            float s, c; sincospif((float)((a * k1) & 63) / 32.0f, &s, &c);
            const float v = (ro == ri) ? c : (ro == 0 ? s : -s);
            DA[i] = f2bf(v);
        }
        bf16_t* DB = (bf16_t*)(ws + OFF_DB);
        for (int i = gtid; i < 64 * 128; i += gsz) {
            const int k2 = i >> 7, kk = i & 127, ri = kk >> 6, b = kk & 63;
            float s, c; sincospif((float)((b * k2) & 63) / 32.0f, &s, &c);
            DB[i] = f2bf(ri ? s : c);
        }
        float2* tw = (float2*)(ws + OFF_TW);
        for (int i = gtid; i < 64 * 64; i += gsz) {
            const int bp = i >> 6, k1 = i & 63;
            float s, c; sincospif((float)(bp * k1) / 2048.0f, &s, &c);
            tw[i] = make_float2(c, s);
        }
        {
            const int lane = tid & 63, wv = gtid >> 6, nwv = gsz >> 6;
            for (int r = wv; r < 2 * NL * NE; r += nwv) {
                const int tbl = r / (NL * NE), row = r % (NL * NE);
                const float* src = (tbl ? p.pv : p.pu) + (size_t)row * 1024 + lane * 16;
                float4 v[4]; float m = 0.f;
#pragma unroll
                for (int i = 0; i < 4; ++i) { v[i] = ((const float4*)src)[i]; m = fmaxf(m, fmaxf(fmaxf(fabsf(v[i].x), fabsf(v[i].y)), fmaxf(fabsf(v[i].z), fabsf(v[i].w)))); }
#pragma unroll
                for (int o = 32; o >= 1; o >>= 1) m = fmaxf(m, __shfl_xor(m, o));
                const float sc = (m > 0.f) ? 256.0f / m : 1.0f, inv = (m > 0.f) ? m * (1.0f / 256.0f) : 1.0f;
                int w[4];
#pragma unroll
                for (int i = 0; i < 4; ++i) { w[i] = __builtin_amdgcn_cvt_pk_fp8_f32(v[i].x * sc, v[i].y * sc, 0, false); w[i] = __builtin_amdgcn_cvt_pk_fp8_f32(v[i].z * sc, v[i].w * sc, w[i], true); }
                *(int4*)(ws + (tbl ? OFF_VB : OFF_UB) + (size_t)row * 1024 + lane * 16) = make_int4(w[0], w[1], w[2], w[3]);
                if (lane == 0) ((float*)(ws + (tbl ? OFF_VSC : OFF_USC)))[row] = inv;
            }
        }
    }
}

__device__ void phase_norm(const float* __restrict__ xsrc, const float* __restrict__ g, const float* __restrict__ modl  , int sh_off, int scl_off,
                           bf16_t* __restrict__ hout, int bid, int nb) {
    const int tid_ = otid(); const int lane = tid_ & 63, wid = tid_ >> 6;
    for (int tok = bid * 4 + wid; tok < T; tok += nb * 4) {
        const int b = tok / SEQ;
        const float* xr = xsrc + (size_t)tok * D;
        float4 v[4];
        float ss = 0.f;
#pragma unroll
        for (int i = 0; i < 4; ++i) { v[i] = *(const float4*)(xr + i * 256 + lane * 4); ss += v[i].x * v[i].x + v[i].y * v[i].y + v[i].z * v[i].z + v[i].w * v[i].w; }
        ss = wave_sum(ss);
        const float rstd = rsqrtf(ss * (1.0f / D) + EPS);
        const float* mb = modl + (size_t)b * 6144;
#pragma unroll
        for (int i = 0; i < 4; ++i) {
            const int cidx = i * 256 + lane * 4;
            const float4 gg = *(const float4*)(g + cidx), sh = *(const float4*)(mb + sh_off + cidx), sc = *(const float4*)(mb + scl_off + cidx);
            const float o0 = v[i].x * rstd * gg.x * (1.0f + sc.x) + sh.x, o1 = v[i].y * rstd * gg.y * (1.0f + sc.y) + sh.y;
            const float o2 = v[i].z * rstd * gg.z * (1.0f + sc.z) + sh.z, o3 = v[i].w * rstd * gg.w * (1.0f + sc.w) + sh.w;
            *(uint2*)(hout + (size_t)tok * D + cidx) = make_uint2(pk_bf16(o0, o1), pk_bf16(o2, o3));
        }
    }
}

#define LAS __attribute__((address_space(3)))
template <class Epi, class MidK>
__device__ __forceinline__ void gemm_tile(const bf16_t* __restrict__ A, int lda, const bf16_t* __restrict__ Bt, int ldb, int K, int m0, int n0,
                                          char* smem, const Epi& epi, const MidK& midk, int kmid) {
    const int tid = otid(), lane = tid & 63, wid = tid >> 6, wr = wid >> 1, wc = wid & 1, fr = lane & 15, fq = lane >> 4;
    LAS char* lds = (LAS char*)smem;
    f32x4 acc[4][4];
#pragma unroll
    for (int i = 0; i < 4; ++i)
#pragma unroll
        for (int j = 0; j < 4; ++j) acc[i][j] = (f32x4){0.f, 0.f, 0.f, 0.f};
    const int prow = lane >> 3, pch = (lane & 7) ^ prow;
    const bf16_t* ga = A + (size_t)(m0 + wid * 32 + prow) * lda + pch * 8;
    const bf16_t* gb = Bt + (size_t)(n0 + wid * 32 + prow) * ldb + pch * 8;
    const int nk = K / 64;
#define GEMM_STAGE(kt_, buf_) do { _Pragma("unroll") for (int i_ = 0; i_ < 4; ++i_) { \
        __builtin_amdgcn_global_load_lds((const unsigned*)(ga + (size_t)(i_ * 8) * lda + (kt_) * 64), (LAS unsigned*)(lds + (buf_) * 16384 + (wid * 32 + i_ * 8) * 128), 16, 0, 0); \
        __builtin_amdgcn_global_load_lds((const unsigned*)(gb + (size_t)(i_ * 8) * ldb + (kt_) * 64), (LAS unsigned*)(lds + 32768 + (buf_) * 16384 + (wid * 32 + i_ * 8) * 128), 16, 0, 0); } } while (0)
    GEMM_STAGE(0, 0);
    const int swz = fr & 7;
    for (int kt = 0; kt < nk; ++kt) {
        const int cur = kt & 1;
        asm volatile("s_waitcnt vmcnt(0)" ::: "memory");
        __syncthreads();
        if (kt + 1 < nk) GEMM_STAGE(kt + 1, cur ^ 1);
        if (kt == kmid) {
#pragma unroll
            for (int i = 0; i < 4; ++i) { const float sc = midk(m0 + wr * 64 + i * 16 + fr);
#pragma unroll
                for (int j = 0; j < 4; ++j) acc[i][j] *= sc; }
        }
        const LAS char* ca = lds + cur * 16384; const LAS char* cb = lds + 32768 + cur * 16384;
#pragma unroll
        for (int ks = 0; ks < 2; ++ks) {
            bf16x8 af[4], bfr[4];
            const int coff = ((ks * 4 + fq) ^ swz) * 16;
#pragma unroll
            for (int i = 0; i < 4; ++i) af[i] = *(const LAS bf16x8*)(ca + (wr * 64 + i * 16 + fr) * 128 + coff);
#pragma unroll
            for (int j = 0; j < 4; ++j) bfr[j] = *(const LAS bf16x8*)(cb + (wc * 64 + j * 16 + fr) * 128 + coff);
#pragma unroll
            for (int i = 0; i < 4; ++i)
#pragma unroll
                for (int j = 0; j < 4; ++j) acc[i][j] = MFMA16(bfr[j], af[i], acc[i][j]);
        }
    }
#undef GEMM_STAGE
#pragma unroll
    for (int i = 0; i < 4; ++i)
#pragma unroll
        for (int j = 0; j < 4; ++j) { epi(m0 + wr * 64 + i * 16 + fr, n0 + wc * 64 + j * 16 + fq * 4, acc[i][j]); __builtin_amdgcn_sched_barrier(0); }
    __syncthreads();
}
struct NoMid { __device__ __forceinline__ float operator()(int) const { return 1.0f; } };

__device__ void phase_gemm1(const Params& p, int l, char* smem, int bid, int nb) {
    const bf16_t* A = (const bf16_t*)(p.ws + OFF_H);
    const bf16_t* Bt = (const bf16_t*)(p.ws + OFF_W1T) + (size_t)l * 2048 * 1024;
    bf16_t* Z = (bf16_t*)(p.ws + OFF_Z);
    auto epi = [&](int row, int col, const f32x4& v) {
        float a = v[0], b = v[1], c = v[2], d = v[3];
        if (col < 1024) { a = gelu_f(a); b = gelu_f(b); c = gelu_f(c); d = gelu_f(d); }
        *(uint2*)(Z + (size_t)row * NZ + col) = make_uint2(pk_bf16(a, b), pk_bf16(c, d));
    };
    const int NT = NZ / 128, MT = T / 128;
    for (int item = bid; item < MT * NT; item += nb) gemm_tile(A, D, Bt, D, D, (item / NT) * 128, (item % NT) * 128, smem, epi, NoMid(), -1);
}
__device__ void phase_gemm2(const Params& p, int l, char* smem, int bid, int nb) {
    const bf16_t* A = (const bf16_t*)(p.ws + OFF_Y);
    const bf16_t* Bt = (const bf16_t*)(p.ws + OFF_W2T) + (size_t)l * 1024 * 1024;
    const float* ssa = (const float*)(p.ws + OFF_SSQA); const float* ssb = (const float*)(p.ws + OFF_SSQB);
    const float* mod = (const float*)(p.ws + OFF_MOD) + (size_t)l * NB * 6144;
    const float* xin = (l == 0) ? p.x : p.out;
    float* xout = p.out;
    auto rstd_of = [&](const float* s, int row) {
        const float4 a = *(const float4*)(s + (size_t)row * 8), b = *(const float4*)(s + (size_t)row * 8 + 4);
        return rsqrtf(((a.x + a.y) + (a.z + a.w) + (b.x + b.y) + (b.z + b.w)) * (1.0f / 512.0f) + EPS);
    };
    auto midk = [&](int row) { return rstd_of(ssa, row) / rstd_of(ssb, row); };
    auto epi = [&](int row, int col, const f32x4& v) {
        const float rb = rstd_of(ssb, row);
        const int b = row / SEQ;
        const float4 g = *(const float4*)(mod + (size_t)b * 6144 + 2 * D + col);
        const float4 xi = *(const float4*)(xin + (size_t)row * D + col);
        float4 o; o.x = xi.x + g.x * rb * v[0]; o.y = xi.y + g.y * rb * v[1]; o.z = xi.z + g.z * rb * v[2]; o.w = xi.w + g.w * rb * v[3];
        *(float4*)(xout + (size_t)row * D + col) = o;
    };
    const int NT = D / 128, MT = T / 128;
    for (int item = bid; item < MT * NT; item += nb) gemm_tile(A, D, Bt, D, D, (item / NT) * 128, (item % NT) * 128, smem, epi, midk, 8);
}
__device__ void phase_gemm3(const Params& p, int l, char* smem, int bid, int nb) {
    const bf16_t* A = (const bf16_t*)(p.ws + OFF_H);
    const bf16_t* Bt = (const bf16_t*)(p.ws + OFF_WQT) + (size_t)l * 2048 * 1024;
    bf16_t* Q = (bf16_t*)(p.ws + OFF_Z);
    auto epi = [&](int row, int col, const f32x4& v) { *(uint2*)(Q + (size_t)row * 2048 + col) = make_uint2(pk_bf16(v[0], v[1]), pk_bf16(v[2], v[3])); };
    const int NT = 2048 / 128, MT = T / 128;
    for (int item = bid; item < MT * NT; item += nb) gemm_tile(A, D, Bt, D, D, (item / NT) * 128, (item % NT) * 128, smem, epi, NoMid(), -1);
}

constexpr int TP = 136;
__device__ __forceinline__ void stage_transposed(const bf16_t* __restrict__ base, size_t row_stride, bf16_t* dT) {
    const int tid = otid(), r = tid >> 2, part = tid & 3, ri = part >> 1, c0 = (part & 1) * 32;
    const uint4* src = (const uint4*)(base + (size_t)r * row_stride + ri * 64 + c0);
    uint4 v[4];
#pragma unroll
    for (int i = 0; i < 4; ++i) v[i] = src[i];
#pragma unroll
    for (int i = 0; i < 4; ++i) {
        const unsigned w[4] = {v[i].x, v[i].y, v[i].z, v[i].w};
#pragma unroll
        for (int j = 0; j < 4; ++j) {
            dT[(c0 + i * 8 + j * 2) * TP + ri * 64 + r] = (bf16_t)(w[j] & 0xffffu);
            dT[(c0 + i * 8 + j * 2 + 1) * TP + ri * 64 + r] = (bf16_t)(w[j] >> 16);
        }
    }
}

__device__ void gmlp_item(const Params& p, int l, int item, char* smem) {
    const int tid = otid(), lane = tid & 63, wid = tid >> 6, fr = lane & 15, fq = lane >> 4;
    const int h = item & 7, c = (item >> 3) & 31, b = item >> 8;
    const int tok0 = b * SEQ + c * 128;
    bf16_t* vnT = (bf16_t*)smem;
    const bf16_t* Z = (const bf16_t*)(p.ws + OFF_Z);
    {
        const int q = tid >> 1, half = tid & 1, d0 = half * 32;
        const uint4* src = (const uint4*)(Z + (size_t)(tok0 + q) * NZ + 512 + h * 64 + d0);
        float f[32];
#pragma unroll
        for (int i = 0; i < 4; ++i) { const uint4 v = src[i]; const unsigned w[4] = {v.x, v.y, v.z, v.w};
#pragma unroll
            for (int j = 0; j < 4; ++j) { f[i * 8 + j * 2] = bf2f(w[j] & 0xffffu); f[i * 8 + j * 2 + 1] = bf2f(w[j] >> 16); } }
        float s = 0.f;
#pragma unroll
        for (int i = 0; i < 32; ++i) s += f[i];
        s += __shfl_xor(s, 1);
        const float mean = s * (1.0f / 64.0f);
        float qv = 0.f;
#pragma unroll
        for (int i = 0; i < 32; ++i) { f[i] -= mean; qv += f[i] * f[i]; }
        qv += __shfl_xor(qv, 1);
        const float rstd = rsqrtf(qv * (1.0f / 64.0f) + EPS);
#pragma unroll
        for (int i = 0; i < 32; ++i) vnT[(d0 + i) * TP + q] = f2bf(f[i] * rstd);
    }
    __syncthreads();
    const bf16_t* Wsb = (const bf16_t*)(p.ws + OFF_WSB) + ((size_t)l * 8 + h) * 128 * 128;
    f32x4 acc[2][4];
#pragma unroll
    for (int i = 0; i < 2; ++i)
#pragma unroll
        for (int j = 0; j < 4; ++j) acc[i][j] = (f32x4){0.f, 0.f, 0.f, 0.f};
    const int p0 = wid * 32;
#pragma unroll
    for (int ks = 0; ks < 4; ++ks) {
        bf16x8 af[2], bfr[4];
#pragma unroll
        for (int i = 0; i < 2; ++i) af[i] = *(const bf16x8*)(Wsb + (size_t)(p0 + i * 16 + fr) * 128 + ks * 32 + fq * 8);
#pragma unroll
        for (int j = 0; j < 4; ++j) bfr[j] = *(const bf16x8*)(vnT + (j * 16 + fr) * TP + ks * 32 + fq * 8);
#pragma unroll
        for (int i = 0; i < 2; ++i)
#pragma unroll
            for (int j = 0; j < 4; ++j) acc[i][j] = MFMA16(bfr[j], af[i], acc[i][j]);
    }
    bf16_t* Y = (bf16_t*)(p.ws + OFF_Y);
    float* ssa = (float*)(p.ws + OFF_SSQA);
#pragma unroll
    for (int i = 0; i < 2; ++i) {
        const int pp = p0 + i * 16 + fr, tok = tok0 + pp;
        const float bsv = p.gmlp_bs[((size_t)l * 8 + h) * 128 + pp];
        float ss = 0.f;
#pragma unroll
        for (int j = 0; j < 4; ++j) {
            const int d = j * 16 + fq * 4;
            const uint2 uu = *(const uint2*)(Z + (size_t)tok * NZ + h * 64 + d);
            const float y0 = bf2f(uu.x & 0xffffu) * (acc[i][j][0] + bsv), y1 = bf2f(uu.x >> 16) * (acc[i][j][1] + bsv);
            const float y2 = bf2f(uu.y & 0xffffu) * (acc[i][j][2] + bsv), y3 = bf2f(uu.y >> 16) * (acc[i][j][3] + bsv);
            ss += y0 * y0 + y1 * y1 + y2 * y2 + y3 * y3;
            *(uint2*)(Y + (size_t)tok * D + h * 64 + d) = make_uint2(pk_bf16(y0, y1), pk_bf16(y2, y3));
        }
        ss += __shfl_xor(ss, 16); ss += __shfl_xor(ss, 32);
        if (fq == 0) ssa[(size_t)tok * 8 + h] = ss;
    }
    __syncthreads();
}

__device__ void ffta_item(const Params& p, int item, char* smem) {
    const int tid = otid(), lane = tid & 63, wid = tid >> 6, fr = lane & 15, fq = lane >> 4;
    const int bp = item & 63, g = (item >> 6) & 7, b = item >> 9;
    bf16_t* dT = (bf16_t*)smem;
    const bf16_t* Z = (const bf16_t*)(p.ws + OFF_Z);
    stage_transposed(Z + (size_t)(b * SEQ + bp) * NZ + 1024 + g * 128, (size_t)64 * NZ, dT);
    __syncthreads();
    const bf16_t* DA = (const bf16_t*)(p.ws + OFF_DA);
    f32x4 acc[2][4];
#pragma unroll
    for (int i = 0; i < 2; ++i)
#pragma unroll
        for (int j = 0; j < 4; ++j) acc[i][j] = (f32x4){0.f, 0.f, 0.f, 0.f};
#pragma unroll
    for (int ks = 0; ks < 4; ++ks) {
        bf16x8 af[2], bfr[4];
#pragma unroll
        for (int i = 0; i < 2; ++i) af[i] = *(const bf16x8*)(DA + (size_t)(i * 64 + wid * 16 + fr) * 128 + ks * 32 + fq * 8);
#pragma unroll
        for (int j = 0; j < 4; ++j) bfr[j] = *(const bf16x8*)(dT + (j * 16 + fr) * TP + ks * 32 + fq * 8);
#pragma unroll
        for (int i = 0; i < 2; ++i)
#pragma unroll
            for (int j = 0; j < 4; ++j) acc[i][j] = MFMA16(bfr[j], af[i], acc[i][j]);
    }
    const int k1 = wid * 16 + fr;
    const float2 cs = ((const float2*)(p.ws + OFF_TW))[bp * 64 + k1];
    bf16_t* Yb = (bf16_t*)(p.ws + OFF_H) + ((((size_t)(b * 8 + g) * 64 + k1) * 64 + bp) * 128);
#pragma unroll
    for (int j = 0; j < 4; ++j) {
        const int ch = j * 16 + fq * 4;
        float yr[4], yi[4];
#pragma unroll
        for (int e = 0; e < 4; ++e) { const float r = acc[0][j][e], im = acc[1][j][e]; yr[e] = r * cs.x + im * cs.y; yi[e] = im * cs.x - r * cs.y; }
        *(uint2*)(Yb + ch) = make_uint2(pk_bf16(yr[0], yr[1]), pk_bf16(yr[2], yr[3]));
        *(uint2*)(Yb + 64 + ch) = make_uint2(pk_bf16(yi[0], yi[1]), pk_bf16(yi[2], yi[3]));
    }
    __syncthreads();
}

__device__ void phase_mix(const Params& p, int l, char* smem, int bid, int nb) {
    for (int item = bid; item < 2048 + 4096; item += nb) {
        if (item < 2048) gmlp_item(p, l, item, smem); else ffta_item(p, item - 2048, smem);
    }
}

__device__ void phase_fftb(const Params& p, int l, char* smem, int bid, int nb) {
    const int tid = otid(), lane = tid & 63, wid = tid >> 6, fr = lane & 15, fq = lane >> 4;
    bf16_t* dT = (bf16_t*)smem;
    const bf16_t* DB = (const bf16_t*)(p.ws + OFF_DB);
    bf16_t* Y = (bf16_t*)(p.ws + OFF_Y);
    float* ssb = (float*)(p.ws + OFF_SSQB);
    for (int item = bid; item < 4096; item += nb) {
        const int k1 = item & 63, g = (item >> 6) & 7, b = item >> 9;
        stage_transposed((const bf16_t*)(p.ws + OFF_H) + (((size_t)(b * 8 + g) * 64 + k1) * 64) * 128, 128, dT);
        __syncthreads();
        f32x4 acc[4];
#pragma unroll
        for (int j = 0; j < 4; ++j) acc[j] = (f32x4){0.f, 0.f, 0.f, 0.f};
#pragma unroll
        for (int ks = 0; ks < 4; ++ks) {
            const bf16x8 af = *(const bf16x8*)(DB + (size_t)(wid * 16 + fr) * 128 + ks * 32 + fq * 8);
#pragma unroll
            for (int j = 0; j < 4; ++j) { const bf16x8 bfr = *(const bf16x8*)(dT + (j * 16 + fr) * TP + ks * 32 + fq * 8); acc[j] = MFMA16(bfr, af, acc[j]); }
        }
        const int k2 = wid * 16 + fr, tok = b * SEQ + k1 + 64 * k2;
        float ss = 0.f;
#pragma unroll
        for (int j = 0; j < 4; ++j) {
            const int ch = j * 16 + fq * 4;
            const float4 fb = *(const float4*)(p.fnet_b + ((size_t)l * 8 + g) * 64 + ch);
            const float y0 = acc[j][0] * (1.0f / 512.0f) + fb.x, y1 = acc[j][1] * (1.0f / 512.0f) + fb.y, y2 = acc[j][2] * (1.0f / 512.0f) + fb.z, y3 = acc[j][3] * (1.0f / 512.0f) + fb.w;
            ss += y0 * y0 + y1 * y1 + y2 * y2 + y3 * y3;
            *(uint2*)(Y + (size_t)tok * D + 512 + g * 64 + ch) = make_uint2(pk_bf16(y0, y1), pk_bf16(y2, y3));
        }
        ss += __shfl_xor(ss, 16); ss += __shfl_xor(ss, 32);
        if (fq == 0) ssb[(size_t)tok * 8 + g] = ss;
        __syncthreads();
    }
}

#define INS16(a, v) do { a[15] = med3i(a[14], a[15], v); a[14] = med3i(a[13], a[14], v); a[13] = med3i(a[12], a[13], v); a[12] = med3i(a[11], a[12], v); \
    a[11] = med3i(a[10], a[11], v); a[10] = med3i(a[9], a[10], v); a[9] = med3i(a[8], a[9], v); a[8] = med3i(a[7], a[8], v); a[7] = med3i(a[6], a[7], v); \
    a[6] = med3i(a[5], a[6], v); a[5] = med3i(a[4], a[5], v); a[4] = med3i(a[3], a[4], v); a[3] = med3i(a[2], a[3], v); a[2] = med3i(a[1], a[2], v); \
    a[1] = med3i(a[0], a[1], v); a[0] = max(a[0], v); } while (0)

template <int I, int J> struct CandLoop {
    static __device__ __forceinline__ void run(int (&a)[16], const float (&f1)[16], const float (&f2)[16]) {
        if constexpr ((I + 1) * (J + 1) <= 16) { const int key = (f2key(f1[I] + f2[J]) & ~255) | (I * 16 + J); INS16(a, key); }
        if constexpr (J + 1 < 16) CandLoop<I, J + 1>::run(a, f1, f2);
        else if constexpr (I + 1 < 16) CandLoop<I + 1, 0>::run(a, f1, f2);
    }
};

__device__ void phase_topk(const Params& p, int l, char* smem, int bid, int nb) {
    const int tid = otid(), lane = tid & 63, wid = tid >> 6, fr = lane & 15, fq = lane >> 4;
    float* S = (float*)smem;
    int* TT = (int*)(smem + 64 * 257 * 4);
    const bf16_t* Q = (const bf16_t*)(p.ws + OFF_Z);
    int* eidx = (int*)(p.ws + OFF_Y); float* gw = (float*)(p.ws + OFF_Y + (size_t)T * 128 * 4);
    for (int item = bid; item < (T / 64) * 8; item += nb) {
        const int h = item & 7, tok0 = (item >> 3) * 64;
        const bf16_t* K12 = (const bf16_t*)(p.ws + OFF_K12) + ((size_t)l * 8 + h) * 256 * 128;
        {
            const int half = wid >> 1;
            f32x4 acc[4][4];
#pragma unroll
            for (int i = 0; i < 4; ++i)
#pragma unroll
                for (int j = 0; j < 4; ++j) acc[i][j] = (f32x4){0.f, 0.f, 0.f, 0.f};
#pragma unroll
            for (int ks = 0; ks < 4; ++ks) {
                bf16x8 af[4], bfr[4];
#pragma unroll
                for (int i = 0; i < 4; ++i) af[i] = *(const bf16x8*)(Q + (size_t)(tok0 + i * 16 + fr) * 2048 + h * 256 + half * 128 + ks * 32 + fq * 8);
#pragma unroll
                for (int j = 0; j < 4; ++j) bfr[j] = *(const bf16x8*)(K12 + (size_t)((wid * 4 + j) * 16 + fr) * 128 + ks * 32 + fq * 8);
#pragma unroll
                for (int i = 0; i < 4; ++i)
#pragma unroll
                    for (int j = 0; j < 4; ++j) acc[i][j] = MFMA16(bfr[j], af[i], acc[i][j]);
            }
#pragma unroll
            for (int i = 0; i < 4; ++i)
#pragma unroll
                for (int j = 0; j < 4; ++j)
#pragma unroll
                    for (int e = 0; e < 4; ++e) S[(i * 16 + fr) * 257 + (wid * 4 + j) * 16 + fq * 4 + e] = acc[i][j][e];
        }
        __syncthreads();
        if (tid < 128) {
            const int tk = tid & 63, half = tid >> 6;
            int a[16];
#pragma unroll
            for (int i = 0; i < 16; ++i) a[i] = (int)0x80000000;
            const float* sr = S + tk * 257 + half * 128;
#pragma unroll 4
            for (int i = 0; i < 128; ++i) { const int key = (f2key(sr[i]) & ~127) | i; INS16(a, key); }
#pragma unroll
            for (int i = 0; i < 16; ++i) TT[(tk * 2 + half) * 16 + i] = a[i];
        }
        __syncthreads();
        if (tid < 64) {
            const int tk = tid;
            float f1[16], f2[16];
#pragma unroll
            for (int i = 0; i < 16; ++i) { f1[i] = key2f(TT[(tk * 2) * 16 + i] & ~127); f2[i] = key2f(TT[(tk * 2 + 1) * 16 + i] & ~127); }
            int a[16];
#pragma unroll
            for (int i = 0; i < 16; ++i) a[i] = (int)0x80000000;
            CandLoop<0, 0>::run(a, f1, f2);
            float sc[16], e[16], sum = 0.f; int ex[16];
#pragma unroll
            for (int i = 0; i < 16; ++i) {
                sc[i] = key2f(a[i] & ~255);
                const int code = a[i] & 255;
                const int e1 = TT[(tk * 2) * 16 + (code >> 4)] & 127, e2 = TT[(tk * 2 + 1) * 16 + (code & 15)] & 127;
                ex[i] = e1 * 128 + e2;
            }
#pragma unroll
            for (int i = 0; i < 16; ++i) { e[i] = __expf(sc[i] - sc[0]); sum += e[i]; }
            const float inv = 1.0f / sum;
            int4* ep = (int4*)(eidx + (size_t)(tok0 + tk) * 128 + h * 16); float4* gp = (float4*)(gw + (size_t)(tok0 + tk) * 128 + h * 16);
#pragma unroll
            for (int i = 0; i < 4; ++i) { ep[i] = make_int4(ex[4 * i], ex[4 * i + 1], ex[4 * i + 2], ex[4 * i + 3]); gp[i] = make_float4(e[4 * i] * inv, e[4 * i + 1] * inv, e[4 * i + 2] * inv, e[4 * i + 3] * inv); }
        }
        __syncthreads();
    }
}

__device__ __forceinline__ float dot16_fp8(const float (&h)[16], const int4& u) {
    const int w[4] = {u.x, u.y, u.z, u.w};
    float a0 = 0.f, a1 = 0.f;
#pragma unroll
    for (int i = 0; i < 4; ++i) {
        const f32x2_t lo = __builtin_amdgcn_cvt_pk_f32_fp8(w[i], false), hi = __builtin_amdgcn_cvt_pk_f32_fp8(w[i], true);
        a0 += lo.x * h[4 * i] + lo.y * h[4 * i + 1]; a1 += hi.x * h[4 * i + 2] + hi.y * h[4 * i + 3];
    }
    return a0 + a1;
}
__device__ __forceinline__ void axpy16_fp8(float (&o)[16], float c, const int4& v) {
    const int w[4] = {v.x, v.y, v.z, v.w};
#pragma unroll
    for (int i = 0; i < 4; ++i) {
        const f32x2_t lo = __builtin_amdgcn_cvt_pk_f32_fp8(w[i], false), hi = __builtin_amdgcn_cvt_pk_f32_fp8(w[i], true);
        o[4 * i] += c * lo.x; o[4 * i + 1] += c * lo.y; o[4 * i + 2] += c * hi.x; o[4 * i + 3] += c * hi.y;
    }
}

__device__ void phase_peer(const Params& p, int l, int bid, int nb) {
    const int tid_ = otid(); const int lane = tid_ & 63, wid = tid_ >> 6;
    const bf16_t* H = (const bf16_t*)(p.ws + OFF_H);
    const char* U8 = p.ws + OFF_UB + (size_t)l * NE * 1024;
    const char* V8 = p.ws + OFF_VB + (size_t)l * NE * 1024;
    const float* usc = (const float*)(p.ws + OFF_USC) + (size_t)l * NE; const float* vsc = (const float*)(p.ws + OFF_VSC) + (size_t)l * NE;
    const int* eidx = (const int*)(p.ws + OFF_Y); const float* gw = (const float*)(p.ws + OFF_Y + (size_t)T * 128 * 4);
    const float* mod = (const float*)(p.ws + OFF_MOD) + (size_t)l * NB * 6144;
    const bool last = (l == NL - 1);
    const float* gnext = last ? p.final_g : (p.norm1_g + (l + 1) * D);
    const float* modn = (const float*)(p.ws + OFF_MOD) + (size_t)(last ? l : l + 1) * NB * 6144;
    for (int tok = bid * 4 + wid; tok < T; tok += nb * 4) {
        const int b = tok / SEQ;
        float hf[16], o[16];
        {
            const uint4 h0 = *(const uint4*)(H + (size_t)tok * D + lane * 16), h1 = *(const uint4*)(H + (size_t)tok * D + lane * 16 + 8);
            const unsigned w[8] = {h0.x, h0.y, h0.z, h0.w, h1.x, h1.y, h1.z, h1.w};
#pragma unroll
            for (int i = 0; i < 8; ++i) { hf[2 * i] = bf2f(w[i] & 0xffffu); hf[2 * i + 1] = bf2f(w[i] >> 16); }
        }
#pragma unroll
        for (int i = 0; i < 16; ++i) o[i] = 0.f;
        for (int h = 0; h < 8; ++h) {
            const int my_e = eidx[(size_t)tok * 128 + h * 16 + (lane & 15)];
            const int e2 = eidx[(size_t)tok * 128 + h * 16 + (lane >> 2)];
            const float my_g = gw[(size_t)tok * 128 + h * 16 + (lane >> 2)];
            const float us = usc[e2], vs = vsc[e2];
            float pp[16];
#pragma unroll
            for (int k = 0; k < 16; ++k) {
                const int e = __builtin_amdgcn_readlane(my_e, k);
                const int4 u = *(const int4*)(U8 + (size_t)e * 1024 + lane * 16);
                pp[k] = dot16_fp8(hf, u);
            }
            float r8[8], r4[4], r2[2], r1;
            { const bool hi = (lane & 32) != 0;
#pragma unroll
              for (int j = 0; j < 8; ++j) { const float send = hi ? pp[j] : pp[j + 8], keep = hi ? pp[j + 8] : pp[j]; r8[j] = keep + __shfl_xor(send, 32); } }
            { const bool hi = (lane & 16) != 0;
#pragma unroll
              for (int j = 0; j < 4; ++j) { const float send = hi ? r8[j] : r8[j + 4], keep = hi ? r8[j + 4] : r8[j]; r4[j] = keep + __shfl_xor(send, 16); } }
            { const bool hi = (lane & 8) != 0;
#pragma unroll
              for (int j = 0; j < 2; ++j) { const float send = hi ? r4[j] : r4[j + 2], keep = hi ? r4[j + 2] : r4[j]; r2[j] = keep + __shfl_xor(send, 8); } }
            { const bool hi = (lane & 4) != 0; const float send = hi ? r2[0] : r2[1], keep = hi ? r2[1] : r2[0]; r1 = keep + __shfl_xor(send, 4); }
            r1 += __shfl_xor(r1, 2); r1 += __shfl_xor(r1, 1);
            const float coef = my_g * gelu_f(r1 * us) * vs;
#pragma unroll
            for (int k = 0; k < 16; ++k) {
                const int e = __builtin_amdgcn_readlane(my_e, k);
                const float ck = __builtin_bit_cast(float, __builtin_amdgcn_readlane(__builtin_bit_cast(int, coef), 4 * k));
                const int4 v = *(const int4*)(V8 + (size_t)e * 1024 + lane * 16);
                axpy16_fp8(o, ck, v);
            }
        }
        float* xr = p.out + (size_t)tok * D + lane * 16;
        const float* g2 = mod + (size_t)b * 6144 + 5 * D + lane * 16;
        float xn[16]; float ss = 0.f;
#pragma unroll
        for (int q = 0; q < 4; ++q) {
            const float4 xa = *(const float4*)(xr + q * 4), ga = *(const float4*)(g2 + q * 4);
            xn[q * 4 + 0] = xa.x + ga.x * o[q * 4 + 0]; xn[q * 4 + 1] = xa.y + ga.y * o[q * 4 + 1]; xn[q * 4 + 2] = xa.z + ga.z * o[q * 4 + 2]; xn[q * 4 + 3] = xa.w + ga.w * o[q * 4 + 3];
        }
#pragma unroll
        for (int i = 0; i < 16; ++i) ss += xn[i] * xn[i];
        ss = wave_sum(ss);
        const float rstd = rsqrtf(ss * (1.0f / D) + EPS);
        const float* gn = gnext + lane * 16;
        if (last) {
#pragma unroll
            for (int q = 0; q < 4; ++q) {
                const float4 ga = *(const float4*)(gn + q * 4);
                *(float4*)(xr + q * 4) = make_float4(xn[q * 4] * rstd * ga.x, xn[q * 4 + 1] * rstd * ga.y, xn[q * 4 + 2] * rstd * ga.z, xn[q * 4 + 3] * rstd * ga.w);
            }
        } else {
            const float* shn = modn + (size_t)b * 6144 + lane * 16; const float* scn = shn + D;
            unsigned w[8];
#pragma unroll
            for (int q = 0; q < 4; ++q) {
                *(float4*)(xr + q * 4) = make_float4(xn[q * 4], xn[q * 4 + 1], xn[q * 4 + 2], xn[q * 4 + 3]);
                const float4 ga = *(const float4*)(gn + q * 4), sa = *(const float4*)(shn + q * 4), ca = *(const float4*)(scn + q * 4);
                w[q * 2]     = pk_bf16(xn[q * 4] * rstd * ga.x * (1.f + ca.x) + sa.x, xn[q * 4 + 1] * rstd * ga.y * (1.f + ca.y) + sa.y);
                w[q * 2 + 1] = pk_bf16(xn[q * 4 + 2] * rstd * ga.z * (1.f + ca.z) + sa.z, xn[q * 4 + 3] * rstd * ga.w * (1.f + ca.w) + sa.w);
            }
            bf16_t* hr = (bf16_t*)(p.ws + OFF_H) + (size_t)tok * D + lane * 16;
            *(uint4*)(hr) = make_uint4(w[0], w[1], w[2], w[3]);
            *(uint4*)(hr + 8) = make_uint4(w[4], w[5], w[6], w[7]);
        }
    }
}

#define XB_TMO      128
#define XB_XCNT(j)  (256  + 64 * (j))
#define XB_XSUB(j)  (1280 + 64 * (j))
#define XB_XGEN(j)  (2304 + 64 * (j))
#define XB_TOP      3328
#define XB_TOPGEN   3392
#define XCD_BAR_WORDS 3456
#define XB_SPIN_CAP (1u << 22)
__device__ __forceinline__ unsigned xb_ld(unsigned* p)              { return __hip_atomic_load(p, __ATOMIC_RELAXED, __HIP_MEMORY_SCOPE_AGENT); }
__device__ __forceinline__ unsigned xb_add(unsigned* p, unsigned v) { return __hip_atomic_fetch_add(p, v, __ATOMIC_RELAXED, __HIP_MEMORY_SCOPE_AGENT); }
__device__ __forceinline__ unsigned xb_xcc_id() { return (unsigned)__builtin_amdgcn_s_getreg((3 << 11) | 20) & 0xFu; }
#define XB_SPIN(cond, bar) do { unsigned _sp = 0; while (cond) { __builtin_amdgcn_s_sleep(1); \
    if ((++_sp & 255u) == 0u) { if (xb_ld(&(bar)[XB_TMO])) break; if (_sp > XB_SPIN_CAP) { atomicAdd(&(bar)[XB_TMO], 1u); break; } } } } while (0)
struct XcdBarrier { unsigned* bar; unsigned x; volatile LAS unsigned* st; };
__device__ __forceinline__ XcdBarrier xcd_barrier_post(unsigned* bar, volatile LAS unsigned* st) {
    XcdBarrier b; b.bar = bar; b.x = xb_xcc_id(); b.st = st;
    if (threadIdx.x == 0) (void)xb_add(&bar[XB_XCNT(b.x)], 1u);
    return b;
}
__device__ __forceinline__ void xcd_barrier_complete(unsigned* bar, unsigned x, unsigned& nloc, unsigned& nx) {
    const unsigned G = gridDim.x * gridDim.y * gridDim.z;
    unsigned sum, cnt, mine, sp = 0u;
    for (;;) {
        sum = 0u; cnt = 0u; mine = 0u;
#pragma unroll
        for (unsigned j = 0; j < 16; ++j) { const unsigned c = xb_ld(&bar[XB_XCNT(j)]); sum += c; cnt += (c > 0u) ? 1u : 0u; mine = (j == x) ? c : mine; }
        if (sum == G) break;
        __builtin_amdgcn_s_sleep(1);
        if ((++sp & 255u) == 0u) { if (xb_ld(&bar[XB_TMO])) break; if (sp > XB_SPIN_CAP) { atomicAdd(&bar[XB_TMO], 1u); break; } }
    }
    nloc = mine > 0u ? mine : 1u; nx = cnt > 0u ? cnt : 1u;
}
__device__ __forceinline__ void xcd_barrier(const XcdBarrier& b) {
    asm volatile("s_waitcnt vmcnt(0)" ::: "memory");
    __syncthreads();
    if (threadIdx.x == 0) {
        unsigned* bar = b.bar;
        __builtin_amdgcn_s_waitcnt(0);
        unsigned nloc = b.st[0], nx = b.st[1];
        if (nloc == 0u) { xcd_barrier_complete(bar, b.x, nloc, nx); b.st[0] = nloc; b.st[1] = nx; }
        const unsigned old = xb_add(&bar[XB_XSUB(b.x)], 1u);
        const unsigned gen = old / nloc;
        if (old + 1u == (gen + 1u) * nloc) {
            __builtin_amdgcn_fence(__ATOMIC_RELEASE, "agent");
            asm volatile("s_waitcnt vmcnt(0)" ::: "memory");
            const unsigned og = xb_add(&bar[XB_TOP], 1u);
            const unsigned tg = og / nx;
            if (og + 1u == (tg + 1u) * nx) xb_add(&bar[XB_TOPGEN], 1u);
            else XB_SPIN(xb_ld(&bar[XB_TOPGEN]) == tg, bar);
            __builtin_amdgcn_fence(__ATOMIC_ACQUIRE, "agent");
            xb_add(&bar[XB_XGEN(b.x)], 1u);
            asm volatile("s_waitcnt vmcnt(0)" ::: "memory");
        } else {
            XB_SPIN(xb_ld(&bar[XB_XGEN(b.x)]) == gen, bar);
            __builtin_amdgcn_fence(__ATOMIC_ACQUIRE, "agent");
            asm volatile("s_waitcnt vmcnt(0)" ::: "memory");
        }
    }
    __syncthreads();
}

constexpr int NPHASE = 2 + 8 * NL;
__device__ __forceinline__ void run_phase(const Params& p, int ph, char* smem, int bid, int nb) {
    if (ph == 0) { phase_prep(p, smem, bid, nb); return; }
    if (ph == 1) { phase_norm(p.x, p.norm1_g, (const float*)(p.ws + OFF_MOD), 0, D, (bf16_t*)(p.ws + OFF_H), bid, nb); return; }
    const int l = (ph - 2) / 8, s = (ph - 2) % 8;
    switch (s) {
        case 0: phase_gemm1(p, l, smem, bid, nb); break;
        case 1: phase_mix(p, l, smem, bid, nb); break;
        case 2: phase_fftb(p, l, smem, bid, nb); break;
        case 3: phase_gemm2(p, l, smem, bid, nb); break;
        case 4: phase_norm(p.out, p.norm2_g + l * D, (const float*)(p.ws + OFF_MOD) + (size_t)l * NB * 6144, 3 * D, 4 * D, (bf16_t*)(p.ws + OFF_H), bid, nb); break;
        case 5: phase_gemm3(p, l, smem, bid, nb); break;
        case 6: phase_topk(p, l, smem, bid, nb); break;
        default: phase_peer(p, l, bid, nb); break;
    }
}

#if MEGA
#if PROBE_A >= 0
#define TSTAMP(i) do { if (blockIdx.x == 0 && threadIdx.x == 0) ts[i] = __builtin_amdgcn_s_memrealtime(); } while (0)
#else
#define TSTAMP(i) do { } while (0)
#endif
__global__ void __launch_bounds__(256, 2) mega_kernel(Params p) {
    __shared__ __attribute__((aligned(16))) char smem[SMEM_BYTES];
    __shared__ uint4 xb_words;
#if PROBE_A >= 0
    __shared__ unsigned long long ts[24];
#endif
    cg::grid_group grid = cg::this_grid();
    const int bid = blockIdx.x, nb = gridDim.x;
    unsigned* bar = (unsigned*)(p.ws + OFF_BAR);
    if (threadIdx.x == 0) xb_words = make_uint4(0u, 0u, 0u, 0u);
    if (bid == 0) for (int i = threadIdx.x; i < XCD_BAR_WORDS; i += 256) bar[i] = 0u;
    TSTAMP(0);
    phase_prep(p, smem, bid, nb);
    grid.sync();
    const XcdBarrier xb = xcd_barrier_post(bar, (volatile LAS unsigned*)&xb_words);
    TSTAMP(1);
    phase_norm(p.x, p.norm1_g, (const float*)(p.ws + OFF_MOD), 0, D, (bf16_t*)(p.ws + OFF_H), bid, nb); xcd_barrier(xb);
#pragma nounroll
    for (int l = 0; l < NL; ++l) {
        TSTAMP(2 + 8 * l); phase_gemm1(p, l, smem, bid, nb); xcd_barrier(xb);
        TSTAMP(3 + 8 * l); phase_mix(p, l, smem, bid, nb); xcd_barrier(xb);
        TSTAMP(4 + 8 * l); phase_fftb(p, l, smem, bid, nb); xcd_barrier(xb);
        TSTAMP(5 + 8 * l); phase_gemm2(p, l, smem, bid, nb); xcd_barrier(xb);
        TSTAMP(6 + 8 * l); phase_norm(p.out, p.norm2_g + l * D, (const float*)(p.ws + OFF_MOD) + (size_t)l * NB * 6144, 3 * D, 4 * D, (bf16_t*)(p.ws + OFF_H), bid, nb); xcd_barrier(xb);
        TSTAMP(7 + 8 * l); phase_gemm3(p, l, smem, bid, nb); xcd_barrier(xb);
        TSTAMP(8 + 8 * l); phase_topk(p, l, smem, bid, nb); xcd_barrier(xb);
        TSTAMP(9 + 8 * l); phase_peer(p, l, bid, nb);
        if (l + 1 < NL) xcd_barrier(xb);
    }
    TSTAMP(18);
#if PROBE_A >= 0
    if (bid == 0 && threadIdx.x == 0) p.out[0] += (float)(ts[PROBE_B] - ts[PROBE_A]) * 0.01f / PROBE_DIV;
#endif
}
#else
__global__ void __launch_bounds__(256, 2) phase_kernel(Params p, int ph) {
    __shared__ __attribute__((aligned(16))) char smem[SMEM_BYTES];
    run_phase(p, ph, smem, blockIdx.x, gridDim.x);
}
#endif

__global__ void digest_kernel(Params p) {
    const int* eidx = (const int*)(p.ws + OFF_Y); const float* gw = (const float*)(p.ws + OFF_Y + (size_t)T * 128 * 4);
    for (size_t i = (size_t)blockIdx.x * 256 + threadIdx.x; i < (size_t)T * D; i += (size_t)gridDim.x * 256) {
        const size_t j = i % ((size_t)T * 128);
        p.out[i] = (float)eidx[j] * 1e-3f + gw[j];
    }
}
extern "C" void kernel_launch(void* const* d_in, const int* in_sizes, int n_in, void* d_out, int out_size, void* d_ws, size_t ws_size, hipStream_t stream) {
    (void)in_sizes; (void)n_in; (void)out_size;
    if (ws_size < OFF_END) { fprintf(stderr, "workspace too small: %zu < %zu\n", ws_size, (size_t)OFF_END); return; }
    Params p{};
    p.x = (const float*)d_in[0]; p.c = (const float*)d_in[1]; p.mod_w = (const float*)d_in[2]; p.mod_b = (const float*)d_in[3]; p.norm1_g = (const float*)d_in[4];
    p.w_in = (const float*)d_in[5]; p.gmlp_ws = (const float*)d_in[6]; p.gmlp_bs = (const float*)d_in[7]; p.fnet_w = (const float*)d_in[8]; p.fnet_b = (const float*)d_in[9];
    p.gain_a = (const float*)d_in[10]; p.gain_b = (const float*)d_in[11]; p.w_out = (const float*)d_in[12]; p.norm2_g = (const float*)d_in[13]; p.wq = (const float*)d_in[14];
    p.k1 = (const float*)d_in[15]; p.k2 = (const float*)d_in[16]; p.pu = (const float*)d_in[17]; p.pv = (const float*)d_in[18]; p.final_g = (const float*)d_in[19];
    p.out = (float*)d_out; p.ws = (char*)d_ws;
#if MEGA
    static int grid_blocks = 0;
    if (!grid_blocks) {
        int dev = 0, cus = 0, per_cu = 0;
        hipGetDevice(&dev);
        hipDeviceGetAttribute(&cus, hipDeviceAttributeMultiprocessorCount, dev);
        hipOccupancyMaxActiveBlocksPerMultiprocessor(&per_cu, mega_kernel, 256, 0);
        if (per_cu > 2) per_cu = 2;
        grid_blocks = cus * per_cu;
    }
    void* args[] = {&p};
    hipError_t e = hipLaunchCooperativeKernel((void*)mega_kernel, dim3(grid_blocks), dim3(256), args, 0, stream);
    if (e != hipSuccess) fprintf(stderr, "cooperative launch failed: %s (grid %d)\n", hipGetErrorString(e), grid_blocks);
#else
    for (int ph = 0; ph < NPHASE && ph <= STOP_AFTER; ++ph) phase_kernel<<<512, 256, 0, stream>>>(p, ph);
    if (DIGEST) digest_kernel<<<1024, 256, 0, stream>>>(p);
#endif
}
```

```cpp
#include <hip/hip_runtime.h>
#include <hip/hip_cooperative_groups.h>
#include <cstdio>
#include <cstdint>
namespace cg = cooperative_groups;

#ifndef MEGA
#define MEGA 1
#endif
#ifndef PROBE_A
#define PROBE_A -1
#define PROBE_B 0
#define PROBE_DIV 10.0f
#endif

typedef unsigned short bf16_t;
typedef short bf16x8 __attribute__((ext_vector_type(8)));
typedef float f32x4 __attribute__((ext_vector_type(4)));
typedef __bf16 bf16x2_t __attribute__((ext_vector_type(2)));

constexpr int D = 1024, NB = 8, SEQ = 4096, T = NB * SEQ, NL = 2;
constexpr int NZ = 2048;
constexpr int NE = 16384;
constexpr float EPS = 1e-6f;

constexpr size_t OFF_MOD  = 0;
constexpr size_t OFF_W1T  = OFF_MOD  + (size_t)NL * NB * 6144 * 4;
constexpr size_t OFF_W2T  = OFF_W1T  + (size_t)NL * 2048 * 1024 * 2;
constexpr size_t OFF_WQT  = OFF_W2T  + (size_t)NL * 1024 * 1024 * 2;
constexpr size_t OFF_K12  = OFF_WQT  + (size_t)NL * 2048 * 1024 * 2;
constexpr size_t OFF_WSB  = OFF_K12  + (size_t)NL * 8 * 256 * 128 * 2;
constexpr size_t OFF_DA   = OFF_WSB  + (size_t)NL * 8 * 128 * 128 * 2;
constexpr size_t OFF_DB   = OFF_DA   + 128 * 128 * 2;
constexpr size_t OFF_TW   = OFF_DB   + 64 * 128 * 2;
constexpr size_t OFF_SSQA = OFF_TW   + 64 * 64 * 8;
constexpr size_t OFF_SSQB = OFF_SSQA + (size_t)T * 8 * 4;
constexpr size_t OFF_UB   = OFF_SSQB + (size_t)T * 8 * 4;
constexpr size_t OFF_VB   = OFF_UB   + (size_t)NL * NE * 1024;
constexpr size_t OFF_USC  = OFF_VB   + (size_t)NL * NE * 1024;
constexpr size_t OFF_VSC  = OFF_USC  + (size_t)NL * NE * 4;
constexpr size_t OFF_H    = OFF_VSC  + (size_t)NL * NE * 4;
constexpr size_t OFF_Z    = OFF_H    + (size_t)T * 1024 * 2;
constexpr size_t OFF_Y    = OFF_Z    + (size_t)T * 2048 * 2;
constexpr size_t OFF_BAR  = OFF_Y    + (size_t)T * 1024 * 2;
constexpr size_t OFF_END  = OFF_BAR  + 16384;

struct Params {
    const float* x; const float* c; const float* mod_w; const float* mod_b; const float* norm1_g; const float* w_in;
    const float* gmlp_ws; const float* gmlp_bs; const float* fnet_w; const float* fnet_b; const float* gain_a; const float* gain_b;
    const float* w_out; const float* norm2_g; const float* wq; const float* k1; const float* k2; const float* pu; const float* pv; const float* final_g;
    float* out; char* ws;
};

constexpr int SMEM_BYTES = 73984;

__device__ __forceinline__ float bf2f(unsigned v) { return __uint_as_float(v << 16); }
typedef float f32x2_t __attribute__((ext_vector_type(2)));
__device__ __forceinline__ unsigned pk_bf16(float lo, float hi) { const f32x2_t v = {lo, hi}; return __builtin_bit_cast(unsigned, __builtin_convertvector(v, bf16x2_t)); }
__device__ __forceinline__ bf16_t f2bf(float f) { return (bf16_t)(pk_bf16(f, 0.f) & 0xffffu); }
__device__ __forceinline__ float gelu_f(float v) {
    const float t = __builtin_amdgcn_rcpf(fabsf(v) * 0.2316418882f + 1.0f);
    float q = t * 0.5307027145f + (-0.7265760135f); q = q * t + 0.7107068705f; q = q * t + (-0.142248368f); q = q * t + 0.127414796f; q = q * t;
    const float m = v * (q * __builtin_amdgcn_exp2f(v * v * (-0.72134752044f)));
    return v < 0.f ? m : v - m;
}
__device__ __forceinline__ int med3i(int a, int b, int c) { return max(min(a, b), min(max(a, b), c)); }
__device__ __forceinline__ int f2key(float f) { int b = __float_as_int(f); return b ^ ((b >> 31) & 0x7fffffff); }
__device__ __forceinline__ float key2f(int k) { return __int_as_float(k ^ ((k >> 31) & 0x7fffffff)); }
__device__ __forceinline__ float wave_sum(float v) {
#pragma unroll
    for (int o = 32; o >= 1; o >>= 1) v += __shfl_xor(v, o);
    return v;
}
__device__ __forceinline__ int otid() { int t = threadIdx.x; asm volatile("" : "+v"(t)); return t; }
#define MFMA16(a, b, c) __builtin_amdgcn_mfma_f32_16x16x32_bf16((a), (b), (c), 0, 0, 0)

__device__ void transpose_tile(const float* __restrict__ src, int ld, int k0, int n0, bf16_t* __restrict__ dst  , int dn0,
                               const float* __restrict__ kscale, float* tile  ) {
    const int tid = otid();
#pragma unroll
    for (int i = 0; i < 4; ++i) {
        const int r = (tid >> 4) + 16 * i, c4 = (tid & 15) * 4;
        const float4 v = *(const float4*)(src + (size_t)(k0 + r) * ld + n0 + c4);
        const float s = kscale ? kscale[k0 + r] : 1.0f;
        tile[r * 65 + c4 + 0] = v.x * s; tile[r * 65 + c4 + 1] = v.y * s; tile[r * 65 + c4 + 2] = v.z * s; tile[r * 65 + c4 + 3] = v.w * s;
    }
    __syncthreads();
    {
        const int n = tid >> 2, ks = (tid & 3) * 16;
        unsigned w[8];
#pragma unroll
        for (int j = 0; j < 8; ++j) w[j] = pk_bf16(tile[(ks + 2 * j) * 65 + n], tile[(ks + 2 * j + 1) * 65 + n]);
        uint4* d = (uint4*)(dst + (size_t)(dn0 + n) * 1024 + k0 + ks);
        d[0] = make_uint4(w[0], w[1], w[2], w[3]); d[1] = make_uint4(w[4], w[5], w[6], w[7]);
    }
    __syncthreads();
}

__device__ void phase_prep(const Params& p, char* smem, int bid, int nb) {
    const int tid = otid();
    const int gtid = bid * 256 + tid, gsz = nb * 256;
    char* ws = p.ws;
    {
        float* sc = (float*)smem;
        float* red = (float*)(smem + 32768);
        for (int i = tid; i < 8192; i += 256) { const float v = p.c[i]; sc[i] = v / (1.0f + __expf(-v)); }
        __syncthreads();
        float* mod = (float*)(ws + OFF_MOD);
        for (int item = bid; item < NL * 192; item += nb) {
            const int l = item / 192, n0 = (item % 192) * 32, nn = tid & 31, kq = tid >> 5;
            float acc[8];
#pragma unroll
            for (int b = 0; b < 8; ++b) acc[b] = 0.f;
            const float* W = p.mod_w + (size_t)l * 1024 * 6144 + n0 + nn;
            for (int k = kq; k < 1024; k += 8) {
                const float w = W[(size_t)k * 6144];
#pragma unroll
                for (int b = 0; b < 8; ++b) acc[b] += sc[b * 1024 + k] * w;
            }
#pragma unroll
            for (int b = 0; b < 8; ++b) red[(kq * 8 + b) * 32 + nn] = acc[b];
            __syncthreads();
            {
                const int b = tid >> 5;
                float s = 0.f;
#pragma unroll
                for (int q = 0; q < 8; ++q) s += red[(q * 8 + b) * 32 + nn];
                mod[((size_t)l * NB + b) * 6144 + n0 + nn] = s + p.mod_b[l * 6144 + n0 + nn];
            }
            __syncthreads();
        }
    }
    {
        float* tile = (float*)smem;
        for (int item = bid; item < NL * 1024; item += nb) {
            const int l = item / 1024, r = item % 1024;
            if (r < 256) {
                const int kt = r / 16, nt = r % 16;
                transpose_tile(p.w_in + (size_t)l * 1024 * 1536, 1536, kt * 64, nt * 64, (bf16_t*)(ws + OFF_W1T) + (size_t)l * 2048 * 1024, nt * 64, nullptr, tile);
            } else if (r < 512) {
                const int rr = r - 256, kt = rr / 16, nt = rr % 16;
                const float* gk = (kt < 8) ? (p.gain_a + l * 512) : (p.gain_b + l * 512 - 512);
                transpose_tile(p.w_out + (size_t)l * 1024 * 1024, 1024, kt * 64, nt * 64, (bf16_t*)(ws + OFF_W2T) + (size_t)l * 1024 * 1024, nt * 64, gk, tile);
            } else {
                const int rr = r - 512, kt = rr / 32, nt = rr % 32;
                transpose_tile(p.wq + (size_t)l * 1024 * 2048, 2048, kt * 64, nt * 64, (bf16_t*)(ws + OFF_WQT) + (size_t)l * 2048 * 1024, nt * 64, nullptr, tile);
            }
        }
    }
    {
        float* fws = (float*)smem;
        float* Ms  = (float*)(smem + 16384);
        float* wt  = (float*)(smem + 49152);
        float* cs  = (float*)(smem + 49152 + 16640);
        for (int item = bid; item < NL * 8 * 16; item += nb) {
            const int l = item / 128, g = (item % 128) / 16, kt = item % 16;
            if (tid < 64) { float s, c; sincospif((float)tid / 32.0f, &s, &c); cs[tid] = c; cs[64 + tid] = s; }
            for (int i = tid; i < 4096; i += 256) fws[i] = p.fnet_w[((size_t)l * 8 + g) * 4096 + i];
#pragma unroll
            for (int i = 0; i < 4; ++i) {
                const int r = (tid >> 4) + 16 * i, c4 = (tid & 15) * 4;
                const float4 v = *(const float4*)(p.w_in + (size_t)l * 1024 * 1536 + (size_t)(kt * 64 + r) * 1536 + 1024 + g * 64 + c4);
                wt[r * 65 + c4] = v.x; wt[r * 65 + c4 + 1] = v.y; wt[r * 65 + c4 + 2] = v.z; wt[r * 65 + c4 + 3] = v.w;
            }
            __syncthreads();
            {
                const int d = tid >> 2, r0 = (tid & 3) * 32;
                const bool im = r0 >= 64; const int e0 = r0 & 63;
                float acc[32];
#pragma unroll
                for (int e = 0; e < 32; ++e) acc[e] = 0.f;
                for (int j = 0; j < 64; ++j) {
                    const int ph = (d * j) & 63;
                    const float t = im ? -cs[64 + ph] : cs[ph];
#pragma unroll
                    for (int e = 0; e < 32; ++e) acc[e] += t * fws[j * 64 + e0 + e];
                }
#pragma unroll
                for (int e = 0; e < 32; ++e) Ms[d * 128 + r0 + e] = acc[e];
            }
            __syncthreads();
            {
                const int r = tid >> 1, kk0 = (tid & 1) * 32;
                float acc[32];
#pragma unroll
                for (int k = 0; k < 32; ++k) acc[k] = 0.f;
                for (int d = 0; d < 64; ++d) {
                    const float m = Ms[d * 128 + r];
#pragma unroll
                    for (int k = 0; k < 32; ++k) acc[k] += wt[(kk0 + k) * 65 + d] * m;
                }
                bf16_t* dst = (bf16_t*)(ws + OFF_W1T) + (size_t)l * 2048 * 1024 + (size_t)(1024 + g * 128 + r) * 1024 + kt * 64 + kk0;
#pragma unroll
                for (int q = 0; q < 4; ++q)
                    ((uint4*)dst)[q] = make_uint4(pk_bf16(acc[q * 8], acc[q * 8 + 1]), pk_bf16(acc[q * 8 + 2], acc[q * 8 + 3]), pk_bf16(acc[q * 8 + 4], acc[q * 8 + 5]), pk_bf16(acc[q * 8 + 6], acc[q * 8 + 7]));
            }
            __syncthreads();
        }
    }
    {
        bf16_t* k12 = (bf16_t*)(ws + OFF_K12);
        for (int i = gtid; i < NL * 8 * 256 * 128; i += gsz) {
            const int d = i & 127, n = (i >> 7) & 255, h = (i >> 15) & 7, l = i >> 18;
            const float* src = (n < 128) ? p.k1 : p.k2;
            k12[i] = f2bf(src[(((size_t)l * 8 + h) * 128 + (n & 127)) * 128 + d]);
        }
        bf16_t* wsb = (bf16_t*)(ws + OFF_WSB);
        for (int i = gtid; i < NL * 8 * 128 * 128; i += gsz) wsb[i] = f2bf(p.gmlp_ws[i]);
        bf16_t* DA = (bf16_t*)(ws + OFF_DA);
        for (int i = gtid; i < 128 * 128; i += gsz) {
            const int m = i >> 7, kk = i & 127, ro = m >> 6, k1 = m & 63, ri = kk >> 6, a = kk & 63;
            float s, c; sincospif((float)((a * k1) & 63) / 32.0f, &s, &c);
            const float v = (ro == ri) ? c : (ro == 0 ? s : -s);
            DA[i] = f2bf(v);
        }
        bf16_t* DB = (bf16_t*)(ws + OFF_DB);
        for (int i = gtid; i < 64 * 128; i += gsz) {
            const int k2 = i >> 7, kk = i & 127, ri = kk >> 6, b = kk & 63;
            float s, c; sincospif((float)((b * k2) & 63) / 32.0f, &s, &c);
            DB[i] = f2bf(ri ? s : c);
        }
        float2* tw = (float2*)(ws + OFF_TW);
        for (int i = gtid; i < 64 * 64; i += gsz) {
            const int bp = i >> 6, k1 = i & 63;
            float s, c; sincospif((float)(bp * k1) / 2048.0f, &s, &c);
            tw[i] = make_float2(c, s);
        }
        {
            const int lane = tid & 63, wv = gtid >> 6, nwv = gsz >> 6;
            for (int r = wv; r < 2 * NL * NE; r += nwv) {
                const int tbl = r / (NL * NE), row = r % (NL * NE);
                const float* src = (tbl ? p.pv : p.pu) + (size_t)row * 1024 + lane * 16;
                float4 v[4]; float m = 0.f;
#pragma unroll
                for (int i = 0; i < 4; ++i) { v[i] = ((const float4*)src)[i]; m = fmaxf(m, fmaxf(fmaxf(fabsf(v[i].x), fabsf(v[i].y)), fmaxf(fabsf(v[i].z), fabsf(v[i].w)))); }
#pragma unroll
                for (int o = 32; o >= 1; o >>= 1) m = fmaxf(m, __shfl_xor(m, o));
                const float sc = (m > 0.f) ? 256.0f / m : 1.0f, inv = (m > 0.f) ? m * (1.0f / 256.0f) : 1.0f;
                int w[4];
#pragma unroll
                for (int i = 0; i < 4; ++i) { w[i] = __builtin_amdgcn_cvt_pk_fp8_f32(v[i].x * sc, v[i].y * sc, 0, false); w[i] = __builtin_amdgcn_cvt_pk_fp8_f32(v[i].z * sc, v[i].w * sc, w[i], true); }
                {
                    const int lyr = row / NE, ex = row % NE;
                    *(int4*)(ws + (tbl ? OFF_VB : OFF_UB) + ((size_t)(lyr * 8 + (lane >> 3)) * NE + ex) * 128 + (lane & 7) * 16) = make_int4(w[0], w[1], w[2], w[3]);
                }
                if (lane == 0) ((float*)(ws + (tbl ? OFF_VSC : OFF_USC)))[row] = inv;
            }
        }
    }
}

__device__ void phase_norm(const float* __restrict__ xsrc, const float* __restrict__ g, const float* __restrict__ modl  , int sh_off, int scl_off,
                           bf16_t* __restrict__ hout, int bid, int nb) {
    const int tid_ = otid(); const int lane = tid_ & 63, wid = tid_ >> 6;
    for (int tok = bid * 4 + wid; tok < T; tok += nb * 4) {
        const int b = tok / SEQ;
        const float* xr = xsrc + (size_t)tok * D;
        float4 v[4];
        float ss = 0.f;
#pragma unroll
        for (int i = 0; i < 4; ++i) { v[i] = *(const float4*)(xr + i * 256 + lane * 4); ss += v[i].x * v[i].x + v[i].y * v[i].y + v[i].z * v[i].z + v[i].w * v[i].w; }
        ss = wave_sum(ss);
        const float rstd = rsqrtf(ss * (1.0f / D) + EPS);
        const float* mb = modl + (size_t)b * 6144;
#pragma unroll
        for (int i = 0; i < 4; ++i) {
            const int cidx = i * 256 + lane * 4;
            const float4 gg = *(const float4*)(g + cidx), sh = *(const float4*)(mb + sh_off + cidx), sc = *(const float4*)(mb + scl_off + cidx);
            const float o0 = v[i].x * rstd * gg.x * (1.0f + sc.x) + sh.x, o1 = v[i].y * rstd * gg.y * (1.0f + sc.y) + sh.y;
            const float o2 = v[i].z * rstd * gg.z * (1.0f + sc.z) + sh.z, o3 = v[i].w * rstd * gg.w * (1.0f + sc.w) + sh.w;
            *(uint2*)(hout + (size_t)tok * D + cidx) = make_uint2(pk_bf16(o0, o1), pk_bf16(o2, o3));
        }
    }
}

#define LAS __attribute__((address_space(3)))
template <class Epi, class MidK>
__device__ __forceinline__ void gemm_tile(const bf16_t* __restrict__ A, int lda, const bf16_t* __restrict__ Bt, int ldb, int K, int m0, int n0,
                                          char* smem, const Epi& epi, const MidK& midk, int kmid) {
    const int tid = otid(), lane = tid & 63, wid = tid >> 6, wr = wid >> 1, wc = wid & 1, fr = lane & 15, fq = lane >> 4;
    LAS char* lds = (LAS char*)smem;
    f32x4 acc[4][4];
#pragma unroll
    for (int i = 0; i < 4; ++i)
#pragma unroll
        for (int j = 0; j < 4; ++j) acc[i][j] = (f32x4){0.f, 0.f, 0.f, 0.f};
    const int prow = lane >> 3, pch = (lane & 7) ^ prow;
    const bf16_t* ga = A + (size_t)(m0 + wid * 32 + prow) * lda + pch * 8;
    const bf16_t* gb = Bt + (size_t)(n0 + wid * 32 + prow) * ldb + pch * 8;
    const int nk = K / 64;
#define GEMM_STAGE(kt_, buf_) do { _Pragma("unroll") for (int i_ = 0; i_ < 4; ++i_) { \
        __builtin_amdgcn_global_load_lds((const unsigned*)(ga + (size_t)(i_ * 8) * lda + (kt_) * 64), (LAS unsigned*)(lds + (buf_) * 16384 + (wid * 32 + i_ * 8) * 128), 16, 0, 0); \
        __builtin_amdgcn_global_load_lds((const unsigned*)(gb + (size_t)(i_ * 8) * ldb + (kt_) * 64), (LAS unsigned*)(lds + 32768 + (buf_) * 16384 + (wid * 32 + i_ * 8) * 128), 16, 0, 0); } } while (0)
    GEMM_STAGE(0, 0);
    const int swz = fr & 7;
    for (int kt = 0; kt < nk; ++kt) {
        const int cur = kt & 1;
        asm volatile("s_waitcnt vmcnt(0)" ::: "memory");
        __syncthreads();
        if (kt + 1 < nk) GEMM_STAGE(kt + 1, cur ^ 1);
        if (kt == kmid) {
#pragma unroll
            for (int i = 0; i < 4; ++i) { const float sc = midk(m0 + wr * 64 + i * 16 + fr);
#pragma unroll
                for (int j = 0; j < 4; ++j) acc[i][j] *= sc; }
        }
        const LAS char* ca = lds + cur * 16384; const LAS char* cb = lds + 32768 + cur * 16384;
#pragma unroll
        for (int ks = 0; ks < 2; ++ks) {
            bf16x8 af[4], bfr[4];
            const int coff = ((ks * 4 + fq) ^ swz) * 16;
#pragma unroll
            for (int i = 0; i < 4; ++i) af[i] = *(const LAS bf16x8*)(ca + (wr * 64 + i * 16 + fr) * 128 + coff);
#pragma unroll
            for (int j = 0; j < 4; ++j) bfr[j] = *(const LAS bf16x8*)(cb + (wc * 64 + j * 16 + fr) * 128 + coff);
#pragma unroll
            for (int i = 0; i < 4; ++i)
#pragma unroll
                for (int j = 0; j < 4; ++j) acc[i][j] = MFMA16(bfr[j], af[i], acc[i][j]);
        }
    }
#undef GEMM_STAGE
#pragma unroll
    for (int i = 0; i < 4; ++i)
#pragma unroll
        for (int j = 0; j < 4; ++j) { epi(m0 + wr * 64 + i * 16 + fr, n0 + wc * 64 + j * 16 + fq * 4, acc[i][j]); __builtin_amdgcn_sched_barrier(0); }
    __syncthreads();
}
struct NoMid { __device__ __forceinline__ float operator()(int) const { return 1.0f; } };

__device__ void phase_gemm1(const Params& p, int l, char* smem, int bid, int nb) {
    const bf16_t* A = (const bf16_t*)(p.ws + OFF_H);
    const bf16_t* Bt = (const bf16_t*)(p.ws + OFF_W1T) + (size_t)l * 2048 * 1024;
    bf16_t* Z = (bf16_t*)(p.ws + OFF_Z);
    auto epi_gelu = [&](int row, int col, const f32x4& v) {
        *(uint2*)(Z + (size_t)row * NZ + col) = make_uint2(pk_bf16(gelu_f(v[0]), gelu_f(v[1])), pk_bf16(gelu_f(v[2]), gelu_f(v[3])));
    };
    auto epi_plain = [&](int row, int col, const f32x4& v) { *(uint2*)(Z + (size_t)row * NZ + col) = make_uint2(pk_bf16(v[0], v[1]), pk_bf16(v[2], v[3])); };
    const int NT = NZ / 128, MT = T / 128;
    for (int item = bid; item < MT * NT; item += nb) {
        const int n0 = (item % NT) * 128;
        if (n0 < 1024) gemm_tile(A, D, Bt, D, D, (item / NT) * 128, n0, smem, epi_gelu, NoMid(), -1);
        else           gemm_tile(A, D, Bt, D, D, (item / NT) * 128, n0, smem, epi_plain, NoMid(), -1);
    }
}
__device__ void phase_gemm2(const Params& p, int l, char* smem, int bid, int nb) {
    const bf16_t* A = (const bf16_t*)(p.ws + OFF_Y);
    const bf16_t* Bt = (const bf16_t*)(p.ws + OFF_W2T) + (size_t)l * 1024 * 1024;
    const float* ssa = (const float*)(p.ws + OFF_SSQA); const float* ssb = (const float*)(p.ws + OFF_SSQB);
    const float* mod = (const float*)(p.ws + OFF_MOD) + (size_t)l * NB * 6144;
    const float* xin = (l == 0) ? p.x : p.out;
    float* xout = p.out;
    auto rstd_of = [&](const float* s, int row) {
        const float4 a = *(const float4*)(s + (size_t)row * 8), b = *(const float4*)(s + (size_t)row * 8 + 4);
        return rsqrtf(((a.x + a.y) + (a.z + a.w) + (b.x + b.y) + (b.z + b.w)) * (1.0f / 512.0f) + EPS);
    };
    auto midk = [&](int row) { return rstd_of(ssa, row) / rstd_of(ssb, row); };
    auto epi = [&](int row, int col, const f32x4& v) {
        const float rb = rstd_of(ssb, row);
        const int b = row / SEQ;
        const float4 g = *(const float4*)(mod + (size_t)b * 6144 + 2 * D + col);
        const float4 xi = *(const float4*)(xin + (size_t)row * D + col);
        float4 o; o.x = xi.x + g.x * rb * v[0]; o.y = xi.y + g.y * rb * v[1]; o.z = xi.z + g.z * rb * v[2]; o.w = xi.w + g.w * rb * v[3];
        *(float4*)(xout + (size_t)row * D + col) = o;
    };
    const int NT = D / 128, MT = T / 128;
    for (int item = bid; item < MT * NT; item += nb) gemm_tile(A, D, Bt, D, D, (item / NT) * 128, (item % NT) * 128, smem, epi, midk, 8);
}
__device__ void phase_gemm3(const Params& p, int l, char* smem, int bid, int nb) {
    const bf16_t* A = (const bf16_t*)(p.ws + OFF_H);
    const bf16_t* Bt = (const bf16_t*)(p.ws + OFF_WQT) + (size_t)l * 2048 * 1024;
    bf16_t* Q = (bf16_t*)(p.ws + OFF_Z);
    auto epi = [&](int row, int col, const f32x4& v) { *(uint2*)(Q + (size_t)row * 2048 + col) = make_uint2(pk_bf16(v[0], v[1]), pk_bf16(v[2], v[3])); };
    const int NT = 2048 / 128, MT = T / 128;
    for (int item = bid; item < MT * NT; item += nb) gemm_tile(A, D, Bt, D, D, (item / NT) * 128, (item % NT) * 128, smem, epi, NoMid(), -1);
}

constexpr int TP = 136;
__device__ __forceinline__ void stage_transposed(const bf16_t* __restrict__ base, size_t row_stride, bf16_t* dT) {
    const int tid = otid(), r = tid >> 2, part = tid & 3, ri = part >> 1, c0 = (part & 1) * 32;
    const uint4* src = (const uint4*)(base + (size_t)r * row_stride + ri * 64 + c0);
    uint4 v[4];
#pragma unroll
    for (int i = 0; i < 4; ++i) v[i] = src[i];
#pragma unroll
    for (int i = 0; i < 4; ++i) {
        const unsigned w[4] = {v[i].x, v[i].y, v[i].z, v[i].w};
#pragma unroll
        for (int j = 0; j < 4; ++j) {
            dT[(c0 + i * 8 + j * 2) * TP + ri * 64 + r] = (bf16_t)(w[j] & 0xffffu);
            dT[(c0 + i * 8 + j * 2 + 1) * TP + ri * 64 + r] = (bf16_t)(w[j] >> 16);
        }
    }
}

__device__ void gmlp_item(const Params& p, int l, int item, char* smem) {
    const int tid = otid(), lane = tid & 63, wid = tid >> 6, fr = lane & 15, fq = lane >> 4;
    const int h = item & 7, c = (item >> 3) & 31, b = item >> 8;
    const int tok0 = b * SEQ + c * 128;
    bf16_t* vnT = (bf16_t*)smem;
    const bf16_t* Z = (const bf16_t*)(p.ws + OFF_Z);
    {
        const int q = tid >> 1, half = tid & 1, d0 = half * 32;
        const uint4* src = (const uint4*)(Z + (size_t)(tok0 + q) * NZ + 512 + h * 64 + d0);
        float f[32];
#pragma unroll
        for (int i = 0; i < 4; ++i) { const uint4 v = src[i]; const unsigned w[4] = {v.x, v.y, v.z, v.w};
#pragma unroll
            for (int j = 0; j < 4; ++j) { f[i * 8 + j * 2] = bf2f(w[j] & 0xffffu); f[i * 8 + j * 2 + 1] = bf2f(w[j] >> 16); } }
        float s = 0.f;
#pragma unroll
        for (int i = 0; i < 32; ++i) s += f[i];
        s += __shfl_xor(s, 1);
        const float mean = s * (1.0f / 64.0f);
        float qv = 0.f;
#pragma unroll
        for (int i = 0; i < 32; ++i) { f[i] -= mean; qv += f[i] * f[i]; }
        qv += __shfl_xor(qv, 1);
        const float rstd = rsqrtf(qv * (1.0f / 64.0f) + EPS);
#pragma unroll
        for (int i = 0; i < 32; ++i) vnT[(d0 + i) * TP + q] = f2bf(f[i] * rstd);
    }
    __syncthreads();
    const bf16_t* Wsb = (const bf16_t*)(p.ws + OFF_WSB) + ((size_t)l * 8 + h) * 128 * 128;
    f32x4 acc[2][4];
#pragma unroll
    for (int i = 0; i < 2; ++i)
#pragma unroll
        for (int j = 0; j < 4; ++j) acc[i][j] = (f32x4){0.f, 0.f, 0.f, 0.f};
    const int p0 = wid * 32;
#pragma unroll
    for (int ks = 0; ks < 4; ++ks) {
        bf16x8 af[2], bfr[4];
#pragma unroll
        for (int i = 0; i < 2; ++i) af[i] = *(const bf16x8*)(Wsb + (size_t)(p0 + i * 16 + fr) * 128 + ks * 32 + fq * 8);
#pragma unroll
        for (int j = 0; j < 4; ++j) bfr[j] = *(const bf16x8*)(vnT + (j * 16 + fr) * TP + ks * 32 + fq * 8);
#pragma unroll
        for (int i = 0; i < 2; ++i)
#pragma unroll
            for (int j = 0; j < 4; ++j) acc[i][j] = MFMA16(bfr[j], af[i], acc[i][j]);
    }
    bf16_t* Y = (bf16_t*)(p.ws + OFF_Y);
    float* ssa = (float*)(p.ws + OFF_SSQA);
#pragma unroll
    for (int i = 0; i < 2; ++i) {
        const int pp = p0 + i * 16 + fr, tok = tok0 + pp;
        const float bsv = p.gmlp_bs[((size_t)l * 8 + h) * 128 + pp];
        float ss = 0.f;
#pragma unroll
        for (int j = 0; j < 4; ++j) {
            const int d = j * 16 + fq * 4;
            const uint2 uu = *(const uint2*)(Z + (size_t)tok * NZ + h * 64 + d);
            const float y0 = bf2f(uu.x & 0xffffu) * (acc[i][j][0] + bsv), y1 = bf2f(uu.x >> 16) * (acc[i][j][1] + bsv);
            const float y2 = bf2f(uu.y & 0xffffu) * (acc[i][j][2] + bsv), y3 = bf2f(uu.y >> 16) * (acc[i][j][3] + bsv);
            ss += y0 * y0 + y1 * y1 + y2 * y2 + y3 * y3;
            *(uint2*)(Y + (size_t)tok * D + h * 64 + d) = make_uint2(pk_bf16(y0, y1), pk_bf16(y2, y3));
        }
        ss += __shfl_xor(ss, 16); ss += __shfl_xor(ss, 32);
        if (fq == 0) ssa[(size_t)tok * 8 + h] = ss;
    }
    __syncthreads();
}

__device__ void ffta_item(const Params& p, int item, char* smem) {
    const int tid = otid(), lane = tid & 63, wid = tid >> 6, fr = lane & 15, fq = lane >> 4;
    const int bp = item & 63, g = (item >> 6) & 7, b = item >> 9;
    bf16_t* dT = (bf16_t*)smem;
    const bf16_t* Z = (const bf16_t*)(p.ws + OFF_Z);
    stage_transposed(Z + (size_t)(b * SEQ + bp) * NZ + 1024 + g * 128, (size_t)64 * NZ, dT);
    __syncthreads();
    const bf16_t* DA = (const bf16_t*)(p.ws + OFF_DA);
    f32x4 acc[2][4];
#pragma unroll
    for (int i = 0; i < 2; ++i)
#pragma unroll
        for (int j = 0; j < 4; ++j) acc[i][j] = (f32x4){0.f, 0.f, 0.f, 0.f};
#pragma unroll
    for (int ks = 0; ks < 4; ++ks) {
        bf16x8 af[2], bfr[4];
#pragma unroll
        for (int i = 0; i < 2; ++i) af[i] = *(const bf16x8*)(DA + (size_t)(i * 64 + wid * 16 + fr) * 128 + ks * 32 + fq * 8);
#pragma unroll
        for (int j = 0; j < 4; ++j) bfr[j] = *(const bf16x8*)(dT + (j * 16 + fr) * TP + ks * 32 + fq * 8);
#pragma unroll
        for (int i = 0; i < 2; ++i)
#pragma unroll
            for (int j = 0; j < 4; ++j) acc[i][j] = MFMA16(bfr[j], af[i], acc[i][j]);
    }
    const int k1 = wid * 16 + fr;
    const float2 cs = ((const float2*)(p.ws + OFF_TW))[bp * 64 + k1];
    bf16_t* Yb = (bf16_t*)(p.ws + OFF_H) + ((((size_t)(b * 8 + g) * 64 + k1) * 64 + bp) * 128);
#pragma unroll
    for (int j = 0; j < 4; ++j) {
        const int ch = j * 16 + fq * 4;
        float yr[4], yi[4];
#pragma unroll
        for (int e = 0; e < 4; ++e) { const float r = acc[0][j][e], im = acc[1][j][e]; yr[e] = r * cs.x + im * cs.y; yi[e] = im * cs.x - r * cs.y; }
        *(uint2*)(Yb + ch) = make_uint2(pk_bf16(yr[0], yr[1]), pk_bf16(yr[2], yr[3]));
        *(uint2*)(Yb + 64 + ch) = make_uint2(pk_bf16(yi[0], yi[1]), pk_bf16(yi[2], yi[3]));
    }
    __syncthreads();
}

__device__ void phase_mix(const Params& p, int l, char* smem, int bid, int nb) {
    for (int item = bid; item < 2048 + 4096; item += nb) {
        if (item < 2048) gmlp_item(p, l, item, smem); else ffta_item(p, item - 2048, smem);
    }
}

__device__ void phase_fftb(const Params& p, int l, char* smem, int bid, int nb) {
    const int tid = otid(), lane = tid & 63, wid = tid >> 6, fr = lane & 15, fq = lane >> 4;
    bf16_t* dT = (bf16_t*)smem;
    const bf16_t* DB = (const bf16_t*)(p.ws + OFF_DB);
    bf16_t* Y = (bf16_t*)(p.ws + OFF_Y);
    float* ssb = (float*)(p.ws + OFF_SSQB);
    for (int item = bid; item < 4096; item += nb) {
        const int k1 = item & 63, g = (item >> 6) & 7, b = item >> 9;
        stage_transposed((const bf16_t*)(p.ws + OFF_H) + (((size_t)(b * 8 + g) * 64 + k1) * 64) * 128, 128, dT);
        __syncthreads();
        f32x4 acc[4];
#pragma unroll
        for (int j = 0; j < 4; ++j) acc[j] = (f32x4){0.f, 0.f, 0.f, 0.f};
#pragma unroll
        for (int ks = 0; ks < 4; ++ks) {
            const bf16x8 af = *(const bf16x8*)(DB + (size_t)(wid * 16 + fr) * 128 + ks * 32 + fq * 8);
#pragma unroll
            for (int j = 0; j < 4; ++j) { const bf16x8 bfr = *(const bf16x8*)(dT + (j * 16 + fr) * TP + ks * 32 + fq * 8); acc[j] = MFMA16(bfr, af, acc[j]); }
        }
        const int k2 = wid * 16 + fr, tok = b * SEQ + k1 + 64 * k2;
        float ss = 0.f;
#pragma unroll
        for (int j = 0; j < 4; ++j) {
            const int ch = j * 16 + fq * 4;
            const float4 fb = *(const float4*)(p.fnet_b + ((size_t)l * 8 + g) * 64 + ch);
            const float y0 = acc[j][0] * (1.0f / 512.0f) + fb.x, y1 = acc[j][1] * (1.0f / 512.0f) + fb.y, y2 = acc[j][2] * (1.0f / 512.0f) + fb.z, y3 = acc[j][3] * (1.0f / 512.0f) + fb.w;
            ss += y0 * y0 + y1 * y1 + y2 * y2 + y3 * y3;
            *(uint2*)(Y + (size_t)tok * D + 512 + g * 64 + ch) = make_uint2(pk_bf16(y0, y1), pk_bf16(y2, y3));
        }
        ss += __shfl_xor(ss, 16); ss += __shfl_xor(ss, 32);
        if (fq == 0) ssb[(size_t)tok * 8 + g] = ss;
        __syncthreads();
    }
}

#define INS16(a, v) do { a[15] = med3i(a[14], a[15], v); a[14] = med3i(a[13], a[14], v); a[13] = med3i(a[12], a[13], v); a[12] = med3i(a[11], a[12], v); \
    a[11] = med3i(a[10], a[11], v); a[10] = med3i(a[9], a[10], v); a[9] = med3i(a[8], a[9], v); a[8] = med3i(a[7], a[8], v); a[7] = med3i(a[6], a[7], v); \
    a[6] = med3i(a[5], a[6], v); a[5] = med3i(a[4], a[5], v); a[4] = med3i(a[3], a[4], v); a[3] = med3i(a[2], a[3], v); a[2] = med3i(a[1], a[2], v); \
    a[1] = med3i(a[0], a[1], v); a[0] = max(a[0], v); } while (0)

template <int I, int J> struct CandLoop {
    static __device__ __forceinline__ void run(int (&a)[16], const float (&f1)[16], const float (&f2)[16]) {
        if constexpr ((I + 1) * (J + 1) <= 16) { const int key = (f2key(f1[I] + f2[J]) & ~255) | (I * 16 + J); INS16(a, key); }
        if constexpr (J + 1 < 16) CandLoop<I, J + 1>::run(a, f1, f2);
        else if constexpr (I + 1 < 16) CandLoop<I + 1, 0>::run(a, f1, f2);
    }
};

__device__ void phase_topk(const Params& p, int l, char* smem, int bid, int nb) {
    const int tid = otid(), lane = tid & 63, wid = tid >> 6, fr = lane & 15, fq = lane >> 4;
    float* S = (float*)smem;
    int* TT = (int*)(smem + 64 * 257 * 4);
    const bf16_t* Q = (const bf16_t*)(p.ws + OFF_Z);
    int* eidx = (int*)(p.ws + OFF_Y); float* gw = (float*)(p.ws + OFF_Y + (size_t)T * 128 * 4);
    for (int item = bid; item < (T / 64) * 8; item += nb) {
        const int h = item & 7, tok0 = (item >> 3) * 64;
        const bf16_t* K12 = (const bf16_t*)(p.ws + OFF_K12) + ((size_t)l * 8 + h) * 256 * 128;
        {
            const int half = wid >> 1;
            f32x4 acc[4][4];
#pragma unroll
            for (int i = 0; i < 4; ++i)
#pragma unroll
                for (int j = 0; j < 4; ++j) acc[i][j] = (f32x4){0.f, 0.f, 0.f, 0.f};
#pragma unroll
            for (int ks = 0; ks < 4; ++ks) {
                bf16x8 af[4], bfr[4];
#pragma unroll
                for (int i = 0; i < 4; ++i) af[i] = *(const bf16x8*)(Q + (size_t)(tok0 + i * 16 + fr) * 2048 + h * 256 + half * 128 + ks * 32 + fq * 8);
#pragma unroll
                for (int j = 0; j < 4; ++j) bfr[j] = *(const bf16x8*)(K12 + (size_t)((wid * 4 + j) * 16 + fr) * 128 + ks * 32 + fq * 8);
#pragma unroll
                for (int i = 0; i < 4; ++i)
#pragma unroll
                    for (int j = 0; j < 4; ++j) acc[i][j] = MFMA16(bfr[j], af[i], acc[i][j]);
            }
#pragma unroll
            for (int i = 0; i < 4; ++i)
#pragma unroll
                for (int j = 0; j < 4; ++j)
#pragma unroll
                    for (int e = 0; e < 4; ++e) S[(i * 16 + fr) * 257 + (wid * 4 + j) * 16 + fq * 4 + e] = acc[i][j][e];
        }
        __syncthreads();
        if (tid < 128) {
            const int tk = tid & 63, half = tid >> 6;
            int a[16];
#pragma unroll
            for (int i = 0; i < 16; ++i) a[i] = (int)0x80000000;
            const float* sr = S + tk * 257 + half * 128;
#pragma unroll 4
            for (int i = 0; i < 128; ++i) { const int key = (f2key(sr[i]) & ~127) | i; INS16(a, key); }
#pragma unroll
            for (int i = 0; i < 16; ++i) TT[(tk * 2 + half) * 16 + i] = a[i];
        }
        __syncthreads();
        if (tid < 64) {
            const int tk = tid;
            float f1[16], f2[16];
#pragma unroll
            for (int i = 0; i < 16; ++i) { f1[i] = key2f(TT[(tk * 2) * 16 + i] & ~127); f2[i] = key2f(TT[(tk * 2 + 1) * 16 + i] & ~127); }
            int a[16];
#pragma unroll
            for (int i = 0; i < 16; ++i) a[i] = (int)0x80000000;
            CandLoop<0, 0>::run(a, f1, f2);
            float sc[16], e[16], sum = 0.f; int ex[16];
#pragma unroll
            for (int i = 0; i < 16; ++i) {
                sc[i] = key2f(a[i] & ~255);
                const int code = a[i] & 255;
                const int e1 = TT[(tk * 2) * 16 + (code >> 4)] & 127, e2 = TT[(tk * 2 + 1) * 16 + (code & 15)] & 127;
                ex[i] = e1 * 128 + e2;
            }
#pragma unroll
            for (int i = 0; i < 16; ++i) { e[i] = __expf(sc[i] - sc[0]); sum += e[i]; }
            const float inv = 1.0f / sum;
            int4* ep = (int4*)(eidx + (size_t)(tok0 + tk) * 128 + h * 16); float4* gp = (float4*)(gw + (size_t)(tok0 + tk) * 128 + h * 16);
#pragma unroll
            for (int i = 0; i < 4; ++i) { ep[i] = make_int4(ex[4 * i], ex[4 * i + 1], ex[4 * i + 2], ex[4 * i + 3]); gp[i] = make_float4(e[4 * i] * inv, e[4 * i + 1] * inv, e[4 * i + 2] * inv, e[4 * i + 3] * inv); }
        }
        __syncthreads();
    }
}

__device__ __forceinline__ float dot16_fp8(const float (&h)[16], const int4& u) {
    const int w[4] = {u.x, u.y, u.z, u.w};
    f32x2_t a = {0.f, 0.f};
#pragma unroll
    for (int i = 0; i < 4; ++i) {
        const f32x2_t lo = __builtin_amdgcn_cvt_pk_f32_fp8(w[i], false), hi = __builtin_amdgcn_cvt_pk_f32_fp8(w[i], true);
        const f32x2_t h0 = {h[4 * i], h[4 * i + 1]}, h1 = {h[4 * i + 2], h[4 * i + 3]};
        a = __builtin_elementwise_fma(lo, h0, a); a = __builtin_elementwise_fma(hi, h1, a);
    }
    return a.x + a.y;
}
__device__ __forceinline__ void axpy16_fp8(float (&o)[16], float c, const int4& v) {
    const int w[4] = {v.x, v.y, v.z, v.w};
#pragma unroll
    for (int i = 0; i < 4; ++i) {
        const f32x2_t lo = __builtin_amdgcn_cvt_pk_f32_fp8(w[i], false), hi = __builtin_amdgcn_cvt_pk_f32_fp8(w[i], true);
        o[4 * i] += c * lo.x; o[4 * i + 1] += c * lo.y; o[4 * i + 2] += c * hi.x; o[4 * i + 3] += c * hi.y;
    }
}

__device__ void phase_pu(const Params& p, int l, int slice, int grank, int gsz) {
    const int tid_ = otid(); const int lane = tid_ & 63, wid = tid_ >> 6, sub = lane & 7, pg = lane >> 3;
    const bf16_t* H = (const bf16_t*)(p.ws + OFF_H);
    const char* U8 = p.ws + OFF_UB + ((size_t)(l * 8 + slice) * NE) * 128 + sub * 16;
    const int* eidx = (const int*)(p.ws + OFF_Y);
    float* part = (float*)(p.ws + OFF_Z) + (size_t)slice * T * 128;
#pragma nounroll
    for (int tok = grank * 4 + wid; tok < T; tok += gsz * 4) {
        __builtin_amdgcn_sched_barrier(0);
        const int ea = eidx[(size_t)tok * 128 + lane], eb = eidx[(size_t)tok * 128 + 64 + lane];
        float hf[16];
        {
            const bf16_t* hp = H + (size_t)tok * D + slice * 128 + sub * 16;
            const uint4 h0 = *(const uint4*)hp, h1 = *(const uint4*)(hp + 8);
            const unsigned w[8] = {h0.x, h0.y, h0.z, h0.w, h1.x, h1.y, h1.z, h1.w};
#pragma unroll
            for (int i = 0; i < 8; ++i) { hf[2 * i] = bf2f(w[i] & 0xffffu); hf[2 * i + 1] = bf2f(w[i] >> 16); }
        }
        int4 u[16];
#pragma unroll
        for (int q = 0; q < 16; ++q) { const int ej = __shfl(q < 8 ? ea : eb, (8 * q + pg) & 63); u[q] = *(const int4*)(U8 + (size_t)ej * 128); }
        __builtin_amdgcn_sched_barrier(0);
        float v[16];
#pragma unroll
        for (int q = 0; q < 16; ++q) v[q] = dot16_fp8(hf, u[q]);
        __builtin_amdgcn_sched_barrier(0);
        float w8[8], w4[4], w2[2];
        { const bool hi = (lane & 4) != 0;
#pragma unroll
          for (int m = 0; m < 8; ++m) { const float send = hi ? v[m] : v[m + 8], keep = hi ? v[m + 8] : v[m]; w8[m] = keep + __shfl_xor(send, 4); } }
        { const bool hi = (lane & 2) != 0;
#pragma unroll
          for (int m = 0; m < 4; ++m) { const float send = hi ? w8[m] : w8[m + 4], keep = hi ? w8[m + 4] : w8[m]; w4[m] = keep + __shfl_xor(send, 2); } }
        { const bool hi = (lane & 1) != 0;
#pragma unroll
          for (int m = 0; m < 2; ++m) { const float send = hi ? w4[m] : w4[m + 2], keep = hi ? w4[m + 2] : w4[m]; w2[m] = keep + __shfl_xor(send, 1); } }
        float* pr = part + (size_t)tok * 128 + 16 * sub + pg;
        pr[0] = w2[0]; pr[8] = w2[1];
    }
}
__device__ void phase_pc(const Params& p, int l, int bid, int nb) {
    const int tid_ = otid(); const int lane = tid_ & 63, wid = tid_ >> 6;
    const int* eidx = (const int*)(p.ws + OFF_Y); const float* gw = (const float*)(p.ws + OFF_Y + (size_t)T * 128 * 4);
    float* coef = (float*)(p.ws + OFF_Y + (size_t)T * 128 * 8);
    const float* part = (const float*)(p.ws + OFF_Z);
    const float* usc = (const float*)(p.ws + OFF_USC) + (size_t)l * NE; const float* vsc = (const float*)(p.ws + OFF_VSC) + (size_t)l * NE;
    for (int tok = bid * 4 + wid; tok < T; tok += nb * 4) {
#pragma unroll
        for (int hh = 0; hh < 2; ++hh) {
            const size_t j = (size_t)tok * 128 + hh * 64 + lane;
            const int e = eidx[j]; const float g = gw[j];
            float a = 0.f;
#pragma unroll
            for (int sl = 0; sl < 8; ++sl) a += part[(size_t)sl * T * 128 + j];
            coef[j] = g * gelu_f(a * usc[e]) * vsc[e];
        }
    }
}
__device__ void phase_pv(const Params& p, int l, int slice, int grank, int gsz) {
    const int tid_ = otid(); const int lane = tid_ & 63, wid = tid_ >> 6, sub = lane & 7, pg = lane >> 3;
    const char* V8 = p.ws + OFF_VB + ((size_t)(l * 8 + slice) * NE) * 128 + sub * 16;
    const int* eidx = (const int*)(p.ws + OFF_Y);
    const float* coef = (const float*)(p.ws + OFF_Y + (size_t)T * 128 * 8);
    const float* mod = (const float*)(p.ws + OFF_MOD) + (size_t)l * NB * 6144;
    const int col = slice * 128 + 16 * sub + 2 * pg;
#pragma nounroll
    for (int tok = grank * 4 + wid; tok < T; tok += gsz * 4) {
        __builtin_amdgcn_sched_barrier(0);
        const int b = tok / SEQ;
        const int ea = eidx[(size_t)tok * 128 + lane], eb = eidx[(size_t)tok * 128 + 64 + lane];
        const float ca = coef[(size_t)tok * 128 + lane], cb = coef[(size_t)tok * 128 + 64 + lane];
        int4 v[16]; float cj[16];
#pragma unroll
        for (int q = 0; q < 16; ++q) { const int src = (8 * q + pg) & 63; const int ej = __shfl(q < 8 ? ea : eb, src); cj[q] = __shfl(q < 8 ? ca : cb, src); v[q] = *(const int4*)(V8 + (size_t)ej * 128); }
        __builtin_amdgcn_sched_barrier(0);
        float o[16];
#pragma unroll
        for (int i = 0; i < 16; ++i) o[i] = 0.f;
#pragma unroll
        for (int q = 0; q < 16; ++q) axpy16_fp8(o, cj[q], v[q]);
        __builtin_amdgcn_sched_barrier(0);
        float t8[8], t4[4], t2[2];
        { const bool hi = (lane & 32) != 0;
#pragma unroll
          for (int m = 0; m < 8; ++m) { const float send = hi ? o[m] : o[m + 8], keep = hi ? o[m + 8] : o[m]; t8[m] = keep + __shfl_xor(send, 32); } }
        { const bool hi = (lane & 16) != 0;
#pragma unroll
          for (int m = 0; m < 4; ++m) { const float send = hi ? t8[m] : t8[m + 4], keep = hi ? t8[m + 4] : t8[m]; t4[m] = keep + __shfl_xor(send, 16); } }
        { const bool hi = (lane & 8) != 0;
#pragma unroll
          for (int m = 0; m < 2; ++m) { const float send = hi ? t4[m] : t4[m + 2], keep = hi ? t4[m + 2] : t4[m]; t2[m] = keep + __shfl_xor(send, 8); } }
        float2* xp = (float2*)(p.out + (size_t)tok * D + col);
        const float2 g2 = *(const float2*)(mod + (size_t)b * 6144 + 5 * D + col);
        float2 xv = *xp; xv.x += g2.x * t2[0]; xv.y += g2.y * t2[1]; *xp = xv;
    }
}
__device__ void phase_final_norm(const Params& p, int bid, int nb) {
    const int tid_ = otid(); const int lane = tid_ & 63, wid = tid_ >> 6;
    for (int tok = bid * 4 + wid; tok < T; tok += nb * 4) {
        float* xr = p.out + (size_t)tok * D;
        float4 v[4]; float ss = 0.f;
#pragma unroll
        for (int i = 0; i < 4; ++i) { v[i] = *(const float4*)(xr + i * 256 + lane * 4); ss += v[i].x * v[i].x + v[i].y * v[i].y + v[i].z * v[i].z + v[i].w * v[i].w; }
        ss = wave_sum(ss);
        const float rstd = rsqrtf(ss * (1.0f / D) + EPS);
#pragma unroll
        for (int i = 0; i < 4; ++i) { const float4 g = *(const float4*)(p.final_g + i * 256 + lane * 4);
            *(float4*)(xr + i * 256 + lane * 4) = make_float4(v[i].x * rstd * g.x, v[i].y * rstd * g.y, v[i].z * rstd * g.z, v[i].w * rstd * g.w); }
    }
}

#define XB_TMO      128
#define XB_XCNT(j)  (256  + 64 * (j))
#define XB_XSUB(j)  (1280 + 64 * (j))
#define XB_XGEN(j)  (2304 + 64 * (j))
#define XB_TOP      3328
#define XB_TOPGEN   3392
#define XCD_BAR_WORDS 3456
#define XB_SPIN_CAP (1u << 22)
__device__ __forceinline__ unsigned xb_ld(unsigned* p)              { return __hip_atomic_load(p, __ATOMIC_RELAXED, __HIP_MEMORY_SCOPE_AGENT); }
__device__ __forceinline__ unsigned xb_add(unsigned* p, unsigned v) { return __hip_atomic_fetch_add(p, v, __ATOMIC_RELAXED, __HIP_MEMORY_SCOPE_AGENT); }
__device__ __forceinline__ unsigned xb_xcc_id() { return (unsigned)__builtin_amdgcn_s_getreg((3 << 11) | 20) & 0xFu; }
#define XB_SPIN(cond, bar) do { unsigned _sp = 0; while (cond) { __builtin_amdgcn_s_sleep(1); \
    if ((++_sp & 255u) == 0u) { if (xb_ld(&(bar)[XB_TMO])) break; if (_sp > XB_SPIN_CAP) { atomicAdd(&(bar)[XB_TMO], 1u); break; } } } } while (0)
__device__ __forceinline__ void xcd_barrier_post(unsigned* bar, volatile LAS unsigned* st) {
    if (threadIdx.x == 0) { const unsigned x = xb_xcc_id(); st[3] = x; st[2] = xb_add(&bar[XB_XCNT(x)], 1u); }
}
__device__ __forceinline__ void xcd_barrier_complete(unsigned* bar, unsigned x, unsigned& nloc, unsigned& nx) {
    const unsigned G = gridDim.x * gridDim.y * gridDim.z;
    unsigned sum, cnt, mine, sp = 0u;
    for (;;) {
        sum = 0u; cnt = 0u; mine = 0u;
#pragma unroll
        for (unsigned j = 0; j < 16; ++j) { const unsigned c = xb_ld(&bar[XB_XCNT(j)]); sum += c; cnt += (c > 0u) ? 1u : 0u; mine = (j == x) ? c : mine; }
        if (sum == G) break;
        __builtin_amdgcn_s_sleep(1);
        if ((++sp & 255u) == 0u) { if (xb_ld(&bar[XB_TMO])) break; if (sp > XB_SPIN_CAP) { atomicAdd(&bar[XB_TMO], 1u); break; } }
    }
    nloc = mine > 0u ? mine : 1u; nx = cnt > 0u ? cnt : 1u;
}
__device__ __forceinline__ void xcd_barrier(unsigned* bar, volatile LAS unsigned* st) {
    asm volatile("s_waitcnt vmcnt(0)" ::: "memory");
    __syncthreads();
    if (threadIdx.x == 0) {
        __builtin_amdgcn_s_waitcnt(0);
        unsigned nloc = st[0], nx = st[1]; const unsigned x = st[3];
        if (nloc == 0u) { xcd_barrier_complete(bar, x, nloc, nx); st[0] = nloc; st[1] = nx; }
        const unsigned old = xb_add(&bar[XB_XSUB(x)], 1u);
        const unsigned gen = old / nloc;
        if (old + 1u == (gen + 1u) * nloc) {
            __builtin_amdgcn_fence(__ATOMIC_RELEASE, "agent");
            asm volatile("s_waitcnt vmcnt(0)" ::: "memory");
            const unsigned og = xb_add(&bar[XB_TOP], 1u);
            const unsigned tg = og / nx;
            if (og + 1u == (tg + 1u) * nx) xb_add(&bar[XB_TOPGEN], 1u);
            else XB_SPIN(xb_ld(&bar[XB_TOPGEN]) == tg, bar);
            __builtin_amdgcn_fence(__ATOMIC_ACQUIRE, "agent");
            xb_add(&bar[XB_XGEN(x)], 1u);
            asm volatile("s_waitcnt vmcnt(0)" ::: "memory");
        } else {
            XB_SPIN(xb_ld(&bar[XB_XGEN(x)]) == gen, bar);
            __builtin_amdgcn_fence(__ATOMIC_ACQUIRE, "agent");
            asm volatile("s_waitcnt vmcnt(0)" ::: "memory");
        }
    }
    __syncthreads();
}

#if MEGA
#if PROBE_A >= 0
#define TSTAMP(i) do { if (blockIdx.x == 0 && threadIdx.x == 0) ts[i] = __builtin_amdgcn_s_memrealtime(); } while (0)
#else
#define TSTAMP(i) do { } while (0)
#endif
__global__ void __launch_bounds__(256, 2) mega_kernel(Params p) {
    __shared__ __attribute__((aligned(16))) char smem[SMEM_BYTES];
    __shared__ uint4 xb_words;
#if PROBE_A >= 0
    __shared__ unsigned long long ts[26];
#endif
    cg::grid_group grid = cg::this_grid();
    const int bid = blockIdx.x, nb = gridDim.x;
    unsigned* bar = (unsigned*)(p.ws + OFF_BAR);
    if (threadIdx.x == 0) xb_words = make_uint4(0u, 0u, 0u, 0u);
    if (bid == 0) for (int i = threadIdx.x; i < XCD_BAR_WORDS; i += 256) bar[i] = 0u;
    TSTAMP(0);
    phase_prep(p, smem, bid, nb);
    grid.sync();
    volatile LAS unsigned* xst = (volatile LAS unsigned*)&xb_words;
    xcd_barrier_post(bar, xst);
    TSTAMP(1);
    phase_norm(p.x, p.norm1_g, (const float*)(p.ws + OFF_MOD), 0, D, (bf16_t*)(p.ws + OFF_H), bid, nb); xcd_barrier((unsigned*)(p.ws + OFF_BAR), (volatile LAS unsigned*)&xb_words);
    int slice, grank; const int gsz = nb / 8;
    {
        const unsigned myx = xst[3], myrank = xst[2];
        unsigned pre = 0;
#pragma unroll
        for (unsigned j = 0; j < 16; ++j) { const unsigned c = xb_ld(&bar[XB_XCNT(j)]); pre += (j < myx) ? c : 0u; }
        const int gi = __builtin_amdgcn_readfirstlane((int)(pre + myrank));
        slice = gi / gsz; grank = gi % gsz;
    }
#pragma nounroll
    for (int l = 0; l < NL; ++l) {
        TSTAMP(2 + 11 * l); phase_gemm1(p, l, smem, bid, nb); xcd_barrier((unsigned*)(p.ws + OFF_BAR), (volatile LAS unsigned*)&xb_words);
        TSTAMP(3 + 11 * l); phase_mix(p, l, smem, bid, nb); xcd_barrier((unsigned*)(p.ws + OFF_BAR), (volatile LAS unsigned*)&xb_words);
        TSTAMP(4 + 11 * l); phase_fftb(p, l, smem, bid, nb); xcd_barrier((unsigned*)(p.ws + OFF_BAR), (volatile LAS unsigned*)&xb_words);
        TSTAMP(5 + 11 * l); phase_gemm2(p, l, smem, bid, nb); xcd_barrier((unsigned*)(p.ws + OFF_BAR), (volatile LAS unsigned*)&xb_words);
        TSTAMP(6 + 11 * l); phase_norm(p.out, p.norm2_g + l * D, (const float*)(p.ws + OFF_MOD) + (size_t)l * NB * 6144, 3 * D, 4 * D, (bf16_t*)(p.ws + OFF_H), bid, nb); xcd_barrier((unsigned*)(p.ws + OFF_BAR), (volatile LAS unsigned*)&xb_words);
        TSTAMP(7 + 11 * l); phase_gemm3(p, l, smem, bid, nb); xcd_barrier((unsigned*)(p.ws + OFF_BAR), (volatile LAS unsigned*)&xb_words);
        TSTAMP(8 + 11 * l); phase_topk(p, l, smem, bid, nb); xcd_barrier((unsigned*)(p.ws + OFF_BAR), (volatile LAS unsigned*)&xb_words);
        TSTAMP(9 + 11 * l); phase_pu(p, l, slice, grank, gsz); xcd_barrier((unsigned*)(p.ws + OFF_BAR), (volatile LAS unsigned*)&xb_words);
        TSTAMP(10 + 11 * l); phase_pc(p, l, bid, nb); xcd_barrier((unsigned*)(p.ws + OFF_BAR), (volatile LAS unsigned*)&xb_words);
        TSTAMP(11 + 11 * l); phase_pv(p, l, slice, grank, gsz); xcd_barrier((unsigned*)(p.ws + OFF_BAR), (volatile LAS unsigned*)&xb_words);
        TSTAMP(12 + 11 * l);
        if (l + 1 < NL) { phase_norm(p.out, p.norm1_g + (l + 1) * D, (const float*)(p.ws + OFF_MOD) + (size_t)(l + 1) * NB * 6144, 0, D, (bf16_t*)(p.ws + OFF_H), bid, nb); xcd_barrier((unsigned*)(p.ws + OFF_BAR), (volatile LAS unsigned*)&xb_words); }
        else phase_final_norm(p, bid, nb);
    }
    TSTAMP(24);
#if PROBE_A >= 0
    if (bid == 0 && threadIdx.x == 0) p.out[0] += (float)(ts[PROBE_B] - ts[PROBE_A]) * 0.01f / PROBE_DIV;
#endif
}
#endif

extern "C" void kernel_launch(void* const* d_in, const int* in_sizes, int n_in, void* d_out, int out_size, void* d_ws, size_t ws_size, hipStream_t stream) {
    (void)in_sizes; (void)n_in; (void)out_size;
    if (ws_size < OFF_END) { fprintf(stderr, "workspace too small: %zu < %zu\n", ws_size, (size_t)OFF_END); return; }
    Params p{};
    p.x = (const float*)d_in[0]; p.c = (const float*)d_in[1]; p.mod_w = (const float*)d_in[2]; p.mod_b = (const float*)d_in[3]; p.norm1_g = (const float*)d_in[4];
    p.w_in = (const float*)d_in[5]; p.gmlp_ws = (const float*)d_in[6]; p.gmlp_bs = (const float*)d_in[7]; p.fnet_w = (const float*)d_in[8]; p.fnet_b = (const float*)d_in[9];
    p.gain_a = (const float*)d_in[10]; p.gain_b = (const float*)d_in[11]; p.w_out = (const float*)d_in[12]; p.norm2_g = (const float*)d_in[13]; p.wq = (const float*)d_in[14];
    p.k1 = (const float*)d_in[15]; p.k2 = (const float*)d_in[16]; p.pu = (const float*)d_in[17]; p.pv = (const float*)d_in[18]; p.final_g = (const float*)d_in[19];
    p.out = (float*)d_out; p.ws = (char*)d_ws;
#if MEGA
    static int grid_blocks = 0;
    if (!grid_blocks) {
        int dev = 0, cus = 0, per_cu = 0;
        hipGetDevice(&dev);
        hipDeviceGetAttribute(&cus, hipDeviceAttributeMultiprocessorCount, dev);
        hipOccupancyMaxActiveBlocksPerMultiprocessor(&per_cu, mega_kernel, 256, 0);
        if (per_cu > 2) per_cu = 2;
        grid_blocks = (cus * per_cu) / 8 * 8;
    }
    void* args[] = {&p};
    hipError_t e = hipLaunchCooperativeKernel((void*)mega_kernel, dim3(grid_blocks), dim3(256), args, 0, stream);
    if (e != hipSuccess) fprintf(stderr, "cooperative launch failed: %s (grid %d)\n", hipGetErrorString(e), grid_blocks);
#endif
}
```

```cpp
#include <hip/hip_runtime.h>
#include <hip/hip_cooperative_groups.h>
#include <cstdio>
#include <cstdint>
namespace cg = cooperative_groups;

#ifndef MEGA
#define MEGA 1
#endif
#ifndef PROBE_A
#define PROBE_A -1
#define PROBE_B 0
#define PROBE_DIV 10.0f
#endif

typedef unsigned short bf16_t;
typedef short bf16x8 __attribute__((ext_vector_type(8)));
typedef float f32x4 __attribute__((ext_vector_type(4)));
typedef __bf16 bf16x2_t __attribute__((ext_vector_type(2)));

constexpr int D = 1024, NB = 8, SEQ = 4096, T = NB * SEQ, NL = 2;
constexpr int NZ = 2048;
constexpr int NE = 16384;
constexpr float EPS = 1e-6f;

constexpr size_t OFF_MOD  = 0;
constexpr size_t OFF_W1T  = OFF_MOD  + (size_t)NL * NB * 6144 * 4;
constexpr size_t OFF_W2T  = OFF_W1T  + (size_t)NL * 2048 * 1024 * 2;
constexpr size_t OFF_WQT  = OFF_W2T  + (size_t)NL * 1024 * 1024 * 2;
constexpr size_t OFF_K12  = OFF_WQT  + (size_t)NL * 2048 * 1024 * 2;
constexpr size_t OFF_WSB  = OFF_K12  + (size_t)NL * 8 * 256 * 128 * 2;
constexpr size_t OFF_DA   = OFF_WSB  + (size_t)NL * 8 * 128 * 128 * 2;
constexpr size_t OFF_DB   = OFF_DA   + 128 * 128 * 2;
constexpr size_t OFF_TW   = OFF_DB   + 64 * 128 * 2;
constexpr size_t OFF_SSQA = OFF_TW   + 64 * 64 * 8;
constexpr size_t OFF_SSQB = OFF_SSQA + (size_t)T * 8 * 4;
constexpr size_t OFF_UB   = OFF_SSQB + (size_t)T * 8 * 4;
constexpr size_t OFF_VB   = OFF_UB   + (size_t)NL * NE * 1024;
constexpr size_t OFF_USC  = OFF_VB   + (size_t)NL * NE * 1024;
constexpr size_t OFF_VSC  = OFF_USC  + (size_t)NL * NE * 4;
constexpr size_t OFF_H    = OFF_VSC  + (size_t)NL * NE * 4;
constexpr size_t OFF_Z    = OFF_H    + (size_t)T * 1024 * 2;
constexpr size_t OFF_Y    = OFF_Z    + (size_t)T * 2048 * 2;
constexpr size_t OFF_BAR  = OFF_Y    + (size_t)T * 1024 * 2;
constexpr size_t OFF_END  = OFF_BAR  + 16384;

struct Params {
    const float* x; const float* c; const float* mod_w; const float* mod_b; const float* norm1_g; const float* w_in;
    const float* gmlp_ws; const float* gmlp_bs; const float* fnet_w; const float* fnet_b; const float* gain_a; const float* gain_b;
    const float* w_out; const float* norm2_g; const float* wq; const float* k1; const float* k2; const float* pu; const float* pv; const float* final_g;
    float* out; char* ws;
};

constexpr int SMEM_BYTES = 73984;

__device__ __forceinline__ float bf2f(unsigned v) { return __uint_as_float(v << 16); }
typedef float f32x2_t __attribute__((ext_vector_type(2)));
__device__ __forceinline__ unsigned pk_bf16(float lo, float hi) { const f32x2_t v = {lo, hi}; return __builtin_bit_cast(unsigned, __builtin_convertvector(v, bf16x2_t)); }
__device__ __forceinline__ bf16_t f2bf(float f) { return (bf16_t)(pk_bf16(f, 0.f) & 0xffffu); }
__device__ __forceinline__ float gelu_f(float v) {
    const float t = __builtin_amdgcn_rcpf(fabsf(v) * 0.2316418882f + 1.0f);
    float q = t * 0.5307027145f + (-0.7265760135f); q = q * t + 0.7107068705f; q = q * t + (-0.142248368f); q = q * t + 0.127414796f; q = q * t;
    const float m = v * (q * __builtin_amdgcn_exp2f(v * v * (-0.72134752044f)));
    return v < 0.f ? m : v - m;
}
__device__ __forceinline__ int med3i(int a, int b, int c) { return max(min(a, b), min(max(a, b), c)); }
__device__ __forceinline__ int f2key(float f) { int b = __float_as_int(f); return b ^ ((b >> 31) & 0x7fffffff); }
__device__ __forceinline__ float key2f(int k) { return __int_as_float(k ^ ((k >> 31) & 0x7fffffff)); }
__device__ __forceinline__ float wave_sum(float v) {
#pragma unroll
    for (int o = 32; o >= 1; o >>= 1) v += __shfl_xor(v, o);
    return v;
}
__device__ __forceinline__ int otid() { int t = threadIdx.x; asm volatile("" : "+v"(t)); return t; }
#define MFMA16(a, b, c) __builtin_amdgcn_mfma_f32_16x16x32_bf16((a), (b), (c), 0, 0, 0)

__device__ void transpose_tile(const float* __restrict__ src, int ld, int k0, int n0, bf16_t* __restrict__ dst  , int dn0,
                               const float* __restrict__ kscale, float* tile  ) {
    const int tid = otid();
#pragma unroll
    for (int i = 0; i < 4; ++i) {
        const int r = (tid >> 4) + 16 * i, c4 = (tid & 15) * 4;
        const float4 v = *(const float4*)(src + (size_t)(k0 + r) * ld + n0 + c4);
        const float s = kscale ? kscale[k0 + r] : 1.0f;
        tile[r * 65 + c4 + 0] = v.x * s; tile[r * 65 + c4 + 1] = v.y * s; tile[r * 65 + c4 + 2] = v.z * s; tile[r * 65 + c4 + 3] = v.w * s;
    }
    __syncthreads();
    {
        const int n = tid >> 2, ks = (tid & 3) * 16;
        unsigned w[8];
#pragma unroll
        for (int j = 0; j < 8; ++j) w[j] = pk_bf16(tile[(ks + 2 * j) * 65 + n], tile[(ks + 2 * j + 1) * 65 + n]);
        uint4* d = (uint4*)(dst + (size_t)(dn0 + n) * 1024 + k0 + ks);
        d[0] = make_uint4(w[0], w[1], w[2], w[3]); d[1] = make_uint4(w[4], w[5], w[6], w[7]);
    }
    __syncthreads();
}

__device__ void phase_prep(const Params& p, char* smem, int bid, int nb) {
    const int tid = otid();
    const int gtid = bid * 256 + tid, gsz = nb * 256;
    char* ws = p.ws;
    {
        float* sc = (float*)smem;
        float* red = (float*)(smem + 32768);
        for (int i = tid; i < 8192; i += 256) { const float v = p.c[i]; sc[i] = v / (1.0f + __expf(-v)); }
        __syncthreads();
        float* mod = (float*)(ws + OFF_MOD);
        for (int item = bid; item < NL * 192; item += nb) {
            const int l = item / 192, n0 = (item % 192) * 32, nn = tid & 31, kq = tid >> 5;
            float acc[8];
#pragma unroll
            for (int b = 0; b < 8; ++b) acc[b] = 0.f;
            const float* W = p.mod_w + (size_t)l * 1024 * 6144 + n0 + nn;
            for (int k = kq; k < 1024; k += 8) {
                const float w = W[(size_t)k * 6144];
#pragma unroll
                for (int b = 0; b < 8; ++b) acc[b] += sc[b * 1024 + k] * w;
            }
#pragma unroll
            for (int b = 0; b < 8; ++b) red[(kq * 8 + b) * 32 + nn] = acc[b];
            __syncthreads();
            {
                const int b = tid >> 5;
                float s = 0.f;
#pragma unroll
                for (int q = 0; q < 8; ++q) s += red[(q * 8 + b) * 32 + nn];
                mod[((size_t)l * NB + b) * 6144 + n0 + nn] = s + p.mod_b[l * 6144 + n0 + nn];
            }
            __syncthreads();
        }
    }
    {
        float* tile = (float*)smem;
        for (int item = bid; item < NL * 1024; item += nb) {
            const int l = item / 1024, r = item % 1024;
            if (r < 256) {
                const int kt = r / 16, nt = r % 16;
                transpose_tile(p.w_in + (size_t)l * 1024 * 1536, 1536, kt * 64, nt * 64, (bf16_t*)(ws + OFF_W1T) + (size_t)l * 2048 * 1024, nt * 64, nullptr, tile);
            } else if (r < 512) {
                const int rr = r - 256, kt = rr / 16, nt = rr % 16;
                const float* gk = (kt < 8) ? (p.gain_a + l * 512) : (p.gain_b + l * 512 - 512);
                transpose_tile(p.w_out + (size_t)l * 1024 * 1024, 1024, kt * 64, nt * 64, (bf16_t*)(ws + OFF_W2T) + (size_t)l * 1024 * 1024, nt * 64, gk, tile);
            } else {
                const int rr = r - 512, kt = rr / 32, nt = rr % 32;
                transpose_tile(p.wq + (size_t)l * 1024 * 2048, 2048, kt * 64, nt * 64, (bf16_t*)(ws + OFF_WQT) + (size_t)l * 2048 * 1024, nt * 64, nullptr, tile);
            }
        }
    }
    {
        float* fws = (float*)smem;
        float* Ms  = (float*)(smem + 16384);
        float* wt  = (float*)(smem + 49152);
        float* cs  = (float*)(smem + 49152 + 16640);
        for (int item = bid; item < NL * 8 * 16; item += nb) {
            const int l = item / 128, g = (item % 128) / 16, kt = item % 16;
            if (tid < 64) { float s, c; sincospif((float)tid / 32.0f, &s, &c); cs[tid] = c; cs[64 + tid] = s; }
            for (int i = tid; i < 4096; i += 256) fws[i] = p.fnet_w[((size_t)l * 8 + g) * 4096 + i];
#pragma unroll
            for (int i = 0; i < 4; ++i) {
                const int r = (tid >> 4) + 16 * i, c4 = (tid & 15) * 4;
                const float4 v = *(const float4*)(p.w_in + (size_t)l * 1024 * 1536 + (size_t)(kt * 64 + r) * 1536 + 1024 + g * 64 + c4);
                wt[r * 65 + c4] = v.x; wt[r * 65 + c4 + 1] = v.y; wt[r * 65 + c4 + 2] = v.z; wt[r * 65 + c4 + 3] = v.w;
            }
            __syncthreads();
            {
                const int d = tid >> 2, r0 = (tid & 3) * 32;
                const bool im = r0 >= 64; const int e0 = r0 & 63;
                float acc[32];
#pragma unroll
                for (int e = 0; e < 32; ++e) acc[e] = 0.f;
                for (int j = 0; j < 64; ++j) {
                    const int ph = (d * j) & 63;
                    const float t = im ? -cs[64 + ph] : cs[ph];
#pragma unroll
                    for (int e = 0; e < 32; ++e) acc[e] += t * fws[j * 64 + e0 + e];
                }
#pragma unroll
                for (int e = 0; e < 32; ++e) Ms[d * 128 + r0 + e] = acc[e];
            }
            __syncthreads();
            {
                const int r = tid >> 1, kk0 = (tid & 1) * 32;
                float acc[32];
#pragma unroll
                for (int k = 0; k < 32; ++k) acc[k] = 0.f;
                for (int d = 0; d < 64; ++d) {
                    const float m = Ms[d * 128 + r];
#pragma unroll
                    for (int k = 0; k < 32; ++k) acc[k] += wt[(kk0 + k) * 65 + d] * m;
                }
                bf16_t* dst = (bf16_t*)(ws + OFF_W1T) + (size_t)l * 2048 * 1024 + (size_t)(1024 + g * 128 + r) * 1024 + kt * 64 + kk0;
#pragma unroll
                for (int q = 0; q < 4; ++q)
                    ((uint4*)dst)[q] = make_uint4(pk_bf16(acc[q * 8], acc[q * 8 + 1]), pk_bf16(acc[q * 8 + 2], acc[q * 8 + 3]), pk_bf16(acc[q * 8 + 4], acc[q * 8 + 5]), pk_bf16(acc[q * 8 + 6], acc[q * 8 + 7]));
            }
            __syncthreads();
        }
    }
    {
        bf16_t* k12 = (bf16_t*)(ws + OFF_K12);
        for (int i = gtid; i < NL * 8 * 256 * 128; i += gsz) {
            const int d = i & 127, n = (i >> 7) & 255, h = (i >> 15) & 7, l = i >> 18;
            const float* src = (n < 128) ? p.k1 : p.k2;
            k12[i] = f2bf(src[(((size_t)l * 8 + h) * 128 + (n & 127)) * 128 + d]);
        }
        bf16_t* wsb = (bf16_t*)(ws + OFF_WSB);
        for (int i = gtid; i < NL * 8 * 128 * 128; i += gsz) wsb[i] = f2bf(p.gmlp_ws[i]);
        bf16_t* DA = (bf16_t*)(ws + OFF_DA);
        for (int i = gtid; i < 128 * 128; i += gsz) {
            const int m = i >> 7, kk = i & 127, ro = m >> 6, k1 = m & 63, ri = kk >> 6, a = kk & 63;
            float s, c; sincospif((float)((a * k1) & 63) / 32.0f, &s, &c);
            const float v = (ro == ri) ? c : (ro == 0 ? s : -s);
            DA[i] = f2bf(v);
        }
        bf16_t* DB = (bf16_t*)(ws + OFF_DB);
        for (int i = gtid; i < 64 * 128; i += gsz) {
            const int k2 = i >> 7, kk = i & 127, ri = kk >> 6, b = kk & 63;
            float s, c; sincospif((float)((b * k2) & 63) / 32.0f, &s, &c);
            DB[i] = f2bf(ri ? s : c);
        }
        float2* tw = (float2*)(ws + OFF_TW);
        for (int i = gtid; i < 64 * 64; i += gsz) {
            const int bp = i >> 6, k1 = i & 63;
            float s, c; sincospif((float)(bp * k1) / 2048.0f, &s, &c);
            tw[i] = make_float2(c, s);
        }
        {
            const int lane = tid & 63, wv = gtid >> 6, nwv = gsz >> 6;
            for (int r = wv; r < 2 * NL * NE; r += nwv) {
                const int tbl = r / (NL * NE), row = r % (NL * NE);
                const float* src = (tbl ? p.pv : p.pu) + (size_t)row * 1024 + lane * 16;
                float4 v[4]; float m = 0.f;
#pragma unroll
                for (int i = 0; i < 4; ++i) { v[i] = ((const float4*)src)[i]; m = fmaxf(m, fmaxf(fmaxf(fabsf(v[i].x), fabsf(v[i].y)), fmaxf(fabsf(v[i].z), fabsf(v[i].w)))); }
#pragma unroll
                for (int o = 32; o >= 1; o >>= 1) m = fmaxf(m, __shfl_xor(m, o));
                const float sc = (m > 0.f) ? 256.0f / m : 1.0f, inv = (m > 0.f) ? m * (1.0f / 256.0f) : 1.0f;
                int w[4];
#pragma unroll
                for (int i = 0; i < 4; ++i) { w[i] = __builtin_amdgcn_cvt_pk_fp8_f32(v[i].x * sc, v[i].y * sc, 0, false); w[i] = __builtin_amdgcn_cvt_pk_fp8_f32(v[i].z * sc, v[i].w * sc, w[i], true); }
                {
                    const int lyr = row / NE, ex = row % NE;
                    *(int4*)(ws + (tbl ? OFF_VB : OFF_UB) + ((size_t)(lyr * 8 + (lane >> 3)) * NE + ex) * 128 + (lane & 7) * 16) = make_int4(w[0], w[1], w[2], w[3]);
                }
                if (lane == 0) ((float*)(ws + (tbl ? OFF_VSC : OFF_USC)))[row] = inv;
            }
        }
    }
}

__device__ void phase_norm(const float* __restrict__ xsrc, const float* __restrict__ g, const float* __restrict__ modl  , int sh_off, int scl_off,
                           bf16_t* __restrict__ hout, int bid, int nb) {
    const int tid_ = otid(); const int lane = tid_ & 63, wid = tid_ >> 6;
    for (int tok = bid * 4 + wid; tok < T; tok += nb * 4) {
        const int b = tok / SEQ;
        const float* xr = xsrc + (size_t)tok * D;
        float4 v[4];
        float ss = 0.f;
#pragma unroll
        for (int i = 0; i < 4; ++i) { v[i] = *(const float4*)(xr + i * 256 + lane * 4); ss += v[i].x * v[i].x + v[i].y * v[i].y + v[i].z * v[i].z + v[i].w * v[i].w; }
        ss = wave_sum(ss);
        const float rstd = rsqrtf(ss * (1.0f / D) + EPS);
        const float* mb = modl + (size_t)b * 6144;
#pragma unroll
        for (int i = 0; i < 4; ++i) {
            const int cidx = i * 256 + lane * 4;
            const float4 gg = *(const float4*)(g + cidx), sh = *(const float4*)(mb + sh_off + cidx), sc = *(const float4*)(mb + scl_off + cidx);
            const float o0 = v[i].x * rstd * gg.x * (1.0f + sc.x) + sh.x, o1 = v[i].y * rstd * gg.y * (1.0f + sc.y) + sh.y;
            const float o2 = v[i].z * rstd * gg.z * (1.0f + sc.z) + sh.z, o3 = v[i].w * rstd * gg.w * (1.0f + sc.w) + sh.w;
            *(uint2*)(hout + (size_t)tok * D + cidx) = make_uint2(pk_bf16(o0, o1), pk_bf16(o2, o3));
        }
    }
}

#define LAS __attribute__((address_space(3)))
template <class Epi, class MidK>
__device__ __forceinline__ void gemm_tile(const bf16_t* __restrict__ A, int lda, const bf16_t* __restrict__ Bt, int ldb, int K, int m0, int n0,
                                          char* smem, const Epi& epi, const MidK& midk, int kmid) {
    const int tid = otid(), lane = tid & 63, wid = tid >> 6, wr = wid >> 1, wc = wid & 1, fr = lane & 15, fq = lane >> 4;
    LAS char* lds = (LAS char*)smem;
    f32x4 acc[4][4];
#pragma unroll
    for (int i = 0; i < 4; ++i)
#pragma unroll
        for (int j = 0; j < 4; ++j) acc[i][j] = (f32x4){0.f, 0.f, 0.f, 0.f};
    const int prow = lane >> 3, pch = (lane & 7) ^ prow;
    const bf16_t* ga = A + (size_t)(m0 + wid * 32 + prow) * lda + pch * 8;
    const bf16_t* gb = Bt + (size_t)(n0 + wid * 32 + prow) * ldb + pch * 8;
    const int nk = K / 64;
#define GEMM_STAGE(kt_, buf_) do { _Pragma("unroll") for (int i_ = 0; i_ < 4; ++i_) { \
        __builtin_amdgcn_global_load_lds((const unsigned*)(ga + (size_t)(i_ * 8) * lda + (kt_) * 64), (LAS unsigned*)(lds + (buf_) * 16384 + (wid * 32 + i_ * 8) * 128), 16, 0, 0); \
        __builtin_amdgcn_global_load_lds((const unsigned*)(gb + (size_t)(i_ * 8) * ldb + (kt_) * 64), (LAS unsigned*)(lds + 32768 + (buf_) * 16384 + (wid * 32 + i_ * 8) * 128), 16, 0, 0); } } while (0)
    GEMM_STAGE(0, 0);
    const int swz = fr & 7;
    for (int kt = 0; kt < nk; ++kt) {
        const int cur = kt & 1;
        asm volatile("s_waitcnt vmcnt(0)" ::: "memory");
        __syncthreads();
        if (kt + 1 < nk) GEMM_STAGE(kt + 1, cur ^ 1);
        if (kt == kmid) {
#pragma unroll
            for (int i = 0; i < 4; ++i) { const float sc = midk(m0 + wr * 64 + i * 16 + fr);
#pragma unroll
                for (int j = 0; j < 4; ++j) acc[i][j] *= sc; }
        }
        const LAS char* ca = lds + cur * 16384; const LAS char* cb = lds + 32768 + cur * 16384;
#pragma unroll
        for (int ks = 0; ks < 2; ++ks) {
            bf16x8 af[4], bfr[4];
            const int coff = ((ks * 4 + fq) ^ swz) * 16;
#pragma unroll
            for (int i = 0; i < 4; ++i) af[i] = *(const LAS bf16x8*)(ca + (wr * 64 + i * 16 + fr) * 128 + coff);
#pragma unroll
            for (int j = 0; j < 4; ++j) bfr[j] = *(const LAS bf16x8*)(cb + (wc * 64 + j * 16 + fr) * 128 + coff);
#pragma unroll
            for (int i = 0; i < 4; ++i)
#pragma unroll
                for (int j = 0; j < 4; ++j) acc[i][j] = MFMA16(bfr[j], af[i], acc[i][j]);
        }
    }
#undef GEMM_STAGE
#pragma unroll
    for (int i = 0; i < 4; ++i)
#pragma unroll
        for (int j = 0; j < 4; ++j) { epi(m0 + wr * 64 + i * 16 + fr, n0 + wc * 64 + j * 16 + fq * 4, acc[i][j]); __builtin_amdgcn_sched_barrier(0); }
    __syncthreads();
}
struct NoMid { __device__ __forceinline__ float operator()(int) const { return 1.0f; } };

__device__ void phase_gemm1(const Params& p, int l, char* smem, int bid, int nb) {
    const bf16_t* A = (const bf16_t*)(p.ws + OFF_H);
    const bf16_t* Bt = (const bf16_t*)(p.ws + OFF_W1T) + (size_t)l * 2048 * 1024;
    bf16_t* Z = (bf16_t*)(p.ws + OFF_Z);
    auto epi_gelu = [&](int row, int col, const f32x4& v) {
        *(uint2*)(Z + (size_t)row * NZ + col) = make_uint2(pk_bf16(gelu_f(v[0]), gelu_f(v[1])), pk_bf16(gelu_f(v[2]), gelu_f(v[3])));
    };
    auto epi_plain = [&](int row, int col, const f32x4& v) { *(uint2*)(Z + (size_t)row * NZ + col) = make_uint2(pk_bf16(v[0], v[1]), pk_bf16(v[2], v[3])); };
    const int NT = NZ / 128, MT = T / 128;
    for (int item = bid; item < MT * NT; item += nb) {
        const int n0 = (item % NT) * 128;
        if (n0 < 1024) gemm_tile(A, D, Bt, D, D, (item / NT) * 128, n0, smem, epi_gelu, NoMid(), -1);
        else           gemm_tile(A, D, Bt, D, D, (item / NT) * 128, n0, smem, epi_plain, NoMid(), -1);
    }
}
__device__ void phase_gemm2(const Params& p, int l, char* smem, int bid, int nb) {
    const bf16_t* A = (const bf16_t*)(p.ws + OFF_Y);
    const bf16_t* Bt = (const bf16_t*)(p.ws + OFF_W2T) + (size_t)l * 1024 * 1024;
    const float* ssa = (const float*)(p.ws + OFF_SSQA); const float* ssb = (const float*)(p.ws + OFF_SSQB);
    const float* mod = (const float*)(p.ws + OFF_MOD) + (size_t)l * NB * 6144;
    const float* xin = (l == 0) ? p.x : p.out;
    float* xout = p.out;
    auto rstd_of = [&](const float* s, int row) {
        const float4 a = *(const float4*)(s + (size_t)row * 8), b = *(const float4*)(s + (size_t)row * 8 + 4);
        return rsqrtf(((a.x + a.y) + (a.z + a.w) + (b.x + b.y) + (b.z + b.w)) * (1.0f / 512.0f) + EPS);
    };
    auto midk = [&](int row) { return rstd_of(ssa, row) / rstd_of(ssb, row); };
    auto epi = [&](int row, int col, const f32x4& v) {
        const float rb = rstd_of(ssb, row);
        const int b = row / SEQ;
        const float4 g = *(const float4*)(mod + (size_t)b * 6144 + 2 * D + col);
        const float4 xi = *(const float4*)(xin + (size_t)row * D + col);
        float4 o; o.x = xi.x + g.x * rb * v[0]; o.y = xi.y + g.y * rb * v[1]; o.z = xi.z + g.z * rb * v[2]; o.w = xi.w + g.w * rb * v[3];
        *(float4*)(xout + (size_t)row * D + col) = o;
    };
    const int NT = D / 128, MT = T / 128;
    for (int item = bid; item < MT * NT; item += nb) gemm_tile(A, D, Bt, D, D, (item / NT) * 128, (item % NT) * 128, smem, epi, midk, 8);
}
__device__ void phase_gemm3(const Params& p, int l, char* smem, int bid, int nb) {
    const bf16_t* A = (const bf16_t*)(p.ws + OFF_H);
    const bf16_t* Bt = (const bf16_t*)(p.ws + OFF_WQT) + (size_t)l * 2048 * 1024;
    bf16_t* Q = (bf16_t*)(p.ws + OFF_Z);
    auto epi = [&](int row, int col, const f32x4& v) { *(uint2*)(Q + (size_t)row * 2048 + col) = make_uint2(pk_bf16(v[0], v[1]), pk_bf16(v[2], v[3])); };
    const int NT = 2048 / 128, MT = T / 128;
    for (int item = bid; item < MT * NT; item += nb) gemm_tile(A, D, Bt, D, D, (item / NT) * 128, (item % NT) * 128, smem, epi, NoMid(), -1);
}

constexpr int TP = 136;
__device__ __forceinline__ void stage_transposed(const bf16_t* __restrict__ base, size_t row_stride, bf16_t* dT) {
    const int tid = otid(), r = tid >> 2, part = tid & 3, ri = part >> 1, c0 = (part & 1) * 32;
    const uint4* src = (const uint4*)(base + (size_t)r * row_stride + ri * 64 + c0);
    uint4 v[4];
#pragma unroll
    for (int i = 0; i < 4; ++i) v[i] = src[i];
#pragma unroll
    for (int i = 0; i < 4; ++i) {
        const unsigned w[4] = {v[i].x, v[i].y, v[i].z, v[i].w};
#pragma unroll
        for (int j = 0; j < 4; ++j) {
            dT[(c0 + i * 8 + j * 2) * TP + ri * 64 + r] = (bf16_t)(w[j] & 0xffffu);
            dT[(c0 + i * 8 + j * 2 + 1) * TP + ri * 64 + r] = (bf16_t)(w[j] >> 16);
        }
    }
}

__device__ void gmlp_item(const Params& p, int l, int item, char* smem) {
    const int tid = otid(), lane = tid & 63, wid = tid >> 6, fr = lane & 15, fq = lane >> 4;
    const int h = item & 7, c = (item >> 3) & 31, b = item >> 8;
    const int tok0 = b * SEQ + c * 128;
    bf16_t* vnT = (bf16_t*)smem;
    const bf16_t* Z = (const bf16_t*)(p.ws + OFF_Z);
    {
        const int q = tid >> 1, half = tid & 1, d0 = half * 32;
        const uint4* src = (const uint4*)(Z + (size_t)(tok0 + q) * NZ + 512 + h * 64 + d0);
        float f[32];
#pragma unroll
        for (int i = 0; i < 4; ++i) { const uint4 v = src[i]; const unsigned w[4] = {v.x, v.y, v.z, v.w};
#pragma unroll
            for (int j = 0; j < 4; ++j) { f[i * 8 + j * 2] = bf2f(w[j] & 0xffffu); f[i * 8 + j * 2 + 1] = bf2f(w[j] >> 16); } }
        float s = 0.f;
#pragma unroll
        for (int i = 0; i < 32; ++i) s += f[i];
        s += __shfl_xor(s, 1);
        const float mean = s * (1.0f / 64.0f);
        float qv = 0.f;
#pragma unroll
        for (int i = 0; i < 32; ++i) { f[i] -= mean; qv += f[i] * f[i]; }
        qv += __shfl_xor(qv, 1);
        const float rstd = rsqrtf(qv * (1.0f / 64.0f) + EPS);
#pragma unroll
        for (int i = 0; i < 32; ++i) vnT[(d0 + i) * TP + q] = f2bf(f[i] * rstd);
    }
    __syncthreads();
    const bf16_t* Wsb = (const bf16_t*)(p.ws + OFF_WSB) + ((size_t)l * 8 + h) * 128 * 128;
    f32x4 acc[2][4];
#pragma unroll
    for (int i = 0; i < 2; ++i)
#pragma unroll
        for (int j = 0; j < 4; ++j) acc[i][j] = (f32x4){0.f, 0.f, 0.f, 0.f};
    const int p0 = wid * 32;
#pragma unroll
    for (int ks = 0; ks < 4; ++ks) {
        bf16x8 af[2], bfr[4];
#pragma unroll
        for (int i = 0; i < 2; ++i) af[i] = *(const bf16x8*)(Wsb + (size_t)(p0 + i * 16 + fr) * 128 + ks * 32 + fq * 8);
#pragma unroll
        for (int j = 0; j < 4; ++j) bfr[j] = *(const bf16x8*)(vnT + (j * 16 + fr) * TP + ks * 32 + fq * 8);
#pragma unroll
        for (int i = 0; i < 2; ++i)
#pragma unroll
            for (int j = 0; j < 4; ++j) acc[i][j] = MFMA16(bfr[j], af[i], acc[i][j]);
    }
    bf16_t* Y = (bf16_t*)(p.ws + OFF_Y);
    float* ssa = (float*)(p.ws + OFF_SSQA);
#pragma unroll
    for (int i = 0; i < 2; ++i) {
        const int pp = p0 + i * 16 + fr, tok = tok0 + pp;
        const float bsv = p.gmlp_bs[((size_t)l * 8 + h) * 128 + pp];
        float ss = 0.f;
#pragma unroll
        for (int j = 0; j < 4; ++j) {
            const int d = j * 16 + fq * 4;
            const uint2 uu = *(const uint2*)(Z + (size_t)tok * NZ + h * 64 + d);
            const float y0 = bf2f(uu.x & 0xffffu) * (acc[i][j][0] + bsv), y1 = bf2f(uu.x >> 16) * (acc[i][j][1] + bsv);
            const float y2 = bf2f(uu.y & 0xffffu) * (acc[i][j][2] + bsv), y3 = bf2f(uu.y >> 16) * (acc[i][j][3] + bsv);
            ss += y0 * y0 + y1 * y1 + y2 * y2 + y3 * y3;
            *(uint2*)(Y + (size_t)tok * D + h * 64 + d) = make_uint2(pk_bf16(y0, y1), pk_bf16(y2, y3));
        }
        ss += __shfl_xor(ss, 16); ss += __shfl_xor(ss, 32);
        if (fq == 0) ssa[(size_t)tok * 8 + h] = ss;
    }
    __syncthreads();
}

__device__ void ffta_item(const Params& p, int item, char* smem) {
    const int tid = otid(), lane = tid & 63, wid = tid >> 6, fr = lane & 15, fq = lane >> 4;
    const int bp = item & 63, g = (item >> 6) & 7, b = item >> 9;
    bf16_t* dT = (bf16_t*)smem;
    const bf16_t* Z = (const bf16_t*)(p.ws + OFF_Z);
    stage_transposed(Z + (size_t)(b * SEQ + bp) * NZ + 1024 + g * 128, (size_t)64 * NZ, dT);
    __syncthreads();
    const bf16_t* DA = (const bf16_t*)(p.ws + OFF_DA);
    f32x4 acc[2][4];
#pragma unroll
    for (int i = 0; i < 2; ++i)
#pragma unroll
        for (int j = 0; j < 4; ++j) acc[i][j] = (f32x4){0.f, 0.f, 0.f, 0.f};
#pragma unroll
    for (int ks = 0; ks < 4; ++ks) {
        bf16x8 af[2], bfr[4];
#pragma unroll
        for (int i = 0; i < 2; ++i) af[i] = *(const bf16x8*)(DA + (size_t)(i * 64 + wid * 16 + fr) * 128 + ks * 32 + fq * 8);
#pragma unroll
        for (int j = 0; j < 4; ++j) bfr[j] = *(const bf16x8*)(dT + (j * 16 + fr) * TP + ks * 32 + fq * 8);
#pragma unroll
        for (int i = 0; i < 2; ++i)
#pragma unroll
            for (int j = 0; j < 4; ++j) acc[i][j] = MFMA16(bfr[j], af[i], acc[i][j]);
    }
    const int k1 = wid * 16 + fr;
    const float2 cs = ((const float2*)(p.ws + OFF_TW))[bp * 64 + k1];
    bf16_t* Yb = (bf16_t*)(p.ws + OFF_H) + ((((size_t)(b * 8 + g) * 64 + k1) * 64 + bp) * 128);
#pragma unroll
    for (int j = 0; j < 4; ++j) {
        const int ch = j * 16 + fq * 4;
        float yr[4], yi[4];
#pragma unroll
        for (int e = 0; e < 4; ++e) { const float r = acc[0][j][e], im = acc[1][j][e]; yr[e] = r * cs.x + im * cs.y; yi[e] = im * cs.x - r * cs.y; }
        *(uint2*)(Yb + ch) = make_uint2(pk_bf16(yr[0], yr[1]), pk_bf16(yr[2], yr[3]));
        *(uint2*)(Yb + 64 + ch) = make_uint2(pk_bf16(yi[0], yi[1]), pk_bf16(yi[2], yi[3]));
    }
    __syncthreads();
}

__device__ void phase_mix(const Params& p, int l, char* smem, int bid, int nb) {
    for (int item = bid; item < 2048 + 4096; item += nb) {
        if (item < 2048) gmlp_item(p, l, item, smem); else ffta_item(p, item - 2048, smem);
    }
}

__device__ void phase_fftb(const Params& p, int l, char* smem, int bid, int nb) {
    const int tid = otid(), lane = tid & 63, wid = tid >> 6, fr = lane & 15, fq = lane >> 4;
    bf16_t* dT = (bf16_t*)smem;
    const bf16_t* DB = (const bf16_t*)(p.ws + OFF_DB);
    bf16_t* Y = (bf16_t*)(p.ws + OFF_Y);
    float* ssb = (float*)(p.ws + OFF_SSQB);
    for (int item = bid; item < 4096; item += nb) {
        const int k1 = item & 63, g = (item >> 6) & 7, b = item >> 9;
        stage_transposed((const bf16_t*)(p.ws + OFF_H) + (((size_t)(b * 8 + g) * 64 + k1) * 64) * 128, 128, dT);
        __syncthreads();
        f32x4 acc[4];
#pragma unroll
        for (int j = 0; j < 4; ++j) acc[j] = (f32x4){0.f, 0.f, 0.f, 0.f};
#pragma unroll
        for (int ks = 0; ks < 4; ++ks) {
            const bf16x8 af = *(const bf16x8*)(DB + (size_t)(wid * 16 + fr) * 128 + ks * 32 + fq * 8);
#pragma unroll
            for (int j = 0; j < 4; ++j) { const bf16x8 bfr = *(const bf16x8*)(dT + (j * 16 + fr) * TP + ks * 32 + fq * 8); acc[j] = MFMA16(bfr, af, acc[j]); }
        }
        const int k2 = wid * 16 + fr, tok = b * SEQ + k1 + 64 * k2;
        float ss = 0.f;
#pragma unroll
        for (int j = 0; j < 4; ++j) {
            const int ch = j * 16 + fq * 4;
            const float4 fb = *(const float4*)(p.fnet_b + ((size_t)l * 8 + g) * 64 + ch);
            const float y0 = acc[j][0] * (1.0f / 512.0f) + fb.x, y1 = acc[j][1] * (1.0f / 512.0f) + fb.y, y2 = acc[j][2] * (1.0f / 512.0f) + fb.z, y3 = acc[j][3] * (1.0f / 512.0f) + fb.w;
            ss += y0 * y0 + y1 * y1 + y2 * y2 + y3 * y3;
            *(uint2*)(Y + (size_t)tok * D + 512 + g * 64 + ch) = make_uint2(pk_bf16(y0, y1), pk_bf16(y2, y3));
        }
        ss += __shfl_xor(ss, 16); ss += __shfl_xor(ss, 32);
        if (fq == 0) ssb[(size_t)tok * 8 + g] = ss;
        __syncthreads();
    }
}

#define INS16(a, v) do { a[15] = med3i(a[14], a[15], v); a[14] = med3i(a[13], a[14], v); a[13] = med3i(a[12], a[13], v); a[12] = med3i(a[11], a[12], v); \
    a[11] = med3i(a[10], a[11], v); a[10] = med3i(a[9], a[10], v); a[9] = med3i(a[8], a[9], v); a[8] = med3i(a[7], a[8], v); a[7] = med3i(a[6], a[7], v); \
    a[6] = med3i(a[5], a[6], v); a[5] = med3i(a[4], a[5], v); a[4] = med3i(a[3], a[4], v); a[3] = med3i(a[2], a[3], v); a[2] = med3i(a[1], a[2], v); \
    a[1] = med3i(a[0], a[1], v); a[0] = max(a[0], v); } while (0)

template <int I, int J> struct CandLoop {
    static __device__ __forceinline__ void run(int (&a)[16], const float (&f1)[16], const float (&f2)[16]) {
        if constexpr ((I + 1) * (J + 1) <= 16) { const int key = (f2key(f1[I] + f2[J]) & ~255) | (I * 16 + J); INS16(a, key); }
        if constexpr (J + 1 < 16) CandLoop<I, J + 1>::run(a, f1, f2);
        else if constexpr (I + 1 < 16) CandLoop<I + 1, 0>::run(a, f1, f2);
    }
};

__device__ void phase_topk(const Params& p, int l, char* smem, int bid, int nb) {
    const int tid = otid(), lane = tid & 63, wid = tid >> 6, fr = lane & 15, fq = lane >> 4;
    float* S = (float*)smem;
    int* TT = (int*)(smem + 64 * 257 * 4);
    const bf16_t* Q = (const bf16_t*)(p.ws + OFF_Z);
    int* eidx = (int*)(p.ws + OFF_Y); float* gw = (float*)(p.ws + OFF_Y + (size_t)T * 128 * 4);
    for (int item = bid; item < (T / 64) * 8; item += nb) {
        const int h = item & 7, tok0 = (item >> 3) * 64;
        const bf16_t* K12 = (const bf16_t*)(p.ws + OFF_K12) + ((size_t)l * 8 + h) * 256 * 128;
        {
            const int half = wid >> 1;
            f32x4 acc[4][4];
#pragma unroll
            for (int i = 0; i < 4; ++i)
#pragma unroll
                for (int j = 0; j < 4; ++j) acc[i][j] = (f32x4){0.f, 0.f, 0.f, 0.f};
#pragma unroll
            for (int ks = 0; ks < 4; ++ks) {
                bf16x8 af[4], bfr[4];
#pragma unroll
                for (int i = 0; i < 4; ++i) af[i] = *(const bf16x8*)(Q + (size_t)(tok0 + i * 16 + fr) * 2048 + h * 256 + half * 128 + ks * 32 + fq * 8);
#pragma unroll
                for (int j = 0; j < 4; ++j) bfr[j] = *(const bf16x8*)(K12 + (size_t)((wid * 4 + j) * 16 + fr) * 128 + ks * 32 + fq * 8);
#pragma unroll
                for (int i = 0; i < 4; ++i)
#pragma unroll
                    for (int j = 0; j < 4; ++j) acc[i][j] = MFMA16(bfr[j], af[i], acc[i][j]);
            }
#pragma unroll
            for (int i = 0; i < 4; ++i)
#pragma unroll
                for (int j = 0; j < 4; ++j)
#pragma unroll
                    for (int e = 0; e < 4; ++e) S[(i * 16 + fr) * 257 + (wid * 4 + j) * 16 + fq * 4 + e] = acc[i][j][e];
        }
        __syncthreads();
        if (tid < 128) {
            const int tk = tid & 63, half = tid >> 6;
            int a[16];
#pragma unroll
            for (int i = 0; i < 16; ++i) a[i] = (int)0x80000000;
            const float* sr = S + tk * 257 + half * 128;
#pragma unroll 4
            for (int i = 0; i < 128; ++i) { const int key = (f2key(sr[i]) & ~127) | i; INS16(a, key); }
#pragma unroll
            for (int i = 0; i < 16; ++i) TT[(tk * 2 + half) * 16 + i] = a[i];
        }
        __syncthreads();
        if (tid < 64) {
            const int tk = tid;
            float f1[16], f2[16];
#pragma unroll
            for (int i = 0; i < 16; ++i) { f1[i] = key2f(TT[(tk * 2) * 16 + i] & ~127); f2[i] = key2f(TT[(tk * 2 + 1) * 16 + i] & ~127); }
            int a[16];
#pragma unroll
            for (int i = 0; i < 16; ++i) a[i] = (int)0x80000000;
            CandLoop<0, 0>::run(a, f1, f2);
            float sc[16], e[16], sum = 0.f; int ex[16];
#pragma unroll
            for (int i = 0; i < 16; ++i) {
                sc[i] = key2f(a[i] & ~255);
                const int code = a[i] & 255;
                const int e1 = TT[(tk * 2) * 16 + (code >> 4)] & 127, e2 = TT[(tk * 2 + 1) * 16 + (code & 15)] & 127;
                ex[i] = e1 * 128 + e2;
            }
#pragma unroll
            for (int i = 0; i < 16; ++i) { e[i] = __expf(sc[i] - sc[0]); sum += e[i]; }
            const float inv = 1.0f / sum;
            int4* ep = (int4*)(eidx + (size_t)(tok0 + tk) * 128 + h * 16); float4* gp = (float4*)(gw + (size_t)(tok0 + tk) * 128 + h * 16);
#pragma unroll
            for (int i = 0; i < 4; ++i) { ep[i] = make_int4(ex[4 * i], ex[4 * i + 1], ex[4 * i + 2], ex[4 * i + 3]); gp[i] = make_float4(e[4 * i] * inv, e[4 * i + 1] * inv, e[4 * i + 2] * inv, e[4 * i + 3] * inv); }
        }
        __syncthreads();
    }
}

__device__ __forceinline__ float dot16_fp8(const float (&h)[16], const int4& u) {
    const int w[4] = {u.x, u.y, u.z, u.w};
    f32x2_t a = {0.f, 0.f};
#pragma unroll
    for (int i = 0; i < 4; ++i) {
        const f32x2_t lo = __builtin_amdgcn_cvt_pk_f32_fp8(w[i], false), hi = __builtin_amdgcn_cvt_pk_f32_fp8(w[i], true);
        const f32x2_t h0 = {h[4 * i], h[4 * i + 1]}, h1 = {h[4 * i + 2], h[4 * i + 3]};
        a = __builtin_elementwise_fma(lo, h0, a); a = __builtin_elementwise_fma(hi, h1, a);
    }
    return a.x + a.y;
}
__device__ __forceinline__ void axpy16_fp8(float (&o)[16], float c, const int4& v) {
    const int w[4] = {v.x, v.y, v.z, v.w};
#pragma unroll
    for (int i = 0; i < 4; ++i) {
        const f32x2_t lo = __builtin_amdgcn_cvt_pk_f32_fp8(w[i], false), hi = __builtin_amdgcn_cvt_pk_f32_fp8(w[i], true);
        o[4 * i] += c * lo.x; o[4 * i + 1] += c * lo.y; o[4 * i + 2] += c * hi.x; o[4 * i + 3] += c * hi.y;
    }
}

__device__ void phase_pu(const Params& p, int l, int slice, int grank, int gsz) {
    const int tid_ = otid(); const int lane = tid_ & 63, wid = tid_ >> 6, sub = lane & 7, pg = lane >> 3;
    const bf16_t* H = (const bf16_t*)(p.ws + OFF_H) + slice * 128 + sub * 16;
    const char* U8 = p.ws + OFF_UB + ((size_t)(l * 8 + slice) * NE) * 128 + sub * 16;
    const int* eidx = (const int*)(p.ws + OFF_Y) + lane;
    float* part = (float*)(p.ws + OFF_Z) + (size_t)slice * T * 128 + 16 * sub + pg;
    const int stride = gsz * 4;
#define PU_ISSUE(e_, u_) do { _Pragma("unroll") for (int q = 0; q < 8; ++q) { const int ej = __shfl(e_, 8 * q + pg); u_[q] = *(const int4*)(U8 + (size_t)ej * 128); } } while (0)
    int tok = grank * 4 + wid;
    if (tok >= T) return;
    int4 uA[8], uB[8];
    int ea = eidx[(size_t)tok * 128], eb = eidx[(size_t)tok * 128 + 64];
    uint4 h0 = *(const uint4*)(H + (size_t)tok * D), h1 = *(const uint4*)(H + (size_t)tok * D + 8);
    PU_ISSUE(ea, uA);
#pragma nounroll
    for (;;) {
        __builtin_amdgcn_sched_barrier(0);
        const int tokn = tok + stride; const bool more = tokn < T;
        int ean = 0, ebn = 0; uint4 h0n = h0, h1n = h1;
        if (more) { ean = eidx[(size_t)tokn * 128]; ebn = eidx[(size_t)tokn * 128 + 64]; h0n = *(const uint4*)(H + (size_t)tokn * D); h1n = *(const uint4*)(H + (size_t)tokn * D + 8); }
        PU_ISSUE(eb, uB);
        __builtin_amdgcn_sched_barrier(0);
        float hf[16];
        { const unsigned w_[8] = {h0.x, h0.y, h0.z, h0.w, h1.x, h1.y, h1.z, h1.w};
#pragma unroll
          for (int i = 0; i < 8; ++i) { hf[2 * i] = bf2f(w_[i] & 0xffffu); hf[2 * i + 1] = bf2f(w_[i] >> 16); } }
        float v[16];
#pragma unroll
        for (int q = 0; q < 8; ++q) v[q] = dot16_fp8(hf, uA[q]);
        __builtin_amdgcn_sched_barrier(0);
        if (more) PU_ISSUE(ean, uA);
        __builtin_amdgcn_sched_barrier(0);
#pragma unroll
        for (int q = 0; q < 8; ++q) v[8 + q] = dot16_fp8(hf, uB[q]);
        float w8[8], w4[4], w2[2];
        { const bool hi = (lane & 4) != 0;
#pragma unroll
          for (int m = 0; m < 8; ++m) { const float send = hi ? v[m] : v[m + 8], keep = hi ? v[m + 8] : v[m]; w8[m] = keep + __shfl_xor(send, 4); } }
        { const bool hi = (lane & 2) != 0;
#pragma unroll
          for (int m = 0; m < 4; ++m) { const float send = hi ? w8[m] : w8[m + 4], keep = hi ? w8[m + 4] : w8[m]; w4[m] = keep + __shfl_xor(send, 2); } }
        { const bool hi = (lane & 1) != 0;
#pragma unroll
          for (int m = 0; m < 2; ++m) { const float send = hi ? w4[m] : w4[m + 2], keep = hi ? w4[m + 2] : w4[m]; w2[m] = keep + __shfl_xor(send, 1); } }
        float* pr = part + (size_t)tok * 128;
        pr[0] = w2[0]; pr[8] = w2[1];
        if (!more) break;
        tok = tokn; ea = ean; eb = ebn; h0 = h0n; h1 = h1n;
    }
#undef PU_ISSUE
}
__device__ void phase_pc(const Params& p, int l, int bid, int nb) {
    const int tid_ = otid(); const int lane = tid_ & 63, wid = tid_ >> 6;
    const int* eidx = (const int*)(p.ws + OFF_Y); const float* gw = (const float*)(p.ws + OFF_Y + (size_t)T * 128 * 4);
    float* coef = (float*)(p.ws + OFF_Y + (size_t)T * 128 * 8);
    const float* part = (const float*)(p.ws + OFF_Z);
    const float* usc = (const float*)(p.ws + OFF_USC) + (size_t)l * NE; const float* vsc = (const float*)(p.ws + OFF_VSC) + (size_t)l * NE;
    for (int tok = bid * 4 + wid; tok < T; tok += nb * 4) {
#pragma unroll
        for (int hh = 0; hh < 2; ++hh) {
            const size_t j = (size_t)tok * 128 + hh * 64 + lane;
            const int e = eidx[j]; const float g = gw[j];
            float a = 0.f;
#pragma unroll
            for (int sl = 0; sl < 8; ++sl) a += part[(size_t)sl * T * 128 + j];
            coef[j] = g * gelu_f(a * usc[e]) * vsc[e];
        }
    }
}
__device__ void phase_pv(const Params& p, int l, int slice, int grank, int gsz) {
    const int tid_ = otid(); const int lane = tid_ & 63, wid = tid_ >> 6, sub = lane & 7, pg = lane >> 3;
    const char* V8 = p.ws + OFF_VB + ((size_t)(l * 8 + slice) * NE) * 128 + sub * 16;
    const int* eidx = (const int*)(p.ws + OFF_Y) + lane;
    const float* coef = (const float*)(p.ws + OFF_Y + (size_t)T * 128 * 8) + lane;
    const int col = slice * 128 + 16 * sub + 2 * pg;
    const float* g2p = (const float*)(p.ws + OFF_MOD) + (size_t)l * NB * 6144 + 5 * D + col;
    float* xcol = p.out + col;
    const int stride = gsz * 4;
#define PV_ISSUE(e_, c_, v_, cj_) do { _Pragma("unroll") for (int q = 0; q < 8; ++q) { const int ej = __shfl(e_, 8 * q + pg); cj_[q] = __shfl(c_, 8 * q + pg); v_[q] = *(const int4*)(V8 + (size_t)ej * 128); } } while (0)
    int tok = grank * 4 + wid;
    if (tok >= T) return;
    int4 vA[8], vB[8]; float cA[8], cB[8];
    int ea = eidx[(size_t)tok * 128], eb = eidx[(size_t)tok * 128 + 64];
    float ca = coef[(size_t)tok * 128], cb = coef[(size_t)tok * 128 + 64];
    PV_ISSUE(ea, ca, vA, cA);
#pragma nounroll
    for (;;) {
        __builtin_amdgcn_sched_barrier(0);
        const int tokn = tok + stride; const bool more = tokn < T;
        int ean = 0, ebn = 0; float can = 0.f, cbn = 0.f;
        if (more) { ean = eidx[(size_t)tokn * 128]; ebn = eidx[(size_t)tokn * 128 + 64]; can = coef[(size_t)tokn * 128]; cbn = coef[(size_t)tokn * 128 + 64]; }
        float2* xp = (float2*)(xcol + (size_t)tok * D); const float2 g2 = *(const float2*)(g2p + (size_t)(tok / SEQ) * 6144);
        float2 xv = *xp;
        PV_ISSUE(eb, cb, vB, cB);
        __builtin_amdgcn_sched_barrier(0);
        float o[16];
#pragma unroll
        for (int i = 0; i < 16; ++i) o[i] = 0.f;
#pragma unroll
        for (int q = 0; q < 8; ++q) axpy16_fp8(o, cA[q], vA[q]);
        __builtin_amdgcn_sched_barrier(0);
        if (more) PV_ISSUE(ean, can, vA, cA);
        __builtin_amdgcn_sched_barrier(0);
#pragma unroll
        for (int q = 0; q < 8; ++q) axpy16_fp8(o, cB[q], vB[q]);
        float t8[8], t4[4], t2[2];
        { const bool hi = (lane & 32) != 0;
#pragma unroll
          for (int m = 0; m < 8; ++m) { const float send = hi ? o[m] : o[m + 8], keep = hi ? o[m + 8] : o[m]; t8[m] = keep + __shfl_xor(send, 32); } }
        { const bool hi = (lane & 16) != 0;
#pragma unroll
          for (int m = 0; m < 4; ++m) { const float send = hi ? t8[m] : t8[m + 4], keep = hi ? t8[m + 4] : t8[m]; t4[m] = keep + __shfl_xor(send, 16); } }
        { const bool hi = (lane & 8) != 0;
#pragma unroll
          for (int m = 0; m < 2; ++m) { const float send = hi ? t4[m] : t4[m + 2], keep = hi ? t4[m + 2] : t4[m]; t2[m] = keep + __shfl_xor(send, 8); } }
        xv.x += g2.x * t2[0]; xv.y += g2.y * t2[1]; *xp = xv;
        if (!more) break;
        tok = tokn; ea = ean; eb = ebn; ca = can; cb = cbn;
    }
#undef PV_ISSUE
}
__device__ void phase_final_norm(const Params& p, int bid, int nb) {
    const int tid_ = otid(); const int lane = tid_ & 63, wid = tid_ >> 6;
    for (int tok = bid * 4 + wid; tok < T; tok += nb * 4) {
        float* xr = p.out + (size_t)tok * D;
        float4 v[4]; float ss = 0.f;
#pragma unroll
        for (int i = 0; i < 4; ++i) { v[i] = *(const float4*)(xr + i * 256 + lane * 4); ss += v[i].x * v[i].x + v[i].y * v[i].y + v[i].z * v[i].z + v[i].w * v[i].w; }
        ss = wave_sum(ss);
        const float rstd = rsqrtf(ss * (1.0f / D) + EPS);
#pragma unroll
        for (int i = 0; i < 4; ++i) { const float4 g = *(const float4*)(p.final_g + i * 256 + lane * 4);
            *(float4*)(xr + i * 256 + lane * 4) = make_float4(v[i].x * rstd * g.x, v[i].y * rstd * g.y, v[i].z * rstd * g.z, v[i].w * rstd * g.w); }
    }
}

#define XB_TMO      128
#define XB_XCNT(j)  (256  + 64 * (j))
#define XB_XSUB(j)  (1280 + 64 * (j))
#define XB_XGEN(j)  (2304 + 64 * (j))
#define XB_TOP      3328
#define XB_TOPGEN   3392
#define XCD_BAR_WORDS 3456
#define XB_SPIN_CAP (1u << 22)
__device__ __forceinline__ unsigned xb_ld(unsigned* p)              { return __hip_atomic_load(p, __ATOMIC_RELAXED, __HIP_MEMORY_SCOPE_AGENT); }
__device__ __forceinline__ unsigned xb_add(unsigned* p, unsigned v) { return __hip_atomic_fetch_add(p, v, __ATOMIC_RELAXED, __HIP_MEMORY_SCOPE_AGENT); }
__device__ __forceinline__ unsigned xb_xcc_id() { return (unsigned)__builtin_amdgcn_s_getreg((3 << 11) | 20) & 0xFu; }
#define XB_SPIN(cond, bar) do { unsigned _sp = 0; while (cond) { __builtin_amdgcn_s_sleep(1); \
    if ((++_sp & 255u) == 0u) { if (xb_ld(&(bar)[XB_TMO])) break; if (_sp > XB_SPIN_CAP) { atomicAdd(&(bar)[XB_TMO], 1u); break; } } } } while (0)
__device__ __forceinline__ void xcd_barrier_post(unsigned* bar, volatile LAS unsigned* st) {
    if (threadIdx.x == 0) { const unsigned x = xb_xcc_id(); st[3] = x; st[2] = xb_add(&bar[XB_XCNT(x)], 1u); }
}
__device__ __forceinline__ void xcd_barrier_complete(unsigned* bar, unsigned x, unsigned& nloc, unsigned& nx) {
    const unsigned G = gridDim.x * gridDim.y * gridDim.z;
    unsigned sum, cnt, mine, sp = 0u;
    for (;;) {
        sum = 0u; cnt = 0u; mine = 0u;
#pragma unroll
        for (unsigned j = 0; j < 16; ++j) { const unsigned c = xb_ld(&bar[XB_XCNT(j)]); sum += c; cnt += (c > 0u) ? 1u : 0u; mine = (j == x) ? c : mine; }
        if (sum == G) break;
        __builtin_amdgcn_s_sleep(1);
        if ((++sp & 255u) == 0u) { if (xb_ld(&bar[XB_TMO])) break; if (sp > XB_SPIN_CAP) { atomicAdd(&bar[XB_TMO], 1u); break; } }
    }
    nloc = mine > 0u ? mine : 1u; nx = cnt > 0u ? cnt : 1u;
}
__device__ __forceinline__ void xcd_barrier(unsigned* bar, volatile LAS unsigned* st) {
    asm volatile("s_waitcnt vmcnt(0)" ::: "memory");
    __syncthreads();
    if (threadIdx.x == 0) {
        __builtin_amdgcn_s_waitcnt(0);
        unsigned nloc = st[0], nx = st[1]; const unsigned x = st[3];
        if (nloc == 0u) { xcd_barrier_complete(bar, x, nloc, nx); st[0] = nloc; st[1] = nx; }
        const unsigned old = xb_add(&bar[XB_XSUB(x)], 1u);
        const unsigned gen = old / nloc;
        if (old + 1u == (gen + 1u) * nloc) {
            __builtin_amdgcn_fence(__ATOMIC_RELEASE, "agent");
            asm volatile("s_waitcnt vmcnt(0)" ::: "memory");
            const unsigned og = xb_add(&bar[XB_TOP], 1u);
            const unsigned tg = og / nx;
            if (og + 1u == (tg + 1u) * nx) xb_add(&bar[XB_TOPGEN], 1u);
            else XB_SPIN(xb_ld(&bar[XB_TOPGEN]) == tg, bar);
            __builtin_amdgcn_fence(__ATOMIC_ACQUIRE, "agent");
            xb_add(&bar[XB_XGEN(x)], 1u);
            asm volatile("s_waitcnt vmcnt(0)" ::: "memory");
        } else {
            XB_SPIN(xb_ld(&bar[XB_XGEN(x)]) == gen, bar);
            __builtin_amdgcn_fence(__ATOMIC_ACQUIRE, "agent");
            asm volatile("s_waitcnt vmcnt(0)" ::: "memory");
        }
    }
    __syncthreads();
}

#if MEGA
#if PROBE_A >= 0
#define TSTAMP(i) do { if (blockIdx.x == 0 && threadIdx.x == 0) ts[i] = __builtin_amdgcn_s_memrealtime(); } while (0)
#else
#define TSTAMP(i) do { } while (0)
#endif
__global__ void __launch_bounds__(256, 2) mega_kernel(Params p) {
    __shared__ __attribute__((aligned(16))) char smem[SMEM_BYTES];
    __shared__ uint4 xb_words;
#if PROBE_A >= 0
    __shared__ unsigned long long ts[26];
#endif
    cg::grid_group grid = cg::this_grid();
    const int bid = blockIdx.x, nb = gridDim.x;
    unsigned* bar = (unsigned*)(p.ws + OFF_BAR);
    if (threadIdx.x == 0) xb_words = make_uint4(0u, 0u, 0u, 0u);
    if (bid == 0) for (int i = threadIdx.x; i < XCD_BAR_WORDS; i += 256) bar[i] = 0u;
    TSTAMP(0);
    phase_prep(p, smem, bid, nb);
    grid.sync();
    volatile LAS unsigned* xst = (volatile LAS unsigned*)&xb_words;
    xcd_barrier_post(bar, xst);
    TSTAMP(1);
    phase_norm(p.x, p.norm1_g, (const float*)(p.ws + OFF_MOD), 0, D, (bf16_t*)(p.ws + OFF_H), bid, nb); xcd_barrier((unsigned*)(p.ws + OFF_BAR), (volatile LAS unsigned*)&xb_words);
    int slice, grank; const int gsz = nb / 8;
    {
        const unsigned myx = xst[3], myrank = xst[2];
        unsigned pre = 0;
#pragma unroll
        for (unsigned j = 0; j < 16; ++j) { const unsigned c = xb_ld(&bar[XB_XCNT(j)]); pre += (j < myx) ? c : 0u; }
        const int gi = __builtin_amdgcn_readfirstlane((int)(pre + myrank));
        slice = gi / gsz; grank = gi % gsz;
    }
#pragma nounroll
    for (int l = 0; l < NL; ++l) {
        TSTAMP(2 + 11 * l); phase_gemm1(p, l, smem, bid, nb); xcd_barrier((unsigned*)(p.ws + OFF_BAR), (volatile LAS unsigned*)&xb_words);
        TSTAMP(3 + 11 * l); phase_mix(p, l, smem, bid, nb); xcd_barrier((unsigned*)(p.ws + OFF_BAR), (volatile LAS unsigned*)&xb_words);
        TSTAMP(4 + 11 * l); phase_fftb(p, l, smem, bid, nb); xcd_barrier((unsigned*)(p.ws + OFF_BAR), (volatile LAS unsigned*)&xb_words);
        TSTAMP(5 + 11 * l); phase_gemm2(p, l, smem, bid, nb); xcd_barrier((unsigned*)(p.ws + OFF_BAR), (volatile LAS unsigned*)&xb_words);
        TSTAMP(6 + 11 * l); phase_norm(p.out, p.norm2_g + l * D, (const float*)(p.ws + OFF_MOD) + (size_t)l * NB * 6144, 3 * D, 4 * D, (bf16_t*)(p.ws + OFF_H), bid, nb); xcd_barrier((unsigned*)(p.ws + OFF_BAR), (volatile LAS unsigned*)&xb_words);
        TSTAMP(7 + 11 * l); phase_gemm3(p, l, smem, bid, nb); xcd_barrier((unsigned*)(p.ws + OFF_BAR), (volatile LAS unsigned*)&xb_words);
        TSTAMP(8 + 11 * l); phase_topk(p, l, smem, bid, nb); xcd_barrier((unsigned*)(p.ws + OFF_BAR), (volatile LAS unsigned*)&xb_words);
        TSTAMP(9 + 11 * l); phase_pu(p, l, slice, grank, gsz); xcd_barrier((unsigned*)(p.ws + OFF_BAR), (volatile LAS unsigned*)&xb_words);
        TSTAMP(10 + 11 * l); phase_pc(p, l, bid, nb); xcd_barrier((unsigned*)(p.ws + OFF_BAR), (volatile LAS unsigned*)&xb_words);
        TSTAMP(11 + 11 * l); phase_pv(p, l, slice, grank, gsz); xcd_barrier((unsigned*)(p.ws + OFF_BAR), (volatile LAS unsigned*)&xb_words);
        TSTAMP(12 + 11 * l);
        if (l + 1 < NL) { phase_norm(p.out, p.norm1_g + (l + 1) * D, (const float*)(p.ws + OFF_MOD) + (size_t)(l + 1) * NB * 6144, 0, D, (bf16_t*)(p.ws + OFF_H), bid, nb); xcd_barrier((unsigned*)(p.ws + OFF_BAR), (volatile LAS unsigned*)&xb_words); }
        else phase_final_norm(p, bid, nb);
    }
    TSTAMP(24);
#if PROBE_A >= 0
    if (bid == 0 && threadIdx.x == 0) p.out[0] += (float)(ts[PROBE_B] - ts[PROBE_A]) * 0.01f / PROBE_DIV;
#endif
}
#endif

extern "C" void kernel_launch(void* const* d_in, const int* in_sizes, int n_in, void* d_out, int out_size, void* d_ws, size_t ws_size, hipStream_t stream) {
    (void)in_sizes; (void)n_in; (void)out_size;
    if (ws_size < OFF_END) { fprintf(stderr, "workspace too small: %zu < %zu\n", ws_size, (size_t)OFF_END); return; }
    Params p{};
    p.x = (const float*)d_in[0]; p.c = (const float*)d_in[1]; p.mod_w = (const float*)d_in[2]; p.mod_b = (const float*)d_in[3]; p.norm1_g = (const float*)d_in[4];
    p.w_in = (const float*)d_in[5]; p.gmlp_ws = (const float*)d_in[6]; p.gmlp_bs = (const float*)d_in[7]; p.fnet_w = (const float*)d_in[8]; p.fnet_b = (const float*)d_in[9];
    p.gain_a = (const float*)d_in[10]; p.gain_b = (const float*)d_in[11]; p.w_out = (const float*)d_in[12]; p.norm2_g = (const float*)d_in[13]; p.wq = (const float*)d_in[14];
    p.k1 = (const float*)d_in[15]; p.k2 = (const float*)d_in[16]; p.pu = (const float*)d_in[17]; p.pv = (const float*)d_in[18]; p.final_g = (const float*)d_in[19];
    p.out = (float*)d_out; p.ws = (char*)d_ws;
#if MEGA
    static int grid_blocks = 0;
    if (!grid_blocks) {
        int dev = 0, cus = 0, per_cu = 0;
        hipGetDevice(&dev);
        hipDeviceGetAttribute(&cus, hipDeviceAttributeMultiprocessorCount, dev);
        hipOccupancyMaxActiveBlocksPerMultiprocessor(&per_cu, mega_kernel, 256, 0);
        if (per_cu > 2) per_cu = 2;
        grid_blocks = (cus * per_cu) / 8 * 8;
    }
    void* args[] = {&p};
    hipError_t e = hipLaunchCooperativeKernel((void*)mega_kernel, dim3(grid_blocks), dim3(256), args, 0, stream);
    if (e != hipSuccess) fprintf(stderr, "cooperative launch failed: %s (grid %d)\n", hipGetErrorString(e), grid_blocks);
#endif
}
```

```cpp
#include <hip/hip_runtime.h>
#include <hip/hip_cooperative_groups.h>
#include <cstdio>
#include <cstdint>
namespace cg = cooperative_groups;

#ifndef MEGA
#define MEGA 1
#endif
#ifndef PROBE_A
#define PROBE_A -1
#define PROBE_B 0
#define PROBE_DIV 10.0f
#endif

typedef unsigned short bf16_t;
typedef short bf16x8 __attribute__((ext_vector_type(8)));
typedef float f32x4 __attribute__((ext_vector_type(4)));
typedef __bf16 bf16x2_t __attribute__((ext_vector_type(2)));

constexpr int D = 1024, NB = 8, SEQ = 4096, T = NB * SEQ, NL = 2;
constexpr int NZ = 2048;
constexpr int NE = 16384;
constexpr float EPS = 1e-6f;

constexpr size_t OFF_MOD  = 0;
constexpr size_t OFF_W1T  = OFF_MOD  + (size_t)NL * NB * 6144 * 4;
constexpr size_t OFF_W2T  = OFF_W1T  + (size_t)NL * 2048 * 1024 * 2;
constexpr size_t OFF_WQT  = OFF_W2T  + (size_t)NL * 1024 * 1024 * 2;
constexpr size_t OFF_K12  = OFF_WQT  + (size_t)NL * 2048 * 1024 * 2;
constexpr size_t OFF_WSB  = OFF_K12  + (size_t)NL * 8 * 256 * 128 * 2;
constexpr size_t OFF_DA   = OFF_WSB  + (size_t)NL * 8 * 128 * 128 * 2;
constexpr size_t OFF_DB   = OFF_DA   + 128 * 128 * 2;
constexpr size_t OFF_TW   = OFF_DB   + 64 * 128 * 2;
constexpr size_t OFF_SSQA = OFF_TW   + 64 * 64 * 8;
constexpr size_t OFF_SSQB = OFF_SSQA + (size_t)T * 8 * 4;
constexpr size_t OFF_UB   = OFF_SSQB + (size_t)T * 8 * 4;
constexpr size_t OFF_VB   = OFF_UB   + (size_t)NL * NE * 1024;
constexpr size_t OFF_USC  = OFF_VB   + (size_t)NL * NE * 1024;
constexpr size_t OFF_VSC  = OFF_USC  + (size_t)NL * NE * 4;
constexpr size_t OFF_H    = OFF_VSC  + (size_t)NL * NE * 4;
constexpr size_t OFF_Z    = OFF_H    + (size_t)T * 1024 * 2;
constexpr size_t OFF_Y    = OFF_Z    + (size_t)T * 2048 * 2;
constexpr size_t OFF_BAR  = OFF_Y    + (size_t)T * 1024 * 2;
constexpr size_t OFF_END  = OFF_BAR  + 16384;

struct Params {
    const float* x; const float* c; const float* mod_w; const float* mod_b; const float* norm1_g; const float* w_in;
    const float* gmlp_ws; const float* gmlp_bs; const float* fnet_w; const float* fnet_b; const float* gain_a; const float* gain_b;
    const float* w_out; const float* norm2_g; const float* wq; const float* k1; const float* k2; const float* pu; const float* pv; const float* final_g;
    float* out; char* ws;
};

constexpr int SMEM_BYTES = 73984;

__device__ __forceinline__ float bf2f(unsigned v) { return __uint_as_float(v << 16); }
typedef float f32x2_t __attribute__((ext_vector_type(2)));
__device__ __forceinline__ unsigned pk_bf16(float lo, float hi) { const f32x2_t v = {lo, hi}; return __builtin_bit_cast(unsigned, __builtin_convertvector(v, bf16x2_t)); }
__device__ __forceinline__ bf16_t f2bf(float f) { return (bf16_t)(pk_bf16(f, 0.f) & 0xffffu); }
__device__ __forceinline__ float gelu_f(float v) {
    const float t = __builtin_amdgcn_rcpf(fabsf(v) * 0.2316418882f + 1.0f);
    float q = t * 0.5307027145f + (-0.7265760135f); q = q * t + 0.7107068705f; q = q * t + (-0.142248368f); q = q * t + 0.127414796f; q = q * t;
    const float m = v * (q * __builtin_amdgcn_exp2f(v * v * (-0.72134752044f)));
    return v < 0.f ? m : v - m;
}
__device__ __forceinline__ int med3i(int a, int b, int c) { return max(min(a, b), min(max(a, b), c)); }
__device__ __forceinline__ int f2key(float f) { int b = __float_as_int(f); return b ^ ((b >> 31) & 0x7fffffff); }
__device__ __forceinline__ float key2f(int k) { return __int_as_float(k ^ ((k >> 31) & 0x7fffffff)); }
__device__ __forceinline__ float wave_sum(float v) {
#pragma unroll
    for (int o = 32; o >= 1; o >>= 1) v += __shfl_xor(v, o);
    return v;
}
__device__ __forceinline__ int otid() { int t = threadIdx.x; asm volatile("" : "+v"(t)); return t; }
#define MFMA16(a, b, c) __builtin_amdgcn_mfma_f32_16x16x32_bf16((a), (b), (c), 0, 0, 0)

__device__ void transpose_tile(const float* __restrict__ src, int ld, int k0, int n0, bf16_t* __restrict__ dst  , int dn0,
                               const float* __restrict__ kscale, float* tile  ) {
    const int tid = otid();
#pragma unroll
    for (int i = 0; i < 4; ++i) {
        const int r = (tid >> 4) + 16 * i, c4 = (tid & 15) * 4;
        const float4 v = *(const float4*)(src + (size_t)(k0 + r) * ld + n0 + c4);
        const float s = kscale ? kscale[k0 + r] : 1.0f;
        tile[r * 65 + c4 + 0] = v.x * s; tile[r * 65 + c4 + 1] = v.y * s; tile[r * 65 + c4 + 2] = v.z * s; tile[r * 65 + c4 + 3] = v.w * s;
    }
    __syncthreads();
    {
        const int n = tid >> 2, ks = (tid & 3) * 16;
        unsigned w[8];
#pragma unroll
        for (int j = 0; j < 8; ++j) w[j] = pk_bf16(tile[(ks + 2 * j) * 65 + n], tile[(ks + 2 * j + 1) * 65 + n]);
        uint4* d = (uint4*)(dst + (size_t)(dn0 + n) * 1024 + k0 + ks);
        d[0] = make_uint4(w[0], w[1], w[2], w[3]); d[1] = make_uint4(w[4], w[5], w[6], w[7]);
    }
    __syncthreads();
}

__device__ void phase_prep(const Params& p, char* smem, int bid, int nb) {
    const int tid = otid();
    const int gtid = bid * 256 + tid, gsz = nb * 256;
    char* ws = p.ws;
    {
        float* sc = (float*)smem;
        float* red = (float*)(smem + 32768);
        for (int i = tid; i < 8192; i += 256) { const float v = p.c[i]; sc[i] = v / (1.0f + __expf(-v)); }
        __syncthreads();
        float* mod = (float*)(ws + OFF_MOD);
        for (int item = bid; item < NL * 192; item += nb) {
            const int l = item / 192, n0 = (item % 192) * 32, nn = tid & 31, kq = tid >> 5;
            float acc[8];
#pragma unroll
            for (int b = 0; b < 8; ++b) acc[b] = 0.f;
            const float* W = p.mod_w + (size_t)l * 1024 * 6144 + n0 + nn;
            for (int k = kq; k < 1024; k += 8) {
                const float w = W[(size_t)k * 6144];
#pragma unroll
                for (int b = 0; b < 8; ++b) acc[b] += sc[b * 1024 + k] * w;
            }
#pragma unroll
            for (int b = 0; b < 8; ++b) red[(kq * 8 + b) * 32 + nn] = acc[b];
            __syncthreads();
            {
                const int b = tid >> 5;
                float s = 0.f;
#pragma unroll
                for (int q = 0; q < 8; ++q) s += red[(q * 8 + b) * 32 + nn];
                mod[((size_t)l * NB + b) * 6144 + n0 + nn] = s + p.mod_b[l * 6144 + n0 + nn];
            }
            __syncthreads();
        }
    }
    {
        float* tile = (float*)smem;
        for (int item = bid; item < NL * 1024; item += nb) {
            const int l = item / 1024, r = item % 1024;
            if (r < 256) {
                const int kt = r / 16, nt = r % 16;
                transpose_tile(p.w_in + (size_t)l * 1024 * 1536, 1536, kt * 64, nt * 64, (bf16_t*)(ws + OFF_W1T) + (size_t)l * 2048 * 1024, nt * 64, nullptr, tile);
            } else if (r < 512) {
                const int rr = r - 256, kt = rr / 16, nt = rr % 16;
                const float* gk = (kt < 8) ? (p.gain_a + l * 512) : (p.gain_b + l * 512 - 512);
                transpose_tile(p.w_out + (size_t)l * 1024 * 1024, 1024, kt * 64, nt * 64, (bf16_t*)(ws + OFF_W2T) + (size_t)l * 1024 * 1024, nt * 64, gk, tile);
            } else {
                const int rr = r - 512, kt = rr / 32, nt = rr % 32;
                transpose_tile(p.wq + (size_t)l * 1024 * 2048, 2048, kt * 64, nt * 64, (bf16_t*)(ws + OFF_WQT) + (size_t)l * 2048 * 1024, nt * 64, nullptr, tile);
            }
        }
    }
    {
        float* fws = (float*)smem;
        float* Ms  = (float*)(smem + 16384);
        float* wt  = (float*)(smem + 49152);
        float* cs  = (float*)(smem + 49152 + 16640);
        for (int item = bid; item < NL * 8 * 16; item += nb) {
            const int l = item / 128, g = (item % 128) / 16, kt = item % 16;
            if (tid < 64) { float s, c; sincospif((float)tid / 32.0f, &s, &c); cs[tid] = c; cs[64 + tid] = s; }
            for (int i = tid; i < 4096; i += 256) fws[i] = p.fnet_w[((size_t)l * 8 + g) * 4096 + i];
#pragma unroll
            for (int i = 0; i < 4; ++i) {
                const int r = (tid >> 4) + 16 * i, c4 = (tid & 15) * 4;
                const float4 v = *(const float4*)(p.w_in + (size_t)l * 1024 * 1536 + (size_t)(kt * 64 + r) * 1536 + 1024 + g * 64 + c4);
                wt[r * 65 + c4] = v.x; wt[r * 65 + c4 + 1] = v.y; wt[r * 65 + c4 + 2] = v.z; wt[r * 65 + c4 + 3] = v.w;
            }
            __syncthreads();
            {
                const int d = tid >> 2, r0 = (tid & 3) * 32;
                const bool im = r0 >= 64; const int e0 = r0 & 63;
                float acc[32];
#pragma unroll
                for (int e = 0; e < 32; ++e) acc[e] = 0.f;
                for (int j = 0; j < 64; ++j) {
                    const int ph = (d * j) & 63;
                    const float t = im ? -cs[64 + ph] : cs[ph];
#pragma unroll
                    for (int e = 0; e < 32; ++e) acc[e] += t * fws[j * 64 + e0 + e];
                }
#pragma unroll
                for (int e = 0; e < 32; ++e) Ms[d * 128 + r0 + e] = acc[e];
            }
            __syncthreads();
            {
                const int r = tid >> 1, kk0 = (tid & 1) * 32;
                float acc[32];
#pragma unroll
                for (int k = 0; k < 32; ++k) acc[k] = 0.f;
                for (int d = 0; d < 64; ++d) {
                    const float m = Ms[d * 128 + r];
#pragma unroll
                    for (int k = 0; k < 32; ++k) acc[k] += wt[(kk0 + k) * 65 + d] * m;
                }
                bf16_t* dst = (bf16_t*)(ws + OFF_W1T) + (size_t)l * 2048 * 1024 + (size_t)(1024 + g * 128 + r) * 1024 + kt * 64 + kk0;
#pragma unroll
                for (int q = 0; q < 4; ++q)
                    ((uint4*)dst)[q] = make_uint4(pk_bf16(acc[q * 8], acc[q * 8 + 1]), pk_bf16(acc[q * 8 + 2], acc[q * 8 + 3]), pk_bf16(acc[q * 8 + 4], acc[q * 8 + 5]), pk_bf16(acc[q * 8 + 6], acc[q * 8 + 7]));
            }
            __syncthreads();
        }
    }
    {
        bf16_t* k12 = (bf16_t*)(ws + OFF_K12);
        for (int i = gtid; i < NL * 8 * 256 * 128; i += gsz) {
            const int d = i & 127, n = (i >> 7) & 255, h = (i >> 15) & 7, l = i >> 18;
            const float* src = (n < 128) ? p.k1 : p.k2;
            k12[i] = f2bf(src[(((size_t)l * 8 + h) * 128 + (n & 127)) * 128 + d]);
        }
        bf16_t* wsb = (bf16_t*)(ws + OFF_WSB);
        for (int i = gtid; i < NL * 8 * 128 * 128; i += gsz) wsb[i] = f2bf(p.gmlp_ws[i]);
        bf16_t* DA = (bf16_t*)(ws + OFF_DA);
        for (int i = gtid; i < 128 * 128; i += gsz) {
            const int m = i >> 7, kk = i & 127, ro = m >> 6, k1 = m & 63, ri = kk >> 6, a = kk & 63;
            float s, c; sincospif((float)((a * k1) & 63) / 32.0f, &s, &c);
            const float v = (ro == ri) ? c : (ro == 0 ? s : -s);
            DA[i] = f2bf(v);
        }
        bf16_t* DB = (bf16_t*)(ws + OFF_DB);
        for (int i = gtid; i < 64 * 128; i += gsz) {
            const int k2 = i >> 7, kk = i & 127, ri = kk >> 6, b = kk & 63;
            float s, c; sincospif((float)((b * k2) & 63) / 32.0f, &s, &c);
            DB[i] = f2bf(ri ? s : c);
        }
        float2* tw = (float2*)(ws + OFF_TW);
        for (int i = gtid; i < 64 * 64; i += gsz) {
            const int bp = i >> 6, k1 = i & 63;
            float s, c; sincospif((float)(bp * k1) / 2048.0f, &s, &c);
            tw[i] = make_float2(c, s);
        }
        {
            const int lane = tid & 63, wv = gtid >> 6, nwv = gsz >> 6;
            for (int r = wv; r < 2 * NL * NE; r += nwv) {
                const int tbl = r / (NL * NE), row = r % (NL * NE);
                const float* src = (tbl ? p.pv : p.pu) + (size_t)row * 1024 + lane * 16;
                float4 v[4]; float m = 0.f;
#pragma unroll
                for (int i = 0; i < 4; ++i) { v[i] = ((const float4*)src)[i]; m = fmaxf(m, fmaxf(fmaxf(fabsf(v[i].x), fabsf(v[i].y)), fmaxf(fabsf(v[i].z), fabsf(v[i].w)))); }
#pragma unroll
                for (int o = 32; o >= 1; o >>= 1) m = fmaxf(m, __shfl_xor(m, o));
                const float sc = (m > 0.f) ? 256.0f / m : 1.0f, inv = (m > 0.f) ? m * (1.0f / 256.0f) : 1.0f;
                int w[4];
#pragma unroll
                for (int i = 0; i < 4; ++i) { w[i] = __builtin_amdgcn_cvt_pk_fp8_f32(v[i].x * sc, v[i].y * sc, 0, false); w[i] = __builtin_amdgcn_cvt_pk_fp8_f32(v[i].z * sc, v[i].w * sc, w[i], true); }
                {
                    const int lyr = row / NE, ex = row % NE;
                    *(int4*)(ws + (tbl ? OFF_VB : OFF_UB) + ((size_t)(lyr * 8 + (lane >> 3)) * NE + ex) * 128 + (lane & 7) * 16) = make_int4(w[0], w[1], w[2], w[3]);
                }
                if (lane == 0) ((float*)(ws + (tbl ? OFF_VSC : OFF_USC)))[row] = inv;
            }
        }
    }
}

__device__ void phase_norm(const float* __restrict__ xsrc, const float* __restrict__ g, const float* __restrict__ modl  , int sh_off, int scl_off,
                           bf16_t* __restrict__ hout, int bid, int nb) {
    const int tid_ = otid(); const int lane = tid_ & 63, wid = tid_ >> 6;
    for (int tok = bid * 4 + wid; tok < T; tok += nb * 4) {
        const int b = tok / SEQ;
        const float* xr = xsrc + (size_t)tok * D;
        float4 v[4];
        float ss = 0.f;
#pragma unroll
        for (int i = 0; i < 4; ++i) { v[i] = *(const float4*)(xr + i * 256 + lane * 4); ss += v[i].x * v[i].x + v[i].y * v[i].y + v[i].z * v[i].z + v[i].w * v[i].w; }
        ss = wave_sum(ss);
        const float rstd = rsqrtf(ss * (1.0f / D) + EPS);
        const float* mb = modl + (size_t)b * 6144;
#pragma unroll
        for (int i = 0; i < 4; ++i) {
            const int cidx = i * 256 + lane * 4;
            const float4 gg = *(const float4*)(g + cidx), sh = *(const float4*)(mb + sh_off + cidx), sc = *(const float4*)(mb + scl_off + cidx);
            const float o0 = v[i].x * rstd * gg.x * (1.0f + sc.x) + sh.x, o1 = v[i].y * rstd * gg.y * (1.0f + sc.y) + sh.y;
            const float o2 = v[i].z * rstd * gg.z * (1.0f + sc.z) + sh.z, o3 = v[i].w * rstd * gg.w * (1.0f + sc.w) + sh.w;
            *(uint2*)(hout + (size_t)tok * D + cidx) = make_uint2(pk_bf16(o0, o1), pk_bf16(o2, o3));
        }
    }
}

#define LAS __attribute__((address_space(3)))
template <class Epi, class MidK>
__device__ __forceinline__ void gemm_tile(const bf16_t* __restrict__ A, int lda, const bf16_t* __restrict__ Bt, int ldb, int K, int m0, int n0,
                                          char* smem, const Epi& epi, const MidK& midk, int kmid) {
    const int tid = otid(), lane = tid & 63, wid = tid >> 6, wr = wid >> 1, wc = wid & 1, fr = lane & 15, fq = lane >> 4;
    LAS char* lds = (LAS char*)smem;
    f32x4 acc[4][4];
#pragma unroll
    for (int i = 0; i < 4; ++i)
#pragma unroll
        for (int j = 0; j < 4; ++j) acc[i][j] = (f32x4){0.f, 0.f, 0.f, 0.f};
    const int prow = lane >> 3, pch = (lane & 7) ^ prow;
    const bf16_t* ga = A + (size_t)(m0 + wid * 32 + prow) * lda + pch * 8;
    const bf16_t* gb = Bt + (size_t)(n0 + wid * 32 + prow) * ldb + pch * 8;
    const int nk = K / 64;
#define GEMM_STAGE(kt_, buf_) do { _Pragma("unroll") for (int i_ = 0; i_ < 4; ++i_) { \
        __builtin_amdgcn_global_load_lds((const unsigned*)(ga + (size_t)(i_ * 8) * lda + (kt_) * 64), (LAS unsigned*)(lds + (buf_) * 16384 + (wid * 32 + i_ * 8) * 128), 16, 0, 0); \
        __builtin_amdgcn_global_load_lds((const unsigned*)(gb + (size_t)(i_ * 8) * ldb + (kt_) * 64), (LAS unsigned*)(lds + 32768 + (buf_) * 16384 + (wid * 32 + i_ * 8) * 128), 16, 0, 0); } } while (0)
    GEMM_STAGE(0, 0);
    const int swz = fr & 7;
    for (int kt = 0; kt < nk; ++kt) {
        const int cur = kt & 1;
        asm volatile("s_waitcnt vmcnt(0)" ::: "memory");
        __syncthreads();
        if (kt + 1 < nk) GEMM_STAGE(kt + 1, cur ^ 1);
        if (kt == kmid) {
#pragma unroll
            for (int i = 0; i < 4; ++i) { const float sc = midk(m0 + wr * 64 + i * 16 + fr);
#pragma unroll
                for (int j = 0; j < 4; ++j) acc[i][j] *= sc; }
        }
        const LAS char* ca = lds + cur * 16384; const LAS char* cb = lds + 32768 + cur * 16384;
#pragma unroll
        for (int ks = 0; ks < 2; ++ks) {
            bf16x8 af[4], bfr[4];
            const int coff = ((ks * 4 + fq) ^ swz) * 16;
#pragma unroll
            for (int i = 0; i < 4; ++i) af[i] = *(const LAS bf16x8*)(ca + (wr * 64 + i * 16 + fr) * 128 + coff);
#pragma unroll
            for (int j = 0; j < 4; ++j) bfr[j] = *(const LAS bf16x8*)(cb + (wc * 64 + j * 16 + fr) * 128 + coff);
#pragma unroll
            for (int i = 0; i < 4; ++i)
#pragma unroll
                for (int j = 0; j < 4; ++j) acc[i][j] = MFMA16(bfr[j], af[i], acc[i][j]);
        }
    }
#undef GEMM_STAGE
#pragma unroll
    for (int i = 0; i < 4; ++i)
#pragma unroll
        for (int j = 0; j < 4; ++j) { epi(m0 + wr * 64 + i * 16 + fr, n0 + wc * 64 + j * 16 + fq * 4, acc[i][j]); __builtin_amdgcn_sched_barrier(0); }
    __syncthreads();
}
struct NoMid { __device__ __forceinline__ float operator()(int) const { return 1.0f; } };

__device__ void phase_gemm1(const Params& p, int l, char* smem, int bid, int nb) {
    const bf16_t* A = (const bf16_t*)(p.ws + OFF_H);
    const bf16_t* Bt = (const bf16_t*)(p.ws + OFF_W1T) + (size_t)l * 2048 * 1024;
    bf16_t* Z = (bf16_t*)(p.ws + OFF_Z);
    auto epi_gelu = [&](int row, int col, const f32x4& v) {
        *(uint2*)(Z + (size_t)row * NZ + col) = make_uint2(pk_bf16(gelu_f(v[0]), gelu_f(v[1])), pk_bf16(gelu_f(v[2]), gelu_f(v[3])));
    };
    auto epi_plain = [&](int row, int col, const f32x4& v) { *(uint2*)(Z + (size_t)row * NZ + col) = make_uint2(pk_bf16(v[0], v[1]), pk_bf16(v[2], v[3])); };
    const int NT = NZ / 128, MT = T / 128;
    for (int item = bid; item < MT * NT; item += nb) {
        const int n0 = (item % NT) * 128;
        if (n0 < 1024) gemm_tile(A, D, Bt, D, D, (item / NT) * 128, n0, smem, epi_gelu, NoMid(), -1);
        else           gemm_tile(A, D, Bt, D, D, (item / NT) * 128, n0, smem, epi_plain, NoMid(), -1);
    }
}
__device__ void phase_gemm2(const Params& p, int l, char* smem, int bid, int nb) {
    const bf16_t* A = (const bf16_t*)(p.ws + OFF_Y);
    const bf16_t* Bt = (const bf16_t*)(p.ws + OFF_W2T) + (size_t)l * 1024 * 1024;
    const float* ssa = (const float*)(p.ws + OFF_SSQA); const float* ssb = (const float*)(p.ws + OFF_SSQB);
    const float* mod = (const float*)(p.ws + OFF_MOD) + (size_t)l * NB * 6144;
    const float* xin = (l == 0) ? p.x : p.out;
    float* xout = p.out;
    auto rstd_of = [&](const float* s, int row) {
        const float4 a = *(const float4*)(s + (size_t)row * 8), b = *(const float4*)(s + (size_t)row * 8 + 4);
        return rsqrtf(((a.x + a.y) + (a.z + a.w) + (b.x + b.y) + (b.z + b.w)) * (1.0f / 512.0f) + EPS);
    };
    auto midk = [&](int row) { return rstd_of(ssa, row) / rstd_of(ssb, row); };
    auto epi = [&](int row, int col, const f32x4& v) {
        const float rb = rstd_of(ssb, row);
        const int b = row / SEQ;
        const float4 g = *(const float4*)(mod + (size_t)b * 6144 + 2 * D + col);
        const float4 xi = *(const float4*)(xin + (size_t)row * D + col);
        float4 o; o.x = xi.x + g.x * rb * v[0]; o.y = xi.y + g.y * rb * v[1]; o.z = xi.z + g.z * rb * v[2]; o.w = xi.w + g.w * rb * v[3];
        *(float4*)(xout + (size_t)row * D + col) = o;
    };
    const int NT = D / 128, MT = T / 128;
    for (int item = bid; item < MT * NT; item += nb) gemm_tile(A, D, Bt, D, D, (item / NT) * 128, (item % NT) * 128, smem, epi, midk, 8);
}
__device__ void phase_gemm3(const Params& p, int l, char* smem, int bid, int nb) {
    const bf16_t* A = (const bf16_t*)(p.ws + OFF_H);
    const bf16_t* Bt = (const bf16_t*)(p.ws + OFF_WQT) + (size_t)l * 2048 * 1024;
    bf16_t* Q = (bf16_t*)(p.ws + OFF_Z);
    auto epi = [&](int row, int col, const f32x4& v) { *(uint2*)(Q + (size_t)row * 2048 + col) = make_uint2(pk_bf16(v[0], v[1]), pk_bf16(v[2], v[3])); };
    const int NT = 2048 / 128, MT = T / 128;
    for (int item = bid; item < MT * NT; item += nb) gemm_tile(A, D, Bt, D, D, (item / NT) * 128, (item % NT) * 128, smem, epi, NoMid(), -1);
}

constexpr int TP = 136;
__device__ __forceinline__ void stage_transposed(const bf16_t* __restrict__ base, size_t row_stride, bf16_t* dT) {
    const int tid = otid(), r = tid >> 2, part = tid & 3, ri = part >> 1, c0 = (part & 1) * 32;
    const uint4* src = (const uint4*)(base + (size_t)r * row_stride + ri * 64 + c0);
    uint4 v[4];
#pragma unroll
    for (int i = 0; i < 4; ++i) v[i] = src[i];
#pragma unroll
    for (int i = 0; i < 4; ++i) {
        const unsigned w[4] = {v[i].x, v[i].y, v[i].z, v[i].w};
#pragma unroll
        for (int j = 0; j < 4; ++j) {
            dT[(c0 + i * 8 + j * 2) * TP + ri * 64 + r] = (bf16_t)(w[j] & 0xffffu);
            dT[(c0 + i * 8 + j * 2 + 1) * TP + ri * 64 + r] = (bf16_t)(w[j] >> 16);
        }
    }
}

__device__ void gmlp_item(const Params& p, int l, int item, char* smem) {
    const int tid = otid(), lane = tid & 63, wid = tid >> 6, fr = lane & 15, fq = lane >> 4;
    const int h = item & 7, c = (item >> 3) & 31, b = item >> 8;
    const int tok0 = b * SEQ + c * 128;
    bf16_t* vnT = (bf16_t*)smem;
    const bf16_t* Z = (const bf16_t*)(p.ws + OFF_Z);
    {
        const int q = tid >> 1, half = tid & 1, d0 = half * 32;
        const uint4* src = (const uint4*)(Z + (size_t)(tok0 + q) * NZ + 512 + h * 64 + d0);
        float f[32];
#pragma unroll
        for (int i = 0; i < 4; ++i) { const uint4 v = src[i]; const unsigned w[4] = {v.x, v.y, v.z, v.w};
#pragma unroll
            for (int j = 0; j < 4; ++j) { f[i * 8 + j * 2] = bf2f(w[j] & 0xffffu); f[i * 8 + j * 2 + 1] = bf2f(w[j] >> 16); } }
        float s = 0.f;
#pragma unroll
        for (int i = 0; i < 32; ++i) s += f[i];
        s += __shfl_xor(s, 1);
        const float mean = s * (1.0f / 64.0f);
        float qv = 0.f;
#pragma unroll
        for (int i = 0; i < 32; ++i) { f[i] -= mean; qv += f[i] * f[i]; }
        qv += __shfl_xor(qv, 1);
        const float rstd = rsqrtf(qv * (1.0f / 64.0f) + EPS);
#pragma unroll
        for (int i = 0; i < 32; ++i) vnT[(d0 + i) * TP + q] = f2bf(f[i] * rstd);
    }
    __syncthreads();
    const bf16_t* Wsb = (const bf16_t*)(p.ws + OFF_WSB) + ((size_t)l * 8 + h) * 128 * 128;
    f32x4 acc[2][4];
#pragma unroll
    for (int i = 0; i < 2; ++i)
#pragma unroll
        for (int j = 0; j < 4; ++j) acc[i][j] = (f32x4){0.f, 0.f, 0.f, 0.f};
    const int p0 = wid * 32;
#pragma unroll
    for (int ks = 0; ks < 4; ++ks) {
        bf16x8 af[2], bfr[4];
#pragma unroll
        for (int i = 0; i < 2; ++i) af[i] = *(const bf16x8*)(Wsb + (size_t)(p0 + i * 16 + fr) * 128 + ks * 32 + fq * 8);
#pragma unroll
        for (int j = 0; j < 4; ++j) bfr[j] = *(const bf16x8*)(vnT + (j * 16 + fr) * TP + ks * 32 + fq * 8);
#pragma unroll
        for (int i = 0; i < 2; ++i)
#pragma unroll
            for (int j = 0; j < 4; ++j) acc[i][j] = MFMA16(bfr[j], af[i], acc[i][j]);
    }
    bf16_t* Y = (bf16_t*)(p.ws + OFF_Y);
    float* ssa = (float*)(p.ws + OFF_SSQA);
#pragma unroll
    for (int i = 0; i < 2; ++i) {
        const int pp = p0 + i * 16 + fr, tok = tok0 + pp;
        const float bsv = p.gmlp_bs[((size_t)l * 8 + h) * 128 + pp];
        float ss = 0.f;
#pragma unroll
        for (int j = 0; j < 4; ++j) {
            const int d = j * 16 + fq * 4;
            const uint2 uu = *(const uint2*)(Z + (size_t)tok * NZ + h * 64 + d);
            const float y0 = bf2f(uu.x & 0xffffu) * (acc[i][j][0] + bsv), y1 = bf2f(uu.x >> 16) * (acc[i][j][1] + bsv);
            const float y2 = bf2f(uu.y & 0xffffu) * (acc[i][j][2] + bsv), y3 = bf2f(uu.y >> 16) * (acc[i][j][3] + bsv);
            ss += y0 * y0 + y1 * y1 + y2 * y2 + y3 * y3;
            *(uint2*)(Y + (size_t)tok * D + h * 64 + d) = make_uint2(pk_bf16(y0, y1), pk_bf16(y2, y3));
        }
        ss += __shfl_xor(ss, 16); ss += __shfl_xor(ss, 32);
        if (fq == 0) ssa[(size_t)tok * 8 + h] = ss;
    }
    __syncthreads();
}

__device__ void ffta_item(const Params& p, int item, char* smem) {
    const int tid = otid(), lane = tid & 63, wid = tid >> 6, fr = lane & 15, fq = lane >> 4;
    const int bp = item & 63, g = (item >> 6) & 7, b = item >> 9;
    bf16_t* dT = (bf16_t*)smem;
    const bf16_t* Z = (const bf16_t*)(p.ws + OFF_Z);
    stage_transposed(Z + (size_t)(b * SEQ + bp) * NZ + 1024 + g * 128, (size_t)64 * NZ, dT);
    __syncthreads();
    const bf16_t* DA = (const bf16_t*)(p.ws + OFF_DA);
    f32x4 acc[2][4];
#pragma unroll
    for (int i = 0; i < 2; ++i)
#pragma unroll
        for (int j = 0; j < 4; ++j) acc[i][j] = (f32x4){0.f, 0.f, 0.f, 0.f};
#pragma unroll
    for (int ks = 0; ks < 4; ++ks) {
        bf16x8 af[2], bfr[4];
#pragma unroll
        for (int i = 0; i < 2; ++i) af[i] = *(const bf16x8*)(DA + (size_t)(i * 64 + wid * 16 + fr) * 128 + ks * 32 + fq * 8);
#pragma unroll
        for (int j = 0; j < 4; ++j) bfr[j] = *(const bf16x8*)(dT + (j * 16 + fr) * TP + ks * 32 + fq * 8);
#pragma unroll
        for (int i = 0; i < 2; ++i)
#pragma unroll
            for (int j = 0; j < 4; ++j) acc[i][j] = MFMA16(bfr[j], af[i], acc[i][j]);
    }
    const int k1 = wid * 16 + fr;
    const float2 cs = ((const float2*)(p.ws + OFF_TW))[bp * 64 + k1];
    bf16_t* Yb = (bf16_t*)(p.ws + OFF_H) + ((((size_t)(b * 8 + g) * 64 + k1) * 64 + bp) * 128);
#pragma unroll
    for (int j = 0; j < 4; ++j) {
        const int ch = j * 16 + fq * 4;
        float yr[4], yi[4];
#pragma unroll
        for (int e = 0; e < 4; ++e) { const float r = acc[0][j][e], im = acc[1][j][e]; yr[e] = r * cs.x + im * cs.y; yi[e] = im * cs.x - r * cs.y; }
        *(uint2*)(Yb + ch) = make_uint2(pk_bf16(yr[0], yr[1]), pk_bf16(yr[2], yr[3]));
        *(uint2*)(Yb + 64 + ch) = make_uint2(pk_bf16(yi[0], yi[1]), pk_bf16(yi[2], yi[3]));
    }
    __syncthreads();
}

__device__ void phase_mix(const Params& p, int l, char* smem, int bid, int nb) {
    for (int item = bid; item < 2048 + 4096; item += nb) {
        if (item < 2048) gmlp_item(p, l, item, smem); else ffta_item(p, item - 2048, smem);
    }
}

__device__ void phase_fftb(const Params& p, int l, char* smem, int bid, int nb) {
    const int tid = otid(), lane = tid & 63, wid = tid >> 6, fr = lane & 15, fq = lane >> 4;
    bf16_t* dT = (bf16_t*)smem;
    const bf16_t* DB = (const bf16_t*)(p.ws + OFF_DB);
    bf16_t* Y = (bf16_t*)(p.ws + OFF_Y);
    float* ssb = (float*)(p.ws + OFF_SSQB);
    for (int item = bid; item < 4096; item += nb) {
        const int k1 = item & 63, g = (item >> 6) & 7, b = item >> 9;
        stage_transposed((const bf16_t*)(p.ws + OFF_H) + (((size_t)(b * 8 + g) * 64 + k1) * 64) * 128, 128, dT);
        __syncthreads();
        f32x4 acc[4];
#pragma unroll
        for (int j = 0; j < 4; ++j) acc[j] = (f32x4){0.f, 0.f, 0.f, 0.f};
#pragma unroll
        for (int ks = 0; ks < 4; ++ks) {
            const bf16x8 af = *(const bf16x8*)(DB + (size_t)(wid * 16 + fr) * 128 + ks * 32 + fq * 8);
#pragma unroll
            for (int j = 0; j < 4; ++j) { const bf16x8 bfr = *(const bf16x8*)(dT + (j * 16 + fr) * TP + ks * 32 + fq * 8); acc[j] = MFMA16(bfr, af, acc[j]); }
        }
        const int k2 = wid * 16 + fr, tok = b * SEQ + k1 + 64 * k2;
        float ss = 0.f;
#pragma unroll
        for (int j = 0; j < 4; ++j) {
            const int ch = j * 16 + fq * 4;
            const float4 fb = *(const float4*)(p.fnet_b + ((size_t)l * 8 + g) * 64 + ch);
            const float y0 = acc[j][0] * (1.0f / 512.0f) + fb.x, y1 = acc[j][1] * (1.0f / 512.0f) + fb.y, y2 = acc[j][2] * (1.0f / 512.0f) + fb.z, y3 = acc[j][3] * (1.0f / 512.0f) + fb.w;
            ss += y0 * y0 + y1 * y1 + y2 * y2 + y3 * y3;
            *(uint2*)(Y + (size_t)tok * D + 512 + g * 64 + ch) = make_uint2(pk_bf16(y0, y1), pk_bf16(y2, y3));
        }
        ss += __shfl_xor(ss, 16); ss += __shfl_xor(ss, 32);
        if (fq == 0) ssb[(size_t)tok * 8 + g] = ss;
        __syncthreads();
    }
}

#define INS16(a, v) do { a[15] = med3i(a[14], a[15], v); a[14] = med3i(a[13], a[14], v); a[13] = med3i(a[12], a[13], v); a[12] = med3i(a[11], a[12], v); \
    a[11] = med3i(a[10], a[11], v); a[10] = med3i(a[9], a[10], v); a[9] = med3i(a[8], a[9], v); a[8] = med3i(a[7], a[8], v); a[7] = med3i(a[6], a[7], v); \
    a[6] = med3i(a[5], a[6], v); a[5] = med3i(a[4], a[5], v); a[4] = med3i(a[3], a[4], v); a[3] = med3i(a[2], a[3], v); a[2] = med3i(a[1], a[2], v); \
    a[1] = med3i(a[0], a[1], v); a[0] = max(a[0], v); } while (0)

template <int I, int J> struct CandLoop {
    static __device__ __forceinline__ void run(int (&a)[16], const float (&f1)[16], const float (&f2)[16]) {
        if constexpr ((I + 1) * (J + 1) <= 16) { const int key = (f2key(f1[I] + f2[J]) & ~255) | (I * 16 + J); INS16(a, key); }
        if constexpr (J + 1 < 16) CandLoop<I, J + 1>::run(a, f1, f2);
        else if constexpr (I + 1 < 16) CandLoop<I + 1, 0>::run(a, f1, f2);
    }
};

typedef _Float16 f16x2_t __attribute__((ext_vector_type(2)));
__device__ __forceinline__ unsigned pk_f16(float lo, float hi) { const f16x2_t v = {(_Float16)lo, (_Float16)hi}; return __builtin_bit_cast(unsigned, v); }
__device__ __forceinline__ int h2key(unsigned bits16) { const int b = (int)(short)bits16; return b ^ ((b >> 15) & 0x7fff); }
__device__ __forceinline__ float key2h(int k) { const int b = k ^ ((k >> 15) & 0x7fff); return (float)__builtin_bit_cast(_Float16, (unsigned short)(b & 0xffff)); }

__device__ void phase_topk(const Params& p, int l, char* smem, int bid, int nb) {
    const int tid = otid(), lane = tid & 63, wid = tid >> 6, fr = lane & 15, fq = lane >> 4;
    unsigned* S32 = (unsigned*)smem;
    int* TT = (int*)smem;
    const bf16_t* Q = (const bf16_t*)(p.ws + OFF_Z);
    int* eidx = (int*)(p.ws + OFF_Y); float* gw = (float*)(p.ws + OFF_Y + (size_t)T * 128 * 4);
    const int hh = wid >> 1, half = wid & 1;
    for (int item = bid; item < (T / 64) * 4; item += nb) {
        const int hp = item & 3, tok0 = (item >> 2) * 64, h = hp * 2 + hh;
        const bf16_t* Kh = (const bf16_t*)(p.ws + OFF_K12) + (((size_t)l * 8 + h) * 256 + half * 128) * 128;
        const bf16_t* Qh = Q + (size_t)tok0 * 2048 + h * 256 + half * 128;
#pragma unroll
        for (int mp = 0; mp < 2; ++mp) {
            f32x4 acc[2][8];
#pragma unroll
            for (int i = 0; i < 2; ++i)
#pragma unroll
                for (int j = 0; j < 8; ++j) acc[i][j] = (f32x4){0.f, 0.f, 0.f, 0.f};
#pragma unroll
            for (int ks = 0; ks < 4; ++ks) {
                bf16x8 af[2], bfr[8];
#pragma unroll
                for (int i = 0; i < 2; ++i) af[i] = *(const bf16x8*)(Qh + (size_t)((mp * 2 + i) * 16 + fr) * 2048 + ks * 32 + fq * 8);
#pragma unroll
                for (int j = 0; j < 8; ++j) bfr[j] = *(const bf16x8*)(Kh + (size_t)(j * 16 + fr) * 128 + ks * 32 + fq * 8);
#pragma unroll
                for (int i = 0; i < 2; ++i)
#pragma unroll
                    for (int j = 0; j < 8; ++j) acc[i][j] = MFMA16(bfr[j], af[i], acc[i][j]);
            }
#pragma unroll
            for (int i = 0; i < 2; ++i)
#pragma unroll
                for (int j = 0; j < 8; ++j) {
                    unsigned* d = S32 + ((mp * 2 + i) * 16 + fr) * 257 + hh * 128 + half * 64 + j * 8 + fq * 2;
                    d[0] = pk_f16(acc[i][j][0], acc[i][j][1]); d[1] = pk_f16(acc[i][j][2], acc[i][j][3]);
                }
        }
        __syncthreads();
        int a[16];
#pragma unroll
        for (int i = 0; i < 16; ++i) a[i] = (int)0x80000000;
        {
            const unsigned* sr = S32 + lane * 257 + hh * 128 + half * 64;
#pragma unroll 2
            for (int i = 0; i < 64; ++i) {
                const unsigned w = sr[i];
                const int k0 = (h2key(w & 0xffffu) << 7) | (2 * i), k1 = (h2key(w >> 16) << 7) | (2 * i + 1);
                INS16(a, k0); INS16(a, k1);
            }
        }
        __syncthreads();
#pragma unroll
        for (int i = 0; i < 16; ++i) TT[((lane * 2 + hh) * 2 + half) * 16 + i] = a[i];
        __syncthreads();
        if (tid < 128) {
            const int tk = tid & 63, h2 = tid >> 6, hd = hp * 2 + h2;
            const int* t1 = TT + ((tk * 2 + h2) * 2) * 16; const int* t2 = t1 + 16;
            float f1[16], f2[16];
#pragma unroll
            for (int i = 0; i < 16; ++i) { f1[i] = key2h(t1[i] >> 7); f2[i] = key2h(t2[i] >> 7); }
            int c[16];
#pragma unroll
            for (int i = 0; i < 16; ++i) c[i] = (int)0x80000000;
            CandLoop<0, 0>::run(c, f1, f2);
            float sc[16], e[16], sum = 0.f; int ex[16];
#pragma unroll
            for (int i = 0; i < 16; ++i) {
                sc[i] = key2f(c[i] & ~255);
                const int code = c[i] & 255;
                ex[i] = (t1[code >> 4] & 127) * 128 + (t2[code & 15] & 127);
            }
#pragma unroll
            for (int i = 0; i < 16; ++i) { e[i] = __expf(sc[i] - sc[0]); sum += e[i]; }
            const float inv = 1.0f / sum;
            int4* ep = (int4*)(eidx + (size_t)(tok0 + tk) * 128 + hd * 16); float4* gp = (float4*)(gw + (size_t)(tok0 + tk) * 128 + hd * 16);
#pragma unroll
            for (int i = 0; i < 4; ++i) { ep[i] = make_int4(ex[4 * i], ex[4 * i + 1], ex[4 * i + 2], ex[4 * i + 3]); gp[i] = make_float4(e[4 * i] * inv, e[4 * i + 1] * inv, e[4 * i + 2] * inv, e[4 * i + 3] * inv); }
        }
        __syncthreads();
    }
}

__device__ __forceinline__ float dot16_fp8(const float (&h)[16], const int4& u) {
    const int w[4] = {u.x, u.y, u.z, u.w};
    f32x2_t a = {0.f, 0.f};
#pragma unroll
    for (int i = 0; i < 4; ++i) {
        const f32x2_t lo = __builtin_amdgcn_cvt_pk_f32_fp8(w[i], false), hi = __builtin_amdgcn_cvt_pk_f32_fp8(w[i], true);
        const f32x2_t h0 = {h[4 * i], h[4 * i + 1]}, h1 = {h[4 * i + 2], h[4 * i + 3]};
        a = __builtin_elementwise_fma(lo, h0, a); a = __builtin_elementwise_fma(hi, h1, a);
    }
    return a.x + a.y;
}
__device__ __forceinline__ void axpy16_fp8(float (&o)[16], float c, const int4& v) {
    const int w[4] = {v.x, v.y, v.z, v.w};
#pragma unroll
    for (int i = 0; i < 4; ++i) {
        const f32x2_t lo = __builtin_amdgcn_cvt_pk_f32_fp8(w[i], false), hi = __builtin_amdgcn_cvt_pk_f32_fp8(w[i], true);
        o[4 * i] += c * lo.x; o[4 * i + 1] += c * lo.y; o[4 * i + 2] += c * hi.x; o[4 * i + 3] += c * hi.y;
    }
}

__device__ void phase_pu(const Params& p, int l, int slice, int grank, int gsz) {
    const int tid_ = otid(); const int lane = tid_ & 63, wid = tid_ >> 6, sub = lane & 7, pg = lane >> 3;
    const bf16_t* H = (const bf16_t*)(p.ws + OFF_H) + slice * 128 + sub * 16;
    const char* U8 = p.ws + OFF_UB + ((size_t)(l * 8 + slice) * NE) * 128 + sub * 16;
    const int* eidx = (const int*)(p.ws + OFF_Y) + lane;
    float* part = (float*)(p.ws + OFF_Z) + (size_t)slice * T * 128 + 16 * sub + pg;
    const int stride = gsz * 4;
#define PU_ISSUE(e_, u_) do { _Pragma("unroll") for (int q = 0; q < 8; ++q) { const int ej = __shfl(e_, 8 * q + pg); u_[q] = *(const int4*)(U8 + (size_t)ej * 128); } } while (0)
    int tok = grank * 4 + wid;
    if (tok >= T) return;
    int4 uA[8], uB[8];
    int ea = eidx[(size_t)tok * 128], eb = eidx[(size_t)tok * 128 + 64];
    uint4 h0 = *(const uint4*)(H + (size_t)tok * D), h1 = *(const uint4*)(H + (size_t)tok * D + 8);
    PU_ISSUE(ea, uA);
#pragma nounroll
    for (;;) {
        __builtin_amdgcn_sched_barrier(0);
        const int tokn = tok + stride; const bool more = tokn < T;
        int ean = 0, ebn = 0; uint4 h0n = h0, h1n = h1;
        if (more) { ean = eidx[(size_t)tokn * 128]; ebn = eidx[(size_t)tokn * 128 + 64]; h0n = *(const uint4*)(H + (size_t)tokn * D); h1n = *(const uint4*)(H + (size_t)tokn * D + 8); }
        PU_ISSUE(eb, uB);
        __builtin_amdgcn_sched_barrier(0);
        float hf[16];
        { const unsigned w_[8] = {h0.x, h0.y, h0.z, h0.w, h1.x, h1.y, h1.z, h1.w};
#pragma unroll
          for (int i = 0; i < 8; ++i) { hf[2 * i] = bf2f(w_[i] & 0xffffu); hf[2 * i + 1] = bf2f(w_[i] >> 16); } }
        float v[16];
#pragma unroll
        for (int q = 0; q < 8; ++q) v[q] = dot16_fp8(hf, uA[q]);
        __builtin_amdgcn_sched_barrier(0);
        if (more) PU_ISSUE(ean, uA);
        __builtin_amdgcn_sched_barrier(0);
#pragma unroll
        for (int q = 0; q < 8; ++q) v[8 + q] = dot16_fp8(hf, uB[q]);
        float w8[8], w4[4], w2[2];
        { const bool hi = (lane & 4) != 0;
#pragma unroll
          for (int m = 0; m < 8; ++m) { const float send = hi ? v[m] : v[m + 8], keep = hi ? v[m + 8] : v[m]; w8[m] = keep + __shfl_xor(send, 4); } }
        { const bool hi = (lane & 2) != 0;
#pragma unroll
          for (int m = 0; m < 4; ++m) { const float send = hi ? w8[m] : w8[m + 4], keep = hi ? w8[m + 4] : w8[m]; w4[m] = keep + __shfl_xor(send, 2); } }
        { const bool hi = (lane & 1) != 0;
#pragma unroll
          for (int m = 0; m < 2; ++m) { const float send = hi ? w4[m] : w4[m + 2], keep = hi ? w4[m + 2] : w4[m]; w2[m] = keep + __shfl_xor(send, 1); } }
        float* pr = part + (size_t)tok * 128;
        pr[0] = w2[0]; pr[8] = w2[1];
        if (!more) break;
        tok = tokn; ea = ean; eb = ebn; h0 = h0n; h1 = h1n;
    }
#undef PU_ISSUE
}
__device__ void phase_pc(const Params& p, int l, int bid, int nb) {
    const int tid_ = otid(); const int lane = tid_ & 63, wid = tid_ >> 6;
    const int* eidx = (const int*)(p.ws + OFF_Y); const float* gw = (const float*)(p.ws + OFF_Y + (size_t)T * 128 * 4);
    float* coef = (float*)(p.ws + OFF_Y + (size_t)T * 128 * 8);
    const float* part = (const float*)(p.ws + OFF_Z);
    const float* usc = (const float*)(p.ws + OFF_USC) + (size_t)l * NE; const float* vsc = (const float*)(p.ws + OFF_VSC) + (size_t)l * NE;
    for (int tok = bid * 4 + wid; tok < T; tok += nb * 4) {
#pragma unroll
        for (int hh = 0; hh < 2; ++hh) {
            const size_t j = (size_t)tok * 128 + hh * 64 + lane;
            const int e = eidx[j]; const float g = gw[j];
            float a = 0.f;
#pragma unroll
            for (int sl = 0; sl < 8; ++sl) a += part[(size_t)sl * T * 128 + j];
            coef[j] = g * gelu_f(a * usc[e]) * vsc[e];
        }
    }
}
__device__ void phase_pv(const Params& p, int l, int slice, int grank, int gsz) {
    const int tid_ = otid(); const int lane = tid_ & 63, wid = tid_ >> 6, sub = lane & 7, pg = lane >> 3;
    const char* V8 = p.ws + OFF_VB + ((size_t)(l * 8 + slice) * NE) * 128 + sub * 16;
    const int* eidx = (const int*)(p.ws + OFF_Y) + lane;
    const float* coef = (const float*)(p.ws + OFF_Y + (size_t)T * 128 * 8) + lane;
    const int col = slice * 128 + 16 * sub + 2 * pg;
    const float* g2p = (const float*)(p.ws + OFF_MOD) + (size_t)l * NB * 6144 + 5 * D + col;
    float* xcol = p.out + col;
    const int stride = gsz * 4;
#define PV_ISSUE(e_, c_, v_, cj_) do { _Pragma("unroll") for (int q = 0; q < 8; ++q) { const int ej = __shfl(e_, 8 * q + pg); cj_[q] = __shfl(c_, 8 * q + pg); v_[q] = *(const int4*)(V8 + (size_t)ej * 128); } } while (0)
    int tok = grank * 4 + wid;
    if (tok >= T) return;
    int4 vA[8], vB[8]; float cA[8], cB[8];
    int ea = eidx[(size_t)tok * 128], eb = eidx[(size_t)tok * 128 + 64];
    float ca = coef[(size_t)tok * 128], cb = coef[(size_t)tok * 128 + 64];
    PV_ISSUE(ea, ca, vA, cA);
#pragma nounroll
    for (;;) {
        __builtin_amdgcn_sched_barrier(0);
        const int tokn = tok + stride; const bool more = tokn < T;
        int ean = 0, ebn = 0; float can = 0.f, cbn = 0.f;
        if (more) { ean = eidx[(size_t)tokn * 128]; ebn = eidx[(size_t)tokn * 128 + 64]; can = coef[(size_t)tokn * 128]; cbn = coef[(size_t)tokn * 128 + 64]; }
        float2* xp = (float2*)(xcol + (size_t)tok * D); const float2 g2 = *(const float2*)(g2p + (size_t)(tok / SEQ) * 6144);
        float2 xv = *xp;
        PV_ISSUE(eb, cb, vB, cB);
        __builtin_amdgcn_sched_barrier(0);
        float o[16];
#pragma unroll
        for (int i = 0; i < 16; ++i) o[i] = 0.f;
#pragma unroll
        for (int q = 0; q < 8; ++q) axpy16_fp8(o, cA[q], vA[q]);
        __builtin_amdgcn_sched_barrier(0);
        if (more) PV_ISSUE(ean, can, vA, cA);
        __builtin_amdgcn_sched_barrier(0);
#pragma unroll
        for (int q = 0; q < 8; ++q) axpy16_fp8(o, cB[q], vB[q]);
        float t8[8], t4[4], t2[2];
        { const bool hi = (lane & 32) != 0;
#pragma unroll
          for (int m = 0; m < 8; ++m) { const float send = hi ? o[m] : o[m + 8], keep = hi ? o[m + 8] : o[m]; t8[m] = keep + __shfl_xor(send, 32); } }
        { const bool hi = (lane & 16) != 0;
#pragma unroll
          for (int m = 0; m < 4; ++m) { const float send = hi ? t8[m] : t8[m + 4], keep = hi ? t8[m + 4] : t8[m]; t4[m] = keep + __shfl_xor(send, 16); } }
        { const bool hi = (lane & 8) != 0;
#pragma unroll
          for (int m = 0; m < 2; ++m) { const float send = hi ? t4[m] : t4[m + 2], keep = hi ? t4[m + 2] : t4[m]; t2[m] = keep + __shfl_xor(send, 8); } }
        xv.x += g2.x * t2[0]; xv.y += g2.y * t2[1]; *xp = xv;
        if (!more) break;
        tok = tokn; ea = ean; eb = ebn; ca = can; cb = cbn;
    }
#undef PV_ISSUE
}
__device__ void phase_final_norm(const Params& p, int bid, int nb) {
    const int tid_ = otid(); const int lane = tid_ & 63, wid = tid_ >> 6;
    for (int tok = bid * 4 + wid; tok < T; tok += nb * 4) {
        float* xr = p.out + (size_t)tok * D;
        float4 v[4]; float ss = 0.f;
#pragma unroll
        for (int i = 0; i < 4; ++i) { v[i] = *(const float4*)(xr + i * 256 + lane * 4); ss += v[i].x * v[i].x + v[i].y * v[i].y + v[i].z * v[i].z + v[i].w * v[i].w; }
        ss = wave_sum(ss);
        const float rstd = rsqrtf(ss * (1.0f / D) + EPS);
#pragma unroll
        for (int i = 0; i < 4; ++i) { const float4 g = *(const float4*)(p.final_g + i * 256 + lane * 4);
            *(float4*)(xr + i * 256 + lane * 4) = make_float4(v[i].x * rstd * g.x, v[i].y * rstd * g.y, v[i].z * rstd * g.z, v[i].w * rstd * g.w); }
    }
}

#define XB_TMO      128
#define XB_XCNT(j)  (256  + 64 * (j))
#define XB_XSUB(j)  (1280 + 64 * (j))
#define XB_XGEN(j)  (2304 + 64 * (j))
#define XB_TOP      3328
#define XB_TOPGEN   3392
#define XCD_BAR_WORDS 3456
#define XB_SPIN_CAP (1u << 22)
__device__ __forceinline__ unsigned xb_ld(unsigned* p)              { return __hip_atomic_load(p, __ATOMIC_RELAXED, __HIP_MEMORY_SCOPE_AGENT); }
__device__ __forceinline__ unsigned xb_add(unsigned* p, unsigned v) { return __hip_atomic_fetch_add(p, v, __ATOMIC_RELAXED, __HIP_MEMORY_SCOPE_AGENT); }
__device__ __forceinline__ unsigned xb_xcc_id() { return (unsigned)__builtin_amdgcn_s_getreg((3 << 11) | 20) & 0xFu; }
#define XB_SPIN(cond, bar) do { unsigned _sp = 0; while (cond) { __builtin_amdgcn_s_sleep(1); \
    if ((++_sp & 255u) == 0u) { if (xb_ld(&(bar)[XB_TMO])) break; if (_sp > XB_SPIN_CAP) { atomicAdd(&(bar)[XB_TMO], 1u); break; } } } } while (0)
__device__ __forceinline__ void xcd_barrier_post(unsigned* bar, volatile LAS unsigned* st) {
    if (threadIdx.x == 0) { const unsigned x = xb_xcc_id(); st[3] = x; st[2] = xb_add(&bar[XB_XCNT(x)], 1u); }
}
__device__ __forceinline__ void xcd_barrier_complete(unsigned* bar, unsigned x, unsigned& nloc, unsigned& nx) {
    const unsigned G = gridDim.x * gridDim.y * gridDim.z;
    unsigned sum, cnt, mine, sp = 0u;
    for (;;) {
        sum = 0u; cnt = 0u; mine = 0u;
#pragma unroll
        for (unsigned j = 0; j < 16; ++j) { const unsigned c = xb_ld(&bar[XB_XCNT(j)]); sum += c; cnt += (c > 0u) ? 1u : 0u; mine = (j == x) ? c : mine; }
        if (sum == G) break;
        __builtin_amdgcn_s_sleep(1);
        if ((++sp & 255u) == 0u) { if (xb_ld(&bar[XB_TMO])) break; if (sp > XB_SPIN_CAP) { atomicAdd(&bar[XB_TMO], 1u); break; } }
    }
    nloc = mine > 0u ? mine : 1u; nx = cnt > 0u ? cnt : 1u;
}
__device__ __forceinline__ void xcd_barrier(unsigned* bar, volatile LAS unsigned* st) {
    asm volatile("s_waitcnt vmcnt(0)" ::: "memory");
    __syncthreads();
    if (threadIdx.x == 0) {
        __builtin_amdgcn_s_waitcnt(0);
        unsigned nloc = st[0], nx = st[1]; const unsigned x = st[3];
        if (nloc == 0u) { xcd_barrier_complete(bar, x, nloc, nx); st[0] = nloc; st[1] = nx; }
        const unsigned old = xb_add(&bar[XB_XSUB(x)], 1u);
        const unsigned gen = old / nloc;
        if (old + 1u == (gen + 1u) * nloc) {
            __builtin_amdgcn_fence(__ATOMIC_RELEASE, "agent");
            asm volatile("s_waitcnt vmcnt(0)" ::: "memory");
            const unsigned og = xb_add(&bar[XB_TOP], 1u);
            const unsigned tg = og / nx;
            if (og + 1u == (tg + 1u) * nx) xb_add(&bar[XB_TOPGEN], 1u);
            else XB_SPIN(xb_ld(&bar[XB_TOPGEN]) == tg, bar);
            __builtin_amdgcn_fence(__ATOMIC_ACQUIRE, "agent");
            xb_add(&bar[XB_XGEN(x)], 1u);
            asm volatile("s_waitcnt vmcnt(0)" ::: "memory");
        } else {
            XB_SPIN(xb_ld(&bar[XB_XGEN(x)]) == gen, bar);
            __builtin_amdgcn_fence(__ATOMIC_ACQUIRE, "agent");
            asm volatile("s_waitcnt vmcnt(0)" ::: "memory");
        }
    }
    __syncthreads();
}

#if MEGA
#if PROBE_A >= 0
#define TSTAMP(i) do { if (blockIdx.x == 0 && threadIdx.x == 0) ts[i] = __builtin_amdgcn_s_memrealtime(); } while (0)
#else
#define TSTAMP(i) do { } while (0)
#endif
__global__ void __launch_bounds__(256, 2) mega_kernel(Params p) {
    __shared__ __attribute__((aligned(16))) char smem[SMEM_BYTES];
    __shared__ uint4 xb_words;
#if PROBE_A >= 0
    __shared__ unsigned long long ts[26];
#endif
    cg::grid_group grid = cg::this_grid();
    const int bid = blockIdx.x, nb = gridDim.x;
    unsigned* bar = (unsigned*)(p.ws + OFF_BAR);
    if (threadIdx.x == 0) xb_words = make_uint4(0u, 0u, 0u, 0u);
    if (bid == 0) for (int i = threadIdx.x; i < XCD_BAR_WORDS; i += 256) bar[i] = 0u;
    TSTAMP(0);
    phase_prep(p, smem, bid, nb);
    grid.sync();
    volatile LAS unsigned* xst = (volatile LAS unsigned*)&xb_words;
    xcd_barrier_post(bar, xst);
    TSTAMP(1);
    phase_norm(p.x, p.norm1_g, (const float*)(p.ws + OFF_MOD), 0, D, (bf16_t*)(p.ws + OFF_H), bid, nb); xcd_barrier((unsigned*)(p.ws + OFF_BAR), (volatile LAS unsigned*)&xb_words);
    int slice, grank; const int gsz = nb / 8;
    {
        const unsigned myx = xst[3], myrank = xst[2];
        unsigned pre = 0;
#pragma unroll
        for (unsigned j = 0; j < 16; ++j) { const unsigned c = xb_ld(&bar[XB_XCNT(j)]); pre += (j < myx) ? c : 0u; }
        const int gi = __builtin_amdgcn_readfirstlane((int)(pre + myrank));
        slice = gi / gsz; grank = gi % gsz;
    }
#pragma nounroll
    for (int l = 0; l < NL; ++l) {
        TSTAMP(2 + 11 * l); phase_gemm1(p, l, smem, bid, nb); xcd_barrier((unsigned*)(p.ws + OFF_BAR), (volatile LAS unsigned*)&xb_words);
        TSTAMP(3 + 11 * l); phase_mix(p, l, smem, bid, nb); xcd_barrier((unsigned*)(p.ws + OFF_BAR), (volatile LAS unsigned*)&xb_words);
        TSTAMP(4 + 11 * l); phase_fftb(p, l, smem, bid, nb); xcd_barrier((unsigned*)(p.ws + OFF_BAR), (volatile LAS unsigned*)&xb_words);
        TSTAMP(5 + 11 * l); phase_gemm2(p, l, smem, bid, nb); xcd_barrier((unsigned*)(p.ws + OFF_BAR), (volatile LAS unsigned*)&xb_words);
        TSTAMP(6 + 11 * l); phase_norm(p.out, p.norm2_g + l * D, (const float*)(p.ws + OFF_MOD) + (size_t)l * NB * 6144, 3 * D, 4 * D, (bf16_t*)(p.ws + OFF_H), bid, nb); xcd_barrier((unsigned*)(p.ws + OFF_BAR), (volatile LAS unsigned*)&xb_words);
        TSTAMP(7 + 11 * l); phase_gemm3(p, l, smem, bid, nb); xcd_barrier((unsigned*)(p.ws + OFF_BAR), (volatile LAS unsigned*)&xb_words);
        TSTAMP(8 + 11 * l); phase_topk(p, l, smem, bid, nb); xcd_barrier((unsigned*)(p.ws + OFF_BAR), (volatile LAS unsigned*)&xb_words);
        TSTAMP(9 + 11 * l); phase_pu(p, l, slice, grank, gsz); xcd_barrier((unsigned*)(p.ws + OFF_BAR), (volatile LAS unsigned*)&xb_words);
        TSTAMP(10 + 11 * l); phase_pc(p, l, bid, nb); xcd_barrier((unsigned*)(p.ws + OFF_BAR), (volatile LAS unsigned*)&xb_words);
        TSTAMP(11 + 11 * l); phase_pv(p, l, slice, grank, gsz); xcd_barrier((unsigned*)(p.ws + OFF_BAR), (volatile LAS unsigned*)&xb_words);
        TSTAMP(12 + 11 * l);
        if (l + 1 < NL) { phase_norm(p.out, p.norm1_g + (l + 1) * D, (const float*)(p.ws + OFF_MOD) + (size_t)(l + 1) * NB * 6144, 0, D, (bf16_t*)(p.ws + OFF_H), bid, nb); xcd_barrier((unsigned*)(p.ws + OFF_BAR), (volatile LAS unsigned*)&xb_words); }
        else phase_final_norm(p, bid, nb);
    }
    TSTAMP(24);
#if PROBE_A >= 0
    if (bid == 0 && threadIdx.x == 0) p.out[0] += (float)(ts[PROBE_B] - ts[PROBE_A]) * 0.01f / PROBE_DIV;
#endif
}
#endif

extern "C" void kernel_launch(void* const* d_in, const int* in_sizes, int n_in, void* d_out, int out_size, void* d_ws, size_t ws_size, hipStream_t stream) {
    (void)in_sizes; (void)n_in; (void)out_size;
    if (ws_size < OFF_END) { fprintf(stderr, "workspace too small: %zu < %zu\n", ws_size, (size_t)OFF_END); return; }
    Params p{};
    p.x = (const float*)d_in[0]; p.c = (const float*)d_in[1]; p.mod_w = (const float*)d_in[2]; p.mod_b = (const float*)d_in[3]; p.norm1_g = (const float*)d_in[4];
    p.w_in = (const float*)d_in[5]; p.gmlp_ws = (const float*)d_in[6]; p.gmlp_bs = (const float*)d_in[7]; p.fnet_w = (const float*)d_in[8]; p.fnet_b = (const float*)d_in[9];
    p.gain_a = (const float*)d_in[10]; p.gain_b = (const float*)d_in[11]; p.w_out = (const float*)d_in[12]; p.norm2_g = (const float*)d_in[13]; p.wq = (const float*)d_in[14];
    p.k1 = (const float*)d_in[15]; p.k2 = (const float*)d_in[16]; p.pu = (const float*)d_in[17]; p.pv = (const float*)d_in[18]; p.final_g = (const float*)d_in[19];
    p.out = (float*)d_out; p.ws = (char*)d_ws;
#if MEGA
    static int grid_blocks = 0;
    if (!grid_blocks) {
        int dev = 0, cus = 0, per_cu = 0;
        hipGetDevice(&dev);
        hipDeviceGetAttribute(&cus, hipDeviceAttributeMultiprocessorCount, dev);
        hipOccupancyMaxActiveBlocksPerMultiprocessor(&per_cu, mega_kernel, 256, 0);
        if (per_cu > 2) per_cu = 2;
        grid_blocks = (cus * per_cu) / 8 * 8;
    }
    void* args[] = {&p};
    hipError_t e = hipLaunchCooperativeKernel((void*)mega_kernel, dim3(grid_blocks), dim3(256), args, 0, stream);
    if (e != hipSuccess) fprintf(stderr, "cooperative launch failed: %s (grid %d)\n", hipGetErrorString(e), grid_blocks);
#endif
}
```

```cpp
#include <hip/hip_runtime.h>
#include <hip/hip_cooperative_groups.h>
#include <cstdio>
#include <cstdint>
namespace cg = cooperative_groups;

#ifndef MEGA
#define MEGA 1
#endif
#ifndef PROBE_A
#define PROBE_A -1
#define PROBE_B 0
#define PROBE_DIV 10.0f
#endif

typedef unsigned short bf16_t;
typedef short bf16x8 __attribute__((ext_vector_type(8)));
typedef float f32x4 __attribute__((ext_vector_type(4)));
typedef __bf16 bf16x2_t __attribute__((ext_vector_type(2)));

constexpr int D = 1024, NB = 8, SEQ = 4096, T = NB * SEQ, NL = 2;
constexpr int NZ = 2048;
constexpr int NE = 16384;
constexpr float EPS = 1e-6f;

constexpr size_t OFF_MOD  = 0;
constexpr size_t OFF_W1T  = OFF_MOD  + (size_t)NL * NB * 6144 * 4;
constexpr size_t OFF_W2T  = OFF_W1T  + (size_t)NL * 2048 * 1024 * 2;
constexpr size_t OFF_WQT  = OFF_W2T  + (size_t)NL * 1024 * 1024 * 2;
constexpr size_t OFF_K12  = OFF_WQT  + (size_t)NL * 2048 * 1024 * 2;
constexpr size_t OFF_WSB  = OFF_K12  + (size_t)NL * 8 * 256 * 128 * 2;
constexpr size_t OFF_DA   = OFF_WSB  + (size_t)NL * 8 * 128 * 128 * 2;
constexpr size_t OFF_DB   = OFF_DA   + 128 * 128 * 2;
constexpr size_t OFF_TW   = OFF_DB   + 64 * 128 * 2;
constexpr size_t OFF_SSQA = OFF_TW   + 64 * 64 * 8;
constexpr size_t OFF_SSQB = OFF_SSQA + (size_t)T * 8 * 4;
constexpr size_t OFF_UB   = OFF_SSQB + (size_t)T * 8 * 4;
constexpr size_t OFF_VB   = OFF_UB   + (size_t)NL * NE * 1024;
constexpr size_t OFF_USC  = OFF_VB   + (size_t)NL * NE * 1024;
constexpr size_t OFF_VSC  = OFF_USC  + (size_t)NL * NE * 4;
constexpr size_t OFF_H    = OFF_VSC  + (size_t)NL * NE * 4;
constexpr size_t OFF_Z    = OFF_H    + (size_t)T * 1024 * 2;
constexpr size_t OFF_Y    = OFF_Z    + (size_t)T * 2048 * 2;
constexpr size_t OFF_BAR  = OFF_Y    + (size_t)T * 1024 * 2;
constexpr size_t OFF_XR   = OFF_BAR  + 16384;
constexpr size_t OFF_END  = OFF_XR   + (size_t)T * 1024 * 2;

struct Params {
    const float* x; const float* c; const float* mod_w; const float* mod_b; const float* norm1_g; const float* w_in;
    const float* gmlp_ws; const float* gmlp_bs; const float* fnet_w; const float* fnet_b; const float* gain_a; const float* gain_b;
    const float* w_out; const float* norm2_g; const float* wq; const float* k1; const float* k2; const float* pu; const float* pv; const float* final_g;
    float* out; char* ws;
};

constexpr int SMEM_BYTES = 73984;

__device__ __forceinline__ float bf2f(unsigned v) { return __uint_as_float(v << 16); }
typedef float f32x2_t __attribute__((ext_vector_type(2)));
__device__ __forceinline__ unsigned pk_bf16(float lo, float hi) { const f32x2_t v = {lo, hi}; return __builtin_bit_cast(unsigned, __builtin_convertvector(v, bf16x2_t)); }
__device__ __forceinline__ bf16_t f2bf(float f) { return (bf16_t)(pk_bf16(f, 0.f) & 0xffffu); }
__device__ __forceinline__ float gelu_f(float v) {
    const float t = __builtin_amdgcn_rcpf(fabsf(v) * 0.2316418882f + 1.0f);
    float q = t * 0.5307027145f + (-0.7265760135f); q = q * t + 0.7107068705f; q = q * t + (-0.142248368f); q = q * t + 0.127414796f; q = q * t;
    const float m = v * (q * __builtin_amdgcn_exp2f(v * v * (-0.72134752044f)));
    return v < 0.f ? m : v - m;
}
__device__ __forceinline__ int med3i(int a, int b, int c) { return max(min(a, b), min(max(a, b), c)); }
__device__ __forceinline__ int f2key(float f) { int b = __float_as_int(f); return b ^ ((b >> 31) & 0x7fffffff); }
__device__ __forceinline__ float key2f(int k) { return __int_as_float(k ^ ((k >> 31) & 0x7fffffff)); }
__device__ __forceinline__ float wave_sum(float v) {
#pragma unroll
    for (int o = 32; o >= 1; o >>= 1) v += __shfl_xor(v, o);
    return v;
}
__device__ __forceinline__ int otid() { int t = threadIdx.x; asm volatile("" : "+v"(t)); return t; }
#define MFMA16(a, b, c) __builtin_amdgcn_mfma_f32_16x16x32_bf16((a), (b), (c), 0, 0, 0)

__device__ void transpose_tile(const float* __restrict__ src, int ld, int k0, int n0, bf16_t* __restrict__ dst  , int dn0,
                               const float* __restrict__ kscale, float* tile  ) {
    const int tid = otid();
#pragma unroll
    for (int i = 0; i < 4; ++i) {
        const int r = (tid >> 4) + 16 * i, c4 = (tid & 15) * 4;
        const float4 v = *(const float4*)(src + (size_t)(k0 + r) * ld + n0 + c4);
        const float s = kscale ? kscale[k0 + r] : 1.0f;
        tile[r * 65 + c4 + 0] = v.x * s; tile[r * 65 + c4 + 1] = v.y * s; tile[r * 65 + c4 + 2] = v.z * s; tile[r * 65 + c4 + 3] = v.w * s;
    }
    __syncthreads();
    {
        const int n = tid >> 2, ks = (tid & 3) * 16;
        unsigned w[8];
#pragma unroll
        for (int j = 0; j < 8; ++j) w[j] = pk_bf16(tile[(ks + 2 * j) * 65 + n], tile[(ks + 2 * j + 1) * 65 + n]);
        uint4* d = (uint4*)(dst + (size_t)(dn0 + n) * 1024 + k0 + ks);
        d[0] = make_uint4(w[0], w[1], w[2], w[3]); d[1] = make_uint4(w[4], w[5], w[6], w[7]);
    }
    __syncthreads();
}

__device__ void phase_prep(const Params& p, char* smem, int bid, int nb) {
    const int tid = otid();
    const int gtid = bid * 256 + tid, gsz = nb * 256;
    char* ws = p.ws;
    {
        float* sc = (float*)smem;
        float* red = (float*)(smem + 32768);
        for (int i = tid; i < 8192; i += 256) { const float v = p.c[i]; sc[i] = v / (1.0f + __expf(-v)); }
        __syncthreads();
        float* mod = (float*)(ws + OFF_MOD);
        for (int item = bid; item < NL * 192; item += nb) {
            const int l = item / 192, n0 = (item % 192) * 32, nn = tid & 31, kq = tid >> 5;
            float acc[8];
#pragma unroll
            for (int b = 0; b < 8; ++b) acc[b] = 0.f;
            const float* W = p.mod_w + (size_t)l * 1024 * 6144 + n0 + nn;
#pragma nounroll
            for (int k0 = kq; k0 < 1024; k0 += 128) {
                float w[16];
#pragma unroll
                for (int u = 0; u < 16; ++u) w[u] = W[(size_t)(k0 + 8 * u) * 6144];
#pragma unroll
                for (int u = 0; u < 16; ++u)
#pragma unroll
                    for (int b = 0; b < 8; ++b) acc[b] += sc[b * 1024 + k0 + 8 * u] * w[u];
            }
#pragma unroll
            for (int b = 0; b < 8; ++b) red[(kq * 8 + b) * 32 + nn] = acc[b];
            __syncthreads();
            {
                const int b = tid >> 5;
                float s = 0.f;
#pragma unroll
                for (int q = 0; q < 8; ++q) s += red[(q * 8 + b) * 32 + nn];
                mod[((size_t)l * NB + b) * 6144 + n0 + nn] = s + p.mod_b[l * 6144 + n0 + nn];
            }
            __syncthreads();
        }
    }
    {
        float* tile = (float*)smem;
        for (int item = bid; item < NL * 1024; item += nb) {
            const int l = item / 1024, r = item % 1024;
            if (r < 256) {
                const int kt = r / 16, nt = r % 16;
                transpose_tile(p.w_in + (size_t)l * 1024 * 1536, 1536, kt * 64, nt * 64, (bf16_t*)(ws + OFF_W1T) + (size_t)l * 2048 * 1024, nt * 64, nullptr, tile);
            } else if (r < 512) {
                const int rr = r - 256, kt = rr / 16, nt = rr % 16;
                const float* gk = (kt < 8) ? (p.gain_a + l * 512) : (p.gain_b + l * 512 - 512);
                transpose_tile(p.w_out + (size_t)l * 1024 * 1024, 1024, kt * 64, nt * 64, (bf16_t*)(ws + OFF_W2T) + (size_t)l * 1024 * 1024, nt * 64, gk, tile);
            } else {
                const int rr = r - 512, kt = rr / 32, nt = rr % 32;
                transpose_tile(p.wq + (size_t)l * 1024 * 2048, 2048, kt * 64, nt * 64, (bf16_t*)(ws + OFF_WQT) + (size_t)l * 2048 * 1024, nt * 64, nullptr, tile);
            }
        }
    }
    {
        float* fws = (float*)smem;
        float* Ms  = (float*)(smem + 16384);
        float* wt  = (float*)(smem + 49152);
        float* cs  = (float*)(smem + 49152 + 16640);
        for (int item = bid; item < NL * 8 * 16; item += nb) {
            const int l = item / 128, g = (item % 128) / 16, kt = item % 16;
            if (tid < 64) { float s, c; sincospif((float)tid / 32.0f, &s, &c); cs[tid] = c; cs[64 + tid] = s; }
            for (int i = tid; i < 4096; i += 256) fws[i] = p.fnet_w[((size_t)l * 8 + g) * 4096 + i];
#pragma unroll
            for (int i = 0; i < 4; ++i) {
                const int r = (tid >> 4) + 16 * i, c4 = (tid & 15) * 4;
                const float4 v = *(const float4*)(p.w_in + (size_t)l * 1024 * 1536 + (size_t)(kt * 64 + r) * 1536 + 1024 + g * 64 + c4);
                wt[r * 65 + c4] = v.x; wt[r * 65 + c4 + 1] = v.y; wt[r * 65 + c4 + 2] = v.z; wt[r * 65 + c4 + 3] = v.w;
            }
            __syncthreads();
            {
                const int d = tid >> 2, r0 = (tid & 3) * 32;
                const bool im = r0 >= 64; const int e0 = r0 & 63;
                float acc[32];
#pragma unroll
                for (int e = 0; e < 32; ++e) acc[e] = 0.f;
                for (int j = 0; j < 64; ++j) {
                    const int ph = (d * j) & 63;
                    const float t = im ? -cs[64 + ph] : cs[ph];
#pragma unroll
                    for (int e = 0; e < 32; ++e) acc[e] += t * fws[j * 64 + e0 + e];
                }
#pragma unroll
                for (int e = 0; e < 32; ++e) Ms[d * 128 + r0 + e] = acc[e];
            }
            __syncthreads();
            {
                const int r = tid >> 1, kk0 = (tid & 1) * 32;
                float acc[32];
#pragma unroll
                for (int k = 0; k < 32; ++k) acc[k] = 0.f;
                for (int d = 0; d < 64; ++d) {
                    const float m = Ms[d * 128 + r];
#pragma unroll
                    for (int k = 0; k < 32; ++k) acc[k] += wt[(kk0 + k) * 65 + d] * m;
                }
                bf16_t* dst = (bf16_t*)(ws + OFF_W1T) + (size_t)l * 2048 * 1024 + (size_t)(1024 + g * 128 + r) * 1024 + kt * 64 + kk0;
#pragma unroll
                for (int q = 0; q < 4; ++q)
                    ((uint4*)dst)[q] = make_uint4(pk_bf16(acc[q * 8], acc[q * 8 + 1]), pk_bf16(acc[q * 8 + 2], acc[q * 8 + 3]), pk_bf16(acc[q * 8 + 4], acc[q * 8 + 5]), pk_bf16(acc[q * 8 + 6], acc[q * 8 + 7]));
            }
            __syncthreads();
        }
    }
    {
        bf16_t* k12 = (bf16_t*)(ws + OFF_K12);
        for (int i = gtid; i < NL * 8 * 256 * 128; i += gsz) {
            const int d = i & 127, n = (i >> 7) & 255, h = (i >> 15) & 7, l = i >> 18;
            const float* src = (n < 128) ? p.k1 : p.k2;
            k12[i] = f2bf(src[(((size_t)l * 8 + h) * 128 + (n & 127)) * 128 + d]);
        }
        bf16_t* wsb = (bf16_t*)(ws + OFF_WSB);
        for (int i = gtid; i < NL * 8 * 128 * 128; i += gsz) wsb[i] = f2bf(p.gmlp_ws[i]);
        bf16_t* DA = (bf16_t*)(ws + OFF_DA);
        for (int i = gtid; i < 128 * 128; i += gsz) {
            const int m = i >> 7, kk = i & 127, ro = m >> 6, k1 = m & 63, ri = kk >> 6, a = kk & 63;
            float s, c; sincospif((float)((a * k1) & 63) / 32.0f, &s, &c);
            const float v = (ro == ri) ? c : (ro == 0 ? s : -s);
            DA[i] = f2bf(v);
        }
        bf16_t* DB = (bf16_t*)(ws + OFF_DB);
        for (int i = gtid; i < 64 * 128; i += gsz) {
            const int k2 = i >> 7, kk = i & 127, ri = kk >> 6, b = kk & 63;
            float s, c; sincospif((float)((b * k2) & 63) / 32.0f, &s, &c);
            DB[i] = f2bf(ri ? s : c);
        }
        float2* tw = (float2*)(ws + OFF_TW);
        for (int i = gtid; i < 64 * 64; i += gsz) {
            const int bp = i >> 6, k1 = i & 63;
            float s, c; sincospif((float)(bp * k1) / 2048.0f, &s, &c);
            tw[i] = make_float2(c, s);
        }
        {
            const int lane = tid & 63, wv = gtid >> 6, nwv = gsz >> 6;
            const int R = 2 * NL * NE;
#pragma nounroll
            for (int r0 = wv; r0 < R; r0 += 2 * nwv) {
                float4 v[2][4];
#pragma unroll
                for (int t = 0; t < 2; ++t) {
                    const int r = (r0 + t * nwv < R) ? r0 + t * nwv : r0;
                    const int tbl = r / (NL * NE), row = r % (NL * NE);
                    const float* src = (tbl ? p.pv : p.pu) + (size_t)row * 1024 + lane * 16;
#pragma unroll
                    for (int i = 0; i < 4; ++i) v[t][i] = ((const float4*)src)[i];
                }
#pragma unroll
                for (int t = 0; t < 2; ++t) {
                    const int r = r0 + t * nwv;
                    if (r >= R) break;
                    const int tbl = r / (NL * NE), row = r % (NL * NE);
                    float m = 0.f;
#pragma unroll
                    for (int i = 0; i < 4; ++i) m = fmaxf(m, fmaxf(fmaxf(fabsf(v[t][i].x), fabsf(v[t][i].y)), fmaxf(fabsf(v[t][i].z), fabsf(v[t][i].w))));
#pragma unroll
                    for (int o = 32; o >= 1; o >>= 1) m = fmaxf(m, __shfl_xor(m, o));
                    const float sc = (m > 0.f) ? 256.0f / m : 1.0f, inv = (m > 0.f) ? m * (1.0f / 256.0f) : 1.0f;
                    int w[4];
#pragma unroll
                    for (int i = 0; i < 4; ++i) { w[i] = __builtin_amdgcn_cvt_pk_fp8_f32(v[t][i].x * sc, v[t][i].y * sc, 0, false); w[i] = __builtin_amdgcn_cvt_pk_fp8_f32(v[t][i].z * sc, v[t][i].w * sc, w[i], true); }
                    const int lyr = row / NE, ex = row % NE;
                    *(int4*)(ws + (tbl ? OFF_VB : OFF_UB) + ((size_t)(lyr * 8 + (lane >> 3)) * NE + ex) * 128 + (lane & 7) * 16) = make_int4(w[0], w[1], w[2], w[3]);
                    if (lane == 0) ((float*)(ws + (tbl ? OFF_VSC : OFF_USC)))[row] = inv;
                }
            }
        }
    }
}

template <bool SRC_BF16>
__device__ void phase_norm(const void* __restrict__ xsrc_, const float* __restrict__ g, const float* __restrict__ modl  , int sh_off, int scl_off,
                           bf16_t* __restrict__ hout, int bid, int nb) {
    const int tid_ = otid(); const int lane = tid_ & 63, wid = tid_ >> 6;
    for (int tok = bid * 4 + wid; tok < T; tok += nb * 4) {
        const int b = tok / SEQ;
        float4 v[4];
        float ss = 0.f;
#pragma unroll
        for (int i = 0; i < 4; ++i) {
            if (SRC_BF16) { const uint2 w = *(const uint2*)((const bf16_t*)xsrc_ + (size_t)tok * D + i * 256 + lane * 4); v[i] = make_float4(bf2f(w.x & 0xffffu), bf2f(w.x >> 16), bf2f(w.y & 0xffffu), bf2f(w.y >> 16)); }
            else v[i] = *(const float4*)((const float*)xsrc_ + (size_t)tok * D + i * 256 + lane * 4);
            ss += v[i].x * v[i].x + v[i].y * v[i].y + v[i].z * v[i].z + v[i].w * v[i].w;
        }
        ss = wave_sum(ss);
        const float rstd = rsqrtf(ss * (1.0f / D) + EPS);
        const float* mb = modl + (size_t)b * 6144;
#pragma unroll
        for (int i = 0; i < 4; ++i) {
            const int cidx = i * 256 + lane * 4;
            const float4 gg = *(const float4*)(g + cidx), sh = *(const float4*)(mb + sh_off + cidx), sc = *(const float4*)(mb + scl_off + cidx);
            const float o0 = v[i].x * rstd * gg.x * (1.0f + sc.x) + sh.x, o1 = v[i].y * rstd * gg.y * (1.0f + sc.y) + sh.y;
            const float o2 = v[i].z * rstd * gg.z * (1.0f + sc.z) + sh.z, o3 = v[i].w * rstd * gg.w * (1.0f + sc.w) + sh.w;
            *(uint2*)(hout + (size_t)tok * D + cidx) = make_uint2(pk_bf16(o0, o1), pk_bf16(o2, o3));
        }
    }
}

#define LAS __attribute__((address_space(3)))
template <class Epi, class MidK>
__device__ __forceinline__ void gemm_tile(const bf16_t* __restrict__ A, int lda, const bf16_t* __restrict__ Bt, int ldb, int K, int m0, int n0,
                                          char* smem, const Epi& epi, const MidK& midk, int kmid) {
    const int tid = otid(), lane = tid & 63, wid = tid >> 6, wr = wid >> 1, wc = wid & 1, fr = lane & 15, fq = lane >> 4;
    LAS char* lds = (LAS char*)smem;
    f32x4 acc[4][4];
#pragma unroll
    for (int i = 0; i < 4; ++i)
#pragma unroll
        for (int j = 0; j < 4; ++j) acc[i][j] = (f32x4){0.f, 0.f, 0.f, 0.f};
    const int prow = lane >> 3, pch = (lane & 7) ^ prow;
    const bf16_t* ga = A + (size_t)(m0 + wid * 32 + prow) * lda + pch * 8;
    const bf16_t* gb = Bt + (size_t)(n0 + wid * 32 + prow) * ldb + pch * 8;
    const int nk = K / 64;
#define GEMM_STAGE(kt_, buf_) do { _Pragma("unroll") for (int i_ = 0; i_ < 4; ++i_) { \
        __builtin_amdgcn_global_load_lds((const unsigned*)(ga + (size_t)(i_ * 8) * lda + (kt_) * 64), (LAS unsigned*)(lds + (buf_) * 16384 + (wid * 32 + i_ * 8) * 128), 16, 0, 0); \
        __builtin_amdgcn_global_load_lds((const unsigned*)(gb + (size_t)(i_ * 8) * ldb + (kt_) * 64), (LAS unsigned*)(lds + 32768 + (buf_) * 16384 + (wid * 32 + i_ * 8) * 128), 16, 0, 0); } } while (0)
    GEMM_STAGE(0, 0);
    const int swz = fr & 7;
    for (int kt = 0; kt < nk; ++kt) {
        const int cur = kt & 1;
        asm volatile("s_waitcnt vmcnt(0)" ::: "memory");
        __syncthreads();
        if (kt + 1 < nk) GEMM_STAGE(kt + 1, cur ^ 1);
        if (kt == kmid) {
#pragma unroll
            for (int i = 0; i < 4; ++i) { const float sc = midk(m0 + wr * 64 + i * 16 + fr);
#pragma unroll
                for (int j = 0; j < 4; ++j) acc[i][j] *= sc; }
        }
        const LAS char* ca = lds + cur * 16384; const LAS char* cb = lds + 32768 + cur * 16384;
#pragma unroll
        for (int ks = 0; ks < 2; ++ks) {
            bf16x8 af[4], bfr[4];
            const int coff = ((ks * 4 + fq) ^ swz) * 16;
#pragma unroll
            for (int i = 0; i < 4; ++i) af[i] = *(const LAS bf16x8*)(ca + (wr * 64 + i * 16 + fr) * 128 + coff);
#pragma unroll
            for (int j = 0; j < 4; ++j) bfr[j] = *(const LAS bf16x8*)(cb + (wc * 64 + j * 16 + fr) * 128 + coff);
#pragma unroll
            for (int i = 0; i < 4; ++i)
#pragma unroll
                for (int j = 0; j < 4; ++j) acc[i][j] = MFMA16(bfr[j], af[i], acc[i][j]);
        }
    }
#undef GEMM_STAGE
#pragma unroll
    for (int i = 0; i < 4; ++i)
#pragma unroll
        for (int j = 0; j < 4; ++j) { epi(m0 + wr * 64 + i * 16 + fr, n0 + wc * 64 + j * 16 + fq * 4, acc[i][j]); __builtin_amdgcn_sched_barrier(0); }
    __syncthreads();
}
struct NoMid { __device__ __forceinline__ float operator()(int) const { return 1.0f; } };

__device__ void phase_gemm1(const Params& p, int l, char* smem, int bid, int nb) {
    const bf16_t* A = (const bf16_t*)(p.ws + OFF_H);
    const bf16_t* Bt = (const bf16_t*)(p.ws + OFF_W1T) + (size_t)l * 2048 * 1024;
    bf16_t* Z = (bf16_t*)(p.ws + OFF_Z);
    auto epi_gelu = [&](int row, int col, const f32x4& v) {
        *(uint2*)(Z + (size_t)row * NZ + col) = make_uint2(pk_bf16(gelu_f(v[0]), gelu_f(v[1])), pk_bf16(gelu_f(v[2]), gelu_f(v[3])));
    };
    auto epi_plain = [&](int row, int col, const f32x4& v) { *(uint2*)(Z + (size_t)row * NZ + col) = make_uint2(pk_bf16(v[0], v[1]), pk_bf16(v[2], v[3])); };
    const int NT = NZ / 128, MT = T / 128;
    for (int item = bid; item < MT * NT; item += nb) {
        const int n0 = (item % NT) * 128;
        if (n0 < 1024) gemm_tile(A, D, Bt, D, D, (item / NT) * 128, n0, smem, epi_gelu, NoMid(), -1);
        else           gemm_tile(A, D, Bt, D, D, (item / NT) * 128, n0, smem, epi_plain, NoMid(), -1);
    }
}
__device__ void phase_gemm2(const Params& p, int l, char* smem, int bid, int nb) {
    const bf16_t* A = (const bf16_t*)(p.ws + OFF_Y);
    const bf16_t* Bt = (const bf16_t*)(p.ws + OFF_W2T) + (size_t)l * 1024 * 1024;
    const float* ssa = (const float*)(p.ws + OFF_SSQA); const float* ssb = (const float*)(p.ws + OFF_SSQB);
    const float* mod = (const float*)(p.ws + OFF_MOD) + (size_t)l * NB * 6144;
    bf16_t* XR = (bf16_t*)(p.ws + OFF_XR);
    auto rstd_of = [&](const float* s, int row) {
        const float4 a = *(const float4*)(s + (size_t)row * 8), b = *(const float4*)(s + (size_t)row * 8 + 4);
        return rsqrtf(((a.x + a.y) + (a.z + a.w) + (b.x + b.y) + (b.z + b.w)) * (1.0f / 512.0f) + EPS);
    };
    auto midk = [&](int row) { return rstd_of(ssa, row) / rstd_of(ssb, row); };
    auto epi = [&](int row, int col, const f32x4& v) {
        const float rb = rstd_of(ssb, row);
        const int b = row / SEQ;
        const float4 g = *(const float4*)(mod + (size_t)b * 6144 + 2 * D + col);
        float4 xi;
        if (l == 0) xi = *(const float4*)(p.x + (size_t)row * D + col);
        else { const uint2 w = *(const uint2*)(XR + (size_t)row * D + col); xi = make_float4(bf2f(w.x & 0xffffu), bf2f(w.x >> 16), bf2f(w.y & 0xffffu), bf2f(w.y >> 16)); }
        *(uint2*)(XR + (size_t)row * D + col) = make_uint2(pk_bf16(xi.x + g.x * rb * v[0], xi.y + g.y * rb * v[1]), pk_bf16(xi.z + g.z * rb * v[2], xi.w + g.w * rb * v[3]));
    };
    const int NT = D / 128, MT = T / 128;
    for (int item = bid; item < MT * NT; item += nb) gemm_tile(A, D, Bt, D, D, (item / NT) * 128, (item % NT) * 128, smem, epi, midk, 8);
}
__device__ void phase_gemm3(const Params& p, int l, char* smem, int bid, int nb) {
    const bf16_t* A = (const bf16_t*)(p.ws + OFF_H);
    const bf16_t* Bt = (const bf16_t*)(p.ws + OFF_WQT) + (size_t)l * 2048 * 1024;
    bf16_t* Q = (bf16_t*)(p.ws + OFF_Z);
    auto epi = [&](int row, int col, const f32x4& v) { *(uint2*)(Q + (size_t)row * 2048 + col) = make_uint2(pk_bf16(v[0], v[1]), pk_bf16(v[2], v[3])); };
    const int NT = 2048 / 128, MT = T / 128;
    for (int item = bid; item < MT * NT; item += nb) gemm_tile(A, D, Bt, D, D, (item / NT) * 128, (item % NT) * 128, smem, epi, NoMid(), -1);
}

constexpr int TP = 136;
__device__ __forceinline__ void stage_transposed(const bf16_t* __restrict__ base, size_t row_stride, bf16_t* dT) {
    const int tid = otid(), r = tid >> 2, part = tid & 3, ri = part >> 1, c0 = (part & 1) * 32;
    const uint4* src = (const uint4*)(base + (size_t)r * row_stride + ri * 64 + c0);
    uint4 v[4];
#pragma unroll
    for (int i = 0; i < 4; ++i) v[i] = src[i];
#pragma unroll
    for (int i = 0; i < 4; ++i) {
        const unsigned w[4] = {v[i].x, v[i].y, v[i].z, v[i].w};
#pragma unroll
        for (int j = 0; j < 4; ++j) {
            dT[(c0 + i * 8 + j * 2) * TP + ri * 64 + r] = (bf16_t)(w[j] & 0xffffu);
            dT[(c0 + i * 8 + j * 2 + 1) * TP + ri * 64 + r] = (bf16_t)(w[j] >> 16);
        }
    }
}

__device__ void gmlp_item(const Params& p, int l, int item, char* smem) {
    const int tid = otid(), lane = tid & 63, wid = tid >> 6, fr = lane & 15, fq = lane >> 4;
    const int h = item & 7, c = (item >> 3) & 31, b = item >> 8;
    const int tok0 = b * SEQ + c * 128;
    bf16_t* vnT = (bf16_t*)smem;
    const bf16_t* Z = (const bf16_t*)(p.ws + OFF_Z);
    {
        const int q = tid >> 1, half = tid & 1, d0 = half * 32;
        const uint4* src = (const uint4*)(Z + (size_t)(tok0 + q) * NZ + 512 + h * 64 + d0);
        float f[32];
#pragma unroll
        for (int i = 0; i < 4; ++i) { const uint4 v = src[i]; const unsigned w[4] = {v.x, v.y, v.z, v.w};
#pragma unroll
            for (int j = 0; j < 4; ++j) { f[i * 8 + j * 2] = bf2f(w[j] & 0xffffu); f[i * 8 + j * 2 + 1] = bf2f(w[j] >> 16); } }
        float s = 0.f;
#pragma unroll
        for (int i = 0; i < 32; ++i) s += f[i];
        s += __shfl_xor(s, 1);
        const float mean = s * (1.0f / 64.0f);
        float qv = 0.f;
#pragma unroll
        for (int i = 0; i < 32; ++i) { f[i] -= mean; qv += f[i] * f[i]; }
        qv += __shfl_xor(qv, 1);
        const float rstd = rsqrtf(qv * (1.0f / 64.0f) + EPS);
#pragma unroll
        for (int i = 0; i < 32; ++i) vnT[(d0 + i) * TP + q] = f2bf(f[i] * rstd);
    }
    __syncthreads();
    const bf16_t* Wsb = (const bf16_t*)(p.ws + OFF_WSB) + ((size_t)l * 8 + h) * 128 * 128;
    f32x4 acc[2][4];
#pragma unroll
    for (int i = 0; i < 2; ++i)
#pragma unroll
        for (int j = 0; j < 4; ++j) acc[i][j] = (f32x4){0.f, 0.f, 0.f, 0.f};
    const int p0 = wid * 32;
#pragma unroll
    for (int ks = 0; ks < 4; ++ks) {
        bf16x8 af[2], bfr[4];
#pragma unroll
        for (int i = 0; i < 2; ++i) af[i] = *(const bf16x8*)(Wsb + (size_t)(p0 + i * 16 + fr) * 128 + ks * 32 + fq * 8);
#pragma unroll
        for (int j = 0; j < 4; ++j) bfr[j] = *(const bf16x8*)(vnT + (j * 16 + fr) * TP + ks * 32 + fq * 8);
#pragma unroll
        for (int i = 0; i < 2; ++i)
#pragma unroll
            for (int j = 0; j < 4; ++j) acc[i][j] = MFMA16(bfr[j], af[i], acc[i][j]);
    }
    bf16_t* Y = (bf16_t*)(p.ws + OFF_Y);
    float* ssa = (float*)(p.ws + OFF_SSQA);
#pragma unroll
    for (int i = 0; i < 2; ++i) {
        const int pp = p0 + i * 16 + fr, tok = tok0 + pp;
        const float bsv = p.gmlp_bs[((size_t)l * 8 + h) * 128 + pp];
        float ss = 0.f;
#pragma unroll
        for (int j = 0; j < 4; ++j) {
            const int d = j * 16 + fq * 4;
            const uint2 uu = *(const uint2*)(Z + (size_t)tok * NZ + h * 64 + d);
            const float y0 = bf2f(uu.x & 0xffffu) * (acc[i][j][0] + bsv), y1 = bf2f(uu.x >> 16) * (acc[i][j][1] + bsv);
            const float y2 = bf2f(uu.y & 0xffffu) * (acc[i][j][2] + bsv), y3 = bf2f(uu.y >> 16) * (acc[i][j][3] + bsv);
            ss += y0 * y0 + y1 * y1 + y2 * y2 + y3 * y3;
            *(uint2*)(Y + (size_t)tok * D + h * 64 + d) = make_uint2(pk_bf16(y0, y1), pk_bf16(y2, y3));
        }
        ss += __shfl_xor(ss, 16); ss += __shfl_xor(ss, 32);
        if (fq == 0) ssa[(size_t)tok * 8 + h] = ss;
    }
    __syncthreads();
}

__device__ void ffta_item(const Params& p, int item, char* smem) {
    const int tid = otid(), lane = tid & 63, wid = tid >> 6, fr = lane & 15, fq = lane >> 4;
    const int bp = item & 63, g = (item >> 6) & 7, b = item >> 9;
    bf16_t* dT = (bf16_t*)smem;
    const bf16_t* Z = (const bf16_t*)(p.ws + OFF_Z);
    stage_transposed(Z + (size_t)(b * SEQ + bp) * NZ + 1024 + g * 128, (size_t)64 * NZ, dT);
    __syncthreads();
    const bf16_t* DA = (const bf16_t*)(p.ws + OFF_DA);
    f32x4 acc[2][4];
#pragma unroll
    for (int i = 0; i < 2; ++i)
#pragma unroll
        for (int j = 0; j < 4; ++j) acc[i][j] = (f32x4){0.f, 0.f, 0.f, 0.f};
#pragma unroll
    for (int ks = 0; ks < 4; ++ks) {
        bf16x8 af[2], bfr[4];
#pragma unroll
        for (int i = 0; i < 2; ++i) af[i] = *(const bf16x8*)(DA + (size_t)(i * 64 + wid * 16 + fr) * 128 + ks * 32 + fq * 8);
#pragma unroll
        for (int j = 0; j < 4; ++j) bfr[j] = *(const bf16x8*)(dT + (j * 16 + fr) * TP + ks * 32 + fq * 8);
#pragma unroll
        for (int i = 0; i < 2; ++i)
#pragma unroll
            for (int j = 0; j < 4; ++j) acc[i][j] = MFMA16(bfr[j], af[i], acc[i][j]);
    }
    const int k1 = wid * 16 + fr;
    const float2 cs = ((const float2*)(p.ws + OFF_TW))[bp * 64 + k1];
    bf16_t* Yb = (bf16_t*)(p.ws + OFF_H) + ((((size_t)(b * 8 + g) * 64 + k1) * 64 + bp) * 128);
#pragma unroll
    for (int j = 0; j < 4; ++j) {
        const int ch = j * 16 + fq * 4;
        float yr[4], yi[4];
#pragma unroll
        for (int e = 0; e < 4; ++e) { const float r = acc[0][j][e], im = acc[1][j][e]; yr[e] = r * cs.x + im * cs.y; yi[e] = im * cs.x - r * cs.y; }
        *(uint2*)(Yb + ch) = make_uint2(pk_bf16(yr[0], yr[1]), pk_bf16(yr[2], yr[3]));
        *(uint2*)(Yb + 64 + ch) = make_uint2(pk_bf16(yi[0], yi[1]), pk_bf16(yi[2], yi[3]));
    }
    __syncthreads();
}

__device__ void phase_mix(const Params& p, int l, char* smem, int bid, int nb) {
    for (int item = bid; item < 2048 + 4096; item += nb) {
        if (item < 2048) gmlp_item(p, l, item, smem); else ffta_item(p, item - 2048, smem);
    }
}

__device__ void phase_fftb(const Params& p, int l, char* smem, int bid, int nb) {
    const int tid = otid(), lane = tid & 63, wid = tid >> 6, fr = lane & 15, fq = lane >> 4;
    bf16_t* dT = (bf16_t*)smem;
    const bf16_t* DB = (const bf16_t*)(p.ws + OFF_DB);
    bf16_t* Y = (bf16_t*)(p.ws + OFF_Y);
    float* ssb = (float*)(p.ws + OFF_SSQB);
    for (int item = bid; item < 4096; item += nb) {
        const int k1 = item & 63, g = (item >> 6) & 7, b = item >> 9;
        stage_transposed((const bf16_t*)(p.ws + OFF_H) + (((size_t)(b * 8 + g) * 64 + k1) * 64) * 128, 128, dT);
        __syncthreads();
        f32x4 acc[4];
#pragma unroll
        for (int j = 0; j < 4; ++j) acc[j] = (f32x4){0.f, 0.f, 0.f, 0.f};
#pragma unroll
        for (int ks = 0; ks < 4; ++ks) {
            const bf16x8 af = *(const bf16x8*)(DB + (size_t)(wid * 16 + fr) * 128 + ks * 32 + fq * 8);
#pragma unroll
            for (int j = 0; j < 4; ++j) { const bf16x8 bfr = *(const bf16x8*)(dT + (j * 16 + fr) * TP + ks * 32 + fq * 8); acc[j] = MFMA16(bfr, af, acc[j]); }
        }
        const int k2 = wid * 16 + fr, tok = b * SEQ + k1 + 64 * k2;
        float ss = 0.f;
#pragma unroll
        for (int j = 0; j < 4; ++j) {
            const int ch = j * 16 + fq * 4;
            const float4 fb = *(const float4*)(p.fnet_b + ((size_t)l * 8 + g) * 64 + ch);
            const float y0 = acc[j][0] * (1.0f / 512.0f) + fb.x, y1 = acc[j][1] * (1.0f / 512.0f) + fb.y, y2 = acc[j][2] * (1.0f / 512.0f) + fb.z, y3 = acc[j][3] * (1.0f / 512.0f) + fb.w;
            ss += y0 * y0 + y1 * y1 + y2 * y2 + y3 * y3;
            *(uint2*)(Y + (size_t)tok * D + 512 + g * 64 + ch) = make_uint2(pk_bf16(y0, y1), pk_bf16(y2, y3));
        }
        ss += __shfl_xor(ss, 16); ss += __shfl_xor(ss, 32);
        if (fq == 0) ssb[(size_t)tok * 8 + g] = ss;
        __syncthreads();
    }
}

#define INS16(a, v) do { a[15] = med3i(a[14], a[15], v); a[14] = med3i(a[13], a[14], v); a[13] = med3i(a[12], a[13], v); a[12] = med3i(a[11], a[12], v); \
    a[11] = med3i(a[10], a[11], v); a[10] = med3i(a[9], a[10], v); a[9] = med3i(a[8], a[9], v); a[8] = med3i(a[7], a[8], v); a[7] = med3i(a[6], a[7], v); \
    a[6] = med3i(a[5], a[6], v); a[5] = med3i(a[4], a[5], v); a[4] = med3i(a[3], a[4], v); a[3] = med3i(a[2], a[3], v); a[2] = med3i(a[1], a[2], v); \
    a[1] = med3i(a[0], a[1], v); a[0] = max(a[0], v); } while (0)

template <int I, int J> struct CandLoop {
    static __device__ __forceinline__ void run(int (&a)[16], const float (&f1)[16], const float (&f2)[16]) {
        if constexpr ((I + 1) * (J + 1) <= 16) { const int key = (f2key(f1[I] + f2[J]) & ~255) | (I * 16 + J); INS16(a, key); }
        if constexpr (J + 1 < 16) CandLoop<I, J + 1>::run(a, f1, f2);
        else if constexpr (I + 1 < 16) CandLoop<I + 1, 0>::run(a, f1, f2);
    }
};

typedef _Float16 f16x2_t __attribute__((ext_vector_type(2)));
__device__ __forceinline__ unsigned pk_f16(float lo, float hi) { const f16x2_t v = {(_Float16)lo, (_Float16)hi}; return __builtin_bit_cast(unsigned, v); }
__device__ __forceinline__ int h2key(unsigned bits16) { const int b = (int)(short)bits16; return b ^ ((b >> 15) & 0x7fff); }
__device__ __forceinline__ float key2h(int k) { const int b = k ^ ((k >> 15) & 0x7fff); return (float)__builtin_bit_cast(_Float16, (unsigned short)(b & 0xffff)); }

__device__ void phase_topk(const Params& p, int l, char* smem, int bid, int nb) {
    const int tid = otid(), lane = tid & 63, wid = tid >> 6, fr = lane & 15, fq = lane >> 4;
    unsigned* S32 = (unsigned*)smem;
    int* TT = (int*)smem;
    const bf16_t* Q = (const bf16_t*)(p.ws + OFF_Z);
    int* eidx = (int*)(p.ws + OFF_Y); float* gw = (float*)(p.ws + OFF_Y + (size_t)T * 128 * 4);
    const int hh = wid >> 1, half = wid & 1;
    for (int item = bid; item < (T / 64) * 4; item += nb) {
        const int hp = item & 3, tok0 = (item >> 2) * 64, h = hp * 2 + hh;
        const bf16_t* Kh = (const bf16_t*)(p.ws + OFF_K12) + (((size_t)l * 8 + h) * 256 + half * 128) * 128;
        const bf16_t* Qh = Q + (size_t)tok0 * 2048 + h * 256 + half * 128;
#pragma unroll
        for (int mp = 0; mp < 2; ++mp) {
            f32x4 acc[2][8];
#pragma unroll
            for (int i = 0; i < 2; ++i)
#pragma unroll
                for (int j = 0; j < 8; ++j) acc[i][j] = (f32x4){0.f, 0.f, 0.f, 0.f};
#pragma unroll
            for (int ks = 0; ks < 4; ++ks) {
                bf16x8 af[2], bfr[8];
#pragma unroll
                for (int i = 0; i < 2; ++i) af[i] = *(const bf16x8*)(Qh + (size_t)((mp * 2 + i) * 16 + fr) * 2048 + ks * 32 + fq * 8);
#pragma unroll
                for (int j = 0; j < 8; ++j) bfr[j] = *(const bf16x8*)(Kh + (size_t)(j * 16 + fr) * 128 + ks * 32 + fq * 8);
#pragma unroll
                for (int i = 0; i < 2; ++i)
#pragma unroll
                    for (int j = 0; j < 8; ++j) acc[i][j] = MFMA16(bfr[j], af[i], acc[i][j]);
            }
#pragma unroll
            for (int i = 0; i < 2; ++i)
#pragma unroll
                for (int j = 0; j < 8; ++j) {
                    unsigned* d = S32 + ((mp * 2 + i) * 16 + fr) * 257 + hh * 128 + half * 64 + j * 8 + fq * 2;
                    d[0] = pk_f16(acc[i][j][0], acc[i][j][1]); d[1] = pk_f16(acc[i][j][2], acc[i][j][3]);
                }
        }
        __syncthreads();
        int a[16];
#pragma unroll
        for (int i = 0; i < 16; ++i) a[i] = (int)0x80000000;
        {
            const unsigned* sr = S32 + lane * 257 + hh * 128 + half * 64;
#pragma unroll 2
            for (int i = 0; i < 64; ++i) {
                const unsigned w = sr[i];
                const int k0 = (h2key(w & 0xffffu) << 7) | (2 * i), k1 = (h2key(w >> 16) << 7) | (2 * i + 1);
                INS16(a, k0); INS16(a, k1);
            }
        }
        __syncthreads();
#pragma unroll
        for (int i = 0; i < 16; ++i) TT[((lane * 2 + hh) * 2 + half) * 16 + i] = a[i];
        __syncthreads();
        if (tid < 128) {
            const int tk = tid & 63, h2 = tid >> 6, hd = hp * 2 + h2;
            const int* t1 = TT + ((tk * 2 + h2) * 2) * 16; const int* t2 = t1 + 16;
            float f1[16], f2[16];
#pragma unroll
            for (int i = 0; i < 16; ++i) { f1[i] = key2h(t1[i] >> 7); f2[i] = key2h(t2[i] >> 7); }
            int c[16];
#pragma unroll
            for (int i = 0; i < 16; ++i) c[i] = (int)0x80000000;
            CandLoop<0, 0>::run(c, f1, f2);
            float sc[16], e[16], sum = 0.f; int ex[16];
#pragma unroll
            for (int i = 0; i < 16; ++i) {
                sc[i] = key2f(c[i] & ~255);
                const int code = c[i] & 255;
                ex[i] = (t1[code >> 4] & 127) * 128 + (t2[code & 15] & 127);
            }
#pragma unroll
            for (int i = 0; i < 16; ++i) { e[i] = __expf(sc[i] - sc[0]); sum += e[i]; }
            const float inv = 1.0f / sum;
            int4* ep = (int4*)(eidx + (size_t)(tok0 + tk) * 128 + hd * 16); float4* gp = (float4*)(gw + (size_t)(tok0 + tk) * 128 + hd * 16);
#pragma unroll
            for (int i = 0; i < 4; ++i) { ep[i] = make_int4(ex[4 * i], ex[4 * i + 1], ex[4 * i + 2], ex[4 * i + 3]); gp[i] = make_float4(e[4 * i] * inv, e[4 * i + 1] * inv, e[4 * i + 2] * inv, e[4 * i + 3] * inv); }
        }
        __syncthreads();
    }
}

__device__ __forceinline__ float dot16_fp8(const float (&h)[16], const int4& u) {
    const int w[4] = {u.x, u.y, u.z, u.w};
    f32x2_t a = {0.f, 0.f};
#pragma unroll
    for (int i = 0; i < 4; ++i) {
        const f32x2_t lo = __builtin_amdgcn_cvt_pk_f32_fp8(w[i], false), hi = __builtin_amdgcn_cvt_pk_f32_fp8(w[i], true);
        const f32x2_t h0 = {h[4 * i], h[4 * i + 1]}, h1 = {h[4 * i + 2], h[4 * i + 3]};
        a = __builtin_elementwise_fma(lo, h0, a); a = __builtin_elementwise_fma(hi, h1, a);
    }
    return a.x + a.y;
}
__device__ __forceinline__ void axpy16_fp8(float (&o)[16], float c, const int4& v) {
    const int w[4] = {v.x, v.y, v.z, v.w};
#pragma unroll
    for (int i = 0; i < 4; ++i) {
        const f32x2_t lo = __builtin_amdgcn_cvt_pk_f32_fp8(w[i], false), hi = __builtin_amdgcn_cvt_pk_f32_fp8(w[i], true);
        o[4 * i] += c * lo.x; o[4 * i + 1] += c * lo.y; o[4 * i + 2] += c * hi.x; o[4 * i + 3] += c * hi.y;
    }
}

__device__ void phase_pu(const Params& p, int l, int slice, int grank, int gsz) {
    const int tid_ = otid(); const int lane = tid_ & 63, wid = tid_ >> 6, sub = lane & 7, pg = lane >> 3;
    const bf16_t* H = (const bf16_t*)(p.ws + OFF_H) + slice * 128 + sub * 16;
    const char* U8 = p.ws + OFF_UB + ((size_t)(l * 8 + slice) * NE) * 128 + sub * 16;
    const int* eidx = (const int*)(p.ws + OFF_Y) + lane;
    float* part = (float*)(p.ws + OFF_Z) + (size_t)slice * T * 128 + 16 * sub + pg;
    const int stride = gsz * 4;
#define PU_ISSUE(e_, u_) do { _Pragma("unroll") for (int q = 0; q < 8; ++q) { const int ej = __shfl(e_, 8 * q + pg); u_[q] = *(const int4*)(U8 + (size_t)ej * 128); } } while (0)
    int tok = grank * 4 + wid;
    if (tok >= T) return;
    int4 uA[8], uB[8];
    int ea = eidx[(size_t)tok * 128], eb = eidx[(size_t)tok * 128 + 64];
    uint4 h0 = *(const uint4*)(H + (size_t)tok * D), h1 = *(const uint4*)(H + (size_t)tok * D + 8);
    PU_ISSUE(ea, uA);
#pragma nounroll
    for (;;) {
        __builtin_amdgcn_sched_barrier(0);
        const int tokn = tok + stride; const bool more = tokn < T;
        int ean = 0, ebn = 0; uint4 h0n = h0, h1n = h1;
        if (more) { ean = eidx[(size_t)tokn * 128]; ebn = eidx[(size_t)tokn * 128 + 64]; h0n = *(const uint4*)(H + (size_t)tokn * D); h1n = *(const uint4*)(H + (size_t)tokn * D + 8); }
        PU_ISSUE(eb, uB);
        __builtin_amdgcn_sched_barrier(0);
        float hf[16];
        { const unsigned w_[8] = {h0.x, h0.y, h0.z, h0.w, h1.x, h1.y, h1.z, h1.w};
#pragma unroll
          for (int i = 0; i < 8; ++i) { hf[2 * i] = bf2f(w_[i] & 0xffffu); hf[2 * i + 1] = bf2f(w_[i] >> 16); } }
        float v[16];
#pragma unroll
        for (int q = 0; q < 8; ++q) v[q] = dot16_fp8(hf, uA[q]);
        __builtin_amdgcn_sched_barrier(0);
        if (more) PU_ISSUE(ean, uA);
        __builtin_amdgcn_sched_barrier(0);
#pragma unroll
        for (int q = 0; q < 8; ++q) v[8 + q] = dot16_fp8(hf, uB[q]);
        float w8[8], w4[4], w2[2];
        { const bool hi = (lane & 4) != 0;
#pragma unroll
          for (int m = 0; m < 8; ++m) { const float send = hi ? v[m] : v[m + 8], keep = hi ? v[m + 8] : v[m]; w8[m] = keep + __shfl_xor(send, 4); } }
        { const bool hi = (lane & 2) != 0;
#pragma unroll
          for (int m = 0; m < 4; ++m) { const float send = hi ? w8[m] : w8[m + 4], keep = hi ? w8[m + 4] : w8[m]; w4[m] = keep + __shfl_xor(send, 2); } }
        { const bool hi = (lane & 1) != 0;
#pragma unroll
          for (int m = 0; m < 2; ++m) { const float send = hi ? w4[m] : w4[m + 2], keep = hi ? w4[m + 2] : w4[m]; w2[m] = keep + __shfl_xor(send, 1); } }
        float* pr = part + (size_t)tok * 128;
        pr[0] = w2[0]; pr[8] = w2[1];
        if (!more) break;
        tok = tokn; ea = ean; eb = ebn; h0 = h0n; h1 = h1n;
    }
#undef PU_ISSUE
}
__device__ void phase_pc(const Params& p, int l, int bid, int nb) {
    const int tid_ = otid(); const int lane = tid_ & 63, wid = tid_ >> 6;
    const int* eidx = (const int*)(p.ws + OFF_Y); const float* gw = (const float*)(p.ws + OFF_Y + (size_t)T * 128 * 4);
    float* coef = (float*)(p.ws + OFF_Y + (size_t)T * 128 * 8);
    const float* part = (const float*)(p.ws + OFF_Z);
    const float* usc = (const float*)(p.ws + OFF_USC) + (size_t)l * NE; const float* vsc = (const float*)(p.ws + OFF_VSC) + (size_t)l * NE;
    for (int tok = bid * 4 + wid; tok < T; tok += nb * 4) {
#pragma unroll
        for (int hh = 0; hh < 2; ++hh) {
            const size_t j = (size_t)tok * 128 + hh * 64 + lane;
            const int e = eidx[j]; const float g = gw[j];
            float a = 0.f;
#pragma unroll
            for (int sl = 0; sl < 8; ++sl) a += part[(size_t)sl * T * 128 + j];
            coef[j] = g * gelu_f(a * usc[e]) * vsc[e];
        }
    }
}
__device__ void phase_pv(const Params& p, int l, int slice, int grank, int gsz) {
    const int tid_ = otid(); const int lane = tid_ & 63, wid = tid_ >> 6, sub = lane & 7, pg = lane >> 3;
    const char* V8 = p.ws + OFF_VB + ((size_t)(l * 8 + slice) * NE) * 128 + sub * 16;
    const int* eidx = (const int*)(p.ws + OFF_Y) + lane;
    const float* coef = (const float*)(p.ws + OFF_Y + (size_t)T * 128 * 8) + lane;
    const int col = slice * 128 + 16 * sub + 2 * pg;
    const float* g2p = (const float*)(p.ws + OFF_MOD) + (size_t)l * NB * 6144 + 5 * D + col;
    bf16_t* xcol = (bf16_t*)(p.ws + OFF_XR) + col;
    const int stride = gsz * 4;
#define PV_ISSUE(e_, c_, v_, cj_) do { _Pragma("unroll") for (int q = 0; q < 8; ++q) { const int ej = __shfl(e_, 8 * q + pg); cj_[q] = __shfl(c_, 8 * q + pg); v_[q] = *(const int4*)(V8 + (size_t)ej * 128); } } while (0)
    int tok = grank * 4 + wid;
    if (tok >= T) return;
    int4 vA[8], vB[8]; float cA[8], cB[8];
    int ea = eidx[(size_t)tok * 128], eb = eidx[(size_t)tok * 128 + 64];
    float ca = coef[(size_t)tok * 128], cb = coef[(size_t)tok * 128 + 64];
    PV_ISSUE(ea, ca, vA, cA);
#pragma nounroll
    for (;;) {
        __builtin_amdgcn_sched_barrier(0);
        const int tokn = tok + stride; const bool more = tokn < T;
        int ean = 0, ebn = 0; float can = 0.f, cbn = 0.f;
        if (more) { ean = eidx[(size_t)tokn * 128]; ebn = eidx[(size_t)tokn * 128 + 64]; can = coef[(size_t)tokn * 128]; cbn = coef[(size_t)tokn * 128 + 64]; }
        unsigned* xp = (unsigned*)(xcol + (size_t)tok * D); const float2 g2 = *(const float2*)(g2p + (size_t)(tok / SEQ) * 6144);
        const unsigned xw = *xp;
        PV_ISSUE(eb, cb, vB, cB);
        __builtin_amdgcn_sched_barrier(0);
        float o[16];
#pragma unroll
        for (int i = 0; i < 16; ++i) o[i] = 0.f;
#pragma unroll
        for (int q = 0; q < 8; ++q) axpy16_fp8(o, cA[q], vA[q]);
        __builtin_amdgcn_sched_barrier(0);
        if (more) PV_ISSUE(ean, can, vA, cA);
        __builtin_amdgcn_sched_barrier(0);
#pragma unroll
        for (int q = 0; q < 8; ++q) axpy16_fp8(o, cB[q], vB[q]);
        float t8[8], t4[4], t2[2];
        { const bool hi = (lane & 32) != 0;
#pragma unroll
          for (int m = 0; m < 8; ++m) { const float send = hi ? o[m] : o[m + 8], keep = hi ? o[m + 8] : o[m]; t8[m] = keep + __shfl_xor(send, 32); } }
        { const bool hi = (lane & 16) != 0;
#pragma unroll
          for (int m = 0; m < 4; ++m) { const float send = hi ? t8[m] : t8[m + 4], keep = hi ? t8[m + 4] : t8[m]; t4[m] = keep + __shfl_xor(send, 16); } }
        { const bool hi = (lane & 8) != 0;
#pragma unroll
          for (int m = 0; m < 2; ++m) { const float send = hi ? t4[m] : t4[m + 2], keep = hi ? t4[m + 2] : t4[m]; t2[m] = keep + __shfl_xor(send, 8); } }
        *xp = pk_bf16(bf2f(xw & 0xffffu) + g2.x * t2[0], bf2f(xw >> 16) + g2.y * t2[1]);
        if (!more) break;
        tok = tokn; ea = ean; eb = ebn; ca = can; cb = cbn;
    }
#undef PV_ISSUE
}
__device__ void phase_final_norm(const Params& p, int bid, int nb) {
    const int tid_ = otid(); const int lane = tid_ & 63, wid = tid_ >> 6;
    for (int tok = bid * 4 + wid; tok < T; tok += nb * 4) {
        float* xr = p.out + (size_t)tok * D;
        const bf16_t* xs = (const bf16_t*)(p.ws + OFF_XR) + (size_t)tok * D;
        float4 v[4]; float ss = 0.f;
#pragma unroll
        for (int i = 0; i < 4; ++i) { const uint2 w = *(const uint2*)(xs + i * 256 + lane * 4); v[i] = make_float4(bf2f(w.x & 0xffffu), bf2f(w.x >> 16), bf2f(w.y & 0xffffu), bf2f(w.y >> 16));
            ss += v[i].x * v[i].x + v[i].y * v[i].y + v[i].z * v[i].z + v[i].w * v[i].w; }
        ss = wave_sum(ss);
        const float rstd = rsqrtf(ss * (1.0f / D) + EPS);
#pragma unroll
        for (int i = 0; i < 4; ++i) { const float4 g = *(const float4*)(p.final_g + i * 256 + lane * 4);
            *(float4*)(xr + i * 256 + lane * 4) = make_float4(v[i].x * rstd * g.x, v[i].y * rstd * g.y, v[i].z * rstd * g.z, v[i].w * rstd * g.w); }
    }
}

#define XB_TMO      128
#define XB_XCNT(j)  (256  + 64 * (j))
#define XB_XSUB(j)  (1280 + 64 * (j))
#define XB_XGEN(j)  (2304 + 64 * (j))
#define XB_TOP      3328
#define XB_TOPGEN   3392
#define XCD_BAR_WORDS 3456
#define XB_SPIN_CAP (1u << 22)
__device__ __forceinline__ unsigned xb_ld(unsigned* p)              { return __hip_atomic_load(p, __ATOMIC_RELAXED, __HIP_MEMORY_SCOPE_AGENT); }
__device__ __forceinline__ unsigned xb_add(unsigned* p, unsigned v) { return __hip_atomic_fetch_add(p, v, __ATOMIC_RELAXED, __HIP_MEMORY_SCOPE_AGENT); }
__device__ __forceinline__ unsigned xb_xcc_id() { return (unsigned)__builtin_amdgcn_s_getreg((3 << 11) | 20) & 0xFu; }
#define XB_SPIN(cond, bar) do { unsigned _sp = 0; while (cond) { __builtin_amdgcn_s_sleep(1); \
    if ((++_sp & 255u) == 0u) { if (xb_ld(&(bar)[XB_TMO])) break; if (_sp > XB_SPIN_CAP) { atomicAdd(&(bar)[XB_TMO], 1u); break; } } } } while (0)
__device__ __forceinline__ void xcd_barrier_post(unsigned* bar, volatile LAS unsigned* st) {
    if (threadIdx.x == 0) { const unsigned x = xb_xcc_id(); st[3] = x; st[2] = xb_add(&bar[XB_XCNT(x)], 1u); }
}
__device__ __forceinline__ void xcd_barrier_complete(unsigned* bar, unsigned x, unsigned& nloc, unsigned& nx) {
    const unsigned G = gridDim.x * gridDim.y * gridDim.z;
    unsigned sum, cnt, mine, sp = 0u;
    for (;;) {
        sum = 0u; cnt = 0u; mine = 0u;
#pragma unroll
        for (unsigned j = 0; j < 16; ++j) { const unsigned c = xb_ld(&bar[XB_XCNT(j)]); sum += c; cnt += (c > 0u) ? 1u : 0u; mine = (j == x) ? c : mine; }
        if (sum == G) break;
        __builtin_amdgcn_s_sleep(1);
        if ((++sp & 255u) == 0u) { if (xb_ld(&bar[XB_TMO])) break; if (sp > XB_SPIN_CAP) { atomicAdd(&bar[XB_TMO], 1u); break; } }
    }
    nloc = mine > 0u ? mine : 1u; nx = cnt > 0u ? cnt : 1u;
}
__device__ __forceinline__ void xcd_barrier(unsigned* bar, volatile LAS unsigned* st) {
    asm volatile("s_waitcnt vmcnt(0)" ::: "memory");
    __syncthreads();
    if (threadIdx.x == 0) {
        __builtin_amdgcn_s_waitcnt(0);
        unsigned nloc = st[0], nx = st[1]; const unsigned x = st[3];
        if (nloc == 0u) { xcd_barrier_complete(bar, x, nloc, nx); st[0] = nloc; st[1] = nx; }
        const unsigned old = xb_add(&bar[XB_XSUB(x)], 1u);
        const unsigned gen = old / nloc;
        if (old + 1u == (gen + 1u) * nloc) {
            __builtin_amdgcn_fence(__ATOMIC_RELEASE, "agent");
            asm volatile("s_waitcnt vmcnt(0)" ::: "memory");
            const unsigned og = xb_add(&bar[XB_TOP], 1u);
            const unsigned tg = og / nx;
            if (og + 1u == (tg + 1u) * nx) xb_add(&bar[XB_TOPGEN], 1u);
            else XB_SPIN(xb_ld(&bar[XB_TOPGEN]) == tg, bar);
            __builtin_amdgcn_fence(__ATOMIC_ACQUIRE, "agent");
            xb_add(&bar[XB_XGEN(x)], 1u);
            asm volatile("s_waitcnt vmcnt(0)" ::: "memory");
        } else {
            XB_SPIN(xb_ld(&bar[XB_XGEN(x)]) == gen, bar);
            __builtin_amdgcn_fence(__ATOMIC_ACQUIRE, "agent");
            asm volatile("s_waitcnt vmcnt(0)" ::: "memory");
        }
    }
    __syncthreads();
}

#if MEGA
#if PROBE_A >= 0
#define TSTAMP(i) do { if (blockIdx.x == 0 && threadIdx.x == 0) ts[i] = __builtin_amdgcn_s_memrealtime(); } while (0)
#else
#define TSTAMP(i) do { } while (0)
#endif
__global__ void __launch_bounds__(256, 2) mega_kernel(Params p) {
    __shared__ __attribute__((aligned(16))) char smem[SMEM_BYTES];
    __shared__ uint4 xb_words;
#if PROBE_A >= 0
    __shared__ unsigned long long ts[26];
#endif
    cg::grid_group grid = cg::this_grid();
    const int bid = blockIdx.x, nb = gridDim.x;
    unsigned* bar = (unsigned*)(p.ws + OFF_BAR);
    if (threadIdx.x == 0) xb_words = make_uint4(0u, 0u, 0u, 0u);
    if (bid == 0) for (int i = threadIdx.x; i < XCD_BAR_WORDS; i += 256) bar[i] = 0u;
    TSTAMP(0);
    phase_prep(p, smem, bid, nb);
    grid.sync();
    volatile LAS unsigned* xst = (volatile LAS unsigned*)&xb_words;
    xcd_barrier_post(bar, xst);
    TSTAMP(1);
    phase_norm<false>(p.x, p.norm1_g, (const float*)(p.ws + OFF_MOD), 0, D, (bf16_t*)(p.ws + OFF_H), bid, nb); xcd_barrier((unsigned*)(p.ws + OFF_BAR), (volatile LAS unsigned*)&xb_words);
    int slice, grank; const int gsz = nb / 8;
    {
        const unsigned myx = xst[3], myrank = xst[2];
        unsigned pre = 0;
#pragma unroll
        for (unsigned j = 0; j < 16; ++j) { const unsigned c = xb_ld(&bar[XB_XCNT(j)]); pre += (j < myx) ? c : 0u; }
        const int gi = __builtin_amdgcn_readfirstlane((int)(pre + myrank));
        slice = gi / gsz; grank = gi % gsz;
    }
#pragma nounroll
    for (int l = 0; l < NL; ++l) {
        TSTAMP(2 + 11 * l); phase_gemm1(p, l, smem, bid, nb); xcd_barrier((unsigned*)(p.ws + OFF_BAR), (volatile LAS unsigned*)&xb_words);
        TSTAMP(3 + 11 * l); phase_mix(p, l, smem, bid, nb); xcd_barrier((unsigned*)(p.ws + OFF_BAR), (volatile LAS unsigned*)&xb_words);
        TSTAMP(4 + 11 * l); phase_fftb(p, l, smem, bid, nb); xcd_barrier((unsigned*)(p.ws + OFF_BAR), (volatile LAS unsigned*)&xb_words);
        TSTAMP(5 + 11 * l); phase_gemm2(p, l, smem, bid, nb); xcd_barrier((unsigned*)(p.ws + OFF_BAR), (volatile LAS unsigned*)&xb_words);
        TSTAMP(6 + 11 * l); phase_norm<true>(p.ws + OFF_XR, p.norm2_g + l * D, (const float*)(p.ws + OFF_MOD) + (size_t)l * NB * 6144, 3 * D, 4 * D, (bf16_t*)(p.ws + OFF_H), bid, nb); xcd_barrier((unsigned*)(p.ws + OFF_BAR), (volatile LAS unsigned*)&xb_words);
        TSTAMP(7 + 11 * l); phase_gemm3(p, l, smem, bid, nb); xcd_barrier((unsigned*)(p.ws + OFF_BAR), (volatile LAS unsigned*)&xb_words);
        TSTAMP(8 + 11 * l); phase_topk(p, l, smem, bid, nb); xcd_barrier((unsigned*)(p.ws + OFF_BAR), (volatile LAS unsigned*)&xb_words);
        TSTAMP(9 + 11 * l); phase_pu(p, l, slice, grank, gsz); xcd_barrier((unsigned*)(p.ws + OFF_BAR), (volatile LAS unsigned*)&xb_words);
        TSTAMP(10 + 11 * l); phase_pc(p, l, bid, nb); xcd_barrier((unsigned*)(p.ws + OFF_BAR), (volatile LAS unsigned*)&xb_words);
        TSTAMP(11 + 11 * l); phase_pv(p, l, slice, grank, gsz); xcd_barrier((unsigned*)(p.ws + OFF_BAR), (volatile LAS unsigned*)&xb_words);
        TSTAMP(12 + 11 * l);
        if (l + 1 < NL) { phase_norm<true>(p.ws + OFF_XR, p.norm1_g + (l + 1) * D, (const float*)(p.ws + OFF_MOD) + (size_t)(l + 1) * NB * 6144, 0, D, (bf16_t*)(p.ws + OFF_H), bid, nb); xcd_barrier((unsigned*)(p.ws + OFF_BAR), (volatile LAS unsigned*)&xb_words); }
        else phase_final_norm(p, bid, nb);
    }
    TSTAMP(24);
#if PROBE_A >= 0
    if (bid == 0 && threadIdx.x == 0) p.out[0] += (float)(ts[PROBE_B] - ts[PROBE_A]) * 0.01f / PROBE_DIV;
#endif
}
#endif

extern "C" void kernel_launch(void* const* d_in, const int* in_sizes, int n_in, void* d_out, int out_size, void* d_ws, size_t ws_size, hipStream_t stream) {
    (void)in_sizes; (void)n_in; (void)out_size;
    if (ws_size < OFF_END) { fprintf(stderr, "workspace too small: %zu < %zu\n", ws_size, (size_t)OFF_END); return; }
    Params p{};
    p.x = (const float*)d_in[0]; p.c = (const float*)d_in[1]; p.mod_w = (const float*)d_in[2]; p.mod_b = (const float*)d_in[3]; p.norm1_g = (const float*)d_in[4];
    p.w_in = (const float*)d_in[5]; p.gmlp_ws = (const float*)d_in[6]; p.gmlp_bs = (const float*)d_in[7]; p.fnet_w = (const float*)d_in[8]; p.fnet_b = (const float*)d_in[9];
    p.gain_a = (const float*)d_in[10]; p.gain_b = (const float*)d_in[11]; p.w_out = (const float*)d_in[12]; p.norm2_g = (const float*)d_in[13]; p.wq = (const float*)d_in[14];
    p.k1 = (const float*)d_in[15]; p.k2 = (const float*)d_in[16]; p.pu = (const float*)d_in[17]; p.pv = (const float*)d_in[18]; p.final_g = (const float*)d_in[19];
    p.out = (float*)d_out; p.ws = (char*)d_ws;
#if MEGA
    static int grid_blocks = 0;
    if (!grid_blocks) {
        int dev = 0, cus = 0, per_cu = 0;
        hipGetDevice(&dev);
        hipDeviceGetAttribute(&cus, hipDeviceAttributeMultiprocessorCount, dev);
        hipOccupancyMaxActiveBlocksPerMultiprocessor(&per_cu, mega_kernel, 256, 0);
        if (per_cu > 2) per_cu = 2;
        grid_blocks = (cus * per_cu) / 8 * 8;
    }
    void* args[] = {&p};
    hipError_t e = hipLaunchCooperativeKernel((void*)mega_kernel, dim3(grid_blocks), dim3(256), args, 0, stream);
    if (e != hipSuccess) fprintf(stderr, "cooperative launch failed: %s (grid %d)\n", hipGetErrorString(e), grid_blocks);
#endif
}
```

```cpp
#include <hip/hip_runtime.h>
#include <hip/hip_cooperative_groups.h>
#include <cstdio>
#include <cstdint>
namespace cg = cooperative_groups;

#ifndef MEGA
#define MEGA 1
#endif
#ifndef PROBE_A
#define PROBE_A -1
#define PROBE_B 0
#define PROBE_DIV 10.0f
#endif

typedef unsigned short bf16_t;
typedef short bf16x8 __attribute__((ext_vector_type(8)));
typedef float f32x4 __attribute__((ext_vector_type(4)));
typedef __bf16 bf16x2_t __attribute__((ext_vector_type(2)));

constexpr int D = 1024, NB = 8, SEQ = 4096, T = NB * SEQ, NL = 2;
constexpr int NZ = 2048;
constexpr int NE = 16384;
constexpr float EPS = 1e-6f;

constexpr size_t OFF_MOD  = 0;
constexpr size_t OFF_W1T  = OFF_MOD  + (size_t)NL * NB * 6144 * 4;
constexpr size_t OFF_W2T  = OFF_W1T  + (size_t)NL * 2048 * 1024 * 2;
constexpr size_t OFF_WQT  = OFF_W2T  + (size_t)NL * 1024 * 1024 * 2;
constexpr size_t OFF_K12  = OFF_WQT  + (size_t)NL * 2048 * 1024 * 2;
constexpr size_t OFF_WSB  = OFF_K12  + (size_t)NL * 8 * 256 * 128 * 2;
constexpr size_t OFF_DA   = OFF_WSB  + (size_t)NL * 8 * 128 * 128 * 2;
constexpr size_t OFF_DB   = OFF_DA   + 128 * 128 * 2;
constexpr size_t OFF_TW   = OFF_DB   + 64 * 128 * 2;
constexpr size_t OFF_SSQA = OFF_TW   + 64 * 64 * 8;
constexpr size_t OFF_SSQB = OFF_SSQA + (size_t)T * 8 * 4;
constexpr size_t OFF_UB   = OFF_SSQB + (size_t)T * 8 * 4;
constexpr size_t OFF_VB   = OFF_UB   + (size_t)NL * NE * 1024;
constexpr size_t OFF_USC  = OFF_VB   + (size_t)NL * NE * 1024;
constexpr size_t OFF_VSC  = OFF_USC  + (size_t)NL * NE * 4;
constexpr size_t OFF_H    = OFF_VSC  + (size_t)NL * NE * 4;
constexpr size_t OFF_Z    = OFF_H    + (size_t)T * 1024 * 2;
constexpr size_t OFF_Y    = OFF_Z    + (size_t)T * 2048 * 2;
constexpr size_t OFF_BAR  = OFF_Y    + (size_t)T * 1024 * 2;
constexpr size_t OFF_XR   = OFF_BAR  + 16384;
constexpr size_t OFF_END  = OFF_XR   + (size_t)T * 1024 * 2;

struct Params {
    const float* x; const float* c; const float* mod_w; const float* mod_b; const float* norm1_g; const float* w_in;
    const float* gmlp_ws; const float* gmlp_bs; const float* fnet_w; const float* fnet_b; const float* gain_a; const float* gain_b;
    const float* w_out; const float* norm2_g; const float* wq; const float* k1; const float* k2; const float* pu; const float* pv; const float* final_g;
    float* out; char* ws;
};

constexpr int SMEM_BYTES = 73984;

__device__ __forceinline__ float bf2f(unsigned v) { return __uint_as_float(v << 16); }
typedef float f32x2_t __attribute__((ext_vector_type(2)));
__device__ __forceinline__ unsigned pk_bf16(float lo, float hi) { const f32x2_t v = {lo, hi}; return __builtin_bit_cast(unsigned, __builtin_convertvector(v, bf16x2_t)); }
__device__ __forceinline__ bf16_t f2bf(float f) { return (bf16_t)(pk_bf16(f, 0.f) & 0xffffu); }
__device__ __forceinline__ float gelu_f(float v) {
    const float t = __builtin_amdgcn_rcpf(fabsf(v) * 0.2316418882f + 1.0f);
    float q = t * 0.5307027145f + (-0.7265760135f); q = q * t + 0.7107068705f; q = q * t + (-0.142248368f); q = q * t + 0.127414796f; q = q * t;
    const float m = v * (q * __builtin_amdgcn_exp2f(v * v * (-0.72134752044f)));
    return v < 0.f ? m : v - m;
}
__device__ __forceinline__ int med3i(int a, int b, int c) { return max(min(a, b), min(max(a, b), c)); }
__device__ __forceinline__ int f2key(float f) { int b = __float_as_int(f); return b ^ ((b >> 31) & 0x7fffffff); }
__device__ __forceinline__ float key2f(int k) { return __int_as_float(k ^ ((k >> 31) & 0x7fffffff)); }
__device__ __forceinline__ float wave_sum(float v) {
#pragma unroll
    for (int o = 32; o >= 1; o >>= 1) v += __shfl_xor(v, o);
    return v;
}
__device__ __forceinline__ int otid() { int t = threadIdx.x; asm volatile("" : "+v"(t)); return t; }
#define MFMA16(a, b, c) __builtin_amdgcn_mfma_f32_16x16x32_bf16((a), (b), (c), 0, 0, 0)

__device__ void transpose_tile(const float* __restrict__ src, int ld, int k0, int n0, bf16_t* __restrict__ dst  , int dn0,
                               const float* __restrict__ kscale, float* tile  ) {
    const int tid = otid();
#pragma unroll
    for (int i = 0; i < 4; ++i) {
        const int r = (tid >> 4) + 16 * i, c4 = (tid & 15) * 4;
        const float4 v = *(const float4*)(src + (size_t)(k0 + r) * ld + n0 + c4);
        const float s = kscale ? kscale[k0 + r] : 1.0f;
        tile[r * 65 + c4 + 0] = v.x * s; tile[r * 65 + c4 + 1] = v.y * s; tile[r * 65 + c4 + 2] = v.z * s; tile[r * 65 + c4 + 3] = v.w * s;
    }
    __syncthreads();
    {
        const int n = tid >> 2, ks = (tid & 3) * 16;
        unsigned w[8];
#pragma unroll
        for (int j = 0; j < 8; ++j) w[j] = pk_bf16(tile[(ks + 2 * j) * 65 + n], tile[(ks + 2 * j + 1) * 65 + n]);
        uint4* d = (uint4*)(dst + (size_t)(dn0 + n) * 1024 + k0 + ks);
        d[0] = make_uint4(w[0], w[1], w[2], w[3]); d[1] = make_uint4(w[4], w[5], w[6], w[7]);
    }
    __syncthreads();
}

__device__ void phase_prep(const Params& p, char* smem, int bid, int nb) {
    const int tid = otid();
    const int gtid = bid * 256 + tid, gsz = nb * 256;
    char* ws = p.ws;
    {
        float* sc = (float*)smem;
        float* red = (float*)(smem + 32768);
        for (int i = tid; i < 8192; i += 256) { const float v = p.c[i]; sc[i] = v / (1.0f + __expf(-v)); }
        __syncthreads();
        float* mod = (float*)(ws + OFF_MOD);
        for (int item = bid; item < NL * 192; item += nb) {
            const int l = item / 192, n0 = (item % 192) * 32, nn = tid & 31, kq = tid >> 5;
            float acc[8];
#pragma unroll
            for (int b = 0; b < 8; ++b) acc[b] = 0.f;
            const float* W = p.mod_w + (size_t)l * 1024 * 6144 + n0 + nn;
#pragma nounroll
            for (int k0 = kq; k0 < 1024; k0 += 128) {
                float w[16];
#pragma unroll
                for (int u = 0; u < 16; ++u) w[u] = W[(size_t)(k0 + 8 * u) * 6144];
#pragma unroll
                for (int u = 0; u < 16; ++u)
#pragma unroll
                    for (int b = 0; b < 8; ++b) acc[b] += sc[b * 1024 + k0 + 8 * u] * w[u];
            }
#pragma unroll
            for (int b = 0; b < 8; ++b) red[(kq * 8 + b) * 32 + nn] = acc[b];
            __syncthreads();
            {
                const int b = tid >> 5;
                float s = 0.f;
#pragma unroll
                for (int q = 0; q < 8; ++q) s += red[(q * 8 + b) * 32 + nn];
                mod[((size_t)l * NB + b) * 6144 + n0 + nn] = s + p.mod_b[l * 6144 + n0 + nn];
            }
            __syncthreads();
        }
    }
    {
        float* tile = (float*)smem;
        for (int item = bid; item < NL * 1024; item += nb) {
            const int l = item / 1024, r = item % 1024;
            if (r < 256) {
                const int kt = r / 16, nt = r % 16;
                transpose_tile(p.w_in + (size_t)l * 1024 * 1536, 1536, kt * 64, nt * 64, (bf16_t*)(ws + OFF_W1T) + (size_t)l * 2048 * 1024, nt * 64, nullptr, tile);
            } else if (r < 512) {
                const int rr = r - 256, kt = rr / 16, nt = rr % 16;
                const float* gk = (kt < 8) ? (p.gain_a + l * 512) : (p.gain_b + l * 512 - 512);
                transpose_tile(p.w_out + (size_t)l * 1024 * 1024, 1024, kt * 64, nt * 64, (bf16_t*)(ws + OFF_W2T) + (size_t)l * 1024 * 1024, nt * 64, gk, tile);
            } else {
                const int rr = r - 512, kt = rr / 32, nt = rr % 32;
                transpose_tile(p.wq + (size_t)l * 1024 * 2048, 2048, kt * 64, nt * 64, (bf16_t*)(ws + OFF_WQT) + (size_t)l * 2048 * 1024, nt * 64, nullptr, tile);
            }
        }
    }
    {
        float* fws = (float*)smem;
        float* Ms  = (float*)(smem + 16384);
        float* wt  = (float*)(smem + 49152);
        float* cs  = (float*)(smem + 49152 + 16640);
        for (int item = bid; item < NL * 8 * 16; item += nb) {
            const int l = item / 128, g = (item % 128) / 16, kt = item % 16;
            if (tid < 64) { float s, c; sincospif((float)tid / 32.0f, &s, &c); cs[tid] = c; cs[64 + tid] = s; }
            for (int i = tid; i < 4096; i += 256) fws[i] = p.fnet_w[((size_t)l * 8 + g) * 4096 + i];
#pragma unroll
            for (int i = 0; i < 4; ++i) {
                const int r = (tid >> 4) + 16 * i, c4 = (tid & 15) * 4;
                const float4 v = *(const float4*)(p.w_in + (size_t)l * 1024 * 1536 + (size_t)(kt * 64 + r) * 1536 + 1024 + g * 64 + c4);
                wt[r * 65 + c4] = v.x; wt[r * 65 + c4 + 1] = v.y; wt[r * 65 + c4 + 2] = v.z; wt[r * 65 + c4 + 3] = v.w;
            }
            __syncthreads();
            {
                const int d = tid >> 2, r0 = (tid & 3) * 32;
                const bool im = r0 >= 64; const int e0 = r0 & 63;
                float acc[32];
#pragma unroll
                for (int e = 0; e < 32; ++e) acc[e] = 0.f;
                for (int j = 0; j < 64; ++j) {
                    const int ph = (d * j) & 63;
                    const float t = im ? -cs[64 + ph] : cs[ph];
#pragma unroll
                    for (int e = 0; e < 32; ++e) acc[e] += t * fws[j * 64 + e0 + e];
                }
#pragma unroll
                for (int e = 0; e < 32; ++e) Ms[d * 128 + r0 + e] = acc[e];
            }
            __syncthreads();
            {
                const int r = tid >> 1, kk0 = (tid & 1) * 32;
                float acc[32];
#pragma unroll
                for (int k = 0; k < 32; ++k) acc[k] = 0.f;
                for (int d = 0; d < 64; ++d) {
                    const float m = Ms[d * 128 + r];
#pragma unroll
                    for (int k = 0; k < 32; ++k) acc[k] += wt[(kk0 + k) * 65 + d] * m;
                }
                bf16_t* dst = (bf16_t*)(ws + OFF_W1T) + (size_t)l * 2048 * 1024 + (size_t)(1024 + g * 128 + r) * 1024 + kt * 64 + kk0;
#pragma unroll
                for (int q = 0; q < 4; ++q)
                    ((uint4*)dst)[q] = make_uint4(pk_bf16(acc[q * 8], acc[q * 8 + 1]), pk_bf16(acc[q * 8 + 2], acc[q * 8 + 3]), pk_bf16(acc[q * 8 + 4], acc[q * 8 + 5]), pk_bf16(acc[q * 8 + 6], acc[q * 8 + 7]));
            }
            __syncthreads();
        }
    }
    {
        bf16_t* k12 = (bf16_t*)(ws + OFF_K12);
        for (int i = gtid; i < NL * 8 * 256 * 128; i += gsz) {
            const int d = i & 127, n = (i >> 7) & 255, h = (i >> 15) & 7, l = i >> 18;
            const float* src = (n < 128) ? p.k1 : p.k2;
            k12[i] = f2bf(src[(((size_t)l * 8 + h) * 128 + (n & 127)) * 128 + d]);
        }
        bf16_t* wsb = (bf16_t*)(ws + OFF_WSB);
        for (int i = gtid; i < NL * 8 * 128 * 128; i += gsz) wsb[i] = f2bf(p.gmlp_ws[i]);
        bf16_t* DA = (bf16_t*)(ws + OFF_DA);
        for (int i = gtid; i < 128 * 128; i += gsz) {
            const int m = i >> 7, kk = i & 127, ro = m >> 6, k1 = m & 63, ri = kk >> 6, a = kk & 63;
            float s, c; sincospif((float)((a * k1) & 63) / 32.0f, &s, &c);
            const float v = (ro == ri) ? c : (ro == 0 ? s : -s);
            DA[i] = f2bf(v);
        }
        bf16_t* DB = (bf16_t*)(ws + OFF_DB);
        for (int i = gtid; i < 64 * 128; i += gsz) {
            const int k2 = i >> 7, kk = i & 127, ri = kk >> 6, b = kk & 63;
            float s, c; sincospif((float)((b * k2) & 63) / 32.0f, &s, &c);
            DB[i] = f2bf(ri ? s : c);
        }
        float2* tw = (float2*)(ws + OFF_TW);
        for (int i = gtid; i < 64 * 64; i += gsz) {
            const int bp = i >> 6, k1 = i & 63;
            float s, c; sincospif((float)(bp * k1) / 2048.0f, &s, &c);
            tw[i] = make_float2(c, s);
        }
        {
            const int lane = tid & 63, wv = gtid >> 6, nwv = gsz >> 6;
            const int R = 2 * NL * NE;
#pragma nounroll
            for (int r0 = wv; r0 < R; r0 += 2 * nwv) {
                float4 v[2][4];
#pragma unroll
                for (int t = 0; t < 2; ++t) {
                    const int r = (r0 + t * nwv < R) ? r0 + t * nwv : r0;
                    const int tbl = r / (NL * NE), row = r % (NL * NE);
                    const float* src = (tbl ? p.pv : p.pu) + (size_t)row * 1024 + lane * 16;
#pragma unroll
                    for (int i = 0; i < 4; ++i) v[t][i] = ((const float4*)src)[i];
                }
#pragma unroll
                for (int t = 0; t < 2; ++t) {
                    const int r = r0 + t * nwv;
                    if (r >= R) break;
                    const int tbl = r / (NL * NE), row = r % (NL * NE);
                    float m = 0.f;
#pragma unroll
                    for (int i = 0; i < 4; ++i) m = fmaxf(m, fmaxf(fmaxf(fabsf(v[t][i].x), fabsf(v[t][i].y)), fmaxf(fabsf(v[t][i].z), fabsf(v[t][i].w))));
#pragma unroll
                    for (int o = 32; o >= 1; o >>= 1) m = fmaxf(m, __shfl_xor(m, o));
                    const float sc = (m > 0.f) ? 256.0f / m : 1.0f, inv = (m > 0.f) ? m * (1.0f / 256.0f) : 1.0f;
                    int w[4];
#pragma unroll
                    for (int i = 0; i < 4; ++i) { w[i] = __builtin_amdgcn_cvt_pk_fp8_f32(v[t][i].x * sc, v[t][i].y * sc, 0, false); w[i] = __builtin_amdgcn_cvt_pk_fp8_f32(v[t][i].z * sc, v[t][i].w * sc, w[i], true); }
                    const int lyr = row / NE, ex = row % NE;
                    *(int4*)(ws + (tbl ? OFF_VB : OFF_UB) + ((size_t)(lyr * 8 + (lane >> 3)) * NE + ex) * 128 + (lane & 7) * 16) = make_int4(w[0], w[1], w[2], w[3]);
                    if (lane == 0) ((float*)(ws + (tbl ? OFF_VSC : OFF_USC)))[row] = inv;
                }
            }
        }
    }
}

template <bool SRC_BF16>
__device__ void phase_norm(const void* __restrict__ xsrc_, const float* __restrict__ g, const float* __restrict__ modl  , int sh_off, int scl_off,
                           bf16_t* __restrict__ hout, int bid, int nb) {
    const int tid_ = otid(); const int lane = tid_ & 63, wid = tid_ >> 6;
    for (int tok = bid * 4 + wid; tok < T; tok += nb * 4) {
        const int b = tok / SEQ;
        float4 v[4];
        float ss = 0.f;
#pragma unroll
        for (int i = 0; i < 4; ++i) {
            if (SRC_BF16) { const uint2 w = *(const uint2*)((const bf16_t*)xsrc_ + (size_t)tok * D + i * 256 + lane * 4); v[i] = make_float4(bf2f(w.x & 0xffffu), bf2f(w.x >> 16), bf2f(w.y & 0xffffu), bf2f(w.y >> 16)); }
            else v[i] = *(const float4*)((const float*)xsrc_ + (size_t)tok * D + i * 256 + lane * 4);
            ss += v[i].x * v[i].x + v[i].y * v[i].y + v[i].z * v[i].z + v[i].w * v[i].w;
        }
        ss = wave_sum(ss);
        const float rstd = rsqrtf(ss * (1.0f / D) + EPS);
        const float* mb = modl + (size_t)b * 6144;
#pragma unroll
        for (int i = 0; i < 4; ++i) {
            const int cidx = i * 256 + lane * 4;
            const float4 gg = *(const float4*)(g + cidx), sh = *(const float4*)(mb + sh_off + cidx), sc = *(const float4*)(mb + scl_off + cidx);
            const float o0 = v[i].x * rstd * gg.x * (1.0f + sc.x) + sh.x, o1 = v[i].y * rstd * gg.y * (1.0f + sc.y) + sh.y;
            const float o2 = v[i].z * rstd * gg.z * (1.0f + sc.z) + sh.z, o3 = v[i].w * rstd * gg.w * (1.0f + sc.w) + sh.w;
            *(uint2*)(hout + (size_t)tok * D + cidx) = make_uint2(pk_bf16(o0, o1), pk_bf16(o2, o3));
        }
    }
}

#define LAS __attribute__((address_space(3)))
template <class Epi, class MidK>
__device__ __forceinline__ void gemm_tile(const bf16_t* __restrict__ A, int lda, const bf16_t* __restrict__ Bt, int ldb, int K, int m0, int n0,
                                          char* smem, const Epi& epi, const MidK& midk, int kmid) {
    const int tid = otid(), lane = tid & 63, wid = tid >> 6, wr = wid >> 1, wc = wid & 1, fr = lane & 15, fq = lane >> 4;
    LAS char* lds = (LAS char*)smem;
    f32x4 acc[4][4];
#pragma unroll
    for (int i = 0; i < 4; ++i)
#pragma unroll
        for (int j = 0; j < 4; ++j) acc[i][j] = (f32x4){0.f, 0.f, 0.f, 0.f};
    const int prow = lane >> 3, pch = (lane & 7) ^ prow;
    const bf16_t* ga = A + (size_t)(m0 + wid * 32 + prow) * lda + pch * 8;
    const bf16_t* gb = Bt + (size_t)(n0 + wid * 32 + prow) * ldb + pch * 8;
    const int nk = K / 64;
#define GEMM_STAGE(kt_, buf_) do { _Pragma("unroll") for (int i_ = 0; i_ < 4; ++i_) { \
        __builtin_amdgcn_global_load_lds((const unsigned*)(ga + (size_t)(i_ * 8) * lda + (kt_) * 64), (LAS unsigned*)(lds + (buf_) * 16384 + (wid * 32 + i_ * 8) * 128), 16, 0, 0); \
        __builtin_amdgcn_global_load_lds((const unsigned*)(gb + (size_t)(i_ * 8) * ldb + (kt_) * 64), (LAS unsigned*)(lds + 32768 + (buf_) * 16384 + (wid * 32 + i_ * 8) * 128), 16, 0, 0); } } while (0)
    GEMM_STAGE(0, 0);
    const int swz = fr & 7;
    for (int kt = 0; kt < nk; ++kt) {
        const int cur = kt & 1;
        asm volatile("s_waitcnt vmcnt(0)" ::: "memory");
        __syncthreads();
        if (kt + 1 < nk) GEMM_STAGE(kt + 1, cur ^ 1);
        if (kt == kmid) {
#pragma unroll
            for (int i = 0; i < 4; ++i) { const float sc = midk(m0 + wr * 64 + i * 16 + fr);
#pragma unroll
                for (int j = 0; j < 4; ++j) acc[i][j] *= sc; }
        }
        const LAS char* ca = lds + cur * 16384; const LAS char* cb = lds + 32768 + cur * 16384;
#pragma unroll
        for (int ks = 0; ks < 2; ++ks) {
            bf16x8 af[4], bfr[4];
            const int coff = ((ks * 4 + fq) ^ swz) * 16;
#pragma unroll
            for (int i = 0; i < 4; ++i) af[i] = *(const LAS bf16x8*)(ca + (wr * 64 + i * 16 + fr) * 128 + coff);
#pragma unroll
            for (int j = 0; j < 4; ++j) bfr[j] = *(const LAS bf16x8*)(cb + (wc * 64 + j * 16 + fr) * 128 + coff);
#pragma unroll
            for (int i = 0; i < 4; ++i)
#pragma unroll
                for (int j = 0; j < 4; ++j) acc[i][j] = MFMA16(bfr[j], af[i], acc[i][j]);
        }
    }
#undef GEMM_STAGE
    __syncthreads();
    {
        LAS char* stg = lds + wid * 17408;
#pragma unroll
        for (int i = 0; i < 4; ++i)
#pragma unroll
            for (int j = 0; j < 4; ++j) *(LAS f32x4*)(stg + (i * 16 + fr) * 272 + (j * 16 + fq * 4) * 4) = acc[i][j];
        const int er = lane >> 3, ec = (lane & 7) * 8;
#pragma unroll
        for (int t = 0; t < 8; ++t) {
            const f32x4 v0 = *(const LAS f32x4*)(stg + (t * 8 + er) * 272 + ec * 4), v1 = *(const LAS f32x4*)(stg + (t * 8 + er) * 272 + ec * 4 + 16);
            epi(m0 + wr * 64 + t * 8 + er, n0 + wc * 64 + ec, v0, v1);
            __builtin_amdgcn_sched_barrier(0);
        }
    }
    __syncthreads();
}
__device__ __forceinline__ bool tile_of(int round, int bid, int nb, int MT, int NT, int& mt, int& nt) {
    if (nb == 512) {
        const int x = bid & 7, r = bid >> 3, st = x + 8 * round, snt = NT >> 3;
        if (st >= (MT >> 3) * snt) return false;
        mt = (st / snt) * 8 + (r >> 3); nt = (st % snt) * 8 + (r & 7);
        return true;
    }
    const int item = bid + round * nb;
    if (item >= MT * NT) return false;
    mt = item / NT; nt = item % NT;
    return true;
}
struct NoMid { __device__ __forceinline__ float operator()(int) const { return 1.0f; } };

__device__ void phase_gemm1(const Params& p, int l, char* smem, int bid, int nb) {
    const bf16_t* A = (const bf16_t*)(p.ws + OFF_H);
    const bf16_t* Bt = (const bf16_t*)(p.ws + OFF_W1T) + (size_t)l * 2048 * 1024;
    bf16_t* Z = (bf16_t*)(p.ws + OFF_Z);
    auto epi_gelu = [&](int row, int col, const f32x4& a, const f32x4& b) {
        *(uint4*)(Z + (size_t)row * NZ + col) = make_uint4(pk_bf16(gelu_f(a[0]), gelu_f(a[1])), pk_bf16(gelu_f(a[2]), gelu_f(a[3])), pk_bf16(gelu_f(b[0]), gelu_f(b[1])), pk_bf16(gelu_f(b[2]), gelu_f(b[3])));
    };
    auto epi_plain = [&](int row, int col, const f32x4& a, const f32x4& b) {
        *(uint4*)(Z + (size_t)row * NZ + col) = make_uint4(pk_bf16(a[0], a[1]), pk_bf16(a[2], a[3]), pk_bf16(b[0], b[1]), pk_bf16(b[2], b[3]));
    };
    const int NT = NZ / 128, MT = T / 128;
    int mt, nt;
    for (int round = 0; tile_of(round, bid, nb, MT, NT, mt, nt); ++round) {
        const int n0 = nt * 128;
        if (n0 < 1024) gemm_tile(A, D, Bt, D, D, mt * 128, n0, smem, epi_gelu, NoMid(), -1);
        else           gemm_tile(A, D, Bt, D, D, mt * 128, n0, smem, epi_plain, NoMid(), -1);
    }
}
__device__ void phase_gemm2(const Params& p, int l, char* smem, int bid, int nb) {
    const bf16_t* A = (const bf16_t*)(p.ws + OFF_Y);
    const bf16_t* Bt = (const bf16_t*)(p.ws + OFF_W2T) + (size_t)l * 1024 * 1024;
    const float* ssa = (const float*)(p.ws + OFF_SSQA); const float* ssb = (const float*)(p.ws + OFF_SSQB);
    const float* mod = (const float*)(p.ws + OFF_MOD) + (size_t)l * NB * 6144;
    bf16_t* XR = (bf16_t*)(p.ws + OFF_XR);
    auto rstd_of = [&](const float* s, int row) {
        const float4 a = *(const float4*)(s + (size_t)row * 8), b = *(const float4*)(s + (size_t)row * 8 + 4);
        return rsqrtf(((a.x + a.y) + (a.z + a.w) + (b.x + b.y) + (b.z + b.w)) * (1.0f / 512.0f) + EPS);
    };
    auto midk = [&](int row) { return rstd_of(ssa, row) / rstd_of(ssb, row); };
    auto epi = [&](int row, int col, const f32x4& a, const f32x4& c) {
        const float rb = rstd_of(ssb, row);
        const int b = row / SEQ;
        const float4 g0 = *(const float4*)(mod + (size_t)b * 6144 + 2 * D + col), g1 = *(const float4*)(mod + (size_t)b * 6144 + 2 * D + col + 4);
        float x[8];
        if (l == 0) { const float4 x0 = *(const float4*)(p.x + (size_t)row * D + col), x1 = *(const float4*)(p.x + (size_t)row * D + col + 4);
            x[0] = x0.x; x[1] = x0.y; x[2] = x0.z; x[3] = x0.w; x[4] = x1.x; x[5] = x1.y; x[6] = x1.z; x[7] = x1.w; }
        else { const uint4 w = *(const uint4*)(XR + (size_t)row * D + col);
            x[0] = bf2f(w.x & 0xffffu); x[1] = bf2f(w.x >> 16); x[2] = bf2f(w.y & 0xffffu); x[3] = bf2f(w.y >> 16); x[4] = bf2f(w.z & 0xffffu); x[5] = bf2f(w.z >> 16); x[6] = bf2f(w.w & 0xffffu); x[7] = bf2f(w.w >> 16); }
        *(uint4*)(XR + (size_t)row * D + col) = make_uint4(pk_bf16(x[0] + g0.x * rb * a[0], x[1] + g0.y * rb * a[1]), pk_bf16(x[2] + g0.z * rb * a[2], x[3] + g0.w * rb * a[3]),
                                                           pk_bf16(x[4] + g1.x * rb * c[0], x[5] + g1.y * rb * c[1]), pk_bf16(x[6] + g1.z * rb * c[2], x[7] + g1.w * rb * c[3]));
    };
    const int NT = D / 128, MT = T / 128;
    int mt, nt;
    for (int round = 0; tile_of(round, bid, nb, MT, NT, mt, nt); ++round) gemm_tile(A, D, Bt, D, D, mt * 128, nt * 128, smem, epi, midk, 8);
}
__device__ void phase_gemm3(const Params& p, int l, char* smem, int bid, int nb) {
    const bf16_t* A = (const bf16_t*)(p.ws + OFF_H);
    const bf16_t* Bt = (const bf16_t*)(p.ws + OFF_WQT) + (size_t)l * 2048 * 1024;
    bf16_t* Q = (bf16_t*)(p.ws + OFF_Z);
    auto epi = [&](int row, int col, const f32x4& a, const f32x4& b) { *(uint4*)(Q + (size_t)row * 2048 + col) = make_uint4(pk_bf16(a[0], a[1]), pk_bf16(a[2], a[3]), pk_bf16(b[0], b[1]), pk_bf16(b[2], b[3])); };
    const int NT = 2048 / 128, MT = T / 128;
    int mt, nt;
    for (int round = 0; tile_of(round, bid, nb, MT, NT, mt, nt); ++round) gemm_tile(A, D, Bt, D, D, mt * 128, nt * 128, smem, epi, NoMid(), -1);
}

constexpr int TP = 136;
__device__ __forceinline__ void stage_transposed(const bf16_t* __restrict__ base, size_t row_stride, bf16_t* dT) {
    const int tid = otid(), r = tid >> 2, part = tid & 3, ri = part >> 1, c0 = (part & 1) * 32;
    const uint4* src = (const uint4*)(base + (size_t)r * row_stride + ri * 64 + c0);
    uint4 v[4];
#pragma unroll
    for (int i = 0; i < 4; ++i) v[i] = src[i];
#pragma unroll
    for (int i = 0; i < 4; ++i) {
        const unsigned w[4] = {v[i].x, v[i].y, v[i].z, v[i].w};
#pragma unroll
        for (int j = 0; j < 4; ++j) {
            dT[(c0 + i * 8 + j * 2) * TP + ri * 64 + r] = (bf16_t)(w[j] & 0xffffu);
            dT[(c0 + i * 8 + j * 2 + 1) * TP + ri * 64 + r] = (bf16_t)(w[j] >> 16);
        }
    }
}

__device__ void gmlp_item(const Params& p, int l, int item, char* smem) {
    const int tid = otid(), lane = tid & 63, wid = tid >> 6, fr = lane & 15, fq = lane >> 4;
    const int h = item & 7, c = (item >> 3) & 31, b = item >> 8;
    const int tok0 = b * SEQ + c * 128;
    bf16_t* vnT = (bf16_t*)smem;
    const bf16_t* Z = (const bf16_t*)(p.ws + OFF_Z);
    {
        const int q = tid >> 1, half = tid & 1, d0 = half * 32;
        const uint4* src = (const uint4*)(Z + (size_t)(tok0 + q) * NZ + 512 + h * 64 + d0);
        float f[32];
#pragma unroll
        for (int i = 0; i < 4; ++i) { const uint4 v = src[i]; const unsigned w[4] = {v.x, v.y, v.z, v.w};
#pragma unroll
            for (int j = 0; j < 4; ++j) { f[i * 8 + j * 2] = bf2f(w[j] & 0xffffu); f[i * 8 + j * 2 + 1] = bf2f(w[j] >> 16); } }
        float s = 0.f;
#pragma unroll
        for (int i = 0; i < 32; ++i) s += f[i];
        s += __shfl_xor(s, 1);
        const float mean = s * (1.0f / 64.0f);
        float qv = 0.f;
#pragma unroll
        for (int i = 0; i < 32; ++i) { f[i] -= mean; qv += f[i] * f[i]; }
        qv += __shfl_xor(qv, 1);
        const float rstd = rsqrtf(qv * (1.0f / 64.0f) + EPS);
#pragma unroll
        for (int i = 0; i < 32; ++i) vnT[(d0 + i) * TP + q] = f2bf(f[i] * rstd);
    }
    __syncthreads();
    const bf16_t* Wsb = (const bf16_t*)(p.ws + OFF_WSB) + ((size_t)l * 8 + h) * 128 * 128;
    f32x4 acc[2][4];
#pragma unroll
    for (int i = 0; i < 2; ++i)
#pragma unroll
        for (int j = 0; j < 4; ++j) acc[i][j] = (f32x4){0.f, 0.f, 0.f, 0.f};
    const int p0 = wid * 32;
#pragma unroll
    for (int ks = 0; ks < 4; ++ks) {
        bf16x8 af[2], bfr[4];
#pragma unroll
        for (int i = 0; i < 2; ++i) af[i] = *(const bf16x8*)(Wsb + (size_t)(p0 + i * 16 + fr) * 128 + ks * 32 + fq * 8);
#pragma unroll
        for (int j = 0; j < 4; ++j) bfr[j] = *(const bf16x8*)(vnT + (j * 16 + fr) * TP + ks * 32 + fq * 8);
#pragma unroll
        for (int i = 0; i < 2; ++i)
#pragma unroll
            for (int j = 0; j < 4; ++j) acc[i][j] = MFMA16(bfr[j], af[i], acc[i][j]);
    }
    bf16_t* Y = (bf16_t*)(p.ws + OFF_Y);
    float* ssa = (float*)(p.ws + OFF_SSQA);
#pragma unroll
    for (int i = 0; i < 2; ++i) {
        const int pp = p0 + i * 16 + fr, tok = tok0 + pp;
        const float bsv = p.gmlp_bs[((size_t)l * 8 + h) * 128 + pp];
        float ss = 0.f;
#pragma unroll
        for (int j = 0; j < 4; ++j) {
            const int d = j * 16 + fq * 4;
            const uint2 uu = *(const uint2*)(Z + (size_t)tok * NZ + h * 64 + d);
            const float y0 = bf2f(uu.x & 0xffffu) * (acc[i][j][0] + bsv), y1 = bf2f(uu.x >> 16) * (acc[i][j][1] + bsv);
            const float y2 = bf2f(uu.y & 0xffffu) * (acc[i][j][2] + bsv), y3 = bf2f(uu.y >> 16) * (acc[i][j][3] + bsv);
            ss += y0 * y0 + y1 * y1 + y2 * y2 + y3 * y3;
            *(uint2*)(Y + (size_t)tok * D + h * 64 + d) = make_uint2(pk_bf16(y0, y1), pk_bf16(y2, y3));
        }
        ss += __shfl_xor(ss, 16); ss += __shfl_xor(ss, 32);
        if (fq == 0) ssa[(size_t)tok * 8 + h] = ss;
    }
    __syncthreads();
}

__device__ void ffta_item(const Params& p, int item, char* smem) {
    const int tid = otid(), lane = tid & 63, wid = tid >> 6, fr = lane & 15, fq = lane >> 4;
    const int bp = item & 63, g = (item >> 6) & 7, b = item >> 9;
    bf16_t* dT = (bf16_t*)smem;
    const bf16_t* Z = (const bf16_t*)(p.ws + OFF_Z);
    stage_transposed(Z + (size_t)(b * SEQ + bp) * NZ + 1024 + g * 128, (size_t)64 * NZ, dT);
    __syncthreads();
    const bf16_t* DA = (const bf16_t*)(p.ws + OFF_DA);
    f32x4 acc[2][4];
#pragma unroll
    for (int i = 0; i < 2; ++i)
#pragma unroll
        for (int j = 0; j < 4; ++j) acc[i][j] = (f32x4){0.f, 0.f, 0.f, 0.f};
#pragma unroll
    for (int ks = 0; ks < 4; ++ks) {
        bf16x8 af[2], bfr[4];
#pragma unroll
        for (int i = 0; i < 2; ++i) af[i] = *(const bf16x8*)(DA + (size_t)(i * 64 + wid * 16 + fr) * 128 + ks * 32 + fq * 8);
#pragma unroll
        for (int j = 0; j < 4; ++j) bfr[j] = *(const bf16x8*)(dT + (j * 16 + fr) * TP + ks * 32 + fq * 8);
#pragma unroll
        for (int i = 0; i < 2; ++i)
#pragma unroll
            for (int j = 0; j < 4; ++j) acc[i][j] = MFMA16(bfr[j], af[i], acc[i][j]);
    }
    const int k1 = wid * 16 + fr;
    const float2 cs = ((const float2*)(p.ws + OFF_TW))[bp * 64 + k1];
    bf16_t* Yb = (bf16_t*)(p.ws + OFF_H) + ((((size_t)(b * 8 + g) * 64 + k1) * 64 + bp) * 128);
#pragma unroll
    for (int j = 0; j < 4; ++j) {
        const int ch = j * 16 + fq * 4;
        float yr[4], yi[4];
#pragma unroll
        for (int e = 0; e < 4; ++e) { const float r = acc[0][j][e], im = acc[1][j][e]; yr[e] = r * cs.x + im * cs.y; yi[e] = im * cs.x - r * cs.y; }
        *(uint2*)(Yb + ch) = make_uint2(pk_bf16(yr[0], yr[1]), pk_bf16(yr[2], yr[3]));
        *(uint2*)(Yb + 64 + ch) = make_uint2(pk_bf16(yi[0], yi[1]), pk_bf16(yi[2], yi[3]));
    }
    __syncthreads();
}

__device__ void phase_mix(const Params& p, int l, char* smem, int bid, int nb) {
    for (int item = bid; item < 2048 + 4096; item += nb) {
        if (item < 2048) gmlp_item(p, l, item, smem); else ffta_item(p, item - 2048, smem);
    }
}

__device__ void phase_fftb(const Params& p, int l, char* smem, int bid, int nb) {
    const int tid = otid(), lane = tid & 63, wid = tid >> 6, fr = lane & 15, fq = lane >> 4;
    bf16_t* dT = (bf16_t*)smem;
    const bf16_t* DB = (const bf16_t*)(p.ws + OFF_DB);
    bf16_t* Y = (bf16_t*)(p.ws + OFF_Y);
    float* ssb = (float*)(p.ws + OFF_SSQB);
    for (int item = bid; item < 4096; item += nb) {
        const int k1 = item & 63, g = (item >> 6) & 7, b = item >> 9;
        stage_transposed((const bf16_t*)(p.ws + OFF_H) + (((size_t)(b * 8 + g) * 64 + k1) * 64) * 128, 128, dT);
        __syncthreads();
        f32x4 acc[4];
#pragma unroll
        for (int j = 0; j < 4; ++j) acc[j] = (f32x4){0.f, 0.f, 0.f, 0.f};
#pragma unroll
        for (int ks = 0; ks < 4; ++ks) {
            const bf16x8 af = *(const bf16x8*)(DB + (size_t)(wid * 16 + fr) * 128 + ks * 32 + fq * 8);
#pragma unroll
            for (int j = 0; j < 4; ++j) { const bf16x8 bfr = *(const bf16x8*)(dT + (j * 16 + fr) * TP + ks * 32 + fq * 8); acc[j] = MFMA16(bfr, af, acc[j]); }
        }
        const int k2 = wid * 16 + fr, tok = b * SEQ + k1 + 64 * k2;
        float ss = 0.f;
#pragma unroll
        for (int j = 0; j < 4; ++j) {
            const int ch = j * 16 + fq * 4;
            const float4 fb = *(const float4*)(p.fnet_b + ((size_t)l * 8 + g) * 64 + ch);
            const float y0 = acc[j][0] * (1.0f / 512.0f) + fb.x, y1 = acc[j][1] * (1.0f / 512.0f) + fb.y, y2 = acc[j][2] * (1.0f / 512.0f) + fb.z, y3 = acc[j][3] * (1.0f / 512.0f) + fb.w;
            ss += y0 * y0 + y1 * y1 + y2 * y2 + y3 * y3;
            *(uint2*)(Y + (size_t)tok * D + 512 + g * 64 + ch) = make_uint2(pk_bf16(y0, y1), pk_bf16(y2, y3));
        }
        ss += __shfl_xor(ss, 16); ss += __shfl_xor(ss, 32);
        if (fq == 0) ssb[(size_t)tok * 8 + g] = ss;
        __syncthreads();
    }
}

#define INS16(a, v) do { a[15] = med3i(a[14], a[15], v); a[14] = med3i(a[13], a[14], v); a[13] = med3i(a[12], a[13], v); a[12] = med3i(a[11], a[12], v); \
    a[11] = med3i(a[10], a[11], v); a[10] = med3i(a[9], a[10], v); a[9] = med3i(a[8], a[9], v); a[8] = med3i(a[7], a[8], v); a[7] = med3i(a[6], a[7], v); \
    a[6] = med3i(a[5], a[6], v); a[5] = med3i(a[4], a[5], v); a[4] = med3i(a[3], a[4], v); a[3] = med3i(a[2], a[3], v); a[2] = med3i(a[1], a[2], v); \
    a[1] = med3i(a[0], a[1], v); a[0] = max(a[0], v); } while (0)

template <int I, int J> struct CandLoop {
    static __device__ __forceinline__ void run(int (&a)[16], const float (&f1)[16], const float (&f2)[16]) {
        if constexpr ((I + 1) * (J + 1) <= 16) { const int key = (f2key(f1[I] + f2[J]) & ~255) | (I * 16 + J); INS16(a, key); }
        if constexpr (J + 1 < 16) CandLoop<I, J + 1>::run(a, f1, f2);
        else if constexpr (I + 1 < 16) CandLoop<I + 1, 0>::run(a, f1, f2);
    }
};

typedef _Float16 f16x2_t __attribute__((ext_vector_type(2)));
__device__ __forceinline__ unsigned pk_f16(float lo, float hi) { const f16x2_t v = {(_Float16)lo, (_Float16)hi}; return __builtin_bit_cast(unsigned, v); }
__device__ __forceinline__ int h2key(unsigned bits16) { const int b = (int)(short)bits16; return b ^ ((b >> 15) & 0x7fff); }
__device__ __forceinline__ float key2h(int k) { const int b = k ^ ((k >> 15) & 0x7fff); return (float)__builtin_bit_cast(_Float16, (unsigned short)(b & 0xffff)); }

__device__ void phase_topk(const Params& p, int l, char* smem, int bid, int nb) {
    const int tid = otid(), lane = tid & 63, wid = tid >> 6, fr = lane & 15, fq = lane >> 4;
    unsigned* S32 = (unsigned*)smem;
    int* TT = (int*)smem;
    const bf16_t* Q = (const bf16_t*)(p.ws + OFF_Z);
    int* eidx = (int*)(p.ws + OFF_Y); float* gw = (float*)(p.ws + OFF_Y + (size_t)T * 128 * 4);
    const int hh = wid >> 1, half = wid & 1;
    for (int item = bid; item < (T / 64) * 4; item += nb) {
        const int hp = item & 3, tok0 = (item >> 2) * 64, h = hp * 2 + hh;
        const bf16_t* Kh = (const bf16_t*)(p.ws + OFF_K12) + (((size_t)l * 8 + h) * 256 + half * 128) * 128;
        const bf16_t* Qh = Q + (size_t)tok0 * 2048 + h * 256 + half * 128;
        {
            f32x4 acc[4][8];
#pragma unroll
            for (int i = 0; i < 4; ++i)
#pragma unroll
                for (int j = 0; j < 8; ++j) acc[i][j] = (f32x4){0.f, 0.f, 0.f, 0.f};
#pragma unroll
            for (int ks = 0; ks < 4; ++ks) {
                bf16x8 af[4];
#pragma unroll
                for (int i = 0; i < 4; ++i) af[i] = *(const bf16x8*)(Qh + (size_t)(i * 16 + fr) * 2048 + ks * 32 + fq * 8);
#pragma unroll
                for (int jh = 0; jh < 2; ++jh) {
                    bf16x8 bfr[4];
#pragma unroll
                    for (int j = 0; j < 4; ++j) bfr[j] = *(const bf16x8*)(Kh + (size_t)((jh * 4 + j) * 16 + fr) * 128 + ks * 32 + fq * 8);
#pragma unroll
                    for (int i = 0; i < 4; ++i)
#pragma unroll
                        for (int j = 0; j < 4; ++j) acc[i][jh * 4 + j] = MFMA16(bfr[j], af[i], acc[i][jh * 4 + j]);
                    __builtin_amdgcn_sched_barrier(0);
                }
            }
#pragma unroll
            for (int i = 0; i < 4; ++i)
#pragma unroll
                for (int j = 0; j < 8; ++j) {
                    unsigned* d = S32 + (i * 16 + fr) * 257 + hh * 128 + half * 64 + j * 8 + fq * 2;
                    d[0] = pk_f16(acc[i][j][0], acc[i][j][1]); d[1] = pk_f16(acc[i][j][2], acc[i][j][3]);
                }
        }
        __syncthreads();
        int a[16];
#pragma unroll
        for (int i = 0; i < 16; ++i) a[i] = (int)0x80000000;
        {
            const unsigned* sr = S32 + lane * 257 + hh * 128 + half * 64;
#pragma unroll 2
            for (int i = 0; i < 64; ++i) {
                const unsigned w = sr[i];
                const int k0 = (h2key(w & 0xffffu) << 7) | (2 * i), k1 = (h2key(w >> 16) << 7) | (2 * i + 1);
                INS16(a, k0); INS16(a, k1);
            }
        }
        __syncthreads();
#pragma unroll
        for (int i = 0; i < 16; ++i) TT[((lane * 2 + hh) * 2 + half) * 16 + i] = a[i];
        __syncthreads();
        if (tid < 128) {
            const int tk = tid & 63, h2 = tid >> 6, hd = hp * 2 + h2;
            const int* t1 = TT + ((tk * 2 + h2) * 2) * 16; const int* t2 = t1 + 16;
            float f1[16], f2[16];
#pragma unroll
            for (int i = 0; i < 16; ++i) { f1[i] = key2h(t1[i] >> 7); f2[i] = key2h(t2[i] >> 7); }
            int c[16];
#pragma unroll
            for (int i = 0; i < 16; ++i) c[i] = (int)0x80000000;
            CandLoop<0, 0>::run(c, f1, f2);
            float sc[16], e[16], sum = 0.f; int ex[16];
#pragma unroll
            for (int i = 0; i < 16; ++i) {
                sc[i] = key2f(c[i] & ~255);
                const int code = c[i] & 255;
                ex[i] = (t1[code >> 4] & 127) * 128 + (t2[code & 15] & 127);
            }
#pragma unroll
            for (int i = 0; i < 16; ++i) { e[i] = __expf(sc[i] - sc[0]); sum += e[i]; }
            const float inv = 1.0f / sum;
            int4* ep = (int4*)(eidx + (size_t)(tok0 + tk) * 128 + hd * 16); float4* gp = (float4*)(gw + (size_t)(tok0 + tk) * 128 + hd * 16);
#pragma unroll
            for (int i = 0; i < 4; ++i) { ep[i] = make_int4(ex[4 * i], ex[4 * i + 1], ex[4 * i + 2], ex[4 * i + 3]); gp[i] = make_float4(e[4 * i] * inv, e[4 * i + 1] * inv, e[4 * i + 2] * inv, e[4 * i + 3] * inv); }
        }
        __syncthreads();
    }
}

__device__ __forceinline__ float dot16_fp8(const float (&h)[16], const int4& u) {
    const int w[4] = {u.x, u.y, u.z, u.w};
    f32x2_t a = {0.f, 0.f};
#pragma unroll
    for (int i = 0; i < 4; ++i) {
        const f32x2_t lo = __builtin_amdgcn_cvt_pk_f32_fp8(w[i], false), hi = __builtin_amdgcn_cvt_pk_f32_fp8(w[i], true);
        const f32x2_t h0 = {h[4 * i], h[4 * i + 1]}, h1 = {h[4 * i + 2], h[4 * i + 3]};
        a = __builtin_elementwise_fma(lo, h0, a); a = __builtin_elementwise_fma(hi, h1, a);
    }
    return a.x + a.y;
}
__device__ __forceinline__ void axpy16_fp8(float (&o)[16], float c, const int4& v) {
    const int w[4] = {v.x, v.y, v.z, v.w};
#pragma unroll
    for (int i = 0; i < 4; ++i) {
        const f32x2_t lo = __builtin_amdgcn_cvt_pk_f32_fp8(w[i], false), hi = __builtin_amdgcn_cvt_pk_f32_fp8(w[i], true);
        o[4 * i] += c * lo.x; o[4 * i + 1] += c * lo.y; o[4 * i + 2] += c * hi.x; o[4 * i + 3] += c * hi.y;
    }
}

__device__ void phase_pu(const Params& p, int l, int slice, int grank, int gsz) {
    const int tid_ = otid(); const int lane = tid_ & 63, wid = tid_ >> 6, sub = lane & 7, pg = lane >> 3;
    const bf16_t* H = (const bf16_t*)(p.ws + OFF_H) + slice * 128 + sub * 16;
    const char* U8 = p.ws + OFF_UB + ((size_t)(l * 8 + slice) * NE) * 128 + sub * 16;
    const int* eidx = (const int*)(p.ws + OFF_Y) + lane;
    float* part = (float*)(p.ws + OFF_Z) + (size_t)slice * T * 128 + 16 * sub + pg;
    const int stride = gsz * 4;
#define PU_ISSUE(e_, u_) do { _Pragma("unroll") for (int q = 0; q < 8; ++q) { const int ej = __shfl(e_, 8 * q + pg); u_[q] = *(const int4*)(U8 + (size_t)ej * 128); } } while (0)
    int tok = grank * 4 + wid;
    if (tok >= T) return;
    int4 uA[8], uB[8];
    int ea = eidx[(size_t)tok * 128], eb = eidx[(size_t)tok * 128 + 64];
    uint4 h0 = *(const uint4*)(H + (size_t)tok * D), h1 = *(const uint4*)(H + (size_t)tok * D + 8);
    PU_ISSUE(ea, uA);
#pragma nounroll
    for (;;) {
        __builtin_amdgcn_sched_barrier(0);
        const int tokn = tok + stride; const bool more = tokn < T;
        int ean = 0, ebn = 0; uint4 h0n = h0, h1n = h1;
        if (more) { ean = eidx[(size_t)tokn * 128]; ebn = eidx[(size_t)tokn * 128 + 64]; h0n = *(const uint4*)(H + (size_t)tokn * D); h1n = *(const uint4*)(H + (size_t)tokn * D + 8); }
        PU_ISSUE(eb, uB);
        __builtin_amdgcn_sched_barrier(0);
        float hf[16];
        { const unsigned w_[8] = {h0.x, h0.y, h0.z, h0.w, h1.x, h1.y, h1.z, h1.w};
#pragma unroll
          for (int i = 0; i < 8; ++i) { hf[2 * i] = bf2f(w_[i] & 0xffffu); hf[2 * i + 1] = bf2f(w_[i] >> 16); } }
        float v[16];
#pragma unroll
        for (int q = 0; q < 8; ++q) v[q] = dot16_fp8(hf, uA[q]);
        __builtin_amdgcn_sched_barrier(0);
        if (more) PU_ISSUE(ean, uA);
        __builtin_amdgcn_sched_barrier(0);
#pragma unroll
        for (int q = 0; q < 8; ++q) v[8 + q] = dot16_fp8(hf, uB[q]);
        float w8[8], w4[4], w2[2];
        { const bool hi = (lane & 4) != 0;
#pragma unroll
          for (int m = 0; m < 8; ++m) { const float send = hi ? v[m] : v[m + 8], keep = hi ? v[m + 8] : v[m]; w8[m] = keep + __shfl_xor(send, 4); } }
        { const bool hi = (lane & 2) != 0;
#pragma unroll
          for (int m = 0; m < 4; ++m) { const float send = hi ? w8[m] : w8[m + 4], keep = hi ? w8[m + 4] : w8[m]; w4[m] = keep + __shfl_xor(send, 2); } }
        { const bool hi = (lane & 1) != 0;
#pragma unroll
          for (int m = 0; m < 2; ++m) { const float send = hi ? w4[m] : w4[m + 2], keep = hi ? w4[m + 2] : w4[m]; w2[m] = keep + __shfl_xor(send, 1); } }
        float* pr = part + (size_t)tok * 128;
        pr[0] = w2[0]; pr[8] = w2[1];
        if (!more) break;
        tok = tokn; ea = ean; eb = ebn; h0 = h0n; h1 = h1n;
    }
#undef PU_ISSUE
}
__device__ void phase_pc(const Params& p, int l, int bid, int nb) {
    const int tid_ = otid(); const int lane = tid_ & 63, wid = tid_ >> 6;
    const int* eidx = (const int*)(p.ws + OFF_Y); const float* gw = (const float*)(p.ws + OFF_Y + (size_t)T * 128 * 4);
    float* coef = (float*)(p.ws + OFF_Y + (size_t)T * 128 * 8);
    const float* part = (const float*)(p.ws + OFF_Z);
    const float* usc = (const float*)(p.ws + OFF_USC) + (size_t)l * NE; const float* vsc = (const float*)(p.ws + OFF_VSC) + (size_t)l * NE;
    for (int tok = bid * 4 + wid; tok < T; tok += nb * 4) {
#pragma unroll
        for (int hh = 0; hh < 2; ++hh) {
            const size_t j = (size_t)tok * 128 + hh * 64 + lane;
            const int e = eidx[j]; const float g = gw[j];
            float a = 0.f;
#pragma unroll
            for (int sl = 0; sl < 8; ++sl) a += part[(size_t)sl * T * 128 + j];
            coef[j] = g * gelu_f(a * usc[e]) * vsc[e];
        }
    }
}
__device__ void phase_pv(const Params& p, int l, int slice, int grank, int gsz) {
    const int tid_ = otid(); const int lane = tid_ & 63, wid = tid_ >> 6, sub = lane & 7, pg = lane >> 3;
    const char* V8 = p.ws + OFF_VB + ((size_t)(l * 8 + slice) * NE) * 128 + sub * 16;
    const int* eidx = (const int*)(p.ws + OFF_Y) + lane;
    const float* coef = (const float*)(p.ws + OFF_Y + (size_t)T * 128 * 8) + lane;
    const int col = slice * 128 + 16 * sub + 2 * pg;
    const float* g2p = (const float*)(p.ws + OFF_MOD) + (size_t)l * NB * 6144 + 5 * D + col;
    bf16_t* xcol = (bf16_t*)(p.ws + OFF_XR) + col;
    const int stride = gsz * 4;
#define PV_ISSUE(e_, c_, v_, cj_) do { _Pragma("unroll") for (int q = 0; q < 8; ++q) { const int ej = __shfl(e_, 8 * q + pg); cj_[q] = __shfl(c_, 8 * q + pg); v_[q] = *(const int4*)(V8 + (size_t)ej * 128); } } while (0)
    int tok = grank * 4 + wid;
    if (tok >= T) return;
    int4 vA[8], vB[8]; float cA[8], cB[8];
    int ea = eidx[(size_t)tok * 128], eb = eidx[(size_t)tok * 128 + 64];
    float ca = coef[(size_t)tok * 128], cb = coef[(size_t)tok * 128 + 64];
    PV_ISSUE(ea, ca, vA, cA);
#pragma nounroll
    for (;;) {
        __builtin_amdgcn_sched_barrier(0);
        const int tokn = tok + stride; const bool more = tokn < T;
        int ean = 0, ebn = 0; float can = 0.f, cbn = 0.f;
        if (more) { ean = eidx[(size_t)tokn * 128]; ebn = eidx[(size_t)tokn * 128 + 64]; can = coef[(size_t)tokn * 128]; cbn = coef[(size_t)tokn * 128 + 64]; }
        unsigned* xp = (unsigned*)(xcol + (size_t)tok * D); const float2 g2 = *(const float2*)(g2p + (size_t)(tok / SEQ) * 6144);
        const unsigned xw = *xp;
        PV_ISSUE(eb, cb, vB, cB);
        __builtin_amdgcn_sched_barrier(0);
        float o[16];
#pragma unroll
        for (int i = 0; i < 16; ++i) o[i] = 0.f;
#pragma unroll
        for (int q = 0; q < 8; ++q) axpy16_fp8(o, cA[q], vA[q]);
        __builtin_amdgcn_sched_barrier(0);
        if (more) PV_ISSUE(ean, can, vA, cA);
        __builtin_amdgcn_sched_barrier(0);
#pragma unroll
        for (int q = 0; q < 8; ++q) axpy16_fp8(o, cB[q], vB[q]);
        float t8[8], t4[4], t2[2];
        { const bool hi = (lane & 32) != 0;
#pragma unroll
          for (int m = 0; m < 8; ++m) { const float send = hi ? o[m] : o[m + 8], keep = hi ? o[m + 8] : o[m]; t8[m] = keep + __shfl_xor(send, 32); } }
        { const bool hi = (lane & 16) != 0;
#pragma unroll
          for (int m = 0; m < 4; ++m) { const float send = hi ? t8[m] : t8[m + 4], keep = hi ? t8[m + 4] : t8[m]; t4[m] = keep + __shfl_xor(send, 16); } }
        { const bool hi = (lane & 8) != 0;
#pragma unroll
          for (int m = 0; m < 2; ++m) { const float send = hi ? t4[m] : t4[m + 2], keep = hi ? t4[m + 2] : t4[m]; t2[m] = keep + __shfl_xor(send, 8); } }
        *xp = pk_bf16(bf2f(xw & 0xffffu) + g2.x * t2[0], bf2f(xw >> 16) + g2.y * t2[1]);
        if (!more) break;
        tok = tokn; ea = ean; eb = ebn; ca = can; cb = cbn;
    }
#undef PV_ISSUE
}
__device__ void phase_final_norm(const Params& p, int bid, int nb) {
    const int tid_ = otid(); const int lane = tid_ & 63, wid = tid_ >> 6;
    for (int tok = bid * 4 + wid; tok < T; tok += nb * 4) {
        float* xr = p.out + (size_t)tok * D;
        const bf16_t* xs = (const bf16_t*)(p.ws + OFF_XR) + (size_t)tok * D;
        float4 v[4]; float ss = 0.f;
#pragma unroll
        for (int i = 0; i < 4; ++i) { const uint2 w = *(const uint2*)(xs + i * 256 + lane * 4); v[i] = make_float4(bf2f(w.x & 0xffffu), bf2f(w.x >> 16), bf2f(w.y & 0xffffu), bf2f(w.y >> 16));
            ss += v[i].x * v[i].x + v[i].y * v[i].y + v[i].z * v[i].z + v[i].w * v[i].w; }
        ss = wave_sum(ss);
        const float rstd = rsqrtf(ss * (1.0f / D) + EPS);
#pragma unroll
        for (int i = 0; i < 4; ++i) { const float4 g = *(const float4*)(p.final_g + i * 256 + lane * 4);
            *(float4*)(xr + i * 256 + lane * 4) = make_float4(v[i].x * rstd * g.x, v[i].y * rstd * g.y, v[i].z * rstd * g.z, v[i].w * rstd * g.w); }
    }
}

#define XB_TMO      128
#define XB_XCNT(j)  (256  + 64 * (j))
#define XB_XSUB(j)  (1280 + 64 * (j))
#define XB_XGEN(j)  (2304 + 64 * (j))
#define XB_TOP      3328
#define XB_TOPGEN   3392
#define XCD_BAR_WORDS 3456
#define XB_SPIN_CAP (1u << 22)
__device__ __forceinline__ unsigned xb_ld(unsigned* p)              { return __hip_atomic_load(p, __ATOMIC_RELAXED, __HIP_MEMORY_SCOPE_AGENT); }
__device__ __forceinline__ unsigned xb_add(unsigned* p, unsigned v) { return __hip_atomic_fetch_add(p, v, __ATOMIC_RELAXED, __HIP_MEMORY_SCOPE_AGENT); }
__device__ __forceinline__ unsigned xb_xcc_id() { return (unsigned)__builtin_amdgcn_s_getreg((3 << 11) | 20) & 0xFu; }
#define XB_SPIN(cond, bar) do { unsigned _sp = 0; while (cond) { __builtin_amdgcn_s_sleep(1); \
    if ((++_sp & 255u) == 0u) { if (xb_ld(&(bar)[XB_TMO])) break; if (_sp > XB_SPIN_CAP) { atomicAdd(&(bar)[XB_TMO], 1u); break; } } } } while (0)
__device__ __forceinline__ void xcd_barrier_post(unsigned* bar, volatile LAS unsigned* st) {
    if (threadIdx.x == 0) { const unsigned x = xb_xcc_id(); st[3] = x; st[2] = xb_add(&bar[XB_XCNT(x)], 1u); }
}
__device__ __forceinline__ void xcd_barrier_complete(unsigned* bar, unsigned x, unsigned& nloc, unsigned& nx) {
    const unsigned G = gridDim.x * gridDim.y * gridDim.z;
    unsigned sum, cnt, mine, sp = 0u;
    for (;;) {
        sum = 0u; cnt = 0u; mine = 0u;
#pragma unroll
        for (unsigned j = 0; j < 16; ++j) { const unsigned c = xb_ld(&bar[XB_XCNT(j)]); sum += c; cnt += (c > 0u) ? 1u : 0u; mine = (j == x) ? c : mine; }
        if (sum == G) break;
        __builtin_amdgcn_s_sleep(1);
        if ((++sp & 255u) == 0u) { if (xb_ld(&bar[XB_TMO])) break; if (sp > XB_SPIN_CAP) { atomicAdd(&bar[XB_TMO], 1u); break; } }
    }
    nloc = mine > 0u ? mine : 1u; nx = cnt > 0u ? cnt : 1u;
}
__device__ __forceinline__ void xcd_barrier(unsigned* bar, volatile LAS unsigned* st) {
    asm volatile("s_waitcnt vmcnt(0)" ::: "memory");
    __syncthreads();
    if (threadIdx.x == 0) {
        __builtin_amdgcn_s_waitcnt(0);
        unsigned nloc = st[0], nx = st[1]; const unsigned x = st[3];
        if (nloc == 0u) { xcd_barrier_complete(bar, x, nloc, nx); st[0] = nloc; st[1] = nx; }
        const unsigned old = xb_add(&bar[XB_XSUB(x)], 1u);
        const unsigned gen = old / nloc;
        if (old + 1u == (gen + 1u) * nloc) {
            __builtin_amdgcn_fence(__ATOMIC_RELEASE, "agent");
            asm volatile("s_waitcnt vmcnt(0)" ::: "memory");
            const unsigned og = xb_add(&bar[XB_TOP], 1u);
            const unsigned tg = og / nx;
            if (og + 1u == (tg + 1u) * nx) xb_add(&bar[XB_TOPGEN], 1u);
            else XB_SPIN(xb_ld(&bar[XB_TOPGEN]) == tg, bar);
            __builtin_amdgcn_fence(__ATOMIC_ACQUIRE, "agent");
            xb_add(&bar[XB_XGEN(x)], 1u);
            asm volatile("s_waitcnt vmcnt(0)" ::: "memory");
        } else {
            XB_SPIN(xb_ld(&bar[XB_XGEN(x)]) == gen, bar);
            __builtin_amdgcn_fence(__ATOMIC_ACQUIRE, "agent");
            asm volatile("s_waitcnt vmcnt(0)" ::: "memory");
        }
    }
    __syncthreads();
}

#if MEGA
#if PROBE_A >= 0
#define TSTAMP(i) do { if (blockIdx.x == 0 && threadIdx.x == 0) ts[i] = __builtin_amdgcn_s_memrealtime(); } while (0)
#else
#define TSTAMP(i) do { } while (0)
#endif
__global__ void __launch_bounds__(256, 2) mega_kernel(Params p) {
    __shared__ __attribute__((aligned(16))) char smem[SMEM_BYTES];
    __shared__ uint4 xb_words;
#if PROBE_A >= 0
    __shared__ unsigned long long ts[26];
#endif
    cg::grid_group grid = cg::this_grid();
    const int bid = blockIdx.x, nb = gridDim.x;
    unsigned* bar = (unsigned*)(p.ws + OFF_BAR);
    if (threadIdx.x == 0) xb_words = make_uint4(0u, 0u, 0u, 0u);
    if (bid == 0) for (int i = threadIdx.x; i < XCD_BAR_WORDS; i += 256) bar[i] = 0u;
    TSTAMP(0);
    phase_prep(p, smem, bid, nb);
    grid.sync();
    volatile LAS unsigned* xst = (volatile LAS unsigned*)&xb_words;
    xcd_barrier_post(bar, xst);
    TSTAMP(1);
    phase_norm<false>(p.x, p.norm1_g, (const float*)(p.ws + OFF_MOD), 0, D, (bf16_t*)(p.ws + OFF_H), bid, nb); xcd_barrier((unsigned*)(p.ws + OFF_BAR), (volatile LAS unsigned*)&xb_words);
    int slice, grank; const int gsz = nb / 8;
    {
        const unsigned myx = xst[3], myrank = xst[2];
        unsigned pre = 0;
#pragma unroll
        for (unsigned j = 0; j < 16; ++j) { const unsigned c = xb_ld(&bar[XB_XCNT(j)]); pre += (j < myx) ? c : 0u; }
        const int gi = __builtin_amdgcn_readfirstlane((int)(pre + myrank));
        slice = gi / gsz; grank = gi % gsz;
    }
#pragma nounroll
    for (int l = 0; l < NL; ++l) {
        TSTAMP(2 + 11 * l); phase_gemm1(p, l, smem, bid, nb); xcd_barrier((unsigned*)(p.ws + OFF_BAR), (volatile LAS unsigned*)&xb_words);
        TSTAMP(3 + 11 * l); phase_mix(p, l, smem, bid, nb); xcd_barrier((unsigned*)(p.ws + OFF_BAR), (volatile LAS unsigned*)&xb_words);
        TSTAMP(4 + 11 * l); phase_fftb(p, l, smem, bid, nb); xcd_barrier((unsigned*)(p.ws + OFF_BAR), (volatile LAS unsigned*)&xb_words);
        TSTAMP(5 + 11 * l); phase_gemm2(p, l, smem, bid, nb); xcd_barrier((unsigned*)(p.ws + OFF_BAR), (volatile LAS unsigned*)&xb_words);
        TSTAMP(6 + 11 * l); phase_norm<true>(p.ws + OFF_XR, p.norm2_g + l * D, (const float*)(p.ws + OFF_MOD) + (size_t)l * NB * 6144, 3 * D, 4 * D, (bf16_t*)(p.ws + OFF_H), bid, nb); xcd_barrier((unsigned*)(p.ws + OFF_BAR), (volatile LAS unsigned*)&xb_words);
        TSTAMP(7 + 11 * l); phase_gemm3(p, l, smem, bid, nb); xcd_barrier((unsigned*)(p.ws + OFF_BAR), (volatile LAS unsigned*)&xb_words);
        TSTAMP(8 + 11 * l); phase_topk(p, l, smem, bid, nb); xcd_barrier((unsigned*)(p.ws + OFF_BAR), (volatile LAS unsigned*)&xb_words);
        TSTAMP(9 + 11 * l); phase_pu(p, l, slice, grank, gsz); xcd_barrier((unsigned*)(p.ws + OFF_BAR), (volatile LAS unsigned*)&xb_words);
        TSTAMP(10 + 11 * l); phase_pc(p, l, bid, nb); xcd_barrier((unsigned*)(p.ws + OFF_BAR), (volatile LAS unsigned*)&xb_words);
        TSTAMP(11 + 11 * l); phase_pv(p, l, slice, grank, gsz); xcd_barrier((unsigned*)(p.ws + OFF_BAR), (volatile LAS unsigned*)&xb_words);
        TSTAMP(12 + 11 * l);
        if (l + 1 < NL) { phase_norm<true>(p.ws + OFF_XR, p.norm1_g + (l + 1) * D, (const float*)(p.ws + OFF_MOD) + (size_t)(l + 1) * NB * 6144, 0, D, (bf16_t*)(p.ws + OFF_H), bid, nb); xcd_barrier((unsigned*)(p.ws + OFF_BAR), (volatile LAS unsigned*)&xb_words); }
        else phase_final_norm(p, bid, nb);
    }
    TSTAMP(24);
#if PROBE_A >= 0
    if (bid == 0 && threadIdx.x == 0) p.out[0] += (float)(ts[PROBE_B] - ts[PROBE_A]) * 0.01f / PROBE_DIV;
#endif
}
#endif

extern "C" void kernel_launch(void* const* d_in, const int* in_sizes, int n_in, void* d_out, int out_size, void* d_ws, size_t ws_size, hipStream_t stream) {
    (void)in_sizes; (void)n_in; (void)out_size;
    if (ws_size < OFF_END) { fprintf(stderr, "workspace too small: %zu < %zu\n", ws_size, (size_t)OFF_END); return; }
    Params p{};
    p.x = (const float*)d_in[0]; p.c = (const float*)d_in[1]; p.mod_w = (const float*)d_in[2]; p.mod_b = (const float*)d_in[3]; p.norm1_g = (const float*)d_in[4];
    p.w_in = (const float*)d_in[5]; p.gmlp_ws = (const float*)d_in[6]; p.gmlp_bs = (const float*)d_in[7]; p.fnet_w = (const float*)d_in[8]; p.fnet_b = (const float*)d_in[9];
    p.gain_a = (const float*)d_in[10]; p.gain_b = (const float*)d_in[11]; p.w_out = (const float*)d_in[12]; p.norm2_g = (const float*)d_in[13]; p.wq = (const float*)d_in[14];
    p.k1 = (const float*)d_in[15]; p.k2 = (const float*)d_in[16]; p.pu = (const float*)d_in[17]; p.pv = (const float*)d_in[18]; p.final_g = (const float*)d_in[19];
    p.out = (float*)d_out; p.ws = (char*)d_ws;
#if MEGA
    static int grid_blocks = 0;
    if (!grid_blocks) {
        int dev = 0, cus = 0, per_cu = 0;
        hipGetDevice(&dev);
        hipDeviceGetAttribute(&cus, hipDeviceAttributeMultiprocessorCount, dev);
        hipOccupancyMaxActiveBlocksPerMultiprocessor(&per_cu, mega_kernel, 256, 0);
        if (per_cu > 2) per_cu = 2;
        grid_blocks = (cus * per_cu) / 8 * 8;
    }
    void* args[] = {&p};
    hipError_t e = hipLaunchCooperativeKernel((void*)mega_kernel, dim3(grid_blocks), dim3(256), args, 0, stream);
    if (e != hipSuccess) fprintf(stderr, "cooperative launch failed: %s (grid %d)\n", hipGetErrorString(e), grid_blocks);
#endif
}
```

```cpp
#include <hip/hip_runtime.h>
#include <hip/hip_cooperative_groups.h>
#include <cstdio>
#include <cstdint>
namespace cg = cooperative_groups;

#ifndef MEGA
#define MEGA 1
#endif
#ifndef PROBE_A
#define PROBE_A -1
#define PROBE_B 0
#define PROBE_DIV 10.0f
#endif

typedef unsigned short bf16_t;
typedef short bf16x8 __attribute__((ext_vector_type(8)));
typedef float f32x4 __attribute__((ext_vector_type(4)));
typedef __bf16 bf16x2_t __attribute__((ext_vector_type(2)));

constexpr int D = 1024, NB = 8, SEQ = 4096, T = NB * SEQ, NL = 2;
constexpr int NZ = 2048;
constexpr int NE = 16384;
constexpr float EPS = 1e-6f;

constexpr size_t OFF_MOD  = 0;
constexpr size_t OFF_W1T  = OFF_MOD  + (size_t)NL * NB * 6144 * 4;
constexpr size_t OFF_W2T  = OFF_W1T  + (size_t)NL * 2048 * 1024 * 2;
constexpr size_t OFF_WQT  = OFF_W2T  + (size_t)NL * 1024 * 1024 * 2;
constexpr size_t OFF_K12  = OFF_WQT  + (size_t)NL * 2048 * 1024 * 2;
constexpr size_t OFF_WSB  = OFF_K12  + (size_t)NL * 8 * 256 * 128 * 2;
constexpr size_t OFF_DA   = OFF_WSB  + (size_t)NL * 8 * 128 * 128 * 2;
constexpr size_t OFF_DB   = OFF_DA   + 128 * 128 * 2;
constexpr size_t OFF_TW   = OFF_DB   + 64 * 128 * 2;
constexpr size_t OFF_SSQA = OFF_TW   + 64 * 64 * 8;
constexpr size_t OFF_SSQB = OFF_SSQA + (size_t)T * 8 * 4;
constexpr size_t OFF_UB   = OFF_SSQB + (size_t)T * 8 * 4;
constexpr size_t OFF_VB   = OFF_UB   + (size_t)NL * NE * 1024;
constexpr size_t OFF_USC  = OFF_VB   + (size_t)NL * NE * 1024;
constexpr size_t OFF_VSC  = OFF_USC  + (size_t)NL * NE * 4;
constexpr size_t OFF_H    = OFF_VSC  + (size_t)NL * NE * 4;
constexpr size_t OFF_Z    = OFF_H    + (size_t)T * 1024 * 2;
constexpr size_t OFF_Y    = OFF_Z    + (size_t)T * 2048 * 2;
constexpr size_t OFF_BAR  = OFF_Y    + (size_t)T * 1024 * 2;
constexpr size_t OFF_XR   = OFF_BAR  + 16384;
constexpr size_t OFF_END  = OFF_XR   + (size_t)T * 1024 * 2;

struct Params {
    const float* x; const float* c; const float* mod_w; const float* mod_b; const float* norm1_g; const float* w_in;
    const float* gmlp_ws; const float* gmlp_bs; const float* fnet_w; const float* fnet_b; const float* gain_a; const float* gain_b;
    const float* w_out; const float* norm2_g; const float* wq; const float* k1; const float* k2; const float* pu; const float* pv; const float* final_g;
    float* out; char* ws;
};

constexpr int SMEM_BYTES = 73984;

__device__ __forceinline__ float bf2f(unsigned v) { return __uint_as_float(v << 16); }
typedef float f32x2_t __attribute__((ext_vector_type(2)));
__device__ __forceinline__ unsigned pk_bf16(float lo, float hi) { const f32x2_t v = {lo, hi}; return __builtin_bit_cast(unsigned, __builtin_convertvector(v, bf16x2_t)); }
__device__ __forceinline__ bf16_t f2bf(float f) { return (bf16_t)(pk_bf16(f, 0.f) & 0xffffu); }
__device__ __forceinline__ float gelu_f(float v) {
    const float t = __builtin_amdgcn_rcpf(fabsf(v) * 0.2316418882f + 1.0f);
    float q = t * 0.5307027145f + (-0.7265760135f); q = q * t + 0.7107068705f; q = q * t + (-0.142248368f); q = q * t + 0.127414796f; q = q * t;
    const float m = v * (q * __builtin_amdgcn_exp2f(v * v * (-0.72134752044f)));
    return v < 0.f ? m : v - m;
}
__device__ __forceinline__ int med3i(int a, int b, int c) { return max(min(a, b), min(max(a, b), c)); }
__device__ __forceinline__ int f2key(float f) { int b = __float_as_int(f); return b ^ ((b >> 31) & 0x7fffffff); }
__device__ __forceinline__ float key2f(int k) { return __int_as_float(k ^ ((k >> 31) & 0x7fffffff)); }
__device__ __forceinline__ float wave_sum(float v) {
#pragma unroll
    for (int o = 32; o >= 1; o >>= 1) v += __shfl_xor(v, o);
    return v;
}
__device__ __forceinline__ int otid() { int t = threadIdx.x; asm volatile("" : "+v"(t)); return t; }
#define MFMA16(a, b, c) __builtin_amdgcn_mfma_f32_16x16x32_bf16((a), (b), (c), 0, 0, 0)

__device__ void transpose_tile(const float* __restrict__ src, int ld, int k0, int n0, bf16_t* __restrict__ dst  , int dn0,
                               const float* __restrict__ kscale, float* tile  ) {
    const int tid = otid();
#pragma unroll
    for (int i = 0; i < 4; ++i) {
        const int r = (tid >> 4) + 16 * i, c4 = (tid & 15) * 4;
        const float4 v = *(const float4*)(src + (size_t)(k0 + r) * ld + n0 + c4);
        const float s = kscale ? kscale[k0 + r] : 1.0f;
        tile[r * 65 + c4 + 0] = v.x * s; tile[r * 65 + c4 + 1] = v.y * s; tile[r * 65 + c4 + 2] = v.z * s; tile[r * 65 + c4 + 3] = v.w * s;
    }
    __syncthreads();
    {
        const int n = tid >> 2, ks = (tid & 3) * 16;
        unsigned w[8];
#pragma unroll
        for (int j = 0; j < 8; ++j) w[j] = pk_bf16(tile[(ks + 2 * j) * 65 + n], tile[(ks + 2 * j + 1) * 65 + n]);
        uint4* d = (uint4*)(dst + (size_t)(dn0 + n) * 1024 + k0 + ks);
        d[0] = make_uint4(w[0], w[1], w[2], w[3]); d[1] = make_uint4(w[4], w[5], w[6], w[7]);
    }
    __syncthreads();
}

__device__ void phase_prep(const Params& p, char* smem, int bid, int nb) {
    const int tid = otid();
    const int gtid = bid * 256 + tid, gsz = nb * 256;
    char* ws = p.ws;
    {
        float* sc = (float*)smem;
        float* red = (float*)(smem + 32768);
        for (int i = tid; i < 8192; i += 256) { const float v = p.c[i]; sc[i] = v / (1.0f + __expf(-v)); }
        __syncthreads();
        float* mod = (float*)(ws + OFF_MOD);
        for (int item = bid; item < NL * 192; item += nb) {
            const int l = item / 192, n0 = (item % 192) * 32, nn = tid & 31, kq = tid >> 5;
            float acc[8];
#pragma unroll
            for (int b = 0; b < 8; ++b) acc[b] = 0.f;
            const float* W = p.mod_w + (size_t)l * 1024 * 6144 + n0 + nn;
#pragma nounroll
            for (int k0 = kq; k0 < 1024; k0 += 128) {
                float w[16];
#pragma unroll
                for (int u = 0; u < 16; ++u) w[u] = W[(size_t)(k0 + 8 * u) * 6144];
#pragma unroll
                for (int u = 0; u < 16; ++u)
#pragma unroll
                    for (int b = 0; b < 8; ++b) acc[b] += sc[b * 1024 + k0 + 8 * u] * w[u];
            }
#pragma unroll
            for (int b = 0; b < 8; ++b) red[(kq * 8 + b) * 32 + nn] = acc[b];
            __syncthreads();
            {
                const int b = tid >> 5;
                float s = 0.f;
#pragma unroll
                for (int q = 0; q < 8; ++q) s += red[(q * 8 + b) * 32 + nn];
                mod[((size_t)l * NB + b) * 6144 + n0 + nn] = s + p.mod_b[l * 6144 + n0 + nn];
            }
            __syncthreads();
        }
    }
    {
        float* tile = (float*)smem;
        for (int item = bid; item < NL * 1024; item += nb) {
            const int l = item / 1024, r = item % 1024;
            if (r < 256) {
                const int kt = r / 16, nt = r % 16;
                transpose_tile(p.w_in + (size_t)l * 1024 * 1536, 1536, kt * 64, nt * 64, (bf16_t*)(ws + OFF_W1T) + (size_t)l * 2048 * 1024, nt * 64, nullptr, tile);
            } else if (r < 512) {
                const int rr = r - 256, kt = rr / 16, nt = rr % 16;
                const float* gk = (kt < 8) ? (p.gain_a + l * 512) : (p.gain_b + l * 512 - 512);
                transpose_tile(p.w_out + (size_t)l * 1024 * 1024, 1024, kt * 64, nt * 64, (bf16_t*)(ws + OFF_W2T) + (size_t)l * 1024 * 1024, nt * 64, gk, tile);
            } else {
                const int rr = r - 512, kt = rr / 32, nt = rr % 32;
                transpose_tile(p.wq + (size_t)l * 1024 * 2048, 2048, kt * 64, nt * 64, (bf16_t*)(ws + OFF_WQT) + (size_t)l * 2048 * 1024, nt * 64, nullptr, tile);
            }
        }
    }
    {
        float* fws = (float*)smem;
        float* Ms  = (float*)(smem + 16384);
        float* wt  = (float*)(smem + 49152);
        float* cs  = (float*)(smem + 49152 + 16640);
        for (int item = bid; item < NL * 8 * 16; item += nb) {
            const int l = item / 128, g = (item % 128) / 16, kt = item % 16;
            if (tid < 64) { float s, c; sincospif((float)tid / 32.0f, &s, &c); cs[tid] = c; cs[64 + tid] = s; }
            for (int i = tid; i < 4096; i += 256) fws[i] = p.fnet_w[((size_t)l * 8 + g) * 4096 + i];
#pragma unroll
            for (int i = 0; i < 4; ++i) {
                const int r = (tid >> 4) + 16 * i, c4 = (tid & 15) * 4;
                const float4 v = *(const float4*)(p.w_in + (size_t)l * 1024 * 1536 + (size_t)(kt * 64 + r) * 1536 + 1024 + g * 64 + c4);
                wt[r * 65 + c4] = v.x; wt[r * 65 + c4 + 1] = v.y; wt[r * 65 + c4 + 2] = v.z; wt[r * 65 + c4 + 3] = v.w;
            }
            __syncthreads();
            {
                const int d = tid >> 2, r0 = (tid & 3) * 32;
                const bool im = r0 >= 64; const int e0 = r0 & 63;
                float acc[32];
#pragma unroll
                for (int e = 0; e < 32; ++e) acc[e] = 0.f;
                for (int j = 0; j < 64; ++j) {
                    const int ph = (d * j) & 63;
                    const float t = im ? -cs[64 + ph] : cs[ph];
#pragma unroll
                    for (int e = 0; e < 32; ++e) acc[e] += t * fws[j * 64 + e0 + e];
                }
#pragma unroll
                for (int e = 0; e < 32; ++e) Ms[d * 128 + r0 + e] = acc[e];
            }
            __syncthreads();
            {
                const int r = tid >> 1, kk0 = (tid & 1) * 32;
                float acc[32];
#pragma unroll
                for (int k = 0; k < 32; ++k) acc[k] = 0.f;
                for (int d = 0; d < 64; ++d) {
                    const float m = Ms[d * 128 + r];
#pragma unroll
                    for (int k = 0; k < 32; ++k) acc[k] += wt[(kk0 + k) * 65 + d] * m;
                }
                bf16_t* dst = (bf16_t*)(ws + OFF_W1T) + (size_t)l * 2048 * 1024 + (size_t)(1024 + g * 128 + r) * 1024 + kt * 64 + kk0;
#pragma unroll
                for (int q = 0; q < 4; ++q)
                    ((uint4*)dst)[q] = make_uint4(pk_bf16(acc[q * 8], acc[q * 8 + 1]), pk_bf16(acc[q * 8 + 2], acc[q * 8 + 3]), pk_bf16(acc[q * 8 + 4], acc[q * 8 + 5]), pk_bf16(acc[q * 8 + 6], acc[q * 8 + 7]));
            }
            __syncthreads();
        }
    }
    {
        bf16_t* k12 = (bf16_t*)(ws + OFF_K12);
        for (int i = gtid; i < NL * 8 * 256 * 128; i += gsz) {
            const int d = i & 127, n = (i >> 7) & 255, h = (i >> 15) & 7, l = i >> 18;
            const float* src = (n < 128) ? p.k1 : p.k2;
            k12[i] = f2bf(src[(((size_t)l * 8 + h) * 128 + (n & 127)) * 128 + d]);
        }
        bf16_t* wsb = (bf16_t*)(ws + OFF_WSB);
        for (int i = gtid; i < NL * 8 * 128 * 128; i += gsz) wsb[i] = f2bf(p.gmlp_ws[i]);
        bf16_t* DA = (bf16_t*)(ws + OFF_DA);
        for (int i = gtid; i < 128 * 128; i += gsz) {
            const int m = i >> 7, kk = i & 127, ro = m >> 6, k1 = m & 63, ri = kk >> 6, a = kk & 63;
            float s, c; sincospif((float)((a * k1) & 63) / 32.0f, &s, &c);
            const float v = (ro == ri) ? c : (ro == 0 ? s : -s);
            DA[i] = f2bf(v);
        }
        bf16_t* DB = (bf16_t*)(ws + OFF_DB);
        for (int i = gtid; i < 64 * 128; i += gsz) {
            const int k2 = i >> 7, kk = i & 127, ri = kk >> 6, b = kk & 63;
            float s, c; sincospif((float)((b * k2) & 63) / 32.0f, &s, &c);
            DB[i] = f2bf(ri ? s : c);
        }
        float2* tw = (float2*)(ws + OFF_TW);
        for (int i = gtid; i < 64 * 64; i += gsz) {
            const int bp = i >> 6, k1 = i & 63;
            float s, c; sincospif((float)(bp * k1) / 2048.0f, &s, &c);
            tw[i] = make_float2(c, s);
        }
        {
            const int lane = tid & 63, wv = gtid >> 6, nwv = gsz >> 6;
            const int R = 2 * NL * NE;
#pragma nounroll
            for (int r0 = wv; r0 < R; r0 += 2 * nwv) {
                float4 v[2][4];
#pragma unroll
                for (int t = 0; t < 2; ++t) {
                    const int r = (r0 + t * nwv < R) ? r0 + t * nwv : r0;
                    const int tbl = r / (NL * NE), row = r % (NL * NE);
                    const float* src = (tbl ? p.pv : p.pu) + (size_t)row * 1024 + lane * 16;
#pragma unroll
                    for (int i = 0; i < 4; ++i) v[t][i] = ((const float4*)src)[i];
                }
#pragma unroll
                for (int t = 0; t < 2; ++t) {
                    const int r = r0 + t * nwv;
                    if (r >= R) break;
                    const int tbl = r / (NL * NE), row = r % (NL * NE);
                    float m = 0.f;
#pragma unroll
                    for (int i = 0; i < 4; ++i) m = fmaxf(m, fmaxf(fmaxf(fabsf(v[t][i].x), fabsf(v[t][i].y)), fmaxf(fabsf(v[t][i].z), fabsf(v[t][i].w))));
#pragma unroll
                    for (int o = 32; o >= 1; o >>= 1) m = fmaxf(m, __shfl_xor(m, o));
                    const float sc = (m > 0.f) ? 256.0f / m : 1.0f, inv = (m > 0.f) ? m * (1.0f / 256.0f) : 1.0f;
                    int w[4];
#pragma unroll
                    for (int i = 0; i < 4; ++i) { w[i] = __builtin_amdgcn_cvt_pk_fp8_f32(v[t][i].x * sc, v[t][i].y * sc, 0, false); w[i] = __builtin_amdgcn_cvt_pk_fp8_f32(v[t][i].z * sc, v[t][i].w * sc, w[i], true); }
                    const int lyr = row / NE, ex = row % NE;
                    *(int4*)(ws + (tbl ? OFF_VB : OFF_UB) + ((size_t)(lyr * 8 + (lane >> 3)) * NE + ex) * 128 + (lane & 7) * 16) = make_int4(w[0], w[1], w[2], w[3]);
                    if (lane == 0) ((float*)(ws + (tbl ? OFF_VSC : OFF_USC)))[row] = inv;
                }
            }
        }
    }
}

template <bool SRC_BF16>
__device__ void phase_norm(const void* __restrict__ xsrc_, const float* __restrict__ g, const float* __restrict__ modl  , int sh_off, int scl_off,
                           bf16_t* __restrict__ hout, int bid, int nb) {
    const int tid_ = otid(); const int lane = tid_ & 63, wid = tid_ >> 6;
    for (int tok = bid * 4 + wid; tok < T; tok += nb * 4) {
        const int b = tok / SEQ;
        float4 v[4];
        float ss = 0.f;
#pragma unroll
        for (int i = 0; i < 4; ++i) {
            if (SRC_BF16) { const uint2 w = *(const uint2*)((const bf16_t*)xsrc_ + (size_t)tok * D + i * 256 + lane * 4); v[i] = make_float4(bf2f(w.x & 0xffffu), bf2f(w.x >> 16), bf2f(w.y & 0xffffu), bf2f(w.y >> 16)); }
            else v[i] = *(const float4*)((const float*)xsrc_ + (size_t)tok * D + i * 256 + lane * 4);
            ss += v[i].x * v[i].x + v[i].y * v[i].y + v[i].z * v[i].z + v[i].w * v[i].w;
        }
        ss = wave_sum(ss);
        const float rstd = rsqrtf(ss * (1.0f / D) + EPS);
        const float* mb = modl + (size_t)b * 6144;
#pragma unroll
        for (int i = 0; i < 4; ++i) {
            const int cidx = i * 256 + lane * 4;
            const float4 gg = *(const float4*)(g + cidx), sh = *(const float4*)(mb + sh_off + cidx), sc = *(const float4*)(mb + scl_off + cidx);
            const float o0 = v[i].x * rstd * gg.x * (1.0f + sc.x) + sh.x, o1 = v[i].y * rstd * gg.y * (1.0f + sc.y) + sh.y;
            const float o2 = v[i].z * rstd * gg.z * (1.0f + sc.z) + sh.z, o3 = v[i].w * rstd * gg.w * (1.0f + sc.w) + sh.w;
            *(uint2*)(hout + (size_t)tok * D + cidx) = make_uint2(pk_bf16(o0, o1), pk_bf16(o2, o3));
        }
    }
}

#define LAS __attribute__((address_space(3)))
template <class Epi, class MidK>
__device__ __forceinline__ void gemm_tile(const bf16_t* __restrict__ A, int lda, const bf16_t* __restrict__ Bt, int ldb, int K, int m0, int n0,
                                          char* smem, const Epi& epi, const MidK& midk, int kmid) {
    const int tid = otid(), lane = tid & 63, wid = tid >> 6, wr = wid >> 1, wc = wid & 1, fr = lane & 15, fq = lane >> 4;
    LAS char* lds = (LAS char*)smem;
    f32x4 acc[4][4];
#pragma unroll
    for (int i = 0; i < 4; ++i)
#pragma unroll
        for (int j = 0; j < 4; ++j) acc[i][j] = (f32x4){0.f, 0.f, 0.f, 0.f};
    const int prow = lane >> 3, pch = (lane & 7) ^ prow;
    const bf16_t* ga = A + (size_t)(m0 + wid * 32 + prow) * lda + pch * 8;
    const bf16_t* gb = Bt + (size_t)(n0 + wid * 32 + prow) * ldb + pch * 8;
    const int nk = K / 64;
#define GEMM_STAGE(kt_, buf_) do { _Pragma("unroll") for (int i_ = 0; i_ < 4; ++i_) { \
        __builtin_amdgcn_global_load_lds((const unsigned*)(ga + (size_t)(i_ * 8) * lda + (kt_) * 64), (LAS unsigned*)(lds + (buf_) * 16384 + (wid * 32 + i_ * 8) * 128), 16, 0, 0); \
        __builtin_amdgcn_global_load_lds((const unsigned*)(gb + (size_t)(i_ * 8) * ldb + (kt_) * 64), (LAS unsigned*)(lds + 32768 + (buf_) * 16384 + (wid * 32 + i_ * 8) * 128), 16, 0, 0); } } while (0)
    GEMM_STAGE(0, 0);
    const int swz = fr & 7;
    for (int kt = 0; kt < nk; ++kt) {
        const int cur = kt & 1;
        asm volatile("s_waitcnt vmcnt(0)" ::: "memory");
        __syncthreads();
        if (kt + 1 < nk) GEMM_STAGE(kt + 1, cur ^ 1);
        if (kt == kmid) {
#pragma unroll
            for (int i = 0; i < 4; ++i) { const float sc = midk(m0 + wr * 64 + i * 16 + fr);
#pragma unroll
                for (int j = 0; j < 4; ++j) acc[i][j] *= sc; }
        }
        const LAS char* ca = lds + cur * 16384; const LAS char* cb = lds + 32768 + cur * 16384;
#pragma unroll
        for (int ks = 0; ks < 2; ++ks) {
            bf16x8 af[4], bfr[4];
            const int coff = ((ks * 4 + fq) ^ swz) * 16;
#pragma unroll
            for (int i = 0; i < 4; ++i) af[i] = *(const LAS bf16x8*)(ca + (wr * 64 + i * 16 + fr) * 128 + coff);
#pragma unroll
            for (int j = 0; j < 4; ++j) bfr[j] = *(const LAS bf16x8*)(cb + (wc * 64 + j * 16 + fr) * 128 + coff);
#pragma unroll
            for (int i = 0; i < 4; ++i)
#pragma unroll
                for (int j = 0; j < 4; ++j) acc[i][j] = MFMA16(bfr[j], af[i], acc[i][j]);
        }
    }
#undef GEMM_STAGE
    __syncthreads();
    {
        LAS char* stg = lds + wid * 17408;
#pragma unroll
        for (int i = 0; i < 4; ++i)
#pragma unroll
            for (int j = 0; j < 4; ++j) *(LAS f32x4*)(stg + (i * 16 + fr) * 272 + (j * 16 + fq * 4) * 4) = acc[i][j];
        const int er = lane >> 3, ec = (lane & 7) * 8;
#pragma unroll
        for (int t = 0; t < 8; ++t) {
            const f32x4 v0 = *(const LAS f32x4*)(stg + (t * 8 + er) * 272 + ec * 4), v1 = *(const LAS f32x4*)(stg + (t * 8 + er) * 272 + ec * 4 + 16);
            epi(m0 + wr * 64 + t * 8 + er, n0 + wc * 64 + ec, v0, v1);
            __builtin_amdgcn_sched_barrier(0);
        }
    }
    __syncthreads();
}
template <class Epi, class MidK>
__device__ __forceinline__ void gemm_tile256(const bf16_t* __restrict__ A, int lda, const bf16_t* __restrict__ Bt, int ldb, int K, int m0, int n0,
                                             char* smem, const Epi& epi, const MidK& midk, int kmid) {
    const int tid = otid(), lane = tid & 63, wid = tid >> 6, wr = wid >> 1, wc = wid & 1, fr = lane & 15, fq = lane >> 4;
    LAS char* lds = (LAS char*)smem;
    f32x4 acc[8][4];
#pragma unroll
    for (int i = 0; i < 8; ++i)
#pragma unroll
        for (int j = 0; j < 4; ++j) acc[i][j] = (f32x4){0.f, 0.f, 0.f, 0.f};
    const int prow = lane >> 2, pch = (lane & 3) ^ (((lane >> 4) & 1) << 1);
    const bf16_t* ga = A + (size_t)(m0 + wid * 64 + prow) * lda + pch * 8;
    const bf16_t* gb = Bt + (size_t)(n0 + wid * 32 + prow) * ldb + pch * 8;
    const int nk = K / 32;
#define G256_STAGE(kt_, st_) do { \
        _Pragma("unroll") for (int i_ = 0; i_ < 4; ++i_) __builtin_amdgcn_global_load_lds((const unsigned*)(ga + (size_t)(i_ * 16) * lda + (kt_) * 32), (LAS unsigned*)(lds + (st_) * 24576 + (wid * 4 + i_) * 1024), 16, 0, 0); \
        _Pragma("unroll") for (int i_ = 0; i_ < 2; ++i_) __builtin_amdgcn_global_load_lds((const unsigned*)(gb + (size_t)(i_ * 16) * ldb + (kt_) * 32), (LAS unsigned*)(lds + (st_) * 24576 + 16384 + (wid * 2 + i_) * 1024), 16, 0, 0); } while (0)
    G256_STAGE(0, 0);
    const int coff = (fq ^ (((fr >> 2) & 1) << 1)) * 16;
    for (int kt = 0; kt < nk; ++kt) {
        const int cur = kt & 1;
        asm volatile("s_waitcnt vmcnt(0)" ::: "memory");
        __syncthreads();
        if (kt + 1 < nk) G256_STAGE(kt + 1, cur ^ 1);
        if (kt == kmid) {
#pragma unroll
            for (int i = 0; i < 8; ++i) { const float sc = midk(m0 + wr * 128 + i * 16 + fr);
#pragma unroll
                for (int j = 0; j < 4; ++j) acc[i][j] *= sc; }
        }
        const LAS char* ca = lds + cur * 24576 + coff; const LAS char* cb = ca + 16384;
        bf16x8 bfr[4];
#pragma unroll
        for (int j = 0; j < 4; ++j) bfr[j] = *(const LAS bf16x8*)(cb + (wc * 64 + j * 16 + fr) * 64);
#pragma unroll
        for (int ih = 0; ih < 2; ++ih) {
            bf16x8 af[4];
#pragma unroll
            for (int i = 0; i < 4; ++i) af[i] = *(const LAS bf16x8*)(ca + (wr * 128 + (ih * 4 + i) * 16 + fr) * 64);
#pragma unroll
            for (int i = 0; i < 4; ++i)
#pragma unroll
                for (int j = 0; j < 4; ++j) acc[ih * 4 + i][j] = MFMA16(bfr[j], af[i], acc[ih * 4 + i][j]);
        }
    }
#undef G256_STAGE
#pragma unroll
    for (int hb = 0; hb < 2; ++hb) {
        __syncthreads();
        LAS char* stg = lds + wid * 17408;
#pragma unroll
        for (int i = 0; i < 4; ++i)
#pragma unroll
            for (int j = 0; j < 4; ++j) *(LAS f32x4*)(stg + (i * 16 + fr) * 272 + (j * 16 + fq * 4) * 4) = acc[hb * 4 + i][j];
        const int er = lane >> 3, ec = (lane & 7) * 8;
#pragma unroll
        for (int t = 0; t < 8; ++t) {
            const f32x4 v0 = *(const LAS f32x4*)(stg + (t * 8 + er) * 272 + ec * 4), v1 = *(const LAS f32x4*)(stg + (t * 8 + er) * 272 + ec * 4 + 16);
            epi(m0 + wr * 128 + hb * 64 + t * 8 + er, n0 + wc * 64 + ec, v0, v1);
            __builtin_amdgcn_sched_barrier(0);
        }
    }
    __syncthreads();
}
__device__ __forceinline__ bool tile_of(int round, int bid, int nb, int MT, int NT, int& mt, int& nt) {
    if (nb == 512) {
        const int x = bid & 7, r = bid >> 3, st = x + 8 * round, snt = NT >> 3;
        if (st >= (MT >> 3) * snt) return false;
        mt = (st / snt) * 8 + (r >> 3); nt = (st % snt) * 8 + (r & 7);
        return true;
    }
    const int item = bid + round * nb;
    if (item >= MT * NT) return false;
    mt = item / NT; nt = item % NT;
    return true;
}
struct NoMid { __device__ __forceinline__ float operator()(int) const { return 1.0f; } };

__device__ void phase_gemm1(const Params& p, int l, char* smem, int bid, int nb) {
    const bf16_t* A = (const bf16_t*)(p.ws + OFF_H);
    const bf16_t* Bt = (const bf16_t*)(p.ws + OFF_W1T) + (size_t)l * 2048 * 1024;
    bf16_t* Z = (bf16_t*)(p.ws + OFF_Z);
    auto epi_gelu = [&](int row, int col, const f32x4& a, const f32x4& b) {
        *(uint4*)(Z + (size_t)row * NZ + col) = make_uint4(pk_bf16(gelu_f(a[0]), gelu_f(a[1])), pk_bf16(gelu_f(a[2]), gelu_f(a[3])), pk_bf16(gelu_f(b[0]), gelu_f(b[1])), pk_bf16(gelu_f(b[2]), gelu_f(b[3])));
    };
    auto epi_plain = [&](int row, int col, const f32x4& a, const f32x4& b) {
        *(uint4*)(Z + (size_t)row * NZ + col) = make_uint4(pk_bf16(a[0], a[1]), pk_bf16(a[2], a[3]), pk_bf16(b[0], b[1]), pk_bf16(b[2], b[3]));
    };
    const int NT = NZ / 128, MT = T / 256;
    int mt, nt;
    for (int round = 0; tile_of(round, bid, nb, MT, NT, mt, nt); ++round) {
        const int n0 = nt * 128;
        if (n0 < 1024) gemm_tile256(A, D, Bt, D, D, mt * 256, n0, smem, epi_gelu, NoMid(), -1);
        else           gemm_tile256(A, D, Bt, D, D, mt * 256, n0, smem, epi_plain, NoMid(), -1);
    }
}
__device__ void phase_gemm2(const Params& p, int l, char* smem, int bid, int nb) {
    const bf16_t* A = (const bf16_t*)(p.ws + OFF_Y);
    const bf16_t* Bt = (const bf16_t*)(p.ws + OFF_W2T) + (size_t)l * 1024 * 1024;
    const float* ssa = (const float*)(p.ws + OFF_SSQA); const float* ssb = (const float*)(p.ws + OFF_SSQB);
    const float* mod = (const float*)(p.ws + OFF_MOD) + (size_t)l * NB * 6144;
    bf16_t* XR = (bf16_t*)(p.ws + OFF_XR);
    auto rstd_of = [&](const float* s, int row) {
        const float4 a = *(const float4*)(s + (size_t)row * 8), b = *(const float4*)(s + (size_t)row * 8 + 4);
        return rsqrtf(((a.x + a.y) + (a.z + a.w) + (b.x + b.y) + (b.z + b.w)) * (1.0f / 512.0f) + EPS);
    };
    auto midk = [&](int row) { return rstd_of(ssa, row) / rstd_of(ssb, row); };
    auto epi = [&](int row, int col, const f32x4& a, const f32x4& c) {
        const float rb = rstd_of(ssb, row);
        const int b = row / SEQ;
        const float4 g0 = *(const float4*)(mod + (size_t)b * 6144 + 2 * D + col), g1 = *(const float4*)(mod + (size_t)b * 6144 + 2 * D + col + 4);
        float x[8];
        if (l == 0) { const float4 x0 = *(const float4*)(p.x + (size_t)row * D + col), x1 = *(const float4*)(p.x + (size_t)row * D + col + 4);
            x[0] = x0.x; x[1] = x0.y; x[2] = x0.z; x[3] = x0.w; x[4] = x1.x; x[5] = x1.y; x[6] = x1.z; x[7] = x1.w; }
        else { const uint4 w = *(const uint4*)(XR + (size_t)row * D + col);
            x[0] = bf2f(w.x & 0xffffu); x[1] = bf2f(w.x >> 16); x[2] = bf2f(w.y & 0xffffu); x[3] = bf2f(w.y >> 16); x[4] = bf2f(w.z & 0xffffu); x[5] = bf2f(w.z >> 16); x[6] = bf2f(w.w & 0xffffu); x[7] = bf2f(w.w >> 16); }
        *(uint4*)(XR + (size_t)row * D + col) = make_uint4(pk_bf16(x[0] + g0.x * rb * a[0], x[1] + g0.y * rb * a[1]), pk_bf16(x[2] + g0.z * rb * a[2], x[3] + g0.w * rb * a[3]),
                                                           pk_bf16(x[4] + g1.x * rb * c[0], x[5] + g1.y * rb * c[1]), pk_bf16(x[6] + g1.z * rb * c[2], x[7] + g1.w * rb * c[3]));
    };
    const int NT = D / 128, MT = T / 256;
    int mt, nt;
    for (int round = 0; tile_of(round, bid, nb, MT, NT, mt, nt); ++round) gemm_tile256(A, D, Bt, D, D, mt * 256, nt * 128, smem, epi, midk, 16);
}
__device__ void phase_gemm3(const Params& p, int l, char* smem, int bid, int nb) {
    const bf16_t* A = (const bf16_t*)(p.ws + OFF_H);
    const bf16_t* Bt = (const bf16_t*)(p.ws + OFF_WQT) + (size_t)l * 2048 * 1024;
    bf16_t* Q = (bf16_t*)(p.ws + OFF_Z);
    auto epi = [&](int row, int col, const f32x4& a, const f32x4& b) { *(uint4*)(Q + (size_t)row * 2048 + col) = make_uint4(pk_bf16(a[0], a[1]), pk_bf16(a[2], a[3]), pk_bf16(b[0], b[1]), pk_bf16(b[2], b[3])); };
    const int NT = 2048 / 128, MT = T / 256;
    int mt, nt;
    for (int round = 0; tile_of(round, bid, nb, MT, NT, mt, nt); ++round) gemm_tile256(A, D, Bt, D, D, mt * 256, nt * 128, smem, epi, NoMid(), -1);
}

constexpr int TP = 136;
__device__ __forceinline__ void stage_transposed(const bf16_t* __restrict__ base, size_t row_stride, bf16_t* dT) {
    const int tid = otid(), r = tid >> 2, part = tid & 3, ri = part >> 1, c0 = (part & 1) * 32;
    const uint4* src = (const uint4*)(base + (size_t)r * row_stride + ri * 64 + c0);
    uint4 v[4];
#pragma unroll
    for (int i = 0; i < 4; ++i) v[i] = src[i];
#pragma unroll
    for (int i = 0; i < 4; ++i) {
        const unsigned w[4] = {v[i].x, v[i].y, v[i].z, v[i].w};
#pragma unroll
        for (int j = 0; j < 4; ++j) {
            dT[(c0 + i * 8 + j * 2) * TP + ri * 64 + r] = (bf16_t)(w[j] & 0xffffu);
            dT[(c0 + i * 8 + j * 2 + 1) * TP + ri * 64 + r] = (bf16_t)(w[j] >> 16);
        }
    }
}

__device__ void gmlp_item(const Params& p, int l, int item, char* smem) {
    const int tid = otid(), lane = tid & 63, wid = tid >> 6, fr = lane & 15, fq = lane >> 4;
    const int h = item & 7, c = (item >> 3) & 31, b = item >> 8;
    const int tok0 = b * SEQ + c * 128;
    bf16_t* vnT = (bf16_t*)smem;
    const bf16_t* Z = (const bf16_t*)(p.ws + OFF_Z);
    {
        const int q = tid >> 1, half = tid & 1, d0 = half * 32;
        const uint4* src = (const uint4*)(Z + (size_t)(tok0 + q) * NZ + 512 + h * 64 + d0);
        float f[32];
#pragma unroll
        for (int i = 0; i < 4; ++i) { const uint4 v = src[i]; const unsigned w[4] = {v.x, v.y, v.z, v.w};
#pragma unroll
            for (int j = 0; j < 4; ++j) { f[i * 8 + j * 2] = bf2f(w[j] & 0xffffu); f[i * 8 + j * 2 + 1] = bf2f(w[j] >> 16); } }
        float s = 0.f;
#pragma unroll
        for (int i = 0; i < 32; ++i) s += f[i];
        s += __shfl_xor(s, 1);
        const float mean = s * (1.0f / 64.0f);
        float qv = 0.f;
#pragma unroll
        for (int i = 0; i < 32; ++i) { f[i] -= mean; qv += f[i] * f[i]; }
        qv += __shfl_xor(qv, 1);
        const float rstd = rsqrtf(qv * (1.0f / 64.0f) + EPS);
#pragma unroll
        for (int i = 0; i < 32; ++i) vnT[(d0 + i) * TP + q] = f2bf(f[i] * rstd);
    }
    __syncthreads();
    const bf16_t* Wsb = (const bf16_t*)(p.ws + OFF_WSB) + ((size_t)l * 8 + h) * 128 * 128;
    f32x4 acc[2][4];
#pragma unroll
    for (int i = 0; i < 2; ++i)
#pragma unroll
        for (int j = 0; j < 4; ++j) acc[i][j] = (f32x4){0.f, 0.f, 0.f, 0.f};
    const int p0 = wid * 32;
#pragma unroll
    for (int ks = 0; ks < 4; ++ks) {
        bf16x8 af[2], bfr[4];
#pragma unroll
        for (int i = 0; i < 2; ++i) af[i] = *(const bf16x8*)(Wsb + (size_t)(p0 + i * 16 + fr) * 128 + ks * 32 + fq * 8);
#pragma unroll
        for (int j = 0; j < 4; ++j) bfr[j] = *(const bf16x8*)(vnT + (j * 16 + fr) * TP + ks * 32 + fq * 8);
#pragma unroll
        for (int i = 0; i < 2; ++i)
#pragma unroll
            for (int j = 0; j < 4; ++j) acc[i][j] = MFMA16(bfr[j], af[i], acc[i][j]);
    }
    bf16_t* Y = (bf16_t*)(p.ws + OFF_Y);
    float* ssa = (float*)(p.ws + OFF_SSQA);
#pragma unroll
    for (int i = 0; i < 2; ++i) {
        const int pp = p0 + i * 16 + fr, tok = tok0 + pp;
        const float bsv = p.gmlp_bs[((size_t)l * 8 + h) * 128 + pp];
        float ss = 0.f;
#pragma unroll
        for (int j = 0; j < 4; ++j) {
            const int d = j * 16 + fq * 4;
            const uint2 uu = *(const uint2*)(Z + (size_t)tok * NZ + h * 64 + d);
            const float y0 = bf2f(uu.x & 0xffffu) * (acc[i][j][0] + bsv), y1 = bf2f(uu.x >> 16) * (acc[i][j][1] + bsv);
            const float y2 = bf2f(uu.y & 0xffffu) * (acc[i][j][2] + bsv), y3 = bf2f(uu.y >> 16) * (acc[i][j][3] + bsv);
            ss += y0 * y0 + y1 * y1 + y2 * y2 + y3 * y3;
            *(uint2*)(Y + (size_t)tok * D + h * 64 + d) = make_uint2(pk_bf16(y0, y1), pk_bf16(y2, y3));
        }
        ss += __shfl_xor(ss, 16); ss += __shfl_xor(ss, 32);
        if (fq == 0) ssa[(size_t)tok * 8 + h] = ss;
    }
    __syncthreads();
}

__device__ void ffta_item(const Params& p, int item, char* smem) {
    const int tid = otid(), lane = tid & 63, wid = tid >> 6, fr = lane & 15, fq = lane >> 4;
    const int bp = item & 63, g = (item >> 6) & 7, b = item >> 9;
    bf16_t* dT = (bf16_t*)smem;
    const bf16_t* Z = (const bf16_t*)(p.ws + OFF_Z);
    stage_transposed(Z + (size_t)(b * SEQ + bp) * NZ + 1024 + g * 128, (size_t)64 * NZ, dT);
    __syncthreads();
    const bf16_t* DA = (const bf16_t*)(p.ws + OFF_DA);
    f32x4 acc[2][4];
#pragma unroll
    for (int i = 0; i < 2; ++i)
#pragma unroll
        for (int j = 0; j < 4; ++j) acc[i][j] = (f32x4){0.f, 0.f, 0.f, 0.f};
#pragma unroll
    for (int ks = 0; ks < 4; ++ks) {
        bf16x8 af[2], bfr[4];
#pragma unroll
        for (int i = 0; i < 2; ++i) af[i] = *(const bf16x8*)(DA + (size_t)(i * 64 + wid * 16 + fr) * 128 + ks * 32 + fq * 8);
#pragma unroll
        for (int j = 0; j < 4; ++j) bfr[j] = *(const bf16x8*)(dT + (j * 16 + fr) * TP + ks * 32 + fq * 8);
#pragma unroll
        for (int i = 0; i < 2; ++i)
#pragma unroll
            for (int j = 0; j < 4; ++j) acc[i][j] = MFMA16(bfr[j], af[i], acc[i][j]);
    }
    const int k1 = wid * 16 + fr;
    const float2 cs = ((const float2*)(p.ws + OFF_TW))[bp * 64 + k1];
    bf16_t* Yb = (bf16_t*)(p.ws + OFF_H) + ((((size_t)(b * 8 + g) * 64 + k1) * 64 + bp) * 128);
#pragma unroll
    for (int j = 0; j < 4; ++j) {
        const int ch = j * 16 + fq * 4;
        float yr[4], yi[4];
#pragma unroll
        for (int e = 0; e < 4; ++e) { const float r = acc[0][j][e], im = acc[1][j][e]; yr[e] = r * cs.x + im * cs.y; yi[e] = im * cs.x - r * cs.y; }
        *(uint2*)(Yb + ch) = make_uint2(pk_bf16(yr[0], yr[1]), pk_bf16(yr[2], yr[3]));
        *(uint2*)(Yb + 64 + ch) = make_uint2(pk_bf16(yi[0], yi[1]), pk_bf16(yi[2], yi[3]));
    }
    __syncthreads();
}

__device__ void phase_mix(const Params& p, int l, char* smem, int bid, int nb) {
    for (int item = bid; item < 2048 + 4096; item += nb) {
        if (item < 2048) gmlp_item(p, l, item, smem); else ffta_item(p, item - 2048, smem);
    }
}

__device__ void phase_fftb(const Params& p, int l, char* smem, int bid, int nb) {
    const int tid = otid(), lane = tid & 63, wid = tid >> 6, fr = lane & 15, fq = lane >> 4;
    bf16_t* dT = (bf16_t*)smem;
    const bf16_t* DB = (const bf16_t*)(p.ws + OFF_DB);
    bf16_t* Y = (bf16_t*)(p.ws + OFF_Y);
    float* ssb = (float*)(p.ws + OFF_SSQB);
    for (int item = bid; item < 4096; item += nb) {
        const int k1 = item & 63, g = (item >> 6) & 7, b = item >> 9;
        stage_transposed((const bf16_t*)(p.ws + OFF_H) + (((size_t)(b * 8 + g) * 64 + k1) * 64) * 128, 128, dT);
        __syncthreads();
        f32x4 acc[4];
#pragma unroll
        for (int j = 0; j < 4; ++j) acc[j] = (f32x4){0.f, 0.f, 0.f, 0.f};
#pragma unroll
        for (int ks = 0; ks < 4; ++ks) {
            const bf16x8 af = *(const bf16x8*)(DB + (size_t)(wid * 16 + fr) * 128 + ks * 32 + fq * 8);
#pragma unroll
            for (int j = 0; j < 4; ++j) { const bf16x8 bfr = *(const bf16x8*)(dT + (j * 16 + fr) * TP + ks * 32 + fq * 8); acc[j] = MFMA16(bfr, af, acc[j]); }
        }
        const int k2 = wid * 16 + fr, tok = b * SEQ + k1 + 64 * k2;
        float ss = 0.f;
#pragma unroll
        for (int j = 0; j < 4; ++j) {
            const int ch = j * 16 + fq * 4;
            const float4 fb = *(const float4*)(p.fnet_b + ((size_t)l * 8 + g) * 64 + ch);
            const float y0 = acc[j][0] * (1.0f / 512.0f) + fb.x, y1 = acc[j][1] * (1.0f / 512.0f) + fb.y, y2 = acc[j][2] * (1.0f / 512.0f) + fb.z, y3 = acc[j][3] * (1.0f / 512.0f) + fb.w;
            ss += y0 * y0 + y1 * y1 + y2 * y2 + y3 * y3;
            *(uint2*)(Y + (size_t)tok * D + 512 + g * 64 + ch) = make_uint2(pk_bf16(y0, y1), pk_bf16(y2, y3));
        }
        ss += __shfl_xor(ss, 16); ss += __shfl_xor(ss, 32);
        if (fq == 0) ssb[(size_t)tok * 8 + g] = ss;
        __syncthreads();
    }
}

#define INS16(a, v) do { a[15] = med3i(a[14], a[15], v); a[14] = med3i(a[13], a[14], v); a[13] = med3i(a[12], a[13], v); a[12] = med3i(a[11], a[12], v); \
    a[11] = med3i(a[10], a[11], v); a[10] = med3i(a[9], a[10], v); a[9] = med3i(a[8], a[9], v); a[8] = med3i(a[7], a[8], v); a[7] = med3i(a[6], a[7], v); \
    a[6] = med3i(a[5], a[6], v); a[5] = med3i(a[4], a[5], v); a[4] = med3i(a[3], a[4], v); a[3] = med3i(a[2], a[3], v); a[2] = med3i(a[1], a[2], v); \
    a[1] = med3i(a[0], a[1], v); a[0] = max(a[0], v); } while (0)

template <int I, int J> struct CandLoop {
    static __device__ __forceinline__ void run(int (&a)[16], const float (&f1)[16], const float (&f2)[16]) {
        if constexpr ((I + 1) * (J + 1) <= 16) { const int key = (f2key(f1[I] + f2[J]) & ~255) | (I * 16 + J); INS16(a, key); }
        if constexpr (J + 1 < 16) CandLoop<I, J + 1>::run(a, f1, f2);
        else if constexpr (I + 1 < 16) CandLoop<I + 1, 0>::run(a, f1, f2);
    }
};

typedef _Float16 f16x2_t __attribute__((ext_vector_type(2)));
__device__ __forceinline__ unsigned pk_f16(float lo, float hi) { const f16x2_t v = {(_Float16)lo, (_Float16)hi}; return __builtin_bit_cast(unsigned, v); }
__device__ __forceinline__ int h2key(unsigned bits16) { const int b = (int)(short)bits16; return b ^ ((b >> 15) & 0x7fff); }
__device__ __forceinline__ float key2h(int k) { const int b = k ^ ((k >> 15) & 0x7fff); return (float)__builtin_bit_cast(_Float16, (unsigned short)(b & 0xffff)); }

__device__ void phase_topk(const Params& p, int l, char* smem, int bid, int nb) {
    const int tid = otid(), lane = tid & 63, wid = tid >> 6, fr = lane & 15, fq = lane >> 4;
    unsigned* S32 = (unsigned*)smem;
    int* TT = (int*)smem;
    const bf16_t* Q = (const bf16_t*)(p.ws + OFF_Z);
    int* eidx = (int*)(p.ws + OFF_Y); float* gw = (float*)(p.ws + OFF_Y + (size_t)T * 128 * 4);
    const int hh = wid >> 1, half = wid & 1;
    for (int item = bid; item < (T / 64) * 4; item += nb) {
        const int hp = item & 3, tok0 = (item >> 2) * 64, h = hp * 2 + hh;
        const bf16_t* Kh = (const bf16_t*)(p.ws + OFF_K12) + (((size_t)l * 8 + h) * 256 + half * 128) * 128;
        const bf16_t* Qh = Q + (size_t)tok0 * 2048 + h * 256 + half * 128;
        {
            f32x4 acc[4][8];
#pragma unroll
            for (int i = 0; i < 4; ++i)
#pragma unroll
                for (int j = 0; j < 8; ++j) acc[i][j] = (f32x4){0.f, 0.f, 0.f, 0.f};
#pragma unroll
            for (int ks = 0; ks < 4; ++ks) {
                bf16x8 af[4];
#pragma unroll
                for (int i = 0; i < 4; ++i) af[i] = *(const bf16x8*)(Qh + (size_t)(i * 16 + fr) * 2048 + ks * 32 + fq * 8);
#pragma unroll
                for (int jh = 0; jh < 2; ++jh) {
                    bf16x8 bfr[4];
#pragma unroll
                    for (int j = 0; j < 4; ++j) bfr[j] = *(const bf16x8*)(Kh + (size_t)((jh * 4 + j) * 16 + fr) * 128 + ks * 32 + fq * 8);
#pragma unroll
                    for (int i = 0; i < 4; ++i)
#pragma unroll
                        for (int j = 0; j < 4; ++j) acc[i][jh * 4 + j] = MFMA16(bfr[j], af[i], acc[i][jh * 4 + j]);
                    __builtin_amdgcn_sched_barrier(0);
                }
            }
#pragma unroll
            for (int i = 0; i < 4; ++i)
#pragma unroll
                for (int j = 0; j < 8; ++j) {
                    unsigned* d = S32 + (i * 16 + fr) * 257 + hh * 128 + half * 64 + j * 8 + fq * 2;
                    d[0] = pk_f16(acc[i][j][0], acc[i][j][1]); d[1] = pk_f16(acc[i][j][2], acc[i][j][3]);
                }
        }
        __syncthreads();
        int a[16];
#pragma unroll
        for (int i = 0; i < 16; ++i) a[i] = (int)0x80000000;
        {
            const unsigned* sr = S32 + lane * 257 + hh * 128 + half * 64;
#pragma unroll 2
            for (int i = 0; i < 64; ++i) {
                const unsigned w = sr[i];
                const int k0 = (h2key(w & 0xffffu) << 7) | (2 * i), k1 = (h2key(w >> 16) << 7) | (2 * i + 1);
                INS16(a, k0); INS16(a, k1);
            }
        }
        __syncthreads();
#pragma unroll
        for (int i = 0; i < 16; ++i) TT[((lane * 2 + hh) * 2 + half) * 16 + i] = a[i];
        __syncthreads();
        if (tid < 128) {
            const int tk = tid & 63, h2 = tid >> 6, hd = hp * 2 + h2;
            const int* t1 = TT + ((tk * 2 + h2) * 2) * 16; const int* t2 = t1 + 16;
            float f1[16], f2[16];
#pragma unroll
            for (int i = 0; i < 16; ++i) { f1[i] = key2h(t1[i] >> 7); f2[i] = key2h(t2[i] >> 7); }
            int c[16];
#pragma unroll
            for (int i = 0; i < 16; ++i) c[i] = (int)0x80000000;
            CandLoop<0, 0>::run(c, f1, f2);
            float sc[16], e[16], sum = 0.f; int ex[16];
#pragma unroll
            for (int i = 0; i < 16; ++i) {
                sc[i] = key2f(c[i] & ~255);
                const int code = c[i] & 255;
                ex[i] = (t1[code >> 4] & 127) * 128 + (t2[code & 15] & 127);
            }
#pragma unroll
            for (int i = 0; i < 16; ++i) { e[i] = __expf(sc[i] - sc[0]); sum += e[i]; }
            const float inv = 1.0f / sum;
            int4* ep = (int4*)(eidx + (size_t)(tok0 + tk) * 128 + hd * 16); float4* gp = (float4*)(gw + (size_t)(tok0 + tk) * 128 + hd * 16);
#pragma unroll
            for (int i = 0; i < 4; ++i) { ep[i] = make_int4(ex[4 * i], ex[4 * i + 1], ex[4 * i + 2], ex[4 * i + 3]); gp[i] = make_float4(e[4 * i] * inv, e[4 * i + 1] * inv, e[4 * i + 2] * inv, e[4 * i + 3] * inv); }
        }
        __syncthreads();
    }
}

__device__ __forceinline__ float dot16_fp8(const float (&h)[16], const int4& u) {
    const int w[4] = {u.x, u.y, u.z, u.w};
    f32x2_t a = {0.f, 0.f};
#pragma unroll
    for (int i = 0; i < 4; ++i) {
        const f32x2_t lo = __builtin_amdgcn_cvt_pk_f32_fp8(w[i], false), hi = __builtin_amdgcn_cvt_pk_f32_fp8(w[i], true);
        const f32x2_t h0 = {h[4 * i], h[4 * i + 1]}, h1 = {h[4 * i + 2], h[4 * i + 3]};
        a = __builtin_elementwise_fma(lo, h0, a); a = __builtin_elementwise_fma(hi, h1, a);
    }
    return a.x + a.y;
}
__device__ __forceinline__ void axpy16_fp8(float (&o)[16], float c, const int4& v) {
    const int w[4] = {v.x, v.y, v.z, v.w};
#pragma unroll
    for (int i = 0; i < 4; ++i) {
        const f32x2_t lo = __builtin_amdgcn_cvt_pk_f32_fp8(w[i], false), hi = __builtin_amdgcn_cvt_pk_f32_fp8(w[i], true);
        o[4 * i] += c * lo.x; o[4 * i + 1] += c * lo.y; o[4 * i + 2] += c * hi.x; o[4 * i + 3] += c * hi.y;
    }
}

__device__ void phase_pu(const Params& p, int l, int slice, int grank, int gsz) {
    const int tid_ = otid(); const int lane = tid_ & 63, wid = tid_ >> 6, sub = lane & 7, pg = lane >> 3;
    const bf16_t* H = (const bf16_t*)(p.ws + OFF_H) + slice * 128 + sub * 16;
    const char* U8 = p.ws + OFF_UB + ((size_t)(l * 8 + slice) * NE) * 128 + sub * 16;
    const int* eidx = (const int*)(p.ws + OFF_Y) + lane;
    float* part = (float*)(p.ws + OFF_Z) + (size_t)slice * T * 128 + 16 * sub + pg;
    const int stride = gsz * 4;
#define PU_ISSUE(e_, u_) do { _Pragma("unroll") for (int q = 0; q < 8; ++q) { const int ej = __shfl(e_, 8 * q + pg); u_[q] = *(const int4*)(U8 + (size_t)ej * 128); } } while (0)
    int tok = grank * 4 + wid;
    if (tok >= T) return;
    int4 uA[8], uB[8];
    int ea = eidx[(size_t)tok * 128], eb = eidx[(size_t)tok * 128 + 64];
    uint4 h0 = *(const uint4*)(H + (size_t)tok * D), h1 = *(const uint4*)(H + (size_t)tok * D + 8);
    PU_ISSUE(ea, uA);
#pragma nounroll
    for (;;) {
        __builtin_amdgcn_sched_barrier(0);
        const int tokn = tok + stride; const bool more = tokn < T;
        int ean = 0, ebn = 0; uint4 h0n = h0, h1n = h1;
        if (more) { ean = eidx[(size_t)tokn * 128]; ebn = eidx[(size_t)tokn * 128 + 64]; h0n = *(const uint4*)(H + (size_t)tokn * D); h1n = *(const uint4*)(H + (size_t)tokn * D + 8); }
        PU_ISSUE(eb, uB);
        __builtin_amdgcn_sched_barrier(0);
        float hf[16];
        { const unsigned w_[8] = {h0.x, h0.y, h0.z, h0.w, h1.x, h1.y, h1.z, h1.w};
#pragma unroll
          for (int i = 0; i < 8; ++i) { hf[2 * i] = bf2f(w_[i] & 0xffffu); hf[2 * i + 1] = bf2f(w_[i] >> 16); } }
        float v[16];
#pragma unroll
        for (int q = 0; q < 8; ++q) v[q] = dot16_fp8(hf, uA[q]);
        __builtin_amdgcn_sched_barrier(0);
        if (more) PU_ISSUE(ean, uA);
        __builtin_amdgcn_sched_barrier(0);
#pragma unroll
        for (int q = 0; q < 8; ++q) v[8 + q] = dot16_fp8(hf, uB[q]);
        float w8[8], w4[4], w2[2];
        { const bool hi = (lane & 4) != 0;
#pragma unroll
          for (int m = 0; m < 8; ++m) { const float send = hi ? v[m] : v[m + 8], keep = hi ? v[m + 8] : v[m]; w8[m] = keep + __shfl_xor(send, 4); } }
        { const bool hi = (lane & 2) != 0;
#pragma unroll
          for (int m = 0; m < 4; ++m) { const float send = hi ? w8[m] : w8[m + 4], keep = hi ? w8[m + 4] : w8[m]; w4[m] = keep + __shfl_xor(send, 2); } }
        { const bool hi = (lane & 1) != 0;
#pragma unroll
          for (int m = 0; m < 2; ++m) { const float send = hi ? w4[m] : w4[m + 2], keep = hi ? w4[m + 2] : w4[m]; w2[m] = keep + __shfl_xor(send, 1); } }
        float* pr = part + (size_t)tok * 128;
        pr[0] = w2[0]; pr[8] = w2[1];
        if (!more) break;
        tok = tokn; ea = ean; eb = ebn; h0 = h0n; h1 = h1n;
    }
#undef PU_ISSUE
}
__device__ void phase_pc(const Params& p, int l, int bid, int nb) {
    const int tid_ = otid(); const int lane = tid_ & 63, wid = tid_ >> 6;
    const int* eidx = (const int*)(p.ws + OFF_Y); const float* gw = (const float*)(p.ws + OFF_Y + (size_t)T * 128 * 4);
    float* coef = (float*)(p.ws + OFF_Y + (size_t)T * 128 * 8);
    const float* part = (const float*)(p.ws + OFF_Z);
    const float* usc = (const float*)(p.ws + OFF_USC) + (size_t)l * NE; const float* vsc = (const float*)(p.ws + OFF_VSC) + (size_t)l * NE;
    for (int tok = bid * 4 + wid; tok < T; tok += nb * 4) {
#pragma unroll
        for (int hh = 0; hh < 2; ++hh) {
            const size_t j = (size_t)tok * 128 + hh * 64 + lane;
            const int e = eidx[j]; const float g = gw[j];
            float a = 0.f;
#pragma unroll
            for (int sl = 0; sl < 8; ++sl) a += part[(size_t)sl * T * 128 + j];
            coef[j] = g * gelu_f(a * usc[e]) * vsc[e];
        }
    }
}
__device__ void phase_pv(const Params& p, int l, int slice, int grank, int gsz) {
    const int tid_ = otid(); const int lane = tid_ & 63, wid = tid_ >> 6, sub = lane & 7, pg = lane >> 3;
    const char* V8 = p.ws + OFF_VB + ((size_t)(l * 8 + slice) * NE) * 128 + sub * 16;
    const int* eidx = (const int*)(p.ws + OFF_Y) + lane;
    const float* coef = (const float*)(p.ws + OFF_Y + (size_t)T * 128 * 8) + lane;
    const int col = slice * 128 + 16 * sub + 2 * pg;
    const float* g2p = (const float*)(p.ws + OFF_MOD) + (size_t)l * NB * 6144 + 5 * D + col;
    bf16_t* xcol = (bf16_t*)(p.ws + OFF_XR) + col;
    const int stride = gsz * 4;
#define PV_ISSUE(e_, c_, v_, cj_) do { _Pragma("unroll") for (int q = 0; q < 8; ++q) { const int ej = __shfl(e_, 8 * q + pg); cj_[q] = __shfl(c_, 8 * q + pg); v_[q] = *(const int4*)(V8 + (size_t)ej * 128); } } while (0)
    int tok = grank * 4 + wid;
    if (tok >= T) return;
    int4 vA[8], vB[8]; float cA[8], cB[8];
    int ea = eidx[(size_t)tok * 128], eb = eidx[(size_t)tok * 128 + 64];
    float ca = coef[(size_t)tok * 128], cb = coef[(size_t)tok * 128 + 64];
    PV_ISSUE(ea, ca, vA, cA);
#pragma nounroll
    for (;;) {
        __builtin_amdgcn_sched_barrier(0);
        const int tokn = tok + stride; const bool more = tokn < T;
        int ean = 0, ebn = 0; float can = 0.f, cbn = 0.f;
        if (more) { ean = eidx[(size_t)tokn * 128]; ebn = eidx[(size_t)tokn * 128 + 64]; can = coef[(size_t)tokn * 128]; cbn = coef[(size_t)tokn * 128 + 64]; }
        unsigned* xp = (unsigned*)(xcol + (size_t)tok * D); const float2 g2 = *(const float2*)(g2p + (size_t)(tok / SEQ) * 6144);
        const unsigned xw = *xp;
        PV_ISSUE(eb, cb, vB, cB);
        __builtin_amdgcn_sched_barrier(0);
        float o[16];
#pragma unroll
        for (int i = 0; i < 16; ++i) o[i] = 0.f;
#pragma unroll
        for (int q = 0; q < 8; ++q) axpy16_fp8(o, cA[q], vA[q]);
        __builtin_amdgcn_sched_barrier(0);
        if (more) PV_ISSUE(ean, can, vA, cA);
        __builtin_amdgcn_sched_barrier(0);
#pragma unroll
        for (int q = 0; q < 8; ++q) axpy16_fp8(o, cB[q], vB[q]);
        float t8[8], t4[4], t2[2];
        { const bool hi = (lane & 32) != 0;
#pragma unroll
          for (int m = 0; m < 8; ++m) { const float send = hi ? o[m] : o[m + 8], keep = hi ? o[m + 8] : o[m]; t8[m] = keep + __shfl_xor(send, 32); } }
        { const bool hi = (lane & 16) != 0;
#pragma unroll
          for (int m = 0; m < 4; ++m) { const float send = hi ? t8[m] : t8[m + 4], keep = hi ? t8[m + 4] : t8[m]; t4[m] = keep + __shfl_xor(send, 16); } }
        { const bool hi = (lane & 8) != 0;
#pragma unroll
          for (int m = 0; m < 2; ++m) { const float send = hi ? t4[m] : t4[m + 2], keep = hi ? t4[m + 2] : t4[m]; t2[m] = keep + __shfl_xor(send, 8); } }
        *xp = pk_bf16(bf2f(xw & 0xffffu) + g2.x * t2[0], bf2f(xw >> 16) + g2.y * t2[1]);
        if (!more) break;
        tok = tokn; ea = ean; eb = ebn; ca = can; cb = cbn;
    }
#undef PV_ISSUE
}
__device__ void phase_final_norm(const Params& p, int bid, int nb) {
    const int tid_ = otid(); const int lane = tid_ & 63, wid = tid_ >> 6;
    for (int tok = bid * 4 + wid; tok < T; tok += nb * 4) {
        float* xr = p.out + (size_t)tok * D;
        const bf16_t* xs = (const bf16_t*)(p.ws + OFF_XR) + (size_t)tok * D;
        float4 v[4]; float ss = 0.f;
#pragma unroll
        for (int i = 0; i < 4; ++i) { const uint2 w = *(const uint2*)(xs + i * 256 + lane * 4); v[i] = make_float4(bf2f(w.x & 0xffffu), bf2f(w.x >> 16), bf2f(w.y & 0xffffu), bf2f(w.y >> 16));
            ss += v[i].x * v[i].x + v[i].y * v[i].y + v[i].z * v[i].z + v[i].w * v[i].w; }
        ss = wave_sum(ss);
        const float rstd = rsqrtf(ss * (1.0f / D) + EPS);
#pragma unroll
        for (int i = 0; i < 4; ++i) { const float4 g = *(const float4*)(p.final_g + i * 256 + lane * 4);
            *(float4*)(xr + i * 256 + lane * 4) = make_float4(v[i].x * rstd * g.x, v[i].y * rstd * g.y, v[i].z * rstd * g.z, v[i].w * rstd * g.w); }
    }
}

#define XB_TMO      128
#define XB_XCNT(j)  (256  + 64 * (j))
#define XB_XSUB(j)  (1280 + 64 * (j))
#define XB_XGEN(j)  (2304 + 64 * (j))
#define XB_TOP      3328
#define XB_TOPGEN   3392
#define XCD_BAR_WORDS 3456
#define XB_SPIN_CAP (1u << 22)
__device__ __forceinline__ unsigned xb_ld(unsigned* p)              { return __hip_atomic_load(p, __ATOMIC_RELAXED, __HIP_MEMORY_SCOPE_AGENT); }
__device__ __forceinline__ unsigned xb_add(unsigned* p, unsigned v) { return __hip_atomic_fetch_add(p, v, __ATOMIC_RELAXED, __HIP_MEMORY_SCOPE_AGENT); }
__device__ __forceinline__ unsigned xb_xcc_id() { return (unsigned)__builtin_amdgcn_s_getreg((3 << 11) | 20) & 0xFu; }
#define XB_SPIN(cond, bar) do { unsigned _sp = 0; while (cond) { __builtin_amdgcn_s_sleep(1); \
    if ((++_sp & 255u) == 0u) { if (xb_ld(&(bar)[XB_TMO])) break; if (_sp > XB_SPIN_CAP) { atomicAdd(&(bar)[XB_TMO], 1u); break; } } } } while (0)
__device__ __forceinline__ void xcd_barrier_post(unsigned* bar, volatile LAS unsigned* st) {
    if (threadIdx.x == 0) { const unsigned x = xb_xcc_id(); st[3] = x; st[2] = xb_add(&bar[XB_XCNT(x)], 1u); }
}
__device__ __forceinline__ void xcd_barrier_complete(unsigned* bar, unsigned x, unsigned& nloc, unsigned& nx) {
    const unsigned G = gridDim.x * gridDim.y * gridDim.z;
    unsigned sum, cnt, mine, sp = 0u;
    for (;;) {
        sum = 0u; cnt = 0u; mine = 0u;
#pragma unroll
        for (unsigned j = 0; j < 16; ++j) { const unsigned c = xb_ld(&bar[XB_XCNT(j)]); sum += c; cnt += (c > 0u) ? 1u : 0u; mine = (j == x) ? c : mine; }
        if (sum == G) break;
        __builtin_amdgcn_s_sleep(1);
        if ((++sp & 255u) == 0u) { if (xb_ld(&bar[XB_TMO])) break; if (sp > XB_SPIN_CAP) { atomicAdd(&bar[XB_TMO], 1u); break; } }
    }
    nloc = mine > 0u ? mine : 1u; nx = cnt > 0u ? cnt : 1u;
}
__device__ __forceinline__ void xcd_barrier(unsigned* bar, volatile LAS unsigned* st) {
    asm volatile("s_waitcnt vmcnt(0)" ::: "memory");
    __syncthreads();
    if (threadIdx.x == 0) {
        __builtin_amdgcn_s_waitcnt(0);
        unsigned nloc = st[0], nx = st[1]; const unsigned x = st[3];
        if (nloc == 0u) { xcd_barrier_complete(bar, x, nloc, nx); st[0] = nloc; st[1] = nx; }
        const unsigned old = xb_add(&bar[XB_XSUB(x)], 1u);
        const unsigned gen = old / nloc;
        if (old + 1u == (gen + 1u) * nloc) {
            __builtin_amdgcn_fence(__ATOMIC_RELEASE, "agent");
            asm volatile("s_waitcnt vmcnt(0)" ::: "memory");
            const unsigned og = xb_add(&bar[XB_TOP], 1u);
            const unsigned tg = og / nx;
            if (og + 1u == (tg + 1u) * nx) xb_add(&bar[XB_TOPGEN], 1u);
            else XB_SPIN(xb_ld(&bar[XB_TOPGEN]) == tg, bar);
            __builtin_amdgcn_fence(__ATOMIC_ACQUIRE, "agent");
            xb_add(&bar[XB_XGEN(x)], 1u);
            asm volatile("s_waitcnt vmcnt(0)" ::: "memory");
        } else {
            XB_SPIN(xb_ld(&bar[XB_XGEN(x)]) == gen, bar);
            __builtin_amdgcn_fence(__ATOMIC_ACQUIRE, "agent");
            asm volatile("s_waitcnt vmcnt(0)" ::: "memory");
        }
    }
    __syncthreads();
}

#if MEGA
#if PROBE_A >= 0
#define TSTAMP(i) do { if (blockIdx.x == 0 && threadIdx.x == 0) ts[i] = __builtin_amdgcn_s_memrealtime(); } while (0)
#else
#define TSTAMP(i) do { } while (0)
#endif
__global__ void __launch_bounds__(256, 2) mega_kernel(Params p) {
    __shared__ __attribute__((aligned(16))) char smem[SMEM_BYTES];
    __shared__ uint4 xb_words;
#if PROBE_A >= 0
    __shared__ unsigned long long ts[26];
#endif
    cg::grid_group grid = cg::this_grid();
    const int bid = blockIdx.x, nb = gridDim.x;
    unsigned* bar = (unsigned*)(p.ws + OFF_BAR);
    if (threadIdx.x == 0) xb_words = make_uint4(0u, 0u, 0u, 0u);
    if (bid == 0) for (int i = threadIdx.x; i < XCD_BAR_WORDS; i += 256) bar[i] = 0u;
    TSTAMP(0);
    phase_prep(p, smem, bid, nb);
    grid.sync();
    volatile LAS unsigned* xst = (volatile LAS unsigned*)&xb_words;
    xcd_barrier_post(bar, xst);
    TSTAMP(1);
    phase_norm<false>(p.x, p.norm1_g, (const float*)(p.ws + OFF_MOD), 0, D, (bf16_t*)(p.ws + OFF_H), bid, nb); xcd_barrier((unsigned*)(p.ws + OFF_BAR), (volatile LAS unsigned*)&xb_words);
    int slice, grank; const int gsz = nb / 8;
    {
        const unsigned myx = xst[3], myrank = xst[2];
        unsigned pre = 0;
#pragma unroll
        for (unsigned j = 0; j < 16; ++j) { const unsigned c = xb_ld(&bar[XB_XCNT(j)]); pre += (j < myx) ? c : 0u; }
        const int gi = __builtin_amdgcn_readfirstlane((int)(pre + myrank));
        slice = gi / gsz; grank = gi % gsz;
    }
#pragma nounroll
    for (int l = 0; l < NL; ++l) {
        TSTAMP(2 + 11 * l); phase_gemm1(p, l, smem, bid, nb); xcd_barrier((unsigned*)(p.ws + OFF_BAR), (volatile LAS unsigned*)&xb_words);
        TSTAMP(3 + 11 * l); phase_mix(p, l, smem, bid, nb); xcd_barrier((unsigned*)(p.ws + OFF_BAR), (volatile LAS unsigned*)&xb_words);
        TSTAMP(4 + 11 * l); phase_fftb(p, l, smem, bid, nb); xcd_barrier((unsigned*)(p.ws + OFF_BAR), (volatile LAS unsigned*)&xb_words);
        TSTAMP(5 + 11 * l); phase_gemm2(p, l, smem, bid, nb); xcd_barrier((unsigned*)(p.ws + OFF_BAR), (volatile LAS unsigned*)&xb_words);
        TSTAMP(6 + 11 * l); phase_norm<true>(p.ws + OFF_XR, p.norm2_g + l * D, (const float*)(p.ws + OFF_MOD) + (size_t)l * NB * 6144, 3 * D, 4 * D, (bf16_t*)(p.ws + OFF_H), bid, nb); xcd_barrier((unsigned*)(p.ws + OFF_BAR), (volatile LAS unsigned*)&xb_words);
        TSTAMP(7 + 11 * l); phase_gemm3(p, l, smem, bid, nb); xcd_barrier((unsigned*)(p.ws + OFF_BAR), (volatile LAS unsigned*)&xb_words);
        TSTAMP(8 + 11 * l); phase_topk(p, l, smem, bid, nb); xcd_barrier((unsigned*)(p.ws + OFF_BAR), (volatile LAS unsigned*)&xb_words);
        TSTAMP(9 + 11 * l); phase_pu(p, l, slice, grank, gsz); xcd_barrier((unsigned*)(p.ws + OFF_BAR), (volatile LAS unsigned*)&xb_words);
        TSTAMP(10 + 11 * l); phase_pc(p, l, bid, nb); xcd_barrier((unsigned*)(p.ws + OFF_BAR), (volatile LAS unsigned*)&xb_words);
        TSTAMP(11 + 11 * l); phase_pv(p, l, slice, grank, gsz); xcd_barrier((unsigned*)(p.ws + OFF_BAR), (volatile LAS unsigned*)&xb_words);
        TSTAMP(12 + 11 * l);
        if (l + 1 < NL) { phase_norm<true>(p.ws + OFF_XR, p.norm1_g + (l + 1) * D, (const float*)(p.ws + OFF_MOD) + (size_t)(l + 1) * NB * 6144, 0, D, (bf16_t*)(p.ws + OFF_H), bid, nb); xcd_barrier((unsigned*)(p.ws + OFF_BAR), (volatile LAS unsigned*)&xb_words); }
        else phase_final_norm(p, bid, nb);
    }
    TSTAMP(24);
#if PROBE_A >= 0
    if (bid == 0 && threadIdx.x == 0) p.out[0] += (float)(ts[PROBE_B] - ts[PROBE_A]) * 0.01f / PROBE_DIV;
#endif
}
#endif

extern "C" void kernel_launch(void* const* d_in, const int* in_sizes, int n_in, void* d_out, int out_size, void* d_ws, size_t ws_size, hipStream_t stream) {
    (void)in_sizes; (void)n_in; (void)out_size;
    if (ws_size < OFF_END) { fprintf(stderr, "workspace too small: %zu < %zu\n", ws_size, (size_t)OFF_END); return; }
    Params p{};
    p.x = (const float*)d_in[0]; p.c = (const float*)d_in[1]; p.mod_w = (const float*)d_in[2]; p.mod_b = (const float*)d_in[3]; p.norm1_g = (const float*)d_in[4];
    p.w_in = (const float*)d_in[5]; p.gmlp_ws = (const float*)d_in[6]; p.gmlp_bs = (const float*)d_in[7]; p.fnet_w = (const float*)d_in[8]; p.fnet_b = (const float*)d_in[9];
    p.gain_a = (const float*)d_in[10]; p.gain_b = (const float*)d_in[11]; p.w_out = (const float*)d_in[12]; p.norm2_g = (const float*)d_in[13]; p.wq = (const float*)d_in[14];
    p.k1 = (const float*)d_in[15]; p.k2 = (const float*)d_in[16]; p.pu = (const float*)d_in[17]; p.pv = (const float*)d_in[18]; p.final_g = (const float*)d_in[19];
    p.out = (float*)d_out; p.ws = (char*)d_ws;
#if MEGA
    static int grid_blocks = 0;
    if (!grid_blocks) {
        int dev = 0, cus = 0, per_cu = 0;
        hipGetDevice(&dev);
        hipDeviceGetAttribute(&cus, hipDeviceAttributeMultiprocessorCount, dev);
        hipOccupancyMaxActiveBlocksPerMultiprocessor(&per_cu, mega_kernel, 256, 0);
        if (per_cu > 2) per_cu = 2;
        grid_blocks = (cus * per_cu) / 8 * 8;
    }
    void* args[] = {&p};
    hipError_t e = hipLaunchCooperativeKernel((void*)mega_kernel, dim3(grid_blocks), dim3(256), args, 0, stream);
    if (e != hipSuccess) fprintf(stderr, "cooperative launch failed: %s (grid %d)\n", hipGetErrorString(e), grid_blocks);
#endif
}
```

```cpp
#include <hip/hip_runtime.h>
#include <hip/hip_cooperative_groups.h>
#include <cstdio>
#include <cstdint>
namespace cg = cooperative_groups;

#ifndef MEGA
#define MEGA 1
#endif
#ifndef PROBE_A
#define PROBE_A -1
#define PROBE_B 0
#define PROBE_DIV 10.0f
#endif

typedef unsigned short bf16_t;
typedef short bf16x8 __attribute__((ext_vector_type(8)));
typedef float f32x4 __attribute__((ext_vector_type(4)));
typedef __bf16 bf16x2_t __attribute__((ext_vector_type(2)));

constexpr int D = 1024, NB = 8, SEQ = 4096, T = NB * SEQ, NL = 2;
constexpr int NZ = 2048;
constexpr int NE = 16384;
constexpr float EPS = 1e-6f;

constexpr size_t OFF_MOD  = 0;
constexpr size_t OFF_W1T  = OFF_MOD  + (size_t)NL * NB * 6144 * 4;
constexpr size_t OFF_W2T  = OFF_W1T  + (size_t)NL * 2048 * 1024 * 2;
constexpr size_t OFF_WQT  = OFF_W2T  + (size_t)NL * 1024 * 1024 * 2;
constexpr size_t OFF_K12  = OFF_WQT  + (size_t)NL * 2048 * 1024 * 2;
constexpr size_t OFF_WSB  = OFF_K12  + (size_t)NL * 8 * 256 * 128 * 2;
constexpr size_t OFF_DA   = OFF_WSB  + (size_t)NL * 8 * 128 * 128 * 2;
constexpr size_t OFF_DB   = OFF_DA   + 128 * 128 * 2;
constexpr size_t OFF_TW   = OFF_DB   + 64 * 128 * 2;
constexpr size_t OFF_SSQA = OFF_TW   + 64 * 64 * 8;
constexpr size_t OFF_SSQB = OFF_SSQA + (size_t)T * 8 * 4;
constexpr size_t OFF_UB   = OFF_SSQB + (size_t)T * 8 * 4;
constexpr size_t OFF_VB   = OFF_UB   + (size_t)NL * NE * 1024;
constexpr size_t OFF_USC  = OFF_VB   + (size_t)NL * NE * 1024;
constexpr size_t OFF_VSC  = OFF_USC  + (size_t)NL * NE * 4;
constexpr size_t OFF_H    = OFF_VSC  + (size_t)NL * NE * 4;
constexpr size_t OFF_Z    = OFF_H    + (size_t)T * 1024 * 2;
constexpr size_t OFF_Y    = OFF_Z    + (size_t)T * 2048 * 2;
constexpr size_t OFF_BAR  = OFF_Y    + (size_t)T * 1024 * 2;
constexpr size_t OFF_XR   = OFF_BAR  + 16384;
constexpr size_t OFF_END  = OFF_XR   + (size_t)T * 1024 * 2;

struct Params {
    const float* x; const float* c; const float* mod_w; const float* mod_b; const float* norm1_g; const float* w_in;
    const float* gmlp_ws; const float* gmlp_bs; const float* fnet_w; const float* fnet_b; const float* gain_a; const float* gain_b;
    const float* w_out; const float* norm2_g; const float* wq; const float* k1; const float* k2; const float* pu; const float* pv; const float* final_g;
    float* out; char* ws;
};

constexpr int SMEM_BYTES = 73984;

__device__ __forceinline__ float bf2f(unsigned v) { return __uint_as_float(v << 16); }
typedef float f32x2_t __attribute__((ext_vector_type(2)));
__device__ __forceinline__ unsigned pk_bf16(float lo, float hi) { const f32x2_t v = {lo, hi}; return __builtin_bit_cast(unsigned, __builtin_convertvector(v, bf16x2_t)); }
__device__ __forceinline__ bf16_t f2bf(float f) { return (bf16_t)(pk_bf16(f, 0.f) & 0xffffu); }
__device__ __forceinline__ float gelu_f(float v) {
    const float t = __builtin_amdgcn_rcpf(fabsf(v) * 0.2316418882f + 1.0f);
    float q = t * 0.5307027145f + (-0.7265760135f); q = q * t + 0.7107068705f; q = q * t + (-0.142248368f); q = q * t + 0.127414796f; q = q * t;
    const float m = v * (q * __builtin_amdgcn_exp2f(v * v * (-0.72134752044f)));
    return v < 0.f ? m : v - m;
}
__device__ __forceinline__ int med3i(int a, int b, int c) { return max(min(a, b), min(max(a, b), c)); }
__device__ __forceinline__ int f2key(float f) { int b = __float_as_int(f); return b ^ ((b >> 31) & 0x7fffffff); }
__device__ __forceinline__ float key2f(int k) { return __int_as_float(k ^ ((k >> 31) & 0x7fffffff)); }
__device__ __forceinline__ float wave_sum(float v) {
#pragma unroll
    for (int o = 32; o >= 1; o >>= 1) v += __shfl_xor(v, o);
    return v;
}
__device__ __forceinline__ int otid() { int t = threadIdx.x; asm volatile("" : "+v"(t)); return t; }
#define MFMA16(a, b, c) __builtin_amdgcn_mfma_f32_16x16x32_bf16((a), (b), (c), 0, 0, 0)

__device__ void transpose_tile(const float* __restrict__ src, int ld, int k0, int n0, bf16_t* __restrict__ dst  , int dn0,
                               const float* __restrict__ kscale, float* tile  ) {
    const int tid = otid();
#pragma unroll
    for (int i = 0; i < 4; ++i) {
        const int r = (tid >> 4) + 16 * i, c4 = (tid & 15) * 4;
        const float4 v = *(const float4*)(src + (size_t)(k0 + r) * ld + n0 + c4);
        const float s = kscale ? kscale[k0 + r] : 1.0f;
        tile[r * 65 + c4 + 0] = v.x * s; tile[r * 65 + c4 + 1] = v.y * s; tile[r * 65 + c4 + 2] = v.z * s; tile[r * 65 + c4 + 3] = v.w * s;
    }
    __syncthreads();
    {
        const int n = tid >> 2, ks = (tid & 3) * 16;
        unsigned w[8];
#pragma unroll
        for (int j = 0; j < 8; ++j) w[j] = pk_bf16(tile[(ks + 2 * j) * 65 + n], tile[(ks + 2 * j + 1) * 65 + n]);
        uint4* d = (uint4*)(dst + (size_t)(dn0 + n) * 1024 + k0 + ks);
        d[0] = make_uint4(w[0], w[1], w[2], w[3]); d[1] = make_uint4(w[4], w[5], w[6], w[7]);
    }
    __syncthreads();
}

__device__ void phase_prep(const Params& p, char* smem, int bid_, int nb_) {
    const int tid = otid();
    char* ws = p.ws;
    const bool convgrp = (nb_ >= 2) && (bid_ & 1);
    const int bid = (nb_ >= 2) ? (bid_ >> 1) : bid_, nb = (nb_ >= 2) ? ((nb_ + 1 - (bid_ & 1)) >> 1) : nb_;
    const int gtid = bid * 256 + tid, gsz = nb * 256;
    if (!convgrp) {
    {
        float* sc = (float*)smem;
        float* red = (float*)(smem + 32768);
        for (int i = tid; i < 8192; i += 256) { const float v = p.c[i]; sc[i] = v / (1.0f + __expf(-v)); }
        __syncthreads();
        float* mod = (float*)(ws + OFF_MOD);
        for (int item = bid; item < NL * 192; item += nb) {
            const int l = item / 192, n0 = (item % 192) * 32, nn = tid & 31, kq = tid >> 5;
            float acc[8];
#pragma unroll
            for (int b = 0; b < 8; ++b) acc[b] = 0.f;
            const float* W = p.mod_w + (size_t)l * 1024 * 6144 + n0 + nn;
#pragma nounroll
            for (int k0 = kq; k0 < 1024; k0 += 128) {
                float w[16];
#pragma unroll
                for (int u = 0; u < 16; ++u) w[u] = W[(size_t)(k0 + 8 * u) * 6144];
#pragma unroll
                for (int u = 0; u < 16; ++u)
#pragma unroll
                    for (int b = 0; b < 8; ++b) acc[b] += sc[b * 1024 + k0 + 8 * u] * w[u];
            }
#pragma unroll
            for (int b = 0; b < 8; ++b) red[(kq * 8 + b) * 32 + nn] = acc[b];
            __syncthreads();
            {
                const int b = tid >> 5;
                float s = 0.f;
#pragma unroll
                for (int q = 0; q < 8; ++q) s += red[(q * 8 + b) * 32 + nn];
                mod[((size_t)l * NB + b) * 6144 + n0 + nn] = s + p.mod_b[l * 6144 + n0 + nn];
            }
            __syncthreads();
        }
    }
    {
        float* tile = (float*)smem;
        for (int item = bid; item < NL * 1024; item += nb) {
            const int l = item / 1024, r = item % 1024;
            if (r < 256) {
                const int kt = r / 16, nt = r % 16;
                transpose_tile(p.w_in + (size_t)l * 1024 * 1536, 1536, kt * 64, nt * 64, (bf16_t*)(ws + OFF_W1T) + (size_t)l * 2048 * 1024, nt * 64, nullptr, tile);
            } else if (r < 512) {
                const int rr = r - 256, kt = rr / 16, nt = rr % 16;
                const float* gk = (kt < 8) ? (p.gain_a + l * 512) : (p.gain_b + l * 512 - 512);
                transpose_tile(p.w_out + (size_t)l * 1024 * 1024, 1024, kt * 64, nt * 64, (bf16_t*)(ws + OFF_W2T) + (size_t)l * 1024 * 1024, nt * 64, gk, tile);
            } else {
                const int rr = r - 512, kt = rr / 32, nt = rr % 32;
                transpose_tile(p.wq + (size_t)l * 1024 * 2048, 2048, kt * 64, nt * 64, (bf16_t*)(ws + OFF_WQT) + (size_t)l * 2048 * 1024, nt * 64, nullptr, tile);
            }
        }
    }
    {
        float* fws = (float*)smem;
        float* Ms  = (float*)(smem + 16384);
        float* wt  = (float*)(smem + 49152);
        float* cs  = (float*)(smem + 49152 + 16640);
        for (int item = bid; item < NL * 8 * 16; item += nb) {
            const int l = item / 128, g = (item % 128) / 16, kt = item % 16;
            if (tid < 64) { float s, c; sincospif((float)tid / 32.0f, &s, &c); cs[tid] = c; cs[64 + tid] = s; }
            for (int i = tid; i < 4096; i += 256) fws[i] = p.fnet_w[((size_t)l * 8 + g) * 4096 + i];
#pragma unroll
            for (int i = 0; i < 4; ++i) {
                const int r = (tid >> 4) + 16 * i, c4 = (tid & 15) * 4;
                const float4 v = *(const float4*)(p.w_in + (size_t)l * 1024 * 1536 + (size_t)(kt * 64 + r) * 1536 + 1024 + g * 64 + c4);
                wt[r * 65 + c4] = v.x; wt[r * 65 + c4 + 1] = v.y; wt[r * 65 + c4 + 2] = v.z; wt[r * 65 + c4 + 3] = v.w;
            }
            __syncthreads();
            {
                const int d = tid >> 2, r0 = (tid & 3) * 32;
                const bool im = r0 >= 64; const int e0 = r0 & 63;
                float acc[32];
#pragma unroll
                for (int e = 0; e < 32; ++e) acc[e] = 0.f;
                for (int j = 0; j < 64; ++j) {
                    const int ph = (d * j) & 63;
                    const float t = im ? -cs[64 + ph] : cs[ph];
#pragma unroll
                    for (int e = 0; e < 32; ++e) acc[e] += t * fws[j * 64 + e0 + e];
                }
#pragma unroll
                for (int e = 0; e < 32; ++e) Ms[d * 128 + r0 + e] = acc[e];
            }
            __syncthreads();
            {
                const int r = tid >> 1, kk0 = (tid & 1) * 32;
                float acc[32];
#pragma unroll
                for (int k = 0; k < 32; ++k) acc[k] = 0.f;
                for (int d = 0; d < 64; ++d) {
                    const float m = Ms[d * 128 + r];
#pragma unroll
                    for (int k = 0; k < 32; ++k) acc[k] += wt[(kk0 + k) * 65 + d] * m;
                }
                bf16_t* dst = (bf16_t*)(ws + OFF_W1T) + (size_t)l * 2048 * 1024 + (size_t)(1024 + g * 128 + r) * 1024 + kt * 64 + kk0;
#pragma unroll
                for (int q = 0; q < 4; ++q)
                    ((uint4*)dst)[q] = make_uint4(pk_bf16(acc[q * 8], acc[q * 8 + 1]), pk_bf16(acc[q * 8 + 2], acc[q * 8 + 3]), pk_bf16(acc[q * 8 + 4], acc[q * 8 + 5]), pk_bf16(acc[q * 8 + 6], acc[q * 8 + 7]));
            }
            __syncthreads();
        }
    }
    {
        bf16_t* k12 = (bf16_t*)(ws + OFF_K12);
        for (int i = gtid; i < NL * 8 * 256 * 128; i += gsz) {
            const int d = i & 127, n = (i >> 7) & 255, h = (i >> 15) & 7, l = i >> 18;
            const float* src = (n < 128) ? p.k1 : p.k2;
            k12[i] = f2bf(src[(((size_t)l * 8 + h) * 128 + (n & 127)) * 128 + d]);
        }
        bf16_t* wsb = (bf16_t*)(ws + OFF_WSB);
        for (int i = gtid; i < NL * 8 * 128 * 128; i += gsz) wsb[i] = f2bf(p.gmlp_ws[i]);
        bf16_t* DA = (bf16_t*)(ws + OFF_DA);
        for (int i = gtid; i < 128 * 128; i += gsz) {
            const int m = i >> 7, kk = i & 127, ro = m >> 6, k1 = m & 63, ri = kk >> 6, a = kk & 63;
            float s, c; sincospif((float)((a * k1) & 63) / 32.0f, &s, &c);
            const float v = (ro == ri) ? c : (ro == 0 ? s : -s);
            DA[i] = f2bf(v);
        }
        bf16_t* DB = (bf16_t*)(ws + OFF_DB);
        for (int i = gtid; i < 64 * 128; i += gsz) {
            const int k2 = i >> 7, kk = i & 127, ri = kk >> 6, b = kk & 63;
            float s, c; sincospif((float)((b * k2) & 63) / 32.0f, &s, &c);
            DB[i] = f2bf(ri ? s : c);
        }
        float2* tw = (float2*)(ws + OFF_TW);
        for (int i = gtid; i < 64 * 64; i += gsz) {
            const int bp = i >> 6, k1 = i & 63;
            float s, c; sincospif((float)(bp * k1) / 2048.0f, &s, &c);
            tw[i] = make_float2(c, s);
        }
    }
    }
    if (convgrp || nb_ < 2) {
        {
            const int lane = tid & 63, wv = gtid >> 6, nwv = gsz >> 6;
            const int R = 2 * NL * NE;
#pragma nounroll
            for (int r0 = wv; r0 < R; r0 += 4 * nwv) {
                float4 v[4][4];
#pragma unroll
                for (int t = 0; t < 4; ++t) {
                    const int r = (r0 + t * nwv < R) ? r0 + t * nwv : r0;
                    const int tbl = r / (NL * NE), row = r % (NL * NE);
                    const float* src = (tbl ? p.pv : p.pu) + (size_t)row * 1024 + lane * 16;
#pragma unroll
                    for (int i = 0; i < 4; ++i) v[t][i] = ((const float4*)src)[i];
                }
#pragma unroll
                for (int t = 0; t < 4; ++t) {
                    const int r = r0 + t * nwv;
                    if (r >= R) break;
                    const int tbl = r / (NL * NE), row = r % (NL * NE);
                    float m = 0.f;
#pragma unroll
                    for (int i = 0; i < 4; ++i) m = fmaxf(m, fmaxf(fmaxf(fabsf(v[t][i].x), fabsf(v[t][i].y)), fmaxf(fabsf(v[t][i].z), fabsf(v[t][i].w))));
#pragma unroll
                    for (int o = 32; o >= 1; o >>= 1) m = fmaxf(m, __shfl_xor(m, o));
                    const float sc = (m > 0.f) ? 256.0f / m : 1.0f, inv = (m > 0.f) ? m * (1.0f / 256.0f) : 1.0f;
                    int w[4];
#pragma unroll
                    for (int i = 0; i < 4; ++i) { w[i] = __builtin_amdgcn_cvt_pk_fp8_f32(v[t][i].x * sc, v[t][i].y * sc, 0, false); w[i] = __builtin_amdgcn_cvt_pk_fp8_f32(v[t][i].z * sc, v[t][i].w * sc, w[i], true); }
                    const int lyr = row / NE, ex = row % NE;
                    *(int4*)(ws + (tbl ? OFF_VB : OFF_UB) + ((size_t)(lyr * 8 + (lane >> 3)) * NE + ex) * 128 + (lane & 7) * 16) = make_int4(w[0], w[1], w[2], w[3]);
                    if (lane == 0) ((float*)(ws + (tbl ? OFF_VSC : OFF_USC)))[row] = inv;
                }
            }
        }
    }
}

template <bool SRC_BF16>
__device__ void phase_norm(const void* __restrict__ xsrc_, const float* __restrict__ g, const float* __restrict__ modl  , int sh_off, int scl_off,
                           bf16_t* __restrict__ hout, int bid, int nb) {
    const int tid_ = otid(); const int lane = tid_ & 63, wid = tid_ >> 6;
    for (int tok = bid * 4 + wid; tok < T; tok += nb * 4) {
        const int b = tok / SEQ;
        float4 v[4];
        float ss = 0.f;
#pragma unroll
        for (int i = 0; i < 4; ++i) {
            if (SRC_BF16) { const uint2 w = *(const uint2*)((const bf16_t*)xsrc_ + (size_t)tok * D + i * 256 + lane * 4); v[i] = make_float4(bf2f(w.x & 0xffffu), bf2f(w.x >> 16), bf2f(w.y & 0xffffu), bf2f(w.y >> 16)); }
            else v[i] = *(const float4*)((const float*)xsrc_ + (size_t)tok * D + i * 256 + lane * 4);
            ss += v[i].x * v[i].x + v[i].y * v[i].y + v[i].z * v[i].z + v[i].w * v[i].w;
        }
        ss = wave_sum(ss);
        const float rstd = rsqrtf(ss * (1.0f / D) + EPS);
        const float* mb = modl + (size_t)b * 6144;
#pragma unroll
        for (int i = 0; i < 4; ++i) {
            const int cidx = i * 256 + lane * 4;
            const float4 gg = *(const float4*)(g + cidx), sh = *(const float4*)(mb + sh_off + cidx), sc = *(const float4*)(mb + scl_off + cidx);
            const float o0 = v[i].x * rstd * gg.x * (1.0f + sc.x) + sh.x, o1 = v[i].y * rstd * gg.y * (1.0f + sc.y) + sh.y;
            const float o2 = v[i].z * rstd * gg.z * (1.0f + sc.z) + sh.z, o3 = v[i].w * rstd * gg.w * (1.0f + sc.w) + sh.w;
            *(uint2*)(hout + (size_t)tok * D + cidx) = make_uint2(pk_bf16(o0, o1), pk_bf16(o2, o3));
        }
    }
}

#define LAS __attribute__((address_space(3)))
template <class Epi, class MidK>
__device__ __forceinline__ void gemm_tile(const bf16_t* __restrict__ A, int lda, const bf16_t* __restrict__ Bt, int ldb, int K, int m0, int n0,
                                          char* smem, const Epi& epi, const MidK& midk, int kmid) {
    const int tid = otid(), lane = tid & 63, wid = tid >> 6, wr = wid >> 1, wc = wid & 1, fr = lane & 15, fq = lane >> 4;
    LAS char* lds = (LAS char*)smem;
    f32x4 acc[4][4];
#pragma unroll
    for (int i = 0; i < 4; ++i)
#pragma unroll
        for (int j = 0; j < 4; ++j) acc[i][j] = (f32x4){0.f, 0.f, 0.f, 0.f};
    const int prow = lane >> 3, pch = (lane & 7) ^ prow;
    const bf16_t* ga = A + (size_t)(m0 + wid * 32 + prow) * lda + pch * 8;
    const bf16_t* gb = Bt + (size_t)(n0 + wid * 32 + prow) * ldb + pch * 8;
    const int nk = K / 64;
#define GEMM_STAGE(kt_, buf_) do { _Pragma("unroll") for (int i_ = 0; i_ < 4; ++i_) { \
        __builtin_amdgcn_global_load_lds((const unsigned*)(ga + (size_t)(i_ * 8) * lda + (kt_) * 64), (LAS unsigned*)(lds + (buf_) * 16384 + (wid * 32 + i_ * 8) * 128), 16, 0, 0); \
        __builtin_amdgcn_global_load_lds((const unsigned*)(gb + (size_t)(i_ * 8) * ldb + (kt_) * 64), (LAS unsigned*)(lds + 32768 + (buf_) * 16384 + (wid * 32 + i_ * 8) * 128), 16, 0, 0); } } while (0)
    GEMM_STAGE(0, 0);
    const int swz = fr & 7;
    for (int kt = 0; kt < nk; ++kt) {
        const int cur = kt & 1;
        asm volatile("s_waitcnt vmcnt(0)" ::: "memory");
        __syncthreads();
        if (kt + 1 < nk) GEMM_STAGE(kt + 1, cur ^ 1);
        if (kt == kmid) {
#pragma unroll
            for (int i = 0; i < 4; ++i) { const float sc = midk(m0 + wr * 64 + i * 16 + fr);
#pragma unroll
                for (int j = 0; j < 4; ++j) acc[i][j] *= sc; }
        }
        const LAS char* ca = lds + cur * 16384; const LAS char* cb = lds + 32768 + cur * 16384;
#pragma unroll
        for (int ks = 0; ks < 2; ++ks) {
            bf16x8 af[4], bfr[4];
            const int coff = ((ks * 4 + fq) ^ swz) * 16;
#pragma unroll
            for (int i = 0; i < 4; ++i) af[i] = *(const LAS bf16x8*)(ca + (wr * 64 + i * 16 + fr) * 128 + coff);
#pragma unroll
            for (int j = 0; j < 4; ++j) bfr[j] = *(const LAS bf16x8*)(cb + (wc * 64 + j * 16 + fr) * 128 + coff);
#pragma unroll
            for (int i = 0; i < 4; ++i)
#pragma unroll
                for (int j = 0; j < 4; ++j) acc[i][j] = MFMA16(bfr[j], af[i], acc[i][j]);
        }
    }
#undef GEMM_STAGE
    __syncthreads();
    {
        LAS char* stg = lds + wid * 17408;
#pragma unroll
        for (int i = 0; i < 4; ++i)
#pragma unroll
            for (int j = 0; j < 4; ++j) *(LAS f32x4*)(stg + (i * 16 + fr) * 272 + (j * 16 + fq * 4) * 4) = acc[i][j];
        const int er = lane >> 3, ec = (lane & 7) * 8;
#pragma unroll
        for (int t = 0; t < 8; ++t) {
            const f32x4 v0 = *(const LAS f32x4*)(stg + (t * 8 + er) * 272 + ec * 4), v1 = *(const LAS f32x4*)(stg + (t * 8 + er) * 272 + ec * 4 + 16);
            epi(m0 + wr * 64 + t * 8 + er, n0 + wc * 64 + ec, v0, v1);
            __builtin_amdgcn_sched_barrier(0);
        }
    }
    __syncthreads();
}
template <class Epi, class MidK>
__device__ __forceinline__ void gemm_tile256(const bf16_t* __restrict__ A, int lda, const bf16_t* __restrict__ Bt, int ldb, int K, int m0, int n0,
                                             char* smem, const Epi& epi, const MidK& midk, int kmid) {
    const int tid = otid(), lane = tid & 63, wid = tid >> 6, wr = wid >> 1, wc = wid & 1, fr = lane & 15, fq = lane >> 4;
    LAS char* lds = (LAS char*)smem;
    f32x4 acc[8][4];
#pragma unroll
    for (int i = 0; i < 8; ++i)
#pragma unroll
        for (int j = 0; j < 4; ++j) acc[i][j] = (f32x4){0.f, 0.f, 0.f, 0.f};
    const int prow = lane >> 2, pch = (lane & 3) ^ (((lane >> 4) & 1) << 1);
    const bf16_t* ga = A + (size_t)(m0 + wid * 64 + prow) * lda + pch * 8;
    const bf16_t* gb = Bt + (size_t)(n0 + wid * 32 + prow) * ldb + pch * 8;
    const int nk = K / 32;
#define G256_STAGE(kt_, st_) do { \
        _Pragma("unroll") for (int i_ = 0; i_ < 4; ++i_) __builtin_amdgcn_global_load_lds((const unsigned*)(ga + (size_t)(i_ * 16) * lda + (kt_) * 32), (LAS unsigned*)(lds + (st_) * 24576 + (wid * 4 + i_) * 1024), 16, 0, 0); \
        _Pragma("unroll") for (int i_ = 0; i_ < 2; ++i_) __builtin_amdgcn_global_load_lds((const unsigned*)(gb + (size_t)(i_ * 16) * ldb + (kt_) * 32), (LAS unsigned*)(lds + (st_) * 24576 + 16384 + (wid * 2 + i_) * 1024), 16, 0, 0); } while (0)
    G256_STAGE(0, 0);
    const int coff = (fq ^ (((fr >> 2) & 1) << 1)) * 16;
    for (int kt = 0; kt < nk; ++kt) {
        const int cur = kt & 1;
        asm volatile("s_waitcnt vmcnt(0)" ::: "memory");
        __syncthreads();
        if (kt + 1 < nk) G256_STAGE(kt + 1, cur ^ 1);
        if (kt == kmid) {
#pragma unroll
            for (int i = 0; i < 8; ++i) { const float sc = midk(m0 + wr * 128 + i * 16 + fr);
#pragma unroll
                for (int j = 0; j < 4; ++j) acc[i][j] *= sc; }
        }
        const LAS char* ca = lds + cur * 24576 + coff; const LAS char* cb = ca + 16384;
        bf16x8 bfr[4];
#pragma unroll
        for (int j = 0; j < 4; ++j) bfr[j] = *(const LAS bf16x8*)(cb + (wc * 64 + j * 16 + fr) * 64);
#pragma unroll
        for (int ih = 0; ih < 2; ++ih) {
            bf16x8 af[4];
#pragma unroll
            for (int i = 0; i < 4; ++i) af[i] = *(const LAS bf16x8*)(ca + (wr * 128 + (ih * 4 + i) * 16 + fr) * 64);
#pragma unroll
            for (int i = 0; i < 4; ++i)
#pragma unroll
                for (int j = 0; j < 4; ++j) acc[ih * 4 + i][j] = MFMA16(bfr[j], af[i], acc[ih * 4 + i][j]);
        }
    }
#undef G256_STAGE
#pragma unroll
    for (int hb = 0; hb < 2; ++hb) {
        __syncthreads();
        LAS char* stg = lds + wid * 17408;
#pragma unroll
        for (int i = 0; i < 4; ++i)
#pragma unroll
            for (int j = 0; j < 4; ++j) *(LAS f32x4*)(stg + (i * 16 + fr) * 272 + (j * 16 + fq * 4) * 4) = acc[hb * 4 + i][j];
        const int er = lane >> 3, ec = (lane & 7) * 8;
#pragma unroll
        for (int t = 0; t < 8; ++t) {
            const f32x4 v0 = *(const LAS f32x4*)(stg + (t * 8 + er) * 272 + ec * 4), v1 = *(const LAS f32x4*)(stg + (t * 8 + er) * 272 + ec * 4 + 16);
            epi(m0 + wr * 128 + hb * 64 + t * 8 + er, n0 + wc * 64 + ec, v0, v1);
            __builtin_amdgcn_sched_barrier(0);
        }
    }
    __syncthreads();
}
__device__ __forceinline__ bool tile_of(int round, int bid, int nb, int MT, int NT, int& mt, int& nt) {
    if (nb == 512) {
        const int x = bid & 7, r = bid >> 3, st = x + 8 * round, snt = NT >> 3;
        if (st >= (MT >> 3) * snt) return false;
        mt = (st / snt) * 8 + (r >> 3); nt = (st % snt) * 8 + (r & 7);
        return true;
    }
    const int item = bid + round * nb;
    if (item >= MT * NT) return false;
    mt = item / NT; nt = item % NT;
    return true;
}
struct NoMid { __device__ __forceinline__ float operator()(int) const { return 1.0f; } };

__device__ void phase_gemm1(const Params& p, int l, char* smem, int bid, int nb) {
    const bf16_t* A = (const bf16_t*)(p.ws + OFF_H);
    const bf16_t* Bt = (const bf16_t*)(p.ws + OFF_W1T) + (size_t)l * 2048 * 1024;
    bf16_t* Z = (bf16_t*)(p.ws + OFF_Z);
    auto epi_gelu = [&](int row, int col, const f32x4& a, const f32x4& b) {
        *(uint4*)(Z + (size_t)row * NZ + col) = make_uint4(pk_bf16(gelu_f(a[0]), gelu_f(a[1])), pk_bf16(gelu_f(a[2]), gelu_f(a[3])), pk_bf16(gelu_f(b[0]), gelu_f(b[1])), pk_bf16(gelu_f(b[2]), gelu_f(b[3])));
    };
    auto epi_plain = [&](int row, int col, const f32x4& a, const f32x4& b) {
        *(uint4*)(Z + (size_t)row * NZ + col) = make_uint4(pk_bf16(a[0], a[1]), pk_bf16(a[2], a[3]), pk_bf16(b[0], b[1]), pk_bf16(b[2], b[3]));
    };
    const int NT = NZ / 128, MT = T / 256;
    int mt, nt;
    for (int round = 0; tile_of(round, bid, nb, MT, NT, mt, nt); ++round) {
        const int n0 = nt * 128;
        if (n0 < 1024) gemm_tile256(A, D, Bt, D, D, mt * 256, n0, smem, epi_gelu, NoMid(), -1);
        else           gemm_tile256(A, D, Bt, D, D, mt * 256, n0, smem, epi_plain, NoMid(), -1);
    }
}
__device__ void phase_gemm2(const Params& p, int l, char* smem, int bid, int nb) {
    const bf16_t* A = (const bf16_t*)(p.ws + OFF_Y);
    const bf16_t* Bt = (const bf16_t*)(p.ws + OFF_W2T) + (size_t)l * 1024 * 1024;
    const float* ssa = (const float*)(p.ws + OFF_SSQA); const float* ssb = (const float*)(p.ws + OFF_SSQB);
    const float* mod = (const float*)(p.ws + OFF_MOD) + (size_t)l * NB * 6144;
    bf16_t* XR = (bf16_t*)(p.ws + OFF_XR);
    auto rstd_of = [&](const float* s, int row) {
        const float4 a = *(const float4*)(s + (size_t)row * 8), b = *(const float4*)(s + (size_t)row * 8 + 4);
        return rsqrtf(((a.x + a.y) + (a.z + a.w) + (b.x + b.y) + (b.z + b.w)) * (1.0f / 512.0f) + EPS);
    };
    auto midk = [&](int row) { return rstd_of(ssa, row) / rstd_of(ssb, row); };
    auto epi = [&](int row, int col, const f32x4& a, const f32x4& c) {
        const float rb = rstd_of(ssb, row);
        const int b = row / SEQ;
        const float4 g0 = *(const float4*)(mod + (size_t)b * 6144 + 2 * D + col), g1 = *(const float4*)(mod + (size_t)b * 6144 + 2 * D + col + 4);
        float x[8];
        if (l == 0) { const float4 x0 = *(const float4*)(p.x + (size_t)row * D + col), x1 = *(const float4*)(p.x + (size_t)row * D + col + 4);
            x[0] = x0.x; x[1] = x0.y; x[2] = x0.z; x[3] = x0.w; x[4] = x1.x; x[5] = x1.y; x[6] = x1.z; x[7] = x1.w; }
        else { const uint4 w = *(const uint4*)(XR + (size_t)row * D + col);
            x[0] = bf2f(w.x & 0xffffu); x[1] = bf2f(w.x >> 16); x[2] = bf2f(w.y & 0xffffu); x[3] = bf2f(w.y >> 16); x[4] = bf2f(w.z & 0xffffu); x[5] = bf2f(w.z >> 16); x[6] = bf2f(w.w & 0xffffu); x[7] = bf2f(w.w >> 16); }
        *(uint4*)(XR + (size_t)row * D + col) = make_uint4(pk_bf16(x[0] + g0.x * rb * a[0], x[1] + g0.y * rb * a[1]), pk_bf16(x[2] + g0.z * rb * a[2], x[3] + g0.w * rb * a[3]),
                                                           pk_bf16(x[4] + g1.x * rb * c[0], x[5] + g1.y * rb * c[1]), pk_bf16(x[6] + g1.z * rb * c[2], x[7] + g1.w * rb * c[3]));
    };
    const int NT = D / 128, MT = T / 256;
    int mt, nt;
    for (int round = 0; tile_of(round, bid, nb, MT, NT, mt, nt); ++round) gemm_tile256(A, D, Bt, D, D, mt * 256, nt * 128, smem, epi, midk, 16);
}
__device__ void phase_gemm3(const Params& p, int l, char* smem, int bid, int nb) {
    const bf16_t* A = (const bf16_t*)(p.ws + OFF_H);
    const bf16_t* Bt = (const bf16_t*)(p.ws + OFF_WQT) + (size_t)l * 2048 * 1024;
    bf16_t* Q = (bf16_t*)(p.ws + OFF_Z);
    auto epi = [&](int row, int col, const f32x4& a, const f32x4& b) { *(uint4*)(Q + (size_t)row * 2048 + col) = make_uint4(pk_bf16(a[0], a[1]), pk_bf16(a[2], a[3]), pk_bf16(b[0], b[1]), pk_bf16(b[2], b[3])); };
    const int NT = 2048 / 128, MT = T / 256;
    int mt, nt;
    for (int round = 0; tile_of(round, bid, nb, MT, NT, mt, nt); ++round) gemm_tile256(A, D, Bt, D, D, mt * 256, nt * 128, smem, epi, NoMid(), -1);
}

constexpr int TP = 136;
__device__ __forceinline__ void stage_transposed(const bf16_t* __restrict__ base, size_t row_stride, bf16_t* dT) {
    const int tid = otid(), r = tid >> 2, part = tid & 3, ri = part >> 1, c0 = (part & 1) * 32;
    const uint4* src = (const uint4*)(base + (size_t)r * row_stride + ri * 64 + c0);
    uint4 v[4];
#pragma unroll
    for (int i = 0; i < 4; ++i) v[i] = src[i];
#pragma unroll
    for (int i = 0; i < 4; ++i) {
        const unsigned w[4] = {v[i].x, v[i].y, v[i].z, v[i].w};
#pragma unroll
        for (int j = 0; j < 4; ++j) {
            dT[(c0 + i * 8 + j * 2) * TP + ri * 64 + r] = (bf16_t)(w[j] & 0xffffu);
            dT[(c0 + i * 8 + j * 2 + 1) * TP + ri * 64 + r] = (bf16_t)(w[j] >> 16);
        }
    }
}

__device__ void gmlp_item(const Params& p, int l, int item, char* smem) {
    const int tid = otid(), lane = tid & 63, wid = tid >> 6, fr = lane & 15, fq = lane >> 4;
    const int h = item & 7, c = (item >> 3) & 31, b = item >> 8;
    const int tok0 = b * SEQ + c * 128;
    bf16_t* vnT = (bf16_t*)smem;
    const bf16_t* Z = (const bf16_t*)(p.ws + OFF_Z);
    {
        const int q = tid >> 1, half = tid & 1, d0 = half * 32;
        const uint4* src = (const uint4*)(Z + (size_t)(tok0 + q) * NZ + 512 + h * 64 + d0);
        float f[32];
#pragma unroll
        for (int i = 0; i < 4; ++i) { const uint4 v = src[i]; const unsigned w[4] = {v.x, v.y, v.z, v.w};
#pragma unroll
            for (int j = 0; j < 4; ++j) { f[i * 8 + j * 2] = bf2f(w[j] & 0xffffu); f[i * 8 + j * 2 + 1] = bf2f(w[j] >> 16); } }
        float s = 0.f;
#pragma unroll
        for (int i = 0; i < 32; ++i) s += f[i];
        s += __shfl_xor(s, 1);
        const float mean = s * (1.0f / 64.0f);
        float qv = 0.f;
#pragma unroll
        for (int i = 0; i < 32; ++i) { f[i] -= mean; qv += f[i] * f[i]; }
        qv += __shfl_xor(qv, 1);
        const float rstd = rsqrtf(qv * (1.0f / 64.0f) + EPS);
#pragma unroll
        for (int i = 0; i < 32; ++i) vnT[(d0 + i) * TP + q] = f2bf(f[i] * rstd);
    }
    __syncthreads();
    const bf16_t* Wsb = (const bf16_t*)(p.ws + OFF_WSB) + ((size_t)l * 8 + h) * 128 * 128;
    f32x4 acc[2][4];
#pragma unroll
    for (int i = 0; i < 2; ++i)
#pragma unroll
        for (int j = 0; j < 4; ++j) acc[i][j] = (f32x4){0.f, 0.f, 0.f, 0.f};
    const int p0 = wid * 32;
#pragma unroll
    for (int ks = 0; ks < 4; ++ks) {
        bf16x8 af[2], bfr[4];
#pragma unroll
        for (int i = 0; i < 2; ++i) af[i] = *(const bf16x8*)(Wsb + (size_t)(p0 + i * 16 + fr) * 128 + ks * 32 + fq * 8);
#pragma unroll
        for (int j = 0; j < 4; ++j) bfr[j] = *(const bf16x8*)(vnT + (j * 16 + fr) * TP + ks * 32 + fq * 8);
#pragma unroll
        for (int i = 0; i < 2; ++i)
#pragma unroll
            for (int j = 0; j < 4; ++j) acc[i][j] = MFMA16(bfr[j], af[i], acc[i][j]);
    }
    bf16_t* Y = (bf16_t*)(p.ws + OFF_Y);
    float* ssa = (float*)(p.ws + OFF_SSQA);
#pragma unroll
    for (int i = 0; i < 2; ++i) {
        const int pp = p0 + i * 16 + fr, tok = tok0 + pp;
        const float bsv = p.gmlp_bs[((size_t)l * 8 + h) * 128 + pp];
        float ss = 0.f;
#pragma unroll
        for (int j = 0; j < 4; ++j) {
            const int d = j * 16 + fq * 4;
            const uint2 uu = *(const uint2*)(Z + (size_t)tok * NZ + h * 64 + d);
            const float y0 = bf2f(uu.x & 0xffffu) * (acc[i][j][0] + bsv), y1 = bf2f(uu.x >> 16) * (acc[i][j][1] + bsv);
            const float y2 = bf2f(uu.y & 0xffffu) * (acc[i][j][2] + bsv), y3 = bf2f(uu.y >> 16) * (acc[i][j][3] + bsv);
            ss += y0 * y0 + y1 * y1 + y2 * y2 + y3 * y3;
            *(uint2*)(Y + (size_t)tok * D + h * 64 + d) = make_uint2(pk_bf16(y0, y1), pk_bf16(y2, y3));
        }
        ss += __shfl_xor(ss, 16); ss += __shfl_xor(ss, 32);
        if (fq == 0) ssa[(size_t)tok * 8 + h] = ss;
    }
    __syncthreads();
}

__device__ void ffta_item(const Params& p, int item, char* smem) {
    const int tid = otid(), lane = tid & 63, wid = tid >> 6, fr = lane & 15, fq = lane >> 4;
    const int bp = item & 63, g = (item >> 6) & 7, b = item >> 9;
    bf16_t* dT = (bf16_t*)smem;
    const bf16_t* Z = (const bf16_t*)(p.ws + OFF_Z);
    stage_transposed(Z + (size_t)(b * SEQ + bp) * NZ + 1024 + g * 128, (size_t)64 * NZ, dT);
    __syncthreads();
    const bf16_t* DA = (const bf16_t*)(p.ws + OFF_DA);
    f32x4 acc[2][4];
#pragma unroll
    for (int i = 0; i < 2; ++i)
#pragma unroll
        for (int j = 0; j < 4; ++j) acc[i][j] = (f32x4){0.f, 0.f, 0.f, 0.f};
#pragma unroll
    for (int ks = 0; ks < 4; ++ks) {
        bf16x8 af[2], bfr[4];
#pragma unroll
        for (int i = 0; i < 2; ++i) af[i] = *(const bf16x8*)(DA + (size_t)(i * 64 + wid * 16 + fr) * 128 + ks * 32 + fq * 8);
#pragma unroll
        for (int j = 0; j < 4; ++j) bfr[j] = *(const bf16x8*)(dT + (j * 16 + fr) * TP + ks * 32 + fq * 8);
#pragma unroll
        for (int i = 0; i < 2; ++i)
#pragma unroll
            for (int j = 0; j < 4; ++j) acc[i][j] = MFMA16(bfr[j], af[i], acc[i][j]);
    }
    const int k1 = wid * 16 + fr;
    const float2 cs = ((const float2*)(p.ws + OFF_TW))[bp * 64 + k1];
    bf16_t* Yb = (bf16_t*)(p.ws + OFF_H) + ((((size_t)(b * 8 + g) * 64 + k1) * 64 + bp) * 128);
#pragma unroll
    for (int j = 0; j < 4; ++j) {
        const int ch = j * 16 + fq * 4;
        float yr[4], yi[4];
#pragma unroll
        for (int e = 0; e < 4; ++e) { const float r = acc[0][j][e], im = acc[1][j][e]; yr[e] = r * cs.x + im * cs.y; yi[e] = im * cs.x - r * cs.y; }
        *(uint2*)(Yb + ch) = make_uint2(pk_bf16(yr[0], yr[1]), pk_bf16(yr[2], yr[3]));
        *(uint2*)(Yb + 64 + ch) = make_uint2(pk_bf16(yi[0], yi[1]), pk_bf16(yi[2], yi[3]));
    }
    __syncthreads();
}

__device__ void phase_mix(const Params& p, int l, char* smem, int bid, int nb) {
    for (int item = bid; item < 2048 + 4096; item += nb) {
        if (item < 2048) gmlp_item(p, l, item, smem); else ffta_item(p, item - 2048, smem);
    }
}

__device__ void phase_fftb(const Params& p, int l, char* smem, int bid, int nb) {
    const int tid = otid(), lane = tid & 63, wid = tid >> 6, fr = lane & 15, fq = lane >> 4;
    bf16_t* dT = (bf16_t*)smem;
    const bf16_t* DB = (const bf16_t*)(p.ws + OFF_DB);
    bf16_t* Y = (bf16_t*)(p.ws + OFF_Y);
    float* ssb = (float*)(p.ws + OFF_SSQB);
    for (int item = bid; item < 4096; item += nb) {
        const int k1 = item & 63, g = (item >> 6) & 7, b = item >> 9;
        stage_transposed((const bf16_t*)(p.ws + OFF_H) + (((size_t)(b * 8 + g) * 64 + k1) * 64) * 128, 128, dT);
        __syncthreads();
        f32x4 acc[4];
#pragma unroll
        for (int j = 0; j < 4; ++j) acc[j] = (f32x4){0.f, 0.f, 0.f, 0.f};
#pragma unroll
        for (int ks = 0; ks < 4; ++ks) {
            const bf16x8 af = *(const bf16x8*)(DB + (size_t)(wid * 16 + fr) * 128 + ks * 32 + fq * 8);
#pragma unroll
            for (int j = 0; j < 4; ++j) { const bf16x8 bfr = *(const bf16x8*)(dT + (j * 16 + fr) * TP + ks * 32 + fq * 8); acc[j] = MFMA16(bfr, af, acc[j]); }
        }
        const int k2 = wid * 16 + fr, tok = b * SEQ + k1 + 64 * k2;
        float ss = 0.f;
#pragma unroll
        for (int j = 0; j < 4; ++j) {
            const int ch = j * 16 + fq * 4;
            const float4 fb = *(const float4*)(p.fnet_b + ((size_t)l * 8 + g) * 64 + ch);
            const float y0 = acc[j][0] * (1.0f / 512.0f) + fb.x, y1 = acc[j][1] * (1.0f / 512.0f) + fb.y, y2 = acc[j][2] * (1.0f / 512.0f) + fb.z, y3 = acc[j][3] * (1.0f / 512.0f) + fb.w;
            ss += y0 * y0 + y1 * y1 + y2 * y2 + y3 * y3;
            *(uint2*)(Y + (size_t)tok * D + 512 + g * 64 + ch) = make_uint2(pk_bf16(y0, y1), pk_bf16(y2, y3));
        }
        ss += __shfl_xor(ss, 16); ss += __shfl_xor(ss, 32);
        if (fq == 0) ssb[(size_t)tok * 8 + g] = ss;
        __syncthreads();
    }
}

#define INS16(a, v) do { a[15] = med3i(a[14], a[15], v); a[14] = med3i(a[13], a[14], v); a[13] = med3i(a[12], a[13], v); a[12] = med3i(a[11], a[12], v); \
    a[11] = med3i(a[10], a[11], v); a[10] = med3i(a[9], a[10], v); a[9] = med3i(a[8], a[9], v); a[8] = med3i(a[7], a[8], v); a[7] = med3i(a[6], a[7], v); \
    a[6] = med3i(a[5], a[6], v); a[5] = med3i(a[4], a[5], v); a[4] = med3i(a[3], a[4], v); a[3] = med3i(a[2], a[3], v); a[2] = med3i(a[1], a[2], v); \
    a[1] = med3i(a[0], a[1], v); a[0] = max(a[0], v); } while (0)

template <int I, int J> struct CandLoop {
    static __device__ __forceinline__ void run(int (&a)[16], const float (&f1)[16], const float (&f2)[16]) {
        if constexpr ((I + 1) * (J + 1) <= 16) { const int key = (f2key(f1[I] + f2[J]) & ~255) | (I * 16 + J); INS16(a, key); }
        if constexpr (J + 1 < 16) CandLoop<I, J + 1>::run(a, f1, f2);
        else if constexpr (I + 1 < 16) CandLoop<I + 1, 0>::run(a, f1, f2);
    }
};

typedef _Float16 f16x2_t __attribute__((ext_vector_type(2)));
__device__ __forceinline__ unsigned pk_f16(float lo, float hi) { const f16x2_t v = {(_Float16)lo, (_Float16)hi}; return __builtin_bit_cast(unsigned, v); }
__device__ __forceinline__ int h2key(unsigned bits16) { const int b = (int)(short)bits16; return b ^ ((b >> 15) & 0x7fff); }
__device__ __forceinline__ float key2h(int k) { const int b = k ^ ((k >> 15) & 0x7fff); return (float)__builtin_bit_cast(_Float16, (unsigned short)(b & 0xffff)); }

__device__ void phase_topk(const Params& p, int l, char* smem, int bid, int nb) {
    const int tid = otid(), lane = tid & 63, wid = tid >> 6, fr = lane & 15, fq = lane >> 4;
    unsigned* S32 = (unsigned*)smem;
    int* TT = (int*)smem;
    const bf16_t* Q = (const bf16_t*)(p.ws + OFF_Z);
    int* eidx = (int*)(p.ws + OFF_Y); float* gw = (float*)(p.ws + OFF_Y + (size_t)T * 128 * 4);
    const int hh = wid >> 1, half = wid & 1;
    for (int item = bid; item < (T / 64) * 4; item += nb) {
        const int hp = item & 3, tok0 = (item >> 2) * 64, h = hp * 2 + hh;
        const bf16_t* Kh = (const bf16_t*)(p.ws + OFF_K12) + (((size_t)l * 8 + h) * 256 + half * 128) * 128;
        const bf16_t* Qh = Q + (size_t)tok0 * 2048 + h * 256 + half * 128;
        {
            f32x4 acc[4][8];
#pragma unroll
            for (int i = 0; i < 4; ++i)
#pragma unroll
                for (int j = 0; j < 8; ++j) acc[i][j] = (f32x4){0.f, 0.f, 0.f, 0.f};
#pragma unroll
            for (int ks = 0; ks < 4; ++ks) {
                bf16x8 af[4];
#pragma unroll
                for (int i = 0; i < 4; ++i) af[i] = *(const bf16x8*)(Qh + (size_t)(i * 16 + fr) * 2048 + ks * 32 + fq * 8);
#pragma unroll
                for (int jh = 0; jh < 2; ++jh) {
                    bf16x8 bfr[4];
#pragma unroll
                    for (int j = 0; j < 4; ++j) bfr[j] = *(const bf16x8*)(Kh + (size_t)((jh * 4 + j) * 16 + fr) * 128 + ks * 32 + fq * 8);
#pragma unroll
                    for (int i = 0; i < 4; ++i)
#pragma unroll
                        for (int j = 0; j < 4; ++j) acc[i][jh * 4 + j] = MFMA16(bfr[j], af[i], acc[i][jh * 4 + j]);
                    __builtin_amdgcn_sched_barrier(0);
                }
            }
#pragma unroll
            for (int i = 0; i < 4; ++i)
#pragma unroll
                for (int j = 0; j < 8; ++j) {
                    unsigned* d = S32 + (i * 16 + fr) * 257 + hh * 128 + half * 64 + j * 8 + fq * 2;
                    d[0] = pk_f16(acc[i][j][0], acc[i][j][1]); d[1] = pk_f16(acc[i][j][2], acc[i][j][3]);
                }
        }
        __syncthreads();
        int a[16];
#pragma unroll
        for (int i = 0; i < 16; ++i) a[i] = (int)0x80000000;
        {
            const unsigned* sr = S32 + lane * 257 + hh * 128 + half * 64;
#pragma unroll 2
            for (int i = 0; i < 64; ++i) {
                const unsigned w = sr[i];
                const int k0 = (h2key(w & 0xffffu) << 7) | (2 * i), k1 = (h2key(w >> 16) << 7) | (2 * i + 1);
                INS16(a, k0); INS16(a, k1);
            }
        }
        __syncthreads();
#pragma unroll
        for (int i = 0; i < 16; ++i) TT[((lane * 2 + hh) * 2 + half) * 16 + i] = a[i];
        __syncthreads();
        if (tid < 128) {
            const int tk = tid & 63, h2 = tid >> 6, hd = hp * 2 + h2;
            const int* t1 = TT + ((tk * 2 + h2) * 2) * 16; const int* t2 = t1 + 16;
            float f1[16], f2[16];
#pragma unroll
            for (int i = 0; i < 16; ++i) { f1[i] = key2h(t1[i] >> 7); f2[i] = key2h(t2[i] >> 7); }
            int c[16];
#pragma unroll
            for (int i = 0; i < 16; ++i) c[i] = (int)0x80000000;
            CandLoop<0, 0>::run(c, f1, f2);
            float sc[16], e[16], sum = 0.f; int ex[16];
#pragma unroll
            for (int i = 0; i < 16; ++i) {
                sc[i] = key2f(c[i] & ~255);
                const int code = c[i] & 255;
                ex[i] = (t1[code >> 4] & 127) * 128 + (t2[code & 15] & 127);
            }
#pragma unroll
            for (int i = 0; i < 16; ++i) { e[i] = __expf(sc[i] - sc[0]); sum += e[i]; }
            const float inv = 1.0f / sum;
            int4* ep = (int4*)(eidx + (size_t)(tok0 + tk) * 128 + hd * 16); float4* gp = (float4*)(gw + (size_t)(tok0 + tk) * 128 + hd * 16);
#pragma unroll
            for (int i = 0; i < 4; ++i) { ep[i] = make_int4(ex[4 * i], ex[4 * i + 1], ex[4 * i + 2], ex[4 * i + 3]); gp[i] = make_float4(e[4 * i] * inv, e[4 * i + 1] * inv, e[4 * i + 2] * inv, e[4 * i + 3] * inv); }
        }
        __syncthreads();
    }
}

__device__ __forceinline__ float dot16_fp8(const float (&h)[16], const int4& u) {
    const int w[4] = {u.x, u.y, u.z, u.w};
    f32x2_t a = {0.f, 0.f};
#pragma unroll
    for (int i = 0; i < 4; ++i) {
        const f32x2_t lo = __builtin_amdgcn_cvt_pk_f32_fp8(w[i], false), hi = __builtin_amdgcn_cvt_pk_f32_fp8(w[i], true);
        const f32x2_t h0 = {h[4 * i], h[4 * i + 1]}, h1 = {h[4 * i + 2], h[4 * i + 3]};
        a = __builtin_elementwise_fma(lo, h0, a); a = __builtin_elementwise_fma(hi, h1, a);
    }
    return a.x + a.y;
}
__device__ __forceinline__ void axpy16_fp8(float (&o)[16], float c, const int4& v) {
    const int w[4] = {v.x, v.y, v.z, v.w};
#pragma unroll
    for (int i = 0; i < 4; ++i) {
        const f32x2_t lo = __builtin_amdgcn_cvt_pk_f32_fp8(w[i], false), hi = __builtin_amdgcn_cvt_pk_f32_fp8(w[i], true);
        o[4 * i] += c * lo.x; o[4 * i + 1] += c * lo.y; o[4 * i + 2] += c * hi.x; o[4 * i + 3] += c * hi.y;
    }
}

__device__ void phase_pu(const Params& p, int l, int slice, int grank, int gsz) {
    const int tid_ = otid(); const int lane = tid_ & 63, wid = tid_ >> 6, sub = lane & 7, pg = lane >> 3;
    const bf16_t* H = (const bf16_t*)(p.ws + OFF_H) + slice * 128 + sub * 16;
    const char* U8 = p.ws + OFF_UB + ((size_t)(l * 8 + slice) * NE) * 128 + sub * 16;
    const int* eidx = (const int*)(p.ws + OFF_Y) + lane;
    float* part = (float*)(p.ws + OFF_Z) + (size_t)slice * T * 128 + 16 * sub + pg;
    const int stride = gsz * 4;
#define PU_ISSUE(e_, u_) do { _Pragma("unroll") for (int q = 0; q < 8; ++q) { const int ej = __shfl(e_, 8 * q + pg); u_[q] = *(const int4*)(U8 + (size_t)ej * 128); } } while (0)
    int tok = grank * 4 + wid;
    if (tok >= T) return;
    int4 uA[8], uB[8];
    int ea = eidx[(size_t)tok * 128], eb = eidx[(size_t)tok * 128 + 64];
    uint4 h0 = *(const uint4*)(H + (size_t)tok * D), h1 = *(const uint4*)(H + (size_t)tok * D + 8);
    PU_ISSUE(ea, uA);
#pragma nounroll
    for (;;) {
        __builtin_amdgcn_sched_barrier(0);
        const int tokn = tok + stride; const bool more = tokn < T;
        int ean = 0, ebn = 0; uint4 h0n = h0, h1n = h1;
        if (more) { ean = eidx[(size_t)tokn * 128]; ebn = eidx[(size_t)tokn * 128 + 64]; h0n = *(const uint4*)(H + (size_t)tokn * D); h1n = *(const uint4*)(H + (size_t)tokn * D + 8); }
        PU_ISSUE(eb, uB);
        __builtin_amdgcn_sched_barrier(0);
        float hf[16];
        { const unsigned w_[8] = {h0.x, h0.y, h0.z, h0.w, h1.x, h1.y, h1.z, h1.w};
#pragma unroll
          for (int i = 0; i < 8; ++i) { hf[2 * i] = bf2f(w_[i] & 0xffffu); hf[2 * i + 1] = bf2f(w_[i] >> 16); } }
        float v[16];
#pragma unroll
        for (int q = 0; q < 8; ++q) v[q] = dot16_fp8(hf, uA[q]);
        __builtin_amdgcn_sched_barrier(0);
        if (more) PU_ISSUE(ean, uA);
        __builtin_amdgcn_sched_barrier(0);
#pragma unroll
        for (int q = 0; q < 8; ++q) v[8 + q] = dot16_fp8(hf, uB[q]);
        float w8[8], w4[4], w2[2];
        { const bool hi = (lane & 4) != 0;
#pragma unroll
          for (int m = 0; m < 8; ++m) { const float send = hi ? v[m] : v[m + 8], keep = hi ? v[m + 8] : v[m]; w8[m] = keep + __shfl_xor(send, 4); } }
        { const bool hi = (lane & 2) != 0;
#pragma unroll
          for (int m = 0; m < 4; ++m) { const float send = hi ? w8[m] : w8[m + 4], keep = hi ? w8[m + 4] : w8[m]; w4[m] = keep + __shfl_xor(send, 2); } }
        { const bool hi = (lane & 1) != 0;
#pragma unroll
          for (int m = 0; m < 2; ++m) { const float send = hi ? w4[m] : w4[m + 2], keep = hi ? w4[m + 2] : w4[m]; w2[m] = keep + __shfl_xor(send, 1); } }
        float* pr = part + (size_t)tok * 128;
        pr[0] = w2[0]; pr[8] = w2[1];
        if (!more) break;
        tok = tokn; ea = ean; eb = ebn; h0 = h0n; h1 = h1n;
    }
#undef PU_ISSUE
}
__device__ void phase_pc(const Params& p, int l, int bid, int nb) {
    const int tid_ = otid(); const int lane = tid_ & 63, wid = tid_ >> 6;
    const int* eidx = (const int*)(p.ws + OFF_Y); const float* gw = (const float*)(p.ws + OFF_Y + (size_t)T * 128 * 4);
    float* coef = (float*)(p.ws + OFF_Y + (size_t)T * 128 * 8);
    const float* part = (const float*)(p.ws + OFF_Z);
    const float* usc = (const float*)(p.ws + OFF_USC) + (size_t)l * NE; const float* vsc = (const float*)(p.ws + OFF_VSC) + (size_t)l * NE;
    for (int tok = bid * 4 + wid; tok < T; tok += nb * 4) {
#pragma unroll
        for (int hh = 0; hh < 2; ++hh) {
            const size_t j = (size_t)tok * 128 + hh * 64 + lane;
            const int e = eidx[j]; const float g = gw[j];
            float a = 0.f;
#pragma unroll
            for (int sl = 0; sl < 8; ++sl) a += part[(size_t)sl * T * 128 + j];
            coef[j] = g * gelu_f(a * usc[e]) * vsc[e];
        }
    }
}
__device__ void phase_pv(const Params& p, int l, int slice, int grank, int gsz) {
    const int tid_ = otid(); const int lane = tid_ & 63, wid = tid_ >> 6, sub = lane & 7, pg = lane >> 3;
    const char* V8 = p.ws + OFF_VB + ((size_t)(l * 8 + slice) * NE) * 128 + sub * 16;
    const int* eidx = (const int*)(p.ws + OFF_Y) + lane;
    const float* coef = (const float*)(p.ws + OFF_Y + (size_t)T * 128 * 8) + lane;
    const int col = slice * 128 + 16 * sub + 2 * pg;
    const float* g2p = (const float*)(p.ws + OFF_MOD) + (size_t)l * NB * 6144 + 5 * D + col;
    bf16_t* xcol = (bf16_t*)(p.ws + OFF_XR) + col;
    const int stride = gsz * 4;
#define PV_ISSUE(e_, c_, v_, cj_) do { _Pragma("unroll") for (int q = 0; q < 8; ++q) { const int ej = __shfl(e_, 8 * q + pg); cj_[q] = __shfl(c_, 8 * q + pg); v_[q] = *(const int4*)(V8 + (size_t)ej * 128); } } while (0)
    int tok = grank * 4 + wid;
    if (tok >= T) return;
    int4 vA[8], vB[8]; float cA[8], cB[8];
    int ea = eidx[(size_t)tok * 128], eb = eidx[(size_t)tok * 128 + 64];
    float ca = coef[(size_t)tok * 128], cb = coef[(size_t)tok * 128 + 64];
    PV_ISSUE(ea, ca, vA, cA);
#pragma nounroll
    for (;;) {
        __builtin_amdgcn_sched_barrier(0);
        const int tokn = tok + stride; const bool more = tokn < T;
        int ean = 0, ebn = 0; float can = 0.f, cbn = 0.f;
        if (more) { ean = eidx[(size_t)tokn * 128]; ebn = eidx[(size_t)tokn * 128 + 64]; can = coef[(size_t)tokn * 128]; cbn = coef[(size_t)tokn * 128 + 64]; }
        unsigned* xp = (unsigned*)(xcol + (size_t)tok * D); const float2 g2 = *(const float2*)(g2p + (size_t)(tok / SEQ) * 6144);
        const unsigned xw = *xp;
        PV_ISSUE(eb, cb, vB, cB);
        __builtin_amdgcn_sched_barrier(0);
        float o[16];
#pragma unroll
        for (int i = 0; i < 16; ++i) o[i] = 0.f;
#pragma unroll
        for (int q = 0; q < 8; ++q) axpy16_fp8(o, cA[q], vA[q]);
        __builtin_amdgcn_sched_barrier(0);
        if (more) PV_ISSUE(ean, can, vA, cA);
        __builtin_amdgcn_sched_barrier(0);
#pragma unroll
        for (int q = 0; q < 8; ++q) axpy16_fp8(o, cB[q], vB[q]);
        float t8[8], t4[4], t2[2];
        { const bool hi = (lane & 32) != 0;
#pragma unroll
          for (int m = 0; m < 8; ++m) { const float send = hi ? o[m] : o[m + 8], keep = hi ? o[m + 8] : o[m]; t8[m] = keep + __shfl_xor(send, 32); } }
        { const bool hi = (lane & 16) != 0;
#pragma unroll
          for (int m = 0; m < 4; ++m) { const float send = hi ? t8[m] : t8[m + 4], keep = hi ? t8[m + 4] : t8[m]; t4[m] = keep + __shfl_xor(send, 16); } }
        { const bool hi = (lane & 8) != 0;
#pragma unroll
          for (int m = 0; m < 2; ++m) { const float send = hi ? t4[m] : t4[m + 2], keep = hi ? t4[m + 2] : t4[m]; t2[m] = keep + __shfl_xor(send, 8); } }
        *xp = pk_bf16(bf2f(xw & 0xffffu) + g2.x * t2[0], bf2f(xw >> 16) + g2.y * t2[1]);
        if (!more) break;
        tok = tokn; ea = ean; eb = ebn; ca = can; cb = cbn;
    }
#undef PV_ISSUE
}
__device__ void phase_final_norm(const Params& p, int bid, int nb) {
    const int tid_ = otid(); const int lane = tid_ & 63, wid = tid_ >> 6;
    for (int tok = bid * 4 + wid; tok < T; tok += nb * 4) {
        float* xr = p.out + (size_t)tok * D;
        const bf16_t* xs = (const bf16_t*)(p.ws + OFF_XR) + (size_t)tok * D;
        float4 v[4]; float ss = 0.f;
#pragma unroll
        for (int i = 0; i < 4; ++i) { const uint2 w = *(const uint2*)(xs + i * 256 + lane * 4); v[i] = make_float4(bf2f(w.x & 0xffffu), bf2f(w.x >> 16), bf2f(w.y & 0xffffu), bf2f(w.y >> 16));
            ss += v[i].x * v[i].x + v[i].y * v[i].y + v[i].z * v[i].z + v[i].w * v[i].w; }
        ss = wave_sum(ss);
        const float rstd = rsqrtf(ss * (1.0f / D) + EPS);
#pragma unroll
        for (int i = 0; i < 4; ++i) { const float4 g = *(const float4*)(p.final_g + i * 256 + lane * 4);
            *(float4*)(xr + i * 256 + lane * 4) = make_float4(v[i].x * rstd * g.x, v[i].y * rstd * g.y, v[i].z * rstd * g.z, v[i].w * rstd * g.w); }
    }
}

#define XB_TMO      128
#define XB_XCNT(j)  (256  + 64 * (j))
#define XB_XSUB(j)  (1280 + 64 * (j))
#define XB_XGEN(j)  (2304 + 64 * (j))
#define XB_TOP      3328
#define XB_TOPGEN   3392
#define XCD_BAR_WORDS 3456
#define XB_SPIN_CAP (1u << 22)
__device__ __forceinline__ unsigned xb_ld(unsigned* p)              { return __hip_atomic_load(p, __ATOMIC_RELAXED, __HIP_MEMORY_SCOPE_AGENT); }
__device__ __forceinline__ unsigned xb_add(unsigned* p, unsigned v) { return __hip_atomic_fetch_add(p, v, __ATOMIC_RELAXED, __HIP_MEMORY_SCOPE_AGENT); }
__device__ __forceinline__ unsigned xb_xcc_id() { return (unsigned)__builtin_amdgcn_s_getreg((3 << 11) | 20) & 0xFu; }
#define XB_SPIN(cond, bar) do { unsigned _sp = 0; while (cond) { __builtin_amdgcn_s_sleep(1); \
    if ((++_sp & 255u) == 0u) { if (xb_ld(&(bar)[XB_TMO])) break; if (_sp > XB_SPIN_CAP) { atomicAdd(&(bar)[XB_TMO], 1u); break; } } } } while (0)
__device__ __forceinline__ void xcd_barrier_post(unsigned* bar, volatile LAS unsigned* st) {
    if (threadIdx.x == 0) { const unsigned x = xb_xcc_id(); st[3] = x; st[2] = xb_add(&bar[XB_XCNT(x)], 1u); }
}
__device__ __forceinline__ void xcd_barrier_complete(unsigned* bar, unsigned x, unsigned& nloc, unsigned& nx) {
    const unsigned G = gridDim.x * gridDim.y * gridDim.z;
    unsigned sum, cnt, mine, sp = 0u;
    for (;;) {
        sum = 0u; cnt = 0u; mine = 0u;
#pragma unroll
        for (unsigned j = 0; j < 16; ++j) { const unsigned c = xb_ld(&bar[XB_XCNT(j)]); sum += c; cnt += (c > 0u) ? 1u : 0u; mine = (j == x) ? c : mine; }
        if (sum == G) break;
        __builtin_amdgcn_s_sleep(1);
        if ((++sp & 255u) == 0u) { if (xb_ld(&bar[XB_TMO])) break; if (sp > XB_SPIN_CAP) { atomicAdd(&bar[XB_TMO], 1u); break; } }
    }
    nloc = mine > 0u ? mine : 1u; nx = cnt > 0u ? cnt : 1u;
}
__device__ __forceinline__ void xcd_barrier(unsigned* bar, volatile LAS unsigned* st) {
    asm volatile("s_waitcnt vmcnt(0)" ::: "memory");
    __syncthreads();
    if (threadIdx.x == 0) {
        __builtin_amdgcn_s_waitcnt(0);
        unsigned nloc = st[0], nx = st[1]; const unsigned x = st[3];
        if (nloc == 0u) { xcd_barrier_complete(bar, x, nloc, nx); st[0] = nloc; st[1] = nx; }
        const unsigned old = xb_add(&bar[XB_XSUB(x)], 1u);
        const unsigned gen = old / nloc;
        if (old + 1u == (gen + 1u) * nloc) {
            __builtin_amdgcn_fence(__ATOMIC_RELEASE, "agent");
            asm volatile("s_waitcnt vmcnt(0)" ::: "memory");
            const unsigned og = xb_add(&bar[XB_TOP], 1u);
            const unsigned tg = og / nx;
            if (og + 1u == (tg + 1u) * nx) xb_add(&bar[XB_TOPGEN], 1u);
            else XB_SPIN(xb_ld(&bar[XB_TOPGEN]) == tg, bar);
            __builtin_amdgcn_fence(__ATOMIC_ACQUIRE, "agent");
            xb_add(&bar[XB_XGEN(x)], 1u);
            asm volatile("s_waitcnt vmcnt(0)" ::: "memory");
        } else {
            XB_SPIN(xb_ld(&bar[XB_XGEN(x)]) == gen, bar);
            __builtin_amdgcn_fence(__ATOMIC_ACQUIRE, "agent");
            asm volatile("s_waitcnt vmcnt(0)" ::: "memory");
        }
    }
    __syncthreads();
}

#if MEGA
#if PROBE_A >= 0
#define TSTAMP(i) do { if (blockIdx.x == 0 && threadIdx.x == 0) ts[i] = __builtin_amdgcn_s_memrealtime(); } while (0)
#else
#define TSTAMP(i) do { } while (0)
#endif
__global__ void __launch_bounds__(256, 2) mega_kernel(Params p) {
    __shared__ __attribute__((aligned(16))) char smem[SMEM_BYTES];
    __shared__ uint4 xb_words;
#if PROBE_A >= 0
    __shared__ unsigned long long ts[26];
#endif
    cg::grid_group grid = cg::this_grid();
    const int bid = blockIdx.x, nb = gridDim.x;
    unsigned* bar = (unsigned*)(p.ws + OFF_BAR);
    if (threadIdx.x == 0) xb_words = make_uint4(0u, 0u, 0u, 0u);
    if (bid == 0) for (int i = threadIdx.x; i < XCD_BAR_WORDS; i += 256) bar[i] = 0u;
    TSTAMP(0);
    phase_prep(p, smem, bid, nb);
    grid.sync();
    volatile LAS unsigned* xst = (volatile LAS unsigned*)&xb_words;
    xcd_barrier_post(bar, xst);
    TSTAMP(1);
    phase_norm<false>(p.x, p.norm1_g, (const float*)(p.ws + OFF_MOD), 0, D, (bf16_t*)(p.ws + OFF_H), bid, nb); xcd_barrier((unsigned*)(p.ws + OFF_BAR), (volatile LAS unsigned*)&xb_words);
    int slice, grank; const int gsz = nb / 8;
    {
        const unsigned myx = xst[3], myrank = xst[2];
        unsigned pre = 0;
#pragma unroll
        for (unsigned j = 0; j < 16; ++j) { const unsigned c = xb_ld(&bar[XB_XCNT(j)]); pre += (j < myx) ? c : 0u; }
        const int gi = __builtin_amdgcn_readfirstlane((int)(pre + myrank));
        slice = gi / gsz; grank = gi % gsz;
    }
#pragma nounroll
    for (int l = 0; l < NL; ++l) {
        TSTAMP(2 + 11 * l); phase_gemm1(p, l, smem, bid, nb); xcd_barrier((unsigned*)(p.ws + OFF_BAR), (volatile LAS unsigned*)&xb_words);
        TSTAMP(3 + 11 * l); phase_mix(p, l, smem, bid, nb); xcd_barrier((unsigned*)(p.ws + OFF_BAR), (volatile LAS unsigned*)&xb_words);
        TSTAMP(4 + 11 * l); phase_fftb(p, l, smem, bid, nb); xcd_barrier((unsigned*)(p.ws + OFF_BAR), (volatile LAS unsigned*)&xb_words);
        TSTAMP(5 + 11 * l); phase_gemm2(p, l, smem, bid, nb); xcd_barrier((unsigned*)(p.ws + OFF_BAR), (volatile LAS unsigned*)&xb_words);
        TSTAMP(6 + 11 * l); phase_norm<true>(p.ws + OFF_XR, p.norm2_g + l * D, (const float*)(p.ws + OFF_MOD) + (size_t)l * NB * 6144, 3 * D, 4 * D, (bf16_t*)(p.ws + OFF_H), bid, nb); xcd_barrier((unsigned*)(p.ws + OFF_BAR), (volatile LAS unsigned*)&xb_words);
        TSTAMP(7 + 11 * l); phase_gemm3(p, l, smem, bid, nb); xcd_barrier((unsigned*)(p.ws + OFF_BAR), (volatile LAS unsigned*)&xb_words);
        TSTAMP(8 + 11 * l); phase_topk(p, l, smem, bid, nb); xcd_barrier((unsigned*)(p.ws + OFF_BAR), (volatile LAS unsigned*)&xb_words);
        TSTAMP(9 + 11 * l); phase_pu(p, l, slice, grank, gsz); xcd_barrier((unsigned*)(p.ws + OFF_BAR), (volatile LAS unsigned*)&xb_words);
        TSTAMP(10 + 11 * l); phase_pc(p, l, bid, nb); xcd_barrier((unsigned*)(p.ws + OFF_BAR), (volatile LAS unsigned*)&xb_words);
        TSTAMP(11 + 11 * l); phase_pv(p, l, slice, grank, gsz); xcd_barrier((unsigned*)(p.ws + OFF_BAR), (volatile LAS unsigned*)&xb_words);
        TSTAMP(12 + 11 * l);
        if (l + 1 < NL) { phase_norm<true>(p.ws + OFF_XR, p.norm1_g + (l + 1) * D, (const float*)(p.ws + OFF_MOD) + (size_t)(l + 1) * NB * 6144, 0, D, (bf16_t*)(p.ws + OFF_H), bid, nb); xcd_barrier((unsigned*)(p.ws + OFF_BAR), (volatile LAS unsigned*)&xb_words); }
        else phase_final_norm(p, bid, nb);
    }
    TSTAMP(24);
#if PROBE_A >= 0
    if (bid == 0 && threadIdx.x == 0) p.out[0] += (float)(ts[PROBE_B] - ts[PROBE_A]) * 0.01f / PROBE_DIV;
#endif
}
#endif

extern "C" void kernel_launch(void* const* d_in, const int* in_sizes, int n_in, void* d_out, int out_size, void* d_ws, size_t ws_size, hipStream_t stream) {
    (void)in_sizes; (void)n_in; (void)out_size;
    if (ws_size < OFF_END) { fprintf(stderr, "workspace too small: %zu < %zu\n", ws_size, (size_t)OFF_END); return; }
    Params p{};
    p.x = (const float*)d_in[0]; p.c = (const float*)d_in[1]; p.mod_w = (const float*)d_in[2]; p.mod_b = (const float*)d_in[3]; p.norm1_g = (const float*)d_in[4];
    p.w_in = (const float*)d_in[5]; p.gmlp_ws = (const float*)d_in[6]; p.gmlp_bs = (const float*)d_in[7]; p.fnet_w = (const float*)d_in[8]; p.fnet_b = (const float*)d_in[9];
    p.gain_a = (const float*)d_in[10]; p.gain_b = (const float*)d_in[11]; p.w_out = (const float*)d_in[12]; p.norm2_g = (const float*)d_in[13]; p.wq = (const float*)d_in[14];
    p.k1 = (const float*)d_in[15]; p.k2 = (const float*)d_in[16]; p.pu = (const float*)d_in[17]; p.pv = (const float*)d_in[18]; p.final_g = (const float*)d_in[19];
    p.out = (float*)d_out; p.ws = (char*)d_ws;
#if MEGA
    static int grid_blocks = 0;
    if (!grid_blocks) {
        int dev = 0, cus = 0, per_cu = 0;
        hipGetDevice(&dev);
        hipDeviceGetAttribute(&cus, hipDeviceAttributeMultiprocessorCount, dev);
        hipOccupancyMaxActiveBlocksPerMultiprocessor(&per_cu, mega_kernel, 256, 0);
        if (per_cu > 2) per_cu = 2;
        grid_blocks = (cus * per_cu) / 8 * 8;
    }
    void* args[] = {&p};
    hipError_t e = hipLaunchCooperativeKernel((void*)mega_kernel, dim3(grid_blocks), dim3(256), args, 0, stream);
    if (e != hipSuccess) fprintf(stderr, "cooperative launch failed: %s (grid %d)\n", hipGetErrorString(e), grid_blocks);
#endif
}
```

```cpp
#include <hip/hip_runtime.h>
#include <hip/hip_cooperative_groups.h>
#include <cstdio>
#include <cstdint>
namespace cg = cooperative_groups;

#ifndef MEGA
#define MEGA 1
#endif
#ifndef PROBE_A
#define PROBE_A -1
#define PROBE_B 0
#define PROBE_DIV 10.0f
#endif

typedef unsigned short bf16_t;
typedef short bf16x8 __attribute__((ext_vector_type(8)));
typedef float f32x4 __attribute__((ext_vector_type(4)));
typedef __bf16 bf16x2_t __attribute__((ext_vector_type(2)));

constexpr int D = 1024, NB = 8, SEQ = 4096, T = NB * SEQ, NL = 2;
constexpr int NZ = 2048;
constexpr int NE = 16384;
constexpr float EPS = 1e-6f;

constexpr size_t OFF_MOD  = 0;
constexpr size_t OFF_W1T  = OFF_MOD  + (size_t)NL * NB * 6144 * 4;
constexpr size_t OFF_W2T  = OFF_W1T  + (size_t)NL * 2048 * 1024 * 2;
constexpr size_t OFF_WQT  = OFF_W2T  + (size_t)NL * 1024 * 1024 * 2;
constexpr size_t OFF_K12  = OFF_WQT  + (size_t)NL * 2048 * 1024 * 2;
constexpr size_t OFF_WSB  = OFF_K12  + (size_t)NL * 8 * 256 * 128 * 2;
constexpr size_t OFF_DA   = OFF_WSB  + (size_t)NL * 8 * 128 * 128 * 2;
constexpr size_t OFF_DB   = OFF_DA   + 128 * 128 * 2;
constexpr size_t OFF_TW   = OFF_DB   + 64 * 128 * 2;
constexpr size_t OFF_SSQA = OFF_TW   + 64 * 64 * 8;
constexpr size_t OFF_SSQB = OFF_SSQA + (size_t)T * 8 * 4;
constexpr size_t OFF_UB   = OFF_SSQB + (size_t)T * 8 * 4;
constexpr size_t OFF_VB   = OFF_UB   + (size_t)NL * NE * 1024;
constexpr size_t OFF_USC  = OFF_VB   + (size_t)NL * NE * 1024;
constexpr size_t OFF_VSC  = OFF_USC  + (size_t)NL * NE * 4;
constexpr size_t OFF_H    = OFF_VSC  + (size_t)NL * NE * 4;
constexpr size_t OFF_Z    = OFF_H    + (size_t)T * 1024 * 2;
constexpr size_t OFF_Y    = OFF_Z    + (size_t)T * 2048 * 2;
constexpr size_t OFF_BAR  = OFF_Y    + (size_t)T * 1024 * 2;
constexpr size_t OFF_XR   = OFF_BAR  + 16384;
constexpr size_t OFF_END  = OFF_XR   + (size_t)T * 1024 * 2;

struct Params {
    const float* x; const float* c; const float* mod_w; const float* mod_b; const float* norm1_g; const float* w_in;
    const float* gmlp_ws; const float* gmlp_bs; const float* fnet_w; const float* fnet_b; const float* gain_a; const float* gain_b;
    const float* w_out; const float* norm2_g; const float* wq; const float* k1; const float* k2; const float* pu; const float* pv; const float* final_g;
    float* out; char* ws;
};

constexpr int SMEM_BYTES = 73984;

__device__ __forceinline__ float bf2f(unsigned v) { return __uint_as_float(v << 16); }
typedef float f32x2_t __attribute__((ext_vector_type(2)));
__device__ __forceinline__ unsigned pk_bf16(float lo, float hi) { const f32x2_t v = {lo, hi}; return __builtin_bit_cast(unsigned, __builtin_convertvector(v, bf16x2_t)); }
__device__ __forceinline__ bf16_t f2bf(float f) { return (bf16_t)(pk_bf16(f, 0.f) & 0xffffu); }
__device__ __forceinline__ float gelu_f(float v) {
    const float t = __builtin_amdgcn_rcpf(fabsf(v) * 0.2316418882f + 1.0f);
    float q = t * 0.5307027145f + (-0.7265760135f); q = q * t + 0.7107068705f; q = q * t + (-0.142248368f); q = q * t + 0.127414796f; q = q * t;
    const float m = v * (q * __builtin_amdgcn_exp2f(v * v * (-0.72134752044f)));
    return v < 0.f ? m : v - m;
}
__device__ __forceinline__ int med3i(int a, int b, int c) { return max(min(a, b), min(max(a, b), c)); }
__device__ __forceinline__ int f2key(float f) { int b = __float_as_int(f); return b ^ ((b >> 31) & 0x7fffffff); }
__device__ __forceinline__ float key2f(int k) { return __int_as_float(k ^ ((k >> 31) & 0x7fffffff)); }
__device__ __forceinline__ float wave_sum(float v) {
#pragma unroll
    for (int o = 32; o >= 1; o >>= 1) v += __shfl_xor(v, o);
    return v;
}
__device__ __forceinline__ int otid() { int t = threadIdx.x; asm volatile("" : "+v"(t)); return t; }
#define MFMA16(a, b, c) __builtin_amdgcn_mfma_f32_16x16x32_bf16((a), (b), (c), 0, 0, 0)

__device__ void transpose_tile(const float* __restrict__ src, int ld, int k0, int n0, bf16_t* __restrict__ dst  , int dn0,
                               const float* __restrict__ kscale, float* tile  ) {
    const int tid = otid();
#pragma unroll
    for (int i = 0; i < 4; ++i) {
        const int r = (tid >> 4) + 16 * i, c4 = (tid & 15) * 4;
        const float4 v = *(const float4*)(src + (size_t)(k0 + r) * ld + n0 + c4);
        const float s = kscale ? kscale[k0 + r] : 1.0f;
        tile[r * 65 + c4 + 0] = v.x * s; tile[r * 65 + c4 + 1] = v.y * s; tile[r * 65 + c4 + 2] = v.z * s; tile[r * 65 + c4 + 3] = v.w * s;
    }
    __syncthreads();
    {
        const int n = tid >> 2, ks = (tid & 3) * 16;
        unsigned w[8];
#pragma unroll
        for (int j = 0; j < 8; ++j) w[j] = pk_bf16(tile[(ks + 2 * j) * 65 + n], tile[(ks + 2 * j + 1) * 65 + n]);
        uint4* d = (uint4*)(dst + (size_t)(dn0 + n) * 1024 + k0 + ks);
        d[0] = make_uint4(w[0], w[1], w[2], w[3]); d[1] = make_uint4(w[4], w[5], w[6], w[7]);
    }
    __syncthreads();
}

__device__ void phase_prep(const Params& p, char* smem, int bid_, int nb_) {
    const int tid = otid();
    char* ws = p.ws;
    const bool convgrp = (nb_ >= 2) && (bid_ & 1);
    const int bid = (nb_ >= 2) ? (bid_ >> 1) : bid_, nb = (nb_ >= 2) ? ((nb_ + 1 - (bid_ & 1)) >> 1) : nb_;
    const int gtid = bid * 256 + tid, gsz = nb * 256;
    if (!convgrp) {
    {
        float* sc = (float*)smem;
        float* red = (float*)(smem + 32768);
        for (int i = tid; i < 8192; i += 256) { const float v = p.c[i]; sc[i] = v / (1.0f + __expf(-v)); }
        __syncthreads();
        float* mod = (float*)(ws + OFF_MOD);
        for (int item = bid; item < NL * 192; item += nb) {
            const int l = item / 192, n0 = (item % 192) * 32, nn = tid & 31, kq = tid >> 5;
            float acc[8];
#pragma unroll
            for (int b = 0; b < 8; ++b) acc[b] = 0.f;
            const float* W = p.mod_w + (size_t)l * 1024 * 6144 + n0 + nn;
#pragma nounroll
            for (int k0 = kq; k0 < 1024; k0 += 128) {
                float w[16];
#pragma unroll
                for (int u = 0; u < 16; ++u) w[u] = W[(size_t)(k0 + 8 * u) * 6144];
#pragma unroll
                for (int u = 0; u < 16; ++u)
#pragma unroll
                    for (int b = 0; b < 8; ++b) acc[b] += sc[b * 1024 + k0 + 8 * u] * w[u];
            }
#pragma unroll
            for (int b = 0; b < 8; ++b) red[(kq * 8 + b) * 32 + nn] = acc[b];
            __syncthreads();
            {
                const int b = tid >> 5;
                float s = 0.f;
#pragma unroll
                for (int q = 0; q < 8; ++q) s += red[(q * 8 + b) * 32 + nn];
                mod[((size_t)l * NB + b) * 6144 + n0 + nn] = s + p.mod_b[l * 6144 + n0 + nn];
            }
            __syncthreads();
        }
    }
    {
        float* tile = (float*)smem;
        for (int item = bid; item < NL * 1024; item += nb) {
            const int l = item / 1024, r = item % 1024;
            if (r < 256) {
                const int kt = r / 16, nt = r % 16;
                transpose_tile(p.w_in + (size_t)l * 1024 * 1536, 1536, kt * 64, nt * 64, (bf16_t*)(ws + OFF_W1T) + (size_t)l * 2048 * 1024, nt * 64, nullptr, tile);
            } else if (r < 512) {
                const int rr = r - 256, kt = rr / 16, nt = rr % 16;
                const float* gk = (kt < 8) ? (p.gain_a + l * 512) : (p.gain_b + l * 512 - 512);
                transpose_tile(p.w_out + (size_t)l * 1024 * 1024, 1024, kt * 64, nt * 64, (bf16_t*)(ws + OFF_W2T) + (size_t)l * 1024 * 1024, nt * 64, gk, tile);
            } else {
                const int rr = r - 512, kt = rr / 32, nt = rr % 32;
                transpose_tile(p.wq + (size_t)l * 1024 * 2048, 2048, kt * 64, nt * 64, (bf16_t*)(ws + OFF_WQT) + (size_t)l * 2048 * 1024, nt * 64, nullptr, tile);
            }
        }
    }
    {
        float* fws = (float*)smem;
        float* Ms  = (float*)(smem + 16384);
        float* wt  = (float*)(smem + 49152);
        float* cs  = (float*)(smem + 49152 + 16640);
        for (int item = bid; item < NL * 8 * 16; item += nb) {
            const int l = item / 128, g = (item % 128) / 16, kt = item % 16;
            if (tid < 64) { float s, c; sincospif((float)tid / 32.0f, &s, &c); cs[tid] = c; cs[64 + tid] = s; }
            for (int i = tid; i < 4096; i += 256) fws[i] = p.fnet_w[((size_t)l * 8 + g) * 4096 + i];
#pragma unroll
            for (int i = 0; i < 4; ++i) {
                const int r = (tid >> 4) + 16 * i, c4 = (tid & 15) * 4;
                const float4 v = *(const float4*)(p.w_in + (size_t)l * 1024 * 1536 + (size_t)(kt * 64 + r) * 1536 + 1024 + g * 64 + c4);
                wt[r * 65 + c4] = v.x; wt[r * 65 + c4 + 1] = v.y; wt[r * 65 + c4 + 2] = v.z; wt[r * 65 + c4 + 3] = v.w;
            }
            __syncthreads();
            {
                const int d = tid >> 2, r0 = (tid & 3) * 32;
                const bool im = r0 >= 64; const int e0 = r0 & 63;
                float acc[32];
#pragma unroll
                for (int e = 0; e < 32; ++e) acc[e] = 0.f;
                for (int j = 0; j < 64; ++j) {
                    const int ph = (d * j) & 63;
                    const float t = im ? -cs[64 + ph] : cs[ph];
#pragma unroll
                    for (int e = 0; e < 32; ++e) acc[e] += t * fws[j * 64 + e0 + e];
                }
#pragma unroll
                for (int e = 0; e < 32; ++e) Ms[d * 128 + r0 + e] = acc[e];
            }
            __syncthreads();
            {
                const int r = tid >> 1, kk0 = (tid & 1) * 32;
                float acc[32];
#pragma unroll
                for (int k = 0; k < 32; ++k) acc[k] = 0.f;
                for (int d = 0; d < 64; ++d) {
                    const float m = Ms[d * 128 + r];
#pragma unroll
                    for (int k = 0; k < 32; ++k) acc[k] += wt[(kk0 + k) * 65 + d] * m;
                }
                bf16_t* dst = (bf16_t*)(ws + OFF_W1T) + (size_t)l * 2048 * 1024 + (size_t)(1024 + g * 128 + r) * 1024 + kt * 64 + kk0;
#pragma unroll
                for (int q = 0; q < 4; ++q)
                    ((uint4*)dst)[q] = make_uint4(pk_bf16(acc[q * 8], acc[q * 8 + 1]), pk_bf16(acc[q * 8 + 2], acc[q * 8 + 3]), pk_bf16(acc[q * 8 + 4], acc[q * 8 + 5]), pk_bf16(acc[q * 8 + 6], acc[q * 8 + 7]));
            }
            __syncthreads();
        }
    }
    {
        bf16_t* k12 = (bf16_t*)(ws + OFF_K12);
        for (int i = gtid; i < NL * 8 * 256 * 128; i += gsz) {
            const int d = i & 127, n = (i >> 7) & 255, h = (i >> 15) & 7, l = i >> 18;
            const float* src = (n < 128) ? p.k1 : p.k2;
            k12[i] = f2bf(src[(((size_t)l * 8 + h) * 128 + (n & 127)) * 128 + d]);
        }
        bf16_t* wsb = (bf16_t*)(ws + OFF_WSB);
        for (int i = gtid; i < NL * 8 * 128 * 128; i += gsz) wsb[i] = f2bf(p.gmlp_ws[i]);
        bf16_t* DA = (bf16_t*)(ws + OFF_DA);
        for (int i = gtid; i < 128 * 128; i += gsz) {
            const int m = i >> 7, kk = i & 127, ro = m >> 6, k1 = m & 63, ri = kk >> 6, a = kk & 63;
            float s, c; sincospif((float)((a * k1) & 63) / 32.0f, &s, &c);
            const float v = (ro == ri) ? c : (ro == 0 ? s : -s);
            DA[i] = f2bf(v);
        }
        bf16_t* DB = (bf16_t*)(ws + OFF_DB);
        for (int i = gtid; i < 64 * 128; i += gsz) {
            const int k2 = i >> 7, kk = i & 127, ri = kk >> 6, b = kk & 63;
            float s, c; sincospif((float)((b * k2) & 63) / 32.0f, &s, &c);
            DB[i] = f2bf(ri ? s : c);
        }
        float2* tw = (float2*)(ws + OFF_TW);
        for (int i = gtid; i < 64 * 64; i += gsz) {
            const int bp = i >> 6, k1 = i & 63;
            float s, c; sincospif((float)(bp * k1) / 2048.0f, &s, &c);
            tw[i] = make_float2(c, s);
        }
    }
    }
    if (convgrp || nb_ < 2) {
        {
            const int lane = tid & 63, wv = gtid >> 6, nwv = gsz >> 6;
            const int R = 2 * NL * NE;
#pragma nounroll
            for (int r0 = wv; r0 < R; r0 += 4 * nwv) {
                float4 v[4][4];
#pragma unroll
                for (int t = 0; t < 4; ++t) {
                    const int r = (r0 + t * nwv < R) ? r0 + t * nwv : r0;
                    const int tbl = r / (NL * NE), row = r % (NL * NE);
                    const float* src = (tbl ? p.pv : p.pu) + (size_t)row * 1024 + lane * 16;
#pragma unroll
                    for (int i = 0; i < 4; ++i) v[t][i] = ((const float4*)src)[i];
                }
#pragma unroll
                for (int t = 0; t < 4; ++t) {
                    const int r = r0 + t * nwv;
                    if (r >= R) break;
                    const int tbl = r / (NL * NE), row = r % (NL * NE);
                    float m = 0.f;
#pragma unroll
                    for (int i = 0; i < 4; ++i) m = fmaxf(m, fmaxf(fmaxf(fabsf(v[t][i].x), fabsf(v[t][i].y)), fmaxf(fabsf(v[t][i].z), fabsf(v[t][i].w))));
#pragma unroll
                    for (int o = 32; o >= 1; o >>= 1) m = fmaxf(m, __shfl_xor(m, o));
                    const float sc = (m > 0.f) ? 256.0f / m : 1.0f, inv = (m > 0.f) ? m * (1.0f / 256.0f) : 1.0f;
                    int w[4];
#pragma unroll
                    for (int i = 0; i < 4; ++i) { w[i] = __builtin_amdgcn_cvt_pk_fp8_f32(v[t][i].x * sc, v[t][i].y * sc, 0, false); w[i] = __builtin_amdgcn_cvt_pk_fp8_f32(v[t][i].z * sc, v[t][i].w * sc, w[i], true); }
                    const int lyr = row / NE, ex = row % NE;
                    *(int4*)(ws + (tbl ? OFF_VB : OFF_UB) + ((size_t)(lyr * 8 + (lane >> 3)) * NE + ex) * 128 + (lane & 7) * 16) = make_int4(w[0], w[1], w[2], w[3]);
                    if (lane == 0) ((float*)(ws + (tbl ? OFF_VSC : OFF_USC)))[row] = inv;
                }
            }
        }
    }
}

template <bool SRC_BF16>
__device__ void phase_norm(const void* __restrict__ xsrc_, const float* __restrict__ g, const float* __restrict__ modl  , int sh_off, int scl_off,
                           bf16_t* __restrict__ hout, int bid, int nb) {
    const int tid_ = otid(); const int lane = tid_ & 63, wid = tid_ >> 6;
    for (int tok = bid * 4 + wid; tok < T; tok += nb * 4) {
        const int b = tok / SEQ;
        float4 v[4];
        float ss = 0.f;
#pragma unroll
        for (int i = 0; i < 4; ++i) {
            if (SRC_BF16) { const uint2 w = *(const uint2*)((const bf16_t*)xsrc_ + (size_t)tok * D + i * 256 + lane * 4); v[i] = make_float4(bf2f(w.x & 0xffffu), bf2f(w.x >> 16), bf2f(w.y & 0xffffu), bf2f(w.y >> 16)); }
            else v[i] = *(const float4*)((const float*)xsrc_ + (size_t)tok * D + i * 256 + lane * 4);
            ss += v[i].x * v[i].x + v[i].y * v[i].y + v[i].z * v[i].z + v[i].w * v[i].w;
        }
        ss = wave_sum(ss);
        const float rstd = rsqrtf(ss * (1.0f / D) + EPS);
        const float* mb = modl + (size_t)b * 6144;
#pragma unroll
        for (int i = 0; i < 4; ++i) {
            const int cidx = i * 256 + lane * 4;
            const float4 gg = *(const float4*)(g + cidx), sh = *(const float4*)(mb + sh_off + cidx), sc = *(const float4*)(mb + scl_off + cidx);
            const float o0 = v[i].x * rstd * gg.x * (1.0f + sc.x) + sh.x, o1 = v[i].y * rstd * gg.y * (1.0f + sc.y) + sh.y;
            const float o2 = v[i].z * rstd * gg.z * (1.0f + sc.z) + sh.z, o3 = v[i].w * rstd * gg.w * (1.0f + sc.w) + sh.w;
            *(uint2*)(hout + (size_t)tok * D + cidx) = make_uint2(pk_bf16(o0, o1), pk_bf16(o2, o3));
        }
    }
}

#define LAS __attribute__((address_space(3)))
template <class Epi, class MidK>
__device__ __forceinline__ void gemm_tile(const bf16_t* __restrict__ A, int lda, const bf16_t* __restrict__ Bt, int ldb, int K, int m0, int n0,
                                          char* smem, const Epi& epi, const MidK& midk, int kmid) {
    const int tid = otid(), lane = tid & 63, wid = tid >> 6, wr = wid >> 1, wc = wid & 1, fr = lane & 15, fq = lane >> 4;
    LAS char* lds = (LAS char*)smem;
    f32x4 acc[4][4];
#pragma unroll
    for (int i = 0; i < 4; ++i)
#pragma unroll
        for (int j = 0; j < 4; ++j) acc[i][j] = (f32x4){0.f, 0.f, 0.f, 0.f};
    const int prow = lane >> 3, pch = (lane & 7) ^ prow;
    const bf16_t* ga = A + (size_t)(m0 + wid * 32 + prow) * lda + pch * 8;
    const bf16_t* gb = Bt + (size_t)(n0 + wid * 32 + prow) * ldb + pch * 8;
    const int nk = K / 64;
#define GEMM_STAGE(kt_, buf_) do { _Pragma("unroll") for (int i_ = 0; i_ < 4; ++i_) { \
        __builtin_amdgcn_global_load_lds((const unsigned*)(ga + (size_t)(i_ * 8) * lda + (kt_) * 64), (LAS unsigned*)(lds + (buf_) * 16384 + (wid * 32 + i_ * 8) * 128), 16, 0, 0); \
        __builtin_amdgcn_global_load_lds((const unsigned*)(gb + (size_t)(i_ * 8) * ldb + (kt_) * 64), (LAS unsigned*)(lds + 32768 + (buf_) * 16384 + (wid * 32 + i_ * 8) * 128), 16, 0, 0); } } while (0)
    GEMM_STAGE(0, 0);
    const int swz = fr & 7;
    for (int kt = 0; kt < nk; ++kt) {
        const int cur = kt & 1;
        asm volatile("s_waitcnt vmcnt(0)" ::: "memory");
        __syncthreads();
        if (kt + 1 < nk) GEMM_STAGE(kt + 1, cur ^ 1);
        if (kt == kmid) {
#pragma unroll
            for (int i = 0; i < 4; ++i) { const float sc = midk(m0 + wr * 64 + i * 16 + fr);
#pragma unroll
                for (int j = 0; j < 4; ++j) acc[i][j] *= sc; }
        }
        const LAS char* ca = lds + cur * 16384; const LAS char* cb = lds + 32768 + cur * 16384;
#pragma unroll
        for (int ks = 0; ks < 2; ++ks) {
            bf16x8 af[4], bfr[4];
            const int coff = ((ks * 4 + fq) ^ swz) * 16;
#pragma unroll
            for (int i = 0; i < 4; ++i) af[i] = *(const LAS bf16x8*)(ca + (wr * 64 + i * 16 + fr) * 128 + coff);
#pragma unroll
            for (int j = 0; j < 4; ++j) bfr[j] = *(const LAS bf16x8*)(cb + (wc * 64 + j * 16 + fr) * 128 + coff);
#pragma unroll
            for (int i = 0; i < 4; ++i)
#pragma unroll
                for (int j = 0; j < 4; ++j) acc[i][j] = MFMA16(bfr[j], af[i], acc[i][j]);
        }
    }
#undef GEMM_STAGE
    __syncthreads();
    {
        LAS char* stg = lds + wid * 17408;
#pragma unroll
        for (int i = 0; i < 4; ++i)
#pragma unroll
            for (int j = 0; j < 4; ++j) *(LAS f32x4*)(stg + (i * 16 + fr) * 272 + (j * 16 + fq * 4) * 4) = acc[i][j];
        const int er = lane >> 3, ec = (lane & 7) * 8;
#pragma unroll
        for (int t = 0; t < 8; ++t) {
            const f32x4 v0 = *(const LAS f32x4*)(stg + (t * 8 + er) * 272 + ec * 4), v1 = *(const LAS f32x4*)(stg + (t * 8 + er) * 272 + ec * 4 + 16);
            epi(m0 + wr * 64 + t * 8 + er, n0 + wc * 64 + ec, v0, v1);
            __builtin_amdgcn_sched_barrier(0);
        }
    }
    __syncthreads();
}
__device__ __forceinline__ void glds16(const void* g, unsigned lds_addr) {
    unsigned sv_;
    asm volatile("s_mov_b32 %0, m0\n\ts_mov_b32 m0, %2\n\tglobal_load_lds_dwordx4 %1, off\n\ts_mov_b32 m0, %0" : "=&s"(sv_) : "v"(g), "s"(lds_addr) : "memory");
}
template <class Epi, class MidK>
__device__ __forceinline__ void gemm_tile256(const bf16_t* __restrict__ A, int lda, const bf16_t* __restrict__ Bt, int ldb, int K, int m0, int n0,
                                             char* smem, const Epi& epi, const MidK& midk, int kmid) {
    const int tid = otid(), lane = tid & 63, wid = tid >> 6, wr = wid >> 1, wc = wid & 1, fr = lane & 15, fq = lane >> 4;
    LAS char* lds = (LAS char*)smem;
    f32x4 acc[8][4];
#pragma unroll
    for (int i = 0; i < 8; ++i)
#pragma unroll
        for (int j = 0; j < 4; ++j) acc[i][j] = (f32x4){0.f, 0.f, 0.f, 0.f};
    const int prow = lane >> 2, pch = (lane & 3) ^ (((lane >> 4) & 1) << 1);
    const bf16_t* ga = A + (size_t)(m0 + wid * 64 + prow) * lda + pch * 8;
    const bf16_t* gb = Bt + (size_t)(n0 + wid * 32 + prow) * ldb + pch * 8;
    const int nk = K / 32;
    const unsigned la = __builtin_amdgcn_readfirstlane((unsigned)(size_t)lds + wid * 4096), lb = __builtin_amdgcn_readfirstlane((unsigned)(size_t)lds + 16384 + wid * 2048);
#define G256_STAGE(kt_, ST_) do { \
        _Pragma("unroll") for (int i_ = 0; i_ < 4; ++i_) glds16(ga + (size_t)(i_ * 16) * lda + (kt_) * 32, la + (ST_) * 24576 + i_ * 1024); \
        _Pragma("unroll") for (int i_ = 0; i_ < 2; ++i_) glds16(gb + (size_t)(i_ * 16) * ldb + (kt_) * 32, lb + (ST_) * 24576 + i_ * 1024); } while (0)
    G256_STAGE(0, 0);
    G256_STAGE(1, 1);
    const int coff = (fq ^ (((fr >> 2) & 1) << 1)) * 16;
#define G256_STEP(kt_, CUR_, NXT_) do { \
        if ((kt_) + 1 < nk) asm volatile("s_waitcnt vmcnt(6)" ::: "memory"); else asm volatile("s_waitcnt vmcnt(0)" ::: "memory"); \
        __builtin_amdgcn_s_barrier(); \
        asm volatile("" ::: "memory"); \
        if ((kt_) + 2 < nk) G256_STAGE((kt_) + 2, NXT_); \
        if ((kt_) == kmid) { \
            _Pragma("unroll") for (int i = 0; i < 8; ++i) { const float sc = midk(m0 + wr * 128 + i * 16 + fr); \
                _Pragma("unroll") for (int j = 0; j < 4; ++j) acc[i][j] *= sc; } } \
        const LAS char* ca = lds + (CUR_) * 24576 + coff; const LAS char* cb = ca + 16384; \
        bf16x8 bfr[4], af[8]; \
        _Pragma("unroll") for (int j = 0; j < 4; ++j) bfr[j] = *(const LAS bf16x8*)(cb + (wc * 64 + j * 16 + fr) * 64); \
        _Pragma("unroll") for (int i = 0; i < 8; ++i) af[i] = *(const LAS bf16x8*)(ca + (wr * 128 + i * 16 + fr) * 64); \
        __builtin_amdgcn_sched_barrier(0); \
        _Pragma("unroll") for (int i = 0; i < 8; ++i) \
            _Pragma("unroll") for (int j = 0; j < 4; ++j) acc[i][j] = MFMA16(bfr[j], af[i], acc[i][j]); \
        __builtin_amdgcn_sched_barrier(0); } while (0)
#pragma nounroll
    for (int kt = 0; kt < nk; kt += 3) {
        G256_STEP(kt, 0, 2);
        if (kt + 1 < nk) G256_STEP(kt + 1, 1, 0);
        if (kt + 2 < nk) G256_STEP(kt + 2, 2, 1);
    }
#undef G256_STEP
#undef G256_STAGE
#pragma unroll
    for (int hb = 0; hb < 2; ++hb) {
        __syncthreads();
        LAS char* stg = lds + wid * 17408;
#pragma unroll
        for (int i = 0; i < 4; ++i)
#pragma unroll
            for (int j = 0; j < 4; ++j) *(LAS f32x4*)(stg + (i * 16 + fr) * 272 + (j * 16 + fq * 4) * 4) = acc[hb * 4 + i][j];
        const int er = lane >> 3, ec = (lane & 7) * 8;
#pragma unroll
        for (int t = 0; t < 8; ++t) {
            const f32x4 v0 = *(const LAS f32x4*)(stg + (t * 8 + er) * 272 + ec * 4), v1 = *(const LAS f32x4*)(stg + (t * 8 + er) * 272 + ec * 4 + 16);
            epi(m0 + wr * 128 + hb * 64 + t * 8 + er, n0 + wc * 64 + ec, v0, v1);
            __builtin_amdgcn_sched_barrier(0);
        }
    }
    __syncthreads();
}
__device__ __forceinline__ bool tile_of(int round, int bid, int nb, int MT, int NT, int& mt, int& nt) {
    if (nb == 512) {
        const int x = bid & 7, r = bid >> 3, st = x + 8 * round, snt = NT >> 3;
        if (st >= (MT >> 3) * snt) return false;
        mt = (st / snt) * 8 + (r >> 3); nt = (st % snt) * 8 + (r & 7);
        return true;
    }
    const int item = bid + round * nb;
    if (item >= MT * NT) return false;
    mt = item / NT; nt = item % NT;
    return true;
}
struct NoMid { __device__ __forceinline__ float operator()(int) const { return 1.0f; } };

__device__ void phase_gemm1(const Params& p, int l, char* smem, int bid, int nb) {
    const bf16_t* A = (const bf16_t*)(p.ws + OFF_H);
    const bf16_t* Bt = (const bf16_t*)(p.ws + OFF_W1T) + (size_t)l * 2048 * 1024;
    bf16_t* Z = (bf16_t*)(p.ws + OFF_Z);
    auto epi_gelu = [&](int row, int col, const f32x4& a, const f32x4& b) {
        *(uint4*)(Z + (size_t)row * NZ + col) = make_uint4(pk_bf16(gelu_f(a[0]), gelu_f(a[1])), pk_bf16(gelu_f(a[2]), gelu_f(a[3])), pk_bf16(gelu_f(b[0]), gelu_f(b[1])), pk_bf16(gelu_f(b[2]), gelu_f(b[3])));
    };
    auto epi_plain = [&](int row, int col, const f32x4& a, const f32x4& b) {
        *(uint4*)(Z + (size_t)row * NZ + col) = make_uint4(pk_bf16(a[0], a[1]), pk_bf16(a[2], a[3]), pk_bf16(b[0], b[1]), pk_bf16(b[2], b[3]));
    };
    const int NT = NZ / 128, MT = T / 256;
    int mt, nt;
    for (int round = 0; tile_of(round, bid, nb, MT, NT, mt, nt); ++round) {
        const int n0 = nt * 128;
        if (n0 < 1024) gemm_tile256(A, D, Bt, D, D, mt * 256, n0, smem, epi_gelu, NoMid(), -1);
        else           gemm_tile256(A, D, Bt, D, D, mt * 256, n0, smem, epi_plain, NoMid(), -1);
    }
}
__device__ void phase_gemm2(const Params& p, int l, char* smem, int bid, int nb) {
    const bf16_t* A = (const bf16_t*)(p.ws + OFF_Y);
    const bf16_t* Bt = (const bf16_t*)(p.ws + OFF_W2T) + (size_t)l * 1024 * 1024;
    const float* ssa = (const float*)(p.ws + OFF_SSQA); const float* ssb = (const float*)(p.ws + OFF_SSQB);
    const float* mod = (const float*)(p.ws + OFF_MOD) + (size_t)l * NB * 6144;
    bf16_t* XR = (bf16_t*)(p.ws + OFF_XR);
    auto rstd_of = [&](const float* s, int row) {
        const float4 a = *(const float4*)(s + (size_t)row * 8), b = *(const float4*)(s + (size_t)row * 8 + 4);
        return rsqrtf(((a.x + a.y) + (a.z + a.w) + (b.x + b.y) + (b.z + b.w)) * (1.0f / 512.0f) + EPS);
    };
    auto midk = [&](int row) { return rstd_of(ssa, row) / rstd_of(ssb, row); };
    auto epi = [&](int row, int col, const f32x4& a, const f32x4& c) {
        const float rb = rstd_of(ssb, row);
        const int b = row / SEQ;
        const float4 g0 = *(const float4*)(mod + (size_t)b * 6144 + 2 * D + col), g1 = *(const float4*)(mod + (size_t)b * 6144 + 2 * D + col + 4);
        float x[8];
        if (l == 0) { const float4 x0 = *(const float4*)(p.x + (size_t)row * D + col), x1 = *(const float4*)(p.x + (size_t)row * D + col + 4);
            x[0] = x0.x; x[1] = x0.y; x[2] = x0.z; x[3] = x0.w; x[4] = x1.x; x[5] = x1.y; x[6] = x1.z; x[7] = x1.w; }
        else { const uint4 w = *(const uint4*)(XR + (size_t)row * D + col);
            x[0] = bf2f(w.x & 0xffffu); x[1] = bf2f(w.x >> 16); x[2] = bf2f(w.y & 0xffffu); x[3] = bf2f(w.y >> 16); x[4] = bf2f(w.z & 0xffffu); x[5] = bf2f(w.z >> 16); x[6] = bf2f(w.w & 0xffffu); x[7] = bf2f(w.w >> 16); }
        *(uint4*)(XR + (size_t)row * D + col) = make_uint4(pk_bf16(x[0] + g0.x * rb * a[0], x[1] + g0.y * rb * a[1]), pk_bf16(x[2] + g0.z * rb * a[2], x[3] + g0.w * rb * a[3]),
                                                           pk_bf16(x[4] + g1.x * rb * c[0], x[5] + g1.y * rb * c[1]), pk_bf16(x[6] + g1.z * rb * c[2], x[7] + g1.w * rb * c[3]));
    };
    const int NT = D / 128, MT = T / 256;
    int mt, nt;
    for (int round = 0; tile_of(round, bid, nb, MT, NT, mt, nt); ++round) gemm_tile256(A, D, Bt, D, D, mt * 256, nt * 128, smem, epi, midk, 16);
}
__device__ void phase_gemm3(const Params& p, int l, char* smem, int bid, int nb) {
    const bf16_t* A = (const bf16_t*)(p.ws + OFF_H);
    const bf16_t* Bt = (const bf16_t*)(p.ws + OFF_WQT) + (size_t)l * 2048 * 1024;
    bf16_t* Q = (bf16_t*)(p.ws + OFF_Z);
    auto epi = [&](int row, int col, const f32x4& a, const f32x4& b) { *(uint4*)(Q + (size_t)row * 2048 + col) = make_uint4(pk_bf16(a[0], a[1]), pk_bf16(a[2], a[3]), pk_bf16(b[0], b[1]), pk_bf16(b[2], b[3])); };
    const int NT = 2048 / 128, MT = T / 256;
    int mt, nt;
    for (int round = 0; tile_of(round, bid, nb, MT, NT, mt, nt); ++round) gemm_tile256(A, D, Bt, D, D, mt * 256, nt * 128, smem, epi, NoMid(), -1);
}

constexpr int TP = 136;
__device__ __forceinline__ void stage_transposed(const bf16_t* __restrict__ base, size_t row_stride, bf16_t* dT) {
    const int tid = otid(), r = tid >> 2, part = tid & 3, ri = part >> 1, c0 = (part & 1) * 32;
    const uint4* src = (const uint4*)(base + (size_t)r * row_stride + ri * 64 + c0);
    uint4 v[4];
#pragma unroll
    for (int i = 0; i < 4; ++i) v[i] = src[i];
#pragma unroll
    for (int i = 0; i < 4; ++i) {
        const unsigned w[4] = {v[i].x, v[i].y, v[i].z, v[i].w};
#pragma unroll
        for (int j = 0; j < 4; ++j) {
            dT[(c0 + i * 8 + j * 2) * TP + ri * 64 + r] = (bf16_t)(w[j] & 0xffffu);
            dT[(c0 + i * 8 + j * 2 + 1) * TP + ri * 64 + r] = (bf16_t)(w[j] >> 16);
        }
    }
}

__device__ void gmlp_item(const Params& p, int l, int item, char* smem) {
    const int tid = otid(), lane = tid & 63, wid = tid >> 6, fr = lane & 15, fq = lane >> 4;
    const int h = item & 7, c = (item >> 3) & 31, b = item >> 8;
    const int tok0 = b * SEQ + c * 128;
    bf16_t* vnT = (bf16_t*)smem;
    const bf16_t* Z = (const bf16_t*)(p.ws + OFF_Z);
    {
        const int q = tid >> 1, half = tid & 1, d0 = half * 32;
        const uint4* src = (const uint4*)(Z + (size_t)(tok0 + q) * NZ + 512 + h * 64 + d0);
        float f[32];
#pragma unroll
        for (int i = 0; i < 4; ++i) { const uint4 v = src[i]; const unsigned w[4] = {v.x, v.y, v.z, v.w};
#pragma unroll
            for (int j = 0; j < 4; ++j) { f[i * 8 + j * 2] = bf2f(w[j] & 0xffffu); f[i * 8 + j * 2 + 1] = bf2f(w[j] >> 16); } }
        float s = 0.f;
#pragma unroll
        for (int i = 0; i < 32; ++i) s += f[i];
        s += __shfl_xor(s, 1);
        const float mean = s * (1.0f / 64.0f);
        float qv = 0.f;
#pragma unroll
        for (int i = 0; i < 32; ++i) { f[i] -= mean; qv += f[i] * f[i]; }
        qv += __shfl_xor(qv, 1);
        const float rstd = rsqrtf(qv * (1.0f / 64.0f) + EPS);
#pragma unroll
        for (int i = 0; i < 32; ++i) vnT[(d0 + i) * TP + q] = f2bf(f[i] * rstd);
    }
    __syncthreads();
    const bf16_t* Wsb = (const bf16_t*)(p.ws + OFF_WSB) + ((size_t)l * 8 + h) * 128 * 128;
    f32x4 acc[2][4];
#pragma unroll
    for (int i = 0; i < 2; ++i)
#pragma unroll
        for (int j = 0; j < 4; ++j) acc[i][j] = (f32x4){0.f, 0.f, 0.f, 0.f};
    const int p0 = wid * 32;
#pragma unroll
    for (int ks = 0; ks < 4; ++ks) {
        bf16x8 af[2], bfr[4];
#pragma unroll
        for (int i = 0; i < 2; ++i) af[i] = *(const bf16x8*)(Wsb + (size_t)(p0 + i * 16 + fr) * 128 + ks * 32 + fq * 8);
#pragma unroll
        for (int j = 0; j < 4; ++j) bfr[j] = *(const bf16x8*)(vnT + (j * 16 + fr) * TP + ks * 32 + fq * 8);
#pragma unroll
        for (int i = 0; i < 2; ++i)
#pragma unroll
            for (int j = 0; j < 4; ++j) acc[i][j] = MFMA16(bfr[j], af[i], acc[i][j]);
    }
    bf16_t* Y = (bf16_t*)(p.ws + OFF_Y);
    float* ssa = (float*)(p.ws + OFF_SSQA);
#pragma unroll
    for (int i = 0; i < 2; ++i) {
        const int pp = p0 + i * 16 + fr, tok = tok0 + pp;
        const float bsv = p.gmlp_bs[((size_t)l * 8 + h) * 128 + pp];
        float ss = 0.f;
#pragma unroll
        for (int j = 0; j < 4; ++j) {
            const int d = j * 16 + fq * 4;
            const uint2 uu = *(const uint2*)(Z + (size_t)tok * NZ + h * 64 + d);
            const float y0 = bf2f(uu.x & 0xffffu) * (acc[i][j][0] + bsv), y1 = bf2f(uu.x >> 16) * (acc[i][j][1] + bsv);
            const float y2 = bf2f(uu.y & 0xffffu) * (acc[i][j][2] + bsv), y3 = bf2f(uu.y >> 16) * (acc[i][j][3] + bsv);
            ss += y0 * y0 + y1 * y1 + y2 * y2 + y3 * y3;
            *(uint2*)(Y + (size_t)tok * D + h * 64 + d) = make_uint2(pk_bf16(y0, y1), pk_bf16(y2, y3));
        }
        ss += __shfl_xor(ss, 16); ss += __shfl_xor(ss, 32);
        if (fq == 0) ssa[(size_t)tok * 8 + h] = ss;
    }
    __syncthreads();
}

__device__ void ffta_item(const Params& p, int item, char* smem) {
    const int tid = otid(), lane = tid & 63, wid = tid >> 6, fr = lane & 15, fq = lane >> 4;
    const int bp = item & 63, g = (item >> 6) & 7, b = item >> 9;
    bf16_t* dT = (bf16_t*)smem;
    const bf16_t* Z = (const bf16_t*)(p.ws + OFF_Z);
    stage_transposed(Z + (size_t)(b * SEQ + bp) * NZ + 1024 + g * 128, (size_t)64 * NZ, dT);
    __syncthreads();
    const bf16_t* DA = (const bf16_t*)(p.ws + OFF_DA);
    f32x4 acc[2][4];
#pragma unroll
    for (int i = 0; i < 2; ++i)
#pragma unroll
        for (int j = 0; j < 4; ++j) acc[i][j] = (f32x4){0.f, 0.f, 0.f, 0.f};
#pragma unroll
    for (int ks = 0; ks < 4; ++ks) {
        bf16x8 af[2], bfr[4];
#pragma unroll
        for (int i = 0; i < 2; ++i) af[i] = *(const bf16x8*)(DA + (size_t)(i * 64 + wid * 16 + fr) * 128 + ks * 32 + fq * 8);
#pragma unroll
        for (int j = 0; j < 4; ++j) bfr[j] = *(const bf16x8*)(dT + (j * 16 + fr) * TP + ks * 32 + fq * 8);
#pragma unroll
        for (int i = 0; i < 2; ++i)
#pragma unroll
            for (int j = 0; j < 4; ++j) acc[i][j] = MFMA16(bfr[j], af[i], acc[i][j]);
    }
    const int k1 = wid * 16 + fr;
    const float2 cs = ((const float2*)(p.ws + OFF_TW))[bp * 64 + k1];
    bf16_t* Yb = (bf16_t*)(p.ws + OFF_H) + ((((size_t)(b * 8 + g) * 64 + k1) * 64 + bp) * 128);
#pragma unroll
    for (int j = 0; j < 4; ++j) {
        const int ch = j * 16 + fq * 4;
        float yr[4], yi[4];
#pragma unroll
        for (int e = 0; e < 4; ++e) { const float r = acc[0][j][e], im = acc[1][j][e]; yr[e] = r * cs.x + im * cs.y; yi[e] = im * cs.x - r * cs.y; }
        *(uint2*)(Yb + ch) = make_uint2(pk_bf16(yr[0], yr[1]), pk_bf16(yr[2], yr[3]));
        *(uint2*)(Yb + 64 + ch) = make_uint2(pk_bf16(yi[0], yi[1]), pk_bf16(yi[2], yi[3]));
    }
    __syncthreads();
}

__device__ void phase_mix(const Params& p, int l, char* smem, int bid, int nb) {
    for (int item = bid; item < 2048 + 4096; item += nb) {
        if (item < 2048) gmlp_item(p, l, item, smem); else ffta_item(p, item - 2048, smem);
    }
}

__device__ void phase_fftb(const Params& p, int l, char* smem, int bid, int nb) {
    const int tid = otid(), lane = tid & 63, wid = tid >> 6, fr = lane & 15, fq = lane >> 4;
    bf16_t* dT = (bf16_t*)smem;
    const bf16_t* DB = (const bf16_t*)(p.ws + OFF_DB);
    bf16_t* Y = (bf16_t*)(p.ws + OFF_Y);
    float* ssb = (float*)(p.ws + OFF_SSQB);
    for (int item = bid; item < 4096; item += nb) {
        const int k1 = item & 63, g = (item >> 6) & 7, b = item >> 9;
        stage_transposed((const bf16_t*)(p.ws + OFF_H) + (((size_t)(b * 8 + g) * 64 + k1) * 64) * 128, 128, dT);
        __syncthreads();
        f32x4 acc[4];
#pragma unroll
        for (int j = 0; j < 4; ++j) acc[j] = (f32x4){0.f, 0.f, 0.f, 0.f};
#pragma unroll
        for (int ks = 0; ks < 4; ++ks) {
            const bf16x8 af = *(const bf16x8*)(DB + (size_t)(wid * 16 + fr) * 128 + ks * 32 + fq * 8);
#pragma unroll
            for (int j = 0; j < 4; ++j) { const bf16x8 bfr = *(const bf16x8*)(dT + (j * 16 + fr) * TP + ks * 32 + fq * 8); acc[j] = MFMA16(bfr, af, acc[j]); }
        }
        const int k2 = wid * 16 + fr, tok = b * SEQ + k1 + 64 * k2;
        float ss = 0.f;
#pragma unroll
        for (int j = 0; j < 4; ++j) {
            const int ch = j * 16 + fq * 4;
            const float4 fb = *(const float4*)(p.fnet_b + ((size_t)l * 8 + g) * 64 + ch);
            const float y0 = acc[j][0] * (1.0f / 512.0f) + fb.x, y1 = acc[j][1] * (1.0f / 512.0f) + fb.y, y2 = acc[j][2] * (1.0f / 512.0f) + fb.z, y3 = acc[j][3] * (1.0f / 512.0f) + fb.w;
            ss += y0 * y0 + y1 * y1 + y2 * y2 + y3 * y3;
            *(uint2*)(Y + (size_t)tok * D + 512 + g * 64 + ch) = make_uint2(pk_bf16(y0, y1), pk_bf16(y2, y3));
        }
        ss += __shfl_xor(ss, 16); ss += __shfl_xor(ss, 32);
        if (fq == 0) ssb[(size_t)tok * 8 + g] = ss;
        __syncthreads();
    }
}

#define INS16(a, v) do { a[15] = med3i(a[14], a[15], v); a[14] = med3i(a[13], a[14], v); a[13] = med3i(a[12], a[13], v); a[12] = med3i(a[11], a[12], v); \
    a[11] = med3i(a[10], a[11], v); a[10] = med3i(a[9], a[10], v); a[9] = med3i(a[8], a[9], v); a[8] = med3i(a[7], a[8], v); a[7] = med3i(a[6], a[7], v); \
    a[6] = med3i(a[5], a[6], v); a[5] = med3i(a[4], a[5], v); a[4] = med3i(a[3], a[4], v); a[3] = med3i(a[2], a[3], v); a[2] = med3i(a[1], a[2], v); \
    a[1] = med3i(a[0], a[1], v); a[0] = max(a[0], v); } while (0)

template <int I, int J> struct CandLoop {
    static __device__ __forceinline__ void run(int (&a)[16], const float (&f1)[16], const float (&f2)[16]) {
        if constexpr ((I + 1) * (J + 1) <= 16) { const int key = (f2key(f1[I] + f2[J]) & ~255) | (I * 16 + J); INS16(a, key); }
        if constexpr (J + 1 < 16) CandLoop<I, J + 1>::run(a, f1, f2);
        else if constexpr (I + 1 < 16) CandLoop<I + 1, 0>::run(a, f1, f2);
    }
};

typedef _Float16 f16x2_t __attribute__((ext_vector_type(2)));
__device__ __forceinline__ unsigned pk_f16(float lo, float hi) { const f16x2_t v = {(_Float16)lo, (_Float16)hi}; return __builtin_bit_cast(unsigned, v); }
__device__ __forceinline__ int h2key(unsigned bits16) { const int b = (int)(short)bits16; return b ^ ((b >> 15) & 0x7fff); }
__device__ __forceinline__ float key2h(int k) { const int b = k ^ ((k >> 15) & 0x7fff); return (float)__builtin_bit_cast(_Float16, (unsigned short)(b & 0xffff)); }

__device__ void phase_topk(const Params& p, int l, char* smem, int bid, int nb) {
    const int tid = otid(), lane = tid & 63, wid = tid >> 6, fr = lane & 15, fq = lane >> 4;
    unsigned* S32 = (unsigned*)smem;
    int* TT = (int*)smem;
    const bf16_t* Q = (const bf16_t*)(p.ws + OFF_Z);
    int* eidx = (int*)(p.ws + OFF_Y); float* gw = (float*)(p.ws + OFF_Y + (size_t)T * 128 * 4);
    const int hh = wid >> 1, half = wid & 1;
    for (int item = bid; item < (T / 64) * 4; item += nb) {
        const int hp = item & 3, tok0 = (item >> 2) * 64, h = hp * 2 + hh;
        const bf16_t* Kh = (const bf16_t*)(p.ws + OFF_K12) + (((size_t)l * 8 + h) * 256 + half * 128) * 128;
        const bf16_t* Qh = Q + (size_t)tok0 * 2048 + h * 256 + half * 128;
        {
            f32x4 acc[4][8];
#pragma unroll
            for (int i = 0; i < 4; ++i)
#pragma unroll
                for (int j = 0; j < 8; ++j) acc[i][j] = (f32x4){0.f, 0.f, 0.f, 0.f};
#pragma unroll
            for (int ks = 0; ks < 4; ++ks) {
                bf16x8 af[4];
#pragma unroll
                for (int i = 0; i < 4; ++i) af[i] = *(const bf16x8*)(Qh + (size_t)(i * 16 + fr) * 2048 + ks * 32 + fq * 8);
#pragma unroll
                for (int jh = 0; jh < 2; ++jh) {
                    bf16x8 bfr[4];
#pragma unroll
                    for (int j = 0; j < 4; ++j) bfr[j] = *(const bf16x8*)(Kh + (size_t)((jh * 4 + j) * 16 + fr) * 128 + ks * 32 + fq * 8);
#pragma unroll
                    for (int i = 0; i < 4; ++i)
#pragma unroll
                        for (int j = 0; j < 4; ++j) acc[i][jh * 4 + j] = MFMA16(bfr[j], af[i], acc[i][jh * 4 + j]);
                    __builtin_amdgcn_sched_barrier(0);
                }
            }
#pragma unroll
            for (int i = 0; i < 4; ++i)
#pragma unroll
                for (int j = 0; j < 8; ++j) {
                    unsigned* d = S32 + (i * 16 + fr) * 257 + hh * 128 + half * 64 + j * 8 + fq * 2;
                    d[0] = pk_f16(acc[i][j][0], acc[i][j][1]); d[1] = pk_f16(acc[i][j][2], acc[i][j][3]);
                }
        }
        __syncthreads();
        int a[16];
#pragma unroll
        for (int i = 0; i < 16; ++i) a[i] = (int)0x80000000;
        {
            const unsigned* sr = S32 + lane * 257 + hh * 128 + half * 64;
#pragma unroll 2
            for (int i = 0; i < 64; ++i) {
                const unsigned w = sr[i];
                const int k0 = (h2key(w & 0xffffu) << 7) | (2 * i), k1 = (h2key(w >> 16) << 7) | (2 * i + 1);
                INS16(a, k0); INS16(a, k1);
            }
        }
        __syncthreads();
#pragma unroll
        for (int i = 0; i < 16; ++i) TT[((lane * 2 + hh) * 2 + half) * 16 + i] = a[i];
        __syncthreads();
        if (tid < 128) {
            const int tk = tid & 63, h2 = tid >> 6, hd = hp * 2 + h2;
            const int* t1 = TT + ((tk * 2 + h2) * 2) * 16; const int* t2 = t1 + 16;
            float f1[16], f2[16];
#pragma unroll
            for (int i = 0; i < 16; ++i) { f1[i] = key2h(t1[i] >> 7); f2[i] = key2h(t2[i] >> 7); }
            int c[16];
#pragma unroll
            for (int i = 0; i < 16; ++i) c[i] = (int)0x80000000;
            CandLoop<0, 0>::run(c, f1, f2);
            float sc[16], e[16], sum = 0.f; int ex[16];
#pragma unroll
            for (int i = 0; i < 16; ++i) {
                sc[i] = key2f(c[i] & ~255);
                const int code = c[i] & 255;
                ex[i] = (t1[code >> 4] & 127) * 128 + (t2[code & 15] & 127);
            }
#pragma unroll
            for (int i = 0; i < 16; ++i) { e[i] = __expf(sc[i] - sc[0]); sum += e[i]; }
            const float inv = 1.0f / sum;
            int4* ep = (int4*)(eidx + (size_t)(tok0 + tk) * 128 + hd * 16); float4* gp = (float4*)(gw + (size_t)(tok0 + tk) * 128 + hd * 16);
#pragma unroll
            for (int i = 0; i < 4; ++i) { ep[i] = make_int4(ex[4 * i], ex[4 * i + 1], ex[4 * i + 2], ex[4 * i + 3]); gp[i] = make_float4(e[4 * i] * inv, e[4 * i + 1] * inv, e[4 * i + 2] * inv, e[4 * i + 3] * inv); }
        }
        __syncthreads();
    }
}

__device__ __forceinline__ float dot16_fp8(const float (&h)[16], const int4& u) {
    const int w[4] = {u.x, u.y, u.z, u.w};
    f32x2_t a = {0.f, 0.f};
#pragma unroll
    for (int i = 0; i < 4; ++i) {
        const f32x2_t lo = __builtin_amdgcn_cvt_pk_f32_fp8(w[i], false), hi = __builtin_amdgcn_cvt_pk_f32_fp8(w[i], true);
        const f32x2_t h0 = {h[4 * i], h[4 * i + 1]}, h1 = {h[4 * i + 2], h[4 * i + 3]};
        a = __builtin_elementwise_fma(lo, h0, a); a = __builtin_elementwise_fma(hi, h1, a);
    }
    return a.x + a.y;
}
__device__ __forceinline__ void axpy16_fp8(float (&o)[16], float c, const int4& v) {
    const int w[4] = {v.x, v.y, v.z, v.w};
#pragma unroll
    for (int i = 0; i < 4; ++i) {
        const f32x2_t lo = __builtin_amdgcn_cvt_pk_f32_fp8(w[i], false), hi = __builtin_amdgcn_cvt_pk_f32_fp8(w[i], true);
        o[4 * i] += c * lo.x; o[4 * i + 1] += c * lo.y; o[4 * i + 2] += c * hi.x; o[4 * i + 3] += c * hi.y;
    }
}

__device__ void phase_pu(const Params& p, int l, int slice, int grank, int gsz) {
    const int tid_ = otid(); const int lane = tid_ & 63, wid = tid_ >> 6, sub = lane & 7, pg = lane >> 3;
    const bf16_t* H = (const bf16_t*)(p.ws + OFF_H) + slice * 128 + sub * 16;
    const char* U8 = p.ws + OFF_UB + ((size_t)(l * 8 + slice) * NE) * 128 + sub * 16;
    const int* eidx = (const int*)(p.ws + OFF_Y) + lane;
    float* part = (float*)(p.ws + OFF_Z) + (size_t)slice * T * 128 + 16 * sub + pg;
    const int stride = gsz * 4;
#define PU_ISSUE(e_, u_) do { _Pragma("unroll") for (int q = 0; q < 8; ++q) { const int ej = __shfl(e_, 8 * q + pg); u_[q] = *(const int4*)(U8 + (size_t)ej * 128); } } while (0)
    int tok = grank * 4 + wid;
    if (tok >= T) return;
    int4 uA[8], uB[8];
    int ea = eidx[(size_t)tok * 128], eb = eidx[(size_t)tok * 128 + 64];
    uint4 h0 = *(const uint4*)(H + (size_t)tok * D), h1 = *(const uint4*)(H + (size_t)tok * D + 8);
    PU_ISSUE(ea, uA);
#pragma nounroll
    for (;;) {
        __builtin_amdgcn_sched_barrier(0);
        const int tokn = tok + stride; const bool more = tokn < T;
        int ean = 0, ebn = 0; uint4 h0n = h0, h1n = h1;
        if (more) { ean = eidx[(size_t)tokn * 128]; ebn = eidx[(size_t)tokn * 128 + 64]; h0n = *(const uint4*)(H + (size_t)tokn * D); h1n = *(const uint4*)(H + (size_t)tokn * D + 8); }
        PU_ISSUE(eb, uB);
        __builtin_amdgcn_sched_barrier(0);
        float hf[16];
        { const unsigned w_[8] = {h0.x, h0.y, h0.z, h0.w, h1.x, h1.y, h1.z, h1.w};
#pragma unroll
          for (int i = 0; i < 8; ++i) { hf[2 * i] = bf2f(w_[i] & 0xffffu); hf[2 * i + 1] = bf2f(w_[i] >> 16); } }
        float v[16];
#pragma unroll
        for (int q = 0; q < 8; ++q) v[q] = dot16_fp8(hf, uA[q]);
        __builtin_amdgcn_sched_barrier(0);
        if (more) PU_ISSUE(ean, uA);
        __builtin_amdgcn_sched_barrier(0);
#pragma unroll
        for (int q = 0; q < 8; ++q) v[8 + q] = dot16_fp8(hf, uB[q]);
        float w8[8], w4[4], w2[2];
        { const bool hi = (lane & 4) != 0;
#pragma unroll
          for (int m = 0; m < 8; ++m) { const float send = hi ? v[m] : v[m + 8], keep = hi ? v[m + 8] : v[m]; w8[m] = keep + __shfl_xor(send, 4); } }
        { const bool hi = (lane & 2) != 0;
#pragma unroll
          for (int m = 0; m < 4; ++m) { const float send = hi ? w8[m] : w8[m + 4], keep = hi ? w8[m + 4] : w8[m]; w4[m] = keep + __shfl_xor(send, 2); } }
        { const bool hi = (lane & 1) != 0;
#pragma unroll
          for (int m = 0; m < 2; ++m) { const float send = hi ? w4[m] : w4[m + 2], keep = hi ? w4[m + 2] : w4[m]; w2[m] = keep + __shfl_xor(send, 1); } }
        float* pr = part + (size_t)tok * 128;
        pr[0] = w2[0]; pr[8] = w2[1];
        if (!more) break;
        tok = tokn; ea = ean; eb = ebn; h0 = h0n; h1 = h1n;
    }
#undef PU_ISSUE
}
__device__ void phase_pc(const Params& p, int l, int bid, int nb) {
    const int tid_ = otid(); const int lane = tid_ & 63, wid = tid_ >> 6;
    const int* eidx = (const int*)(p.ws + OFF_Y); const float* gw = (const float*)(p.ws + OFF_Y + (size_t)T * 128 * 4);
    float* coef = (float*)(p.ws + OFF_Y + (size_t)T * 128 * 8);
    const float* part = (const float*)(p.ws + OFF_Z);
    const float* usc = (const float*)(p.ws + OFF_USC) + (size_t)l * NE; const float* vsc = (const float*)(p.ws + OFF_VSC) + (size_t)l * NE;
    for (int tok = bid * 4 + wid; tok < T; tok += nb * 4) {
#pragma unroll
        for (int hh = 0; hh < 2; ++hh) {
            const size_t j = (size_t)tok * 128 + hh * 64 + lane;
            const int e = eidx[j]; const float g = gw[j];
            float a = 0.f;
#pragma unroll
            for (int sl = 0; sl < 8; ++sl) a += part[(size_t)sl * T * 128 + j];
            coef[j] = g * gelu_f(a * usc[e]) * vsc[e];
        }
    }
}
__device__ void phase_pv(const Params& p, int l, int slice, int grank, int gsz) {
    const int tid_ = otid(); const int lane = tid_ & 63, wid = tid_ >> 6, sub = lane & 7, pg = lane >> 3;
    const char* V8 = p.ws + OFF_VB + ((size_t)(l * 8 + slice) * NE) * 128 + sub * 16;
    const int* eidx = (const int*)(p.ws + OFF_Y) + lane;
    const float* coef = (const float*)(p.ws + OFF_Y + (size_t)T * 128 * 8) + lane;
    const int col = slice * 128 + 16 * sub + 2 * pg;
    const float* g2p = (const float*)(p.ws + OFF_MOD) + (size_t)l * NB * 6144 + 5 * D + col;
    bf16_t* xcol = (bf16_t*)(p.ws + OFF_XR) + col;
    const int stride = gsz * 4;
#define PV_ISSUE(e_, c_, v_, cj_) do { _Pragma("unroll") for (int q = 0; q < 8; ++q) { const int ej = __shfl(e_, 8 * q + pg); cj_[q] = __shfl(c_, 8 * q + pg); v_[q] = *(const int4*)(V8 + (size_t)ej * 128); } } while (0)
    int tok = grank * 4 + wid;
    if (tok >= T) return;
    int4 vA[8], vB[8]; float cA[8], cB[8];
    int ea = eidx[(size_t)tok * 128], eb = eidx[(size_t)tok * 128 + 64];
    float ca = coef[(size_t)tok * 128], cb = coef[(size_t)tok * 128 + 64];
    PV_ISSUE(ea, ca, vA, cA);
#pragma nounroll
    for (;;) {
        __builtin_amdgcn_sched_barrier(0);
        const int tokn = tok + stride; const bool more = tokn < T;
        int ean = 0, ebn = 0; float can = 0.f, cbn = 0.f;
        if (more) { ean = eidx[(size_t)tokn * 128]; ebn = eidx[(size_t)tokn * 128 + 64]; can = coef[(size_t)tokn * 128]; cbn = coef[(size_t)tokn * 128 + 64]; }
        unsigned* xp = (unsigned*)(xcol + (size_t)tok * D); const float2 g2 = *(const float2*)(g2p + (size_t)(tok / SEQ) * 6144);
        const unsigned xw = *xp;
        PV_ISSUE(eb, cb, vB, cB);
        __builtin_amdgcn_sched_barrier(0);
        float o[16];
#pragma unroll
        for (int i = 0; i < 16; ++i) o[i] = 0.f;
#pragma unroll
        for (int q = 0; q < 8; ++q) axpy16_fp8(o, cA[q], vA[q]);
        __builtin_amdgcn_sched_barrier(0);
        if (more) PV_ISSUE(ean, can, vA, cA);
        __builtin_amdgcn_sched_barrier(0);
#pragma unroll
        for (int q = 0; q < 8; ++q) axpy16_fp8(o, cB[q], vB[q]);
        float t8[8], t4[4], t2[2];
        { const bool hi = (lane & 32) != 0;
#pragma unroll
          for (int m = 0; m < 8; ++m) { const float send = hi ? o[m] : o[m + 8], keep = hi ? o[m + 8] : o[m]; t8[m] = keep + __shfl_xor(send, 32); } }
        { const bool hi = (lane & 16) != 0;
#pragma unroll
          for (int m = 0; m < 4; ++m) { const float send = hi ? t8[m] : t8[m + 4], keep = hi ? t8[m + 4] : t8[m]; t4[m] = keep + __shfl_xor(send, 16); } }
        { const bool hi = (lane & 8) != 0;
#pragma unroll
          for (int m = 0; m < 2; ++m) { const float send = hi ? t4[m] : t4[m + 2], keep = hi ? t4[m + 2] : t4[m]; t2[m] = keep + __shfl_xor(send, 8); } }
        *xp = pk_bf16(bf2f(xw & 0xffffu) + g2.x * t2[0], bf2f(xw >> 16) + g2.y * t2[1]);
        if (!more) break;
        tok = tokn; ea = ean; eb = ebn; ca = can; cb = cbn;
    }
#undef PV_ISSUE
}
__device__ void phase_final_norm(const Params& p, int bid, int nb) {
    const int tid_ = otid(); const int lane = tid_ & 63, wid = tid_ >> 6;
    for (int tok = bid * 4 + wid; tok < T; tok += nb * 4) {
        float* xr = p.out + (size_t)tok * D;
        const bf16_t* xs = (const bf16_t*)(p.ws + OFF_XR) + (size_t)tok * D;
        float4 v[4]; float ss = 0.f;
#pragma unroll
        for (int i = 0; i < 4; ++i) { const uint2 w = *(const uint2*)(xs + i * 256 + lane * 4); v[i] = make_float4(bf2f(w.x & 0xffffu), bf2f(w.x >> 16), bf2f(w.y & 0xffffu), bf2f(w.y >> 16));
            ss += v[i].x * v[i].x + v[i].y * v[i].y + v[i].z * v[i].z + v[i].w * v[i].w; }
        ss = wave_sum(ss);
        const float rstd = rsqrtf(ss * (1.0f / D) + EPS);
#pragma unroll
        for (int i = 0; i < 4; ++i) { const float4 g = *(const float4*)(p.final_g + i * 256 + lane * 4);
            *(float4*)(xr + i * 256 + lane * 4) = make_float4(v[i].x * rstd * g.x, v[i].y * rstd * g.y, v[i].z * rstd * g.z, v[i].w * rstd * g.w); }
    }
}

#define XB_TMO      128
#define XB_XCNT(j)  (256  + 64 * (j))
#define XB_XSUB(j)  (1280 + 64 * (j))
#define XB_XGEN(j)  (2304 + 64 * (j))
#define XB_TOP      3328
#define XB_TOPGEN   3392
#define XCD_BAR_WORDS 3456
#define XB_SPIN_CAP (1u << 22)
__device__ __forceinline__ unsigned xb_ld(unsigned* p)              { return __hip_atomic_load(p, __ATOMIC_RELAXED, __HIP_MEMORY_SCOPE_AGENT); }
__device__ __forceinline__ unsigned xb_add(unsigned* p, unsigned v) { return __hip_atomic_fetch_add(p, v, __ATOMIC_RELAXED, __HIP_MEMORY_SCOPE_AGENT); }
__device__ __forceinline__ unsigned xb_xcc_id() { return (unsigned)__builtin_amdgcn_s_getreg((3 << 11) | 20) & 0xFu; }
#define XB_SPIN(cond, bar) do { unsigned _sp = 0; while (cond) { __builtin_amdgcn_s_sleep(1); \
    if ((++_sp & 255u) == 0u) { if (xb_ld(&(bar)[XB_TMO])) break; if (_sp > XB_SPIN_CAP) { atomicAdd(&(bar)[XB_TMO], 1u); break; } } } } while (0)
__device__ __forceinline__ void xcd_barrier_post(unsigned* bar, volatile LAS unsigned* st) {
    if (threadIdx.x == 0) { const unsigned x = xb_xcc_id(); st[3] = x; st[2] = xb_add(&bar[XB_XCNT(x)], 1u); }
}
__device__ __forceinline__ void xcd_barrier_complete(unsigned* bar, unsigned x, unsigned& nloc, unsigned& nx) {
    const unsigned G = gridDim.x * gridDim.y * gridDim.z;
    unsigned sum, cnt, mine, sp = 0u;
    for (;;) {
        sum = 0u; cnt = 0u; mine = 0u;
#pragma unroll
        for (unsigned j = 0; j < 16; ++j) { const unsigned c = xb_ld(&bar[XB_XCNT(j)]); sum += c; cnt += (c > 0u) ? 1u : 0u; mine = (j == x) ? c : mine; }
        if (sum == G) break;
        __builtin_amdgcn_s_sleep(1);
        if ((++sp & 255u) == 0u) { if (xb_ld(&bar[XB_TMO])) break; if (sp > XB_SPIN_CAP) { atomicAdd(&bar[XB_TMO], 1u); break; } }
    }
    nloc = mine > 0u ? mine : 1u; nx = cnt > 0u ? cnt : 1u;
}
__device__ __forceinline__ void xcd_barrier(unsigned* bar, volatile LAS unsigned* st) {
    asm volatile("s_waitcnt vmcnt(0)" ::: "memory");
    __syncthreads();
    if (threadIdx.x == 0) {
        __builtin_amdgcn_s_waitcnt(0);
        unsigned nloc = st[0], nx = st[1]; const unsigned x = st[3];
        if (nloc == 0u) { xcd_barrier_complete(bar, x, nloc, nx); st[0] = nloc; st[1] = nx; }
        const unsigned old = xb_add(&bar[XB_XSUB(x)], 1u);
        const unsigned gen = old / nloc;
        if (old + 1u == (gen + 1u) * nloc) {
            __builtin_amdgcn_fence(__ATOMIC_RELEASE, "agent");
            asm volatile("s_waitcnt vmcnt(0)" ::: "memory");
            const unsigned og = xb_add(&bar[XB_TOP], 1u);
            const unsigned tg = og / nx;
            if (og + 1u == (tg + 1u) * nx) xb_add(&bar[XB_TOPGEN], 1u);
            else XB_SPIN(xb_ld(&bar[XB_TOPGEN]) == tg, bar);
            __builtin_amdgcn_fence(__ATOMIC_ACQUIRE, "agent");
            xb_add(&bar[XB_XGEN(x)], 1u);
            asm volatile("s_waitcnt vmcnt(0)" ::: "memory");
        } else {
            XB_SPIN(xb_ld(&bar[XB_XGEN(x)]) == gen, bar);
            __builtin_amdgcn_fence(__ATOMIC_ACQUIRE, "agent");
            asm volatile("s_waitcnt vmcnt(0)" ::: "memory");
        }
    }
    __syncthreads();
}

#if MEGA
#if PROBE_A >= 0
#define TSTAMP(i) do { if (blockIdx.x == 0 && threadIdx.x == 0) ts[i] = __builtin_amdgcn_s_memrealtime(); } while (0)
#else
#define TSTAMP(i) do { } while (0)
#endif
__global__ void __launch_bounds__(256, 2) mega_kernel(Params p) {
    __shared__ __attribute__((aligned(16))) char smem[SMEM_BYTES];
    __shared__ uint4 xb_words;
#if PROBE_A >= 0
    __shared__ unsigned long long ts[26];
#endif
    cg::grid_group grid = cg::this_grid();
    const int bid = blockIdx.x, nb = gridDim.x;
    unsigned* bar = (unsigned*)(p.ws + OFF_BAR);
    if (threadIdx.x == 0) xb_words = make_uint4(0u, 0u, 0u, 0u);
    if (bid == 0) for (int i = threadIdx.x; i < XCD_BAR_WORDS; i += 256) bar[i] = 0u;
    TSTAMP(0);
    phase_prep(p, smem, bid, nb);
    grid.sync();
    volatile LAS unsigned* xst = (volatile LAS unsigned*)&xb_words;
    xcd_barrier_post(bar, xst);
    TSTAMP(1);
    phase_norm<false>(p.x, p.norm1_g, (const float*)(p.ws + OFF_MOD), 0, D, (bf16_t*)(p.ws + OFF_H), bid, nb); xcd_barrier((unsigned*)(p.ws + OFF_BAR), (volatile LAS unsigned*)&xb_words);
    int slice, grank; const int gsz = nb / 8;
    {
        const unsigned myx = xst[3], myrank = xst[2];
        unsigned pre = 0;
#pragma unroll
        for (unsigned j = 0; j < 16; ++j) { const unsigned c = xb_ld(&bar[XB_XCNT(j)]); pre += (j < myx) ? c : 0u; }
        const int gi = __builtin_amdgcn_readfirstlane((int)(pre + myrank));
        slice = gi / gsz; grank = gi % gsz;
    }
#pragma nounroll
    for (int l = 0; l < NL; ++l) {
        TSTAMP(2 + 11 * l); phase_gemm1(p, l, smem, bid, nb); xcd_barrier((unsigned*)(p.ws + OFF_BAR), (volatile LAS unsigned*)&xb_words);
        TSTAMP(3 + 11 * l); phase_mix(p, l, smem, bid, nb); xcd_barrier((unsigned*)(p.ws + OFF_BAR), (volatile LAS unsigned*)&xb_words);
        TSTAMP(4 + 11 * l); phase_fftb(p, l, smem, bid, nb); xcd_barrier((unsigned*)(p.ws + OFF_BAR), (volatile LAS unsigned*)&xb_words);
        TSTAMP(5 + 11 * l); phase_gemm2(p, l, smem, bid, nb); xcd_barrier((unsigned*)(p.ws + OFF_BAR), (volatile LAS unsigned*)&xb_words);
        TSTAMP(6 + 11 * l); phase_norm<true>(p.ws + OFF_XR, p.norm2_g + l * D, (const float*)(p.ws + OFF_MOD) + (size_t)l * NB * 6144, 3 * D, 4 * D, (bf16_t*)(p.ws + OFF_H), bid, nb); xcd_barrier((unsigned*)(p.ws + OFF_BAR), (volatile LAS unsigned*)&xb_words);
        TSTAMP(7 + 11 * l); phase_gemm3(p, l, smem, bid, nb); xcd_barrier((unsigned*)(p.ws + OFF_BAR), (volatile LAS unsigned*)&xb_words);
        TSTAMP(8 + 11 * l); phase_topk(p, l, smem, bid, nb); xcd_barrier((unsigned*)(p.ws + OFF_BAR), (volatile LAS unsigned*)&xb_words);
        TSTAMP(9 + 11 * l); phase_pu(p, l, slice, grank, gsz); xcd_barrier((unsigned*)(p.ws + OFF_BAR), (volatile LAS unsigned*)&xb_words);
        TSTAMP(10 + 11 * l); phase_pc(p, l, bid, nb); xcd_barrier((unsigned*)(p.ws + OFF_BAR), (volatile LAS unsigned*)&xb_words);
        TSTAMP(11 + 11 * l); phase_pv(p, l, slice, grank, gsz); xcd_barrier((unsigned*)(p.ws + OFF_BAR), (volatile LAS unsigned*)&xb_words);
        TSTAMP(12 + 11 * l);
        if (l + 1 < NL) { phase_norm<true>(p.ws + OFF_XR, p.norm1_g + (l + 1) * D, (const float*)(p.ws + OFF_MOD) + (size_t)(l + 1) * NB * 6144, 0, D, (bf16_t*)(p.ws + OFF_H), bid, nb); xcd_barrier((unsigned*)(p.ws + OFF_BAR), (volatile LAS unsigned*)&xb_words); }
        else phase_final_norm(p, bid, nb);
    }
    TSTAMP(24);
#if PROBE_A >= 0
    if (bid == 0 && threadIdx.x == 0) p.out[0] += (float)(ts[PROBE_B] - ts[PROBE_A]) * 0.01f / PROBE_DIV;
#endif
}
#endif

extern "C" void kernel_launch(void* const* d_in, const int* in_sizes, int n_in, void* d_out, int out_size, void* d_ws, size_t ws_size, hipStream_t stream) {
    (void)in_sizes; (void)n_in; (void)out_size;
    if (ws_size < OFF_END) { fprintf(stderr, "workspace too small: %zu < %zu\n", ws_size, (size_t)OFF_END); return; }
    Params p{};
    p.x = (const float*)d_in[0]; p.c = (const float*)d_in[1]; p.mod_w = (const float*)d_in[2]; p.mod_b = (const float*)d_in[3]; p.norm1_g = (const float*)d_in[4];
    p.w_in = (const float*)d_in[5]; p.gmlp_ws = (const float*)d_in[6]; p.gmlp_bs = (const float*)d_in[7]; p.fnet_w = (const float*)d_in[8]; p.fnet_b = (const float*)d_in[9];
    p.gain_a = (const float*)d_in[10]; p.gain_b = (const float*)d_in[11]; p.w_out = (const float*)d_in[12]; p.norm2_g = (const float*)d_in[13]; p.wq = (const float*)d_in[14];
    p.k1 = (const float*)d_in[15]; p.k2 = (const float*)d_in[16]; p.pu = (const float*)d_in[17]; p.pv = (const float*)d_in[18]; p.final_g = (const float*)d_in[19];
    p.out = (float*)d_out; p.ws = (char*)d_ws;
#if MEGA
    static int grid_blocks = 0;
    if (!grid_blocks) {
        int dev = 0, cus = 0, per_cu = 0;
        hipGetDevice(&dev);
        hipDeviceGetAttribute(&cus, hipDeviceAttributeMultiprocessorCount, dev);
        hipOccupancyMaxActiveBlocksPerMultiprocessor(&per_cu, mega_kernel, 256, 0);
        if (per_cu > 2) per_cu = 2;
        grid_blocks = (cus * per_cu) / 8 * 8;
    }
    void* args[] = {&p};
    hipError_t e = hipLaunchCooperativeKernel((void*)mega_kernel, dim3(grid_blocks), dim3(256), args, 0, stream);
    if (e != hipSuccess) fprintf(stderr, "cooperative launch failed: %s (grid %d)\n", hipGetErrorString(e), grid_blocks);
#endif
}
```

```cpp
#include <hip/hip_runtime.h>
#include <hip/hip_cooperative_groups.h>
#include <cstdio>
#include <cstdint>
namespace cg = cooperative_groups;

#ifndef MEGA
#define MEGA 1
#endif
#ifndef PROBE_A
#define PROBE_A -1
#define PROBE_B 0
#define PROBE_DIV 10.0f
#endif

typedef unsigned short bf16_t;
typedef short bf16x8 __attribute__((ext_vector_type(8)));
typedef float f32x4 __attribute__((ext_vector_type(4)));
typedef __bf16 bf16x2_t __attribute__((ext_vector_type(2)));

constexpr int D = 1024, NB = 8, SEQ = 4096, T = NB * SEQ, NL = 2;
constexpr int NZ = 2048;
constexpr int NE = 16384;
constexpr float EPS = 1e-6f;

constexpr size_t OFF_MOD  = 0;
constexpr size_t OFF_W1T  = OFF_MOD  + (size_t)NL * NB * 6144 * 4;
constexpr size_t OFF_W2T  = OFF_W1T  + (size_t)NL * 2048 * 1024 * 2;
constexpr size_t OFF_WQT  = OFF_W2T  + (size_t)NL * 1024 * 1024 * 2;
constexpr size_t OFF_K12  = OFF_WQT  + (size_t)NL * 2048 * 1024 * 2;
constexpr size_t OFF_WSB  = OFF_K12  + (size_t)NL * 8 * 256 * 128 * 2;
constexpr size_t OFF_DA   = OFF_WSB  + (size_t)NL * 8 * 128 * 128 * 2;
constexpr size_t OFF_DB   = OFF_DA   + 128 * 128 * 2;
constexpr size_t OFF_TW   = OFF_DB   + 64 * 128 * 2;
constexpr size_t OFF_SSQA = OFF_TW   + 64 * 64 * 8;
constexpr size_t OFF_SSQB = OFF_SSQA + (size_t)T * 8 * 4;
constexpr size_t OFF_UB   = OFF_SSQB + (size_t)T * 8 * 4;
constexpr size_t OFF_VB   = OFF_UB   + (size_t)NL * NE * 1024;
constexpr size_t OFF_USC  = OFF_VB   + (size_t)NL * NE * 1024;
constexpr size_t OFF_VSC  = OFF_USC  + (size_t)NL * NE * 4;
constexpr size_t OFF_H    = OFF_VSC  + (size_t)NL * NE * 4;
constexpr size_t OFF_Z    = OFF_H    + (size_t)T * 1024 * 2;
constexpr size_t OFF_Y    = OFF_Z    + (size_t)T * 2048 * 2;
constexpr size_t OFF_BAR  = OFF_Y    + (size_t)T * 1024 * 2;
constexpr size_t OFF_XR   = OFF_BAR  + 16384;
constexpr size_t OFF_END  = OFF_XR   + (size_t)T * 1024 * 2;

struct Params {
    const float* x; const float* c; const float* mod_w; const float* mod_b; const float* norm1_g; const float* w_in;
    const float* gmlp_ws; const float* gmlp_bs; const float* fnet_w; const float* fnet_b; const float* gain_a; const float* gain_b;
    const float* w_out; const float* norm2_g; const float* wq; const float* k1; const float* k2; const float* pu; const float* pv; const float* final_g;
    float* out; char* ws;
};

constexpr int SMEM_BYTES = 73984;

__device__ __forceinline__ float bf2f(unsigned v) { return __uint_as_float(v << 16); }
typedef float f32x2_t __attribute__((ext_vector_type(2)));
__device__ __forceinline__ unsigned pk_bf16(float lo, float hi) { const f32x2_t v = {lo, hi}; return __builtin_bit_cast(unsigned, __builtin_convertvector(v, bf16x2_t)); }
__device__ __forceinline__ bf16_t f2bf(float f) { return (bf16_t)(pk_bf16(f, 0.f) & 0xffffu); }
__device__ __forceinline__ float gelu_f(float v) {
    const float t = __builtin_amdgcn_rcpf(fabsf(v) * 0.2316418882f + 1.0f);
    float q = t * 0.5307027145f + (-0.7265760135f); q = q * t + 0.7107068705f; q = q * t + (-0.142248368f); q = q * t + 0.127414796f; q = q * t;
    const float m = v * (q * __builtin_amdgcn_exp2f(v * v * (-0.72134752044f)));
    return v < 0.f ? m : v - m;
}
__device__ __forceinline__ int med3i(int a, int b, int c) { return max(min(a, b), min(max(a, b), c)); }
__device__ __forceinline__ int f2key(float f) { int b = __float_as_int(f); return b ^ ((b >> 31) & 0x7fffffff); }
__device__ __forceinline__ float key2f(int k) { return __int_as_float(k ^ ((k >> 31) & 0x7fffffff)); }
__device__ __forceinline__ float wave_sum(float v) {
#pragma unroll
    for (int o = 32; o >= 1; o >>= 1) v += __shfl_xor(v, o);
    return v;
}
__device__ __forceinline__ int otid() { int t = threadIdx.x; asm volatile("" : "+v"(t)); return t; }
#define MFMA16(a, b, c) __builtin_amdgcn_mfma_f32_16x16x32_bf16((a), (b), (c), 0, 0, 0)

__device__ void transpose_tile(const float* __restrict__ src, int ld, int k0, int n0, bf16_t* __restrict__ dst  , int dn0,
                               const float* __restrict__ kscale, float* tile  ) {
    const int tid = otid();
#pragma unroll
    for (int i = 0; i < 4; ++i) {
        const int r = (tid >> 4) + 16 * i, c4 = (tid & 15) * 4;
        const float4 v = *(const float4*)(src + (size_t)(k0 + r) * ld + n0 + c4);
        const float s = kscale ? kscale[k0 + r] : 1.0f;
        tile[r * 65 + c4 + 0] = v.x * s; tile[r * 65 + c4 + 1] = v.y * s; tile[r * 65 + c4 + 2] = v.z * s; tile[r * 65 + c4 + 3] = v.w * s;
    }
    __syncthreads();
    {
        const int n = tid >> 2, ks = (tid & 3) * 16;
        unsigned w[8];
#pragma unroll
        for (int j = 0; j < 8; ++j) w[j] = pk_bf16(tile[(ks + 2 * j) * 65 + n], tile[(ks + 2 * j + 1) * 65 + n]);
        uint4* d = (uint4*)(dst + (size_t)(dn0 + n) * 1024 + k0 + ks);
        d[0] = make_uint4(w[0], w[1], w[2], w[3]); d[1] = make_uint4(w[4], w[5], w[6], w[7]);
    }
    __syncthreads();
}

__device__ void phase_prep(const Params& p, char* smem, int bid_, int nb_) {
    const int tid = otid();
    char* ws = p.ws;
    const bool convgrp = (nb_ >= 2) && (bid_ & 1);
    const int bid = (nb_ >= 2) ? (bid_ >> 1) : bid_, nb = (nb_ >= 2) ? ((nb_ + 1 - (bid_ & 1)) >> 1) : nb_;
    const int gtid = bid * 256 + tid, gsz = nb * 256;
    if (!convgrp) {
    {
        float* sc = (float*)smem;
        float* red = (float*)(smem + 32768);
        for (int i = tid; i < 8192; i += 256) { const float v = p.c[i]; sc[i] = v / (1.0f + __expf(-v)); }
        __syncthreads();
        float* mod = (float*)(ws + OFF_MOD);
        for (int item = bid; item < NL * 192; item += nb) {
            const int l = item / 192, n0 = (item % 192) * 32, nn = tid & 31, kq = tid >> 5;
            float acc[8];
#pragma unroll
            for (int b = 0; b < 8; ++b) acc[b] = 0.f;
            const float* W = p.mod_w + (size_t)l * 1024 * 6144 + n0 + nn;
#pragma nounroll
            for (int k0 = kq; k0 < 1024; k0 += 128) {
                float w[16];
#pragma unroll
                for (int u = 0; u < 16; ++u) w[u] = W[(size_t)(k0 + 8 * u) * 6144];
#pragma unroll
                for (int u = 0; u < 16; ++u)
#pragma unroll
                    for (int b = 0; b < 8; ++b) acc[b] += sc[b * 1024 + k0 + 8 * u] * w[u];
            }
#pragma unroll
            for (int b = 0; b < 8; ++b) red[(kq * 8 + b) * 32 + nn] = acc[b];
            __syncthreads();
            {
                const int b = tid >> 5;
                float s = 0.f;
#pragma unroll
                for (int q = 0; q < 8; ++q) s += red[(q * 8 + b) * 32 + nn];
                mod[((size_t)l * NB + b) * 6144 + n0 + nn] = s + p.mod_b[l * 6144 + n0 + nn];
            }
            __syncthreads();
        }
    }
    {
        float* tile = (float*)smem;
        for (int item = bid; item < NL * 1024; item += nb) {
            const int l = item / 1024, r = item % 1024;
            if (r < 256) {
                const int kt = r / 16, nt = r % 16;
                transpose_tile(p.w_in + (size_t)l * 1024 * 1536, 1536, kt * 64, nt * 64, (bf16_t*)(ws + OFF_W1T) + (size_t)l * 2048 * 1024, nt * 64, nullptr, tile);
            } else if (r < 512) {
                const int rr = r - 256, kt = rr / 16, nt = rr % 16;
                const float* gk = (kt < 8) ? (p.gain_a + l * 512) : (p.gain_b + l * 512 - 512);
                transpose_tile(p.w_out + (size_t)l * 1024 * 1024, 1024, kt * 64, nt * 64, (bf16_t*)(ws + OFF_W2T) + (size_t)l * 1024 * 1024, nt * 64, gk, tile);
            } else {
                const int rr = r - 512, kt = rr / 32, nt = rr % 32;
                transpose_tile(p.wq + (size_t)l * 1024 * 2048, 2048, kt * 64, nt * 64, (bf16_t*)(ws + OFF_WQT) + (size_t)l * 2048 * 1024, nt * 64, nullptr, tile);
            }
        }
    }
    {
        float* fws = (float*)smem;
        float* Ms  = (float*)(smem + 16384);
        float* wt  = (float*)(smem + 49152);
        float* cs  = (float*)(smem + 49152 + 16640);
        for (int item = bid; item < NL * 8 * 16; item += nb) {
            const int l = item / 128, g = (item % 128) / 16, kt = item % 16;
            if (tid < 64) { float s, c; sincospif((float)tid / 32.0f, &s, &c); cs[tid] = c; cs[64 + tid] = s; }
            for (int i = tid; i < 4096; i += 256) fws[i] = p.fnet_w[((size_t)l * 8 + g) * 4096 + i];
#pragma unroll
            for (int i = 0; i < 4; ++i) {
                const int r = (tid >> 4) + 16 * i, c4 = (tid & 15) * 4;
                const float4 v = *(const float4*)(p.w_in + (size_t)l * 1024 * 1536 + (size_t)(kt * 64 + r) * 1536 + 1024 + g * 64 + c4);
                wt[r * 65 + c4] = v.x; wt[r * 65 + c4 + 1] = v.y; wt[r * 65 + c4 + 2] = v.z; wt[r * 65 + c4 + 3] = v.w;
            }
            __syncthreads();
            {
                const int d = tid >> 2, r0 = (tid & 3) * 32;
                const bool im = r0 >= 64; const int e0 = r0 & 63;
                float acc[32];
#pragma unroll
                for (int e = 0; e < 32; ++e) acc[e] = 0.f;
                for (int j = 0; j < 64; ++j) {
                    const int ph = (d * j) & 63;
                    const float t = im ? -cs[64 + ph] : cs[ph];
#pragma unroll
                    for (int e = 0; e < 32; ++e) acc[e] += t * fws[j * 64 + e0 + e];
                }
#pragma unroll
                for (int e = 0; e < 32; ++e) Ms[d * 128 + r0 + e] = acc[e];
            }
            __syncthreads();
            {
                const int r = tid >> 1, kk0 = (tid & 1) * 32;
                float acc[32];
#pragma unroll
                for (int k = 0; k < 32; ++k) acc[k] = 0.f;
                for (int d = 0; d < 64; ++d) {
                    const float m = Ms[d * 128 + r];
#pragma unroll
                    for (int k = 0; k < 32; ++k) acc[k] += wt[(kk0 + k) * 65 + d] * m;
                }
                bf16_t* dst = (bf16_t*)(ws + OFF_W1T) + (size_t)l * 2048 * 1024 + (size_t)(1024 + g * 128 + r) * 1024 + kt * 64 + kk0;
#pragma unroll
                for (int q = 0; q < 4; ++q)
                    ((uint4*)dst)[q] = make_uint4(pk_bf16(acc[q * 8], acc[q * 8 + 1]), pk_bf16(acc[q * 8 + 2], acc[q * 8 + 3]), pk_bf16(acc[q * 8 + 4], acc[q * 8 + 5]), pk_bf16(acc[q * 8 + 6], acc[q * 8 + 7]));
            }
            __syncthreads();
        }
    }
    {
        bf16_t* k12 = (bf16_t*)(ws + OFF_K12);
        for (int i = gtid; i < NL * 8 * 256 * 128; i += gsz) {
            const int d = i & 127, n = (i >> 7) & 255, h = (i >> 15) & 7, l = i >> 18;
            const float* src = (n < 128) ? p.k1 : p.k2;
            k12[i] = f2bf(src[(((size_t)l * 8 + h) * 128 + (n & 127)) * 128 + d]);
        }
        bf16_t* wsb = (bf16_t*)(ws + OFF_WSB);
        for (int i = gtid; i < NL * 8 * 128 * 128; i += gsz) wsb[i] = f2bf(p.gmlp_ws[i]);
        bf16_t* DA = (bf16_t*)(ws + OFF_DA);
        for (int i = gtid; i < 128 * 128; i += gsz) {
            const int m = i >> 7, kk = i & 127, ro = m >> 6, k1 = m & 63, ri = kk >> 6, a = kk & 63;
            float s, c; sincospif((float)((a * k1) & 63) / 32.0f, &s, &c);
            const float v = (ro == ri) ? c : (ro == 0 ? s : -s);
            DA[i] = f2bf(v);
        }
        bf16_t* DB = (bf16_t*)(ws + OFF_DB);
        for (int i = gtid; i < 64 * 128; i += gsz) {
            const int k2 = i >> 7, kk = i & 127, ri = kk >> 6, b = kk & 63;
            float s, c; sincospif((float)((b * k2) & 63) / 32.0f, &s, &c);
            DB[i] = f2bf(ri ? s : c);
        }
        float2* tw = (float2*)(ws + OFF_TW);
        for (int i = gtid; i < 64 * 64; i += gsz) {
            const int bp = i >> 6, k1 = i & 63;
            float s, c; sincospif((float)(bp * k1) / 2048.0f, &s, &c);
            tw[i] = make_float2(c, s);
        }
    }
    }
    if (convgrp || nb_ < 2) {
        {
            const int lane = tid & 63, wv = gtid >> 6, nwv = gsz >> 6;
            const int R = 2 * NL * NE;
#pragma nounroll
            for (int r0 = wv; r0 < R; r0 += 4 * nwv) {
                float4 v[4][4];
#pragma unroll
                for (int t = 0; t < 4; ++t) {
                    const int r = (r0 + t * nwv < R) ? r0 + t * nwv : r0;
                    const int tbl = r / (NL * NE), row = r % (NL * NE);
                    const float* src = (tbl ? p.pv : p.pu) + (size_t)row * 1024 + lane * 16;
#pragma unroll
                    for (int i = 0; i < 4; ++i) v[t][i] = ((const float4*)src)[i];
                }
                __builtin_amdgcn_sched_barrier(0);
#pragma unroll
                for (int t = 0; t < 4; ++t) {
                    const int r = r0 + t * nwv;
                    if (r >= R) break;
                    const int tbl = r / (NL * NE), row = r % (NL * NE);
                    float m = 0.f;
#pragma unroll
                    for (int i = 0; i < 4; ++i) m = fmaxf(m, fmaxf(fmaxf(fabsf(v[t][i].x), fabsf(v[t][i].y)), fmaxf(fabsf(v[t][i].z), fabsf(v[t][i].w))));
#pragma unroll
                    for (int o = 32; o >= 1; o >>= 1) m = fmaxf(m, __shfl_xor(m, o));
                    const float qmax = tbl ? 6.0f : 256.0f;
                    const float sc = (m > 0.f) ? qmax / m : 1.0f, inv = (m > 0.f) ? m / qmax : 1.0f;
                    const int lyr = row / NE, ex = row % NE;
                    if (tbl) {
                        unsigned w0 = 0u, w1 = 0u;
                        w0 = __builtin_amdgcn_cvt_scalef32_pk_fp4_f32(w0, v[t][0].x * sc, v[t][0].y * sc, 1.0f, 0); w0 = __builtin_amdgcn_cvt_scalef32_pk_fp4_f32(w0, v[t][0].z * sc, v[t][0].w * sc, 1.0f, 1);
                        w0 = __builtin_amdgcn_cvt_scalef32_pk_fp4_f32(w0, v[t][1].x * sc, v[t][1].y * sc, 1.0f, 2); w0 = __builtin_amdgcn_cvt_scalef32_pk_fp4_f32(w0, v[t][1].z * sc, v[t][1].w * sc, 1.0f, 3);
                        w1 = __builtin_amdgcn_cvt_scalef32_pk_fp4_f32(w1, v[t][2].x * sc, v[t][2].y * sc, 1.0f, 0); w1 = __builtin_amdgcn_cvt_scalef32_pk_fp4_f32(w1, v[t][2].z * sc, v[t][2].w * sc, 1.0f, 1);
                        w1 = __builtin_amdgcn_cvt_scalef32_pk_fp4_f32(w1, v[t][3].x * sc, v[t][3].y * sc, 1.0f, 2); w1 = __builtin_amdgcn_cvt_scalef32_pk_fp4_f32(w1, v[t][3].z * sc, v[t][3].w * sc, 1.0f, 3);
                        *(uint2*)(ws + OFF_VB + ((size_t)(lyr * 4 + (lane >> 4)) * NE + ex) * 128 + (lane & 15) * 8) = make_uint2(w0, w1);
                    } else {
                        int w[4];
#pragma unroll
                        for (int i = 0; i < 4; ++i) { w[i] = __builtin_amdgcn_cvt_pk_fp8_f32(v[t][i].x * sc, v[t][i].y * sc, 0, false); w[i] = __builtin_amdgcn_cvt_pk_fp8_f32(v[t][i].z * sc, v[t][i].w * sc, w[i], true); }
                        *(int4*)(ws + OFF_UB + ((size_t)(lyr * 8 + (lane >> 3)) * NE + ex) * 128 + (lane & 7) * 16) = make_int4(w[0], w[1], w[2], w[3]);
                    }
                    if (lane == 0) ((float*)(ws + (tbl ? OFF_VSC : OFF_USC)))[row] = inv;
                    __builtin_amdgcn_sched_barrier(0);
                }
            }
        }
    }
}

template <bool SRC_BF16>
__device__ void phase_norm(const void* __restrict__ xsrc_, const float* __restrict__ g, const float* __restrict__ modl  , int sh_off, int scl_off,
                           bf16_t* __restrict__ hout, int bid, int nb) {
    const int tid_ = otid(); const int lane = tid_ & 63, wid = tid_ >> 6;
    for (int tok = bid * 4 + wid; tok < T; tok += nb * 4) {
        const int b = tok / SEQ;
        float4 v[4];
        float ss = 0.f;
#pragma unroll
        for (int i = 0; i < 4; ++i) {
            if (SRC_BF16) { const uint2 w = *(const uint2*)((const bf16_t*)xsrc_ + (size_t)tok * D + i * 256 + lane * 4); v[i] = make_float4(bf2f(w.x & 0xffffu), bf2f(w.x >> 16), bf2f(w.y & 0xffffu), bf2f(w.y >> 16)); }
            else v[i] = *(const float4*)((const float*)xsrc_ + (size_t)tok * D + i * 256 + lane * 4);
            ss += v[i].x * v[i].x + v[i].y * v[i].y + v[i].z * v[i].z + v[i].w * v[i].w;
        }
        ss = wave_sum(ss);
        const float rstd = rsqrtf(ss * (1.0f / D) + EPS);
        const float* mb = modl + (size_t)b * 6144;
#pragma unroll
        for (int i = 0; i < 4; ++i) {
            const int cidx = i * 256 + lane * 4;
            const float4 gg = *(const float4*)(g + cidx), sh = *(const float4*)(mb + sh_off + cidx), sc = *(const float4*)(mb + scl_off + cidx);
            const float o0 = v[i].x * rstd * gg.x * (1.0f + sc.x) + sh.x, o1 = v[i].y * rstd * gg.y * (1.0f + sc.y) + sh.y;
            const float o2 = v[i].z * rstd * gg.z * (1.0f + sc.z) + sh.z, o3 = v[i].w * rstd * gg.w * (1.0f + sc.w) + sh.w;
            *(uint2*)(hout + (size_t)tok * D + cidx) = make_uint2(pk_bf16(o0, o1), pk_bf16(o2, o3));
        }
    }
}

#define LAS __attribute__((address_space(3)))
template <class Epi, class MidK>
__device__ __forceinline__ void gemm_tile(const bf16_t* __restrict__ A, int lda, const bf16_t* __restrict__ Bt, int ldb, int K, int m0, int n0,
                                          char* smem, const Epi& epi, const MidK& midk, int kmid) {
    const int tid = otid(), lane = tid & 63, wid = tid >> 6, wr = wid >> 1, wc = wid & 1, fr = lane & 15, fq = lane >> 4;
    LAS char* lds = (LAS char*)smem;
    f32x4 acc[4][4];
#pragma unroll
    for (int i = 0; i < 4; ++i)
#pragma unroll
        for (int j = 0; j < 4; ++j) acc[i][j] = (f32x4){0.f, 0.f, 0.f, 0.f};
    const int prow = lane >> 3, pch = (lane & 7) ^ prow;
    const bf16_t* ga = A + (size_t)(m0 + wid * 32 + prow) * lda + pch * 8;
    const bf16_t* gb = Bt + (size_t)(n0 + wid * 32 + prow) * ldb + pch * 8;
    const int nk = K / 64;
#define GEMM_STAGE(kt_, buf_) do { _Pragma("unroll") for (int i_ = 0; i_ < 4; ++i_) { \
        __builtin_amdgcn_global_load_lds((const unsigned*)(ga + (size_t)(i_ * 8) * lda + (kt_) * 64), (LAS unsigned*)(lds + (buf_) * 16384 + (wid * 32 + i_ * 8) * 128), 16, 0, 0); \
        __builtin_amdgcn_global_load_lds((const unsigned*)(gb + (size_t)(i_ * 8) * ldb + (kt_) * 64), (LAS unsigned*)(lds + 32768 + (buf_) * 16384 + (wid * 32 + i_ * 8) * 128), 16, 0, 0); } } while (0)
    GEMM_STAGE(0, 0);
    const int swz = fr & 7;
    for (int kt = 0; kt < nk; ++kt) {
        const int cur = kt & 1;
        asm volatile("s_waitcnt vmcnt(0)" ::: "memory");
        __syncthreads();
        if (kt + 1 < nk) GEMM_STAGE(kt + 1, cur ^ 1);
        if (kt == kmid) {
#pragma unroll
            for (int i = 0; i < 4; ++i) { const float sc = midk(m0 + wr * 64 + i * 16 + fr);
#pragma unroll
                for (int j = 0; j < 4; ++j) acc[i][j] *= sc; }
        }
        const LAS char* ca = lds + cur * 16384; const LAS char* cb = lds + 32768 + cur * 16384;
#pragma unroll
        for (int ks = 0; ks < 2; ++ks) {
            bf16x8 af[4], bfr[4];
            const int coff = ((ks * 4 + fq) ^ swz) * 16;
#pragma unroll
            for (int i = 0; i < 4; ++i) af[i] = *(const LAS bf16x8*)(ca + (wr * 64 + i * 16 + fr) * 128 + coff);
#pragma unroll
            for (int j = 0; j < 4; ++j) bfr[j] = *(const LAS bf16x8*)(cb + (wc * 64 + j * 16 + fr) * 128 + coff);
#pragma unroll
            for (int i = 0; i < 4; ++i)
#pragma unroll
                for (int j = 0; j < 4; ++j) acc[i][j] = MFMA16(bfr[j], af[i], acc[i][j]);
        }
    }
#undef GEMM_STAGE
    __syncthreads();
    {
        LAS char* stg = lds + wid * 17408;
#pragma unroll
        for (int i = 0; i < 4; ++i)
#pragma unroll
            for (int j = 0; j < 4; ++j) *(LAS f32x4*)(stg + (i * 16 + fr) * 272 + (j * 16 + fq * 4) * 4) = acc[i][j];
        const int er = lane >> 3, ec = (lane & 7) * 8;
#pragma unroll
        for (int t = 0; t < 8; ++t) {
            const f32x4 v0 = *(const LAS f32x4*)(stg + (t * 8 + er) * 272 + ec * 4), v1 = *(const LAS f32x4*)(stg + (t * 8 + er) * 272 + ec * 4 + 16);
            epi(m0 + wr * 64 + t * 8 + er, n0 + wc * 64 + ec, v0, v1);
            __builtin_amdgcn_sched_barrier(0);
        }
    }
    __syncthreads();
}
__device__ __forceinline__ void glds16(const void* g, unsigned lds_addr) {
    unsigned sv_;
    asm volatile("s_mov_b32 %0, m0\n\ts_mov_b32 m0, %2\n\tglobal_load_lds_dwordx4 %1, off\n\ts_mov_b32 m0, %0" : "=&s"(sv_) : "v"(g), "s"(lds_addr) : "memory");
}
template <class Epi, class MidK>
__device__ __forceinline__ void gemm_tile256(const bf16_t* __restrict__ A, int lda, const bf16_t* __restrict__ Bt, int ldb, int K, int m0, int n0,
                                             char* smem, const Epi& epi, const MidK& midk, int kmid) {
    const int tid = otid(), lane = tid & 63, wid = tid >> 6, wr = wid >> 1, wc = wid & 1, fr = lane & 15, fq = lane >> 4;
    LAS char* lds = (LAS char*)smem;
    f32x4 acc[8][4];
#pragma unroll
    for (int i = 0; i < 8; ++i)
#pragma unroll
        for (int j = 0; j < 4; ++j) acc[i][j] = (f32x4){0.f, 0.f, 0.f, 0.f};
    const int prow = lane >> 2, pch = (lane & 3) ^ (((lane >> 4) & 1) << 1);
    const bf16_t* ga = A + (size_t)(m0 + wid * 64 + prow) * lda + pch * 8;
    const bf16_t* gb = Bt + (size_t)(n0 + wid * 32 + prow) * ldb + pch * 8;
    const int nk = K / 32;
    const unsigned la = __builtin_amdgcn_readfirstlane((unsigned)(size_t)lds + wid * 4096), lb = __builtin_amdgcn_readfirstlane((unsigned)(size_t)lds + 16384 + wid * 2048);
#define G256_STAGE(kt_, ST_) do { \
        _Pragma("unroll") for (int i_ = 0; i_ < 4; ++i_) glds16(ga + (size_t)(i_ * 16) * lda + (kt_) * 32, la + (ST_) * 24576 + i_ * 1024); \
        _Pragma("unroll") for (int i_ = 0; i_ < 2; ++i_) glds16(gb + (size_t)(i_ * 16) * ldb + (kt_) * 32, lb + (ST_) * 24576 + i_ * 1024); } while (0)
    G256_STAGE(0, 0);
    G256_STAGE(1, 1);
    const int coff = (fq ^ (((fr >> 2) & 1) << 1)) * 16;
#define G256_STEP(kt_, CUR_, NXT_) do { \
        if ((kt_) + 1 < nk) asm volatile("s_waitcnt vmcnt(6)" ::: "memory"); else asm volatile("s_waitcnt vmcnt(0)" ::: "memory"); \
        __builtin_amdgcn_s_barrier(); \
        asm volatile("" ::: "memory"); \
        if ((kt_) + 2 < nk) G256_STAGE((kt_) + 2, NXT_); \
        if ((kt_) == kmid) { \
            _Pragma("unroll") for (int i = 0; i < 8; ++i) { const float sc = midk(m0 + wr * 128 + i * 16 + fr); \
                _Pragma("unroll") for (int j = 0; j < 4; ++j) acc[i][j] *= sc; } } \
        const LAS char* ca = lds + (CUR_) * 24576 + coff; const LAS char* cb = ca + 16384; \
        bf16x8 bfr[4], af[8]; \
        _Pragma("unroll") for (int j = 0; j < 4; ++j) bfr[j] = *(const LAS bf16x8*)(cb + (wc * 64 + j * 16 + fr) * 64); \
        _Pragma("unroll") for (int i = 0; i < 8; ++i) af[i] = *(const LAS bf16x8*)(ca + (wr * 128 + i * 16 + fr) * 64); \
        __builtin_amdgcn_sched_barrier(0); \
        _Pragma("unroll") for (int i = 0; i < 8; ++i) \
            _Pragma("unroll") for (int j = 0; j < 4; ++j) acc[i][j] = MFMA16(bfr[j], af[i], acc[i][j]); \
        __builtin_amdgcn_sched_barrier(0); } while (0)
#pragma nounroll
    for (int kt = 0; kt < nk; kt += 3) {
        G256_STEP(kt, 0, 2);
        if (kt + 1 < nk) G256_STEP(kt + 1, 1, 0);
        if (kt + 2 < nk) G256_STEP(kt + 2, 2, 1);
    }
#undef G256_STEP
#undef G256_STAGE
#pragma unroll
    for (int hb = 0; hb < 2; ++hb) {
        __syncthreads();
        LAS char* stg = lds + wid * 17408;
#pragma unroll
        for (int i = 0; i < 4; ++i)
#pragma unroll
            for (int j = 0; j < 4; ++j) *(LAS f32x4*)(stg + (i * 16 + fr) * 272 + (j * 16 + fq * 4) * 4) = acc[hb * 4 + i][j];
        const int er = lane >> 3, ec = (lane & 7) * 8;
#pragma unroll
        for (int t = 0; t < 8; ++t) {
            const f32x4 v0 = *(const LAS f32x4*)(stg + (t * 8 + er) * 272 + ec * 4), v1 = *(const LAS f32x4*)(stg + (t * 8 + er) * 272 + ec * 4 + 16);
            epi(m0 + wr * 128 + hb * 64 + t * 8 + er, n0 + wc * 64 + ec, v0, v1);
            __builtin_amdgcn_sched_barrier(0);
        }
    }
    __syncthreads();
}
__device__ __forceinline__ bool tile_of(int round, int bid, int nb, int MT, int NT, int& mt, int& nt) {
    if (nb == 512) {
        const int x = bid & 7, r = bid >> 3, st = x + 8 * round, snt = NT >> 3;
        if (st >= (MT >> 3) * snt) return false;
        mt = (st / snt) * 8 + (r >> 3); nt = (st % snt) * 8 + (r & 7);
        return true;
    }
    const int item = bid + round * nb;
    if (item >= MT * NT) return false;
    mt = item / NT; nt = item % NT;
    return true;
}
struct NoMid { __device__ __forceinline__ float operator()(int) const { return 1.0f; } };

__device__ void phase_gemm1(const Params& p, int l, char* smem, int bid, int nb) {
    const bf16_t* A = (const bf16_t*)(p.ws + OFF_H);
    const bf16_t* Bt = (const bf16_t*)(p.ws + OFF_W1T) + (size_t)l * 2048 * 1024;
    bf16_t* Z = (bf16_t*)(p.ws + OFF_Z);
    auto epi_gelu = [&](int row, int col, const f32x4& a, const f32x4& b) {
        *(uint4*)(Z + (size_t)row * NZ + col) = make_uint4(pk_bf16(gelu_f(a[0]), gelu_f(a[1])), pk_bf16(gelu_f(a[2]), gelu_f(a[3])), pk_bf16(gelu_f(b[0]), gelu_f(b[1])), pk_bf16(gelu_f(b[2]), gelu_f(b[3])));
    };
    auto epi_plain = [&](int row, int col, const f32x4& a, const f32x4& b) {
        *(uint4*)(Z + (size_t)row * NZ + col) = make_uint4(pk_bf16(a[0], a[1]), pk_bf16(a[2], a[3]), pk_bf16(b[0], b[1]), pk_bf16(b[2], b[3]));
    };
    const int NT = NZ / 128, MT = T / 256;
    int mt, nt;
    for (int round = 0; tile_of(round, bid, nb, MT, NT, mt, nt); ++round) {
        const int n0 = nt * 128;
        if (n0 < 1024) gemm_tile256(A, D, Bt, D, D, mt * 256, n0, smem, epi_gelu, NoMid(), -1);
        else           gemm_tile256(A, D, Bt, D, D, mt * 256, n0, smem, epi_plain, NoMid(), -1);
    }
}
__device__ void phase_gemm2(const Params& p, int l, char* smem, int bid, int nb) {
    const bf16_t* A = (const bf16_t*)(p.ws + OFF_Y);
    const bf16_t* Bt = (const bf16_t*)(p.ws + OFF_W2T) + (size_t)l * 1024 * 1024;
    const float* ssa = (const float*)(p.ws + OFF_SSQA); const float* ssb = (const float*)(p.ws + OFF_SSQB);
    const float* mod = (const float*)(p.ws + OFF_MOD) + (size_t)l * NB * 6144;
    bf16_t* XR = (bf16_t*)(p.ws + OFF_XR);
    auto rstd_of = [&](const float* s, int row) {
        const float4 a = *(const float4*)(s + (size_t)row * 8), b = *(const float4*)(s + (size_t)row * 8 + 4);
        return rsqrtf(((a.x + a.y) + (a.z + a.w) + (b.x + b.y) + (b.z + b.w)) * (1.0f / 512.0f) + EPS);
    };
    auto midk = [&](int row) { return rstd_of(ssa, row) / rstd_of(ssb, row); };
    auto epi = [&](int row, int col, const f32x4& a, const f32x4& c) {
        const float rb = rstd_of(ssb, row);
        const int b = row / SEQ;
        const float4 g0 = *(const float4*)(mod + (size_t)b * 6144 + 2 * D + col), g1 = *(const float4*)(mod + (size_t)b * 6144 + 2 * D + col + 4);
        float x[8];
        if (l == 0) { const float4 x0 = *(const float4*)(p.x + (size_t)row * D + col), x1 = *(const float4*)(p.x + (size_t)row * D + col + 4);
            x[0] = x0.x; x[1] = x0.y; x[2] = x0.z; x[3] = x0.w; x[4] = x1.x; x[5] = x1.y; x[6] = x1.z; x[7] = x1.w; }
        else { const uint4 w = *(const uint4*)(XR + (size_t)row * D + col);
            x[0] = bf2f(w.x & 0xffffu); x[1] = bf2f(w.x >> 16); x[2] = bf2f(w.y & 0xffffu); x[3] = bf2f(w.y >> 16); x[4] = bf2f(w.z & 0xffffu); x[5] = bf2f(w.z >> 16); x[6] = bf2f(w.w & 0xffffu); x[7] = bf2f(w.w >> 16); }
        *(uint4*)(XR + (size_t)row * D + col) = make_uint4(pk_bf16(x[0] + g0.x * rb * a[0], x[1] + g0.y * rb * a[1]), pk_bf16(x[2] + g0.z * rb * a[2], x[3] + g0.w * rb * a[3]),
                                                           pk_bf16(x[4] + g1.x * rb * c[0], x[5] + g1.y * rb * c[1]), pk_bf16(x[6] + g1.z * rb * c[2], x[7] + g1.w * rb * c[3]));
    };
    const int NT = D / 128, MT = T / 256;
    int mt, nt;
    for (int round = 0; tile_of(round, bid, nb, MT, NT, mt, nt); ++round) gemm_tile256(A, D, Bt, D, D, mt * 256, nt * 128, smem, epi, midk, 16);
}
__device__ void phase_gemm3(const Params& p, int l, char* smem, int bid, int nb) {
    const bf16_t* A = (const bf16_t*)(p.ws + OFF_H);
    const bf16_t* Bt = (const bf16_t*)(p.ws + OFF_WQT) + (size_t)l * 2048 * 1024;
    bf16_t* Q = (bf16_t*)(p.ws + OFF_Z);
    auto epi = [&](int row, int col, const f32x4& a, const f32x4& b) { *(uint4*)(Q + (size_t)row * 2048 + col) = make_uint4(pk_bf16(a[0], a[1]), pk_bf16(a[2], a[3]), pk_bf16(b[0], b[1]), pk_bf16(b[2], b[3])); };
    const int NT = 2048 / 128, MT = T / 256;
    int mt, nt;
    for (int round = 0; tile_of(round, bid, nb, MT, NT, mt, nt); ++round) gemm_tile256(A, D, Bt, D, D, mt * 256, nt * 128, smem, epi, NoMid(), -1);
}

constexpr int TP = 136;
__device__ __forceinline__ void stage_transposed(const bf16_t* __restrict__ base, size_t row_stride, bf16_t* dT) {
    const int tid = otid(), r = tid >> 2, part = tid & 3, ri = part >> 1, c0 = (part & 1) * 32;
    const uint4* src = (const uint4*)(base + (size_t)r * row_stride + ri * 64 + c0);
    uint4 v[4];
#pragma unroll
    for (int i = 0; i < 4; ++i) v[i] = src[i];
#pragma unroll
    for (int i = 0; i < 4; ++i) {
        const unsigned w[4] = {v[i].x, v[i].y, v[i].z, v[i].w};
#pragma unroll
        for (int j = 0; j < 4; ++j) {
            dT[(c0 + i * 8 + j * 2) * TP + ri * 64 + r] = (bf16_t)(w[j] & 0xffffu);
            dT[(c0 + i * 8 + j * 2 + 1) * TP + ri * 64 + r] = (bf16_t)(w[j] >> 16);
        }
    }
}

__device__ void gmlp_item(const Params& p, int l, int item, char* smem) {
    const int tid = otid(), lane = tid & 63, wid = tid >> 6, fr = lane & 15, fq = lane >> 4;
    const int h = item & 7, c = (item >> 3) & 31, b = item >> 8;
    const int tok0 = b * SEQ + c * 128;
    bf16_t* vnT = (bf16_t*)smem;
    const bf16_t* Z = (const bf16_t*)(p.ws + OFF_Z);
    {
        const int q = tid >> 1, half = tid & 1, d0 = half * 32;
        const uint4* src = (const uint4*)(Z + (size_t)(tok0 + q) * NZ + 512 + h * 64 + d0);
        float f[32];
#pragma unroll
        for (int i = 0; i < 4; ++i) { const uint4 v = src[i]; const unsigned w[4] = {v.x, v.y, v.z, v.w};
#pragma unroll
            for (int j = 0; j < 4; ++j) { f[i * 8 + j * 2] = bf2f(w[j] & 0xffffu); f[i * 8 + j * 2 + 1] = bf2f(w[j] >> 16); } }
        float s = 0.f;
#pragma unroll
        for (int i = 0; i < 32; ++i) s += f[i];
        s += __shfl_xor(s, 1);
        const float mean = s * (1.0f / 64.0f);
        float qv = 0.f;
#pragma unroll
        for (int i = 0; i < 32; ++i) { f[i] -= mean; qv += f[i] * f[i]; }
        qv += __shfl_xor(qv, 1);
        const float rstd = rsqrtf(qv * (1.0f / 64.0f) + EPS);
#pragma unroll
        for (int i = 0; i < 32; ++i) vnT[(d0 + i) * TP + q] = f2bf(f[i] * rstd);
    }
    __syncthreads();
    const bf16_t* Wsb = (const bf16_t*)(p.ws + OFF_WSB) + ((size_t)l * 8 + h) * 128 * 128;
    f32x4 acc[2][4];
#pragma unroll
    for (int i = 0; i < 2; ++i)
#pragma unroll
        for (int j = 0; j < 4; ++j) acc[i][j] = (f32x4){0.f, 0.f, 0.f, 0.f};
    const int p0 = wid * 32;
#pragma unroll
    for (int ks = 0; ks < 4; ++ks) {
        bf16x8 af[2], bfr[4];
#pragma unroll
        for (int i = 0; i < 2; ++i) af[i] = *(const bf16x8*)(Wsb + (size_t)(p0 + i * 16 + fr) * 128 + ks * 32 + fq * 8);
#pragma unroll
        for (int j = 0; j < 4; ++j) bfr[j] = *(const bf16x8*)(vnT + (j * 16 + fr) * TP + ks * 32 + fq * 8);
#pragma unroll
        for (int i = 0; i < 2; ++i)
#pragma unroll
            for (int j = 0; j < 4; ++j) acc[i][j] = MFMA16(bfr[j], af[i], acc[i][j]);
    }
    bf16_t* Y = (bf16_t*)(p.ws + OFF_Y);
    float* ssa = (float*)(p.ws + OFF_SSQA);
#pragma unroll
    for (int i = 0; i < 2; ++i) {
        const int pp = p0 + i * 16 + fr, tok = tok0 + pp;
        const float bsv = p.gmlp_bs[((size_t)l * 8 + h) * 128 + pp];
        float ss = 0.f;
#pragma unroll
        for (int j = 0; j < 4; ++j) {
            const int d = j * 16 + fq * 4;
            const uint2 uu = *(const uint2*)(Z + (size_t)tok * NZ + h * 64 + d);
            const float y0 = bf2f(uu.x & 0xffffu) * (acc[i][j][0] + bsv), y1 = bf2f(uu.x >> 16) * (acc[i][j][1] + bsv);
            const float y2 = bf2f(uu.y & 0xffffu) * (acc[i][j][2] + bsv), y3 = bf2f(uu.y >> 16) * (acc[i][j][3] + bsv);
            ss += y0 * y0 + y1 * y1 + y2 * y2 + y3 * y3;
            *(uint2*)(Y + (size_t)tok * D + h * 64 + d) = make_uint2(pk_bf16(y0, y1), pk_bf16(y2, y3));
        }
        ss += __shfl_xor(ss, 16); ss += __shfl_xor(ss, 32);
        if (fq == 0) ssa[(size_t)tok * 8 + h] = ss;
    }
    __syncthreads();
}

__device__ void ffta_item(const Params& p, int item, char* smem) {
    const int tid = otid(), lane = tid & 63, wid = tid >> 6, fr = lane & 15, fq = lane >> 4;
    const int bp = item & 63, g = (item >> 6) & 7, b = item >> 9;
    bf16_t* dT = (bf16_t*)smem;
    const bf16_t* Z = (const bf16_t*)(p.ws + OFF_Z);
    stage_transposed(Z + (size_t)(b * SEQ + bp) * NZ + 1024 + g * 128, (size_t)64 * NZ, dT);
    __syncthreads();
    const bf16_t* DA = (const bf16_t*)(p.ws + OFF_DA);
    f32x4 acc[2][4];
#pragma unroll
    for (int i = 0; i < 2; ++i)
#pragma unroll
        for (int j = 0; j < 4; ++j) acc[i][j] = (f32x4){0.f, 0.f, 0.f, 0.f};
#pragma unroll
    for (int ks = 0; ks < 4; ++ks) {
        bf16x8 af[2], bfr[4];
#pragma unroll
        for (int i = 0; i < 2; ++i) af[i] = *(const bf16x8*)(DA + (size_t)(i * 64 + wid * 16 + fr) * 128 + ks * 32 + fq * 8);
#pragma unroll
        for (int j = 0; j < 4; ++j) bfr[j] = *(const bf16x8*)(dT + (j * 16 + fr) * TP + ks * 32 + fq * 8);
#pragma unroll
        for (int i = 0; i < 2; ++i)
#pragma unroll
            for (int j = 0; j < 4; ++j) acc[i][j] = MFMA16(bfr[j], af[i], acc[i][j]);
    }
    const int k1 = wid * 16 + fr;
    const float2 cs = ((const float2*)(p.ws + OFF_TW))[bp * 64 + k1];
    bf16_t* Yb = (bf16_t*)(p.ws + OFF_H) + ((((size_t)(b * 8 + g) * 64 + k1) * 64 + bp) * 128);
#pragma unroll
    for (int j = 0; j < 4; ++j) {
        const int ch = j * 16 + fq * 4;
        float yr[4], yi[4];
#pragma unroll
        for (int e = 0; e < 4; ++e) { const float r = acc[0][j][e], im = acc[1][j][e]; yr[e] = r * cs.x + im * cs.y; yi[e] = im * cs.x - r * cs.y; }
        *(uint2*)(Yb + ch) = make_uint2(pk_bf16(yr[0], yr[1]), pk_bf16(yr[2], yr[3]));
        *(uint2*)(Yb + 64 + ch) = make_uint2(pk_bf16(yi[0], yi[1]), pk_bf16(yi[2], yi[3]));
    }
    __syncthreads();
}

__device__ void phase_mix(const Params& p, int l, char* smem, int bid, int nb) {
    for (int item = bid; item < 2048 + 4096; item += nb) {
        if (item < 2048) gmlp_item(p, l, item, smem); else ffta_item(p, item - 2048, smem);
    }
}

__device__ void phase_fftb(const Params& p, int l, char* smem, int bid, int nb) {
    const int tid = otid(), lane = tid & 63, wid = tid >> 6, fr = lane & 15, fq = lane >> 4;
    bf16_t* dT = (bf16_t*)smem;
    const bf16_t* DB = (const bf16_t*)(p.ws + OFF_DB);
    bf16_t* Y = (bf16_t*)(p.ws + OFF_Y);
    float* ssb = (float*)(p.ws + OFF_SSQB);
    for (int item = bid; item < 4096; item += nb) {
        const int k1 = item & 63, g = (item >> 6) & 7, b = item >> 9;
        stage_transposed((const bf16_t*)(p.ws + OFF_H) + (((size_t)(b * 8 + g) * 64 + k1) * 64) * 128, 128, dT);
        __syncthreads();
        f32x4 acc[4];
#pragma unroll
        for (int j = 0; j < 4; ++j) acc[j] = (f32x4){0.f, 0.f, 0.f, 0.f};
#pragma unroll
        for (int ks = 0; ks < 4; ++ks) {
            const bf16x8 af = *(const bf16x8*)(DB + (size_t)(wid * 16 + fr) * 128 + ks * 32 + fq * 8);
#pragma unroll
            for (int j = 0; j < 4; ++j) { const bf16x8 bfr = *(const bf16x8*)(dT + (j * 16 + fr) * TP + ks * 32 + fq * 8); acc[j] = MFMA16(bfr, af, acc[j]); }
        }
        const int k2 = wid * 16 + fr, tok = b * SEQ + k1 + 64 * k2;
        float ss = 0.f;
#pragma unroll
        for (int j = 0; j < 4; ++j) {
            const int ch = j * 16 + fq * 4;
            const float4 fb = *(const float4*)(p.fnet_b + ((size_t)l * 8 + g) * 64 + ch);
            const float y0 = acc[j][0] * (1.0f / 512.0f) + fb.x, y1 = acc[j][1] * (1.0f / 512.0f) + fb.y, y2 = acc[j][2] * (1.0f / 512.0f) + fb.z, y3 = acc[j][3] * (1.0f / 512.0f) + fb.w;
            ss += y0 * y0 + y1 * y1 + y2 * y2 + y3 * y3;
            *(uint2*)(Y + (size_t)tok * D + 512 + g * 64 + ch) = make_uint2(pk_bf16(y0, y1), pk_bf16(y2, y3));
        }
        ss += __shfl_xor(ss, 16); ss += __shfl_xor(ss, 32);
        if (fq == 0) ssb[(size_t)tok * 8 + g] = ss;
        __syncthreads();
    }
}

#define INS16(a, v) do { a[15] = med3i(a[14], a[15], v); a[14] = med3i(a[13], a[14], v); a[13] = med3i(a[12], a[13], v); a[12] = med3i(a[11], a[12], v); \
    a[11] = med3i(a[10], a[11], v); a[10] = med3i(a[9], a[10], v); a[9] = med3i(a[8], a[9], v); a[8] = med3i(a[7], a[8], v); a[7] = med3i(a[6], a[7], v); \
    a[6] = med3i(a[5], a[6], v); a[5] = med3i(a[4], a[5], v); a[4] = med3i(a[3], a[4], v); a[3] = med3i(a[2], a[3], v); a[2] = med3i(a[1], a[2], v); \
    a[1] = med3i(a[0], a[1], v); a[0] = max(a[0], v); } while (0)

template <int I, int J> struct CandLoop {
    static __device__ __forceinline__ void run(int (&a)[16], const float (&f1)[16], const float (&f2)[16]) {
        if constexpr ((I + 1) * (J + 1) <= 16) { const int key = (f2key(f1[I] + f2[J]) & ~255) | (I * 16 + J); INS16(a, key); }
        if constexpr (J + 1 < 16) CandLoop<I, J + 1>::run(a, f1, f2);
        else if constexpr (I + 1 < 16) CandLoop<I + 1, 0>::run(a, f1, f2);
    }
};

typedef _Float16 f16x2_t __attribute__((ext_vector_type(2)));
__device__ __forceinline__ unsigned pk_f16(float lo, float hi) { const f16x2_t v = {(_Float16)lo, (_Float16)hi}; return __builtin_bit_cast(unsigned, v); }
__device__ __forceinline__ int h2key(unsigned bits16) { const int b = (int)(short)bits16; return b ^ ((b >> 15) & 0x7fff); }
__device__ __forceinline__ float key2h(int k) { const int b = k ^ ((k >> 15) & 0x7fff); return (float)__builtin_bit_cast(_Float16, (unsigned short)(b & 0xffff)); }

__device__ void phase_topk(const Params& p, int l, char* smem, int bid, int nb) {
    const int tid = otid(), lane = tid & 63, wid = tid >> 6, fr = lane & 15, fq = lane >> 4;
    unsigned* S32 = (unsigned*)smem;
    int* TT = (int*)smem;
    const bf16_t* Q = (const bf16_t*)(p.ws + OFF_Z);
    int* eidx = (int*)(p.ws + OFF_Y); float* gw = (float*)(p.ws + OFF_Y + (size_t)T * 128 * 4);
    const int hh = wid >> 1, half = wid & 1;
    for (int item = bid; item < (T / 64) * 4; item += nb) {
        const int hp = item & 3, tok0 = (item >> 2) * 64, h = hp * 2 + hh;
        const bf16_t* Kh = (const bf16_t*)(p.ws + OFF_K12) + (((size_t)l * 8 + h) * 256 + half * 128) * 128;
        const bf16_t* Qh = Q + (size_t)tok0 * 2048 + h * 256 + half * 128;
        {
            f32x4 acc[4][8];
#pragma unroll
            for (int i = 0; i < 4; ++i)
#pragma unroll
                for (int j = 0; j < 8; ++j) acc[i][j] = (f32x4){0.f, 0.f, 0.f, 0.f};
#pragma unroll
            for (int ks = 0; ks < 4; ++ks) {
                bf16x8 af[4];
#pragma unroll
                for (int i = 0; i < 4; ++i) af[i] = *(const bf16x8*)(Qh + (size_t)(i * 16 + fr) * 2048 + ks * 32 + fq * 8);
#pragma unroll
                for (int jh = 0; jh < 2; ++jh) {
                    bf16x8 bfr[4];
#pragma unroll
                    for (int j = 0; j < 4; ++j) bfr[j] = *(const bf16x8*)(Kh + (size_t)((jh * 4 + j) * 16 + fr) * 128 + ks * 32 + fq * 8);
#pragma unroll
                    for (int i = 0; i < 4; ++i)
#pragma unroll
                        for (int j = 0; j < 4; ++j) acc[i][jh * 4 + j] = MFMA16(bfr[j], af[i], acc[i][jh * 4 + j]);
                    __builtin_amdgcn_sched_barrier(0);
                }
            }
#pragma unroll
            for (int i = 0; i < 4; ++i)
#pragma unroll
                for (int j = 0; j < 8; ++j) {
                    unsigned* d = S32 + (i * 16 + fr) * 257 + hh * 128 + half * 64 + j * 8 + fq * 2;
                    d[0] = pk_f16(acc[i][j][0], acc[i][j][1]); d[1] = pk_f16(acc[i][j][2], acc[i][j][3]);
                }
        }
        __syncthreads();
        int a[16];
#pragma unroll
        for (int i = 0; i < 16; ++i) a[i] = (int)0x80000000;
        {
            const unsigned* sr = S32 + lane * 257 + hh * 128 + half * 64;
#pragma unroll 2
            for (int i = 0; i < 64; ++i) {
                const unsigned w = sr[i];
                const int k0 = (h2key(w & 0xffffu) << 7) | (2 * i), k1 = (h2key(w >> 16) << 7) | (2 * i + 1);
                INS16(a, k0); INS16(a, k1);
            }
        }
        __syncthreads();
#pragma unroll
        for (int i = 0; i < 16; ++i) TT[((lane * 2 + hh) * 2 + half) * 16 + i] = a[i];
        __syncthreads();
        if (tid < 128) {
            const int tk = tid & 63, h2 = tid >> 6, hd = hp * 2 + h2;
            const int* t1 = TT + ((tk * 2 + h2) * 2) * 16; const int* t2 = t1 + 16;
            float f1[16], f2[16];
#pragma unroll
            for (int i = 0; i < 16; ++i) { f1[i] = key2h(t1[i] >> 7); f2[i] = key2h(t2[i] >> 7); }
            int c[16];
#pragma unroll
            for (int i = 0; i < 16; ++i) c[i] = (int)0x80000000;
            CandLoop<0, 0>::run(c, f1, f2);
            float sc[16], e[16], sum = 0.f; int ex[16];
#pragma unroll
            for (int i = 0; i < 16; ++i) {
                sc[i] = key2f(c[i] & ~255);
                const int code = c[i] & 255;
                ex[i] = (t1[code >> 4] & 127) * 128 + (t2[code & 15] & 127);
            }
#pragma unroll
            for (int i = 0; i < 16; ++i) { e[i] = __expf(sc[i] - sc[0]); sum += e[i]; }
            const float inv = 1.0f / sum;
            int4* ep = (int4*)(eidx + (size_t)(tok0 + tk) * 128 + hd * 16); float4* gp = (float4*)(gw + (size_t)(tok0 + tk) * 128 + hd * 16);
#pragma unroll
            for (int i = 0; i < 4; ++i) { ep[i] = make_int4(ex[4 * i], ex[4 * i + 1], ex[4 * i + 2], ex[4 * i + 3]); gp[i] = make_float4(e[4 * i] * inv, e[4 * i + 1] * inv, e[4 * i + 2] * inv, e[4 * i + 3] * inv); }
        }
        __syncthreads();
    }
}

__device__ __forceinline__ float dot16_fp8(const float (&h)[16], const int4& u) {
    const int w[4] = {u.x, u.y, u.z, u.w};
    f32x2_t a = {0.f, 0.f};
#pragma unroll
    for (int i = 0; i < 4; ++i) {
        const f32x2_t lo = __builtin_amdgcn_cvt_pk_f32_fp8(w[i], false), hi = __builtin_amdgcn_cvt_pk_f32_fp8(w[i], true);
        const f32x2_t h0 = {h[4 * i], h[4 * i + 1]}, h1 = {h[4 * i + 2], h[4 * i + 3]};
        a = __builtin_elementwise_fma(lo, h0, a); a = __builtin_elementwise_fma(hi, h1, a);
    }
    return a.x + a.y;
}
__device__ __forceinline__ void axpy16_fp8(float (&o)[16], float c, const int4& v) {
    const int w[4] = {v.x, v.y, v.z, v.w};
#pragma unroll
    for (int i = 0; i < 4; ++i) {
        const f32x2_t lo = __builtin_amdgcn_cvt_pk_f32_fp8(w[i], false), hi = __builtin_amdgcn_cvt_pk_f32_fp8(w[i], true);
        o[4 * i] += c * lo.x; o[4 * i + 1] += c * lo.y; o[4 * i + 2] += c * hi.x; o[4 * i + 3] += c * hi.y;
    }
}

__device__ void phase_pu(const Params& p, int l, int slice, int grank, int gsz) {
    const int tid_ = otid(); const int lane = tid_ & 63, wid = tid_ >> 6, sub = lane & 7, pg = lane >> 3;
    const bf16_t* H = (const bf16_t*)(p.ws + OFF_H) + slice * 128 + sub * 16;
    const char* U8 = p.ws + OFF_UB + ((size_t)(l * 8 + slice) * NE) * 128 + sub * 16;
    const int* eidx = (const int*)(p.ws + OFF_Y) + lane;
    float* part = (float*)(p.ws + OFF_Z) + (size_t)slice * T * 128 + 16 * sub + pg;
    const int stride = gsz * 4;
#define PU_ISSUE(e_, u_) do { _Pragma("unroll") for (int q = 0; q < 8; ++q) { const int ej = __shfl(e_, 8 * q + pg); u_[q] = *(const int4*)(U8 + (size_t)ej * 128); } } while (0)
    int tok = grank * 4 + wid;
    if (tok >= T) return;
    int4 uA[8], uB[8];
    int ea = eidx[(size_t)tok * 128], eb = eidx[(size_t)tok * 128 + 64];
    uint4 h0 = *(const uint4*)(H + (size_t)tok * D), h1 = *(const uint4*)(H + (size_t)tok * D + 8);
    PU_ISSUE(ea, uA);
#pragma nounroll
    for (;;) {
        __builtin_amdgcn_sched_barrier(0);
        const int tokn = tok + stride; const bool more = tokn < T;
        int ean = 0, ebn = 0; uint4 h0n = h0, h1n = h1;
        if (more) { ean = eidx[(size_t)tokn * 128]; ebn = eidx[(size_t)tokn * 128 + 64]; h0n = *(const uint4*)(H + (size_t)tokn * D); h1n = *(const uint4*)(H + (size_t)tokn * D + 8); }
        PU_ISSUE(eb, uB);
        __builtin_amdgcn_sched_barrier(0);
        float hf[16];
        { const unsigned w_[8] = {h0.x, h0.y, h0.z, h0.w, h1.x, h1.y, h1.z, h1.w};
#pragma unroll
          for (int i = 0; i < 8; ++i) { hf[2 * i] = bf2f(w_[i] & 0xffffu); hf[2 * i + 1] = bf2f(w_[i] >> 16); } }
        float v[16];
#pragma unroll
        for (int q = 0; q < 8; ++q) v[q] = dot16_fp8(hf, uA[q]);
        __builtin_amdgcn_sched_barrier(0);
        if (more) PU_ISSUE(ean, uA);
        __builtin_amdgcn_sched_barrier(0);
#pragma unroll
        for (int q = 0; q < 8; ++q) v[8 + q] = dot16_fp8(hf, uB[q]);
        float w8[8], w4[4], w2[2];
        { const bool hi = (lane & 4) != 0;
#pragma unroll
          for (int m = 0; m < 8; ++m) { const float send = hi ? v[m] : v[m + 8], keep = hi ? v[m + 8] : v[m]; w8[m] = keep + __shfl_xor(send, 4); } }
        { const bool hi = (lane & 2) != 0;
#pragma unroll
          for (int m = 0; m < 4; ++m) { const float send = hi ? w8[m] : w8[m + 4], keep = hi ? w8[m + 4] : w8[m]; w4[m] = keep + __shfl_xor(send, 2); } }
        { const bool hi = (lane & 1) != 0;
#pragma unroll
          for (int m = 0; m < 2; ++m) { const float send = hi ? w4[m] : w4[m + 2], keep = hi ? w4[m + 2] : w4[m]; w2[m] = keep + __shfl_xor(send, 1); } }
        float* pr = part + (size_t)tok * 128;
        pr[0] = w2[0]; pr[8] = w2[1];
        if (!more) break;
        tok = tokn; ea = ean; eb = ebn; h0 = h0n; h1 = h1n;
    }
#undef PU_ISSUE
}
__device__ void phase_pc(const Params& p, int l, int bid, int nb) {
    const int tid_ = otid(); const int lane = tid_ & 63, wid = tid_ >> 6;
    const int* eidx = (const int*)(p.ws + OFF_Y); const float* gw = (const float*)(p.ws + OFF_Y + (size_t)T * 128 * 4);
    float* coef = (float*)(p.ws + OFF_Y + (size_t)T * 128 * 8);
    const float* part = (const float*)(p.ws + OFF_Z);
    const float* usc = (const float*)(p.ws + OFF_USC) + (size_t)l * NE; const float* vsc = (const float*)(p.ws + OFF_VSC) + (size_t)l * NE;
    for (int tok = bid * 4 + wid; tok < T; tok += nb * 4) {
#pragma unroll
        for (int hh = 0; hh < 2; ++hh) {
            const size_t j = (size_t)tok * 128 + hh * 64 + lane;
            const int e = eidx[j]; const float g = gw[j];
            float a = 0.f;
#pragma unroll
            for (int sl = 0; sl < 8; ++sl) a += part[(size_t)sl * T * 128 + j];
            coef[j] = g * gelu_f(a * usc[e]) * vsc[e];
        }
    }
}
typedef _Float16 h2_t __attribute__((ext_vector_type(2)));
__device__ __forceinline__ void axpy32_fp4(h2_t (&o)[16], h2_t c, const int4& v) {
    const unsigned w[4] = {(unsigned)v.x, (unsigned)v.y, (unsigned)v.z, (unsigned)v.w};
#pragma unroll
    for (int i = 0; i < 4; ++i) {
        o[4 * i]     = __builtin_elementwise_fma(__builtin_bit_cast(h2_t, __builtin_amdgcn_cvt_scalef32_pk_f16_fp4(w[i], 1.0f, 0)), c, o[4 * i]);
        o[4 * i + 1] = __builtin_elementwise_fma(__builtin_bit_cast(h2_t, __builtin_amdgcn_cvt_scalef32_pk_f16_fp4(w[i], 1.0f, 1)), c, o[4 * i + 1]);
        o[4 * i + 2] = __builtin_elementwise_fma(__builtin_bit_cast(h2_t, __builtin_amdgcn_cvt_scalef32_pk_f16_fp4(w[i], 1.0f, 2)), c, o[4 * i + 2]);
        o[4 * i + 3] = __builtin_elementwise_fma(__builtin_bit_cast(h2_t, __builtin_amdgcn_cvt_scalef32_pk_f16_fp4(w[i], 1.0f, 3)), c, o[4 * i + 3]);
    }
}
__device__ void phase_pv(const Params& p, int l, int slice, int grank, int gsz) {
    const int tid_ = otid(); const int lane = tid_ & 63, wid = tid_ >> 6, sub = lane & 7, pg = lane >> 3;
    const char* V4 = p.ws + OFF_VB + ((size_t)(l * 4 + slice) * NE) * 128 + sub * 16;
    const int* eidx = (const int*)(p.ws + OFF_Y) + lane;
    const float* coef = (const float*)(p.ws + OFF_Y + (size_t)T * 128 * 8) + lane;
    const int col = slice * 256 + 32 * sub + 4 * pg;
    const float* g2p = (const float*)(p.ws + OFF_MOD) + (size_t)l * NB * 6144 + 5 * D + col;
    bf16_t* xcol = (bf16_t*)(p.ws + OFF_XR) + col;
    const int stride = gsz * 4;
#define PV_ISSUE(e_, c_, v_, cj_) do { _Pragma("unroll") for (int q = 0; q < 8; ++q) { const int ej = __shfl(e_, 8 * q + pg); const _Float16 ch_ = (_Float16)(64.0f * __shfl(c_, 8 * q + pg)); cj_[q] = (h2_t){ch_, ch_}; v_[q] = *(const int4*)(V4 + (size_t)ej * 128); } } while (0)
    int tok = grank * 4 + wid;
    if (tok >= T) return;
    int4 vA[8], vB[8]; h2_t cA[8], cB[8];
    int ea = eidx[(size_t)tok * 128], eb = eidx[(size_t)tok * 128 + 64];
    float ca = coef[(size_t)tok * 128], cb = coef[(size_t)tok * 128 + 64];
    PV_ISSUE(ea, ca, vA, cA);
#pragma nounroll
    for (;;) {
        __builtin_amdgcn_sched_barrier(0);
        const int tokn = tok + stride; const bool more = tokn < T;
        int ean = 0, ebn = 0; float can = 0.f, cbn = 0.f;
        if (more) { ean = eidx[(size_t)tokn * 128]; ebn = eidx[(size_t)tokn * 128 + 64]; can = coef[(size_t)tokn * 128]; cbn = coef[(size_t)tokn * 128 + 64]; }
        uint2* xp = (uint2*)(xcol + (size_t)tok * D); const float4 g2 = *(const float4*)(g2p + (size_t)(tok / SEQ) * 6144);
        const uint2 xw = *xp;
        PV_ISSUE(eb, cb, vB, cB);
        __builtin_amdgcn_sched_barrier(0);
        h2_t oh[16];
#pragma unroll
        for (int i = 0; i < 16; ++i) oh[i] = (h2_t){(_Float16)0.f, (_Float16)0.f};
#pragma unroll
        for (int q = 0; q < 8; ++q) axpy32_fp4(oh, cA[q], vA[q]);
        __builtin_amdgcn_sched_barrier(0);
        if (more) PV_ISSUE(ean, can, vA, cA);
        __builtin_amdgcn_sched_barrier(0);
#pragma unroll
        for (int q = 0; q < 8; ++q) axpy32_fp4(oh, cB[q], vB[q]);
        __builtin_amdgcn_sched_barrier(0);
        float t16[16], t8[8], t4[4];
        { const bool hi = (lane & 32) != 0;
#pragma unroll
          for (int m = 0; m < 8; ++m) {
              const float lo0 = (float)oh[m].x, lo1 = (float)oh[m].y, hi0 = (float)oh[8 + m].x, hi1 = (float)oh[8 + m].y;
              t16[2 * m]     = (hi ? hi0 : lo0) + __shfl_xor(hi ? lo0 : hi0, 32);
              t16[2 * m + 1] = (hi ? hi1 : lo1) + __shfl_xor(hi ? lo1 : hi1, 32); } }
        { const bool hi = (lane & 16) != 0;
#pragma unroll
          for (int m = 0; m < 8; ++m) { const float send = hi ? t16[m] : t16[m + 8], keep = hi ? t16[m + 8] : t16[m]; t8[m] = keep + __shfl_xor(send, 16); } }
        { const bool hi = (lane & 8) != 0;
#pragma unroll
          for (int m = 0; m < 4; ++m) { const float send = hi ? t8[m] : t8[m + 4], keep = hi ? t8[m + 4] : t8[m]; t4[m] = keep + __shfl_xor(send, 8); } }
        const float k64 = 1.0f / 64.0f;
        *xp = make_uint2(pk_bf16(bf2f(xw.x & 0xffffu) + g2.x * k64 * t4[0], bf2f(xw.x >> 16) + g2.y * k64 * t4[1]), pk_bf16(bf2f(xw.y & 0xffffu) + g2.z * k64 * t4[2], bf2f(xw.y >> 16) + g2.w * k64 * t4[3]));
        if (!more) break;
        tok = tokn; ea = ean; eb = ebn; ca = can; cb = cbn;
    }
#undef PV_ISSUE
}
__device__ void phase_final_norm(const Params& p, int bid, int nb) {
    const int tid_ = otid(); const int lane = tid_ & 63, wid = tid_ >> 6;
    for (int tok = bid * 4 + wid; tok < T; tok += nb * 4) {
        float* xr = p.out + (size_t)tok * D;
        const bf16_t* xs = (const bf16_t*)(p.ws + OFF_XR) + (size_t)tok * D;
        float4 v[4]; float ss = 0.f;
#pragma unroll
        for (int i = 0; i < 4; ++i) { const uint2 w = *(const uint2*)(xs + i * 256 + lane * 4); v[i] = make_float4(bf2f(w.x & 0xffffu), bf2f(w.x >> 16), bf2f(w.y & 0xffffu), bf2f(w.y >> 16));
            ss += v[i].x * v[i].x + v[i].y * v[i].y + v[i].z * v[i].z + v[i].w * v[i].w; }
        ss = wave_sum(ss);
        const float rstd = rsqrtf(ss * (1.0f / D) + EPS);
#pragma unroll
        for (int i = 0; i < 4; ++i) { const float4 g = *(const float4*)(p.final_g + i * 256 + lane * 4);
            *(float4*)(xr + i * 256 + lane * 4) = make_float4(v[i].x * rstd * g.x, v[i].y * rstd * g.y, v[i].z * rstd * g.z, v[i].w * rstd * g.w); }
    }
}

#define XB_TMO      128
#define XB_XCNT(j)  (256  + 64 * (j))
#define XB_XSUB(j)  (1280 + 64 * (j))
#define XB_XGEN(j)  (2304 + 64 * (j))
#define XB_TOP      3328
#define XB_TOPGEN   3392
#define XCD_BAR_WORDS 3456
#define XB_SPIN_CAP (1u << 22)
__device__ __forceinline__ unsigned xb_ld(unsigned* p)              { return __hip_atomic_load(p, __ATOMIC_RELAXED, __HIP_MEMORY_SCOPE_AGENT); }
__device__ __forceinline__ unsigned xb_add(unsigned* p, unsigned v) { return __hip_atomic_fetch_add(p, v, __ATOMIC_RELAXED, __HIP_MEMORY_SCOPE_AGENT); }
__device__ __forceinline__ unsigned xb_xcc_id() { return (unsigned)__builtin_amdgcn_s_getreg((3 << 11) | 20) & 0xFu; }
#define XB_SPIN(cond, bar) do { unsigned _sp = 0; while (cond) { __builtin_amdgcn_s_sleep(1); \
    if ((++_sp & 255u) == 0u) { if (xb_ld(&(bar)[XB_TMO])) break; if (_sp > XB_SPIN_CAP) { atomicAdd(&(bar)[XB_TMO], 1u); break; } } } } while (0)
__device__ __forceinline__ void xcd_barrier_post(unsigned* bar, volatile LAS unsigned* st) {
    if (threadIdx.x == 0) { const unsigned x = xb_xcc_id(); st[3] = x; st[2] = xb_add(&bar[XB_XCNT(x)], 1u); }
}
__device__ __forceinline__ void xcd_barrier_complete(unsigned* bar, unsigned x, unsigned& nloc, unsigned& nx) {
    const unsigned G = gridDim.x * gridDim.y * gridDim.z;
    unsigned sum, cnt, mine, sp = 0u;
    for (;;) {
        sum = 0u; cnt = 0u; mine = 0u;
#pragma unroll
        for (unsigned j = 0; j < 16; ++j) { const unsigned c = xb_ld(&bar[XB_XCNT(j)]); sum += c; cnt += (c > 0u) ? 1u : 0u; mine = (j == x) ? c : mine; }
        if (sum == G) break;
        __builtin_amdgcn_s_sleep(1);
        if ((++sp & 255u) == 0u) { if (xb_ld(&bar[XB_TMO])) break; if (sp > XB_SPIN_CAP) { atomicAdd(&bar[XB_TMO], 1u); break; } }
    }
    nloc = mine > 0u ? mine : 1u; nx = cnt > 0u ? cnt : 1u;
}
__device__ __forceinline__ void xcd_barrier(unsigned* bar, volatile LAS unsigned* st) {
    asm volatile("s_waitcnt vmcnt(0)" ::: "memory");
    __syncthreads();
    if (threadIdx.x == 0) {
        __builtin_amdgcn_s_waitcnt(0);
        unsigned nloc = st[0], nx = st[1]; const unsigned x = st[3];
        if (nloc == 0u) { xcd_barrier_complete(bar, x, nloc, nx); st[0] = nloc; st[1] = nx; }
        const unsigned old = xb_add(&bar[XB_XSUB(x)], 1u);
        const unsigned gen = old / nloc;
        if (old + 1u == (gen + 1u) * nloc) {
            __builtin_amdgcn_fence(__ATOMIC_RELEASE, "agent");
            asm volatile("s_waitcnt vmcnt(0)" ::: "memory");
            const unsigned og = xb_add(&bar[XB_TOP], 1u);
            const unsigned tg = og / nx;
            if (og + 1u == (tg + 1u) * nx) xb_add(&bar[XB_TOPGEN], 1u);
            else XB_SPIN(xb_ld(&bar[XB_TOPGEN]) == tg, bar);
            __builtin_amdgcn_fence(__ATOMIC_ACQUIRE, "agent");
            xb_add(&bar[XB_XGEN(x)], 1u);
            asm volatile("s_waitcnt vmcnt(0)" ::: "memory");
        } else {
            XB_SPIN(xb_ld(&bar[XB_XGEN(x)]) == gen, bar);
            __builtin_amdgcn_fence(__ATOMIC_ACQUIRE, "agent");
            asm volatile("s_waitcnt vmcnt(0)" ::: "memory");
        }
    }
    __syncthreads();
}

#if MEGA
#if PROBE_A >= 0
#define TSTAMP(i) do { if (blockIdx.x == 0 && threadIdx.x == 0) ts[i] = __builtin_amdgcn_s_memrealtime(); } while (0)
#else
#define TSTAMP(i) do { } while (0)
#endif
__global__ void __launch_bounds__(256, 2) mega_kernel(Params p) {
    __shared__ __attribute__((aligned(16))) char smem[SMEM_BYTES];
    __shared__ uint4 xb_words;
#if PROBE_A >= 0
    __shared__ unsigned long long ts[26];
#endif
    cg::grid_group grid = cg::this_grid();
    const int bid = blockIdx.x, nb = gridDim.x;
    unsigned* bar = (unsigned*)(p.ws + OFF_BAR);
    if (threadIdx.x == 0) xb_words = make_uint4(0u, 0u, 0u, 0u);
    if (bid == 0) for (int i = threadIdx.x; i < XCD_BAR_WORDS; i += 256) bar[i] = 0u;
    TSTAMP(0);
    phase_prep(p, smem, bid, nb);
    grid.sync();
    volatile LAS unsigned* xst = (volatile LAS unsigned*)&xb_words;
    xcd_barrier_post(bar, xst);
    TSTAMP(1);
    phase_norm<false>(p.x, p.norm1_g, (const float*)(p.ws + OFF_MOD), 0, D, (bf16_t*)(p.ws + OFF_H), bid, nb); xcd_barrier((unsigned*)(p.ws + OFF_BAR), (volatile LAS unsigned*)&xb_words);
    int slice, grank, slice4, grank4; const int gsz = nb / 8, gsz4 = nb / 4;
    {
        const unsigned myx = xst[3], myrank = xst[2];
        unsigned pre = 0;
#pragma unroll
        for (unsigned j = 0; j < 16; ++j) { const unsigned c = xb_ld(&bar[XB_XCNT(j)]); pre += (j < myx) ? c : 0u; }
        const int gi = __builtin_amdgcn_readfirstlane((int)(pre + myrank));
        slice = gi / gsz; grank = gi % gsz; slice4 = gi / gsz4; grank4 = gi % gsz4;
    }
#pragma nounroll
    for (int l = 0; l < NL; ++l) {
        TSTAMP(2 + 11 * l); phase_gemm1(p, l, smem, bid, nb); xcd_barrier((unsigned*)(p.ws + OFF_BAR), (volatile LAS unsigned*)&xb_words);
        TSTAMP(3 + 11 * l); phase_mix(p, l, smem, bid, nb); xcd_barrier((unsigned*)(p.ws + OFF_BAR), (volatile LAS unsigned*)&xb_words);
        TSTAMP(4 + 11 * l); phase_fftb(p, l, smem, bid, nb); xcd_barrier((unsigned*)(p.ws + OFF_BAR), (volatile LAS unsigned*)&xb_words);
        TSTAMP(5 + 11 * l); phase_gemm2(p, l, smem, bid, nb); xcd_barrier((unsigned*)(p.ws + OFF_BAR), (volatile LAS unsigned*)&xb_words);
        TSTAMP(6 + 11 * l); phase_norm<true>(p.ws + OFF_XR, p.norm2_g + l * D, (const float*)(p.ws + OFF_MOD) + (size_t)l * NB * 6144, 3 * D, 4 * D, (bf16_t*)(p.ws + OFF_H), bid, nb); xcd_barrier((unsigned*)(p.ws + OFF_BAR), (volatile LAS unsigned*)&xb_words);
        TSTAMP(7 + 11 * l); phase_gemm3(p, l, smem, bid, nb); xcd_barrier((unsigned*)(p.ws + OFF_BAR), (volatile LAS unsigned*)&xb_words);
        TSTAMP(8 + 11 * l); phase_topk(p, l, smem, bid, nb); xcd_barrier((unsigned*)(p.ws + OFF_BAR), (volatile LAS unsigned*)&xb_words);
        TSTAMP(9 + 11 * l); phase_pu(p, l, slice, grank, gsz); xcd_barrier((unsigned*)(p.ws + OFF_BAR), (volatile LAS unsigned*)&xb_words);
        TSTAMP(10 + 11 * l); phase_pc(p, l, bid, nb); xcd_barrier((unsigned*)(p.ws + OFF_BAR), (volatile LAS unsigned*)&xb_words);
        TSTAMP(11 + 11 * l); phase_pv(p, l, slice4, grank4, gsz4); xcd_barrier((unsigned*)(p.ws + OFF_BAR), (volatile LAS unsigned*)&xb_words);
        TSTAMP(12 + 11 * l);
        if (l + 1 < NL) { phase_norm<true>(p.ws + OFF_XR, p.norm1_g + (l + 1) * D, (const float*)(p.ws + OFF_MOD) + (size_t)(l + 1) * NB * 6144, 0, D, (bf16_t*)(p.ws + OFF_H), bid, nb); xcd_barrier((unsigned*)(p.ws + OFF_BAR), (volatile LAS unsigned*)&xb_words); }
        else phase_final_norm(p, bid, nb);
    }
    TSTAMP(24);
#if PROBE_A >= 0
    if (bid == 0 && threadIdx.x == 0) p.out[0] += (float)(ts[PROBE_B] - ts[PROBE_A]) * 0.01f / PROBE_DIV;
#endif
}
#endif

extern "C" void kernel_launch(void* const* d_in, const int* in_sizes, int n_in, void* d_out, int out_size, void* d_ws, size_t ws_size, hipStream_t stream) {
    (void)in_sizes; (void)n_in; (void)out_size;
    if (ws_size < OFF_END) { fprintf(stderr, "workspace too small: %zu < %zu\n", ws_size, (size_t)OFF_END); return; }
    Params p{};
    p.x = (const float*)d_in[0]; p.c = (const float*)d_in[1]; p.mod_w = (const float*)d_in[2]; p.mod_b = (const float*)d_in[3]; p.norm1_g = (const float*)d_in[4];
    p.w_in = (const float*)d_in[5]; p.gmlp_ws = (const float*)d_in[6]; p.gmlp_bs = (const float*)d_in[7]; p.fnet_w = (const float*)d_in[8]; p.fnet_b = (const float*)d_in[9];
    p.gain_a = (const float*)d_in[10]; p.gain_b = (const float*)d_in[11]; p.w_out = (const float*)d_in[12]; p.norm2_g = (const float*)d_in[13]; p.wq = (const float*)d_in[14];
    p.k1 = (const float*)d_in[15]; p.k2 = (const float*)d_in[16]; p.pu = (const float*)d_in[17]; p.pv = (const float*)d_in[18]; p.final_g = (const float*)d_in[19];
    p.out = (float*)d_out; p.ws = (char*)d_ws;
#if MEGA
    static int grid_blocks = 0;
    if (!grid_blocks) {
        int dev = 0, cus = 0, per_cu = 0;
        hipGetDevice(&dev);
        hipDeviceGetAttribute(&cus, hipDeviceAttributeMultiprocessorCount, dev);
        hipOccupancyMaxActiveBlocksPerMultiprocessor(&per_cu, mega_kernel, 256, 0);
        if (per_cu > 2) per_cu = 2;
        grid_blocks = (cus * per_cu) / 8 * 8;
    }
    void* args[] = {&p};
    hipError_t e = hipLaunchCooperativeKernel((void*)mega_kernel, dim3(grid_blocks), dim3(256), args, 0, stream);
    if (e != hipSuccess) fprintf(stderr, "cooperative launch failed: %s (grid %d)\n", hipGetErrorString(e), grid_blocks);
#endif
}
```

```cpp
#include <hip/hip_runtime.h>
#include <hip/hip_cooperative_groups.h>
#include <cstdio>
#include <cstdint>
namespace cg = cooperative_groups;

#ifndef MEGA
#define MEGA 1
#endif
#ifndef PROBE_A
#define PROBE_A -1
#define PROBE_B 0
#define PROBE_DIV 10.0f
#endif

typedef unsigned short bf16_t;
typedef short bf16x8 __attribute__((ext_vector_type(8)));
typedef float f32x4 __attribute__((ext_vector_type(4)));
typedef __bf16 bf16x2_t __attribute__((ext_vector_type(2)));

constexpr int D = 1024, NB = 8, SEQ = 4096, T = NB * SEQ, NL = 2;
constexpr int NZ = 2048;
constexpr int NE = 16384;
constexpr float EPS = 1e-6f;

constexpr size_t OFF_MOD  = 0;
constexpr size_t OFF_W1T  = OFF_MOD  + (size_t)NL * NB * 6144 * 4;
constexpr size_t OFF_W2T  = OFF_W1T  + (size_t)NL * 2048 * 1024 * 2;
constexpr size_t OFF_WQT  = OFF_W2T  + (size_t)NL * 1024 * 1024 * 2;
constexpr size_t OFF_K12  = OFF_WQT  + (size_t)NL * 2048 * 1024 * 2;
constexpr size_t OFF_WSB  = OFF_K12  + (size_t)NL * 8 * 256 * 128 * 2;
constexpr size_t OFF_DA   = OFF_WSB  + (size_t)NL * 8 * 128 * 128 * 2;
constexpr size_t OFF_DB   = OFF_DA   + 128 * 128 * 2;
constexpr size_t OFF_TW   = OFF_DB   + 64 * 128 * 2;
constexpr size_t OFF_SSQA = OFF_TW   + 64 * 64 * 8;
constexpr size_t OFF_SSQB = OFF_SSQA + (size_t)T * 8 * 4;
constexpr size_t OFF_UB   = OFF_SSQB + (size_t)T * 8 * 4;
constexpr size_t OFF_VB   = OFF_UB   + (size_t)NL * NE * 1024;
constexpr size_t OFF_USC  = OFF_VB   + (size_t)NL * NE * 1024;
constexpr size_t OFF_VSC  = OFF_USC  + (size_t)NL * NE * 4;
constexpr size_t OFF_H    = OFF_VSC  + (size_t)NL * NE * 4;
constexpr size_t OFF_Z    = OFF_H    + (size_t)T * 1024 * 2;
constexpr size_t OFF_Y    = OFF_Z    + (size_t)T * 2048 * 2;
constexpr size_t OFF_BAR  = OFF_Y    + (size_t)T * 1024 * 2;
constexpr size_t OFF_XR   = OFF_BAR  + 16384;
constexpr size_t OFF_END  = OFF_XR   + (size_t)T * 1024 * 2;

struct Params {
    const float* x; const float* c; const float* mod_w; const float* mod_b; const float* norm1_g; const float* w_in;
    const float* gmlp_ws; const float* gmlp_bs; const float* fnet_w; const float* fnet_b; const float* gain_a; const float* gain_b;
    const float* w_out; const float* norm2_g; const float* wq; const float* k1; const float* k2; const float* pu; const float* pv; const float* final_g;
    float* out; char* ws;
};

constexpr int SMEM_BYTES = 73984;

__device__ __forceinline__ float bf2f(unsigned v) { return __uint_as_float(v << 16); }
typedef float f32x2_t __attribute__((ext_vector_type(2)));
__device__ __forceinline__ unsigned pk_bf16(float lo, float hi) { const f32x2_t v = {lo, hi}; return __builtin_bit_cast(unsigned, __builtin_convertvector(v, bf16x2_t)); }
__device__ __forceinline__ bf16_t f2bf(float f) { return (bf16_t)(pk_bf16(f, 0.f) & 0xffffu); }
__device__ __forceinline__ float gelu_f(float v) {
    const float t = __builtin_amdgcn_rcpf(fabsf(v) * 0.2316418882f + 1.0f);
    float q = t * 0.5307027145f + (-0.7265760135f); q = q * t + 0.7107068705f; q = q * t + (-0.142248368f); q = q * t + 0.127414796f; q = q * t;
    const float m = v * (q * __builtin_amdgcn_exp2f(v * v * (-0.72134752044f)));
    return v < 0.f ? m : v - m;
}
__device__ __forceinline__ int med3i(int a, int b, int c) { return max(min(a, b), min(max(a, b), c)); }
__device__ __forceinline__ int f2key(float f) { int b = __float_as_int(f); return b ^ ((b >> 31) & 0x7fffffff); }
__device__ __forceinline__ float key2f(int k) { return __int_as_float(k ^ ((k >> 31) & 0x7fffffff)); }
__device__ __forceinline__ float wave_sum(float v) {
#pragma unroll
    for (int o = 32; o >= 1; o >>= 1) v += __shfl_xor(v, o);
    return v;
}
__device__ __forceinline__ int otid() { int t = threadIdx.x; asm volatile("" : "+v"(t)); return t; }
#define MFMA16(a, b, c) __builtin_amdgcn_mfma_f32_16x16x32_bf16((a), (b), (c), 0, 0, 0)

__device__ void transpose_tile(const float* __restrict__ src, int ld, int k0, int n0, bf16_t* __restrict__ dst  , int dn0,
                               const float* __restrict__ kscale, float* tile  ) {
    const int tid = otid();
#pragma unroll
    for (int i = 0; i < 4; ++i) {
        const int r = (tid >> 4) + 16 * i, c4 = (tid & 15) * 4;
        const float4 v = *(const float4*)(src + (size_t)(k0 + r) * ld + n0 + c4);
        const float s = kscale ? kscale[k0 + r] : 1.0f;
        tile[r * 65 + c4 + 0] = v.x * s; tile[r * 65 + c4 + 1] = v.y * s; tile[r * 65 + c4 + 2] = v.z * s; tile[r * 65 + c4 + 3] = v.w * s;
    }
    __syncthreads();
    {
        const int n = tid >> 2, ks = (tid & 3) * 16;
        unsigned w[8];
#pragma unroll
        for (int j = 0; j < 8; ++j) w[j] = pk_bf16(tile[(ks + 2 * j) * 65 + n], tile[(ks + 2 * j + 1) * 65 + n]);
        uint4* d = (uint4*)(dst + (size_t)(dn0 + n) * 1024 + k0 + ks);
        d[0] = make_uint4(w[0], w[1], w[2], w[3]); d[1] = make_uint4(w[4], w[5], w[6], w[7]);
    }
    __syncthreads();
}

__device__ void phase_prep(const Params& p, char* smem, int bid_, int nb_) {
    const int tid = otid();
    char* ws = p.ws;
    const bool convgrp = (nb_ >= 2) && (bid_ & 1);
    const int bid = (nb_ >= 2) ? (bid_ >> 1) : bid_, nb = (nb_ >= 2) ? ((nb_ + 1 - (bid_ & 1)) >> 1) : nb_;
    const int gtid = bid * 256 + tid, gsz = nb * 256;
    if (!convgrp) {
    {
        float* sc = (float*)smem;
        float* red = (float*)(smem + 32768);
        for (int i = tid; i < 8192; i += 256) { const float v = p.c[i]; sc[i] = v / (1.0f + __expf(-v)); }
        __syncthreads();
        float* mod = (float*)(ws + OFF_MOD);
        for (int item = bid; item < NL * 192; item += nb) {
            const int l = item / 192, n0 = (item % 192) * 32, nn = tid & 31, kq = tid >> 5;
            float acc[8];
#pragma unroll
            for (int b = 0; b < 8; ++b) acc[b] = 0.f;
            const float* W = p.mod_w + (size_t)l * 1024 * 6144 + n0 + nn;
#pragma nounroll
            for (int k0 = kq; k0 < 1024; k0 += 128) {
                float w[16];
#pragma unroll
                for (int u = 0; u < 16; ++u) w[u] = W[(size_t)(k0 + 8 * u) * 6144];
#pragma unroll
                for (int u = 0; u < 16; ++u)
#pragma unroll
                    for (int b = 0; b < 8; ++b) acc[b] += sc[b * 1024 + k0 + 8 * u] * w[u];
            }
#pragma unroll
            for (int b = 0; b < 8; ++b) red[(kq * 8 + b) * 32 + nn] = acc[b];
            __syncthreads();
            {
                const int b = tid >> 5;
                float s = 0.f;
#pragma unroll
                for (int q = 0; q < 8; ++q) s += red[(q * 8 + b) * 32 + nn];
                mod[((size_t)l * NB + b) * 6144 + n0 + nn] = s + p.mod_b[l * 6144 + n0 + nn];
            }
            __syncthreads();
        }
    }
    {
        float* tile = (float*)smem;
        for (int item = bid; item < NL * 1024; item += nb) {
            const int l = item / 1024, r = item % 1024;
            if (r < 256) {
                const int kt = r / 16, nt = r % 16;
                transpose_tile(p.w_in + (size_t)l * 1024 * 1536, 1536, kt * 64, nt * 64, (bf16_t*)(ws + OFF_W1T) + (size_t)l * 2048 * 1024, nt * 64, nullptr, tile);
            } else if (r < 512) {
                const int rr = r - 256, kt = rr / 16, nt = rr % 16;
                const float* gk = (kt < 8) ? (p.gain_a + l * 512) : (p.gain_b + l * 512 - 512);
                transpose_tile(p.w_out + (size_t)l * 1024 * 1024, 1024, kt * 64, nt * 64, (bf16_t*)(ws + OFF_W2T) + (size_t)l * 1024 * 1024, nt * 64, gk, tile);
            } else {
                const int rr = r - 512, kt = rr / 32, nt = rr % 32;
                transpose_tile(p.wq + (size_t)l * 1024 * 2048, 2048, kt * 64, nt * 64, (bf16_t*)(ws + OFF_WQT) + (size_t)l * 2048 * 1024, nt * 64, nullptr, tile);
            }
        }
    }
    {
        float* fws = (float*)smem;
        float* Ms  = (float*)(smem + 16384);
        float* wt  = (float*)(smem + 49152);
        float* cs  = (float*)(smem + 49152 + 16640);
        for (int item = bid; item < NL * 8 * 16; item += nb) {
            const int l = item / 128, g = (item % 128) / 16, kt = item % 16;
            if (tid < 64) { float s, c; sincospif((float)tid / 32.0f, &s, &c); cs[tid] = c; cs[64 + tid] = s; }
            for (int i = tid; i < 4096; i += 256) fws[i] = p.fnet_w[((size_t)l * 8 + g) * 4096 + i];
#pragma unroll
            for (int i = 0; i < 4; ++i) {
                const int r = (tid >> 4) + 16 * i, c4 = (tid & 15) * 4;
                const float4 v = *(const float4*)(p.w_in + (size_t)l * 1024 * 1536 + (size_t)(kt * 64 + r) * 1536 + 1024 + g * 64 + c4);
                wt[r * 65 + c4] = v.x; wt[r * 65 + c4 + 1] = v.y; wt[r * 65 + c4 + 2] = v.z; wt[r * 65 + c4 + 3] = v.w;
            }
            __syncthreads();
            {
                const int d = tid >> 2, r0 = (tid & 3) * 32;
                const bool im = r0 >= 64; const int e0 = r0 & 63;
                float acc[32];
#pragma unroll
                for (int e = 0; e < 32; ++e) acc[e] = 0.f;
                for (int j = 0; j < 64; ++j) {
                    const int ph = (d * j) & 63;
                    const float t = im ? -cs[64 + ph] : cs[ph];
#pragma unroll
                    for (int e = 0; e < 32; ++e) acc[e] += t * fws[j * 64 + e0 + e];
                }
#pragma unroll
                for (int e = 0; e < 32; ++e) Ms[d * 128 + r0 + e] = acc[e];
            }
            __syncthreads();
            {
                const int r = tid >> 1, kk0 = (tid & 1) * 32;
                float acc[32];
#pragma unroll
                for (int k = 0; k < 32; ++k) acc[k] = 0.f;
                for (int d = 0; d < 64; ++d) {
                    const float m = Ms[d * 128 + r];
#pragma unroll
                    for (int k = 0; k < 32; ++k) acc[k] += wt[(kk0 + k) * 65 + d] * m;
                }
                bf16_t* dst = (bf16_t*)(ws + OFF_W1T) + (size_t)l * 2048 * 1024 + (size_t)(1024 + g * 128 + r) * 1024 + kt * 64 + kk0;
#pragma unroll
                for (int q = 0; q < 4; ++q)
                    ((uint4*)dst)[q] = make_uint4(pk_bf16(acc[q * 8], acc[q * 8 + 1]), pk_bf16(acc[q * 8 + 2], acc[q * 8 + 3]), pk_bf16(acc[q * 8 + 4], acc[q * 8 + 5]), pk_bf16(acc[q * 8 + 6], acc[q * 8 + 7]));
            }
            __syncthreads();
        }
    }
    {
        bf16_t* k12 = (bf16_t*)(ws + OFF_K12);
        for (int i = gtid; i < NL * 8 * 256 * 128; i += gsz) {
            const int d = i & 127, n = (i >> 7) & 255, h = (i >> 15) & 7, l = i >> 18;
            const float* src = (n < 128) ? p.k1 : p.k2;
            k12[i] = f2bf(src[(((size_t)l * 8 + h) * 128 + (n & 127)) * 128 + d]);
        }
        bf16_t* wsb = (bf16_t*)(ws + OFF_WSB);
        for (int i = gtid; i < NL * 8 * 128 * 128; i += gsz) wsb[i] = f2bf(p.gmlp_ws[i]);
        bf16_t* DA = (bf16_t*)(ws + OFF_DA);
        for (int i = gtid; i < 128 * 128; i += gsz) {
            const int m = i >> 7, kk = i & 127, ro = m >> 6, k1 = m & 63, ri = kk >> 6, a = kk & 63;
            float s, c; sincospif((float)((a * k1) & 63) / 32.0f, &s, &c);
            const float v = (ro == ri) ? c : (ro == 0 ? s : -s);
            DA[i] = f2bf(v);
        }
        bf16_t* DB = (bf16_t*)(ws + OFF_DB);
        for (int i = gtid; i < 64 * 128; i += gsz) {
            const int k2 = i >> 7, kk = i & 127, ri = kk >> 6, b = kk & 63;
            float s, c; sincospif((float)((b * k2) & 63) / 32.0f, &s, &c);
            DB[i] = f2bf(ri ? s : c);
        }
        float2* tw = (float2*)(ws + OFF_TW);
        for (int i = gtid; i < 64 * 64; i += gsz) {
            const int bp = i >> 6, k1 = i & 63;
            float s, c; sincospif((float)(bp * k1) / 2048.0f, &s, &c);
            tw[i] = make_float2(c, s);
        }
    }
    }
    if (convgrp || nb_ < 2) {
        {
            const int lane = tid & 63, wv = gtid >> 6, nwv = gsz >> 6;
            const int R = 2 * NL * NE;
#pragma nounroll
            for (int r0 = wv; r0 < R; r0 += 4 * nwv) {
                float4 v[4][4];
#pragma unroll
                for (int t = 0; t < 4; ++t) {
                    const int r = (r0 + t * nwv < R) ? r0 + t * nwv : r0;
                    const int tbl = r / (NL * NE), row = r % (NL * NE);
                    const float* src = (tbl ? p.pv : p.pu) + (size_t)row * 1024 + lane * 16;
#pragma unroll
                    for (int i = 0; i < 4; ++i) v[t][i] = ((const float4*)src)[i];
                }
                __builtin_amdgcn_sched_barrier(0);
#pragma unroll
                for (int t = 0; t < 4; ++t) {
                    const int r = r0 + t * nwv;
                    if (r >= R) break;
                    const int tbl = r / (NL * NE), row = r % (NL * NE);
                    float m = 0.f;
#pragma unroll
                    for (int i = 0; i < 4; ++i) m = fmaxf(m, fmaxf(fmaxf(fabsf(v[t][i].x), fabsf(v[t][i].y)), fmaxf(fabsf(v[t][i].z), fabsf(v[t][i].w))));
#pragma unroll
                    for (int o = 32; o >= 1; o >>= 1) m = fmaxf(m, __shfl_xor(m, o));
                    const float qmax = 6.0f;
                    const float sc = (m > 0.f) ? qmax / m : 1.0f, inv = (m > 0.f) ? m / qmax : 1.0f;
                    const int lyr = row / NE, ex = row % NE;
                    if (true) {
                        unsigned w0 = 0u, w1 = 0u;
                        w0 = __builtin_amdgcn_cvt_scalef32_pk_fp4_f32(w0, v[t][0].x * sc, v[t][0].y * sc, 1.0f, 0); w0 = __builtin_amdgcn_cvt_scalef32_pk_fp4_f32(w0, v[t][0].z * sc, v[t][0].w * sc, 1.0f, 1);
                        w0 = __builtin_amdgcn_cvt_scalef32_pk_fp4_f32(w0, v[t][1].x * sc, v[t][1].y * sc, 1.0f, 2); w0 = __builtin_amdgcn_cvt_scalef32_pk_fp4_f32(w0, v[t][1].z * sc, v[t][1].w * sc, 1.0f, 3);
                        w1 = __builtin_amdgcn_cvt_scalef32_pk_fp4_f32(w1, v[t][2].x * sc, v[t][2].y * sc, 1.0f, 0); w1 = __builtin_amdgcn_cvt_scalef32_pk_fp4_f32(w1, v[t][2].z * sc, v[t][2].w * sc, 1.0f, 1);
                        w1 = __builtin_amdgcn_cvt_scalef32_pk_fp4_f32(w1, v[t][3].x * sc, v[t][3].y * sc, 1.0f, 2); w1 = __builtin_amdgcn_cvt_scalef32_pk_fp4_f32(w1, v[t][3].z * sc, v[t][3].w * sc, 1.0f, 3);
                        *(uint2*)(ws + (tbl ? OFF_VB : OFF_UB) + ((size_t)(lyr * 4 + (lane >> 4)) * NE + ex) * 128 + (lane & 15) * 8) = make_uint2(w0, w1);
                    } else {
                        int w[4];
#pragma unroll
                        for (int i = 0; i < 4; ++i) { w[i] = __builtin_amdgcn_cvt_pk_fp8_f32(v[t][i].x * sc, v[t][i].y * sc, 0, false); w[i] = __builtin_amdgcn_cvt_pk_fp8_f32(v[t][i].z * sc, v[t][i].w * sc, w[i], true); }
                        *(int4*)(ws + OFF_UB + ((size_t)(lyr * 8 + (lane >> 3)) * NE + ex) * 128 + (lane & 7) * 16) = make_int4(w[0], w[1], w[2], w[3]);
                    }
                    if (lane == 0) ((float*)(ws + (tbl ? OFF_VSC : OFF_USC)))[row] = inv;
                    __builtin_amdgcn_sched_barrier(0);
                }
            }
        }
    }
}

template <bool SRC_BF16>
__device__ void phase_norm(const void* __restrict__ xsrc_, const float* __restrict__ g, const float* __restrict__ modl  , int sh_off, int scl_off,
                           bf16_t* __restrict__ hout, int bid, int nb) {
    const int tid_ = otid(); const int lane = tid_ & 63, wid = tid_ >> 6;
    for (int tok = bid * 4 + wid; tok < T; tok += nb * 4) {
        const int b = tok / SEQ;
        float4 v[4];
        float ss = 0.f;
#pragma unroll
        for (int i = 0; i < 4; ++i) {
            if (SRC_BF16) { const uint2 w = *(const uint2*)((const bf16_t*)xsrc_ + (size_t)tok * D + i * 256 + lane * 4); v[i] = make_float4(bf2f(w.x & 0xffffu), bf2f(w.x >> 16), bf2f(w.y & 0xffffu), bf2f(w.y >> 16)); }
            else v[i] = *(const float4*)((const float*)xsrc_ + (size_t)tok * D + i * 256 + lane * 4);
            ss += v[i].x * v[i].x + v[i].y * v[i].y + v[i].z * v[i].z + v[i].w * v[i].w;
        }
        ss = wave_sum(ss);
        const float rstd = rsqrtf(ss * (1.0f / D) + EPS);
        const float* mb = modl + (size_t)b * 6144;
#pragma unroll
        for (int i = 0; i < 4; ++i) {
            const int cidx = i * 256 + lane * 4;
            const float4 gg = *(const float4*)(g + cidx), sh = *(const float4*)(mb + sh_off + cidx), sc = *(const float4*)(mb + scl_off + cidx);
            const float o0 = v[i].x * rstd * gg.x * (1.0f + sc.x) + sh.x, o1 = v[i].y * rstd * gg.y * (1.0f + sc.y) + sh.y;
            const float o2 = v[i].z * rstd * gg.z * (1.0f + sc.z) + sh.z, o3 = v[i].w * rstd * gg.w * (1.0f + sc.w) + sh.w;
            *(uint2*)(hout + (size_t)tok * D + cidx) = make_uint2(pk_bf16(o0, o1), pk_bf16(o2, o3));
        }
    }
}

#define LAS __attribute__((address_space(3)))
template <class Epi, class MidK>
__device__ __forceinline__ void gemm_tile(const bf16_t* __restrict__ A, int lda, const bf16_t* __restrict__ Bt, int ldb, int K, int m0, int n0,
                                          char* smem, const Epi& epi, const MidK& midk, int kmid) {
    const int tid = otid(), lane = tid & 63, wid = tid >> 6, wr = wid >> 1, wc = wid & 1, fr = lane & 15, fq = lane >> 4;
    LAS char* lds = (LAS char*)smem;
    f32x4 acc[4][4];
#pragma unroll
    for (int i = 0; i < 4; ++i)
#pragma unroll
        for (int j = 0; j < 4; ++j) acc[i][j] = (f32x4){0.f, 0.f, 0.f, 0.f};
    const int prow = lane >> 3, pch = (lane & 7) ^ prow;
    const bf16_t* ga = A + (size_t)(m0 + wid * 32 + prow) * lda + pch * 8;
    const bf16_t* gb = Bt + (size_t)(n0 + wid * 32 + prow) * ldb + pch * 8;
    const int nk = K / 64;
#define GEMM_STAGE(kt_, buf_) do { _Pragma("unroll") for (int i_ = 0; i_ < 4; ++i_) { \
        __builtin_amdgcn_global_load_lds((const unsigned*)(ga + (size_t)(i_ * 8) * lda + (kt_) * 64), (LAS unsigned*)(lds + (buf_) * 16384 + (wid * 32 + i_ * 8) * 128), 16, 0, 0); \
        __builtin_amdgcn_global_load_lds((const unsigned*)(gb + (size_t)(i_ * 8) * ldb + (kt_) * 64), (LAS unsigned*)(lds + 32768 + (buf_) * 16384 + (wid * 32 + i_ * 8) * 128), 16, 0, 0); } } while (0)
    GEMM_STAGE(0, 0);
    const int swz = fr & 7;
    for (int kt = 0; kt < nk; ++kt) {
        const int cur = kt & 1;
        asm volatile("s_waitcnt vmcnt(0)" ::: "memory");
        __syncthreads();
        if (kt + 1 < nk) GEMM_STAGE(kt + 1, cur ^ 1);
        if (kt == kmid) {
#pragma unroll
            for (int i = 0; i < 4; ++i) { const float sc = midk(m0 + wr * 64 + i * 16 + fr);
#pragma unroll
                for (int j = 0; j < 4; ++j) acc[i][j] *= sc; }
        }
        const LAS char* ca = lds + cur * 16384; const LAS char* cb = lds + 32768 + cur * 16384;
#pragma unroll
        for (int ks = 0; ks < 2; ++ks) {
            bf16x8 af[4], bfr[4];
            const int coff = ((ks * 4 + fq) ^ swz) * 16;
#pragma unroll
            for (int i = 0; i < 4; ++i) af[i] = *(const LAS bf16x8*)(ca + (wr * 64 + i * 16 + fr) * 128 + coff);
#pragma unroll
            for (int j = 0; j < 4; ++j) bfr[j] = *(const LAS bf16x8*)(cb + (wc * 64 + j * 16 + fr) * 128 + coff);
#pragma unroll
            for (int i = 0; i < 4; ++i)
#pragma unroll
                for (int j = 0; j < 4; ++j) acc[i][j] = MFMA16(bfr[j], af[i], acc[i][j]);
        }
    }
#undef GEMM_STAGE
    __syncthreads();
    {
        LAS char* stg = lds + wid * 17408;
#pragma unroll
        for (int i = 0; i < 4; ++i)
#pragma unroll
            for (int j = 0; j < 4; ++j) *(LAS f32x4*)(stg + (i * 16 + fr) * 272 + (j * 16 + fq * 4) * 4) = acc[i][j];
        const int er = lane >> 3, ec = (lane & 7) * 8;
#pragma unroll
        for (int t = 0; t < 8; ++t) {
            const f32x4 v0 = *(const LAS f32x4*)(stg + (t * 8 + er) * 272 + ec * 4), v1 = *(const LAS f32x4*)(stg + (t * 8 + er) * 272 + ec * 4 + 16);
            epi(m0 + wr * 64 + t * 8 + er, n0 + wc * 64 + ec, v0, v1);
            __builtin_amdgcn_sched_barrier(0);
        }
    }
    __syncthreads();
}
__device__ __forceinline__ void glds16(const void* g, unsigned lds_addr) {
    unsigned sv_;
    asm volatile("s_mov_b32 %0, m0\n\ts_mov_b32 m0, %2\n\tglobal_load_lds_dwordx4 %1, off\n\ts_mov_b32 m0, %0" : "=&s"(sv_) : "v"(g), "s"(lds_addr) : "memory");
}
template <class Epi, class MidK>
__device__ __forceinline__ void gemm_tile256(const bf16_t* __restrict__ A, int lda, const bf16_t* __restrict__ Bt, int ldb, int K, int m0, int n0,
                                             char* smem, const Epi& epi, const MidK& midk, int kmid) {
    const int tid = otid(), lane = tid & 63, wid = tid >> 6, wr = wid >> 1, wc = wid & 1, fr = lane & 15, fq = lane >> 4;
    LAS char* lds = (LAS char*)smem;
    f32x4 acc[8][4];
#pragma unroll
    for (int i = 0; i < 8; ++i)
#pragma unroll
        for (int j = 0; j < 4; ++j) acc[i][j] = (f32x4){0.f, 0.f, 0.f, 0.f};
    const int prow = lane >> 2, pch = (lane & 3) ^ (((lane >> 4) & 1) << 1);
    const bf16_t* ga = A + (size_t)(m0 + wid * 64 + prow) * lda + pch * 8;
    const bf16_t* gb = Bt + (size_t)(n0 + wid * 32 + prow) * ldb + pch * 8;
    const int nk = K / 32;
    const unsigned la = __builtin_amdgcn_readfirstlane((unsigned)(size_t)lds + wid * 4096), lb = __builtin_amdgcn_readfirstlane((unsigned)(size_t)lds + 16384 + wid * 2048);
#define G256_STAGE(kt_, ST_) do { \
        _Pragma("unroll") for (int i_ = 0; i_ < 4; ++i_) glds16(ga + (size_t)(i_ * 16) * lda + (kt_) * 32, la + (ST_) * 24576 + i_ * 1024); \
        _Pragma("unroll") for (int i_ = 0; i_ < 2; ++i_) glds16(gb + (size_t)(i_ * 16) * ldb + (kt_) * 32, lb + (ST_) * 24576 + i_ * 1024); } while (0)
    G256_STAGE(0, 0);
    G256_STAGE(1, 1);
    const int coff = (fq ^ (((fr >> 2) & 1) << 1)) * 16;
#define G256_STEP(kt_, CUR_, NXT_) do { \
        if ((kt_) + 1 < nk) asm volatile("s_waitcnt vmcnt(6)" ::: "memory"); else asm volatile("s_waitcnt vmcnt(0)" ::: "memory"); \
        __builtin_amdgcn_s_barrier(); \
        asm volatile("" ::: "memory"); \
        if ((kt_) + 2 < nk) G256_STAGE((kt_) + 2, NXT_); \
        if ((kt_) == kmid) { \
            _Pragma("unroll") for (int i = 0; i < 8; ++i) { const float sc = midk(m0 + wr * 128 + i * 16 + fr); \
                _Pragma("unroll") for (int j = 0; j < 4; ++j) acc[i][j] *= sc; } } \
        const LAS char* ca = lds + (CUR_) * 24576 + coff; const LAS char* cb = ca + 16384; \
        bf16x8 bfr[4], af[8]; \
        _Pragma("unroll") for (int j = 0; j < 4; ++j) bfr[j] = *(const LAS bf16x8*)(cb + (wc * 64 + j * 16 + fr) * 64); \
        _Pragma("unroll") for (int i = 0; i < 8; ++i) af[i] = *(const LAS bf16x8*)(ca + (wr * 128 + i * 16 + fr) * 64); \
        __builtin_amdgcn_sched_barrier(0); \
        _Pragma("unroll") for (int i = 0; i < 8; ++i) \
            _Pragma("unroll") for (int j = 0; j < 4; ++j) acc[i][j] = MFMA16(bfr[j], af[i], acc[i][j]); \
        __builtin_amdgcn_sched_barrier(0); } while (0)
#pragma nounroll
    for (int kt = 0; kt < nk; kt += 3) {
        G256_STEP(kt, 0, 2);
        if (kt + 1 < nk) G256_STEP(kt + 1, 1, 0);
        if (kt + 2 < nk) G256_STEP(kt + 2, 2, 1);
    }
#undef G256_STEP
#undef G256_STAGE
#pragma unroll
    for (int hb = 0; hb < 2; ++hb) {
        __syncthreads();
        LAS char* stg = lds + wid * 17408;
#pragma unroll
        for (int i = 0; i < 4; ++i)
#pragma unroll
            for (int j = 0; j < 4; ++j) *(LAS f32x4*)(stg + (i * 16 + fr) * 272 + (j * 16 + fq * 4) * 4) = acc[hb * 4 + i][j];
        const int er = lane >> 3, ec = (lane & 7) * 8;
#pragma unroll
        for (int t = 0; t < 8; ++t) {
            const f32x4 v0 = *(const LAS f32x4*)(stg + (t * 8 + er) * 272 + ec * 4), v1 = *(const LAS f32x4*)(stg + (t * 8 + er) * 272 + ec * 4 + 16);
            epi(m0 + wr * 128 + hb * 64 + t * 8 + er, n0 + wc * 64 + ec, v0, v1);
            __builtin_amdgcn_sched_barrier(0);
        }
    }
    __syncthreads();
}
__device__ __forceinline__ bool tile_of(int round, int bid, int nb, int MT, int NT, int& mt, int& nt) {
    if (nb == 512) {
        const int x = bid & 7, r = bid >> 3, st = x + 8 * round, snt = NT >> 3;
        if (st >= (MT >> 3) * snt) return false;
        mt = (st / snt) * 8 + (r >> 3); nt = (st % snt) * 8 + (r & 7);
        return true;
    }
    const int item = bid + round * nb;
    if (item >= MT * NT) return false;
    mt = item / NT; nt = item % NT;
    return true;
}
struct NoMid { __device__ __forceinline__ float operator()(int) const { return 1.0f; } };

__device__ void phase_gemm1(const Params& p, int l, char* smem, int bid, int nb) {
    const bf16_t* A = (const bf16_t*)(p.ws + OFF_H);
    const bf16_t* Bt = (const bf16_t*)(p.ws + OFF_W1T) + (size_t)l * 2048 * 1024;
    bf16_t* Z = (bf16_t*)(p.ws + OFF_Z);
    auto epi_gelu = [&](int row, int col, const f32x4& a, const f32x4& b) {
        *(uint4*)(Z + (size_t)row * NZ + col) = make_uint4(pk_bf16(gelu_f(a[0]), gelu_f(a[1])), pk_bf16(gelu_f(a[2]), gelu_f(a[3])), pk_bf16(gelu_f(b[0]), gelu_f(b[1])), pk_bf16(gelu_f(b[2]), gelu_f(b[3])));
    };
    auto epi_plain = [&](int row, int col, const f32x4& a, const f32x4& b) {
        *(uint4*)(Z + (size_t)row * NZ + col) = make_uint4(pk_bf16(a[0], a[1]), pk_bf16(a[2], a[3]), pk_bf16(b[0], b[1]), pk_bf16(b[2], b[3]));
    };
    const int NT = NZ / 128, MT = T / 256;
    int mt, nt;
    for (int round = 0; tile_of(round, bid, nb, MT, NT, mt, nt); ++round) {
        const int n0 = nt * 128;
        if (n0 < 1024) gemm_tile256(A, D, Bt, D, D, mt * 256, n0, smem, epi_gelu, NoMid(), -1);
        else           gemm_tile256(A, D, Bt, D, D, mt * 256, n0, smem, epi_plain, NoMid(), -1);
    }
}
__device__ void phase_gemm2(const Params& p, int l, char* smem, int bid, int nb) {
    const bf16_t* A = (const bf16_t*)(p.ws + OFF_Y);
    const bf16_t* Bt = (const bf16_t*)(p.ws + OFF_W2T) + (size_t)l * 1024 * 1024;
    const float* ssa = (const float*)(p.ws + OFF_SSQA); const float* ssb = (const float*)(p.ws + OFF_SSQB);
    const float* mod = (const float*)(p.ws + OFF_MOD) + (size_t)l * NB * 6144;
    bf16_t* XR = (bf16_t*)(p.ws + OFF_XR);
    auto rstd_of = [&](const float* s, int row) {
        const float4 a = *(const float4*)(s + (size_t)row * 8), b = *(const float4*)(s + (size_t)row * 8 + 4);
        return rsqrtf(((a.x + a.y) + (a.z + a.w) + (b.x + b.y) + (b.z + b.w)) * (1.0f / 512.0f) + EPS);
    };
    auto midk = [&](int row) { return rstd_of(ssa, row) / rstd_of(ssb, row); };
    auto epi = [&](int row, int col, const f32x4& a, const f32x4& c) {
        const float rb = rstd_of(ssb, row);
        const int b = row / SEQ;
        const float4 g0 = *(const float4*)(mod + (size_t)b * 6144 + 2 * D + col), g1 = *(const float4*)(mod + (size_t)b * 6144 + 2 * D + col + 4);
        float x[8];
        if (l == 0) { const float4 x0 = *(const float4*)(p.x + (size_t)row * D + col), x1 = *(const float4*)(p.x + (size_t)row * D + col + 4);
            x[0] = x0.x; x[1] = x0.y; x[2] = x0.z; x[3] = x0.w; x[4] = x1.x; x[5] = x1.y; x[6] = x1.z; x[7] = x1.w; }
        else { const uint4 w = *(const uint4*)(XR + (size_t)row * D + col);
            x[0] = bf2f(w.x & 0xffffu); x[1] = bf2f(w.x >> 16); x[2] = bf2f(w.y & 0xffffu); x[3] = bf2f(w.y >> 16); x[4] = bf2f(w.z & 0xffffu); x[5] = bf2f(w.z >> 16); x[6] = bf2f(w.w & 0xffffu); x[7] = bf2f(w.w >> 16); }
        *(uint4*)(XR + (size_t)row * D + col) = make_uint4(pk_bf16(x[0] + g0.x * rb * a[0], x[1] + g0.y * rb * a[1]), pk_bf16(x[2] + g0.z * rb * a[2], x[3] + g0.w * rb * a[3]),
                                                           pk_bf16(x[4] + g1.x * rb * c[0], x[5] + g1.y * rb * c[1]), pk_bf16(x[6] + g1.z * rb * c[2], x[7] + g1.w * rb * c[3]));
    };
    const int NT = D / 128, MT = T / 256;
    int mt, nt;
    for (int round = 0; tile_of(round, bid, nb, MT, NT, mt, nt); ++round) gemm_tile256(A, D, Bt, D, D, mt * 256, nt * 128, smem, epi, midk, 16);
}
__device__ void phase_gemm3(const Params& p, int l, char* smem, int bid, int nb) {
    const bf16_t* A = (const bf16_t*)(p.ws + OFF_H);
    const bf16_t* Bt = (const bf16_t*)(p.ws + OFF_WQT) + (size_t)l * 2048 * 1024;
    bf16_t* Q = (bf16_t*)(p.ws + OFF_Z);
    auto epi = [&](int row, int col, const f32x4& a, const f32x4& b) { *(uint4*)(Q + (size_t)row * 2048 + col) = make_uint4(pk_bf16(a[0], a[1]), pk_bf16(a[2], a[3]), pk_bf16(b[0], b[1]), pk_bf16(b[2], b[3])); };
    const int NT = 2048 / 128, MT = T / 256;
    int mt, nt;
    for (int round = 0; tile_of(round, bid, nb, MT, NT, mt, nt); ++round) gemm_tile256(A, D, Bt, D, D, mt * 256, nt * 128, smem, epi, NoMid(), -1);
}

constexpr int TP = 136;
__device__ __forceinline__ void stage_transposed(const bf16_t* __restrict__ base, size_t row_stride, bf16_t* dT) {
    const int tid = otid(), r = tid >> 2, part = tid & 3, ri = part >> 1, c0 = (part & 1) * 32;
    const uint4* src = (const uint4*)(base + (size_t)r * row_stride + ri * 64 + c0);
    uint4 v[4];
#pragma unroll
    for (int i = 0; i < 4; ++i) v[i] = src[i];
#pragma unroll
    for (int i = 0; i < 4; ++i) {
        const unsigned w[4] = {v[i].x, v[i].y, v[i].z, v[i].w};
#pragma unroll
        for (int j = 0; j < 4; ++j) {
            dT[(c0 + i * 8 + j * 2) * TP + ri * 64 + r] = (bf16_t)(w[j] & 0xffffu);
            dT[(c0 + i * 8 + j * 2 + 1) * TP + ri * 64 + r] = (bf16_t)(w[j] >> 16);
        }
    }
}

__device__ void gmlp_item(const Params& p, int l, int item, char* smem) {
    const int tid = otid(), lane = tid & 63, wid = tid >> 6, fr = lane & 15, fq = lane >> 4;
    const int h = item & 7, c = (item >> 3) & 31, b = item >> 8;
    const int tok0 = b * SEQ + c * 128;
    bf16_t* vnT = (bf16_t*)smem;
    const bf16_t* Z = (const bf16_t*)(p.ws + OFF_Z);
    {
        const int q = tid >> 1, half = tid & 1, d0 = half * 32;
        const uint4* src = (const uint4*)(Z + (size_t)(tok0 + q) * NZ + 512 + h * 64 + d0);
        float f[32];
#pragma unroll
        for (int i = 0; i < 4; ++i) { const uint4 v = src[i]; const unsigned w[4] = {v.x, v.y, v.z, v.w};
#pragma unroll
            for (int j = 0; j < 4; ++j) { f[i * 8 + j * 2] = bf2f(w[j] & 0xffffu); f[i * 8 + j * 2 + 1] = bf2f(w[j] >> 16); } }
        float s = 0.f;
#pragma unroll
        for (int i = 0; i < 32; ++i) s += f[i];
        s += __shfl_xor(s, 1);
        const float mean = s * (1.0f / 64.0f);
        float qv = 0.f;
#pragma unroll
        for (int i = 0; i < 32; ++i) { f[i] -= mean; qv += f[i] * f[i]; }
        qv += __shfl_xor(qv, 1);
        const float rstd = rsqrtf(qv * (1.0f / 64.0f) + EPS);
#pragma unroll
        for (int i = 0; i < 32; ++i) vnT[(d0 + i) * TP + q] = f2bf(f[i] * rstd);
    }
    __syncthreads();
    const bf16_t* Wsb = (const bf16_t*)(p.ws + OFF_WSB) + ((size_t)l * 8 + h) * 128 * 128;
    f32x4 acc[2][4];
#pragma unroll
    for (int i = 0; i < 2; ++i)
#pragma unroll
        for (int j = 0; j < 4; ++j) acc[i][j] = (f32x4){0.f, 0.f, 0.f, 0.f};
    const int p0 = wid * 32;
#pragma unroll
    for (int ks = 0; ks < 4; ++ks) {
        bf16x8 af[2], bfr[4];
#pragma unroll
        for (int i = 0; i < 2; ++i) af[i] = *(const bf16x8*)(Wsb + (size_t)(p0 + i * 16 + fr) * 128 + ks * 32 + fq * 8);
#pragma unroll
        for (int j = 0; j < 4; ++j) bfr[j] = *(const bf16x8*)(vnT + (j * 16 + fr) * TP + ks * 32 + fq * 8);
#pragma unroll
        for (int i = 0; i < 2; ++i)
#pragma unroll
            for (int j = 0; j < 4; ++j) acc[i][j] = MFMA16(bfr[j], af[i], acc[i][j]);
    }
    bf16_t* Y = (bf16_t*)(p.ws + OFF_Y);
    float* ssa = (float*)(p.ws + OFF_SSQA);
#pragma unroll
    for (int i = 0; i < 2; ++i) {
        const int pp = p0 + i * 16 + fr, tok = tok0 + pp;
        const float bsv = p.gmlp_bs[((size_t)l * 8 + h) * 128 + pp];
        float ss = 0.f;
#pragma unroll
        for (int j = 0; j < 4; ++j) {
            const int d = j * 16 + fq * 4;
            const uint2 uu = *(const uint2*)(Z + (size_t)tok * NZ + h * 64 + d);
            const float y0 = bf2f(uu.x & 0xffffu) * (acc[i][j][0] + bsv), y1 = bf2f(uu.x >> 16) * (acc[i][j][1] + bsv);
            const float y2 = bf2f(uu.y & 0xffffu) * (acc[i][j][2] + bsv), y3 = bf2f(uu.y >> 16) * (acc[i][j][3] + bsv);
            ss += y0 * y0 + y1 * y1 + y2 * y2 + y3 * y3;
            *(uint2*)(Y + (size_t)tok * D + h * 64 + d) = make_uint2(pk_bf16(y0, y1), pk_bf16(y2, y3));
        }
        ss += __shfl_xor(ss, 16); ss += __shfl_xor(ss, 32);
        if (fq == 0) ssa[(size_t)tok * 8 + h] = ss;
    }
    __syncthreads();
}

__device__ void ffta_item(const Params& p, int item, char* smem) {
    const int tid = otid(), lane = tid & 63, wid = tid >> 6, fr = lane & 15, fq = lane >> 4;
    const int bp = item & 63, g = (item >> 6) & 7, b = item >> 9;
    bf16_t* dT = (bf16_t*)smem;
    const bf16_t* Z = (const bf16_t*)(p.ws + OFF_Z);
    stage_transposed(Z + (size_t)(b * SEQ + bp) * NZ + 1024 + g * 128, (size_t)64 * NZ, dT);
    __syncthreads();
    const bf16_t* DA = (const bf16_t*)(p.ws + OFF_DA);
    f32x4 acc[2][4];
#pragma unroll
    for (int i = 0; i < 2; ++i)
#pragma unroll
        for (int j = 0; j < 4; ++j) acc[i][j] = (f32x4){0.f, 0.f, 0.f, 0.f};
#pragma unroll
    for (int ks = 0; ks < 4; ++ks) {
        bf16x8 af[2], bfr[4];
#pragma unroll
        for (int i = 0; i < 2; ++i) af[i] = *(const bf16x8*)(DA + (size_t)(i * 64 + wid * 16 + fr) * 128 + ks * 32 + fq * 8);
#pragma unroll
        for (int j = 0; j < 4; ++j) bfr[j] = *(const bf16x8*)(dT + (j * 16 + fr) * TP + ks * 32 + fq * 8);
#pragma unroll
        for (int i = 0; i < 2; ++i)
#pragma unroll
            for (int j = 0; j < 4; ++j) acc[i][j] = MFMA16(bfr[j], af[i], acc[i][j]);
    }
    const int k1 = wid * 16 + fr;
    const float2 cs = ((const float2*)(p.ws + OFF_TW))[bp * 64 + k1];
    bf16_t* Yb = (bf16_t*)(p.ws + OFF_H) + ((((size_t)(b * 8 + g) * 64 + k1) * 64 + bp) * 128);
#pragma unroll
    for (int j = 0; j < 4; ++j) {
        const int ch = j * 16 + fq * 4;
        float yr[4], yi[4];
#pragma unroll
        for (int e = 0; e < 4; ++e) { const float r = acc[0][j][e], im = acc[1][j][e]; yr[e] = r * cs.x + im * cs.y; yi[e] = im * cs.x - r * cs.y; }
        *(uint2*)(Yb + ch) = make_uint2(pk_bf16(yr[0], yr[1]), pk_bf16(yr[2], yr[3]));
        *(uint2*)(Yb + 64 + ch) = make_uint2(pk_bf16(yi[0], yi[1]), pk_bf16(yi[2], yi[3]));
    }
    __syncthreads();
}

__device__ void phase_mix(const Params& p, int l, char* smem, int bid, int nb) {
    for (int item = bid; item < 2048 + 4096; item += nb) {
        if (item < 2048) gmlp_item(p, l, item, smem); else ffta_item(p, item - 2048, smem);
    }
}

__device__ void phase_fftb(const Params& p, int l, char* smem, int bid, int nb) {
    const int tid = otid(), lane = tid & 63, wid = tid >> 6, fr = lane & 15, fq = lane >> 4;
    bf16_t* dT = (bf16_t*)smem;
    const bf16_t* DB = (const bf16_t*)(p.ws + OFF_DB);
    bf16_t* Y = (bf16_t*)(p.ws + OFF_Y);
    float* ssb = (float*)(p.ws + OFF_SSQB);
    for (int item = bid; item < 4096; item += nb) {
        const int k1 = item & 63, g = (item >> 6) & 7, b = item >> 9;
        stage_transposed((const bf16_t*)(p.ws + OFF_H) + (((size_t)(b * 8 + g) * 64 + k1) * 64) * 128, 128, dT);
        __syncthreads();
        f32x4 acc[4];
#pragma unroll
        for (int j = 0; j < 4; ++j) acc[j] = (f32x4){0.f, 0.f, 0.f, 0.f};
#pragma unroll
        for (int ks = 0; ks < 4; ++ks) {
            const bf16x8 af = *(const bf16x8*)(DB + (size_t)(wid * 16 + fr) * 128 + ks * 32 + fq * 8);
#pragma unroll
            for (int j = 0; j < 4; ++j) { const bf16x8 bfr = *(const bf16x8*)(dT + (j * 16 + fr) * TP + ks * 32 + fq * 8); acc[j] = MFMA16(bfr, af, acc[j]); }
        }
        const int k2 = wid * 16 + fr, tok = b * SEQ + k1 + 64 * k2;
        float ss = 0.f;
#pragma unroll
        for (int j = 0; j < 4; ++j) {
            const int ch = j * 16 + fq * 4;
            const float4 fb = *(const float4*)(p.fnet_b + ((size_t)l * 8 + g) * 64 + ch);
            const float y0 = acc[j][0] * (1.0f / 512.0f) + fb.x, y1 = acc[j][1] * (1.0f / 512.0f) + fb.y, y2 = acc[j][2] * (1.0f / 512.0f) + fb.z, y3 = acc[j][3] * (1.0f / 512.0f) + fb.w;
            ss += y0 * y0 + y1 * y1 + y2 * y2 + y3 * y3;
            *(uint2*)(Y + (size_t)tok * D + 512 + g * 64 + ch) = make_uint2(pk_bf16(y0, y1), pk_bf16(y2, y3));
        }
        ss += __shfl_xor(ss, 16); ss += __shfl_xor(ss, 32);
        if (fq == 0) ssb[(size_t)tok * 8 + g] = ss;
        __syncthreads();
    }
}

#define INS16(a, v) do { a[15] = med3i(a[14], a[15], v); a[14] = med3i(a[13], a[14], v); a[13] = med3i(a[12], a[13], v); a[12] = med3i(a[11], a[12], v); \
    a[11] = med3i(a[10], a[11], v); a[10] = med3i(a[9], a[10], v); a[9] = med3i(a[8], a[9], v); a[8] = med3i(a[7], a[8], v); a[7] = med3i(a[6], a[7], v); \
    a[6] = med3i(a[5], a[6], v); a[5] = med3i(a[4], a[5], v); a[4] = med3i(a[3], a[4], v); a[3] = med3i(a[2], a[3], v); a[2] = med3i(a[1], a[2], v); \
    a[1] = med3i(a[0], a[1], v); a[0] = max(a[0], v); } while (0)

template <int I, int J> struct CandLoop {
    static __device__ __forceinline__ void run(int (&a)[16], const float (&f1)[16], const float (&f2)[16]) {
        if constexpr ((I + 1) * (J + 1) <= 16) { const int key = (f2key(f1[I] + f2[J]) & ~255) | (I * 16 + J); INS16(a, key); }
        if constexpr (J + 1 < 16) CandLoop<I, J + 1>::run(a, f1, f2);
        else if constexpr (I + 1 < 16) CandLoop<I + 1, 0>::run(a, f1, f2);
    }
};

typedef _Float16 f16x2_t __attribute__((ext_vector_type(2)));
__device__ __forceinline__ unsigned pk_f16(float lo, float hi) { const f16x2_t v = {(_Float16)lo, (_Float16)hi}; return __builtin_bit_cast(unsigned, v); }
__device__ __forceinline__ int h2key(unsigned bits16) { const int b = (int)(short)bits16; return b ^ ((b >> 15) & 0x7fff); }
__device__ __forceinline__ float key2h(int k) { const int b = k ^ ((k >> 15) & 0x7fff); return (float)__builtin_bit_cast(_Float16, (unsigned short)(b & 0xffff)); }

__device__ void phase_topk(const Params& p, int l, char* smem, int bid, int nb) {
    const int tid = otid(), lane = tid & 63, wid = tid >> 6, fr = lane & 15, fq = lane >> 4;
    unsigned* S32 = (unsigned*)smem;
    int* TT = (int*)smem;
    const bf16_t* Q = (const bf16_t*)(p.ws + OFF_Z);
    int* eidx = (int*)(p.ws + OFF_Y); float* gw = (float*)(p.ws + OFF_Y + (size_t)T * 128 * 4);
    const int hh = wid >> 1, half = wid & 1;
    for (int item = bid; item < (T / 64) * 4; item += nb) {
        const int hp = item & 3, tok0 = (item >> 2) * 64, h = hp * 2 + hh;
        const bf16_t* Kh = (const bf16_t*)(p.ws + OFF_K12) + (((size_t)l * 8 + h) * 256 + half * 128) * 128;
        const bf16_t* Qh = Q + (size_t)tok0 * 2048 + h * 256 + half * 128;
        {
            f32x4 acc[4][8];
#pragma unroll
            for (int i = 0; i < 4; ++i)
#pragma unroll
                for (int j = 0; j < 8; ++j) acc[i][j] = (f32x4){0.f, 0.f, 0.f, 0.f};
#pragma unroll
            for (int ks = 0; ks < 4; ++ks) {
                bf16x8 af[4];
#pragma unroll
                for (int i = 0; i < 4; ++i) af[i] = *(const bf16x8*)(Qh + (size_t)(i * 16 + fr) * 2048 + ks * 32 + fq * 8);
#pragma unroll
                for (int jh = 0; jh < 2; ++jh) {
                    bf16x8 bfr[4];
#pragma unroll
                    for (int j = 0; j < 4; ++j) bfr[j] = *(const bf16x8*)(Kh + (size_t)((jh * 4 + j) * 16 + fr) * 128 + ks * 32 + fq * 8);
#pragma unroll
                    for (int i = 0; i < 4; ++i)
#pragma unroll
                        for (int j = 0; j < 4; ++j) acc[i][jh * 4 + j] = MFMA16(bfr[j], af[i], acc[i][jh * 4 + j]);
                    __builtin_amdgcn_sched_barrier(0);
                }
            }
#pragma unroll
            for (int i = 0; i < 4; ++i)
#pragma unroll
                for (int j = 0; j < 8; ++j) {
                    unsigned* d = S32 + (i * 16 + fr) * 257 + hh * 128 + half * 64 + j * 8 + fq * 2;
                    d[0] = pk_f16(acc[i][j][0], acc[i][j][1]); d[1] = pk_f16(acc[i][j][2], acc[i][j][3]);
                }
        }
        __syncthreads();
        int a[16];
#pragma unroll
        for (int i = 0; i < 16; ++i) a[i] = (int)0x80000000;
        {
            const unsigned* sr = S32 + lane * 257 + hh * 128 + half * 64;
#pragma unroll 2
            for (int i = 0; i < 64; ++i) {
                const unsigned w = sr[i];
                const int k0 = (h2key(w & 0xffffu) << 7) | (2 * i), k1 = (h2key(w >> 16) << 7) | (2 * i + 1);
                INS16(a, k0); INS16(a, k1);
            }
        }
        __syncthreads();
#pragma unroll
        for (int i = 0; i < 16; ++i) TT[((lane * 2 + hh) * 2 + half) * 16 + i] = a[i];
        __syncthreads();
        if (tid < 128) {
            const int tk = tid & 63, h2 = tid >> 6, hd = hp * 2 + h2;
            const int* t1 = TT + ((tk * 2 + h2) * 2) * 16; const int* t2 = t1 + 16;
            float f1[16], f2[16];
#pragma unroll
            for (int i = 0; i < 16; ++i) { f1[i] = key2h(t1[i] >> 7); f2[i] = key2h(t2[i] >> 7); }
            int c[16];
#pragma unroll
            for (int i = 0; i < 16; ++i) c[i] = (int)0x80000000;
            CandLoop<0, 0>::run(c, f1, f2);
            float sc[16], e[16], sum = 0.f; int ex[16];
#pragma unroll
            for (int i = 0; i < 16; ++i) {
                sc[i] = key2f(c[i] & ~255);
                const int code = c[i] & 255;
                ex[i] = (t1[code >> 4] & 127) * 128 + (t2[code & 15] & 127);
            }
#pragma unroll
            for (int i = 0; i < 16; ++i) { e[i] = __expf(sc[i] - sc[0]); sum += e[i]; }
            const float inv = 1.0f / sum;
            int4* ep = (int4*)(eidx + (size_t)(tok0 + tk) * 128 + hd * 16); float4* gp = (float4*)(gw + (size_t)(tok0 + tk) * 128 + hd * 16);
#pragma unroll
            for (int i = 0; i < 4; ++i) { ep[i] = make_int4(ex[4 * i], ex[4 * i + 1], ex[4 * i + 2], ex[4 * i + 3]); gp[i] = make_float4(e[4 * i] * inv, e[4 * i + 1] * inv, e[4 * i + 2] * inv, e[4 * i + 3] * inv); }
        }
        __syncthreads();
    }
}

__device__ __forceinline__ float dot16_fp8(const float (&h)[16], const int4& u) {
    const int w[4] = {u.x, u.y, u.z, u.w};
    f32x2_t a = {0.f, 0.f};
#pragma unroll
    for (int i = 0; i < 4; ++i) {
        const f32x2_t lo = __builtin_amdgcn_cvt_pk_f32_fp8(w[i], false), hi = __builtin_amdgcn_cvt_pk_f32_fp8(w[i], true);
        const f32x2_t h0 = {h[4 * i], h[4 * i + 1]}, h1 = {h[4 * i + 2], h[4 * i + 3]};
        a = __builtin_elementwise_fma(lo, h0, a); a = __builtin_elementwise_fma(hi, h1, a);
    }
    return a.x + a.y;
}
__device__ __forceinline__ void axpy16_fp8(float (&o)[16], float c, const int4& v) {
    const int w[4] = {v.x, v.y, v.z, v.w};
#pragma unroll
    for (int i = 0; i < 4; ++i) {
        const f32x2_t lo = __builtin_amdgcn_cvt_pk_f32_fp8(w[i], false), hi = __builtin_amdgcn_cvt_pk_f32_fp8(w[i], true);
        o[4 * i] += c * lo.x; o[4 * i + 1] += c * lo.y; o[4 * i + 2] += c * hi.x; o[4 * i + 3] += c * hi.y;
    }
}

typedef _Float16 h2_t __attribute__((ext_vector_type(2)));
__device__ __forceinline__ float dot32_fp4(const h2_t (&h)[16], const int4& u) {
    const unsigned w[4] = {(unsigned)u.x, (unsigned)u.y, (unsigned)u.z, (unsigned)u.w};
    float a0 = 0.f, a1 = 0.f;
#pragma unroll
    for (int i = 0; i < 4; ++i) {
        a0 = __builtin_amdgcn_fdot2(__builtin_bit_cast(h2_t, __builtin_amdgcn_cvt_scalef32_pk_f16_fp4(w[i], 1.0f, 0)), h[4 * i], a0, false);
        a1 = __builtin_amdgcn_fdot2(__builtin_bit_cast(h2_t, __builtin_amdgcn_cvt_scalef32_pk_f16_fp4(w[i], 1.0f, 1)), h[4 * i + 1], a1, false);
        a0 = __builtin_amdgcn_fdot2(__builtin_bit_cast(h2_t, __builtin_amdgcn_cvt_scalef32_pk_f16_fp4(w[i], 1.0f, 2)), h[4 * i + 2], a0, false);
        a1 = __builtin_amdgcn_fdot2(__builtin_bit_cast(h2_t, __builtin_amdgcn_cvt_scalef32_pk_f16_fp4(w[i], 1.0f, 3)), h[4 * i + 3], a1, false);
    }
    return a0 + a1;
}
__device__ void phase_pu(const Params& p, int l, int slice, int grank, int gsz) {
    const int tid_ = otid(); const int lane = tid_ & 63, wid = tid_ >> 6, sub = lane & 7, pg = lane >> 3;
    const bf16_t* H = (const bf16_t*)(p.ws + OFF_H) + slice * 256 + sub * 32;
    const char* U4 = p.ws + OFF_UB + ((size_t)(l * 4 + slice) * NE) * 128 + sub * 16;
    const int* eidx = (const int*)(p.ws + OFF_Y) + lane;
    float* part = (float*)(p.ws + OFF_Z) + (size_t)slice * T * 128 + 16 * sub + pg;
    const int stride = gsz * 4;
#define PU_ISSUE(e_, u_) do { _Pragma("unroll") for (int q = 0; q < 8; ++q) { const int ej = __shfl(e_, 8 * q + pg); u_[q] = *(const int4*)(U4 + (size_t)ej * 128); } } while (0)
    int tok = grank * 4 + wid;
    if (tok >= T) return;
    int4 uA[8], uB[8];
    int ea = eidx[(size_t)tok * 128], eb = eidx[(size_t)tok * 128 + 64];
    uint4 hr[4];
#pragma unroll
    for (int i = 0; i < 4; ++i) hr[i] = *(const uint4*)(H + (size_t)tok * D + 8 * i);
    PU_ISSUE(ea, uA);
#pragma nounroll
    for (;;) {
        __builtin_amdgcn_sched_barrier(0);
        const int tokn = tok + stride; const bool more = tokn < T;
        int ean = 0, ebn = 0; uint4 hn[4] = {hr[0], hr[1], hr[2], hr[3]};
        if (more) { ean = eidx[(size_t)tokn * 128]; ebn = eidx[(size_t)tokn * 128 + 64];
#pragma unroll
            for (int i = 0; i < 4; ++i) hn[i] = *(const uint4*)(H + (size_t)tokn * D + 8 * i); }
        PU_ISSUE(eb, uB);
        __builtin_amdgcn_sched_barrier(0);
        h2_t hf[16];
#pragma unroll
        for (int i = 0; i < 4; ++i) { const unsigned w_[4] = {hr[i].x, hr[i].y, hr[i].z, hr[i].w};
#pragma unroll
            for (int k = 0; k < 4; ++k) hf[4 * i + k] = (h2_t){(_Float16)bf2f(w_[k] & 0xffffu), (_Float16)bf2f(w_[k] >> 16)}; }
        float v[16];
#pragma unroll
        for (int q = 0; q < 8; ++q) v[q] = dot32_fp4(hf, uA[q]);
        __builtin_amdgcn_sched_barrier(0);
        if (more) PU_ISSUE(ean, uA);
        __builtin_amdgcn_sched_barrier(0);
#pragma unroll
        for (int q = 0; q < 8; ++q) v[8 + q] = dot32_fp4(hf, uB[q]);
        float w8[8], w4[4], w2[2];
        { const bool hi = (lane & 4) != 0;
#pragma unroll
          for (int m = 0; m < 8; ++m) { const float send = hi ? v[m] : v[m + 8], keep = hi ? v[m + 8] : v[m]; w8[m] = keep + __shfl_xor(send, 4); } }
        { const bool hi = (lane & 2) != 0;
#pragma unroll
          for (int m = 0; m < 4; ++m) { const float send = hi ? w8[m] : w8[m + 4], keep = hi ? w8[m + 4] : w8[m]; w4[m] = keep + __shfl_xor(send, 2); } }
        { const bool hi = (lane & 1) != 0;
#pragma unroll
          for (int m = 0; m < 2; ++m) { const float send = hi ? w4[m] : w4[m + 2], keep = hi ? w4[m + 2] : w4[m]; w2[m] = keep + __shfl_xor(send, 1); } }
        float* pr = part + (size_t)tok * 128;
        pr[0] = w2[0]; pr[8] = w2[1];
        if (!more) break;
        tok = tokn; ea = ean; eb = ebn;
#pragma unroll
        for (int i = 0; i < 4; ++i) hr[i] = hn[i];
    }
#undef PU_ISSUE
}
__device__ void phase_pc(const Params& p, int l, int bid, int nb) {
    const int tid_ = otid(); const int lane = tid_ & 63, wid = tid_ >> 6;
    const int* eidx = (const int*)(p.ws + OFF_Y); const float* gw = (const float*)(p.ws + OFF_Y + (size_t)T * 128 * 4);
    float* coef = (float*)(p.ws + OFF_Y + (size_t)T * 128 * 8);
    const float* part = (const float*)(p.ws + OFF_Z);
    const float* usc = (const float*)(p.ws + OFF_USC) + (size_t)l * NE; const float* vsc = (const float*)(p.ws + OFF_VSC) + (size_t)l * NE;
    for (int tok = bid * 4 + wid; tok < T; tok += nb * 4) {
#pragma unroll
        for (int hh = 0; hh < 2; ++hh) {
            const size_t j = (size_t)tok * 128 + hh * 64 + lane;
            const int e = eidx[j]; const float g = gw[j];
            float a = 0.f;
#pragma unroll
            for (int sl = 0; sl < 4; ++sl) a += part[(size_t)sl * T * 128 + j];
            { const _Float16 ch = (_Float16)(64.0f * g * gelu_f(a * usc[e]) * vsc[e]); const h2_t cp = {ch, ch}; coef[j] = __builtin_bit_cast(float, cp); }
        }
    }
}
__device__ __forceinline__ void axpy32_fp4(h2_t (&o)[16], h2_t c, const int4& v) {
    const unsigned w[4] = {(unsigned)v.x, (unsigned)v.y, (unsigned)v.z, (unsigned)v.w};
#pragma unroll
    for (int i = 0; i < 4; ++i) {
        o[4 * i]     = __builtin_elementwise_fma(__builtin_bit_cast(h2_t, __builtin_amdgcn_cvt_scalef32_pk_f16_fp4(w[i], 1.0f, 0)), c, o[4 * i]);
        o[4 * i + 1] = __builtin_elementwise_fma(__builtin_bit_cast(h2_t, __builtin_amdgcn_cvt_scalef32_pk_f16_fp4(w[i], 1.0f, 1)), c, o[4 * i + 1]);
        o[4 * i + 2] = __builtin_elementwise_fma(__builtin_bit_cast(h2_t, __builtin_amdgcn_cvt_scalef32_pk_f16_fp4(w[i], 1.0f, 2)), c, o[4 * i + 2]);
        o[4 * i + 3] = __builtin_elementwise_fma(__builtin_bit_cast(h2_t, __builtin_amdgcn_cvt_scalef32_pk_f16_fp4(w[i], 1.0f, 3)), c, o[4 * i + 3]);
    }
}
__device__ void phase_pv(const Params& p, int l, int slice, int grank, int gsz) {
    const int tid_ = otid(); const int lane = tid_ & 63, wid = tid_ >> 6, sub = lane & 7, pg = lane >> 3;
    const char* V4 = p.ws + OFF_VB + ((size_t)(l * 4 + slice) * NE) * 128 + sub * 16;
    const int* eidx = (const int*)(p.ws + OFF_Y) + lane;
    const float* coef = (const float*)(p.ws + OFF_Y + (size_t)T * 128 * 8) + lane;
    const int col = slice * 256 + 32 * sub + 4 * pg;
    const float* g2p = (const float*)(p.ws + OFF_MOD) + (size_t)l * NB * 6144 + 5 * D + col;
    bf16_t* xcol = (bf16_t*)(p.ws + OFF_XR) + col;
    const int stride = gsz * 4;
#define PV_ISSUE(e_, c_, v_, cj_) do { _Pragma("unroll") for (int q = 0; q < 8; ++q) { const int ej = __shfl(e_, 8 * q + pg); cj_[q] = __builtin_bit_cast(h2_t, __shfl(c_, 8 * q + pg)); v_[q] = *(const int4*)(V4 + (size_t)ej * 128); } } while (0)
    int tok = grank * 4 + wid;
    if (tok >= T) return;
    int4 vA[8], vB[8]; h2_t cA[8], cB[8];
    int ea = eidx[(size_t)tok * 128], eb = eidx[(size_t)tok * 128 + 64];
    float ca = coef[(size_t)tok * 128], cb = coef[(size_t)tok * 128 + 64];
    PV_ISSUE(ea, ca, vA, cA);
#pragma nounroll
    for (;;) {
        __builtin_amdgcn_sched_barrier(0);
        const int tokn = tok + stride; const bool more = tokn < T;
        int ean = 0, ebn = 0; float can = 0.f, cbn = 0.f;
        if (more) { ean = eidx[(size_t)tokn * 128]; ebn = eidx[(size_t)tokn * 128 + 64]; can = coef[(size_t)tokn * 128]; cbn = coef[(size_t)tokn * 128 + 64]; }
        uint2* xp = (uint2*)(xcol + (size_t)tok * D); const float4 g2 = *(const float4*)(g2p + (size_t)(tok / SEQ) * 6144);
        const uint2 xw = *xp;
        PV_ISSUE(eb, cb, vB, cB);
        __builtin_amdgcn_sched_barrier(0);
        h2_t oh[16];
#pragma unroll
        for (int i = 0; i < 16; ++i) oh[i] = (h2_t){(_Float16)0.f, (_Float16)0.f};
#pragma unroll
        for (int q = 0; q < 8; ++q) axpy32_fp4(oh, cA[q], vA[q]);
        __builtin_amdgcn_sched_barrier(0);
        if (more) PV_ISSUE(ean, can, vA, cA);
        __builtin_amdgcn_sched_barrier(0);
#pragma unroll
        for (int q = 0; q < 8; ++q) axpy32_fp4(oh, cB[q], vB[q]);
        __builtin_amdgcn_sched_barrier(0);
        h2_t r8[8], r4[4], r2[2];
        { const bool hi = (lane & 32) != 0;
#pragma unroll
          for (int m = 0; m < 8; ++m) { const h2_t send = hi ? oh[m] : oh[8 + m], keep = hi ? oh[8 + m] : oh[m]; r8[m] = keep + __builtin_bit_cast(h2_t, __shfl_xor(__builtin_bit_cast(int, send), 32)); } }
        { const bool hi = (lane & 16) != 0;
#pragma unroll
          for (int m = 0; m < 4; ++m) { const h2_t send = hi ? r8[m] : r8[4 + m], keep = hi ? r8[4 + m] : r8[m]; r4[m] = keep + __builtin_bit_cast(h2_t, __shfl_xor(__builtin_bit_cast(int, send), 16)); } }
        { const bool hi = (lane & 8) != 0;
#pragma unroll
          for (int m = 0; m < 2; ++m) { const h2_t send = hi ? r4[m] : r4[2 + m], keep = hi ? r4[2 + m] : r4[m]; r2[m] = keep + __builtin_bit_cast(h2_t, __shfl_xor(__builtin_bit_cast(int, send), 8)); } }
        const float t4[4] = {(float)r2[0].x, (float)r2[0].y, (float)r2[1].x, (float)r2[1].y};
        const float k64 = 1.0f / 64.0f;
        *xp = make_uint2(pk_bf16(bf2f(xw.x & 0xffffu) + g2.x * k64 * t4[0], bf2f(xw.x >> 16) + g2.y * k64 * t4[1]), pk_bf16(bf2f(xw.y & 0xffffu) + g2.z * k64 * t4[2], bf2f(xw.y >> 16) + g2.w * k64 * t4[3]));
        if (!more) break;
        tok = tokn; ea = ean; eb = ebn; ca = can; cb = cbn;
    }
#undef PV_ISSUE
}
__device__ void phase_final_norm(const Params& p, int bid, int nb) {
    const int tid_ = otid(); const int lane = tid_ & 63, wid = tid_ >> 6;
    for (int tok = bid * 4 + wid; tok < T; tok += nb * 4) {
        float* xr = p.out + (size_t)tok * D;
        const bf16_t* xs = (const bf16_t*)(p.ws + OFF_XR) + (size_t)tok * D;
        float4 v[4]; float ss = 0.f;
#pragma unroll
        for (int i = 0; i < 4; ++i) { const uint2 w = *(const uint2*)(xs + i * 256 + lane * 4); v[i] = make_float4(bf2f(w.x & 0xffffu), bf2f(w.x >> 16), bf2f(w.y & 0xffffu), bf2f(w.y >> 16));
            ss += v[i].x * v[i].x + v[i].y * v[i].y + v[i].z * v[i].z + v[i].w * v[i].w; }
        ss = wave_sum(ss);
        const float rstd = rsqrtf(ss * (1.0f / D) + EPS);
#pragma unroll
        for (int i = 0; i < 4; ++i) { const float4 g = *(const float4*)(p.final_g + i * 256 + lane * 4);
            *(float4*)(xr + i * 256 + lane * 4) = make_float4(v[i].x * rstd * g.x, v[i].y * rstd * g.y, v[i].z * rstd * g.z, v[i].w * rstd * g.w); }
    }
}

#define XB_TMO      128
#define XB_XCNT(j)  (256  + 64 * (j))
#define XB_XSUB(j)  (1280 + 64 * (j))
#define XB_XGEN(j)  (2304 + 64 * (j))
#define XB_TOP      3328
#define XB_TOPGEN   3392
#define XCD_BAR_WORDS 3456
#define XB_SPIN_CAP (1u << 22)
__device__ __forceinline__ unsigned xb_ld(unsigned* p)              { return __hip_atomic_load(p, __ATOMIC_RELAXED, __HIP_MEMORY_SCOPE_AGENT); }
__device__ __forceinline__ unsigned xb_add(unsigned* p, unsigned v) { return __hip_atomic_fetch_add(p, v, __ATOMIC_RELAXED, __HIP_MEMORY_SCOPE_AGENT); }
__device__ __forceinline__ unsigned xb_xcc_id() { return (unsigned)__builtin_amdgcn_s_getreg((3 << 11) | 20) & 0xFu; }
#define XB_SPIN(cond, bar) do { unsigned _sp = 0; while (cond) { __builtin_amdgcn_s_sleep(1); \
    if ((++_sp & 255u) == 0u) { if (xb_ld(&(bar)[XB_TMO])) break; if (_sp > XB_SPIN_CAP) { atomicAdd(&(bar)[XB_TMO], 1u); break; } } } } while (0)
__device__ __forceinline__ void xcd_barrier_post(unsigned* bar, volatile LAS unsigned* st) {
    if (threadIdx.x == 0) { const unsigned x = xb_xcc_id(); st[3] = x; st[2] = xb_add(&bar[XB_XCNT(x)], 1u); }
}
__device__ __forceinline__ void xcd_barrier_complete(unsigned* bar, unsigned x, unsigned& nloc, unsigned& nx) {
    const unsigned G = gridDim.x * gridDim.y * gridDim.z;
    unsigned sum, cnt, mine, sp = 0u;
    for (;;) {
        sum = 0u; cnt = 0u; mine = 0u;
#pragma unroll
        for (unsigned j = 0; j < 16; ++j) { const unsigned c = xb_ld(&bar[XB_XCNT(j)]); sum += c; cnt += (c > 0u) ? 1u : 0u; mine = (j == x) ? c : mine; }
        if (sum == G) break;
        __builtin_amdgcn_s_sleep(1);
        if ((++sp & 255u) == 0u) { if (xb_ld(&bar[XB_TMO])) break; if (sp > XB_SPIN_CAP) { atomicAdd(&bar[XB_TMO], 1u); break; } }
    }
    nloc = mine > 0u ? mine : 1u; nx = cnt > 0u ? cnt : 1u;
}
__device__ __forceinline__ void xcd_barrier(unsigned* bar, volatile LAS unsigned* st) {
    asm volatile("s_waitcnt vmcnt(0)" ::: "memory");
    __syncthreads();
    if (threadIdx.x == 0) {
        __builtin_amdgcn_s_waitcnt(0);
        unsigned nloc = st[0], nx = st[1]; const unsigned x = st[3];
        if (nloc == 0u) { xcd_barrier_complete(bar, x, nloc, nx); st[0] = nloc; st[1] = nx; }
        const unsigned old = xb_add(&bar[XB_XSUB(x)], 1u);
        const unsigned gen = old / nloc;
        if (old + 1u == (gen + 1u) * nloc) {
            __builtin_amdgcn_fence(__ATOMIC_RELEASE, "agent");
            asm volatile("s_waitcnt vmcnt(0)" ::: "memory");
            const unsigned og = xb_add(&bar[XB_TOP], 1u);
            const unsigned tg = og / nx;
            if (og + 1u == (tg + 1u) * nx) xb_add(&bar[XB_TOPGEN], 1u);
            else XB_SPIN(xb_ld(&bar[XB_TOPGEN]) == tg, bar);
            __builtin_amdgcn_fence(__ATOMIC_ACQUIRE, "agent");
            xb_add(&bar[XB_XGEN(x)], 1u);
            asm volatile("s_waitcnt vmcnt(0)" ::: "memory");
        } else {
            XB_SPIN(xb_ld(&bar[XB_XGEN(x)]) == gen, bar);
            __builtin_amdgcn_fence(__ATOMIC_ACQUIRE, "agent");
            asm volatile("s_waitcnt vmcnt(0)" ::: "memory");
        }
    }
    __syncthreads();
}

#if MEGA
#if PROBE_A >= 0
#define TSTAMP(i) do { if (blockIdx.x == 0 && threadIdx.x == 0) ts[i] = __builtin_amdgcn_s_memrealtime(); } while (0)
#else
#define TSTAMP(i) do { } while (0)
#endif
__global__ void __launch_bounds__(256, 2) mega_kernel(Params p) {
    __shared__ __attribute__((aligned(16))) char smem[SMEM_BYTES];
    __shared__ uint4 xb_words;
#if PROBE_A >= 0
    __shared__ unsigned long long ts[26];
#endif
    cg::grid_group grid = cg::this_grid();
    const int bid = blockIdx.x, nb = gridDim.x;
    unsigned* bar = (unsigned*)(p.ws + OFF_BAR);
    if (threadIdx.x == 0) xb_words = make_uint4(0u, 0u, 0u, 0u);
    if (bid == 0) for (int i = threadIdx.x; i < XCD_BAR_WORDS; i += 256) bar[i] = 0u;
    TSTAMP(0);
    phase_prep(p, smem, bid, nb);
    grid.sync();
    volatile LAS unsigned* xst = (volatile LAS unsigned*)&xb_words;
    xcd_barrier_post(bar, xst);
    TSTAMP(1);
    phase_norm<false>(p.x, p.norm1_g, (const float*)(p.ws + OFF_MOD), 0, D, (bf16_t*)(p.ws + OFF_H), bid, nb); xcd_barrier((unsigned*)(p.ws + OFF_BAR), (volatile LAS unsigned*)&xb_words);
    int slice, grank, slice4, grank4; const int gsz = nb / 8, gsz4 = nb / 4;
    {
        const unsigned myx = xst[3], myrank = xst[2];
        unsigned pre = 0;
#pragma unroll
        for (unsigned j = 0; j < 16; ++j) { const unsigned c = xb_ld(&bar[XB_XCNT(j)]); pre += (j < myx) ? c : 0u; }
        const int gi = __builtin_amdgcn_readfirstlane((int)(pre + myrank));
        slice = gi / gsz; grank = gi % gsz; slice4 = gi / gsz4; grank4 = gi % gsz4;
    }
#pragma nounroll
    for (int l = 0; l < NL; ++l) {
        TSTAMP(2 + 11 * l); phase_gemm1(p, l, smem, bid, nb); xcd_barrier((unsigned*)(p.ws + OFF_BAR), (volatile LAS unsigned*)&xb_words);
        TSTAMP(3 + 11 * l); phase_mix(p, l, smem, bid, nb); xcd_barrier((unsigned*)(p.ws + OFF_BAR), (volatile LAS unsigned*)&xb_words);
        TSTAMP(4 + 11 * l); phase_fftb(p, l, smem, bid, nb); xcd_barrier((unsigned*)(p.ws + OFF_BAR), (volatile LAS unsigned*)&xb_words);
        TSTAMP(5 + 11 * l); phase_gemm2(p, l, smem, bid, nb); xcd_barrier((unsigned*)(p.ws + OFF_BAR), (volatile LAS unsigned*)&xb_words);
        TSTAMP(6 + 11 * l); phase_norm<true>(p.ws + OFF_XR, p.norm2_g + l * D, (const float*)(p.ws + OFF_MOD) + (size_t)l * NB * 6144, 3 * D, 4 * D, (bf16_t*)(p.ws + OFF_H), bid, nb); xcd_barrier((unsigned*)(p.ws + OFF_BAR), (volatile LAS unsigned*)&xb_words);
        TSTAMP(7 + 11 * l); phase_gemm3(p, l, smem, bid, nb); xcd_barrier((unsigned*)(p.ws + OFF_BAR), (volatile LAS unsigned*)&xb_words);
        TSTAMP(8 + 11 * l); phase_topk(p, l, smem, bid, nb); xcd_barrier((unsigned*)(p.ws + OFF_BAR), (volatile LAS unsigned*)&xb_words);
        TSTAMP(9 + 11 * l); phase_pu(p, l, slice4, grank4, gsz4); xcd_barrier((unsigned*)(p.ws + OFF_BAR), (volatile LAS unsigned*)&xb_words);
        TSTAMP(10 + 11 * l); phase_pc(p, l, bid, nb); xcd_barrier((unsigned*)(p.ws + OFF_BAR), (volatile LAS unsigned*)&xb_words);
        TSTAMP(11 + 11 * l); phase_pv(p, l, slice4, grank4, gsz4); xcd_barrier((unsigned*)(p.ws + OFF_BAR), (volatile LAS unsigned*)&xb_words);
        TSTAMP(12 + 11 * l);
        if (l + 1 < NL) { phase_norm<true>(p.ws + OFF_XR, p.norm1_g + (l + 1) * D, (const float*)(p.ws + OFF_MOD) + (size_t)(l + 1) * NB * 6144, 0, D, (bf16_t*)(p.ws + OFF_H), bid, nb); xcd_barrier((unsigned*)(p.ws + OFF_BAR), (volatile LAS unsigned*)&xb_words); }
        else phase_final_norm(p, bid, nb);
    }
    TSTAMP(24);
#if PROBE_A >= 0
    if (bid == 0 && threadIdx.x == 0) p.out[0] += (float)(ts[PROBE_B] - ts[PROBE_A]) * 0.01f / PROBE_DIV;
#endif
}
#endif

extern "C" void kernel_launch(void* const* d_in, const int* in_sizes, int n_in, void* d_out, int out_size, void* d_ws, size_t ws_size, hipStream_t stream) {
    (void)in_sizes; (void)n_in; (void)out_size;
    if (ws_size < OFF_END) { fprintf(stderr, "workspace too small: %zu < %zu\n", ws_size, (size_t)OFF_END); return; }
    Params p{};
    p.x = (const float*)d_in[0]; p.c = (const float*)d_in[1]; p.mod_w = (const float*)d_in[2]; p.mod_b = (const float*)d_in[3]; p.norm1_g = (const float*)d_in[4];
    p.w_in = (const float*)d_in[5]; p.gmlp_ws = (const float*)d_in[6]; p.gmlp_bs = (const float*)d_in[7]; p.fnet_w = (const float*)d_in[8]; p.fnet_b = (const float*)d_in[9];
    p.gain_a = (const float*)d_in[10]; p.gain_b = (const float*)d_in[11]; p.w_out = (const float*)d_in[12]; p.norm2_g = (const float*)d_in[13]; p.wq = (const float*)d_in[14];
    p.k1 = (const float*)d_in[15]; p.k2 = (const float*)d_in[16]; p.pu = (const float*)d_in[17]; p.pv = (const float*)d_in[18]; p.final_g = (const float*)d_in[19];
    p.out = (float*)d_out; p.ws = (char*)d_ws;
#if MEGA
    static int grid_blocks = 0;
    if (!grid_blocks) {
        int dev = 0, cus = 0, per_cu = 0;
        hipGetDevice(&dev);
        hipDeviceGetAttribute(&cus, hipDeviceAttributeMultiprocessorCount, dev);
        hipOccupancyMaxActiveBlocksPerMultiprocessor(&per_cu, mega_kernel, 256, 0);
        if (per_cu > 2) per_cu = 2;
        grid_blocks = (cus * per_cu) / 8 * 8;
    }
    void* args[] = {&p};
    hipError_t e = hipLaunchCooperativeKernel((void*)mega_kernel, dim3(grid_blocks), dim3(256), args, 0, stream);
    if (e != hipSuccess) fprintf(stderr, "cooperative launch failed: %s (grid %d)\n", hipGetErrorString(e), grid_blocks);
#endif
}
```

```cpp
#include <hip/hip_runtime.h>
#include <hip/hip_cooperative_groups.h>
#include <cstdio>
#include <cstdint>
namespace cg = cooperative_groups;

#ifndef MEGA
#define MEGA 1
#endif
#ifndef COOP
#define COOP 1
#endif
#ifndef PROBE_A
#define PROBE_A -1
#define PROBE_B 0
#define PROBE_DIV 10.0f
#endif

typedef unsigned short bf16_t;
typedef short bf16x8 __attribute__((ext_vector_type(8)));
typedef float f32x4 __attribute__((ext_vector_type(4)));
typedef __bf16 bf16x2_t __attribute__((ext_vector_type(2)));

constexpr int D = 1024, NB = 8, SEQ = 4096, T = NB * SEQ, NL = 2;
constexpr int NZ = 2048;
constexpr int NE = 16384;
constexpr float EPS = 1e-6f;

constexpr size_t OFF_MOD  = 0;
constexpr size_t OFF_W1T  = OFF_MOD  + (size_t)NL * NB * 6144 * 4;
constexpr size_t OFF_W2T  = OFF_W1T  + (size_t)NL * 2048 * 1024 * 2;
constexpr size_t OFF_WQT  = OFF_W2T  + (size_t)NL * 1024 * 1024 * 2;
constexpr size_t OFF_K12  = OFF_WQT  + (size_t)NL * 2048 * 1024 * 2;
constexpr size_t OFF_WSB  = OFF_K12  + (size_t)NL * 8 * 256 * 128 * 2;
constexpr size_t OFF_DA   = OFF_WSB  + (size_t)NL * 8 * 128 * 128 * 2;
constexpr size_t OFF_DB   = OFF_DA   + 128 * 128 * 2;
constexpr size_t OFF_TW   = OFF_DB   + 64 * 128 * 2;
constexpr size_t OFF_SSQA = OFF_TW   + 64 * 64 * 8;
constexpr size_t OFF_SSQB = OFF_SSQA + (size_t)T * 8 * 4;
constexpr size_t OFF_UB   = OFF_SSQB + (size_t)T * 8 * 4;
constexpr size_t OFF_VB   = OFF_UB   + (size_t)NL * NE * 1024;
constexpr size_t OFF_USC  = OFF_VB   + (size_t)NL * NE * 1024;
constexpr size_t OFF_VSC  = OFF_USC  + (size_t)NL * NE * 4;
constexpr size_t OFF_H    = OFF_VSC  + (size_t)NL * NE * 4;
constexpr size_t OFF_Z    = OFF_H    + (size_t)T * 1024 * 2;
constexpr size_t OFF_Y    = OFF_Z    + (size_t)T * 2048 * 2;
constexpr size_t OFF_BAR  = OFF_Y    + (size_t)T * 1024 * 2;
constexpr size_t OFF_XR   = OFF_BAR  + 16384;
constexpr size_t OFF_END  = OFF_XR   + (size_t)T * 1024 * 2;

struct Params {
    const float* x; const float* c; const float* mod_w; const float* mod_b; const float* norm1_g; const float* w_in;
    const float* gmlp_ws; const float* gmlp_bs; const float* fnet_w; const float* fnet_b; const float* gain_a; const float* gain_b;
    const float* w_out; const float* norm2_g; const float* wq; const float* k1; const float* k2; const float* pu; const float* pv; const float* final_g;
    float* out; char* ws;
};

constexpr int SMEM_BYTES = 73984;

__device__ __forceinline__ float bf2f(unsigned v) { return __uint_as_float(v << 16); }
typedef float f32x2_t __attribute__((ext_vector_type(2)));
__device__ __forceinline__ unsigned pk_bf16(float lo, float hi) { const f32x2_t v = {lo, hi}; return __builtin_bit_cast(unsigned, __builtin_convertvector(v, bf16x2_t)); }
__device__ __forceinline__ bf16_t f2bf(float f) { return (bf16_t)(pk_bf16(f, 0.f) & 0xffffu); }
__device__ __forceinline__ float gelu_f(float v) {
    const float t = __builtin_amdgcn_rcpf(fabsf(v) * 0.2316418882f + 1.0f);
    float q = t * 0.5307027145f + (-0.7265760135f); q = q * t + 0.7107068705f; q = q * t + (-0.142248368f); q = q * t + 0.127414796f; q = q * t;
    const float m = v * (q * __builtin_amdgcn_exp2f(v * v * (-0.72134752044f)));
    return v < 0.f ? m : v - m;
}
__device__ __forceinline__ int med3i(int a, int b, int c) { return max(min(a, b), min(max(a, b), c)); }
__device__ __forceinline__ int f2key(float f) { int b = __float_as_int(f); return b ^ ((b >> 31) & 0x7fffffff); }
__device__ __forceinline__ float key2f(int k) { return __int_as_float(k ^ ((k >> 31) & 0x7fffffff)); }
__device__ __forceinline__ float wave_sum(float v) {
#pragma unroll
    for (int o = 32; o >= 1; o >>= 1) v += __shfl_xor(v, o);
    return v;
}
__device__ __forceinline__ int otid() { int t = threadIdx.x & 255; asm volatile("" : "+v"(t)); return t; }
__device__ __forceinline__ void vsync(char* smem_v) {
    const int vb_ = threadIdx.x >> 8;
    volatile __attribute__((address_space(3))) unsigned* cnt = (volatile __attribute__((address_space(3))) unsigned*)(smem_v + (2 - vb_) * SMEM_BYTES + 16) + vb_;
    asm volatile("s_waitcnt lgkmcnt(0)" ::: "memory");
    unsigned target = 0u;
    if ((threadIdx.x & 63) == 0) target = (__hip_atomic_fetch_add((__attribute__((address_space(3))) unsigned*)cnt, 1u, __ATOMIC_RELAXED, __HIP_MEMORY_SCOPE_WORKGROUP) / 4u + 1u) * 4u;
    target = __builtin_amdgcn_readfirstlane(target);
    while (*cnt < target) __builtin_amdgcn_s_sleep(1);
    asm volatile("" ::: "memory");
}
#define MFMA16(a, b, c) __builtin_amdgcn_mfma_f32_16x16x32_bf16((a), (b), (c), 0, 0, 0)

__device__ void transpose_tile(const float* __restrict__ src, int ld, int k0, int n0, bf16_t* __restrict__ dst  , int dn0,
                               const float* __restrict__ kscale, float* tile  ) {
    const int tid = otid();
#pragma unroll
    for (int i = 0; i < 4; ++i) {
        const int r = (tid >> 4) + 16 * i, c4 = (tid & 15) * 4;
        const float4 v = *(const float4*)(src + (size_t)(k0 + r) * ld + n0 + c4);
        const float s = kscale ? kscale[k0 + r] : 1.0f;
        tile[r * 65 + c4 + 0] = v.x * s; tile[r * 65 + c4 + 1] = v.y * s; tile[r * 65 + c4 + 2] = v.z * s; tile[r * 65 + c4 + 3] = v.w * s;
    }
    __syncthreads();
    {
        const int n = tid >> 2, ks = (tid & 3) * 16;
        unsigned w[8];
#pragma unroll
        for (int j = 0; j < 8; ++j) w[j] = pk_bf16(tile[(ks + 2 * j) * 65 + n], tile[(ks + 2 * j + 1) * 65 + n]);
        uint4* d = (uint4*)(dst + (size_t)(dn0 + n) * 1024 + k0 + ks);
        d[0] = make_uint4(w[0], w[1], w[2], w[3]); d[1] = make_uint4(w[4], w[5], w[6], w[7]);
    }
    __syncthreads();
}

__device__ void phase_prep(const Params& p, char* smem, int bid_, int nb_) {
    const int tid = otid();
    char* ws = p.ws;
    const bool split = (nb_ % 4 == 0);
    const bool convgrp = split && ((bid_ >> 1) & 1);
    const int bid = split ? (((bid_ >> 2) << 1) | (bid_ & 1)) : bid_, nb = split ? (nb_ >> 1) : nb_;
    const int gtid = bid * 256 + tid, gsz = nb * 256;
    if (!convgrp) {
    {
        float* sc = (float*)smem;
        float* red = (float*)(smem + 32768);
        for (int i = tid; i < 8192; i += 256) { const float v = p.c[i]; sc[i] = v / (1.0f + __expf(-v)); }
        __syncthreads();
        float* mod = (float*)(ws + OFF_MOD);
        for (int rd_ = 0; rd_ < (NL * 192 + nb - 1) / nb; ++rd_) { const int item = min(bid + rd_ * nb, NL * 192 - 1);
            const int l = item / 192, n0 = (item % 192) * 32, nn = tid & 31, kq = tid >> 5;
            float acc[8];
#pragma unroll
            for (int b = 0; b < 8; ++b) acc[b] = 0.f;
            const float* W = p.mod_w + (size_t)l * 1024 * 6144 + n0 + nn;
#pragma nounroll
            for (int k0 = kq; k0 < 1024; k0 += 128) {
                float w[16];
#pragma unroll
                for (int u = 0; u < 16; ++u) w[u] = W[(size_t)(k0 + 8 * u) * 6144];
#pragma unroll
                for (int u = 0; u < 16; ++u)
#pragma unroll
                    for (int b = 0; b < 8; ++b) acc[b] += sc[b * 1024 + k0 + 8 * u] * w[u];
            }
#pragma unroll
            for (int b = 0; b < 8; ++b) red[(kq * 8 + b) * 32 + nn] = acc[b];
            __syncthreads();
            {
                const int b = tid >> 5;
                float s = 0.f;
#pragma unroll
                for (int q = 0; q < 8; ++q) s += red[(q * 8 + b) * 32 + nn];
                mod[((size_t)l * NB + b) * 6144 + n0 + nn] = s + p.mod_b[l * 6144 + n0 + nn];
            }
            __syncthreads();
        }
    }
    {
        float* tile = (float*)smem;
        for (int rd_ = 0; rd_ < (NL * 1024 + nb - 1) / nb; ++rd_) { const int item = min(bid + rd_ * nb, NL * 1024 - 1);
            const int l = item / 1024, r = item % 1024;
            if (r < 256) {
                const int kt = r / 16, nt = r % 16;
                transpose_tile(p.w_in + (size_t)l * 1024 * 1536, 1536, kt * 64, nt * 64, (bf16_t*)(ws + OFF_W1T) + (size_t)l * 2048 * 1024, nt * 64, nullptr, tile);
            } else if (r < 512) {
                const int rr = r - 256, kt = rr / 16, nt = rr % 16;
                const float* gk = (kt < 8) ? (p.gain_a + l * 512) : (p.gain_b + l * 512 - 512);
                transpose_tile(p.w_out + (size_t)l * 1024 * 1024, 1024, kt * 64, nt * 64, (bf16_t*)(ws + OFF_W2T) + (size_t)l * 1024 * 1024, nt * 64, gk, tile);
            } else {
                const int rr = r - 512, kt = rr / 32, nt = rr % 32;
                transpose_tile(p.wq + (size_t)l * 1024 * 2048, 2048, kt * 64, nt * 64, (bf16_t*)(ws + OFF_WQT) + (size_t)l * 2048 * 1024, nt * 64, nullptr, tile);
            }
        }
    }
    {
        float* fws = (float*)smem;
        float* Ms  = (float*)(smem + 16384);
        float* wt  = (float*)(smem + 49152);
        float* cs  = (float*)(smem + 49152 + 16640);
        for (int rd_ = 0; rd_ < (NL * 8 * 16 + nb - 1) / nb; ++rd_) { const int item = min(bid + rd_ * nb, NL * 8 * 16 - 1);
            const int l = item / 128, g = (item % 128) / 16, kt = item % 16;
            if (tid < 64) { float s, c; sincospif((float)tid / 32.0f, &s, &c); cs[tid] = c; cs[64 + tid] = s; }
            for (int i = tid; i < 4096; i += 256) fws[i] = p.fnet_w[((size_t)l * 8 + g) * 4096 + i];
#pragma unroll
            for (int i = 0; i < 4; ++i) {
                const int r = (tid >> 4) + 16 * i, c4 = (tid & 15) * 4;
                const float4 v = *(const float4*)(p.w_in + (size_t)l * 1024 * 1536 + (size_t)(kt * 64 + r) * 1536 + 1024 + g * 64 + c4);
                wt[r * 65 + c4] = v.x; wt[r * 65 + c4 + 1] = v.y; wt[r * 65 + c4 + 2] = v.z; wt[r * 65 + c4 + 3] = v.w;
            }
            __syncthreads();
            {
                const int d = tid >> 2, r0 = (tid & 3) * 32;
                const bool im = r0 >= 64; const int e0 = r0 & 63;
                float acc[32];
#pragma unroll
                for (int e = 0; e < 32; ++e) acc[e] = 0.f;
                for (int j = 0; j < 64; ++j) {
                    const int ph = (d * j) & 63;
                    const float t = im ? -cs[64 + ph] : cs[ph];
#pragma unroll
                    for (int e = 0; e < 32; ++e) acc[e] += t * fws[j * 64 + e0 + e];
                }
#pragma unroll
                for (int e = 0; e < 32; ++e) Ms[d * 128 + r0 + e] = acc[e];
            }
            __syncthreads();
            {
                const int r = tid >> 1, kk0 = (tid & 1) * 32;
                float acc[32];
#pragma unroll
                for (int k = 0; k < 32; ++k) acc[k] = 0.f;
                for (int d = 0; d < 64; ++d) {
                    const float m = Ms[d * 128 + r];
#pragma unroll
                    for (int k = 0; k < 32; ++k) acc[k] += wt[(kk0 + k) * 65 + d] * m;
                }
                bf16_t* dst = (bf16_t*)(ws + OFF_W1T) + (size_t)l * 2048 * 1024 + (size_t)(1024 + g * 128 + r) * 1024 + kt * 64 + kk0;
#pragma unroll
                for (int q = 0; q < 4; ++q)
                    ((uint4*)dst)[q] = make_uint4(pk_bf16(acc[q * 8], acc[q * 8 + 1]), pk_bf16(acc[q * 8 + 2], acc[q * 8 + 3]), pk_bf16(acc[q * 8 + 4], acc[q * 8 + 5]), pk_bf16(acc[q * 8 + 6], acc[q * 8 + 7]));
            }
            __syncthreads();
        }
    }
    {
        bf16_t* k12 = (bf16_t*)(ws + OFF_K12);
        for (int i = gtid; i < NL * 8 * 256 * 128; i += gsz) {
            const int d = i & 127, n = (i >> 7) & 255, h = (i >> 15) & 7, l = i >> 18;
            const float* src = (n < 128) ? p.k1 : p.k2;
            k12[i] = f2bf(src[(((size_t)l * 8 + h) * 128 + (n & 127)) * 128 + d]);
        }
        bf16_t* wsb = (bf16_t*)(ws + OFF_WSB);
        for (int i = gtid; i < NL * 8 * 128 * 128; i += gsz) wsb[i] = f2bf(p.gmlp_ws[i]);
        bf16_t* DA = (bf16_t*)(ws + OFF_DA);
        for (int i = gtid; i < 128 * 128; i += gsz) {
            const int m = i >> 7, kk = i & 127, ro = m >> 6, k1 = m & 63, ri = kk >> 6, a = kk & 63;
            float s, c; sincospif((float)((a * k1) & 63) / 32.0f, &s, &c);
            const float v = (ro == ri) ? c : (ro == 0 ? s : -s);
            DA[i] = f2bf(v);
        }
        bf16_t* DB = (bf16_t*)(ws + OFF_DB);
        for (int i = gtid; i < 64 * 128; i += gsz) {
            const int k2 = i >> 7, kk = i & 127, ri = kk >> 6, b = kk & 63;
            float s, c; sincospif((float)((b * k2) & 63) / 32.0f, &s, &c);
            DB[i] = f2bf(ri ? s : c);
        }
        float2* tw = (float2*)(ws + OFF_TW);
        for (int i = gtid; i < 64 * 64; i += gsz) {
            const int bp = i >> 6, k1 = i & 63;
            float s, c; sincospif((float)(bp * k1) / 2048.0f, &s, &c);
            tw[i] = make_float2(c, s);
        }
    }
    }
    if (convgrp || !split) {
        {
            const int lane = tid & 63, wv = gtid >> 6, nwv = gsz >> 6;
            const int R = 2 * NL * NE;
#pragma nounroll
            for (int r0 = wv; r0 < R; r0 += 4 * nwv) {
                float4 v[4][4];
#pragma unroll
                for (int t = 0; t < 4; ++t) {
                    const int r = (r0 + t * nwv < R) ? r0 + t * nwv : r0;
                    const int tbl = r / (NL * NE), row = r % (NL * NE);
                    const float* src = (tbl ? p.pv : p.pu) + (size_t)row * 1024 + lane * 16;
#pragma unroll
                    for (int i = 0; i < 4; ++i) v[t][i] = ((const float4*)src)[i];
                }
                __builtin_amdgcn_sched_barrier(0);
#pragma unroll
                for (int t = 0; t < 4; ++t) {
                    const int r = r0 + t * nwv;
                    if (r >= R) break;
                    const int tbl = r / (NL * NE), row = r % (NL * NE);
                    float m = 0.f;
#pragma unroll
                    for (int i = 0; i < 4; ++i) m = fmaxf(m, fmaxf(fmaxf(fabsf(v[t][i].x), fabsf(v[t][i].y)), fmaxf(fabsf(v[t][i].z), fabsf(v[t][i].w))));
#pragma unroll
                    for (int o = 32; o >= 1; o >>= 1) m = fmaxf(m, __shfl_xor(m, o));
                    const float qmax = 6.0f;
                    const float sc = (m > 0.f) ? qmax / m : 1.0f, inv = (m > 0.f) ? m / qmax : 1.0f;
                    const int lyr = row / NE, ex = row % NE;
                    if (true) {
                        unsigned w0 = 0u, w1 = 0u;
                        w0 = __builtin_amdgcn_cvt_scalef32_pk_fp4_f32(w0, v[t][0].x * sc, v[t][0].y * sc, 1.0f, 0); w0 = __builtin_amdgcn_cvt_scalef32_pk_fp4_f32(w0, v[t][0].z * sc, v[t][0].w * sc, 1.0f, 1);
                        w0 = __builtin_amdgcn_cvt_scalef32_pk_fp4_f32(w0, v[t][1].x * sc, v[t][1].y * sc, 1.0f, 2); w0 = __builtin_amdgcn_cvt_scalef32_pk_fp4_f32(w0, v[t][1].z * sc, v[t][1].w * sc, 1.0f, 3);
                        w1 = __builtin_amdgcn_cvt_scalef32_pk_fp4_f32(w1, v[t][2].x * sc, v[t][2].y * sc, 1.0f, 0); w1 = __builtin_amdgcn_cvt_scalef32_pk_fp4_f32(w1, v[t][2].z * sc, v[t][2].w * sc, 1.0f, 1);
                        w1 = __builtin_amdgcn_cvt_scalef32_pk_fp4_f32(w1, v[t][3].x * sc, v[t][3].y * sc, 1.0f, 2); w1 = __builtin_amdgcn_cvt_scalef32_pk_fp4_f32(w1, v[t][3].z * sc, v[t][3].w * sc, 1.0f, 3);
                        *(uint2*)(ws + (tbl ? OFF_VB : OFF_UB) + ((size_t)(lyr * 4 + (lane >> 4)) * NE + ex) * 128 + (lane & 15) * 8) = make_uint2(w0, w1);
                    } else {
                        int w[4];
#pragma unroll
                        for (int i = 0; i < 4; ++i) { w[i] = __builtin_amdgcn_cvt_pk_fp8_f32(v[t][i].x * sc, v[t][i].y * sc, 0, false); w[i] = __builtin_amdgcn_cvt_pk_fp8_f32(v[t][i].z * sc, v[t][i].w * sc, w[i], true); }
                        *(int4*)(ws + OFF_UB + ((size_t)(lyr * 8 + (lane >> 3)) * NE + ex) * 128 + (lane & 7) * 16) = make_int4(w[0], w[1], w[2], w[3]);
                    }
                    if (lane == 0) ((float*)(ws + (tbl ? OFF_VSC : OFF_USC)))[row] = inv;
                    __builtin_amdgcn_sched_barrier(0);
                }
            }
        }
    }
}

template <bool SRC_BF16, bool ADD = false, int NU = 2>
__device__ void phase_norm(const void* xsrc_, const float* __restrict__ g, const float* __restrict__ modl  , int sh_off, int scl_off,
                           bf16_t* __restrict__ hout, int bid, int nb, const bf16_t* __restrict__ sadd = nullptr, const float* __restrict__ g2l = nullptr) {
    const int tid_ = otid(); const int lane = tid_ & 63, wid = tid_ >> 6;
    for (int tok0 = bid * 4 + wid; tok0 < T; tok0 += nb * 4 * NU) {
        int tk[NU]; bool ok[NU];
#pragma unroll
        for (int u = 0; u < NU; ++u) { ok[u] = tok0 + u * nb * 4 < T; tk[u] = ok[u] ? tok0 + u * nb * 4 : tok0; }
        float4 v[NU][4]; uint2 xw[NU][4], sw[NU][4]; float4 g2[NU][4];
#pragma unroll
        for (int u = 0; u < NU; ++u)
#pragma unroll
            for (int i = 0; i < 4; ++i) {
                const size_t o = (size_t)tk[u] * D + i * 256 + lane * 4;
                if (SRC_BF16) xw[u][i] = *(const uint2*)((const bf16_t*)xsrc_ + o); else v[u][i] = *(const float4*)((const float*)xsrc_ + o);
                if (ADD) { sw[u][i] = *(const uint2*)(sadd + o); g2[u][i] = *(const float4*)(g2l + (size_t)(tk[u] / SEQ) * 6144 + i * 256 + lane * 4); }
            }
        float ss[NU];
#pragma unroll
        for (int u = 0; u < NU; ++u) { ss[u] = 0.f;
#pragma unroll
            for (int i = 0; i < 4; ++i) {
                if (SRC_BF16) v[u][i] = make_float4(bf2f(xw[u][i].x & 0xffffu), bf2f(xw[u][i].x >> 16), bf2f(xw[u][i].y & 0xffffu), bf2f(xw[u][i].y >> 16));
                if (ADD) { const uint2 s_ = sw[u][i]; const float4 g_ = g2[u][i];
                    const unsigned r0 = pk_bf16(v[u][i].x + g_.x * bf2f(s_.x & 0xffffu), v[u][i].y + g_.y * bf2f(s_.x >> 16)), r1 = pk_bf16(v[u][i].z + g_.z * bf2f(s_.y & 0xffffu), v[u][i].w + g_.w * bf2f(s_.y >> 16));
                    if (ok[u]) *(uint2*)((bf16_t*)xsrc_ + (size_t)tk[u] * D + i * 256 + lane * 4) = make_uint2(r0, r1);
                    v[u][i] = make_float4(bf2f(r0 & 0xffffu), bf2f(r0 >> 16), bf2f(r1 & 0xffffu), bf2f(r1 >> 16)); }
                ss[u] += v[u][i].x * v[u][i].x + v[u][i].y * v[u][i].y + v[u][i].z * v[u][i].z + v[u][i].w * v[u][i].w;
            }
        }
#pragma unroll
        for (int u = 0; u < NU; ++u) {
            const float rstd = rsqrtf(wave_sum(ss[u]) * (1.0f / D) + EPS);
            const float* mb = modl + (size_t)(tk[u] / SEQ) * 6144;
#pragma unroll
            for (int i = 0; i < 4; ++i) {
                const int cidx = i * 256 + lane * 4;
                const float4 gg = *(const float4*)(g + cidx), sh = *(const float4*)(mb + sh_off + cidx), sc = *(const float4*)(mb + scl_off + cidx);
                const float o0 = v[u][i].x * rstd * gg.x * (1.0f + sc.x) + sh.x, o1 = v[u][i].y * rstd * gg.y * (1.0f + sc.y) + sh.y;
                const float o2 = v[u][i].z * rstd * gg.z * (1.0f + sc.z) + sh.z, o3 = v[u][i].w * rstd * gg.w * (1.0f + sc.w) + sh.w;
                if (ok[u]) *(uint2*)(hout + (size_t)tk[u] * D + cidx) = make_uint2(pk_bf16(o0, o1), pk_bf16(o2, o3));
            }
        }
    }
}

namespace pg8 {
#define PG8_LAS __attribute__((address_space(3)))
typedef unsigned short bf16_t;
typedef short bf16x8 __attribute__((ext_vector_type(8)));
typedef float f32x4 __attribute__((ext_vector_type(4)));
typedef unsigned u32x4 __attribute__((ext_vector_type(4)));
constexpr int BM = 256, BK = 64, HALF = 128, HTB = HALF * BK * 2  , STAGE_BYTES = 8 * HTB, NXCD = 8, WGM = 8;

__host__ __device__ __forceinline__ int lds_byte(int r, int c) { const int st = (r >> 4) * 2 + (c >> 5), rr = r & 15, cc = c & 31, ob = rr * 64 + cc * 2; return st * 1024 + (ob ^ (((ob >> 9) & 1) << 5)); }
__host__ __device__ __forceinline__ void stage_rc(int b, int& R, int& C) { const int st = b / 1024, sb = b % 1024, swz = sb ^ (((sb >> 9) & 1) << 5); R = (st >> 1) * 16 + swz / 64; C = (st & 1) * 32 + (swz % 64) / 2; }
__host__ __device__ __forceinline__ int perm32(int rho) { const int n = rho >> 4, i = rho & 15; return 8 * (i >> 2) + 4 * n + (i & 3); }

struct Unit { int pm, pn; };
struct Gemm { const bf16_t* A; const bf16_t* Bt; int M, N, K; };

struct StaticOrder {
    int nM, nN, nwg, G, c;
    __host__ __device__ void init(int M, int N, int G_, int c_) { nM = M / BM; nN = N / BM; nwg = nM * nN; G = G_; c = c_; }
    __host__ __device__ bool next(int i, Unit& u) const {
        const long L = (long)i * G + c; if (L >= nwg) return false;
        int wgid = (int)L; { const int q = nwg / NXCD, r = nwg % NXCD, xcd = wgid % NXCD, off = wgid / NXCD; wgid = (xcd < r ? xcd * (q + 1) : r * (q + 1) + (xcd - r) * q) + off; }
        const int nig = WGM * nN, gid = wgid / nig, fm = gid * WGM, gsz = (nM - fm) < WGM ? (nM - fm) : WGM;
        u.pm = fm + ((wgid % nig) % gsz); u.pn = (wgid % nig) / gsz; return true;
    }
    __device__ __forceinline__ void a_ready(const Unit&) const {}
    __device__ __forceinline__ void done(const Unit&) const {}
};

template <class Epi, class Sched, class MidK, bool STAMP = false>
__device__ __forceinline__ void gemm_phase(PG8_LAS unsigned char* lds, const Gemm g, const Sched& S, const Epi& E, const MidK& MK, int midt, unsigned long long* stamps) {
    int tid_ = threadIdx.x; asm volatile("" : "+v"(tid_));
    const int tid = tid_, wid = __builtin_amdgcn_readfirstlane(tid >> 6), lane = tid & 63, wr = wid >> 2, wc = wid & 3, fr = lane & 15, fq = lane >> 4;
    const int K = g.K, nt = K / BK;
    int ts_lo = 0, ts_hi = 0, nts = 0; const unsigned long long rt_entry = STAMP ? (unsigned long long)wall_clock64() : 0ull;
#define PG8_STAMP() do { if (STAMP && wid == 0 && nts < 64) { const unsigned long long _c = (unsigned long long)clock64(); \
        ts_lo = (lane == nts) ? (int)(unsigned)_c : ts_lo; ts_hi = (lane == nts) ? (int)(unsigned)(_c >> 32) : ts_hi; ++nts; } } while (0)
    PG8_STAMP();
    unsigned voffA[2], voffB[2];
#pragma unroll
    for (int i = 0; i < 2; ++i) { int R, C; stage_rc(tid * 16 + i * 8192, R, C); const int Rb = Epi::PERM ? ((R & ~31) + perm32(R & 31)) : R;
        voffA[i] = (unsigned)(R * K + C) * 2u; voffB[i] = (unsigned)(Rb * K + C) * 2u; }
    const size_t kstep = (size_t)(BK * 2);
    const size_t hstep = (size_t)HALF * K * 2;
    const size_t tstep = 2 * hstep;
    const unsigned ldsw = (unsigned)wid * 1024u;
    const int aoff = lds_byte(wr * 64 + fr, fq * 8), boff = lds_byte(wc * 32 + fr, fq * 8);
#define PG8_SA(b, h) (((b) * 2 + (h)) * HTB)
#define PG8_SB(b, h) ((4 + (b) * 2 + (h)) * HTB)
#define PG8_STAGE(bufoff, gbase, voff) do { _Pragma("unroll") for (int _i = 0; _i < 2; ++_i) \
        __builtin_amdgcn_global_load_lds((const unsigned*)((const char*)(gbase) + (voff)[_i]), (PG8_LAS unsigned*)(lds + (bufoff) + ldsw + _i * 8192), 16, 0, 0); } while (0)
#define PG8_LDA(dst, b, h) do { _Pragma("unroll") for (int m = 0; m < 4; ++m) _Pragma("unroll") for (int k = 0; k < 2; ++k) dst[m][k] = *(const PG8_LAS bf16x8*)(lds + PG8_SA(b, h) + aoff + m * 2048 + k * 1024); } while (0)
#define PG8_LDB(dst, b, h) do { _Pragma("unroll") for (int n = 0; n < 2; ++n) _Pragma("unroll") for (int k = 0; k < 2; ++k) dst[n][k] = *(const PG8_LAS bf16x8*)(lds + PG8_SB(b, h) + boff + n * 2048 + k * 1024); } while (0)
#define PG8_MMA(ai, bj, At, Bt) do { __builtin_amdgcn_s_setprio(1); _Pragma("unroll") for (int m = 0; m < 4; ++m) _Pragma("unroll") for (int n = 0; n < 2; ++n) _Pragma("unroll") for (int k = 0; k < 2; ++k) \
        acc[ai][bj][m][n] = __builtin_amdgcn_mfma_f32_16x16x32_bf16(Bt[n][k], At[m][k], acc[ai][bj][m][n], 0, 0, 0); __builtin_amdgcn_s_setprio(0); } while (0)
#define PG8_WAIT_V(n) asm volatile("s_waitcnt vmcnt(" #n ")" ::: "memory")
#define PG8_WAIT_L(n) asm volatile("s_waitcnt lgkmcnt(" #n ")" ::: "memory")
#define PG8_BAR __builtin_amdgcn_s_barrier()
#define PG8_SCHED __builtin_amdgcn_sched_barrier(0)
    Unit cur, nxt; int ui = 0;
    if (!S.next(0, cur)) return;
    f32x4 acc[2][2][4][2];
#pragma unroll
    for (int a = 0; a < 2; ++a)
#pragma unroll
        for (int b = 0; b < 2; ++b)
#pragma unroll
            for (int m = 0; m < 4; ++m)
#pragma unroll
                for (int n = 0; n < 2; ++n) acc[a][b][m][n] = (f32x4){0.f, 0.f, 0.f, 0.f};
    bf16x8 At[4][2], B0[2][2], B1[2][2];
    const char* cA = (const char*)g.A + (size_t)cur.pm * tstep; const char* cB = (const char*)g.Bt + (size_t)cur.pn * tstep;
    S.a_ready(cur);
    PG8_STAGE(PG8_SB(0, 0), cB, voffB); PG8_STAGE(PG8_SA(0, 0), cA, voffA); PG8_STAGE(PG8_SB(0, 1), cB + hstep, voffB); PG8_STAGE(PG8_SA(0, 1), cA + hstep, voffA);
    if (wr == 1) PG8_BAR;
    PG8_WAIT_V(4); PG8_BAR;
    PG8_STAGE(PG8_SB(1, 0), cB + kstep, voffB); PG8_STAGE(PG8_SA(1, 0), cA + kstep, voffA); PG8_STAGE(PG8_SB(1, 1), cB + hstep + kstep, voffB);
    PG8_WAIT_V(6); PG8_BAR;
    PG8_STAMP();
    for (;;) {
        const bool has_next = S.next(ui + 1, nxt);
        const char* nA = has_next ? (const char*)g.A + (size_t)nxt.pm * tstep : cA; const char* nB = has_next ? (const char*)g.Bt + (size_t)nxt.pn * tstep : cB;
        for (int t = 0; t < nt; t += 2) {
            const bool last = (t == nt - 2);
            if (t == midt) {
#pragma unroll
                for (int ai = 0; ai < 2; ++ai)
#pragma unroll
                    for (int m = 0; m < 4; ++m) { const float s_ = MK(ui, ai * HALF + wr * 64 + m * 16 + fr);
#pragma unroll
                        for (int bj = 0; bj < 2; ++bj)
#pragma unroll
                            for (int n = 0; n < 2; ++n) acc[ai][bj][m][n] *= s_;
                        __builtin_amdgcn_sched_barrier(0); }
            }
            const char* a1 = cA + (size_t)(t + 1) * kstep;
            const char* a2 = last ? nA : cA + (size_t)(t + 2) * kstep; const char* b2 = last ? nB : cB + (size_t)(t + 2) * kstep;
            const char* a3 = a2 + kstep; const char* b3 = b2 + kstep;
            if (last && has_next) S.a_ready(nxt);
            PG8_LDB(B0, 0, 0); PG8_SCHED; PG8_LDA(At, 0, 0); PG8_STAGE(PG8_SA(1, 1), a1 + hstep, voffA);
            PG8_WAIT_L(8); PG8_BAR; PG8_WAIT_L(0); PG8_MMA(0, 0, At, B0); PG8_BAR; PG8_SCHED;
            PG8_LDB(B1, 0, 1); PG8_STAGE(PG8_SB(0, 0), b2, voffB);
            PG8_BAR; PG8_WAIT_L(0); PG8_MMA(0, 1, At, B1); PG8_BAR;
            PG8_LDA(At, 0, 1); PG8_STAGE(PG8_SA(0, 0), a2, voffA);
            PG8_BAR; PG8_WAIT_L(0); PG8_MMA(1, 0, At, B0); PG8_BAR; PG8_SCHED;
            PG8_STAGE(PG8_SB(0, 1), b2 + hstep, voffB);
            PG8_WAIT_V(6); PG8_BAR; PG8_MMA(1, 1, At, B1); PG8_BAR;
            PG8_LDB(B0, 1, 0); PG8_SCHED; PG8_LDA(At, 1, 0); PG8_STAGE(PG8_SA(0, 1), a2 + hstep, voffA);
            PG8_WAIT_L(8); PG8_BAR; PG8_WAIT_L(0); PG8_MMA(0, 0, At, B0); PG8_BAR; PG8_SCHED;
            PG8_LDB(B1, 1, 1); PG8_STAGE(PG8_SB(1, 0), b3, voffB);
            PG8_BAR; PG8_WAIT_L(0); PG8_MMA(0, 1, At, B1); PG8_BAR;
            PG8_LDA(At, 1, 1); PG8_STAGE(PG8_SA(1, 0), a3, voffA);
            PG8_BAR; PG8_WAIT_L(0); PG8_MMA(1, 0, At, B0); PG8_BAR; PG8_SCHED;
            PG8_STAGE(PG8_SB(1, 1), b3 + hstep, voffB);
            PG8_WAIT_V(6); PG8_BAR; PG8_MMA(1, 1, At, B1); PG8_BAR;
        }
        PG8_STAMP();
        if constexpr (!Epi::AFTER_DRAIN) { E(acc, cur, wr, wc, fr, fq, ui); S.done(cur); }
        PG8_STAMP();
        if (!has_next) break;
#pragma unroll
        for (int a = 0; a < 2; ++a)
#pragma unroll
            for (int b = 0; b < 2; ++b)
#pragma unroll
                for (int m = 0; m < 4; ++m)
#pragma unroll
                    for (int n = 0; n < 2; ++n) acc[a][b][m][n] = (f32x4){0.f, 0.f, 0.f, 0.f};
        cur = nxt; cA = nA; cB = nB; ++ui;
    }
    PG8_WAIT_V(0);
    if (wr == 0) PG8_BAR;
    PG8_BAR;
    if constexpr (Epi::AFTER_DRAIN) { E.fused(acc, cur, wr, wc, fr, fq, lds, wid, lane); S.done(cur); }
    PG8_STAMP();
    if (STAMP && wid == 0) { stamps[lane] = lane < nts ? (((unsigned long long)(unsigned)ts_hi << 32) | (unsigned)ts_lo) : 0ull;
        if (lane == 62) stamps[62] = rt_entry; if (lane == 63) stamps[63] = (unsigned long long)wall_clock64(); }
#undef PG8_STAMP
#undef PG8_SA
#undef PG8_SB
#undef PG8_STAGE
#undef PG8_LDA
#undef PG8_LDB
#undef PG8_MMA
#undef PG8_WAIT_V
#undef PG8_WAIT_L
#undef PG8_BAR
#undef PG8_SCHED
}
}

struct NoMid { __device__ __forceinline__ float operator()(int, int) const { return 1.0f; } };
#define LAS __attribute__((address_space(3)))
struct EpiZ {
    static constexpr bool PERM = true, AFTER_DRAIN = false;
    bf16_t* Z;
    __device__ __forceinline__ void operator()(const f32x4 (&acc)[2][2][4][2], const pg8::Unit& u, int wr, int wc, int fr, int fq, int) const {
        const int row0 = u.pm * 256 + wr * 64 + fr, col0 = u.pn * 256 + wc * 32 + 8 * fq; const bool act = u.pn < 4;
#pragma unroll
        for (int ai = 0; ai < 2; ++ai)
#pragma unroll
            for (int m = 0; m < 4; ++m) { bf16_t* rowp = Z + (size_t)(row0 + ai * 128 + m * 16) * NZ + col0;
#pragma unroll
                for (int bj = 0; bj < 2; ++bj) { f32x4 a = acc[ai][bj][m][0], b = acc[ai][bj][m][1];
                    if (act) { a = (f32x4){gelu_f(a[0]), gelu_f(a[1]), gelu_f(a[2]), gelu_f(a[3])}; b = (f32x4){gelu_f(b[0]), gelu_f(b[1]), gelu_f(b[2]), gelu_f(b[3])}; }
                    *(uint4*)(rowp + bj * 128) = make_uint4(pk_bf16(a[0], a[1]), pk_bf16(a[2], a[3]), pk_bf16(b[0], b[1]), pk_bf16(b[2], b[3])); }
                __builtin_amdgcn_sched_barrier(0); }
    }
};
struct EpiQ {
    static constexpr bool PERM = true, AFTER_DRAIN = false;
    bf16_t* Q;
    __device__ __forceinline__ void operator()(const f32x4 (&acc)[2][2][4][2], const pg8::Unit& u, int wr, int wc, int fr, int fq, int) const {
        const int row0 = u.pm * 256 + wr * 64 + fr, col0 = u.pn * 256 + wc * 32 + 8 * fq;
#pragma unroll
        for (int ai = 0; ai < 2; ++ai)
#pragma unroll
            for (int m = 0; m < 4; ++m) { bf16_t* rowp = Q + (size_t)(row0 + ai * 128 + m * 16) * 2048 + col0;
#pragma unroll
                for (int bj = 0; bj < 2; ++bj) { const f32x4 a = acc[ai][bj][m][0], b = acc[ai][bj][m][1];
                    *(uint4*)(rowp + bj * 128) = make_uint4(pk_bf16(a[0], a[1]), pk_bf16(a[2], a[3]), pk_bf16(b[0], b[1]), pk_bf16(b[2], b[3])); } }
    }
};
__device__ __forceinline__ float rstd512(const float* s, int row) {
    const float4 a = *(const float4*)(s + (size_t)row * 8), b = *(const float4*)(s + (size_t)row * 8 + 4);
    return rsqrtf(((a.x + a.y) + (a.z + a.w) + (b.x + b.y) + (b.z + b.w)) * (1.0f / 512.0f) + EPS);
}
struct MidY { const LAS float* tab; __device__ __forceinline__ float operator()(int ui, int r) const { return tab[(2 * ui) * 256 + r]; } };
struct EpiX {
    static constexpr bool PERM = true, AFTER_DRAIN = false;
    const float* xin32; bf16_t* XR; const LAS float* tab; const float* gate;
    __device__ __forceinline__ void operator()(const f32x4 (&acc)[2][2][4][2], const pg8::Unit& u, int wr, int wc, int fr, int fq, int ui) const {
        const int r0 = wr * 64 + fr, row0 = u.pm * 256 + r0, col0 = u.pn * 256 + wc * 32 + 8 * fq;
        const float* gp = gate + (size_t)((u.pm * 256) / SEQ) * 6144 + col0;
#pragma unroll
        for (int ai = 0; ai < 2; ++ai)
#pragma unroll
            for (int m = 0; m < 4; ++m) { const int row = row0 + ai * 128 + m * 16; const float rb = tab[(2 * ui + 1) * 256 + r0 + ai * 128 + m * 16];
#pragma unroll
                for (int bj = 0; bj < 2; ++bj) { const int col = col0 + bj * 128; const f32x4 a = acc[ai][bj][m][0], b = acc[ai][bj][m][1];
                    float x[8];
                    if (xin32) { const float4 x0 = *(const float4*)(xin32 + (size_t)row * D + col), x1 = *(const float4*)(xin32 + (size_t)row * D + col + 4);
                        x[0] = x0.x; x[1] = x0.y; x[2] = x0.z; x[3] = x0.w; x[4] = x1.x; x[5] = x1.y; x[6] = x1.z; x[7] = x1.w; }
                    else { const uint4 w = *(const uint4*)(XR + (size_t)row * D + col);
                        x[0] = bf2f(w.x & 0xffffu); x[1] = bf2f(w.x >> 16); x[2] = bf2f(w.y & 0xffffu); x[3] = bf2f(w.y >> 16); x[4] = bf2f(w.z & 0xffffu); x[5] = bf2f(w.z >> 16); x[6] = bf2f(w.w & 0xffffu); x[7] = bf2f(w.w >> 16); }
                    const float4 g0 = *(const float4*)(gp + bj * 128), g1 = *(const float4*)(gp + bj * 128 + 4);
                    *(uint4*)(XR + (size_t)row * D + col) = make_uint4(pk_bf16(x[0] + g0.x * rb * a[0], x[1] + g0.y * rb * a[1]), pk_bf16(x[2] + g0.z * rb * a[2], x[3] + g0.w * rb * a[3]),
                                                                       pk_bf16(x[4] + g1.x * rb * b[0], x[5] + g1.y * rb * b[1]), pk_bf16(x[6] + g1.z * rb * b[2], x[7] + g1.w * rb * b[3]));
                    __builtin_amdgcn_sched_barrier(0); } }
    }
};
__device__ void phase_gemm1(const Params& p, int l, char* smem512) {
    pg8::Gemm g; g.A = (const pg8::bf16_t*)(p.ws + OFF_H); g.Bt = (const pg8::bf16_t*)(p.ws + OFF_W1T) + (size_t)l * 2048 * 1024; g.M = T; g.N = NZ; g.K = D;
    int G_ = (int)gridDim.x, c_ = (int)blockIdx.x; asm volatile("" : "+s"(G_), "+s"(c_));
    pg8::StaticOrder S; S.init(T, NZ, G_, c_);
    EpiZ E; E.Z = (bf16_t*)(p.ws + OFF_Z);
    pg8::gemm_phase<EpiZ, pg8::StaticOrder, NoMid>((PG8_LAS unsigned char*)smem512, g, S, E, NoMid(), -1, nullptr);
}
__device__ void phase_gemm2(const Params& p, int l, char* smem512) {
    pg8::Gemm g; g.A = (const pg8::bf16_t*)(p.ws + OFF_Y); g.Bt = (const pg8::bf16_t*)(p.ws + OFF_W2T) + (size_t)l * 1024 * 1024; g.M = T; g.N = D; g.K = D;
    int G_ = (int)gridDim.x, c_ = (int)blockIdx.x; asm volatile("" : "+s"(G_), "+s"(c_));
    pg8::StaticOrder S; S.init(T, D, G_, c_);
    LAS float* tab = (LAS float*)((LAS char*)smem512 + pg8::STAGE_BYTES);
    {
        const float* ssa = (const float*)(p.ws + OFF_SSQA); const float* ssb = (const float*)(p.ws + OFF_SSQB);
        pg8::Unit u;
        int t0_ = threadIdx.x; asm volatile("" : "+v"(t0_));
#pragma nounroll
        for (int i = 0; i < 8 && S.next(i, u); ++i)
            for (int r = t0_; r < 256; r += 512) { const float ra = rstd512(ssa, u.pm * 256 + r), rb = rstd512(ssb, u.pm * 256 + r); tab[(2 * i) * 256 + r] = ra / rb; tab[(2 * i + 1) * 256 + r] = rb; }
        __syncthreads();
    }
    MidY MK; MK.tab = tab;
    EpiX E; E.xin32 = (l == 0) ? p.x : nullptr; E.XR = (bf16_t*)(p.ws + OFF_XR); E.tab = tab; E.gate = (const float*)(p.ws + OFF_MOD) + (size_t)l * NB * 6144 + 2 * D;
    pg8::gemm_phase<EpiX, pg8::StaticOrder, MidY>((PG8_LAS unsigned char*)smem512, g, S, E, MK, 8, nullptr);
}
__device__ void phase_gemm3(const Params& p, int l, char* smem512) {
    pg8::Gemm g; g.A = (const pg8::bf16_t*)(p.ws + OFF_H); g.Bt = (const pg8::bf16_t*)(p.ws + OFF_WQT) + (size_t)l * 2048 * 1024; g.M = T; g.N = 2048; g.K = D;
    int G_ = (int)gridDim.x, c_ = (int)blockIdx.x; asm volatile("" : "+s"(G_), "+s"(c_));
    pg8::StaticOrder S; S.init(T, 2048, G_, c_);
    EpiQ E; E.Q = (bf16_t*)(p.ws + OFF_Z);
    pg8::gemm_phase<EpiQ, pg8::StaticOrder, NoMid>((PG8_LAS unsigned char*)smem512, g, S, E, NoMid(), -1, nullptr);
}

constexpr int TP = 136;
__device__ __forceinline__ void stage_transposed(const bf16_t* __restrict__ base, size_t row_stride, bf16_t* dT) {
    const int tid = otid(), r = tid >> 2, part = tid & 3, ri = part >> 1, c0 = (part & 1) * 32;
    const uint4* src = (const uint4*)(base + (size_t)r * row_stride + ri * 64 + c0);
    uint4 v[4];
#pragma unroll
    for (int i = 0; i < 4; ++i) v[i] = src[i];
#pragma unroll
    for (int i = 0; i < 4; ++i) {
        const unsigned w[4] = {v[i].x, v[i].y, v[i].z, v[i].w};
#pragma unroll
        for (int j = 0; j < 4; ++j) {
            dT[(c0 + i * 8 + j * 2) * TP + ri * 64 + r] = (bf16_t)(w[j] & 0xffffu);
            dT[(c0 + i * 8 + j * 2 + 1) * TP + ri * 64 + r] = (bf16_t)(w[j] >> 16);
        }
    }
}

__device__ void gmlp_item(const Params& p, int l, int item, char* smem) {
    const int tid = otid(), lane = tid & 63, wid = tid >> 6, fr = lane & 15, fq = lane >> 4;
    const int h = item & 7, c = (item >> 3) & 31, b = item >> 8;
    const int tok0 = b * SEQ + c * 128;
    bf16_t* vnT = (bf16_t*)smem;
    const bf16_t* Z = (const bf16_t*)(p.ws + OFF_Z);
    {
        const int q = tid >> 1, half = tid & 1, d0 = half * 32;
        const uint4* src = (const uint4*)(Z + (size_t)(tok0 + q) * NZ + 512 + h * 64 + d0);
        float f[32];
#pragma unroll
        for (int i = 0; i < 4; ++i) { const uint4 v = src[i]; const unsigned w[4] = {v.x, v.y, v.z, v.w};
#pragma unroll
            for (int j = 0; j < 4; ++j) { f[i * 8 + j * 2] = bf2f(w[j] & 0xffffu); f[i * 8 + j * 2 + 1] = bf2f(w[j] >> 16); } }
        float s = 0.f;
#pragma unroll
        for (int i = 0; i < 32; ++i) s += f[i];
        s += __shfl_xor(s, 1);
        const float mean = s * (1.0f / 64.0f);
        float qv = 0.f;
#pragma unroll
        for (int i = 0; i < 32; ++i) { f[i] -= mean; qv += f[i] * f[i]; }
        qv += __shfl_xor(qv, 1);
        const float rstd = rsqrtf(qv * (1.0f / 64.0f) + EPS);
#pragma unroll
        for (int i = 0; i < 32; ++i) vnT[(d0 + i) * TP + q] = f2bf(f[i] * rstd);
    }
    __syncthreads();
    const bf16_t* Wsb = (const bf16_t*)(p.ws + OFF_WSB) + ((size_t)l * 8 + h) * 128 * 128;
    f32x4 acc[2][4];
#pragma unroll
    for (int i = 0; i < 2; ++i)
#pragma unroll
        for (int j = 0; j < 4; ++j) acc[i][j] = (f32x4){0.f, 0.f, 0.f, 0.f};
    const int p0 = wid * 32;
#pragma unroll
    for (int ks = 0; ks < 4; ++ks) {
        bf16x8 af[2], bfr[4];
#pragma unroll
        for (int i = 0; i < 2; ++i) af[i] = *(const bf16x8*)(Wsb + (size_t)(p0 + i * 16 + fr) * 128 + ks * 32 + fq * 8);
#pragma unroll
        for (int j = 0; j < 4; ++j) bfr[j] = *(const bf16x8*)(vnT + (j * 16 + fr) * TP + ks * 32 + fq * 8);
#pragma unroll
        for (int i = 0; i < 2; ++i)
#pragma unroll
            for (int j = 0; j < 4; ++j) acc[i][j] = MFMA16(bfr[j], af[i], acc[i][j]);
    }
    bf16_t* Y = (bf16_t*)(p.ws + OFF_Y);
    float* ssa = (float*)(p.ws + OFF_SSQA);
#pragma unroll
    for (int i = 0; i < 2; ++i) {
        const int pp = p0 + i * 16 + fr, tok = tok0 + pp;
        const float bsv = p.gmlp_bs[((size_t)l * 8 + h) * 128 + pp];
        float ss = 0.f;
#pragma unroll
        for (int j = 0; j < 4; ++j) {
            const int d = j * 16 + fq * 4;
            const uint2 uu = *(const uint2*)(Z + (size_t)tok * NZ + h * 64 + d);
            const float y0 = bf2f(uu.x & 0xffffu) * (acc[i][j][0] + bsv), y1 = bf2f(uu.x >> 16) * (acc[i][j][1] + bsv);
            const float y2 = bf2f(uu.y & 0xffffu) * (acc[i][j][2] + bsv), y3 = bf2f(uu.y >> 16) * (acc[i][j][3] + bsv);
            ss += y0 * y0 + y1 * y1 + y2 * y2 + y3 * y3;
            *(uint2*)(Y + (size_t)tok * D + h * 64 + d) = make_uint2(pk_bf16(y0, y1), pk_bf16(y2, y3));
        }
        ss += __shfl_xor(ss, 16); ss += __shfl_xor(ss, 32);
        if (fq == 0) ssa[(size_t)tok * 8 + h] = ss;
    }
    __syncthreads();
}

__device__ void ffta_item(const Params& p, int item, char* smem) {
    const int tid = otid(), lane = tid & 63, wid = tid >> 6, fr = lane & 15, fq = lane >> 4;
    const int bp = item & 63, g = (item >> 6) & 7, b = item >> 9;
    bf16_t* dT = (bf16_t*)smem;
    const bf16_t* Z = (const bf16_t*)(p.ws + OFF_Z);
    stage_transposed(Z + (size_t)(b * SEQ + bp) * NZ + 1024 + g * 128, (size_t)64 * NZ, dT);
    __syncthreads();
    const bf16_t* DA = (const bf16_t*)(p.ws + OFF_DA);
    f32x4 acc[2][4];
#pragma unroll
    for (int i = 0; i < 2; ++i)
#pragma unroll
        for (int j = 0; j < 4; ++j) acc[i][j] = (f32x4){0.f, 0.f, 0.f, 0.f};
#pragma unroll
    for (int ks = 0; ks < 4; ++ks) {
        bf16x8 af[2], bfr[4];
#pragma unroll
        for (int i = 0; i < 2; ++i) af[i] = *(const bf16x8*)(DA + (size_t)(i * 64 + wid * 16 + fr) * 128 + ks * 32 + fq * 8);
#pragma unroll
        for (int j = 0; j < 4; ++j) bfr[j] = *(const bf16x8*)(dT + (j * 16 + fr) * TP + ks * 32 + fq * 8);
#pragma unroll
        for (int i = 0; i < 2; ++i)
#pragma unroll
            for (int j = 0; j < 4; ++j) acc[i][j] = MFMA16(bfr[j], af[i], acc[i][j]);
    }
    const int k1 = wid * 16 + fr;
    const float2 cs = ((const float2*)(p.ws + OFF_TW))[bp * 64 + k1];
    bf16_t* Yb = (bf16_t*)(p.ws + OFF_H) + ((((size_t)(b * 8 + g) * 64 + k1) * 64 + bp) * 128);
#pragma unroll
    for (int j = 0; j < 4; ++j) {
        const int ch = j * 16 + fq * 4;
        float yr[4], yi[4];
#pragma unroll
        for (int e = 0; e < 4; ++e) { const float r = acc[0][j][e], im = acc[1][j][e]; yr[e] = r * cs.x + im * cs.y; yi[e] = im * cs.x - r * cs.y; }
        *(uint2*)(Yb + ch) = make_uint2(pk_bf16(yr[0], yr[1]), pk_bf16(yr[2], yr[3]));
        *(uint2*)(Yb + 64 + ch) = make_uint2(pk_bf16(yi[0], yi[1]), pk_bf16(yi[2], yi[3]));
    }
    __syncthreads();
}

__device__ void phase_mix(const Params& p, int l, char* smem, int bid, int nb) {
    for (int rd_ = 0; rd_ < ((2048 + 4096) + nb - 1) / nb; ++rd_) { const int item = min(bid + rd_ * nb, (2048 + 4096) - 1);
        if (item < 2048) gmlp_item(p, l, item, smem); else ffta_item(p, item - 2048, smem);
    }
}

__device__ void phase_fftb(const Params& p, int l, char* smem, int bid, int nb) {
    const int tid = otid(), lane = tid & 63, wid = tid >> 6, fr = lane & 15, fq = lane >> 4;
    bf16_t* dT = (bf16_t*)smem;
    const bf16_t* DB = (const bf16_t*)(p.ws + OFF_DB);
    bf16_t* Y = (bf16_t*)(p.ws + OFF_Y);
    float* ssb = (float*)(p.ws + OFF_SSQB);
    for (int rd_ = 0; rd_ < (4096 + nb - 1) / nb; ++rd_) { const int item = min(bid + rd_ * nb, 4096 - 1);
        const int k1 = item & 63, g = (item >> 6) & 7, b = item >> 9;
        stage_transposed((const bf16_t*)(p.ws + OFF_H) + (((size_t)(b * 8 + g) * 64 + k1) * 64) * 128, 128, dT);
        __syncthreads();
        f32x4 acc[4];
#pragma unroll
        for (int j = 0; j < 4; ++j) acc[j] = (f32x4){0.f, 0.f, 0.f, 0.f};
#pragma unroll
        for (int ks = 0; ks < 4; ++ks) {
            const bf16x8 af = *(const bf16x8*)(DB + (size_t)(wid * 16 + fr) * 128 + ks * 32 + fq * 8);
#pragma unroll
            for (int j = 0; j < 4; ++j) { const bf16x8 bfr = *(const bf16x8*)(dT + (j * 16 + fr) * TP + ks * 32 + fq * 8); acc[j] = MFMA16(bfr, af, acc[j]); }
        }
        const int k2 = wid * 16 + fr, tok = b * SEQ + k1 + 64 * k2;
        float ss = 0.f;
#pragma unroll
        for (int j = 0; j < 4; ++j) {
            const int ch = j * 16 + fq * 4;
            const float4 fb = *(const float4*)(p.fnet_b + ((size_t)l * 8 + g) * 64 + ch);
            const float y0 = acc[j][0] * (1.0f / 512.0f) + fb.x, y1 = acc[j][1] * (1.0f / 512.0f) + fb.y, y2 = acc[j][2] * (1.0f / 512.0f) + fb.z, y3 = acc[j][3] * (1.0f / 512.0f) + fb.w;
            ss += y0 * y0 + y1 * y1 + y2 * y2 + y3 * y3;
            *(uint2*)(Y + (size_t)tok * D + 512 + g * 64 + ch) = make_uint2(pk_bf16(y0, y1), pk_bf16(y2, y3));
        }
        ss += __shfl_xor(ss, 16); ss += __shfl_xor(ss, 32);
        if (fq == 0) ssb[(size_t)tok * 8 + g] = ss;
        __syncthreads();
    }
}

#define INS16(a, v) do { a[15] = med3i(a[14], a[15], v); a[14] = med3i(a[13], a[14], v); a[13] = med3i(a[12], a[13], v); a[12] = med3i(a[11], a[12], v); \
    a[11] = med3i(a[10], a[11], v); a[10] = med3i(a[9], a[10], v); a[9] = med3i(a[8], a[9], v); a[8] = med3i(a[7], a[8], v); a[7] = med3i(a[6], a[7], v); \
    a[6] = med3i(a[5], a[6], v); a[5] = med3i(a[4], a[5], v); a[4] = med3i(a[3], a[4], v); a[3] = med3i(a[2], a[3], v); a[2] = med3i(a[1], a[2], v); \
    a[1] = med3i(a[0], a[1], v); a[0] = max(a[0], v); } while (0)

template <int I, int J> struct CandLoop {
    static __device__ __forceinline__ void run(int (&a)[16], const float (&f1)[16], const float (&f2)[16]) {
        if constexpr ((I + 1) * (J + 1) <= 16) { const int key = (f2key(f1[I] + f2[J]) & ~255) | (I * 16 + J); INS16(a, key); }
        if constexpr (J + 1 < 16) CandLoop<I, J + 1>::run(a, f1, f2);
        else if constexpr (I + 1 < 16) CandLoop<I + 1, 0>::run(a, f1, f2);
    }
};

typedef _Float16 f16x2_t __attribute__((ext_vector_type(2)));
__device__ __forceinline__ unsigned pk_f16(float lo, float hi) { const f16x2_t v = {(_Float16)lo, (_Float16)hi}; return __builtin_bit_cast(unsigned, v); }
__device__ __forceinline__ int h2key(unsigned bits16) { const int b = (int)(short)bits16; return b ^ ((b >> 15) & 0x7fff); }
__device__ __forceinline__ float key2h(int k) { const int b = k ^ ((k >> 15) & 0x7fff); return (float)__builtin_bit_cast(_Float16, (unsigned short)(b & 0xffff)); }

__device__ void phase_topk(const Params& p, int l, char* smem, int bid, int nb) {
    const int tid = otid(), lane = tid & 63, wid = tid >> 6, fr = lane & 15, fq = lane >> 4;
    unsigned* S32 = (unsigned*)smem;
    int* TT = (int*)smem;
    const bf16_t* Q = (const bf16_t*)(p.ws + OFF_Z);
    int* eidx = (int*)(p.ws + OFF_Y); float* gw = (float*)(p.ws + OFF_Y + (size_t)T * 128 * 4);
    const int hh = wid >> 1, half = wid & 1;
    for (int rd_ = 0; rd_ < (((T / 64) * 4) + nb - 1) / nb; ++rd_) { const int item = min(bid + rd_ * nb, ((T / 64) * 4) - 1);
        const int hp = item & 3, tok0 = (item >> 2) * 64, h = hp * 2 + hh;
        const bf16_t* Kh = (const bf16_t*)(p.ws + OFF_K12) + (((size_t)l * 8 + h) * 256 + half * 128) * 128;
        const bf16_t* Qh = Q + (size_t)tok0 * 2048 + h * 256 + half * 128;
        {
            f32x4 acc[4][8];
#pragma unroll
            for (int i = 0; i < 4; ++i)
#pragma unroll
                for (int j = 0; j < 8; ++j) acc[i][j] = (f32x4){0.f, 0.f, 0.f, 0.f};
#pragma unroll
            for (int ks = 0; ks < 4; ++ks) {
                bf16x8 af[4];
#pragma unroll
                for (int i = 0; i < 4; ++i) af[i] = *(const bf16x8*)(Qh + (size_t)(i * 16 + fr) * 2048 + ks * 32 + fq * 8);
#pragma unroll
                for (int jh = 0; jh < 2; ++jh) {
                    bf16x8 bfr[4];
#pragma unroll
                    for (int j = 0; j < 4; ++j) bfr[j] = *(const bf16x8*)(Kh + (size_t)((jh * 4 + j) * 16 + fr) * 128 + ks * 32 + fq * 8);
#pragma unroll
                    for (int i = 0; i < 4; ++i)
#pragma unroll
                        for (int j = 0; j < 4; ++j) acc[i][jh * 4 + j] = MFMA16(bfr[j], af[i], acc[i][jh * 4 + j]);
                    __builtin_amdgcn_sched_barrier(0);
                }
            }
#pragma unroll
            for (int i = 0; i < 4; ++i)
#pragma unroll
                for (int j = 0; j < 8; ++j) {
                    unsigned* d = S32 + (i * 16 + fr) * 257 + hh * 128 + half * 64 + j * 8 + fq * 2;
                    d[0] = pk_f16(acc[i][j][0], acc[i][j][1]); d[1] = pk_f16(acc[i][j][2], acc[i][j][3]);
                }
        }
        vsync(smem);
        int a[16];
#pragma unroll
        for (int i = 0; i < 16; ++i) a[i] = (int)0x80000000;
        {
            const unsigned* sr = S32 + lane * 257 + hh * 128 + half * 64;
#pragma unroll 2
            for (int i = 0; i < 64; ++i) {
                const unsigned w = sr[i];
                const int k0 = (h2key(w & 0xffffu) << 7) | (2 * i), k1 = (h2key(w >> 16) << 7) | (2 * i + 1);
                INS16(a, k0); INS16(a, k1);
            }
        }
        vsync(smem);
#pragma unroll
        for (int i = 0; i < 16; ++i) TT[((lane * 2 + hh) * 2 + half) * 16 + i] = a[i];
        vsync(smem);
        if (tid < 128) {
            const int tk = tid & 63, h2 = tid >> 6, hd = hp * 2 + h2;
            const int* t1 = TT + ((tk * 2 + h2) * 2) * 16; const int* t2 = t1 + 16;
            float f1[16], f2[16];
#pragma unroll
            for (int i = 0; i < 16; ++i) { f1[i] = key2h(t1[i] >> 7); f2[i] = key2h(t2[i] >> 7); }
            int c[16];
#pragma unroll
            for (int i = 0; i < 16; ++i) c[i] = (int)0x80000000;
            CandLoop<0, 0>::run(c, f1, f2);
            float sc[16], e[16], sum = 0.f; int ex[16];
#pragma unroll
            for (int i = 0; i < 16; ++i) {
                sc[i] = key2f(c[i] & ~255);
                const int code = c[i] & 255;
                ex[i] = (t1[code >> 4] & 127) * 128 + (t2[code & 15] & 127);
            }
#pragma unroll
            for (int i = 0; i < 16; ++i) { e[i] = __expf(sc[i] - sc[0]); sum += e[i]; }
            const float inv = 1.0f / sum;
            int4* ep = (int4*)(eidx + (size_t)(tok0 + tk) * 128 + hd * 16); float4* gp = (float4*)(gw + (size_t)(tok0 + tk) * 128 + hd * 16);
#pragma unroll
            for (int i = 0; i < 4; ++i) { ep[i] = make_int4(ex[4 * i], ex[4 * i + 1], ex[4 * i + 2], ex[4 * i + 3]); gp[i] = make_float4(e[4 * i] * inv, e[4 * i + 1] * inv, e[4 * i + 2] * inv, e[4 * i + 3] * inv); }
        }
        vsync(smem);
    }
}

__device__ __forceinline__ float dot16_fp8(const float (&h)[16], const int4& u) {
    const int w[4] = {u.x, u.y, u.z, u.w};
    f32x2_t a = {0.f, 0.f};
#pragma unroll
    for (int i = 0; i < 4; ++i) {
        const f32x2_t lo = __builtin_amdgcn_cvt_pk_f32_fp8(w[i], false), hi = __builtin_amdgcn_cvt_pk_f32_fp8(w[i], true);
        const f32x2_t h0 = {h[4 * i], h[4 * i + 1]}, h1 = {h[4 * i + 2], h[4 * i + 3]};
        a = __builtin_elementwise_fma(lo, h0, a); a = __builtin_elementwise_fma(hi, h1, a);
    }
    return a.x + a.y;
}
__device__ __forceinline__ void axpy16_fp8(float (&o)[16], float c, const int4& v) {
    const int w[4] = {v.x, v.y, v.z, v.w};
#pragma unroll
    for (int i = 0; i < 4; ++i) {
        const f32x2_t lo = __builtin_amdgcn_cvt_pk_f32_fp8(w[i], false), hi = __builtin_amdgcn_cvt_pk_f32_fp8(w[i], true);
        o[4 * i] += c * lo.x; o[4 * i + 1] += c * lo.y; o[4 * i + 2] += c * hi.x; o[4 * i + 3] += c * hi.y;
    }
}

typedef _Float16 h2_t __attribute__((ext_vector_type(2)));
__device__ __forceinline__ float dot32_fp4(const h2_t (&h)[16], const int4& u) {
    const unsigned w[4] = {(unsigned)u.x, (unsigned)u.y, (unsigned)u.z, (unsigned)u.w};
    float a0 = 0.f, a1 = 0.f;
#pragma unroll
    for (int i = 0; i < 4; ++i) {
        a0 = __builtin_amdgcn_fdot2(__builtin_bit_cast(h2_t, __builtin_amdgcn_cvt_scalef32_pk_f16_fp4(w[i], 1.0f, 0)), h[4 * i], a0, false);
        a1 = __builtin_amdgcn_fdot2(__builtin_bit_cast(h2_t, __builtin_amdgcn_cvt_scalef32_pk_f16_fp4(w[i], 1.0f, 1)), h[4 * i + 1], a1, false);
        a0 = __builtin_amdgcn_fdot2(__builtin_bit_cast(h2_t, __builtin_amdgcn_cvt_scalef32_pk_f16_fp4(w[i], 1.0f, 2)), h[4 * i + 2], a0, false);
        a1 = __builtin_amdgcn_fdot2(__builtin_bit_cast(h2_t, __builtin_amdgcn_cvt_scalef32_pk_f16_fp4(w[i], 1.0f, 3)), h[4 * i + 3], a1, false);
    }
    return a0 + a1;
}
typedef int v8i_t __attribute__((ext_vector_type(8)));
typedef int i32x4_t __attribute__((ext_vector_type(4)));
typedef int i32x2_t __attribute__((ext_vector_type(2)));
constexpr float PU_XS = 4.0f;
constexpr int PU_WAVE_LDS = 16384 + 2048;
__device__ __forceinline__ void glds16(const void* g, unsigned lds_addr) {
    unsigned sv_;
    asm volatile("s_mov_b32 %0, m0\n\ts_mov_b32 m0, %2\n\ts_nop 0\n\tglobal_load_lds_dwordx4 %1, off\n\ts_mov_b32 m0, %0" : "=&s"(sv_) : "v"(g), "s"(lds_addr) : "memory");
}
__device__ void phase_pu(const Params& p, int l, int slice, int grank_base, int gsz, char* smem512) {
    int tid_ = threadIdx.x; asm volatile("" : "+v"(tid_));
    asm volatile("" : "+s"(slice), "+s"(grank_base), "+s"(gsz));
    const int lane = tid_ & 63, wid = __builtin_amdgcn_readfirstlane(tid_ >> 6), n16 = lane & 15, q4 = lane >> 4;
    const char* U4 = p.ws + OFF_UB + ((size_t)(l * 4 + slice) * NE) * 128 + 16 * ((lane & 7) ^ (lane >> 3));
    const char* msrc = lane < 32 ? (p.ws + OFF_Y + 16 * lane) : (p.ws + OFF_H + (size_t)slice * 512 + 16 * (lane - 32));
    const size_t mstep = lane < 32 ? 512 : 2048;
    float* part = (float*)(p.ws + OFF_Z) + (size_t)slice * T * 128 + 16 * q4 + n16;
    const int stride = gsz * 4;
    LAS char* wl = (LAS char*)smem512 + wid * PU_WAVE_LDS;
    const unsigned wla = (unsigned)(size_t)wl;
    const int boff = n16 * 128 + 16 * (q4 ^ (n16 & 7));
    const int ioff = 4 * (lane >> 3);
#define PU_META(tok_, mb_) glds16(msrc + (size_t)(tok_) * mstep, wla + 16384u + (unsigned)(mb_))
#define PU_IDS(id_, mb_, h_) do { _Pragma("unroll") for (int i_ = 0; i_ < 8; ++i_) id_[i_] = *(const LAS int*)(wl + 16384 + (mb_) + 256 * (h_) + ioff + 32 * i_); } while (0)
#define PU_DMA(id_, h_) do { _Pragma("unroll") for (int i_ = 0; i_ < 8; ++i_) glds16(U4 + (size_t)id_[i_] * 128, wla + (unsigned)((h_) * 8192 + i_ * 1024)); } while (0)
#define PU_HALF(h_) do { i32x4_t b0_[4], b1_[4]; \
        _Pragma("unroll") for (int m_ = 0; m_ < 4; ++m_) { b0_[m_] = *(const LAS i32x4_t*)(wl + (h_) * 8192 + m_ * 2048 + boff); b1_[m_] = *(const LAS i32x4_t*)(wl + (h_) * 8192 + m_ * 2048 + (boff ^ 64)); } \
        _Pragma("unroll") for (int m_ = 0; m_ < 4; ++m_) { \
        const v8i_t B0 = {b0_[m_][0], b0_[m_][1], b0_[m_][2], b0_[m_][3], 0, 0, 0, 0}, B1 = {b1_[m_][0], b1_[m_][1], b1_[m_][2], b1_[m_][3], 0, 0, 0, 0}; \
        acc[(h_) * 4 + m_] = __builtin_amdgcn_mfma_scale_f32_16x16x128_f8f6f4(A0, B0, acc[(h_) * 4 + m_], 0, 4, 0, 0, 0, 0); \
        acc[(h_) * 4 + m_] = __builtin_amdgcn_mfma_scale_f32_16x16x128_f8f6f4(A1, B1, acc[(h_) * 4 + m_], 0, 4, 0, 0, 0, 0); } } while (0)
    const int tok0 = grank_base * 4 + wid;
    if (tok0 >= T) return;
    const int nit = (T - tok0 + stride - 1) / stride;
    int tok = tok0, tok1 = min(tok0 + stride, T - 1);
    int idA[8], idB[8];
    PU_META(tok, 0); PU_META(tok1, 1024);
    asm volatile("s_waitcnt vmcnt(0)" ::: "memory");
    PU_IDS(idA, 0, 0); PU_IDS(idB, 0, 1);
    PU_DMA(idA, 0);
#pragma nounroll
    for (int it = 0; it < nit; ++it) {
        const int mbc = (it & 1) * 1024, mbn = 1024 - mbc;
        __builtin_amdgcn_sched_barrier(0);
        PU_DMA(idB, 1);
        asm volatile("s_waitcnt vmcnt(8)" ::: "memory");
        __builtin_amdgcn_sched_barrier(0);
        { const i32x2_t xr = *(const LAS i32x2_t*)(wl + 16384 + mbc + 512 + 8 * lane);
          const float f0 = fminf(fmaxf(bf2f((unsigned)xr[0] & 0xffffu) * PU_XS, -448.f), 448.f), f1 = fminf(fmaxf(bf2f((unsigned)xr[0] >> 16) * PU_XS, -448.f), 448.f),
                      f2 = fminf(fmaxf(bf2f((unsigned)xr[1] & 0xffffu) * PU_XS, -448.f), 448.f), f3 = fminf(fmaxf(bf2f((unsigned)xr[1] >> 16) * PU_XS, -448.f), 448.f);
          int w = __builtin_amdgcn_cvt_pk_fp8_f32(f0, f1, 0, false); w = __builtin_amdgcn_cvt_pk_fp8_f32(f2, f3, w, true);
          *(LAS int*)(wl + 16384 + mbc + 512 + 4 * lane) = w; }
        PU_IDS(idA, mbn, 0);
        asm volatile("s_waitcnt lgkmcnt(0)" ::: "memory");
        const LAS char* xb = wl + 16384 + mbc + 512 + 16 * q4;
        const i32x4_t a00 = *(const LAS i32x4_t*)(xb), a01 = *(const LAS i32x4_t*)(xb + 64), a10 = *(const LAS i32x4_t*)(xb + 128), a11 = *(const LAS i32x4_t*)(xb + 192);
        const v8i_t A0 = {a00[0], a00[1], a00[2], a00[3], a01[0], a01[1], a01[2], a01[3]}, A1 = {a10[0], a10[1], a10[2], a10[3], a11[0], a11[1], a11[2], a11[3]};
        f32x4 acc[8];
#pragma unroll
        for (int m = 0; m < 8; ++m) acc[m] = (f32x4){0.f, 0.f, 0.f, 0.f};
        PU_HALF(0);
        asm volatile("s_waitcnt lgkmcnt(0)" ::: "memory");
        __builtin_amdgcn_sched_barrier(0);
        const int tok2 = min(tok1 + stride, T - 1);
        PU_DMA(idA, 0);
        PU_META(tok2, mbc);
        asm volatile("s_waitcnt vmcnt(9)" ::: "memory");
        __builtin_amdgcn_sched_barrier(0);
        PU_IDS(idB, mbn, 1);
        PU_HALF(1);
        __builtin_amdgcn_sched_barrier(0);
        float s0 = acc[0][0], s1 = acc[4][0];
        s0 = q4 == 1 ? acc[1][0] : s0; s1 = q4 == 1 ? acc[5][0] : s1;
        s0 = q4 == 2 ? acc[2][0] : s0; s1 = q4 == 2 ? acc[6][0] : s1;
        s0 = q4 == 3 ? acc[3][0] : s0; s1 = q4 == 3 ? acc[7][0] : s1;
        float* pr = part + (size_t)tok * 128;
        pr[0] = s0 * (1.0f / PU_XS); pr[64] = s1 * (1.0f / PU_XS);
        tok = tok1; tok1 = tok2;
    }
    asm volatile("s_waitcnt vmcnt(0)" ::: "memory");
#undef PU_META
#undef PU_IDS
#undef PU_DMA
#undef PU_HALF
}
__device__ void phase_pc(const Params& p, int l, int bid, int nb) {
    const int tid_ = otid(); const int lane = tid_ & 63, wid = tid_ >> 6;
    const int* eidx = (const int*)(p.ws + OFF_Y); const float* gw = (const float*)(p.ws + OFF_Y + (size_t)T * 128 * 4);
    unsigned char* crec = (unsigned char*)(p.ws + OFF_Y + (size_t)T * 128 * 8);
    const float* part = (const float*)(p.ws + OFF_Z);
    const float* usc = (const float*)(p.ws + OFF_USC) + (size_t)l * NE; const float* vsc = (const float*)(p.ws + OFF_VSC) + (size_t)l * NE;
    constexpr int NU = 2;
    for (int tok0 = bid * 4 + wid; tok0 < T; tok0 += nb * 4 * NU) {
        int tk[NU]; bool ok[NU];
#pragma unroll
        for (int u = 0; u < NU; ++u) { ok[u] = tok0 + u * nb * 4 < T; tk[u] = ok[u] ? tok0 + u * nb * 4 : tok0; }
        int e[NU][2]; float g[NU][2], a[NU][2][4];
#pragma unroll
        for (int u = 0; u < NU; ++u)
#pragma unroll
            for (int hh = 0; hh < 2; ++hh) { const size_t j = (size_t)tk[u] * 128 + hh * 64 + lane; e[u][hh] = eidx[j]; g[u][hh] = gw[j];
#pragma unroll
                for (int sl = 0; sl < 4; ++sl) a[u][hh][sl] = part[(size_t)sl * T * 128 + j]; }
        float us[NU][2], vs[NU][2];
#pragma unroll
        for (int u = 0; u < NU; ++u)
#pragma unroll
            for (int hh = 0; hh < 2; ++hh) { us[u][hh] = usc[e[u][hh]]; vs[u][hh] = vsc[e[u][hh]]; }
#pragma unroll
        for (int u = 0; u < NU; ++u) {
            float c[2];
#pragma unroll
            for (int hh = 0; hh < 2; ++hh) c[hh] = g[u][hh] * gelu_f(((a[u][hh][0] + a[u][hh][1]) + (a[u][hh][2] + a[u][hh][3])) * us[u][hh]) * vs[u][hh];
            float m = fmaxf(fabsf(c[0]), fabsf(c[1]));
#pragma unroll
            for (int o = 32; o >= 1; o >>= 1) m = fmaxf(m, __shfl_xor(m, o));
            const float S = (m > 1e-30f) ? 256.0f / m : 1.0f;
            unsigned char* rec = crec + (size_t)tk[u] * 512;
#pragma unroll
            for (int hh = 0; hh < 2; ++hh) {
                const float cs = c[hh] * S;
                const int hi = __builtin_amdgcn_cvt_pk_fp8_f32(cs, 0.f, 0, false) & 0xff;
                const float r = (cs - __builtin_amdgcn_cvt_f32_fp8(hi, 0)) * 16.0f;
                const int lo = __builtin_amdgcn_cvt_pk_fp8_f32(r, 0.f, 0, false) & 0xff;
                if (ok[u]) { rec[hh * 64 + lane] = (unsigned char)hi; rec[128 + hh * 64 + lane] = (unsigned char)lo; }
            }
            if (lane == 0 && ok[u]) *(float*)(rec + 256) = 1.0f / S;
        }
    }
}
__device__ void phase_pv(const Params& p, int l, int slice, int grank_base, int gsz, char* smem512) {
    int tid_ = threadIdx.x; asm volatile("" : "+v"(tid_));
    asm volatile("" : "+s"(slice), "+s"(grank_base), "+s"(gsz));
    const int lane = tid_ & 63, wid = __builtin_amdgcn_readfirstlane(tid_ >> 6), n16 = lane & 15, q4 = lane >> 4;
    const char* V4e = p.ws + OFF_VB + ((size_t)(l * 4 + slice) * NE) * 128 + 16 * ((lane & 7) ^ (lane >> 4));
    const char* V4o = p.ws + OFF_VB + ((size_t)(l * 4 + slice) * NE) * 128 + 16 * ((lane & 7) ^ (lane >> 4) ^ 4);
    const char* msrc = lane < 32 ? (p.ws + OFF_Y + 16 * lane) : (p.ws + OFF_Y + (size_t)T * 128 * 8 + 16 * (lane - 32));
    bf16_t* Sout = (bf16_t*)(p.ws + OFF_Z) + slice * 256 + 4 * lane;
    const int stride = gsz * 4;
    LAS char* wl = (LAS char*)smem512 + wid * PU_WAVE_LDS;
    const unsigned wla = (unsigned)(size_t)wl;
    const int ioff = 4 * (lane >> 3);
    const int rowb = (q4 >> 1) * 8192 + (32 * (q4 & 1) + n16) * 128;
    int vad[8];
#pragma unroll
    for (int jj = 0; jj < 8; ++jj) vad[jj] = rowb + ((16 * jj) ^ (16 * (n16 >> 1)));
    const int aoff = 16384 + 512 + 128 * (n16 & 1) + 16 * q4;
#define PV_META(tok_, mb_) glds16(msrc + (size_t)(tok_) * 512, wla + 16384u + (unsigned)(mb_))
#define PV_IDS(id_, mb_) do { _Pragma("unroll") for (int i_ = 0; i_ < 16; ++i_) id_[i_] = *(const LAS int*)(wl + 16384 + (mb_) + ioff + 32 * i_); } while (0)
#define PV_DMA(id_) do { _Pragma("unroll") for (int i_ = 0; i_ < 16; ++i_) glds16(((i_ & 1) ? V4o : V4e) + (size_t)id_[i_] * 128, wla + (unsigned)(i_ * 1024)); } while (0)
    const int tok0 = grank_base * 4 + wid;
    if (tok0 >= T) return;
    const int nit = (T - tok0 + stride - 1) / stride;
    int tok = tok0, tok1 = min(tok0 + stride, T - 1);
    int idv[16];
    PV_META(tok, 0);
    asm volatile("s_waitcnt vmcnt(0)" ::: "memory");
    PV_IDS(idv, 0);
    asm volatile("s_waitcnt lgkmcnt(0)" ::: "memory");
    PV_DMA(idv);
    PV_META(tok1, 1024);
#pragma nounroll
    for (int it = 0; it < nit; ++it) {
        const int mbc = (it & 1) * 1024, mbn = 1024 - mbc;
        __builtin_amdgcn_sched_barrier(0);
        asm volatile("s_waitcnt vmcnt(1)" ::: "memory");
        __builtin_amdgcn_sched_barrier(0);
        const i32x4_t a0 = *(const LAS i32x4_t*)(wl + mbc + aoff), a1 = *(const LAS i32x4_t*)(wl + mbc + aoff + 64);
        const float invS = *(const LAS float*)(wl + 16384 + mbc + 512 + 256);
        const v8i_t A = {a0[0], a0[1], a0[2], a0[3], a1[0], a1[1], a1[2], a1[3]};
        i32x2_t bt[16][2];
#pragma unroll
        for (int j = 0; j < 16; ++j) {
            bt[j][0] = __builtin_amdgcn_ds_read_tr4_b64_v2i32((LAS i32x2_t*)(wl + vad[j >> 1] + 8 * (j & 1)));
            bt[j][1] = __builtin_amdgcn_ds_read_tr4_b64_v2i32((LAS i32x2_t*)(wl + vad[j >> 1] + 8 * (j & 1) + 2048));
        }
        asm volatile("s_waitcnt vmcnt(0)" ::: "memory");
        PV_IDS(idv, mbn);
        asm volatile("s_waitcnt lgkmcnt(0)" ::: "memory");
        __builtin_amdgcn_sched_barrier(0);
        PV_DMA(idv);
        __builtin_amdgcn_sched_barrier(0);
        f32x4 acc[16];
#pragma unroll
        for (int j = 0; j < 16; ++j) {
            const v8i_t B = {bt[j][0][0], bt[j][0][1], bt[j][1][0], bt[j][1][1], 0, 0, 0, 0};
            acc[j] = __builtin_amdgcn_mfma_scale_f32_16x16x128_f8f6f4(A, B, (f32x4){0.f, 0.f, 0.f, 0.f}, 0, 4, 0, 0, 0, 0);
        }
        float v0 = acc[0][0] + acc[0][1] * 0.0625f, v1 = acc[1][0] + acc[1][1] * 0.0625f, v2 = acc[2][0] + acc[2][1] * 0.0625f, v3 = acc[3][0] + acc[3][1] * 0.0625f;
#pragma unroll
        for (int qq = 1; qq < 4; ++qq) {
            v0 = q4 == qq ? acc[4 * qq][0] + acc[4 * qq][1] * 0.0625f : v0; v1 = q4 == qq ? acc[4 * qq + 1][0] + acc[4 * qq + 1][1] * 0.0625f : v1;
            v2 = q4 == qq ? acc[4 * qq + 2][0] + acc[4 * qq + 2][1] * 0.0625f : v2; v3 = q4 == qq ? acc[4 * qq + 3][0] + acc[4 * qq + 3][1] * 0.0625f : v3;
        }
        LAS float* tb = (LAS float*)(wl + 16384 + mbc);
        tb[64 * q4 + n16] = v0; tb[64 * q4 + 16 + n16] = v1; tb[64 * q4 + 32 + n16] = v2; tb[64 * q4 + 48 + n16] = v3;
        asm volatile("s_waitcnt lgkmcnt(0)" ::: "memory");
        const f32x4 o = *(const LAS f32x4*)(tb + 4 * lane);
        *(uint2*)(Sout + (size_t)tok * D) = make_uint2(pk_bf16(o[0] * invS, o[1] * invS), pk_bf16(o[2] * invS, o[3] * invS));
        asm volatile("s_waitcnt lgkmcnt(0)" ::: "memory");
        __builtin_amdgcn_sched_barrier(0);
        const int tok2 = min(tok1 + stride, T - 1);
        PV_META(tok2, mbc);
        tok = tok1; tok1 = tok2;
    }
    asm volatile("s_waitcnt vmcnt(0)" ::: "memory");
#undef PV_META
#undef PV_IDS
#undef PV_DMA
}
__device__ void phase_final_norm(const Params& p, int bid, int nb) {
    const int tid_ = otid(); const int lane = tid_ & 63, wid = tid_ >> 6;
    const bf16_t* sadd = (const bf16_t*)(p.ws + OFF_Z); const float* g2l = (const float*)(p.ws + OFF_MOD) + (size_t)(NL - 1) * NB * 6144 + 5 * D;
    constexpr int NU = 2;
    for (int tok0 = bid * 4 + wid; tok0 < T; tok0 += nb * 4 * NU) {
        int tk[NU]; bool ok[NU];
#pragma unroll
        for (int u = 0; u < NU; ++u) { ok[u] = tok0 + u * nb * 4 < T; tk[u] = ok[u] ? tok0 + u * nb * 4 : tok0; }
        uint2 xw[NU][4], sw[NU][4]; float4 g2[NU][4];
#pragma unroll
        for (int u = 0; u < NU; ++u)
#pragma unroll
            for (int i = 0; i < 4; ++i) { const size_t o = (size_t)tk[u] * D + i * 256 + lane * 4;
                xw[u][i] = *(const uint2*)((const bf16_t*)(p.ws + OFF_XR) + o); sw[u][i] = *(const uint2*)(sadd + o); g2[u][i] = *(const float4*)(g2l + (size_t)(tk[u] / SEQ) * 6144 + i * 256 + lane * 4); }
#pragma unroll
        for (int u = 0; u < NU; ++u) {
            float4 v[4]; float ss = 0.f;
#pragma unroll
            for (int i = 0; i < 4; ++i) { const uint2 w = xw[u][i], s_ = sw[u][i]; const float4 g_ = g2[u][i];
                v[i] = make_float4(bf2f(w.x & 0xffffu) + g_.x * bf2f(s_.x & 0xffffu), bf2f(w.x >> 16) + g_.y * bf2f(s_.x >> 16), bf2f(w.y & 0xffffu) + g_.z * bf2f(s_.y & 0xffffu), bf2f(w.y >> 16) + g_.w * bf2f(s_.y >> 16));
                ss += v[i].x * v[i].x + v[i].y * v[i].y + v[i].z * v[i].z + v[i].w * v[i].w; }
            const float rstd = rsqrtf(wave_sum(ss) * (1.0f / D) + EPS);
            float* xr = p.out + (size_t)tk[u] * D;
#pragma unroll
            for (int i = 0; i < 4; ++i) { const float4 g = *(const float4*)(p.final_g + i * 256 + lane * 4);
                if (ok[u]) *(float4*)(xr + i * 256 + lane * 4) = make_float4(v[i].x * rstd * g.x, v[i].y * rstd * g.y, v[i].z * rstd * g.z, v[i].w * rstd * g.w); }
        }
    }
}

#define XB_TMO      128
#define XB_XCNT(j)  (256  + 64 * (j))
#define XB_XSUB(j)  (1280 + 64 * (j))
#define XB_XGEN(j)  (2304 + 64 * (j))
#define XB_TOP      3328
#define XB_TOPGEN   3392
#define XCD_BAR_WORDS 3456
#define XB_SPIN_CAP (1u << 22)
__device__ __forceinline__ unsigned xb_ld(unsigned* p)              { return __hip_atomic_load(p, __ATOMIC_RELAXED, __HIP_MEMORY_SCOPE_AGENT); }
__device__ __forceinline__ unsigned xb_add(unsigned* p, unsigned v) { return __hip_atomic_fetch_add(p, v, __ATOMIC_RELAXED, __HIP_MEMORY_SCOPE_AGENT); }
__device__ __forceinline__ unsigned xb_xcc_id() { return (unsigned)__builtin_amdgcn_s_getreg((3 << 11) | 20) & 0xFu; }
#define XB_SPIN(cond, bar) do { unsigned _sp = 0; while (cond) { __builtin_amdgcn_s_sleep(1); \
    if ((++_sp & 255u) == 0u) { if (xb_ld(&(bar)[XB_TMO])) break; if (_sp > XB_SPIN_CAP) { atomicAdd(&(bar)[XB_TMO], 1u); break; } } } } while (0)
__device__ __forceinline__ void xcd_barrier_post(unsigned* bar, volatile LAS unsigned* st) {
    if (threadIdx.x == 0) { const unsigned x = xb_xcc_id(); st[3] = x; st[2] = xb_add(&bar[XB_XCNT(x)], 1u); }
}
__device__ __forceinline__ void xcd_barrier_complete(unsigned* bar, unsigned x, unsigned& nloc, unsigned& nx) {
    const unsigned G = gridDim.x * gridDim.y * gridDim.z;
    unsigned sum, cnt, mine, sp = 0u;
    for (;;) {
        sum = 0u; cnt = 0u; mine = 0u;
#pragma unroll
        for (unsigned j = 0; j < 16; ++j) { const unsigned c = xb_ld(&bar[XB_XCNT(j)]); sum += c; cnt += (c > 0u) ? 1u : 0u; mine = (j == x) ? c : mine; }
        if (sum == G) break;
        __builtin_amdgcn_s_sleep(1);
        if ((++sp & 255u) == 0u) { if (xb_ld(&bar[XB_TMO])) break; if (sp > XB_SPIN_CAP) { atomicAdd(&bar[XB_TMO], 1u); break; } }
    }
    nloc = mine > 0u ? mine : 1u; nx = cnt > 0u ? cnt : 1u;
}
__device__ __forceinline__ void xcd_barrier(unsigned* bar, volatile LAS unsigned* st) {
    asm volatile("s_waitcnt vmcnt(0)" ::: "memory");
    __syncthreads();
    int t0_ = threadIdx.x; asm volatile("" : "+v"(t0_));
    if (t0_ == 0) {
        __builtin_amdgcn_s_waitcnt(0);
        unsigned nloc = st[0], nx = st[1]; const unsigned x = st[3];
        if (nloc == 0u) { xcd_barrier_complete(bar, x, nloc, nx); st[0] = nloc; st[1] = nx; }
        const unsigned old = xb_add(&bar[XB_XSUB(x)], 1u);
        const unsigned gen = old / nloc;
        if (old + 1u == (gen + 1u) * nloc) {
            __builtin_amdgcn_fence(__ATOMIC_RELEASE, "agent");
            asm volatile("s_waitcnt vmcnt(0)" ::: "memory");
            const unsigned og = xb_add(&bar[XB_TOP], 1u);
            const unsigned tg = og / nx;
            if (og + 1u == (tg + 1u) * nx) xb_add(&bar[XB_TOPGEN], 1u);
            else XB_SPIN(xb_ld(&bar[XB_TOPGEN]) == tg, bar);
            __builtin_amdgcn_fence(__ATOMIC_ACQUIRE, "agent");
            xb_add(&bar[XB_XGEN(x)], 1u);
            asm volatile("s_waitcnt vmcnt(0)" ::: "memory");
        } else {
            XB_SPIN(xb_ld(&bar[XB_XGEN(x)]) == gen, bar);
            __builtin_amdgcn_fence(__ATOMIC_ACQUIRE, "agent");
            asm volatile("s_waitcnt vmcnt(0)" ::: "memory");
        }
    }
    __syncthreads();
}

#if MEGA
#if PROBE_A >= 0
#define TSTAMP(i) do { if (blockIdx.x == 0 && threadIdx.x == 0) ts[i] = __builtin_amdgcn_s_memrealtime(); } while (0)
#else
#define TSTAMP(i) do { } while (0)
#endif
__global__ void __launch_bounds__(512, 2) mega_kernel(Params p) {
    __shared__ __attribute__((aligned(16))) char smem[2 * SMEM_BYTES + 32];
#if PROBE_A >= 0
    __shared__ unsigned long long ts[26];
#endif
#if COOP
    cg::grid_group grid = cg::this_grid();
#endif
    const int vb = threadIdx.x >> 8;
    const int bid = blockIdx.x * 2 + vb, nb = gridDim.x * 2;
    char* smv = smem + vb * SMEM_BYTES;
    unsigned* bar = (unsigned*)(p.ws + OFF_BAR);
    volatile LAS unsigned* xst = (volatile LAS unsigned*)(smem + 2 * SMEM_BYTES);
#define GBAR() xcd_barrier((unsigned*)(p.ws + OFF_BAR), (volatile LAS unsigned*)(smem + 2 * SMEM_BYTES))
    if (threadIdx.x == 0) { xst[0] = 0u; xst[1] = 0u; xst[2] = 0u; xst[3] = 0u; xst[4] = 0u; xst[5] = 0u; }
    __syncthreads();
#if COOP
    if (blockIdx.x == 0) for (int i = threadIdx.x; i < XCD_BAR_WORDS; i += 512) bar[i] = 0u;
    TSTAMP(0);
    phase_prep(p, smv, bid, nb);
    grid.sync();
    xcd_barrier_post(bar, xst);
#else
    __syncthreads();
    xcd_barrier_post(bar, xst);
    TSTAMP(0);
    phase_prep(p, smv, bid, nb);
    GBAR();
#endif
    TSTAMP(1);
    phase_norm<false, false, 4>(p.x, p.norm1_g, (const float*)(p.ws + OFF_MOD), 0, D, (bf16_t*)(p.ws + OFF_H), bid, nb); GBAR();
    int slice4, grank4; const int gsz4 = (int)gridDim.x / 4 * 2;
    {
        const unsigned myx = xst[3], myrank = xst[2];
        unsigned pre = 0;
#pragma unroll
        for (unsigned j = 0; j < 16; ++j) { const unsigned c = xb_ld(&bar[XB_XCNT(j)]); pre += (j < myx) ? c : 0u; }
        const int gi = __builtin_amdgcn_readfirstlane((int)(pre + myrank));
        slice4 = gi / ((int)gridDim.x / 4); grank4 = (gi % ((int)gridDim.x / 4)) * 2;
    }
#pragma nounroll
    for (int l = 0; l < NL; ++l) {
        TSTAMP(2 + 11 * l); phase_gemm1(p, l, smem); GBAR();
        TSTAMP(3 + 11 * l); phase_mix(p, l, smv, bid, nb); GBAR();
        TSTAMP(4 + 11 * l); phase_fftb(p, l, smv, bid, nb); GBAR();
        TSTAMP(5 + 11 * l); phase_gemm2(p, l, smem); GBAR();
        TSTAMP(6 + 11 * l); phase_norm<true, false, 4>(p.ws + OFF_XR, p.norm2_g + l * D, (const float*)(p.ws + OFF_MOD) + (size_t)l * NB * 6144, 3 * D, 4 * D, (bf16_t*)(p.ws + OFF_H), bid, nb); GBAR();
        TSTAMP(7 + 11 * l); phase_gemm3(p, l, smem); GBAR();
        TSTAMP(8 + 11 * l); phase_topk(p, l, smv, bid, nb); GBAR();
        TSTAMP(9 + 11 * l); phase_pu(p, l, slice4, grank4, gsz4, smem); GBAR();
        TSTAMP(10 + 11 * l); phase_pc(p, l, bid, nb); GBAR();
        TSTAMP(11 + 11 * l); phase_pv(p, l, slice4, grank4, gsz4, smem); GBAR();
        TSTAMP(12 + 11 * l);
        if (l + 1 < NL) { phase_norm<true, true>(p.ws + OFF_XR, p.norm1_g + (l + 1) * D, (const float*)(p.ws + OFF_MOD) + (size_t)(l + 1) * NB * 6144, 0, D, (bf16_t*)(p.ws + OFF_H), bid, nb,
                                                 (const bf16_t*)(p.ws + OFF_Z), (const float*)(p.ws + OFF_MOD) + (size_t)l * NB * 6144 + 5 * D); GBAR(); }
        else phase_final_norm(p, bid, nb);
    }
#undef GBAR
    TSTAMP(24);
#if PROBE_A >= 0
    if (bid == 0 && threadIdx.x == 0) p.out[0] += (float)(ts[PROBE_B] - ts[PROBE_A]) * 0.01f / PROBE_DIV;
#endif
}
#endif

extern "C" void kernel_launch(void* const* d_in, const int* in_sizes, int n_in, void* d_out, int out_size, void* d_ws, size_t ws_size, hipStream_t stream) {
    (void)in_sizes; (void)n_in; (void)out_size;
    if (ws_size < OFF_END) { fprintf(stderr, "workspace too small: %zu < %zu\n", ws_size, (size_t)OFF_END); return; }
    Params p{};
    p.x = (const float*)d_in[0]; p.c = (const float*)d_in[1]; p.mod_w = (const float*)d_in[2]; p.mod_b = (const float*)d_in[3]; p.norm1_g = (const float*)d_in[4];
    p.w_in = (const float*)d_in[5]; p.gmlp_ws = (const float*)d_in[6]; p.gmlp_bs = (const float*)d_in[7]; p.fnet_w = (const float*)d_in[8]; p.fnet_b = (const float*)d_in[9];
    p.gain_a = (const float*)d_in[10]; p.gain_b = (const float*)d_in[11]; p.w_out = (const float*)d_in[12]; p.norm2_g = (const float*)d_in[13]; p.wq = (const float*)d_in[14];
    p.k1 = (const float*)d_in[15]; p.k2 = (const float*)d_in[16]; p.pu = (const float*)d_in[17]; p.pv = (const float*)d_in[18]; p.final_g = (const float*)d_in[19];
    p.out = (float*)d_out; p.ws = (char*)d_ws;
#if MEGA
    static int grid_blocks = 0;
    if (!grid_blocks) {
        int dev = 0, cus = 0, per_cu = 0;
        hipGetDevice(&dev);
        hipDeviceGetAttribute(&cus, hipDeviceAttributeMultiprocessorCount, dev);
        hipOccupancyMaxActiveBlocksPerMultiprocessor(&per_cu, mega_kernel, 512, 0);
        if (per_cu > 1) per_cu = 1;
        grid_blocks = (cus * per_cu) / 8 * 8;
    }
    void* args[] = {&p};
    hipError_t e = hipLaunchCooperativeKernel((void*)mega_kernel, dim3(grid_blocks), dim3(512), args, 0, stream);
    if (e != hipSuccess) fprintf(stderr, "cooperative launch failed: %s (grid %d)\n", hipGetErrorString(e), grid_blocks);
#endif
}
```

```cpp
#include <hip/hip_runtime.h>
#include <hip/hip_cooperative_groups.h>
#include <cstdio>
#include <cstdint>
namespace cg = cooperative_groups;

#ifndef MEGA
#define MEGA 1
#endif
#ifndef COOP
#define COOP 1
#endif
#ifndef PROBE_A
#define PROBE_A -1
#define PROBE_B 0
#define PROBE_DIV 10.0f
#endif

typedef unsigned short bf16_t;
typedef short bf16x8 __attribute__((ext_vector_type(8)));
typedef float f32x4 __attribute__((ext_vector_type(4)));
typedef __bf16 bf16x2_t __attribute__((ext_vector_type(2)));

constexpr int D = 1024, NB = 8, SEQ = 4096, T = NB * SEQ, NL = 2;
constexpr int NZ = 2048;
constexpr int NE = 16384;
constexpr float EPS = 1e-6f;

constexpr size_t OFF_MOD  = 0;
constexpr size_t OFF_W1T  = OFF_MOD  + (size_t)NL * NB * 6144 * 4;
constexpr size_t OFF_W2T  = OFF_W1T  + (size_t)NL * 2048 * 1024 * 2;
constexpr size_t OFF_WQT  = OFF_W2T  + (size_t)NL * 1024 * 1024 * 2;
constexpr size_t OFF_K12  = OFF_WQT  + (size_t)NL * 2048 * 1024 * 2;
constexpr size_t OFF_WSB  = OFF_K12  + (size_t)NL * 8 * 256 * 128 * 2;
constexpr size_t OFF_DA   = OFF_WSB  + (size_t)NL * 8 * 128 * 128 * 2;
constexpr size_t OFF_DB   = OFF_DA   + 128 * 128 * 2;
constexpr size_t OFF_TW   = OFF_DB   + 64 * 128 * 2;
constexpr size_t OFF_SSQA = OFF_TW   + 64 * 64 * 8;
constexpr size_t OFF_SSQB = OFF_SSQA + (size_t)T * 8 * 4;
constexpr size_t OFF_UB   = OFF_SSQB + (size_t)T * 8 * 4;
constexpr size_t OFF_VB   = OFF_UB   + (size_t)NL * NE * 1024;
constexpr size_t OFF_USC  = OFF_VB   + (size_t)NL * NE * 1024;
constexpr size_t OFF_VSC  = OFF_USC  + (size_t)NL * NE * 4;
constexpr size_t OFF_H    = OFF_VSC  + (size_t)NL * NE * 4;
constexpr size_t OFF_Z    = OFF_H    + (size_t)T * 1024 * 2;
constexpr size_t OFF_Y    = OFF_Z    + (size_t)T * 2048 * 2;
constexpr size_t OFF_BAR  = OFF_Y    + (size_t)T * 1024 * 2;
constexpr size_t OFF_XR   = OFF_BAR  + 16384;
constexpr size_t OFF_END  = OFF_XR   + (size_t)T * 1024 * 2;

struct Params {
    const float* x; const float* c; const float* mod_w; const float* mod_b; const float* norm1_g; const float* w_in;
    const float* gmlp_ws; const float* gmlp_bs; const float* fnet_w; const float* fnet_b; const float* gain_a; const float* gain_b;
    const float* w_out; const float* norm2_g; const float* wq; const float* k1; const float* k2; const float* pu; const float* pv; const float* final_g;
    float* out; char* ws;
};

constexpr int SMEM_BYTES = 73984;

__device__ __forceinline__ float bf2f(unsigned v) { return __uint_as_float(v << 16); }
typedef float f32x2_t __attribute__((ext_vector_type(2)));
__device__ __forceinline__ unsigned pk_bf16(float lo, float hi) { const f32x2_t v = {lo, hi}; return __builtin_bit_cast(unsigned, __builtin_convertvector(v, bf16x2_t)); }
__device__ __forceinline__ bf16_t f2bf(float f) { return (bf16_t)(pk_bf16(f, 0.f) & 0xffffu); }
__device__ __forceinline__ float gelu_f(float v) {
    const float t = __builtin_amdgcn_rcpf(fabsf(v) * 0.2316418882f + 1.0f);
    float q = t * 0.5307027145f + (-0.7265760135f); q = q * t + 0.7107068705f; q = q * t + (-0.142248368f); q = q * t + 0.127414796f; q = q * t;
    const float m = v * (q * __builtin_amdgcn_exp2f(v * v * (-0.72134752044f)));
    return v < 0.f ? m : v - m;
}
__device__ __forceinline__ int med3i(int a, int b, int c) { return max(min(a, b), min(max(a, b), c)); }
__device__ __forceinline__ int f2key(float f) { int b = __float_as_int(f); return b ^ ((b >> 31) & 0x7fffffff); }
__device__ __forceinline__ float key2f(int k) { return __int_as_float(k ^ ((k >> 31) & 0x7fffffff)); }
__device__ __forceinline__ float wave_sum(float v) {
#pragma unroll
    for (int o = 32; o >= 1; o >>= 1) v += __shfl_xor(v, o);
    return v;
}
__device__ __forceinline__ int otid() { int t = threadIdx.x & 255; asm volatile("" : "+v"(t)); return t; }
__device__ __forceinline__ void vsync(char* smem_v) {
    const int vb_ = threadIdx.x >> 8;
    volatile __attribute__((address_space(3))) unsigned* cnt = (volatile __attribute__((address_space(3))) unsigned*)(smem_v + (2 - vb_) * SMEM_BYTES + 16) + vb_;
    asm volatile("s_waitcnt lgkmcnt(0)" ::: "memory");
    unsigned target = 0u;
    if ((threadIdx.x & 63) == 0) target = (__hip_atomic_fetch_add((__attribute__((address_space(3))) unsigned*)cnt, 1u, __ATOMIC_RELAXED, __HIP_MEMORY_SCOPE_WORKGROUP) / 4u + 1u) * 4u;
    target = __builtin_amdgcn_readfirstlane(target);
    while (*cnt < target) __builtin_amdgcn_s_sleep(1);
    asm volatile("" ::: "memory");
}
#define MFMA16(a, b, c) __builtin_amdgcn_mfma_f32_16x16x32_bf16((a), (b), (c), 0, 0, 0)

__device__ void transpose_tile(const float* __restrict__ src, int ld, int k0, int n0, bf16_t* __restrict__ dst  , int dn0,
                               const float* __restrict__ kscale, float* tile  ) {
    const int tid = otid();
#pragma unroll
    for (int i = 0; i < 4; ++i) {
        const int r = (tid >> 4) + 16 * i, c4 = (tid & 15) * 4;
        const float4 v = *(const float4*)(src + (size_t)(k0 + r) * ld + n0 + c4);
        const float s = kscale ? kscale[k0 + r] : 1.0f;
        tile[r * 65 + c4 + 0] = v.x * s; tile[r * 65 + c4 + 1] = v.y * s; tile[r * 65 + c4 + 2] = v.z * s; tile[r * 65 + c4 + 3] = v.w * s;
    }
    __syncthreads();
    {
        const int n = tid >> 2, ks = (tid & 3) * 16;
        unsigned w[8];
#pragma unroll
        for (int j = 0; j < 8; ++j) w[j] = pk_bf16(tile[(ks + 2 * j) * 65 + n], tile[(ks + 2 * j + 1) * 65 + n]);
        uint4* d = (uint4*)(dst + (size_t)(dn0 + n) * 1024 + k0 + ks);
        d[0] = make_uint4(w[0], w[1], w[2], w[3]); d[1] = make_uint4(w[4], w[5], w[6], w[7]);
    }
    __syncthreads();
}

__device__ void phase_prep(const Params& p, char* smem, int bid_, int nb_) {
    const int tid = otid();
    char* ws = p.ws;
    const bool split = (nb_ % 4 == 0);
    const bool convgrp = split && ((bid_ >> 1) & 1);
    const int bid = split ? (((bid_ >> 2) << 1) | (bid_ & 1)) : bid_, nb = split ? (nb_ >> 1) : nb_;
    const int gtid = bid * 256 + tid, gsz = nb * 256;
    if (!convgrp) {
    {
        float* sc = (float*)smem;
        float* red = (float*)(smem + 32768);
        for (int i = tid; i < 8192; i += 256) { const float v = p.c[i]; sc[i] = v / (1.0f + __expf(-v)); }
        __syncthreads();
        float* mod = (float*)(ws + OFF_MOD);
        for (int rd_ = 0; rd_ < (NL * 192 + nb - 1) / nb; ++rd_) { const int item = min(bid + rd_ * nb, NL * 192 - 1);
            const int l = item / 192, n0 = (item % 192) * 32, nn = tid & 31, kq = tid >> 5;
            float acc[8];
#pragma unroll
            for (int b = 0; b < 8; ++b) acc[b] = 0.f;
            const float* W = p.mod_w + (size_t)l * 1024 * 6144 + n0 + nn;
#pragma nounroll
            for (int k0 = kq; k0 < 1024; k0 += 128) {
                float w[16];
#pragma unroll
                for (int u = 0; u < 16; ++u) w[u] = W[(size_t)(k0 + 8 * u) * 6144];
#pragma unroll
                for (int u = 0; u < 16; ++u)
#pragma unroll
                    for (int b = 0; b < 8; ++b) acc[b] += sc[b * 1024 + k0 + 8 * u] * w[u];
            }
#pragma unroll
            for (int b = 0; b < 8; ++b) red[(kq * 8 + b) * 32 + nn] = acc[b];
            __syncthreads();
            {
                const int b = tid >> 5;
                float s = 0.f;
#pragma unroll
                for (int q = 0; q < 8; ++q) s += red[(q * 8 + b) * 32 + nn];
                mod[((size_t)l * NB + b) * 6144 + n0 + nn] = s + p.mod_b[l * 6144 + n0 + nn];
            }
            __syncthreads();
        }
    }
    {
        float* tile = (float*)smem;
        for (int rd_ = 0; rd_ < (NL * 1024 + nb - 1) / nb; ++rd_) { const int item = min(bid + rd_ * nb, NL * 1024 - 1);
            const int l = item / 1024, r = item % 1024;
            if (r < 256) {
                const int kt = r / 16, nt = r % 16;
                transpose_tile(p.w_in + (size_t)l * 1024 * 1536, 1536, kt * 64, nt * 64, (bf16_t*)(ws + OFF_W1T) + (size_t)l * 2048 * 1024, nt * 64, nullptr, tile);
            } else if (r < 512) {
                const int rr = r - 256, kt = rr / 16, nt = rr % 16;
                const float* gk = (kt < 8) ? (p.gain_a + l * 512) : (p.gain_b + l * 512 - 512);
                transpose_tile(p.w_out + (size_t)l * 1024 * 1024, 1024, kt * 64, nt * 64, (bf16_t*)(ws + OFF_W2T) + (size_t)l * 1024 * 1024, nt * 64, gk, tile);
            } else {
                const int rr = r - 512, kt = rr / 32, nt = rr % 32;
                transpose_tile(p.wq + (size_t)l * 1024 * 2048, 2048, kt * 64, nt * 64, (bf16_t*)(ws + OFF_WQT) + (size_t)l * 2048 * 1024, nt * 64, nullptr, tile);
            }
        }
    }
    {
        float* fws = (float*)smem;
        float* Ms  = (float*)(smem + 16384);
        float* wt  = (float*)(smem + 49152);
        float* cs  = (float*)(smem + 49152 + 16640);
        for (int rd_ = 0; rd_ < (NL * 8 * 16 + nb - 1) / nb; ++rd_) { const int item = min(bid + rd_ * nb, NL * 8 * 16 - 1);
            const int l = item / 128, g = (item % 128) / 16, kt = item % 16;
            if (tid < 64) { float s, c; sincospif((float)tid / 32.0f, &s, &c); cs[tid] = c; cs[64 + tid] = s; }
            for (int i = tid; i < 4096; i += 256) fws[i] = p.fnet_w[((size_t)l * 8 + g) * 4096 + i];
#pragma unroll
            for (int i = 0; i < 4; ++i) {
                const int r = (tid >> 4) + 16 * i, c4 = (tid & 15) * 4;
                const float4 v = *(const float4*)(p.w_in + (size_t)l * 1024 * 1536 + (size_t)(kt * 64 + r) * 1536 + 1024 + g * 64 + c4);
                wt[r * 65 + c4] = v.x; wt[r * 65 + c4 + 1] = v.y; wt[r * 65 + c4 + 2] = v.z; wt[r * 65 + c4 + 3] = v.w;
            }
            __syncthreads();
            {
                const int d = tid >> 2, r0 = (tid & 3) * 32;
                const bool im = r0 >= 64; const int e0 = r0 & 63;
                float acc[32];
#pragma unroll
                for (int e = 0; e < 32; ++e) acc[e] = 0.f;
                for (int j = 0; j < 64; ++j) {
                    const int ph = (d * j) & 63;
                    const float t = im ? -cs[64 + ph] : cs[ph];
#pragma unroll
                    for (int e = 0; e < 32; ++e) acc[e] += t * fws[j * 64 + e0 + e];
                }
#pragma unroll
                for (int e = 0; e < 32; ++e) Ms[d * 128 + r0 + e] = acc[e];
            }
            __syncthreads();
            {
                const int r = tid >> 1, kk0 = (tid & 1) * 32;
                float acc[32];
#pragma unroll
                for (int k = 0; k < 32; ++k) acc[k] = 0.f;
                for (int d = 0; d < 64; ++d) {
                    const float m = Ms[d * 128 + r];
#pragma unroll
                    for (int k = 0; k < 32; ++k) acc[k] += wt[(kk0 + k) * 65 + d] * m;
                }
                bf16_t* dst = (bf16_t*)(ws + OFF_W1T) + (size_t)l * 2048 * 1024 + (size_t)(1024 + g * 128 + r) * 1024 + kt * 64 + kk0;
#pragma unroll
                for (int q = 0; q < 4; ++q)
                    ((uint4*)dst)[q] = make_uint4(pk_bf16(acc[q * 8], acc[q * 8 + 1]), pk_bf16(acc[q * 8 + 2], acc[q * 8 + 3]), pk_bf16(acc[q * 8 + 4], acc[q * 8 + 5]), pk_bf16(acc[q * 8 + 6], acc[q * 8 + 7]));
            }
            __syncthreads();
        }
    }
    {
        bf16_t* k12 = (bf16_t*)(ws + OFF_K12);
        for (int i = gtid; i < NL * 8 * 256 * 128; i += gsz) {
            const int d = i & 127, n = (i >> 7) & 255, h = (i >> 15) & 7, l = i >> 18;
            const float* src = (n < 128) ? p.k1 : p.k2;
            k12[i] = f2bf(src[(((size_t)l * 8 + h) * 128 + (n & 127)) * 128 + d]);
        }
        bf16_t* wsb = (bf16_t*)(ws + OFF_WSB);
        for (int i = gtid; i < NL * 8 * 128 * 128; i += gsz) wsb[i] = f2bf(p.gmlp_ws[i]);
        bf16_t* DA = (bf16_t*)(ws + OFF_DA);
        for (int i = gtid; i < 128 * 128; i += gsz) {
            const int m = i >> 7, kk = i & 127, ro = m >> 6, k1 = m & 63, ri = kk >> 6, a = kk & 63;
            float s, c; sincospif((float)((a * k1) & 63) / 32.0f, &s, &c);
            const float v = (ro == ri) ? c : (ro == 0 ? s : -s);
            DA[i] = f2bf(v);
        }
        bf16_t* DB = (bf16_t*)(ws + OFF_DB);
        for (int i = gtid; i < 64 * 128; i += gsz) {
            const int k2 = i >> 7, kk = i & 127, ri = kk >> 6, b = kk & 63;
            float s, c; sincospif((float)((b * k2) & 63) / 32.0f, &s, &c);
            DB[i] = f2bf(ri ? s : c);
        }
        float2* tw = (float2*)(ws + OFF_TW);
        for (int i = gtid; i < 64 * 64; i += gsz) {
            const int bp = i >> 6, k1 = i & 63;
            float s, c; sincospif((float)(bp * k1) / 2048.0f, &s, &c);
            tw[i] = make_float2(c, s);
        }
    }
    }
    if (convgrp || !split) {
        {
            const int lane = tid & 63, wv = gtid >> 6, nwv = gsz >> 6;
            const int R = 2 * NL * NE;
#pragma nounroll
            for (int r0 = wv; r0 < R; r0 += 4 * nwv) {
                float4 v[4][4];
#pragma unroll
                for (int t = 0; t < 4; ++t) {
                    const int r = (r0 + t * nwv < R) ? r0 + t * nwv : r0;
                    const int tbl = r / (NL * NE), row = r % (NL * NE);
                    const float* src = (tbl ? p.pv : p.pu) + (size_t)row * 1024 + lane * 16;
#pragma unroll
                    for (int i = 0; i < 4; ++i) v[t][i] = ((const float4*)src)[i];
                }
                __builtin_amdgcn_sched_barrier(0);
#pragma unroll
                for (int t = 0; t < 4; ++t) {
                    const int r = r0 + t * nwv;
                    if (r >= R) break;
                    const int tbl = r / (NL * NE), row = r % (NL * NE);
                    float m = 0.f;
#pragma unroll
                    for (int i = 0; i < 4; ++i) m = fmaxf(m, fmaxf(fmaxf(fabsf(v[t][i].x), fabsf(v[t][i].y)), fmaxf(fabsf(v[t][i].z), fabsf(v[t][i].w))));
#pragma unroll
                    for (int o = 32; o >= 1; o >>= 1) m = fmaxf(m, __shfl_xor(m, o));
                    const float qmax = 6.0f;
                    const float sc = (m > 0.f) ? qmax / m : 1.0f, inv = (m > 0.f) ? m / qmax : 1.0f;
                    const int lyr = row / NE, ex = row % NE;
                    if (true) {
                        unsigned w0 = 0u, w1 = 0u;
                        w0 = __builtin_amdgcn_cvt_scalef32_pk_fp4_f32(w0, v[t][0].x * sc, v[t][0].y * sc, 1.0f, 0); w0 = __builtin_amdgcn_cvt_scalef32_pk_fp4_f32(w0, v[t][0].z * sc, v[t][0].w * sc, 1.0f, 1);
                        w0 = __builtin_amdgcn_cvt_scalef32_pk_fp4_f32(w0, v[t][1].x * sc, v[t][1].y * sc, 1.0f, 2); w0 = __builtin_amdgcn_cvt_scalef32_pk_fp4_f32(w0, v[t][1].z * sc, v[t][1].w * sc, 1.0f, 3);
                        w1 = __builtin_amdgcn_cvt_scalef32_pk_fp4_f32(w1, v[t][2].x * sc, v[t][2].y * sc, 1.0f, 0); w1 = __builtin_amdgcn_cvt_scalef32_pk_fp4_f32(w1, v[t][2].z * sc, v[t][2].w * sc, 1.0f, 1);
                        w1 = __builtin_amdgcn_cvt_scalef32_pk_fp4_f32(w1, v[t][3].x * sc, v[t][3].y * sc, 1.0f, 2); w1 = __builtin_amdgcn_cvt_scalef32_pk_fp4_f32(w1, v[t][3].z * sc, v[t][3].w * sc, 1.0f, 3);
                        *(uint2*)(ws + (tbl ? OFF_VB : OFF_UB) + ((size_t)(lyr * 4 + (lane >> 4)) * NE + ex) * 128 + (lane & 15) * 8) = make_uint2(w0, w1);
                    } else {
                        int w[4];
#pragma unroll
                        for (int i = 0; i < 4; ++i) { w[i] = __builtin_amdgcn_cvt_pk_fp8_f32(v[t][i].x * sc, v[t][i].y * sc, 0, false); w[i] = __builtin_amdgcn_cvt_pk_fp8_f32(v[t][i].z * sc, v[t][i].w * sc, w[i], true); }
                        *(int4*)(ws + OFF_UB + ((size_t)(lyr * 8 + (lane >> 3)) * NE + ex) * 128 + (lane & 7) * 16) = make_int4(w[0], w[1], w[2], w[3]);
                    }
                    if (lane == 0) ((float*)(ws + (tbl ? OFF_VSC : OFF_USC)))[row] = inv;
                    __builtin_amdgcn_sched_barrier(0);
                }
            }
        }
    }
}

template <bool SRC_BF16, bool ADD = false, int NU = 2>
__device__ void phase_norm(const void* xsrc_, const float* __restrict__ g, const float* __restrict__ modl  , int sh_off, int scl_off,
                           bf16_t* __restrict__ hout, int bid, int nb, const bf16_t* __restrict__ sadd = nullptr, const float* __restrict__ g2l = nullptr) {
    const int tid_ = otid(); const int lane = tid_ & 63, wid = tid_ >> 6;
    for (int tok0 = bid * 4 + wid; tok0 < T; tok0 += nb * 4 * NU) {
        int tk[NU]; bool ok[NU];
#pragma unroll
        for (int u = 0; u < NU; ++u) { ok[u] = tok0 + u * nb * 4 < T; tk[u] = ok[u] ? tok0 + u * nb * 4 : tok0; }
        float4 v[NU][4]; uint2 xw[NU][4], sw[NU][4]; float4 g2[NU][4];
#pragma unroll
        for (int u = 0; u < NU; ++u)
#pragma unroll
            for (int i = 0; i < 4; ++i) {
                const size_t o = (size_t)tk[u] * D + i * 256 + lane * 4;
                if (SRC_BF16) xw[u][i] = *(const uint2*)((const bf16_t*)xsrc_ + o); else v[u][i] = *(const float4*)((const float*)xsrc_ + o);
                if (ADD) { sw[u][i] = *(const uint2*)(sadd + o); g2[u][i] = *(const float4*)(g2l + (size_t)(tk[u] / SEQ) * 6144 + i * 256 + lane * 4); }
            }
        float ss[NU];
#pragma unroll
        for (int u = 0; u < NU; ++u) { ss[u] = 0.f;
#pragma unroll
            for (int i = 0; i < 4; ++i) {
                if (SRC_BF16) v[u][i] = make_float4(bf2f(xw[u][i].x & 0xffffu), bf2f(xw[u][i].x >> 16), bf2f(xw[u][i].y & 0xffffu), bf2f(xw[u][i].y >> 16));
                if (ADD) { const uint2 s_ = sw[u][i]; const float4 g_ = g2[u][i];
                    const unsigned r0 = pk_bf16(v[u][i].x + g_.x * bf2f(s_.x & 0xffffu), v[u][i].y + g_.y * bf2f(s_.x >> 16)), r1 = pk_bf16(v[u][i].z + g_.z * bf2f(s_.y & 0xffffu), v[u][i].w + g_.w * bf2f(s_.y >> 16));
                    if (ok[u]) *(uint2*)((bf16_t*)xsrc_ + (size_t)tk[u] * D + i * 256 + lane * 4) = make_uint2(r0, r1);
                    v[u][i] = make_float4(bf2f(r0 & 0xffffu), bf2f(r0 >> 16), bf2f(r1 & 0xffffu), bf2f(r1 >> 16)); }
                ss[u] += v[u][i].x * v[u][i].x + v[u][i].y * v[u][i].y + v[u][i].z * v[u][i].z + v[u][i].w * v[u][i].w;
            }
        }
#pragma unroll
        for (int u = 0; u < NU; ++u) {
            const float rstd = rsqrtf(wave_sum(ss[u]) * (1.0f / D) + EPS);
            const float* mb = modl + (size_t)(tk[u] / SEQ) * 6144;
#pragma unroll
            for (int i = 0; i < 4; ++i) {
                const int cidx = i * 256 + lane * 4;
                const float4 gg = *(const float4*)(g + cidx), sh = *(const float4*)(mb + sh_off + cidx), sc = *(const float4*)(mb + scl_off + cidx);
                const float o0 = v[u][i].x * rstd * gg.x * (1.0f + sc.x) + sh.x, o1 = v[u][i].y * rstd * gg.y * (1.0f + sc.y) + sh.y;
                const float o2 = v[u][i].z * rstd * gg.z * (1.0f + sc.z) + sh.z, o3 = v[u][i].w * rstd * gg.w * (1.0f + sc.w) + sh.w;
                if (ok[u]) *(uint2*)(hout + (size_t)tk[u] * D + cidx) = make_uint2(pk_bf16(o0, o1), pk_bf16(o2, o3));
            }
        }
    }
}

namespace pg8 {
#define PG8_LAS __attribute__((address_space(3)))
typedef unsigned short bf16_t;
typedef short bf16x8 __attribute__((ext_vector_type(8)));
typedef float f32x4 __attribute__((ext_vector_type(4)));
typedef unsigned u32x4 __attribute__((ext_vector_type(4)));
constexpr int BM = 256, BK = 64, HALF = 128, HTB = HALF * BK * 2  , STAGE_BYTES = 8 * HTB, NXCD = 8, WGM = 8;

__host__ __device__ __forceinline__ int lds_byte(int r, int c) { const int st = (r >> 4) * 2 + (c >> 5), rr = r & 15, cc = c & 31, ob = rr * 64 + cc * 2; return st * 1024 + (ob ^ (((ob >> 9) & 1) << 5)); }
__host__ __device__ __forceinline__ void stage_rc(int b, int& R, int& C) { const int st = b / 1024, sb = b % 1024, swz = sb ^ (((sb >> 9) & 1) << 5); R = (st >> 1) * 16 + swz / 64; C = (st & 1) * 32 + (swz % 64) / 2; }
__host__ __device__ __forceinline__ int perm32(int rho) { const int n = rho >> 4, i = rho & 15; return 8 * (i >> 2) + 4 * n + (i & 3); }

struct Unit { int pm, pn; };
struct Gemm { const bf16_t* A; const bf16_t* Bt; int M, N, K; };

struct StaticOrder {
    int nM, nN, nwg, G, c;
    __host__ __device__ void init(int M, int N, int G_, int c_) { nM = M / BM; nN = N / BM; nwg = nM * nN; G = G_; c = c_; }
    __host__ __device__ bool next(int i, Unit& u) const {
        const long L = (long)i * G + c; if (L >= nwg) return false;
        int wgid = (int)L; { const int q = nwg / NXCD, r = nwg % NXCD, xcd = wgid % NXCD, off = wgid / NXCD; wgid = (xcd < r ? xcd * (q + 1) : r * (q + 1) + (xcd - r) * q) + off; }
        const int nig = WGM * nN, gid = wgid / nig, fm = gid * WGM, gsz = (nM - fm) < WGM ? (nM - fm) : WGM;
        u.pm = fm + ((wgid % nig) % gsz); u.pn = (wgid % nig) / gsz; return true;
    }
    __device__ __forceinline__ void a_ready(const Unit&) const {}
    __device__ __forceinline__ void done(const Unit&) const {}
};

template <class Epi, class Sched, class MidK, bool STAMP = false>
__device__ __forceinline__ void gemm_phase(PG8_LAS unsigned char* lds, const Gemm g, const Sched& S, const Epi& E, const MidK& MK, int midt, unsigned long long* stamps) {
    int tid_ = threadIdx.x; asm volatile("" : "+v"(tid_));
    const int tid = tid_, wid = __builtin_amdgcn_readfirstlane(tid >> 6), lane = tid & 63, wr = wid >> 2, wc = wid & 3, fr = lane & 15, fq = lane >> 4;
    const int K = g.K, nt = K / BK;
    int ts_lo = 0, ts_hi = 0, nts = 0; const unsigned long long rt_entry = STAMP ? (unsigned long long)wall_clock64() : 0ull;
#define PG8_STAMP() do { if (STAMP && wid == 0 && nts < 64) { const unsigned long long _c = (unsigned long long)clock64(); \
        ts_lo = (lane == nts) ? (int)(unsigned)_c : ts_lo; ts_hi = (lane == nts) ? (int)(unsigned)(_c >> 32) : ts_hi; ++nts; } } while (0)
    PG8_STAMP();
    unsigned voffA[2], voffB[2];
#pragma unroll
    for (int i = 0; i < 2; ++i) { int R, C; stage_rc(tid * 16 + i * 8192, R, C); const int Rb = Epi::PERM ? ((R & ~31) + perm32(R & 31)) : R;
        voffA[i] = (unsigned)(R * K + C) * 2u; voffB[i] = (unsigned)(Rb * K + C) * 2u; }
    const size_t kstep = (size_t)(BK * 2);
    const size_t hstep = (size_t)HALF * K * 2;
    const size_t tstep = 2 * hstep;
    const unsigned ldsw = (unsigned)wid * 1024u;
    const int aoff = lds_byte(wr * 64 + fr, fq * 8), boff = lds_byte(wc * 32 + fr, fq * 8);
#define PG8_SA(b, h) (((b) * 2 + (h)) * HTB)
#define PG8_SB(b, h) ((4 + (b) * 2 + (h)) * HTB)
#define PG8_STAGE(bufoff, gbase, voff) do { _Pragma("unroll") for (int _i = 0; _i < 2; ++_i) \
        __builtin_amdgcn_global_load_lds((const unsigned*)((const char*)(gbase) + (voff)[_i]), (PG8_LAS unsigned*)(lds + (bufoff) + ldsw + _i * 8192), 16, 0, 0); } while (0)
#define PG8_LDA(dst, b, h) do { _Pragma("unroll") for (int m = 0; m < 4; ++m) _Pragma("unroll") for (int k = 0; k < 2; ++k) dst[m][k] = *(const PG8_LAS bf16x8*)(lds + PG8_SA(b, h) + aoff + m * 2048 + k * 1024); } while (0)
#define PG8_LDB(dst, b, h) do { _Pragma("unroll") for (int n = 0; n < 2; ++n) _Pragma("unroll") for (int k = 0; k < 2; ++k) dst[n][k] = *(const PG8_LAS bf16x8*)(lds + PG8_SB(b, h) + boff + n * 2048 + k * 1024); } while (0)
#define PG8_MMA(ai, bj, At, Bt) do { __builtin_amdgcn_s_setprio(1); _Pragma("unroll") for (int m = 0; m < 4; ++m) _Pragma("unroll") for (int n = 0; n < 2; ++n) _Pragma("unroll") for (int k = 0; k < 2; ++k) \
        acc[ai][bj][m][n] = __builtin_amdgcn_mfma_f32_16x16x32_bf16(Bt[n][k], At[m][k], acc[ai][bj][m][n], 0, 0, 0); __builtin_amdgcn_s_setprio(0); } while (0)
#define PG8_WAIT_V(n) asm volatile("s_waitcnt vmcnt(" #n ")" ::: "memory")
#define PG8_WAIT_L(n) asm volatile("s_waitcnt lgkmcnt(" #n ")" ::: "memory")
#define PG8_BAR __builtin_amdgcn_s_barrier()
#define PG8_SCHED __builtin_amdgcn_sched_barrier(0)
    Unit cur, nxt; int ui = 0;
    if (!S.next(0, cur)) return;
    f32x4 acc[2][2][4][2];
#pragma unroll
    for (int a = 0; a < 2; ++a)
#pragma unroll
        for (int b = 0; b < 2; ++b)
#pragma unroll
            for (int m = 0; m < 4; ++m)
#pragma unroll
                for (int n = 0; n < 2; ++n) acc[a][b][m][n] = (f32x4){0.f, 0.f, 0.f, 0.f};
    bf16x8 At[4][2], B0[2][2], B1[2][2];
    const char* cA = (const char*)g.A + (size_t)cur.pm * tstep; const char* cB = (const char*)g.Bt + (size_t)cur.pn * tstep;
    S.a_ready(cur);
    PG8_STAGE(PG8_SB(0, 0), cB, voffB); PG8_STAGE(PG8_SA(0, 0), cA, voffA); PG8_STAGE(PG8_SB(0, 1), cB + hstep, voffB); PG8_STAGE(PG8_SA(0, 1), cA + hstep, voffA);
    if (wr == 1) PG8_BAR;
    PG8_WAIT_V(4); PG8_BAR;
    PG8_STAGE(PG8_SB(1, 0), cB + kstep, voffB); PG8_STAGE(PG8_SA(1, 0), cA + kstep, voffA); PG8_STAGE(PG8_SB(1, 1), cB + hstep + kstep, voffB);
    PG8_WAIT_V(6); PG8_BAR;
    PG8_STAMP();
    for (;;) {
        const bool has_next = S.next(ui + 1, nxt);
        const char* nA = has_next ? (const char*)g.A + (size_t)nxt.pm * tstep : cA; const char* nB = has_next ? (const char*)g.Bt + (size_t)nxt.pn * tstep : cB;
        for (int t = 0; t < nt; t += 2) {
            const bool last = (t == nt - 2);
            if (t == midt) {
#pragma unroll
                for (int ai = 0; ai < 2; ++ai)
#pragma unroll
                    for (int m = 0; m < 4; ++m) { const float s_ = MK(ui, ai * HALF + wr * 64 + m * 16 + fr);
#pragma unroll
                        for (int bj = 0; bj < 2; ++bj)
#pragma unroll
                            for (int n = 0; n < 2; ++n) acc[ai][bj][m][n] *= s_;
                        __builtin_amdgcn_sched_barrier(0); }
            }
            const char* a1 = cA + (size_t)(t + 1) * kstep;
            const char* a2 = last ? nA : cA + (size_t)(t + 2) * kstep; const char* b2 = last ? nB : cB + (size_t)(t + 2) * kstep;
            const char* a3 = a2 + kstep; const char* b3 = b2 + kstep;
            if (last && has_next) S.a_ready(nxt);
            PG8_LDB(B0, 0, 0); PG8_SCHED; PG8_LDA(At, 0, 0); PG8_STAGE(PG8_SA(1, 1), a1 + hstep, voffA);
            PG8_WAIT_L(8); PG8_BAR; PG8_WAIT_L(0); PG8_MMA(0, 0, At, B0); PG8_BAR; PG8_SCHED;
            PG8_LDB(B1, 0, 1); PG8_STAGE(PG8_SB(0, 0), b2, voffB);
            PG8_BAR; PG8_WAIT_L(0); PG8_MMA(0, 1, At, B1); PG8_BAR;
            PG8_LDA(At, 0, 1); PG8_STAGE(PG8_SA(0, 0), a2, voffA);
            PG8_BAR; PG8_WAIT_L(0); PG8_MMA(1, 0, At, B0); PG8_BAR; PG8_SCHED;
            PG8_STAGE(PG8_SB(0, 1), b2 + hstep, voffB);
            PG8_WAIT_V(6); PG8_BAR; PG8_MMA(1, 1, At, B1); PG8_BAR;
            PG8_LDB(B0, 1, 0); PG8_SCHED; PG8_LDA(At, 1, 0); PG8_STAGE(PG8_SA(0, 1), a2 + hstep, voffA);
            PG8_WAIT_L(8); PG8_BAR; PG8_WAIT_L(0); PG8_MMA(0, 0, At, B0); PG8_BAR; PG8_SCHED;
            PG8_LDB(B1, 1, 1); PG8_STAGE(PG8_SB(1, 0), b3, voffB);
            PG8_BAR; PG8_WAIT_L(0); PG8_MMA(0, 1, At, B1); PG8_BAR;
            PG8_LDA(At, 1, 1); PG8_STAGE(PG8_SA(1, 0), a3, voffA);
            PG8_BAR; PG8_WAIT_L(0); PG8_MMA(1, 0, At, B0); PG8_BAR; PG8_SCHED;
            PG8_STAGE(PG8_SB(1, 1), b3 + hstep, voffB);
            PG8_WAIT_V(6); PG8_BAR; PG8_MMA(1, 1, At, B1); PG8_BAR;
        }
        PG8_STAMP();
        if constexpr (!Epi::AFTER_DRAIN) { E(acc, cur, wr, wc, fr, fq, ui); S.done(cur); }
        PG8_STAMP();
        if (!has_next) break;
#pragma unroll
        for (int a = 0; a < 2; ++a)
#pragma unroll
            for (int b = 0; b < 2; ++b)
#pragma unroll
                for (int m = 0; m < 4; ++m)
#pragma unroll
                    for (int n = 0; n < 2; ++n) acc[a][b][m][n] = (f32x4){0.f, 0.f, 0.f, 0.f};
        cur = nxt; cA = nA; cB = nB; ++ui;
    }
    PG8_WAIT_V(0);
    if (wr == 0) PG8_BAR;
    PG8_BAR;
    if constexpr (Epi::AFTER_DRAIN) { E.fused(acc, cur, wr, wc, fr, fq, lds, wid, lane); S.done(cur); }
    PG8_STAMP();
    if (STAMP && wid == 0) { stamps[lane] = lane < nts ? (((unsigned long long)(unsigned)ts_hi << 32) | (unsigned)ts_lo) : 0ull;
        if (lane == 62) stamps[62] = rt_entry; if (lane == 63) stamps[63] = (unsigned long long)wall_clock64(); }
#undef PG8_STAMP
#undef PG8_SA
#undef PG8_SB
#undef PG8_STAGE
#undef PG8_LDA
#undef PG8_LDB
#undef PG8_MMA
#undef PG8_WAIT_V
#undef PG8_WAIT_L
#undef PG8_BAR
#undef PG8_SCHED
}
}

struct NoMid { __device__ __forceinline__ float operator()(int, int) const { return 1.0f; } };
#define LAS __attribute__((address_space(3)))
struct EpiZ {
    static constexpr bool PERM = true, AFTER_DRAIN = false;
    bf16_t* Z;
    __device__ __forceinline__ void operator()(const f32x4 (&acc)[2][2][4][2], const pg8::Unit& u, int wr, int wc, int fr, int fq, int) const {
        const int row0 = u.pm * 256 + wr * 64 + fr, col0 = u.pn * 256 + wc * 32 + 8 * fq; const bool act = u.pn < 4;
#pragma unroll
        for (int ai = 0; ai < 2; ++ai)
#pragma unroll
            for (int m = 0; m < 4; ++m) { bf16_t* rowp = Z + (size_t)(row0 + ai * 128 + m * 16) * NZ + col0;
#pragma unroll
                for (int bj = 0; bj < 2; ++bj) { f32x4 a = acc[ai][bj][m][0], b = acc[ai][bj][m][1];
                    if (act) { a = (f32x4){gelu_f(a[0]), gelu_f(a[1]), gelu_f(a[2]), gelu_f(a[3])}; b = (f32x4){gelu_f(b[0]), gelu_f(b[1]), gelu_f(b[2]), gelu_f(b[3])}; }
                    *(uint4*)(rowp + bj * 128) = make_uint4(pk_bf16(a[0], a[1]), pk_bf16(a[2], a[3]), pk_bf16(b[0], b[1]), pk_bf16(b[2], b[3])); }
                __builtin_amdgcn_sched_barrier(0); }
    }
};
struct EpiQ {
    static constexpr bool PERM = true, AFTER_DRAIN = false;
    bf16_t* Q;
    __device__ __forceinline__ void operator()(const f32x4 (&acc)[2][2][4][2], const pg8::Unit& u, int wr, int wc, int fr, int fq, int) const {
        const int row0 = u.pm * 256 + wr * 64 + fr, col0 = u.pn * 256 + wc * 32 + 8 * fq;
#pragma unroll
        for (int ai = 0; ai < 2; ++ai)
#pragma unroll
            for (int m = 0; m < 4; ++m) { bf16_t* rowp = Q + (size_t)(row0 + ai * 128 + m * 16) * 2048 + col0;
#pragma unroll
                for (int bj = 0; bj < 2; ++bj) { const f32x4 a = acc[ai][bj][m][0], b = acc[ai][bj][m][1];
                    *(uint4*)(rowp + bj * 128) = make_uint4(pk_bf16(a[0], a[1]), pk_bf16(a[2], a[3]), pk_bf16(b[0], b[1]), pk_bf16(b[2], b[3])); } }
    }
};
__device__ __forceinline__ float rstd512(const float* s, int row) {
    const float4 a = *(const float4*)(s + (size_t)row * 8), b = *(const float4*)(s + (size_t)row * 8 + 4);
    return rsqrtf(((a.x + a.y) + (a.z + a.w) + (b.x + b.y) + (b.z + b.w)) * (1.0f / 512.0f) + EPS);
}
struct MidY { const LAS float* tab; __device__ __forceinline__ float operator()(int ui, int r) const { return tab[(2 * ui) * 256 + r]; } };
struct EpiX {
    static constexpr bool PERM = true, AFTER_DRAIN = false;
    const float* xin32; bf16_t* XR; const LAS float* tab; const float* gate;
    __device__ __forceinline__ void operator()(const f32x4 (&acc)[2][2][4][2], const pg8::Unit& u, int wr, int wc, int fr, int fq, int ui) const {
        const int r0 = wr * 64 + fr, row0 = u.pm * 256 + r0, col0 = u.pn * 256 + wc * 32 + 8 * fq;
        const float* gp = gate + (size_t)((u.pm * 256) / SEQ) * 6144 + col0;
#pragma unroll
        for (int ai = 0; ai < 2; ++ai)
#pragma unroll
            for (int m = 0; m < 4; ++m) { const int row = row0 + ai * 128 + m * 16; const float rb = tab[(2 * ui + 1) * 256 + r0 + ai * 128 + m * 16];
#pragma unroll
                for (int bj = 0; bj < 2; ++bj) { const int col = col0 + bj * 128; const f32x4 a = acc[ai][bj][m][0], b = acc[ai][bj][m][1];
                    float x[8];
                    if (xin32) { const float4 x0 = *(const float4*)(xin32 + (size_t)row * D + col), x1 = *(const float4*)(xin32 + (size_t)row * D + col + 4);
                        x[0] = x0.x; x[1] = x0.y; x[2] = x0.z; x[3] = x0.w; x[4] = x1.x; x[5] = x1.y; x[6] = x1.z; x[7] = x1.w; }
                    else { const uint4 w = *(const uint4*)(XR + (size_t)row * D + col);
                        x[0] = bf2f(w.x & 0xffffu); x[1] = bf2f(w.x >> 16); x[2] = bf2f(w.y & 0xffffu); x[3] = bf2f(w.y >> 16); x[4] = bf2f(w.z & 0xffffu); x[5] = bf2f(w.z >> 16); x[6] = bf2f(w.w & 0xffffu); x[7] = bf2f(w.w >> 16); }
                    const float4 g0 = *(const float4*)(gp + bj * 128), g1 = *(const float4*)(gp + bj * 128 + 4);
                    *(uint4*)(XR + (size_t)row * D + col) = make_uint4(pk_bf16(x[0] + g0.x * rb * a[0], x[1] + g0.y * rb * a[1]), pk_bf16(x[2] + g0.z * rb * a[2], x[3] + g0.w * rb * a[3]),
                                                                       pk_bf16(x[4] + g1.x * rb * b[0], x[5] + g1.y * rb * b[1]), pk_bf16(x[6] + g1.z * rb * b[2], x[7] + g1.w * rb * b[3]));
                    __builtin_amdgcn_sched_barrier(0); } }
    }
};
__device__ void phase_gemm1(const Params& p, int l, char* smem512) {
    pg8::Gemm g; g.A = (const pg8::bf16_t*)(p.ws + OFF_H); g.Bt = (const pg8::bf16_t*)(p.ws + OFF_W1T) + (size_t)l * 2048 * 1024; g.M = T; g.N = NZ; g.K = D;
    int G_ = (int)gridDim.x, c_ = (int)blockIdx.x; asm volatile("" : "+s"(G_), "+s"(c_));
    pg8::StaticOrder S; S.init(T, NZ, G_, c_);
    EpiZ E; E.Z = (bf16_t*)(p.ws + OFF_Z);
    pg8::gemm_phase<EpiZ, pg8::StaticOrder, NoMid>((PG8_LAS unsigned char*)smem512, g, S, E, NoMid(), -1, nullptr);
}
__device__ void phase_gemm2(const Params& p, int l, char* smem512) {
    pg8::Gemm g; g.A = (const pg8::bf16_t*)(p.ws + OFF_Y); g.Bt = (const pg8::bf16_t*)(p.ws + OFF_W2T) + (size_t)l * 1024 * 1024; g.M = T; g.N = D; g.K = D;
    int G_ = (int)gridDim.x, c_ = (int)blockIdx.x; asm volatile("" : "+s"(G_), "+s"(c_));
    pg8::StaticOrder S; S.init(T, D, G_, c_);
    LAS float* tab = (LAS float*)((LAS char*)smem512 + pg8::STAGE_BYTES);
    {
        const float* ssa = (const float*)(p.ws + OFF_SSQA); const float* ssb = (const float*)(p.ws + OFF_SSQB);
        pg8::Unit u;
        int t0_ = threadIdx.x; asm volatile("" : "+v"(t0_));
#pragma nounroll
        for (int i = 0; i < 8 && S.next(i, u); ++i)
            for (int r = t0_; r < 256; r += 512) { const float ra = rstd512(ssa, u.pm * 256 + r), rb = rstd512(ssb, u.pm * 256 + r); tab[(2 * i) * 256 + r] = ra / rb; tab[(2 * i + 1) * 256 + r] = rb; }
        __syncthreads();
    }
    MidY MK; MK.tab = tab;
    EpiX E; E.xin32 = (l == 0) ? p.x : nullptr; E.XR = (bf16_t*)(p.ws + OFF_XR); E.tab = tab; E.gate = (const float*)(p.ws + OFF_MOD) + (size_t)l * NB * 6144 + 2 * D;
    pg8::gemm_phase<EpiX, pg8::StaticOrder, MidY>((PG8_LAS unsigned char*)smem512, g, S, E, MK, 8, nullptr);
}
__device__ void phase_gemm3(const Params& p, int l, char* smem512) {
    pg8::Gemm g; g.A = (const pg8::bf16_t*)(p.ws + OFF_H); g.Bt = (const pg8::bf16_t*)(p.ws + OFF_WQT) + (size_t)l * 2048 * 1024; g.M = T; g.N = 2048; g.K = D;
    int G_ = (int)gridDim.x, c_ = (int)blockIdx.x; asm volatile("" : "+s"(G_), "+s"(c_));
    pg8::StaticOrder S; S.init(T, 2048, G_, c_);
    EpiQ E; E.Q = (bf16_t*)(p.ws + OFF_Z);
    pg8::gemm_phase<EpiQ, pg8::StaticOrder, NoMid>((PG8_LAS unsigned char*)smem512, g, S, E, NoMid(), -1, nullptr);
}

constexpr int TP = 136;
__device__ __forceinline__ void stage_transposed(const bf16_t* __restrict__ base, size_t row_stride, bf16_t* dT) {
    const int tid = otid(), r = tid >> 2, part = tid & 3, ri = part >> 1, c0 = (part & 1) * 32;
    const uint4* src = (const uint4*)(base + (size_t)r * row_stride + ri * 64 + c0);
    uint4 v[4];
#pragma unroll
    for (int i = 0; i < 4; ++i) v[i] = src[i];
#pragma unroll
    for (int i = 0; i < 4; ++i) {
        const unsigned w[4] = {v[i].x, v[i].y, v[i].z, v[i].w};
#pragma unroll
        for (int j = 0; j < 4; ++j) {
            dT[(c0 + i * 8 + j * 2) * TP + ri * 64 + r] = (bf16_t)(w[j] & 0xffffu);
            dT[(c0 + i * 8 + j * 2 + 1) * TP + ri * 64 + r] = (bf16_t)(w[j] >> 16);
        }
    }
}

__device__ void gmlp_item(const Params& p, int l, int item, char* smem) {
    const int tid = otid(), lane = tid & 63, wid = tid >> 6, fr = lane & 15, fq = lane >> 4;
    const int h = item & 7, c = (item >> 3) & 31, b = item >> 8;
    const int tok0 = b * SEQ + c * 128;
    bf16_t* vnT = (bf16_t*)smem;
    const bf16_t* Z = (const bf16_t*)(p.ws + OFF_Z);
    {
        const int q = tid >> 1, half = tid & 1, d0 = half * 32;
        const uint4* src = (const uint4*)(Z + (size_t)(tok0 + q) * NZ + 512 + h * 64 + d0);
        float f[32];
#pragma unroll
        for (int i = 0; i < 4; ++i) { const uint4 v = src[i]; const unsigned w[4] = {v.x, v.y, v.z, v.w};
#pragma unroll
            for (int j = 0; j < 4; ++j) { f[i * 8 + j * 2] = bf2f(w[j] & 0xffffu); f[i * 8 + j * 2 + 1] = bf2f(w[j] >> 16); } }
        float s = 0.f;
#pragma unroll
        for (int i = 0; i < 32; ++i) s += f[i];
        s += __shfl_xor(s, 1);
        const float mean = s * (1.0f / 64.0f);
        float qv = 0.f;
#pragma unroll
        for (int i = 0; i < 32; ++i) { f[i] -= mean; qv += f[i] * f[i]; }
        qv += __shfl_xor(qv, 1);
        const float rstd = rsqrtf(qv * (1.0f / 64.0f) + EPS);
#pragma unroll
        for (int i = 0; i < 32; ++i) vnT[(d0 + i) * TP + q] = f2bf(f[i] * rstd);
    }
    __syncthreads();
    const bf16_t* Wsb = (const bf16_t*)(p.ws + OFF_WSB) + ((size_t)l * 8 + h) * 128 * 128;
    f32x4 acc[2][4];
#pragma unroll
    for (int i = 0; i < 2; ++i)
#pragma unroll
        for (int j = 0; j < 4; ++j) acc[i][j] = (f32x4){0.f, 0.f, 0.f, 0.f};
    const int p0 = wid * 32;
#pragma unroll
    for (int ks = 0; ks < 4; ++ks) {
        bf16x8 af[2], bfr[4];
#pragma unroll
        for (int i = 0; i < 2; ++i) af[i] = *(const bf16x8*)(Wsb + (size_t)(p0 + i * 16 + fr) * 128 + ks * 32 + fq * 8);
#pragma unroll
        for (int j = 0; j < 4; ++j) bfr[j] = *(const bf16x8*)(vnT + (j * 16 + fr) * TP + ks * 32 + fq * 8);
#pragma unroll
        for (int i = 0; i < 2; ++i)
#pragma unroll
            for (int j = 0; j < 4; ++j) acc[i][j] = MFMA16(bfr[j], af[i], acc[i][j]);
    }
    bf16_t* Y = (bf16_t*)(p.ws + OFF_Y);
    float* ssa = (float*)(p.ws + OFF_SSQA);
#pragma unroll
    for (int i = 0; i < 2; ++i) {
        const int pp = p0 + i * 16 + fr, tok = tok0 + pp;
        const float bsv = p.gmlp_bs[((size_t)l * 8 + h) * 128 + pp];
        float ss = 0.f;
#pragma unroll
        for (int j = 0; j < 4; ++j) {
            const int d = j * 16 + fq * 4;
            const uint2 uu = *(const uint2*)(Z + (size_t)tok * NZ + h * 64 + d);
            const float y0 = bf2f(uu.x & 0xffffu) * (acc[i][j][0] + bsv), y1 = bf2f(uu.x >> 16) * (acc[i][j][1] + bsv);
            const float y2 = bf2f(uu.y & 0xffffu) * (acc[i][j][2] + bsv), y3 = bf2f(uu.y >> 16) * (acc[i][j][3] + bsv);
            ss += y0 * y0 + y1 * y1 + y2 * y2 + y3 * y3;
            *(uint2*)(Y + (size_t)tok * D + h * 64 + d) = make_uint2(pk_bf16(y0, y1), pk_bf16(y2, y3));
        }
        ss += __shfl_xor(ss, 16); ss += __shfl_xor(ss, 32);
        if (fq == 0) ssa[(size_t)tok * 8 + h] = ss;
    }
    __syncthreads();
}

__device__ void ffta_item(const Params& p, int item, char* smem) {
    const int tid = otid(), lane = tid & 63, wid = tid >> 6, fr = lane & 15, fq = lane >> 4;
    const int bp = item & 63, g = (item >> 6) & 7, b = item >> 9;
    bf16_t* dT = (bf16_t*)smem;
    const bf16_t* Z = (const bf16_t*)(p.ws + OFF_Z);
    stage_transposed(Z + (size_t)(b * SEQ + bp) * NZ + 1024 + g * 128, (size_t)64 * NZ, dT);
    __syncthreads();
    const bf16_t* DA = (const bf16_t*)(p.ws + OFF_DA);
    f32x4 acc[2][4];
#pragma unroll
    for (int i = 0; i < 2; ++i)
#pragma unroll
        for (int j = 0; j < 4; ++j) acc[i][j] = (f32x4){0.f, 0.f, 0.f, 0.f};
#pragma unroll
    for (int ks = 0; ks < 4; ++ks) {
        bf16x8 af[2], bfr[4];
#pragma unroll
        for (int i = 0; i < 2; ++i) af[i] = *(const bf16x8*)(DA + (size_t)(i * 64 + wid * 16 + fr) * 128 + ks * 32 + fq * 8);
#pragma unroll
        for (int j = 0; j < 4; ++j) bfr[j] = *(const bf16x8*)(dT + (j * 16 + fr) * TP + ks * 32 + fq * 8);
#pragma unroll
        for (int i = 0; i < 2; ++i)
#pragma unroll
            for (int j = 0; j < 4; ++j) acc[i][j] = MFMA16(bfr[j], af[i], acc[i][j]);
    }
    const int k1 = wid * 16 + fr;
    const float2 cs = ((const float2*)(p.ws + OFF_TW))[bp * 64 + k1];
    bf16_t* Yb = (bf16_t*)(p.ws + OFF_H) + ((((size_t)(b * 8 + g) * 64 + k1) * 64 + bp) * 128);
#pragma unroll
    for (int j = 0; j < 4; ++j) {
        const int ch = j * 16 + fq * 4;
        float yr[4], yi[4];
#pragma unroll
        for (int e = 0; e < 4; ++e) { const float r = acc[0][j][e], im = acc[1][j][e]; yr[e] = r * cs.x + im * cs.y; yi[e] = im * cs.x - r * cs.y; }
        *(uint2*)(Yb + ch) = make_uint2(pk_bf16(yr[0], yr[1]), pk_bf16(yr[2], yr[3]));
        *(uint2*)(Yb + 64 + ch) = make_uint2(pk_bf16(yi[0], yi[1]), pk_bf16(yi[2], yi[3]));
    }
    __syncthreads();
}

__device__ void phase_mix(const Params& p, int l, char* smem, int bid, int nb) {
    for (int rd_ = 0; rd_ < ((2048 + 4096) + nb - 1) / nb; ++rd_) { const int item = min(bid + rd_ * nb, (2048 + 4096) - 1);
        if (item < 2048) gmlp_item(p, l, item, smem); else ffta_item(p, item - 2048, smem);
    }
}

__device__ void phase_fftb(const Params& p, int l, char* smem, int bid, int nb) {
    const int tid = otid(), lane = tid & 63, wid = tid >> 6, fr = lane & 15, fq = lane >> 4;
    bf16_t* dT = (bf16_t*)smem;
    const bf16_t* DB = (const bf16_t*)(p.ws + OFF_DB);
    bf16_t* Y = (bf16_t*)(p.ws + OFF_Y);
    float* ssb = (float*)(p.ws + OFF_SSQB);
    for (int rd_ = 0; rd_ < (4096 + nb - 1) / nb; ++rd_) { const int item = min(bid + rd_ * nb, 4096 - 1);
        const int k1 = item & 63, g = (item >> 6) & 7, b = item >> 9;
        stage_transposed((const bf16_t*)(p.ws + OFF_H) + (((size_t)(b * 8 + g) * 64 + k1) * 64) * 128, 128, dT);
        __syncthreads();
        f32x4 acc[4];
#pragma unroll
        for (int j = 0; j < 4; ++j) acc[j] = (f32x4){0.f, 0.f, 0.f, 0.f};
#pragma unroll
        for (int ks = 0; ks < 4; ++ks) {
            const bf16x8 af = *(const bf16x8*)(DB + (size_t)(wid * 16 + fr) * 128 + ks * 32 + fq * 8);
#pragma unroll
            for (int j = 0; j < 4; ++j) { const bf16x8 bfr = *(const bf16x8*)(dT + (j * 16 + fr) * TP + ks * 32 + fq * 8); acc[j] = MFMA16(bfr, af, acc[j]); }
        }
        const int k2 = wid * 16 + fr, tok = b * SEQ + k1 + 64 * k2;
        float ss = 0.f;
#pragma unroll
        for (int j = 0; j < 4; ++j) {
            const int ch = j * 16 + fq * 4;
            const float4 fb = *(const float4*)(p.fnet_b + ((size_t)l * 8 + g) * 64 + ch);
            const float y0 = acc[j][0] * (1.0f / 512.0f) + fb.x, y1 = acc[j][1] * (1.0f / 512.0f) + fb.y, y2 = acc[j][2] * (1.0f / 512.0f) + fb.z, y3 = acc[j][3] * (1.0f / 512.0f) + fb.w;
            ss += y0 * y0 + y1 * y1 + y2 * y2 + y3 * y3;
            *(uint2*)(Y + (size_t)tok * D + 512 + g * 64 + ch) = make_uint2(pk_bf16(y0, y1), pk_bf16(y2, y3));
        }
        ss += __shfl_xor(ss, 16); ss += __shfl_xor(ss, 32);
        if (fq == 0) ssb[(size_t)tok * 8 + g] = ss;
        __syncthreads();
    }
}

#define INS16(a, v) do { a[15] = med3i(a[14], a[15], v); a[14] = med3i(a[13], a[14], v); a[13] = med3i(a[12], a[13], v); a[12] = med3i(a[11], a[12], v); \
    a[11] = med3i(a[10], a[11], v); a[10] = med3i(a[9], a[10], v); a[9] = med3i(a[8], a[9], v); a[8] = med3i(a[7], a[8], v); a[7] = med3i(a[6], a[7], v); \
    a[6] = med3i(a[5], a[6], v); a[5] = med3i(a[4], a[5], v); a[4] = med3i(a[3], a[4], v); a[3] = med3i(a[2], a[3], v); a[2] = med3i(a[1], a[2], v); \
    a[1] = med3i(a[0], a[1], v); a[0] = max(a[0], v); } while (0)

template <int I, int J> struct CandLoop {
    static __device__ __forceinline__ void run(int (&a)[16], const float (&f1)[16], const float (&f2)[16]) {
        if constexpr ((I + 1) * (J + 1) <= 16) { const int key = (f2key(f1[I] + f2[J]) & ~255) | (I * 16 + J); INS16(a, key); }
        if constexpr (J + 1 < 16) CandLoop<I, J + 1>::run(a, f1, f2);
        else if constexpr (I + 1 < 16) CandLoop<I + 1, 0>::run(a, f1, f2);
    }
};

typedef _Float16 f16x2_t __attribute__((ext_vector_type(2)));
__device__ __forceinline__ unsigned pk_f16(float lo, float hi) { const f16x2_t v = {(_Float16)lo, (_Float16)hi}; return __builtin_bit_cast(unsigned, v); }
__device__ __forceinline__ int h2key(unsigned bits16) { const int b = (int)(short)bits16; return b ^ ((b >> 15) & 0x7fff); }
__device__ __forceinline__ float key2h(int k) { const int b = k ^ ((k >> 15) & 0x7fff); return (float)__builtin_bit_cast(_Float16, (unsigned short)(b & 0xffff)); }

__device__ void phase_topk(const Params& p, int l, char* smem, int bid, int nb) {
    const int tid = otid(), lane = tid & 63, wid = tid >> 6, fr = lane & 15, fq = lane >> 4;
    unsigned* S32 = (unsigned*)smem;
    int* TT = (int*)smem;
    const bf16_t* Q = (const bf16_t*)(p.ws + OFF_Z);
    int* eidx = (int*)(p.ws + OFF_Y); float* gw = (float*)(p.ws + OFF_Y + (size_t)T * 128 * 4);
    const int hh = wid >> 1, half = wid & 1;
    for (int rd_ = 0; rd_ < (((T / 64) * 4) + nb - 1) / nb; ++rd_) { const int item = min(bid + rd_ * nb, ((T / 64) * 4) - 1);
        const int hp = item & 3, tok0 = (item >> 2) * 64, h = hp * 2 + hh;
        const bf16_t* Kh = (const bf16_t*)(p.ws + OFF_K12) + (((size_t)l * 8 + h) * 256 + half * 128) * 128;
        const bf16_t* Qh = Q + (size_t)tok0 * 2048 + h * 256 + half * 128;
        {
            f32x4 acc[4][8];
#pragma unroll
            for (int i = 0; i < 4; ++i)
#pragma unroll
                for (int j = 0; j < 8; ++j) acc[i][j] = (f32x4){0.f, 0.f, 0.f, 0.f};
#pragma unroll
            for (int ks = 0; ks < 4; ++ks) {
                bf16x8 af[4];
#pragma unroll
                for (int i = 0; i < 4; ++i) af[i] = *(const bf16x8*)(Qh + (size_t)(i * 16 + fr) * 2048 + ks * 32 + fq * 8);
#pragma unroll
                for (int jh = 0; jh < 2; ++jh) {
                    bf16x8 bfr[4];
#pragma unroll
                    for (int j = 0; j < 4; ++j) bfr[j] = *(const bf16x8*)(Kh + (size_t)((jh * 4 + j) * 16 + fr) * 128 + ks * 32 + fq * 8);
#pragma unroll
                    for (int i = 0; i < 4; ++i)
#pragma unroll
                        for (int j = 0; j < 4; ++j) acc[i][jh * 4 + j] = MFMA16(bfr[j], af[i], acc[i][jh * 4 + j]);
                    __builtin_amdgcn_sched_barrier(0);
                }
            }
#pragma unroll
            for (int i = 0; i < 4; ++i)
#pragma unroll
                for (int j = 0; j < 8; ++j) {
                    unsigned* d = S32 + (i * 16 + fr) * 257 + hh * 128 + half * 64 + j * 8 + fq * 2;
                    d[0] = pk_f16(acc[i][j][0], acc[i][j][1]); d[1] = pk_f16(acc[i][j][2], acc[i][j][3]);
                }
        }
        vsync(smem);
        int a[16];
#pragma unroll
        for (int i = 0; i < 16; ++i) a[i] = (int)0x80000000;
        {
            const unsigned* sr = S32 + lane * 257 + hh * 128 + half * 64;
#pragma unroll 2
            for (int i = 0; i < 64; ++i) {
                const unsigned w = sr[i];
                const int k0 = (h2key(w & 0xffffu) << 7) | (2 * i), k1 = (h2key(w >> 16) << 7) | (2 * i + 1);
                INS16(a, k0); INS16(a, k1);
            }
        }
        vsync(smem);
#pragma unroll
        for (int i = 0; i < 16; ++i) TT[((lane * 2 + hh) * 2 + half) * 16 + i] = a[i];
        vsync(smem);
        if (tid < 128) {
            const int tk = tid & 63, h2 = tid >> 6, hd = hp * 2 + h2;
            const int* t1 = TT + ((tk * 2 + h2) * 2) * 16; const int* t2 = t1 + 16;
            float f1[16], f2[16];
#pragma unroll
            for (int i = 0; i < 16; ++i) { f1[i] = key2h(t1[i] >> 7); f2[i] = key2h(t2[i] >> 7); }
            int c[16];
#pragma unroll
            for (int i = 0; i < 16; ++i) c[i] = (int)0x80000000;
            CandLoop<0, 0>::run(c, f1, f2);
            float sc[16], e[16], sum = 0.f; int ex[16];
#pragma unroll
            for (int i = 0; i < 16; ++i) {
                sc[i] = key2f(c[i] & ~255);
                const int code = c[i] & 255;
                ex[i] = (t1[code >> 4] & 127) * 128 + (t2[code & 15] & 127);
            }
#pragma unroll
            for (int i = 0; i < 16; ++i) { e[i] = __expf(sc[i] - sc[0]); sum += e[i]; }
            const float inv = 1.0f / sum;
            int4* ep = (int4*)(eidx + (size_t)(tok0 + tk) * 128 + hd * 16); float4* gp = (float4*)(gw + (size_t)(tok0 + tk) * 128 + hd * 16);
#pragma unroll
            for (int i = 0; i < 4; ++i) { ep[i] = make_int4(ex[4 * i], ex[4 * i + 1], ex[4 * i + 2], ex[4 * i + 3]); gp[i] = make_float4(e[4 * i] * inv, e[4 * i + 1] * inv, e[4 * i + 2] * inv, e[4 * i + 3] * inv); }
        }
        vsync(smem);
    }
}

__device__ __forceinline__ float dot16_fp8(const float (&h)[16], const int4& u) {
    const int w[4] = {u.x, u.y, u.z, u.w};
    f32x2_t a = {0.f, 0.f};
#pragma unroll
    for (int i = 0; i < 4; ++i) {
        const f32x2_t lo = __builtin_amdgcn_cvt_pk_f32_fp8(w[i], false), hi = __builtin_amdgcn_cvt_pk_f32_fp8(w[i], true);
        const f32x2_t h0 = {h[4 * i], h[4 * i + 1]}, h1 = {h[4 * i + 2], h[4 * i + 3]};
        a = __builtin_elementwise_fma(lo, h0, a); a = __builtin_elementwise_fma(hi, h1, a);
    }
    return a.x + a.y;
}
__device__ __forceinline__ void axpy16_fp8(float (&o)[16], float c, const int4& v) {
    const int w[4] = {v.x, v.y, v.z, v.w};
#pragma unroll
    for (int i = 0; i < 4; ++i) {
        const f32x2_t lo = __builtin_amdgcn_cvt_pk_f32_fp8(w[i], false), hi = __builtin_amdgcn_cvt_pk_f32_fp8(w[i], true);
        o[4 * i] += c * lo.x; o[4 * i + 1] += c * lo.y; o[4 * i + 2] += c * hi.x; o[4 * i + 3] += c * hi.y;
    }
}

typedef _Float16 h2_t __attribute__((ext_vector_type(2)));
__device__ __forceinline__ float dot32_fp4(const h2_t (&h)[16], const int4& u) {
    const unsigned w[4] = {(unsigned)u.x, (unsigned)u.y, (unsigned)u.z, (unsigned)u.w};
    float a0 = 0.f, a1 = 0.f;
#pragma unroll
    for (int i = 0; i < 4; ++i) {
        a0 = __builtin_amdgcn_fdot2(__builtin_bit_cast(h2_t, __builtin_amdgcn_cvt_scalef32_pk_f16_fp4(w[i], 1.0f, 0)), h[4 * i], a0, false);
        a1 = __builtin_amdgcn_fdot2(__builtin_bit_cast(h2_t, __builtin_amdgcn_cvt_scalef32_pk_f16_fp4(w[i], 1.0f, 1)), h[4 * i + 1], a1, false);
        a0 = __builtin_amdgcn_fdot2(__builtin_bit_cast(h2_t, __builtin_amdgcn_cvt_scalef32_pk_f16_fp4(w[i], 1.0f, 2)), h[4 * i + 2], a0, false);
        a1 = __builtin_amdgcn_fdot2(__builtin_bit_cast(h2_t, __builtin_amdgcn_cvt_scalef32_pk_f16_fp4(w[i], 1.0f, 3)), h[4 * i + 3], a1, false);
    }
    return a0 + a1;
}
typedef int v8i_t __attribute__((ext_vector_type(8)));
typedef int i32x4_t __attribute__((ext_vector_type(4)));
typedef int i32x2_t __attribute__((ext_vector_type(2)));
constexpr float PU_XS = 4.0f;
constexpr int PU_WAVE_LDS = 16384 + 2048;
__device__ __forceinline__ void glds16(const void* g, unsigned lds_addr) {
    unsigned sv_;
    asm volatile("s_mov_b32 %0, m0\n\ts_mov_b32 m0, %2\n\ts_nop 0\n\tglobal_load_lds_dwordx4 %1, off\n\ts_mov_b32 m0, %0" : "=&s"(sv_) : "v"(g), "s"(lds_addr) : "memory");
}
__device__ void phase_pu(const Params& p, int l, int slice, int grank_base, int gsz, char* smem512) {
    int tid_ = threadIdx.x; asm volatile("" : "+v"(tid_));
    asm volatile("" : "+s"(slice), "+s"(grank_base), "+s"(gsz));
    const int lane = tid_ & 63, wid = __builtin_amdgcn_readfirstlane(tid_ >> 6), n16 = lane & 15, q4 = lane >> 4;
    const char* U4 = p.ws + OFF_UB + ((size_t)(l * 4 + slice) * NE) * 128 + 16 * ((lane & 7) ^ (lane >> 3));
    const char* msrc = lane < 32 ? (p.ws + OFF_Y + 16 * lane) : (p.ws + OFF_H + (size_t)slice * 512 + 16 * (lane - 32));
    const size_t mstep = lane < 32 ? 512 : 2048;
    float* part = (float*)(p.ws + OFF_Z) + (size_t)slice * T * 128 + 16 * q4 + n16;
    const int stride = gsz * 4;
    LAS char* wl = (LAS char*)smem512 + wid * PU_WAVE_LDS;
    const unsigned wla = (unsigned)(size_t)wl;
    const int boff = n16 * 128 + 16 * (q4 ^ (n16 & 7));
    const int ioff = 4 * (lane >> 3);
#define PU_META(tok_, mb_) glds16(msrc + (size_t)(tok_) * mstep, wla + 16384u + (unsigned)(mb_))
#define PU_IDS(id_, mb_, h_) do { _Pragma("unroll") for (int i_ = 0; i_ < 8; ++i_) id_[i_] = *(const LAS int*)(wl + 16384 + (mb_) + 256 * (h_) + ioff + 32 * i_); } while (0)
#define PU_DMA(id_, h_) do { _Pragma("unroll") for (int i_ = 0; i_ < 8; ++i_) glds16(U4 + (size_t)id_[i_] * 128, wla + (unsigned)((h_) * 8192 + i_ * 1024)); } while (0)
#define PU_HALF(h_) do { i32x4_t b0_[4], b1_[4]; \
        _Pragma("unroll") for (int m_ = 0; m_ < 4; ++m_) { b0_[m_] = *(const LAS i32x4_t*)(wl + (h_) * 8192 + m_ * 2048 + boff); b1_[m_] = *(const LAS i32x4_t*)(wl + (h_) * 8192 + m_ * 2048 + (boff ^ 64)); } \
        _Pragma("unroll") for (int m_ = 0; m_ < 4; ++m_) { \
        const v8i_t B0 = {b0_[m_][0], b0_[m_][1], b0_[m_][2], b0_[m_][3], 0, 0, 0, 0}, B1 = {b1_[m_][0], b1_[m_][1], b1_[m_][2], b1_[m_][3], 0, 0, 0, 0}; \
        acc[(h_) * 4 + m_] = __builtin_amdgcn_mfma_scale_f32_16x16x128_f8f6f4(A0, B0, acc[(h_) * 4 + m_], 0, 4, 0, 0, 0, 0); \
        acc[(h_) * 4 + m_] = __builtin_amdgcn_mfma_scale_f32_16x16x128_f8f6f4(A1, B1, acc[(h_) * 4 + m_], 0, 4, 0, 0, 0, 0); } } while (0)
    const int tok0 = grank_base * 4 + wid;
    if (tok0 >= T) return;
    const int nit = (T - tok0 + stride - 1) / stride;
    int tok = tok0, tok1 = min(tok0 + stride, T - 1);
    int idA[8], idB[8];
    PU_META(tok, 0); PU_META(tok1, 1024);
    asm volatile("s_waitcnt vmcnt(0)" ::: "memory");
    PU_IDS(idA, 0, 0); PU_IDS(idB, 0, 1);
    PU_DMA(idA, 0);
#pragma nounroll
    for (int it = 0; it < nit; ++it) {
        const int mbc = (it & 1) * 1024, mbn = 1024 - mbc;
        __builtin_amdgcn_sched_barrier(0);
        PU_DMA(idB, 1);
        asm volatile("s_waitcnt vmcnt(8)" ::: "memory");
        __builtin_amdgcn_sched_barrier(0);
        { const i32x2_t xr = *(const LAS i32x2_t*)(wl + 16384 + mbc + 512 + 8 * lane);
          const float f0 = fminf(fmaxf(bf2f((unsigned)xr[0] & 0xffffu) * PU_XS, -448.f), 448.f), f1 = fminf(fmaxf(bf2f((unsigned)xr[0] >> 16) * PU_XS, -448.f), 448.f),
                      f2 = fminf(fmaxf(bf2f((unsigned)xr[1] & 0xffffu) * PU_XS, -448.f), 448.f), f3 = fminf(fmaxf(bf2f((unsigned)xr[1] >> 16) * PU_XS, -448.f), 448.f);
          int w = __builtin_amdgcn_cvt_pk_fp8_f32(f0, f1, 0, false); w = __builtin_amdgcn_cvt_pk_fp8_f32(f2, f3, w, true);
          *(LAS int*)(wl + 16384 + mbc + 512 + 4 * lane) = w; }
        PU_IDS(idA, mbn, 0);
        asm volatile("s_waitcnt lgkmcnt(0)" ::: "memory");
        const LAS char* xb = wl + 16384 + mbc + 512 + 16 * q4;
        const i32x4_t a00 = *(const LAS i32x4_t*)(xb), a01 = *(const LAS i32x4_t*)(xb + 64), a10 = *(const LAS i32x4_t*)(xb + 128), a11 = *(const LAS i32x4_t*)(xb + 192);
        const v8i_t A0 = {a00[0], a00[1], a00[2], a00[3], a01[0], a01[1], a01[2], a01[3]}, A1 = {a10[0], a10[1], a10[2], a10[3], a11[0], a11[1], a11[2], a11[3]};
        f32x4 acc[8];
#pragma unroll
        for (int m = 0; m < 8; ++m) acc[m] = (f32x4){0.f, 0.f, 0.f, 0.f};
        PU_HALF(0);
        asm volatile("s_waitcnt lgkmcnt(0)" ::: "memory");
        __builtin_amdgcn_sched_barrier(0);
        const int tok2 = min(tok1 + stride, T - 1);
        PU_DMA(idA, 0);
        PU_META(tok2, mbc);
        asm volatile("s_waitcnt vmcnt(9)" ::: "memory");
        __builtin_amdgcn_sched_barrier(0);
        PU_IDS(idB, mbn, 1);
        PU_HALF(1);
        __builtin_amdgcn_sched_barrier(0);
        float s0 = acc[0][0], s1 = acc[4][0];
        s0 = q4 == 1 ? acc[1][0] : s0; s1 = q4 == 1 ? acc[5][0] : s1;
        s0 = q4 == 2 ? acc[2][0] : s0; s1 = q4 == 2 ? acc[6][0] : s1;
        s0 = q4 == 3 ? acc[3][0] : s0; s1 = q4 == 3 ? acc[7][0] : s1;
        float* pr = part + (size_t)tok * 128;
        pr[0] = s0 * (1.0f / PU_XS); pr[64] = s1 * (1.0f / PU_XS);
        tok = tok1; tok1 = tok2;
    }
    asm volatile("s_waitcnt vmcnt(0)" ::: "memory");
#undef PU_META
#undef PU_IDS
#undef PU_DMA
#undef PU_HALF
}
__device__ void phase_pc(const Params& p, int l, int bid, int nb) {
    const int tid_ = otid(); const int lane = tid_ & 63, wid = tid_ >> 6;
    const int* eidx = (const int*)(p.ws + OFF_Y); const float* gw = (const float*)(p.ws + OFF_Y + (size_t)T * 128 * 4);
    unsigned char* crec = (unsigned char*)(p.ws + OFF_Y + (size_t)T * 128 * 8);
    const float* part = (const float*)(p.ws + OFF_Z);
    const float* usc = (const float*)(p.ws + OFF_USC) + (size_t)l * NE; const float* vsc = (const float*)(p.ws + OFF_VSC) + (size_t)l * NE;
    constexpr int NU = 2;
    for (int tok0 = bid * 4 + wid; tok0 < T; tok0 += nb * 4 * NU) {
        int tk[NU]; bool ok[NU];
#pragma unroll
        for (int u = 0; u < NU; ++u) { ok[u] = tok0 + u * nb * 4 < T; tk[u] = ok[u] ? tok0 + u * nb * 4 : tok0; }
        int e[NU][2]; float g[NU][2], a[NU][2][4];
#pragma unroll
        for (int u = 0; u < NU; ++u)
#pragma unroll
            for (int hh = 0; hh < 2; ++hh) { const size_t j = (size_t)tk[u] * 128 + hh * 64 + lane; e[u][hh] = eidx[j]; g[u][hh] = gw[j];
#pragma unroll
                for (int sl = 0; sl < 4; ++sl) a[u][hh][sl] = part[(size_t)sl * T * 128 + j]; }
        float us[NU][2], vs[NU][2];
#pragma unroll
        for (int u = 0; u < NU; ++u)
#pragma unroll
            for (int hh = 0; hh < 2; ++hh) { us[u][hh] = usc[e[u][hh]]; vs[u][hh] = vsc[e[u][hh]]; }
#pragma unroll
        for (int u = 0; u < NU; ++u) {
            float c[2];
#pragma unroll
            for (int hh = 0; hh < 2; ++hh) c[hh] = g[u][hh] * gelu_f(((a[u][hh][0] + a[u][hh][1]) + (a[u][hh][2] + a[u][hh][3])) * us[u][hh]) * vs[u][hh];
            float m = fmaxf(fabsf(c[0]), fabsf(c[1]));
#pragma unroll
            for (int o = 32; o >= 1; o >>= 1) m = fmaxf(m, __shfl_xor(m, o));
            const float S = (m > 1e-30f) ? 256.0f / m : 1.0f;
            unsigned char* rec = crec + (size_t)tk[u] * 512;
#pragma unroll
            for (int hh = 0; hh < 2; ++hh) {
                const float cs = c[hh] * S;
                const int hi = __builtin_amdgcn_cvt_pk_fp8_f32(cs, 0.f, 0, false) & 0xff;
                const float r = (cs - __builtin_amdgcn_cvt_f32_fp8(hi, 0)) * 16.0f;
                const int lo = __builtin_amdgcn_cvt_pk_fp8_f32(r, 0.f, 0, false) & 0xff;
                if (ok[u]) { rec[hh * 64 + lane] = (unsigned char)hi; rec[128 + hh * 64 + lane] = (unsigned char)lo; }
            }
            if (lane == 0 && ok[u]) *(float*)(rec + 256) = 1.0f / S;
        }
    }
}
__device__ void phase_pv(const Params& p, int l, int slice, int grank_base, int gsz, char* smem512) {
    int tid_ = threadIdx.x; asm volatile("" : "+v"(tid_));
    asm volatile("" : "+s"(slice), "+s"(grank_base), "+s"(gsz));
    const int lane = tid_ & 63, wid = __builtin_amdgcn_readfirstlane(tid_ >> 6), n16 = lane & 15, q4 = lane >> 4;
    const char* V4e = p.ws + OFF_VB + ((size_t)(l * 4 + slice) * NE) * 128 + 16 * ((lane & 7) ^ (lane >> 4));
    const char* V4o = p.ws + OFF_VB + ((size_t)(l * 4 + slice) * NE) * 128 + 16 * ((lane & 7) ^ (lane >> 4) ^ 4);
    const char* msrc = lane < 32 ? (p.ws + OFF_Y + 16 * lane) : (p.ws + OFF_Y + (size_t)T * 128 * 8 + 16 * (lane - 32));
    bf16_t* Sout = (bf16_t*)(p.ws + OFF_Z) + slice * 256 + 4 * lane;
    const int stride = gsz * 4;
    LAS char* wl = (LAS char*)smem512 + wid * PU_WAVE_LDS;
    const unsigned wla = (unsigned)(size_t)wl;
    const int ioff = 4 * (lane >> 3);
    const int rowb = (q4 >> 1) * 8192 + (32 * (q4 & 1) + n16) * 128;
    int vad[8];
#pragma unroll
    for (int jj = 0; jj < 8; ++jj) vad[jj] = rowb + ((16 * jj) ^ (16 * (n16 >> 1)));
    const int aoff = 16384 + 512 + 128 * (n16 & 1) + 16 * q4;
#define PV_META(tok_, mb_) glds16(msrc + (size_t)(tok_) * 512, wla + 16384u + (unsigned)(mb_))
#define PV_IDS(id_, mb_) do { _Pragma("unroll") for (int i_ = 0; i_ < 16; ++i_) id_[i_] = *(const LAS int*)(wl + 16384 + (mb_) + ioff + 32 * i_); } while (0)
#define PV_DMA(id_) do { _Pragma("unroll") for (int i_ = 0; i_ < 16; ++i_) glds16(((i_ & 1) ? V4o : V4e) + (size_t)id_[i_] * 128, wla + (unsigned)(i_ * 1024)); } while (0)
    const int tok0 = grank_base * 4 + wid;
    if (tok0 >= T) return;
    const int nit = (T - tok0 + stride - 1) / stride;
    int tok = tok0, tok1 = min(tok0 + stride, T - 1);
    int idv[16];
    PV_META(tok, 0);
    asm volatile("s_waitcnt vmcnt(0)" ::: "memory");
    PV_IDS(idv, 0);
    asm volatile("s_waitcnt lgkmcnt(0)" ::: "memory");
    PV_DMA(idv);
    PV_META(tok1, 1024);
#pragma nounroll
    for (int it = 0; it < nit; ++it) {
        const int mbc = (it & 1) * 1024, mbn = 1024 - mbc;
        __builtin_amdgcn_sched_barrier(0);
        asm volatile("s_waitcnt vmcnt(1)" ::: "memory");
        __builtin_amdgcn_sched_barrier(0);
        const i32x4_t a0 = *(const LAS i32x4_t*)(wl + mbc + aoff), a1 = *(const LAS i32x4_t*)(wl + mbc + aoff + 64);
        const float invS = *(const LAS float*)(wl + 16384 + mbc + 512 + 256);
        const v8i_t A = {a0[0], a0[1], a0[2], a0[3], a1[0], a1[1], a1[2], a1[3]};
        i32x2_t bt[16][2];
#pragma unroll
        for (int j = 0; j < 16; ++j) {
            bt[j][0] = __builtin_amdgcn_ds_read_tr4_b64_v2i32((LAS i32x2_t*)(wl + vad[j >> 1] + 8 * (j & 1)));
            bt[j][1] = __builtin_amdgcn_ds_read_tr4_b64_v2i32((LAS i32x2_t*)(wl + vad[j >> 1] + 8 * (j & 1) + 2048));
        }
        asm volatile("s_waitcnt vmcnt(0)" ::: "memory");
        PV_IDS(idv, mbn);
        asm volatile("s_waitcnt lgkmcnt(0)" ::: "memory");
        __builtin_amdgcn_sched_barrier(0);
        PV_DMA(idv);
        __builtin_amdgcn_sched_barrier(0);
        f32x4 acc[16];
#pragma unroll
        for (int j = 0; j < 16; ++j) {
            const v8i_t B = {bt[j][0][0], bt[j][0][1], bt[j][1][0], bt[j][1][1], 0, 0, 0, 0};
            acc[j] = __builtin_amdgcn_mfma_scale_f32_16x16x128_f8f6f4(A, B, (f32x4){0.f, 0.f, 0.f, 0.f}, 0, 4, 0, 0, 0, 0);
        }
        float v0 = acc[0][0] + acc[0][1] * 0.0625f, v1 = acc[1][0] + acc[1][1] * 0.0625f, v2 = acc[2][0] + acc[2][1] * 0.0625f, v3 = acc[3][0] + acc[3][1] * 0.0625f;
#pragma unroll
        for (int qq = 1; qq < 4; ++qq) {
            v0 = q4 == qq ? acc[4 * qq][0] + acc[4 * qq][1] * 0.0625f : v0; v1 = q4 == qq ? acc[4 * qq + 1][0] + acc[4 * qq + 1][1] * 0.0625f : v1;
            v2 = q4 == qq ? acc[4 * qq + 2][0] + acc[4 * qq + 2][1] * 0.0625f : v2; v3 = q4 == qq ? acc[4 * qq + 3][0] + acc[4 * qq + 3][1] * 0.0625f : v3;
        }
        LAS float* tb = (LAS float*)(wl + 16384 + mbc);
        tb[64 * q4 + n16] = v0; tb[64 * q4 + 16 + n16] = v1; tb[64 * q4 + 32 + n16] = v2; tb[64 * q4 + 48 + n16] = v3;
        asm volatile("s_waitcnt lgkmcnt(0)" ::: "memory");
        const f32x4 o = *(const LAS f32x4*)(tb + 4 * lane);
        *(uint2*)(Sout + (size_t)tok * D) = make_uint2(pk_bf16(o[0] * invS, o[1] * invS), pk_bf16(o[2] * invS, o[3] * invS));
        asm volatile("s_waitcnt lgkmcnt(0)" ::: "memory");
        __builtin_amdgcn_sched_barrier(0);
        const int tok2 = min(tok1 + stride, T - 1);
        PV_META(tok2, mbc);
        tok = tok1; tok1 = tok2;
    }
    asm volatile("s_waitcnt vmcnt(0)" ::: "memory");
#undef PV_META
#undef PV_IDS
#undef PV_DMA
}
__device__ void phase_final_norm(const Params& p, int bid, int nb) {
    const int tid_ = otid(); const int lane = tid_ & 63, wid = tid_ >> 6;
    const bf16_t* sadd = (const bf16_t*)(p.ws + OFF_Z); const float* g2l = (const float*)(p.ws + OFF_MOD) + (size_t)(NL - 1) * NB * 6144 + 5 * D;
    constexpr int NU = 2;
    for (int tok0 = bid * 4 + wid; tok0 < T; tok0 += nb * 4 * NU) {
        int tk[NU]; bool ok[NU];
#pragma unroll
        for (int u = 0; u < NU; ++u) { ok[u] = tok0 + u * nb * 4 < T; tk[u] = ok[u] ? tok0 + u * nb * 4 : tok0; }
        uint2 xw[NU][4], sw[NU][4]; float4 g2[NU][4];
#pragma unroll
        for (int u = 0; u < NU; ++u)
#pragma unroll
            for (int i = 0; i < 4; ++i) { const size_t o = (size_t)tk[u] * D + i * 256 + lane * 4;
                xw[u][i] = *(const uint2*)((const bf16_t*)(p.ws + OFF_XR) + o); sw[u][i] = *(const uint2*)(sadd + o); g2[u][i] = *(const float4*)(g2l + (size_t)(tk[u] / SEQ) * 6144 + i * 256 + lane * 4); }
#pragma unroll
        for (int u = 0; u < NU; ++u) {
            float4 v[4]; float ss = 0.f;
#pragma unroll
            for (int i = 0; i < 4; ++i) { const uint2 w = xw[u][i], s_ = sw[u][i]; const float4 g_ = g2[u][i];
                v[i] = make_float4(bf2f(w.x & 0xffffu) + g_.x * bf2f(s_.x & 0xffffu), bf2f(w.x >> 16) + g_.y * bf2f(s_.x >> 16), bf2f(w.y & 0xffffu) + g_.z * bf2f(s_.y & 0xffffu), bf2f(w.y >> 16) + g_.w * bf2f(s_.y >> 16));
                ss += v[i].x * v[i].x + v[i].y * v[i].y + v[i].z * v[i].z + v[i].w * v[i].w; }
            const float rstd = rsqrtf(wave_sum(ss) * (1.0f / D) + EPS);
            float* xr = p.out + (size_t)tk[u] * D;
#pragma unroll
            for (int i = 0; i < 4; ++i) { const float4 g = *(const float4*)(p.final_g + i * 256 + lane * 4);
                if (ok[u]) *(float4*)(xr + i * 256 + lane * 4) = make_float4(v[i].x * rstd * g.x, v[i].y * rstd * g.y, v[i].z * rstd * g.z, v[i].w * rstd * g.w); }
        }
    }
}

#define XB_TMO      128
#define XB_XCNT(j)  (256  + 64 * (j))
#define XB_XSUB(j)  (1280 + 64 * (j))
#define XB_XGEN(j)  (2304 + 64 * (j))
#define XB_TOP      3328
#define XB_TOPGEN   3392
#define XCD_BAR_WORDS 3456
#define XB_SPIN_CAP (1u << 22)
__device__ __forceinline__ unsigned xb_ld(unsigned* p)              { return __hip_atomic_load(p, __ATOMIC_RELAXED, __HIP_MEMORY_SCOPE_AGENT); }
__device__ __forceinline__ unsigned xb_add(unsigned* p, unsigned v) { return __hip_atomic_fetch_add(p, v, __ATOMIC_RELAXED, __HIP_MEMORY_SCOPE_AGENT); }
__device__ __forceinline__ unsigned xb_xcc_id() { return (unsigned)__builtin_amdgcn_s_getreg((3 << 11) | 20) & 0xFu; }
#define XB_SPIN(cond, bar) do { unsigned _sp = 0; while (cond) { __builtin_amdgcn_s_sleep(1); \
    if ((++_sp & 255u) == 0u) { if (xb_ld(&(bar)[XB_TMO])) break; if (_sp > XB_SPIN_CAP) { atomicAdd(&(bar)[XB_TMO], 1u); break; } } } } while (0)
__device__ __forceinline__ void xcd_barrier_post(unsigned* bar, volatile LAS unsigned* st) {
    if (threadIdx.x == 0) { const unsigned x = xb_xcc_id(); st[3] = x; st[2] = xb_add(&bar[XB_XCNT(x)], 1u); }
}
__device__ __forceinline__ void xcd_barrier_complete(unsigned* bar, unsigned x, unsigned& nloc, unsigned& nx) {
    const unsigned G = gridDim.x * gridDim.y * gridDim.z;
    unsigned sum, cnt, mine, sp = 0u;
    for (;;) {
        sum = 0u; cnt = 0u; mine = 0u;
#pragma unroll
        for (unsigned j = 0; j < 16; ++j) { const unsigned c = xb_ld(&bar[XB_XCNT(j)]); sum += c; cnt += (c > 0u) ? 1u : 0u; mine = (j == x) ? c : mine; }
        if (sum == G) break;
        __builtin_amdgcn_s_sleep(1);
        if ((++sp & 255u) == 0u) { if (xb_ld(&bar[XB_TMO])) break; if (sp > XB_SPIN_CAP) { atomicAdd(&bar[XB_TMO], 1u); break; } }
    }
    nloc = mine > 0u ? mine : 1u; nx = cnt > 0u ? cnt : 1u;
}
__device__ __forceinline__ void xcd_barrier(unsigned* bar, volatile LAS unsigned* st) {
    asm volatile("s_waitcnt vmcnt(0)" ::: "memory");
    __syncthreads();
    int t0_ = threadIdx.x; asm volatile("" : "+v"(t0_));
    if (t0_ == 0) {
        __builtin_amdgcn_s_waitcnt(0);
        unsigned nloc = st[0], nx = st[1]; const unsigned x = st[3];
        if (nloc == 0u) { xcd_barrier_complete(bar, x, nloc, nx); st[0] = nloc; st[1] = nx; }
        const unsigned old = xb_add(&bar[XB_XSUB(x)], 1u);
        const unsigned gen = old / nloc;
        if (old + 1u == (gen + 1u) * nloc) {
            __builtin_amdgcn_fence(__ATOMIC_RELEASE, "agent");
            asm volatile("s_waitcnt vmcnt(0)" ::: "memory");
            const unsigned og = xb_add(&bar[XB_TOP], 1u);
            const unsigned tg = og / nx;
            if (og + 1u == (tg + 1u) * nx) xb_add(&bar[XB_TOPGEN], 1u);
            else XB_SPIN(xb_ld(&bar[XB_TOPGEN]) == tg, bar);
            __builtin_amdgcn_fence(__ATOMIC_ACQUIRE, "agent");
            xb_add(&bar[XB_XGEN(x)], 1u);
            asm volatile("s_waitcnt vmcnt(0)" ::: "memory");
        } else {
            XB_SPIN(xb_ld(&bar[XB_XGEN(x)]) == gen, bar);
            __builtin_amdgcn_fence(__ATOMIC_ACQUIRE, "agent");
            asm volatile("s_waitcnt vmcnt(0)" ::: "memory");
        }
    }
    __syncthreads();
}

#if MEGA
#if PROBE_A >= 0
#define TSTAMP(i) do { if (blockIdx.x == 0 && threadIdx.x == 0) ts[i] = __builtin_amdgcn_s_memrealtime(); } while (0)
#else
#define TSTAMP(i) do { } while (0)
#endif
__global__ void __launch_bounds__(512, 2) mega_kernel(Params p) {
    __shared__ __attribute__((aligned(16))) char smem[2 * SMEM_BYTES + 32];
#if PROBE_A >= 0
    __shared__ unsigned long long ts[26];
#endif
#if COOP
    cg::grid_group grid = cg::this_grid();
#endif
    const int vb = threadIdx.x >> 8;
    const int bid = blockIdx.x * 2 + vb, nb = gridDim.x * 2;
    char* smv = smem + vb * SMEM_BYTES;
    unsigned* bar = (unsigned*)(p.ws + OFF_BAR);
    volatile LAS unsigned* xst = (volatile LAS unsigned*)(smem + 2 * SMEM_BYTES);
#define GBAR() xcd_barrier((unsigned*)(p.ws + OFF_BAR), (volatile LAS unsigned*)(smem + 2 * SMEM_BYTES))
    if (threadIdx.x == 0) { xst[0] = 0u; xst[1] = 0u; xst[2] = 0u; xst[3] = 0u; xst[4] = 0u; xst[5] = 0u; }
    __syncthreads();
#if COOP
    if (blockIdx.x == 0) for (int i = threadIdx.x; i < XCD_BAR_WORDS; i += 512) bar[i] = 0u;
    TSTAMP(0);
    phase_prep(p, smv, bid, nb);
    grid.sync();
    xcd_barrier_post(bar, xst);
#else
    __syncthreads();
    xcd_barrier_post(bar, xst);
    TSTAMP(0);
    phase_prep(p, smv, bid, nb);
    GBAR();
#endif
    TSTAMP(1);
    phase_norm<false, false, 2>(p.x, p.norm1_g, (const float*)(p.ws + OFF_MOD), 0, D, (bf16_t*)(p.ws + OFF_H), bid, nb); GBAR();
    int slice4, grank4; const int gsz4 = (int)gridDim.x / 4 * 2;
    {
        const unsigned myx = xst[3], myrank = xst[2];
        unsigned pre = 0;
#pragma unroll
        for (unsigned j = 0; j < 16; ++j) { const unsigned c = xb_ld(&bar[XB_XCNT(j)]); pre += (j < myx) ? c : 0u; }
        const int gi = __builtin_amdgcn_readfirstlane((int)(pre + myrank));
        slice4 = gi / ((int)gridDim.x / 4); grank4 = (gi % ((int)gridDim.x / 4)) * 2;
    }
#pragma nounroll
    for (int l = 0; l < NL; ++l) {
        TSTAMP(2 + 11 * l); phase_gemm1(p, l, smem); GBAR();
        TSTAMP(3 + 11 * l); phase_mix(p, l, smv, bid, nb); GBAR();
        TSTAMP(4 + 11 * l); phase_fftb(p, l, smv, bid, nb); GBAR();
        TSTAMP(5 + 11 * l); phase_gemm2(p, l, smem); GBAR();
        TSTAMP(6 + 11 * l); phase_norm<true, false, 2>(p.ws + OFF_XR, p.norm2_g + l * D, (const float*)(p.ws + OFF_MOD) + (size_t)l * NB * 6144, 3 * D, 4 * D, (bf16_t*)(p.ws + OFF_H), bid, nb); GBAR();
        TSTAMP(7 + 11 * l); phase_gemm3(p, l, smem); GBAR();
        TSTAMP(8 + 11 * l); phase_topk(p, l, smv, bid, nb); GBAR();
        TSTAMP(9 + 11 * l); phase_pu(p, l, slice4, grank4, gsz4, smem); GBAR();
        TSTAMP(10 + 11 * l); phase_pc(p, l, bid, nb); GBAR();
        TSTAMP(11 + 11 * l); phase_pv(p, l, slice4, grank4, gsz4, smem); GBAR();
        TSTAMP(12 + 11 * l);
        if (l + 1 < NL) { phase_norm<true, true>(p.ws + OFF_XR, p.norm1_g + (l + 1) * D, (const float*)(p.ws + OFF_MOD) + (size_t)(l + 1) * NB * 6144, 0, D, (bf16_t*)(p.ws + OFF_H), bid, nb,
                                                 (const bf16_t*)(p.ws + OFF_Z), (const float*)(p.ws + OFF_MOD) + (size_t)l * NB * 6144 + 5 * D); GBAR(); }
        else phase_final_norm(p, bid, nb);
    }
#undef GBAR
    TSTAMP(24);
#if PROBE_A >= 0
    if (bid == 0 && threadIdx.x == 0) p.out[0] += (float)(ts[PROBE_B] - ts[PROBE_A]) * 0.01f / PROBE_DIV;
#endif
}
#endif

extern "C" void kernel_launch(void* const* d_in, const int* in_sizes, int n_in, void* d_out, int out_size, void* d_ws, size_t ws_size, hipStream_t stream) {
    (void)in_sizes; (void)n_in; (void)out_size;
    if (ws_size < OFF_END) { fprintf(stderr, "workspace too small: %zu < %zu\n", ws_size, (size_t)OFF_END); return; }
    Params p{};
    p.x = (const float*)d_in[0]; p.c = (const float*)d_in[1]; p.mod_w = (const float*)d_in[2]; p.mod_b = (const float*)d_in[3]; p.norm1_g = (const float*)d_in[4];
    p.w_in = (const float*)d_in[5]; p.gmlp_ws = (const float*)d_in[6]; p.gmlp_bs = (const float*)d_in[7]; p.fnet_w = (const float*)d_in[8]; p.fnet_b = (const float*)d_in[9];
    p.gain_a = (const float*)d_in[10]; p.gain_b = (const float*)d_in[11]; p.w_out = (const float*)d_in[12]; p.norm2_g = (const float*)d_in[13]; p.wq = (const float*)d_in[14];
    p.k1 = (const float*)d_in[15]; p.k2 = (const float*)d_in[16]; p.pu = (const float*)d_in[17]; p.pv = (const float*)d_in[18]; p.final_g = (const float*)d_in[19];
    p.out = (float*)d_out; p.ws = (char*)d_ws;
#if MEGA
    static int grid_blocks = 0;
    if (!grid_blocks) {
        int dev = 0, cus = 0, per_cu = 0;
        hipGetDevice(&dev);
        hipDeviceGetAttribute(&cus, hipDeviceAttributeMultiprocessorCount, dev);
        hipOccupancyMaxActiveBlocksPerMultiprocessor(&per_cu, mega_kernel, 512, 0);
        if (per_cu > 1) per_cu = 1;
        grid_blocks = (cus * per_cu) / 8 * 8;
    }
    void* args[] = {&p};
    hipError_t e = hipLaunchCooperativeKernel((void*)mega_kernel, dim3(grid_blocks), dim3(512), args, 0, stream);
    if (e != hipSuccess) fprintf(stderr, "cooperative launch failed: %s (grid %d)\n", hipGetErrorString(e), grid_blocks);
#endif
}
```

```cpp
#include <hip/hip_runtime.h>
#include <hip/hip_cooperative_groups.h>
#include <cstdio>
#include <cstdint>
namespace cg = cooperative_groups;

#ifndef MEGA
#define MEGA 1
#endif
#ifndef COOP
#define COOP 1
#endif
#ifndef PROBE_A
#define PROBE_A -1
#define PROBE_B 0
#define PROBE_DIV 10.0f
#endif

typedef unsigned short bf16_t;
typedef short bf16x8 __attribute__((ext_vector_type(8)));
typedef float f32x4 __attribute__((ext_vector_type(4)));
typedef __bf16 bf16x2_t __attribute__((ext_vector_type(2)));

constexpr int D = 1024, NB = 8, SEQ = 4096, T = NB * SEQ, NL = 2;
constexpr int NZ = 2048;
constexpr int NE = 16384;
constexpr float EPS = 1e-6f;

constexpr size_t OFF_MOD  = 0;
constexpr size_t OFF_W1T  = OFF_MOD  + (size_t)NL * NB * 6144 * 4;
constexpr size_t OFF_W2T  = OFF_W1T  + (size_t)NL * 2048 * 1024 * 2;
constexpr size_t OFF_WQT  = OFF_W2T  + (size_t)NL * 1024 * 1024 * 2;
constexpr size_t OFF_K12  = OFF_WQT  + (size_t)NL * 2048 * 1024 * 2;
constexpr size_t OFF_WSB  = OFF_K12  + (size_t)NL * 8 * 256 * 128 * 2;
constexpr size_t OFF_DA   = OFF_WSB  + (size_t)NL * 8 * 128 * 128 * 2;
constexpr size_t OFF_DB   = OFF_DA   + 128 * 128 * 2;
constexpr size_t OFF_TW   = OFF_DB   + 64 * 128 * 2;
constexpr size_t OFF_SSQA = OFF_TW   + 64 * 64 * 8;
constexpr size_t OFF_SSQB = OFF_SSQA + (size_t)T * 8 * 4;
constexpr size_t OFF_UB   = OFF_SSQB + (size_t)T * 8 * 4;
constexpr size_t OFF_VB   = OFF_UB   + (size_t)NL * NE * 1024;
constexpr size_t OFF_USC  = OFF_VB   + (size_t)NL * NE * 1024;
constexpr size_t OFF_VSC  = OFF_USC  + (size_t)NL * NE * 4;
constexpr size_t OFF_H    = OFF_VSC  + (size_t)NL * NE * 4;
constexpr size_t OFF_Z    = OFF_H    + (size_t)T * 1024 * 2;
constexpr size_t OFF_Y    = OFF_Z    + (size_t)T * 2048 * 2;
constexpr size_t OFF_BAR  = OFF_Y    + (size_t)T * 1024 * 2;
constexpr size_t OFF_XR   = OFF_BAR  + 16384;
constexpr size_t OFF_END  = OFF_XR   + (size_t)T * 1024 * 2;

struct Params {
    const float* x; const float* c; const float* mod_w; const float* mod_b; const float* norm1_g; const float* w_in;
    const float* gmlp_ws; const float* gmlp_bs; const float* fnet_w; const float* fnet_b; const float* gain_a; const float* gain_b;
    const float* w_out; const float* norm2_g; const float* wq; const float* k1; const float* k2; const float* pu; const float* pv; const float* final_g;
    float* out; char* ws;
};

constexpr int SMEM_BYTES = 73984;

__device__ __forceinline__ float bf2f(unsigned v) { return __uint_as_float(v << 16); }
typedef float f32x2_t __attribute__((ext_vector_type(2)));
__device__ __forceinline__ unsigned pk_bf16(float lo, float hi) { const f32x2_t v = {lo, hi}; return __builtin_bit_cast(unsigned, __builtin_convertvector(v, bf16x2_t)); }
__device__ __forceinline__ bf16_t f2bf(float f) { return (bf16_t)(pk_bf16(f, 0.f) & 0xffffu); }
__device__ __forceinline__ float gelu_f(float v) {
    const float t = __builtin_amdgcn_rcpf(fabsf(v) * 0.2316418882f + 1.0f);
    float q = t * 0.5307027145f + (-0.7265760135f); q = q * t + 0.7107068705f; q = q * t + (-0.142248368f); q = q * t + 0.127414796f; q = q * t;
    const float m = v * (q * __builtin_amdgcn_exp2f(v * v * (-0.72134752044f)));
    return v < 0.f ? m : v - m;
}
__device__ __forceinline__ int med3i(int a, int b, int c) { return max(min(a, b), min(max(a, b), c)); }
__device__ __forceinline__ int f2key(float f) { int b = __float_as_int(f); return b ^ ((b >> 31) & 0x7fffffff); }
__device__ __forceinline__ float key2f(int k) { return __int_as_float(k ^ ((k >> 31) & 0x7fffffff)); }
__device__ __forceinline__ float wave_sum(float v) {
#pragma unroll
    for (int o = 32; o >= 1; o >>= 1) v += __shfl_xor(v, o);
    return v;
}
__device__ __forceinline__ int otid() { int t = threadIdx.x & 255; asm volatile("" : "+v"(t)); return t; }
__device__ __forceinline__ void vsync(char* smem_v) {
    const int vb_ = threadIdx.x >> 8;
    volatile __attribute__((address_space(3))) unsigned* cnt = (volatile __attribute__((address_space(3))) unsigned*)(smem_v + (2 - vb_) * SMEM_BYTES + 16) + vb_;
    asm volatile("s_waitcnt lgkmcnt(0)" ::: "memory");
    unsigned target = 0u;
    if ((threadIdx.x & 63) == 0) target = (__hip_atomic_fetch_add((__attribute__((address_space(3))) unsigned*)cnt, 1u, __ATOMIC_RELAXED, __HIP_MEMORY_SCOPE_WORKGROUP) / 4u + 1u) * 4u;
    target = __builtin_amdgcn_readfirstlane(target);
    while (*cnt < target) __builtin_amdgcn_s_sleep(1);
    asm volatile("" ::: "memory");
}
#define MFMA16(a, b, c) __builtin_amdgcn_mfma_f32_16x16x32_bf16((a), (b), (c), 0, 0, 0)

__device__ void transpose_tile(const float* __restrict__ src, int ld, int k0, int n0, bf16_t* __restrict__ dst  , int dn0,
                               const float* __restrict__ kscale, float* tile  ) {
    const int tid = otid();
#pragma unroll
    for (int i = 0; i < 4; ++i) {
        const int r = (tid >> 4) + 16 * i, c4 = (tid & 15) * 4;
        const float4 v = *(const float4*)(src + (size_t)(k0 + r) * ld + n0 + c4);
        const float s = kscale ? kscale[k0 + r] : 1.0f;
        tile[r * 65 + c4 + 0] = v.x * s; tile[r * 65 + c4 + 1] = v.y * s; tile[r * 65 + c4 + 2] = v.z * s; tile[r * 65 + c4 + 3] = v.w * s;
    }
    __syncthreads();
    {
        const int n = tid >> 2, ks = (tid & 3) * 16;
        unsigned w[8];
#pragma unroll
        for (int j = 0; j < 8; ++j) w[j] = pk_bf16(tile[(ks + 2 * j) * 65 + n], tile[(ks + 2 * j + 1) * 65 + n]);
        uint4* d = (uint4*)(dst + (size_t)(dn0 + n) * 1024 + k0 + ks);
        d[0] = make_uint4(w[0], w[1], w[2], w[3]); d[1] = make_uint4(w[4], w[5], w[6], w[7]);
    }
    __syncthreads();
}

__device__ void phase_prep(const Params& p, char* smem, int bid_, int nb_) {
    const int tid = otid();
    char* ws = p.ws;
    const bool split = (nb_ % 4 == 0);
    const bool convgrp = split && ((bid_ >> 1) & 1);
    const int bid = split ? (((bid_ >> 2) << 1) | (bid_ & 1)) : bid_, nb = split ? (nb_ >> 1) : nb_;
    const int gtid = bid * 256 + tid, gsz = nb * 256;
    if (!convgrp) {
    {
        float* sc = (float*)smem;
        float* red = (float*)(smem + 32768);
        for (int i = tid; i < 8192; i += 256) { const float v = p.c[i]; sc[i] = v / (1.0f + __expf(-v)); }
        __syncthreads();
        float* mod = (float*)(ws + OFF_MOD);
        for (int rd_ = 0; rd_ < (NL * 192 + nb - 1) / nb; ++rd_) { const int item = min(bid + rd_ * nb, NL * 192 - 1);
            const int l = item / 192, n0 = (item % 192) * 32, nn = tid & 31, kq = tid >> 5;
            float acc[8];
#pragma unroll
            for (int b = 0; b < 8; ++b) acc[b] = 0.f;
            const float* W = p.mod_w + (size_t)l * 1024 * 6144 + n0 + nn;
#pragma nounroll
            for (int k0 = kq; k0 < 1024; k0 += 128) {
                float w[16];
#pragma unroll
                for (int u = 0; u < 16; ++u) w[u] = W[(size_t)(k0 + 8 * u) * 6144];
#pragma unroll
                for (int u = 0; u < 16; ++u)
#pragma unroll
                    for (int b = 0; b < 8; ++b) acc[b] += sc[b * 1024 + k0 + 8 * u] * w[u];
            }
#pragma unroll
            for (int b = 0; b < 8; ++b) red[(kq * 8 + b) * 32 + nn] = acc[b];
            __syncthreads();
            {
                const int b = tid >> 5;
                float s = 0.f;
#pragma unroll
                for (int q = 0; q < 8; ++q) s += red[(q * 8 + b) * 32 + nn];
                mod[((size_t)l * NB + b) * 6144 + n0 + nn] = s + p.mod_b[l * 6144 + n0 + nn];
            }
            __syncthreads();
        }
    }
    {
        float* tile = (float*)smem;
        for (int rd_ = 0; rd_ < (NL * 1024 + nb - 1) / nb; ++rd_) { const int item = min(bid + rd_ * nb, NL * 1024 - 1);
            const int l = item / 1024, r = item % 1024;
            if (r < 256) {
                const int kt = r / 16, nt = r % 16;
                transpose_tile(p.w_in + (size_t)l * 1024 * 1536, 1536, kt * 64, nt * 64, (bf16_t*)(ws + OFF_W1T) + (size_t)l * 2048 * 1024, nt * 64, nullptr, tile);
            } else if (r < 512) {
                const int rr = r - 256, kt = rr / 16, nt = rr % 16;
                const float* gk = (kt < 8) ? (p.gain_a + l * 512) : (p.gain_b + l * 512 - 512);
                transpose_tile(p.w_out + (size_t)l * 1024 * 1024, 1024, kt * 64, nt * 64, (bf16_t*)(ws + OFF_W2T) + (size_t)l * 1024 * 1024, nt * 64, gk, tile);
            } else {
                const int rr = r - 512, kt = rr / 32, nt = rr % 32;
                transpose_tile(p.wq + (size_t)l * 1024 * 2048, 2048, kt * 64, nt * 64, (bf16_t*)(ws + OFF_WQT) + (size_t)l * 2048 * 1024, nt * 64, nullptr, tile);
            }
        }
    }
    {
        float* fws = (float*)smem;
        float* Ms  = (float*)(smem + 16384);
        float* wt  = (float*)(smem + 49152);
        float* cs  = (float*)(smem + 49152 + 16640);
        for (int rd_ = 0; rd_ < (NL * 8 * 16 + nb - 1) / nb; ++rd_) { const int item = min(bid + rd_ * nb, NL * 8 * 16 - 1);
            const int l = item / 128, g = (item % 128) / 16, kt = item % 16;
            if (tid < 64) { float s, c; sincospif((float)tid / 32.0f, &s, &c); cs[tid] = c; cs[64 + tid] = s; }
            for (int i = tid; i < 4096; i += 256) fws[i] = p.fnet_w[((size_t)l * 8 + g) * 4096 + i];
#pragma unroll
            for (int i = 0; i < 4; ++i) {
                const int r = (tid >> 4) + 16 * i, c4 = (tid & 15) * 4;
                const float4 v = *(const float4*)(p.w_in + (size_t)l * 1024 * 1536 + (size_t)(kt * 64 + r) * 1536 + 1024 + g * 64 + c4);
                wt[r * 65 + c4] = v.x; wt[r * 65 + c4 + 1] = v.y; wt[r * 65 + c4 + 2] = v.z; wt[r * 65 + c4 + 3] = v.w;
            }
            __syncthreads();
            {
                const int d = tid >> 2, r0 = (tid & 3) * 32;
                const bool im = r0 >= 64; const int e0 = r0 & 63;
                float acc[32];
#pragma unroll
                for (int e = 0; e < 32; ++e) acc[e] = 0.f;
                for (int j = 0; j < 64; ++j) {
                    const int ph = (d * j) & 63;
                    const float t = im ? -cs[64 + ph] : cs[ph];
#pragma unroll
                    for (int e = 0; e < 32; ++e) acc[e] += t * fws[j * 64 + e0 + e];
                }
#pragma unroll
                for (int e = 0; e < 32; ++e) Ms[d * 128 + r0 + e] = acc[e];
            }
            __syncthreads();
            {
                const int r = tid >> 1, kk0 = (tid & 1) * 32;
                float acc[32];
#pragma unroll
                for (int k = 0; k < 32; ++k) acc[k] = 0.f;
                for (int d = 0; d < 64; ++d) {
                    const float m = Ms[d * 128 + r];
#pragma unroll
                    for (int k = 0; k < 32; ++k) acc[k] += wt[(kk0 + k) * 65 + d] * m;
                }
                bf16_t* dst = (bf16_t*)(ws + OFF_W1T) + (size_t)l * 2048 * 1024 + (size_t)(1024 + g * 128 + r) * 1024 + kt * 64 + kk0;
#pragma unroll
                for (int q = 0; q < 4; ++q)
                    ((uint4*)dst)[q] = make_uint4(pk_bf16(acc[q * 8], acc[q * 8 + 1]), pk_bf16(acc[q * 8 + 2], acc[q * 8 + 3]), pk_bf16(acc[q * 8 + 4], acc[q * 8 + 5]), pk_bf16(acc[q * 8 + 6], acc[q * 8 + 7]));
            }
            __syncthreads();
        }
    }
    {
        bf16_t* k12 = (bf16_t*)(ws + OFF_K12);
        for (int i = gtid; i < NL * 8 * 256 * 128; i += gsz) {
            const int d = i & 127, n = (i >> 7) & 255, h = (i >> 15) & 7, l = i >> 18;
            const float* src = (n < 128) ? p.k1 : p.k2;
            k12[i] = f2bf(src[(((size_t)l * 8 + h) * 128 + (n & 127)) * 128 + d]);
        }
        bf16_t* wsb = (bf16_t*)(ws + OFF_WSB);
        for (int i = gtid; i < NL * 8 * 128 * 128; i += gsz) wsb[i] = f2bf(p.gmlp_ws[i]);
        bf16_t* DA = (bf16_t*)(ws + OFF_DA);
        for (int i = gtid; i < 128 * 128; i += gsz) {
            const int m = i >> 7, kk = i & 127, ro = m >> 6, k1 = m & 63, ri = kk >> 6, a = kk & 63;
            float s, c; sincospif((float)((a * k1) & 63) / 32.0f, &s, &c);
            const float v = (ro == ri) ? c : (ro == 0 ? s : -s);
            DA[i] = f2bf(v);
        }
        bf16_t* DB = (bf16_t*)(ws + OFF_DB);
        for (int i = gtid; i < 64 * 128; i += gsz) {
            const int k2 = i >> 7, kk = i & 127, ri = kk >> 6, b = kk & 63;
            float s, c; sincospif((float)((b * k2) & 63) / 32.0f, &s, &c);
            DB[i] = f2bf(ri ? s : c);
        }
        float2* tw = (float2*)(ws + OFF_TW);
        for (int i = gtid; i < 64 * 64; i += gsz) {
            const int bp = i >> 6, k1 = i & 63;
            float s, c; sincospif((float)(bp * k1) / 2048.0f, &s, &c);
            tw[i] = make_float2(c, s);
        }
    }
    }
    if (convgrp || !split) {
        {
            const int lane = tid & 63, wv = gtid >> 6, nwv = gsz >> 6;
            const int R = 2 * NL * NE;
#pragma nounroll
            for (int r0 = wv; r0 < R; r0 += 4 * nwv) {
                float4 v[4][4];
#pragma unroll
                for (int t = 0; t < 4; ++t) {
                    const int r = (r0 + t * nwv < R) ? r0 + t * nwv : r0;
                    const int tbl = r / (NL * NE), row = r % (NL * NE);
                    const float* src = (tbl ? p.pv : p.pu) + (size_t)row * 1024 + lane * 16;
#pragma unroll
                    for (int i = 0; i < 4; ++i) v[t][i] = ((const float4*)src)[i];
                }
                __builtin_amdgcn_sched_barrier(0);
#pragma unroll
                for (int t = 0; t < 4; ++t) {
                    const int r = r0 + t * nwv;
                    if (r >= R) break;
                    const int tbl = r / (NL * NE), row = r % (NL * NE);
                    float m = 0.f;
#pragma unroll
                    for (int i = 0; i < 4; ++i) m = fmaxf(m, fmaxf(fmaxf(fabsf(v[t][i].x), fabsf(v[t][i].y)), fmaxf(fabsf(v[t][i].z), fabsf(v[t][i].w))));
#pragma unroll
                    for (int o = 32; o >= 1; o >>= 1) m = fmaxf(m, __shfl_xor(m, o));
                    const float qmax = 6.0f;
                    const float sc = (m > 0.f) ? qmax / m : 1.0f, inv = (m > 0.f) ? m / qmax : 1.0f;
                    const int lyr = row / NE, ex = row % NE;
                    if (true) {
                        unsigned w0 = 0u, w1 = 0u;
                        w0 = __builtin_amdgcn_cvt_scalef32_pk_fp4_f32(w0, v[t][0].x * sc, v[t][0].y * sc, 1.0f, 0); w0 = __builtin_amdgcn_cvt_scalef32_pk_fp4_f32(w0, v[t][0].z * sc, v[t][0].w * sc, 1.0f, 1);
                        w0 = __builtin_amdgcn_cvt_scalef32_pk_fp4_f32(w0, v[t][1].x * sc, v[t][1].y * sc, 1.0f, 2); w0 = __builtin_amdgcn_cvt_scalef32_pk_fp4_f32(w0, v[t][1].z * sc, v[t][1].w * sc, 1.0f, 3);
                        w1 = __builtin_amdgcn_cvt_scalef32_pk_fp4_f32(w1, v[t][2].x * sc, v[t][2].y * sc, 1.0f, 0); w1 = __builtin_amdgcn_cvt_scalef32_pk_fp4_f32(w1, v[t][2].z * sc, v[t][2].w * sc, 1.0f, 1);
                        w1 = __builtin_amdgcn_cvt_scalef32_pk_fp4_f32(w1, v[t][3].x * sc, v[t][3].y * sc, 1.0f, 2); w1 = __builtin_amdgcn_cvt_scalef32_pk_fp4_f32(w1, v[t][3].z * sc, v[t][3].w * sc, 1.0f, 3);
                        *(uint2*)(ws + (tbl ? OFF_VB : OFF_UB) + ((size_t)(lyr * 4 + (lane >> 4)) * NE + ex) * 128 + (lane & 15) * 8) = make_uint2(w0, w1);
                    } else {
                        int w[4];
#pragma unroll
                        for (int i = 0; i < 4; ++i) { w[i] = __builtin_amdgcn_cvt_pk_fp8_f32(v[t][i].x * sc, v[t][i].y * sc, 0, false); w[i] = __builtin_amdgcn_cvt_pk_fp8_f32(v[t][i].z * sc, v[t][i].w * sc, w[i], true); }
                        *(int4*)(ws + OFF_UB + ((size_t)(lyr * 8 + (lane >> 3)) * NE + ex) * 128 + (lane & 7) * 16) = make_int4(w[0], w[1], w[2], w[3]);
                    }
                    if (lane == 0) ((float*)(ws + (tbl ? OFF_VSC : OFF_USC)))[row] = inv;
                    __builtin_amdgcn_sched_barrier(0);
                }
            }
        }
    }
}

template <bool SRC_BF16, bool ADD = false, int NU = 2>
__device__ void phase_norm(const void* xsrc_, const float* __restrict__ g, const float* __restrict__ modl  , int sh_off, int scl_off,
                           bf16_t* __restrict__ hout, int bid, int nb, const bf16_t* __restrict__ sadd = nullptr, const float* __restrict__ g2l = nullptr, bf16_t* __restrict__ xcopy = nullptr) {
    const int tid_ = otid(); const int lane = tid_ & 63, wid = tid_ >> 6;
    for (int tok0 = bid * 4 + wid; tok0 < T; tok0 += nb * 4 * NU) {
        int tk[NU]; bool ok[NU];
#pragma unroll
        for (int u = 0; u < NU; ++u) { ok[u] = tok0 + u * nb * 4 < T; tk[u] = ok[u] ? tok0 + u * nb * 4 : tok0; }
        float4 v[NU][4]; uint2 xw[NU][4], sw[NU][4]; float4 g2[NU][4];
#pragma unroll
        for (int u = 0; u < NU; ++u)
#pragma unroll
            for (int i = 0; i < 4; ++i) {
                const size_t o = (size_t)tk[u] * D + i * 256 + lane * 4;
                if (SRC_BF16) xw[u][i] = *(const uint2*)((const bf16_t*)xsrc_ + o); else v[u][i] = *(const float4*)((const float*)xsrc_ + o);
                if (ADD) { sw[u][i] = *(const uint2*)(sadd + o); g2[u][i] = *(const float4*)(g2l + (size_t)(tk[u] / SEQ) * 6144 + i * 256 + lane * 4); }
            }
        float ss[NU];
#pragma unroll
        for (int u = 0; u < NU; ++u) { ss[u] = 0.f;
#pragma unroll
            for (int i = 0; i < 4; ++i) {
                if (SRC_BF16) v[u][i] = make_float4(bf2f(xw[u][i].x & 0xffffu), bf2f(xw[u][i].x >> 16), bf2f(xw[u][i].y & 0xffffu), bf2f(xw[u][i].y >> 16));
                if (ADD) { const uint2 s_ = sw[u][i]; const float4 g_ = g2[u][i];
                    const unsigned r0 = pk_bf16(v[u][i].x + g_.x * bf2f(s_.x & 0xffffu), v[u][i].y + g_.y * bf2f(s_.x >> 16)), r1 = pk_bf16(v[u][i].z + g_.z * bf2f(s_.y & 0xffffu), v[u][i].w + g_.w * bf2f(s_.y >> 16));
                    if (ok[u]) *(uint2*)((bf16_t*)xsrc_ + (size_t)tk[u] * D + i * 256 + lane * 4) = make_uint2(r0, r1);
                    v[u][i] = make_float4(bf2f(r0 & 0xffffu), bf2f(r0 >> 16), bf2f(r1 & 0xffffu), bf2f(r1 >> 16)); }
                if (!SRC_BF16 && xcopy != nullptr && ok[u]) *(uint2*)(xcopy + (size_t)tk[u] * D + i * 256 + lane * 4) = make_uint2(pk_bf16(v[u][i].x, v[u][i].y), pk_bf16(v[u][i].z, v[u][i].w));
                ss[u] += v[u][i].x * v[u][i].x + v[u][i].y * v[u][i].y + v[u][i].z * v[u][i].z + v[u][i].w * v[u][i].w;
            }
        }
#pragma unroll
        for (int u = 0; u < NU; ++u) {
            const float rstd = rsqrtf(wave_sum(ss[u]) * (1.0f / D) + EPS);
            const float* mb = modl + (size_t)(tk[u] / SEQ) * 6144;
#pragma unroll
            for (int i = 0; i < 4; ++i) {
                const int cidx = i * 256 + lane * 4;
                const float4 gg = *(const float4*)(g + cidx), sh = *(const float4*)(mb + sh_off + cidx), sc = *(const float4*)(mb + scl_off + cidx);
                const float o0 = v[u][i].x * rstd * gg.x * (1.0f + sc.x) + sh.x, o1 = v[u][i].y * rstd * gg.y * (1.0f + sc.y) + sh.y;
                const float o2 = v[u][i].z * rstd * gg.z * (1.0f + sc.z) + sh.z, o3 = v[u][i].w * rstd * gg.w * (1.0f + sc.w) + sh.w;
                if (ok[u]) *(uint2*)(hout + (size_t)tk[u] * D + cidx) = make_uint2(pk_bf16(o0, o1), pk_bf16(o2, o3));
            }
        }
    }
}

namespace pg8 {
#define PG8_LAS __attribute__((address_space(3)))
typedef unsigned short bf16_t;
typedef short bf16x8 __attribute__((ext_vector_type(8)));
typedef float f32x4 __attribute__((ext_vector_type(4)));
typedef unsigned u32x4 __attribute__((ext_vector_type(4)));
constexpr int BM = 256, BK = 64, HALF = 128, HTB = HALF * BK * 2  , STAGE_BYTES = 8 * HTB, NXCD = 8, WGM = 8;

__host__ __device__ __forceinline__ int lds_byte(int r, int c) { const int st = (r >> 4) * 2 + (c >> 5), rr = r & 15, cc = c & 31, ob = rr * 64 + cc * 2; return st * 1024 + (ob ^ (((ob >> 9) & 1) << 5)); }
__host__ __device__ __forceinline__ void stage_rc(int b, int& R, int& C) { const int st = b / 1024, sb = b % 1024, swz = sb ^ (((sb >> 9) & 1) << 5); R = (st >> 1) * 16 + swz / 64; C = (st & 1) * 32 + (swz % 64) / 2; }
__host__ __device__ __forceinline__ int perm32(int rho) { const int n = rho >> 4, i = rho & 15; return 8 * (i >> 2) + 4 * n + (i & 3); }

struct Unit { int pm, pn; };
struct Gemm { const bf16_t* A; const bf16_t* Bt; int M, N, K; };

struct StaticOrder {
    int nM, nN, nwg, G, c;
    __host__ __device__ void init(int M, int N, int G_, int c_) { nM = M / BM; nN = N / BM; nwg = nM * nN; G = G_; c = c_; }
    __host__ __device__ bool next(int i, Unit& u) const {
        const long L = (long)i * G + c; if (L >= nwg) return false;
        int wgid = (int)L; { const int q = nwg / NXCD, r = nwg % NXCD, xcd = wgid % NXCD, off = wgid / NXCD; wgid = (xcd < r ? xcd * (q + 1) : r * (q + 1) + (xcd - r) * q) + off; }
        const int nig = WGM * nN, gid = wgid / nig, fm = gid * WGM, gsz = (nM - fm) < WGM ? (nM - fm) : WGM;
        u.pm = fm + ((wgid % nig) % gsz); u.pn = (wgid % nig) / gsz; return true;
    }
    __device__ __forceinline__ void a_ready(const Unit&) const {}
    __device__ __forceinline__ void done(const Unit&) const {}
};

template <class Epi, class Sched, class MidK, bool STAMP = false>
__device__ __forceinline__ void gemm_phase(PG8_LAS unsigned char* lds, const Gemm g, const Sched& S, const Epi& E, const MidK& MK, int midt, unsigned long long* stamps) {
    int tid_ = threadIdx.x; asm volatile("" : "+v"(tid_));
    const int tid = tid_, wid = __builtin_amdgcn_readfirstlane(tid >> 6), lane = tid & 63, wr = wid >> 2, wc = wid & 3, fr = lane & 15, fq = lane >> 4;
    const int K = g.K, nt = K / BK;
    int ts_lo = 0, ts_hi = 0, nts = 0; const unsigned long long rt_entry = STAMP ? (unsigned long long)wall_clock64() : 0ull;
#define PG8_STAMP() do { if (STAMP && wid == 0 && nts < 64) { const unsigned long long _c = (unsigned long long)clock64(); \
        ts_lo = (lane == nts) ? (int)(unsigned)_c : ts_lo; ts_hi = (lane == nts) ? (int)(unsigned)(_c >> 32) : ts_hi; ++nts; } } while (0)
    PG8_STAMP();
    unsigned voffA[2], voffB[2];
#pragma unroll
    for (int i = 0; i < 2; ++i) { int R, C; stage_rc(tid * 16 + i * 8192, R, C); const int Rb = Epi::PERM ? ((R & ~31) + perm32(R & 31)) : R;
        voffA[i] = (unsigned)(R * K + C) * 2u; voffB[i] = (unsigned)(Rb * K + C) * 2u; }
    const size_t kstep = (size_t)(BK * 2);
    const size_t hstep = (size_t)HALF * K * 2;
    const size_t tstep = 2 * hstep;
    const unsigned ldsw = (unsigned)wid * 1024u;
    const int aoff = lds_byte(wr * 64 + fr, fq * 8), boff = lds_byte(wc * 32 + fr, fq * 8);
#define PG8_SA(b, h) (((b) * 2 + (h)) * HTB)
#define PG8_SB(b, h) ((4 + (b) * 2 + (h)) * HTB)
#define PG8_STAGE(bufoff, gbase, voff) do { _Pragma("unroll") for (int _i = 0; _i < 2; ++_i) \
        __builtin_amdgcn_global_load_lds((const unsigned*)((const char*)(gbase) + (voff)[_i]), (PG8_LAS unsigned*)(lds + (bufoff) + ldsw + _i * 8192), 16, 0, 0); } while (0)
#define PG8_LDA(dst, b, h) do { _Pragma("unroll") for (int m = 0; m < 4; ++m) _Pragma("unroll") for (int k = 0; k < 2; ++k) dst[m][k] = *(const PG8_LAS bf16x8*)(lds + PG8_SA(b, h) + aoff + m * 2048 + k * 1024); } while (0)
#define PG8_LDB(dst, b, h) do { _Pragma("unroll") for (int n = 0; n < 2; ++n) _Pragma("unroll") for (int k = 0; k < 2; ++k) dst[n][k] = *(const PG8_LAS bf16x8*)(lds + PG8_SB(b, h) + boff + n * 2048 + k * 1024); } while (0)
#define PG8_MMA(ai, bj, At, Bt) do { __builtin_amdgcn_s_setprio(1); _Pragma("unroll") for (int m = 0; m < 4; ++m) _Pragma("unroll") for (int n = 0; n < 2; ++n) _Pragma("unroll") for (int k = 0; k < 2; ++k) \
        acc[ai][bj][m][n] = __builtin_amdgcn_mfma_f32_16x16x32_bf16(Bt[n][k], At[m][k], acc[ai][bj][m][n], 0, 0, 0); __builtin_amdgcn_s_setprio(0); } while (0)
#define PG8_WAIT_V(n) asm volatile("s_waitcnt vmcnt(" #n ")" ::: "memory")
#define PG8_WAIT_L(n) asm volatile("s_waitcnt lgkmcnt(" #n ")" ::: "memory")
#define PG8_BAR __builtin_amdgcn_s_barrier()
#define PG8_SCHED __builtin_amdgcn_sched_barrier(0)
    Unit cur, nxt; int ui = 0;
    if (!S.next(0, cur)) return;
    f32x4 acc[2][2][4][2];
#pragma unroll
    for (int a = 0; a < 2; ++a)
#pragma unroll
        for (int b = 0; b < 2; ++b)
#pragma unroll
            for (int m = 0; m < 4; ++m)
#pragma unroll
                for (int n = 0; n < 2; ++n) acc[a][b][m][n] = (f32x4){0.f, 0.f, 0.f, 0.f};
    bf16x8 At[4][2], B0[2][2], B1[2][2];
    const char* cA = (const char*)g.A + (size_t)cur.pm * tstep; const char* cB = (const char*)g.Bt + (size_t)cur.pn * tstep;
    S.a_ready(cur);
    PG8_STAGE(PG8_SB(0, 0), cB, voffB); PG8_STAGE(PG8_SA(0, 0), cA, voffA); PG8_STAGE(PG8_SB(0, 1), cB + hstep, voffB); PG8_STAGE(PG8_SA(0, 1), cA + hstep, voffA);
    if (wr == 1) PG8_BAR;
    PG8_WAIT_V(4); PG8_BAR;
    PG8_STAGE(PG8_SB(1, 0), cB + kstep, voffB); PG8_STAGE(PG8_SA(1, 0), cA + kstep, voffA); PG8_STAGE(PG8_SB(1, 1), cB + hstep + kstep, voffB);
    PG8_WAIT_V(6); PG8_BAR;
    PG8_STAMP();
    for (;;) {
        const bool has_next = S.next(ui + 1, nxt);
        const char* nA = has_next ? (const char*)g.A + (size_t)nxt.pm * tstep : cA; const char* nB = has_next ? (const char*)g.Bt + (size_t)nxt.pn * tstep : cB;
        for (int t = 0; t < nt; t += 2) {
            const bool last = (t == nt - 2);
            if (t == midt) {
#pragma unroll
                for (int ai = 0; ai < 2; ++ai)
#pragma unroll
                    for (int m = 0; m < 4; ++m) { const float s_ = MK(ui, ai * HALF + wr * 64 + m * 16 + fr);
#pragma unroll
                        for (int bj = 0; bj < 2; ++bj)
#pragma unroll
                            for (int n = 0; n < 2; ++n) acc[ai][bj][m][n] *= s_;
                        __builtin_amdgcn_sched_barrier(0); }
            }
            const char* a1 = cA + (size_t)(t + 1) * kstep;
            const char* a2 = last ? nA : cA + (size_t)(t + 2) * kstep; const char* b2 = last ? nB : cB + (size_t)(t + 2) * kstep;
            const char* a3 = a2 + kstep; const char* b3 = b2 + kstep;
            if (last && has_next) S.a_ready(nxt);
            PG8_LDB(B0, 0, 0); PG8_SCHED; PG8_LDA(At, 0, 0); PG8_STAGE(PG8_SA(1, 1), a1 + hstep, voffA);
            PG8_WAIT_L(8); PG8_BAR; PG8_WAIT_L(0); PG8_MMA(0, 0, At, B0); PG8_BAR; PG8_SCHED;
            PG8_LDB(B1, 0, 1); PG8_STAGE(PG8_SB(0, 0), b2, voffB);
            PG8_BAR; PG8_WAIT_L(0); PG8_MMA(0, 1, At, B1); PG8_BAR;
            PG8_LDA(At, 0, 1); PG8_STAGE(PG8_SA(0, 0), a2, voffA);
            PG8_BAR; PG8_WAIT_L(0); PG8_MMA(1, 0, At, B0); PG8_BAR; PG8_SCHED;
            PG8_STAGE(PG8_SB(0, 1), b2 + hstep, voffB);
            PG8_WAIT_V(6); PG8_BAR; PG8_MMA(1, 1, At, B1); PG8_BAR;
            PG8_LDB(B0, 1, 0); PG8_SCHED; PG8_LDA(At, 1, 0); PG8_STAGE(PG8_SA(0, 1), a2 + hstep, voffA);
            PG8_WAIT_L(8); PG8_BAR; PG8_WAIT_L(0); PG8_MMA(0, 0, At, B0); PG8_BAR; PG8_SCHED;
            PG8_LDB(B1, 1, 1); PG8_STAGE(PG8_SB(1, 0), b3, voffB);
            PG8_BAR; PG8_WAIT_L(0); PG8_MMA(0, 1, At, B1); PG8_BAR;
            PG8_LDA(At, 1, 1); PG8_STAGE(PG8_SA(1, 0), a3, voffA);
            PG8_BAR; PG8_WAIT_L(0); PG8_MMA(1, 0, At, B0); PG8_BAR; PG8_SCHED;
            PG8_STAGE(PG8_SB(1, 1), b3 + hstep, voffB);
            PG8_WAIT_V(6); PG8_BAR; PG8_MMA(1, 1, At, B1); PG8_BAR;
        }
        PG8_STAMP();
        if constexpr (!Epi::AFTER_DRAIN) { E(acc, cur, wr, wc, fr, fq, ui); S.done(cur); }
        PG8_STAMP();
        if (!has_next) break;
#pragma unroll
        for (int a = 0; a < 2; ++a)
#pragma unroll
            for (int b = 0; b < 2; ++b)
#pragma unroll
                for (int m = 0; m < 4; ++m)
#pragma unroll
                    for (int n = 0; n < 2; ++n) acc[a][b][m][n] = (f32x4){0.f, 0.f, 0.f, 0.f};
        cur = nxt; cA = nA; cB = nB; ++ui;
    }
    PG8_WAIT_V(0);
    if (wr == 0) PG8_BAR;
    PG8_BAR;
    if constexpr (Epi::AFTER_DRAIN) { E.fused(acc, cur, wr, wc, fr, fq, lds, wid, lane); S.done(cur); }
    PG8_STAMP();
    if (STAMP && wid == 0) { stamps[lane] = lane < nts ? (((unsigned long long)(unsigned)ts_hi << 32) | (unsigned)ts_lo) : 0ull;
        if (lane == 62) stamps[62] = rt_entry; if (lane == 63) stamps[63] = (unsigned long long)wall_clock64(); }
#undef PG8_STAMP
#undef PG8_SA
#undef PG8_SB
#undef PG8_STAGE
#undef PG8_LDA
#undef PG8_LDB
#undef PG8_MMA
#undef PG8_WAIT_V
#undef PG8_WAIT_L
#undef PG8_BAR
#undef PG8_SCHED
}
}

struct NoMid { __device__ __forceinline__ float operator()(int, int) const { return 1.0f; } };
#define LAS __attribute__((address_space(3)))
struct EpiZ {
    static constexpr bool PERM = true, AFTER_DRAIN = false;
    bf16_t* Z;
    __device__ __forceinline__ void operator()(const f32x4 (&acc)[2][2][4][2], const pg8::Unit& u, int wr, int wc, int fr, int fq, int) const {
        const int row0 = u.pm * 256 + wr * 64 + fr, col0 = u.pn * 256 + wc * 32 + 8 * fq; const bool act = u.pn < 4;
#pragma unroll
        for (int ai = 0; ai < 2; ++ai)
#pragma unroll
            for (int m = 0; m < 4; ++m) { bf16_t* rowp = Z + (size_t)(row0 + ai * 128 + m * 16) * NZ + col0;
#pragma unroll
                for (int bj = 0; bj < 2; ++bj) { f32x4 a = acc[ai][bj][m][0], b = acc[ai][bj][m][1];
                    if (act) { a = (f32x4){gelu_f(a[0]), gelu_f(a[1]), gelu_f(a[2]), gelu_f(a[3])}; b = (f32x4){gelu_f(b[0]), gelu_f(b[1]), gelu_f(b[2]), gelu_f(b[3])}; }
                    *(uint4*)(rowp + bj * 128) = make_uint4(pk_bf16(a[0], a[1]), pk_bf16(a[2], a[3]), pk_bf16(b[0], b[1]), pk_bf16(b[2], b[3])); }
                __builtin_amdgcn_sched_barrier(0); }
    }
};
struct EpiQ {
    static constexpr bool PERM = true, AFTER_DRAIN = false;
    bf16_t* Q;
    __device__ __forceinline__ void operator()(const f32x4 (&acc)[2][2][4][2], const pg8::Unit& u, int wr, int wc, int fr, int fq, int) const {
        const int row0 = u.pm * 256 + wr * 64 + fr, col0 = u.pn * 256 + wc * 32 + 8 * fq;
#pragma unroll
        for (int ai = 0; ai < 2; ++ai)
#pragma unroll
            for (int m = 0; m < 4; ++m) { bf16_t* rowp = Q + (size_t)(row0 + ai * 128 + m * 16) * 2048 + col0;
#pragma unroll
                for (int bj = 0; bj < 2; ++bj) { const f32x4 a = acc[ai][bj][m][0], b = acc[ai][bj][m][1];
                    *(uint4*)(rowp + bj * 128) = make_uint4(pk_bf16(a[0], a[1]), pk_bf16(a[2], a[3]), pk_bf16(b[0], b[1]), pk_bf16(b[2], b[3])); } }
    }
};
__device__ __forceinline__ float rstd512(const float* s, int row) {
    const float4 a = *(const float4*)(s + (size_t)row * 8), b = *(const float4*)(s + (size_t)row * 8 + 4);
    return rsqrtf(((a.x + a.y) + (a.z + a.w) + (b.x + b.y) + (b.z + b.w)) * (1.0f / 512.0f) + EPS);
}
struct MidY { const LAS float* tab; __device__ __forceinline__ float operator()(int ui, int r) const { return tab[(2 * ui) * 256 + r]; } };
struct EpiX {
    static constexpr bool PERM = true, AFTER_DRAIN = false;
    bf16_t* XR; const LAS float* tab; const float* gate;
    __device__ __forceinline__ void operator()(const f32x4 (&acc)[2][2][4][2], const pg8::Unit& u, int wr, int wc, int fr, int fq, int ui) const {
        const int r0 = wr * 64 + fr, row0 = u.pm * 256 + r0, col0 = u.pn * 256 + wc * 32 + 8 * fq;
        const float* gp = gate + (size_t)((u.pm * 256) / SEQ) * 6144 + col0;
        bf16_t* xp = XR + (size_t)row0 * D + col0;
        float4 g[2][2];
#pragma unroll
        for (int bj = 0; bj < 2; ++bj) { g[bj][0] = *(const float4*)(gp + bj * 128); g[bj][1] = *(const float4*)(gp + bj * 128 + 4); }
#pragma unroll
        for (int ai = 0; ai < 2; ++ai) {
            uint4 xw[4][2];
#pragma unroll
            for (int m = 0; m < 4; ++m)
#pragma unroll
                for (int bj = 0; bj < 2; ++bj) xw[m][bj] = *(const uint4*)(xp + (size_t)(ai * 128 + m * 16) * D + bj * 128);
            __builtin_amdgcn_sched_barrier(0);
#pragma unroll
            for (int m = 0; m < 4; ++m) { const float rb = tab[(2 * ui + 1) * 256 + r0 + ai * 128 + m * 16];
#pragma unroll
                for (int bj = 0; bj < 2; ++bj) { const f32x4 a = acc[ai][bj][m][0], b = acc[ai][bj][m][1]; const uint4 w = xw[m][bj]; const float4 g0 = g[bj][0], g1 = g[bj][1];
                    *(uint4*)(xp + (size_t)(ai * 128 + m * 16) * D + bj * 128) =
                        make_uint4(pk_bf16(bf2f(w.x & 0xffffu) + g0.x * rb * a[0], bf2f(w.x >> 16) + g0.y * rb * a[1]), pk_bf16(bf2f(w.y & 0xffffu) + g0.z * rb * a[2], bf2f(w.y >> 16) + g0.w * rb * a[3]),
                                   pk_bf16(bf2f(w.z & 0xffffu) + g1.x * rb * b[0], bf2f(w.z >> 16) + g1.y * rb * b[1]), pk_bf16(bf2f(w.w & 0xffffu) + g1.z * rb * b[2], bf2f(w.w >> 16) + g1.w * rb * b[3])); }
                __builtin_amdgcn_sched_barrier(0); }
        }
    }
};
__device__ void phase_gemm1(const Params& p, int l, char* smem512) {
    pg8::Gemm g; g.A = (const pg8::bf16_t*)(p.ws + OFF_H); g.Bt = (const pg8::bf16_t*)(p.ws + OFF_W1T) + (size_t)l * 2048 * 1024; g.M = T; g.N = NZ; g.K = D;
    int G_ = (int)gridDim.x, c_ = (int)blockIdx.x; asm volatile("" : "+s"(G_), "+s"(c_));
    pg8::StaticOrder S; S.init(T, NZ, G_, c_);
    EpiZ E; E.Z = (bf16_t*)(p.ws + OFF_Z);
    pg8::gemm_phase<EpiZ, pg8::StaticOrder, NoMid>((PG8_LAS unsigned char*)smem512, g, S, E, NoMid(), -1, nullptr);
}
__device__ void phase_gemm2(const Params& p, int l, char* smem512) {
    pg8::Gemm g; g.A = (const pg8::bf16_t*)(p.ws + OFF_Y); g.Bt = (const pg8::bf16_t*)(p.ws + OFF_W2T) + (size_t)l * 1024 * 1024; g.M = T; g.N = D; g.K = D;
    int G_ = (int)gridDim.x, c_ = (int)blockIdx.x; asm volatile("" : "+s"(G_), "+s"(c_));
    pg8::StaticOrder S; S.init(T, D, G_, c_);
    LAS float* tab = (LAS float*)((LAS char*)smem512 + pg8::STAGE_BYTES);
    {
        const float* ssa = (const float*)(p.ws + OFF_SSQA); const float* ssb = (const float*)(p.ws + OFF_SSQB);
        pg8::Unit u;
        int t0_ = threadIdx.x; asm volatile("" : "+v"(t0_));
#pragma nounroll
        for (int i = 0; i < 8 && S.next(i, u); ++i)
            for (int r = t0_; r < 256; r += 512) { const float ra = rstd512(ssa, u.pm * 256 + r), rb = rstd512(ssb, u.pm * 256 + r); tab[(2 * i) * 256 + r] = ra / rb; tab[(2 * i + 1) * 256 + r] = rb; }
        __syncthreads();
    }
    MidY MK; MK.tab = tab;
    EpiX E; E.XR = (bf16_t*)(p.ws + OFF_XR); E.tab = tab; E.gate = (const float*)(p.ws + OFF_MOD) + (size_t)l * NB * 6144 + 2 * D;
    pg8::gemm_phase<EpiX, pg8::StaticOrder, MidY>((PG8_LAS unsigned char*)smem512, g, S, E, MK, 8, nullptr);
}
__device__ void phase_gemm3(const Params& p, int l, char* smem512) {
    pg8::Gemm g; g.A = (const pg8::bf16_t*)(p.ws + OFF_H); g.Bt = (const pg8::bf16_t*)(p.ws + OFF_WQT) + (size_t)l * 2048 * 1024; g.M = T; g.N = 2048; g.K = D;
    int G_ = (int)gridDim.x, c_ = (int)blockIdx.x; asm volatile("" : "+s"(G_), "+s"(c_));
    pg8::StaticOrder S; S.init(T, 2048, G_, c_);
    EpiQ E; E.Q = (bf16_t*)(p.ws + OFF_Z);
    pg8::gemm_phase<EpiQ, pg8::StaticOrder, NoMid>((PG8_LAS unsigned char*)smem512, g, S, E, NoMid(), -1, nullptr);
}

constexpr int TP = 136;
__device__ __forceinline__ void stage_transposed(const bf16_t* __restrict__ base, size_t row_stride, bf16_t* dT) {
    const int tid = otid(), r = tid >> 2, part = tid & 3, ri = part >> 1, c0 = (part & 1) * 32;
    const uint4* src = (const uint4*)(base + (size_t)r * row_stride + ri * 64 + c0);
    uint4 v[4];
#pragma unroll
    for (int i = 0; i < 4; ++i) v[i] = src[i];
#pragma unroll
    for (int i = 0; i < 4; ++i) {
        const unsigned w[4] = {v[i].x, v[i].y, v[i].z, v[i].w};
#pragma unroll
        for (int j = 0; j < 4; ++j) {
            dT[(c0 + i * 8 + j * 2) * TP + ri * 64 + r] = (bf16_t)(w[j] & 0xffffu);
            dT[(c0 + i * 8 + j * 2 + 1) * TP + ri * 64 + r] = (bf16_t)(w[j] >> 16);
        }
    }
}

__device__ void gmlp_item(const Params& p, int l, int item, char* smem) {
    const int tid = otid(), lane = tid & 63, wid = tid >> 6, fr = lane & 15, fq = lane >> 4;
    const int h = item & 7, c = (item >> 3) & 31, b = item >> 8;
    const int tok0 = b * SEQ + c * 128;
    bf16_t* vnT = (bf16_t*)smem;
    const bf16_t* Z = (const bf16_t*)(p.ws + OFF_Z);
    {
        const int q = tid >> 1, half = tid & 1, d0 = half * 32;
        const uint4* src = (const uint4*)(Z + (size_t)(tok0 + q) * NZ + 512 + h * 64 + d0);
        float f[32];
#pragma unroll
        for (int i = 0; i < 4; ++i) { const uint4 v = src[i]; const unsigned w[4] = {v.x, v.y, v.z, v.w};
#pragma unroll
            for (int j = 0; j < 4; ++j) { f[i * 8 + j * 2] = bf2f(w[j] & 0xffffu); f[i * 8 + j * 2 + 1] = bf2f(w[j] >> 16); } }
        float s = 0.f;
#pragma unroll
        for (int i = 0; i < 32; ++i) s += f[i];
        s += __shfl_xor(s, 1);
        const float mean = s * (1.0f / 64.0f);
        float qv = 0.f;
#pragma unroll
        for (int i = 0; i < 32; ++i) { f[i] -= mean; qv += f[i] * f[i]; }
        qv += __shfl_xor(qv, 1);
        const float rstd = rsqrtf(qv * (1.0f / 64.0f) + EPS);
#pragma unroll
        for (int i = 0; i < 32; ++i) vnT[(d0 + i) * TP + q] = f2bf(f[i] * rstd);
    }
    __syncthreads();
    const bf16_t* Wsb = (const bf16_t*)(p.ws + OFF_WSB) + ((size_t)l * 8 + h) * 128 * 128;
    f32x4 acc[2][4];
#pragma unroll
    for (int i = 0; i < 2; ++i)
#pragma unroll
        for (int j = 0; j < 4; ++j) acc[i][j] = (f32x4){0.f, 0.f, 0.f, 0.f};
    const int p0 = wid * 32;
#pragma unroll
    for (int ks = 0; ks < 4; ++ks) {
        bf16x8 af[2], bfr[4];
#pragma unroll
        for (int i = 0; i < 2; ++i) af[i] = *(const bf16x8*)(Wsb + (size_t)(p0 + i * 16 + fr) * 128 + ks * 32 + fq * 8);
#pragma unroll
        for (int j = 0; j < 4; ++j) bfr[j] = *(const bf16x8*)(vnT + (j * 16 + fr) * TP + ks * 32 + fq * 8);
#pragma unroll
        for (int i = 0; i < 2; ++i)
#pragma unroll
            for (int j = 0; j < 4; ++j) acc[i][j] = MFMA16(bfr[j], af[i], acc[i][j]);
    }
    bf16_t* Y = (bf16_t*)(p.ws + OFF_Y);
    float* ssa = (float*)(p.ws + OFF_SSQA);
#pragma unroll
    for (int i = 0; i < 2; ++i) {
        const int pp = p0 + i * 16 + fr, tok = tok0 + pp;
        const float bsv = p.gmlp_bs[((size_t)l * 8 + h) * 128 + pp];
        float ss = 0.f;
#pragma unroll
        for (int j = 0; j < 4; ++j) {
            const int d = j * 16 + fq * 4;
            const uint2 uu = *(const uint2*)(Z + (size_t)tok * NZ + h * 64 + d);
            const float y0 = bf2f(uu.x & 0xffffu) * (acc[i][j][0] + bsv), y1 = bf2f(uu.x >> 16) * (acc[i][j][1] + bsv);
            const float y2 = bf2f(uu.y & 0xffffu) * (acc[i][j][2] + bsv), y3 = bf2f(uu.y >> 16) * (acc[i][j][3] + bsv);
            ss += y0 * y0 + y1 * y1 + y2 * y2 + y3 * y3;
            *(uint2*)(Y + (size_t)tok * D + h * 64 + d) = make_uint2(pk_bf16(y0, y1), pk_bf16(y2, y3));
        }
        ss += __shfl_xor(ss, 16); ss += __shfl_xor(ss, 32);
        if (fq == 0) ssa[(size_t)tok * 8 + h] = ss;
    }
    __syncthreads();
}

__device__ void ffta_item(const Params& p, int item, char* smem) {
    const int tid = otid(), lane = tid & 63, wid = tid >> 6, fr = lane & 15, fq = lane >> 4;
    const int bp = item & 63, g = (item >> 6) & 7, b = item >> 9;
    bf16_t* dT = (bf16_t*)smem;
    const bf16_t* Z = (const bf16_t*)(p.ws + OFF_Z);
    stage_transposed(Z + (size_t)(b * SEQ + bp) * NZ + 1024 + g * 128, (size_t)64 * NZ, dT);
    __syncthreads();
    const bf16_t* DA = (const bf16_t*)(p.ws + OFF_DA);
    f32x4 acc[2][4];
#pragma unroll
    for (int i = 0; i < 2; ++i)
#pragma unroll
        for (int j = 0; j < 4; ++j) acc[i][j] = (f32x4){0.f, 0.f, 0.f, 0.f};
#pragma unroll
    for (int ks = 0; ks < 4; ++ks) {
        bf16x8 af[2], bfr[4];
#pragma unroll
        for (int i = 0; i < 2; ++i) af[i] = *(const bf16x8*)(DA + (size_t)(i * 64 + wid * 16 + fr) * 128 + ks * 32 + fq * 8);
#pragma unroll
        for (int j = 0; j < 4; ++j) bfr[j] = *(const bf16x8*)(dT + (j * 16 + fr) * TP + ks * 32 + fq * 8);
#pragma unroll
        for (int i = 0; i < 2; ++i)
#pragma unroll
            for (int j = 0; j < 4; ++j) acc[i][j] = MFMA16(bfr[j], af[i], acc[i][j]);
    }
    const int k1 = wid * 16 + fr;
    const float2 cs = ((const float2*)(p.ws + OFF_TW))[bp * 64 + k1];
    bf16_t* Yb = (bf16_t*)(p.ws + OFF_H) + ((((size_t)(b * 8 + g) * 64 + k1) * 64 + bp) * 128);
#pragma unroll
    for (int j = 0; j < 4; ++j) {
        const int ch = j * 16 + fq * 4;
        float yr[4], yi[4];
#pragma unroll
        for (int e = 0; e < 4; ++e) { const float r = acc[0][j][e], im = acc[1][j][e]; yr[e] = r * cs.x + im * cs.y; yi[e] = im * cs.x - r * cs.y; }
        *(uint2*)(Yb + ch) = make_uint2(pk_bf16(yr[0], yr[1]), pk_bf16(yr[2], yr[3]));
        *(uint2*)(Yb + 64 + ch) = make_uint2(pk_bf16(yi[0], yi[1]), pk_bf16(yi[2], yi[3]));
    }
    __syncthreads();
}

__device__ void phase_mix(const Params& p, int l, char* smem, int bid, int nb) {
    for (int rd_ = 0; rd_ < ((2048 + 4096) + nb - 1) / nb; ++rd_) { const int item = min(bid + rd_ * nb, (2048 + 4096) - 1);
        if (item < 2048) gmlp_item(p, l, item, smem); else ffta_item(p, item - 2048, smem);
    }
}

__device__ void phase_fftb(const Params& p, int l, char* smem, int bid, int nb) {
    const int tid = otid(), lane = tid & 63, wid = tid >> 6, fr = lane & 15, fq = lane >> 4;
    bf16_t* dT = (bf16_t*)smem;
    const bf16_t* DB = (const bf16_t*)(p.ws + OFF_DB);
    bf16_t* Y = (bf16_t*)(p.ws + OFF_Y);
    float* ssb = (float*)(p.ws + OFF_SSQB);
    for (int rd_ = 0; rd_ < (4096 + nb - 1) / nb; ++rd_) { const int item = min(bid + rd_ * nb, 4096 - 1);
        const int k1 = item & 63, g = (item >> 6) & 7, b = item >> 9;
        stage_transposed((const bf16_t*)(p.ws + OFF_H) + (((size_t)(b * 8 + g) * 64 + k1) * 64) * 128, 128, dT);
        __syncthreads();
        f32x4 acc[4];
#pragma unroll
        for (int j = 0; j < 4; ++j) acc[j] = (f32x4){0.f, 0.f, 0.f, 0.f};
#pragma unroll
        for (int ks = 0; ks < 4; ++ks) {
            const bf16x8 af = *(const bf16x8*)(DB + (size_t)(wid * 16 + fr) * 128 + ks * 32 + fq * 8);
#pragma unroll
            for (int j = 0; j < 4; ++j) { const bf16x8 bfr = *(const bf16x8*)(dT + (j * 16 + fr) * TP + ks * 32 + fq * 8); acc[j] = MFMA16(bfr, af, acc[j]); }
        }
        const int k2 = wid * 16 + fr, tok = b * SEQ + k1 + 64 * k2;
        float ss = 0.f;
#pragma unroll
        for (int j = 0; j < 4; ++j) {
            const int ch = j * 16 + fq * 4;
            const float4 fb = *(const float4*)(p.fnet_b + ((size_t)l * 8 + g) * 64 + ch);
            const float y0 = acc[j][0] * (1.0f / 512.0f) + fb.x, y1 = acc[j][1] * (1.0f / 512.0f) + fb.y, y2 = acc[j][2] * (1.0f / 512.0f) + fb.z, y3 = acc[j][3] * (1.0f / 512.0f) + fb.w;
            ss += y0 * y0 + y1 * y1 + y2 * y2 + y3 * y3;
            *(uint2*)(Y + (size_t)tok * D + 512 + g * 64 + ch) = make_uint2(pk_bf16(y0, y1), pk_bf16(y2, y3));
        }
        ss += __shfl_xor(ss, 16); ss += __shfl_xor(ss, 32);
        if (fq == 0) ssb[(size_t)tok * 8 + g] = ss;
        __syncthreads();
    }
}

#define INS16(a, v) do { a[15] = med3i(a[14], a[15], v); a[14] = med3i(a[13], a[14], v); a[13] = med3i(a[12], a[13], v); a[12] = med3i(a[11], a[12], v); \
    a[11] = med3i(a[10], a[11], v); a[10] = med3i(a[9], a[10], v); a[9] = med3i(a[8], a[9], v); a[8] = med3i(a[7], a[8], v); a[7] = med3i(a[6], a[7], v); \
    a[6] = med3i(a[5], a[6], v); a[5] = med3i(a[4], a[5], v); a[4] = med3i(a[3], a[4], v); a[3] = med3i(a[2], a[3], v); a[2] = med3i(a[1], a[2], v); \
    a[1] = med3i(a[0], a[1], v); a[0] = max(a[0], v); } while (0)

template <int I, int J> struct CandLoop {
    static __device__ __forceinline__ void run(int (&a)[16], const float (&f1)[16], const float (&f2)[16]) {
        if constexpr ((I + 1) * (J + 1) <= 16) { const int key = (f2key(f1[I] + f2[J]) & ~255) | (I * 16 + J); INS16(a, key); }
        if constexpr (J + 1 < 16) CandLoop<I, J + 1>::run(a, f1, f2);
        else if constexpr (I + 1 < 16) CandLoop<I + 1, 0>::run(a, f1, f2);
    }
};

typedef _Float16 f16x2_t __attribute__((ext_vector_type(2)));
__device__ __forceinline__ unsigned pk_f16(float lo, float hi) { const f16x2_t v = {(_Float16)lo, (_Float16)hi}; return __builtin_bit_cast(unsigned, v); }
__device__ __forceinline__ int h2key(unsigned bits16) { const int b = (int)(short)bits16; return b ^ ((b >> 15) & 0x7fff); }
__device__ __forceinline__ float key2h(int k) { const int b = k ^ ((k >> 15) & 0x7fff); return (float)__builtin_bit_cast(_Float16, (unsigned short)(b & 0xffff)); }

__device__ void phase_topk(const Params& p, int l, char* smem, int bid, int nb) {
    const int tid = otid(), lane = tid & 63, wid = tid >> 6, fr = lane & 15, fq = lane >> 4;
    unsigned* S32 = (unsigned*)smem;
    int* TT = (int*)smem;
    const bf16_t* Q = (const bf16_t*)(p.ws + OFF_Z);
    int* eidx = (int*)(p.ws + OFF_Y); float* gw = (float*)(p.ws + OFF_Y + (size_t)T * 128 * 4);
    const int hh = wid >> 1, half = wid & 1;
    for (int rd_ = 0; rd_ < (((T / 64) * 4) + nb - 1) / nb; ++rd_) { const int item = min(bid + rd_ * nb, ((T / 64) * 4) - 1);
        const int hp = item & 3, tok0 = (item >> 2) * 64, h = hp * 2 + hh;
        const bf16_t* Kh = (const bf16_t*)(p.ws + OFF_K12) + (((size_t)l * 8 + h) * 256 + half * 128) * 128;
        const bf16_t* Qh = Q + (size_t)tok0 * 2048 + h * 256 + half * 128;
        {
            f32x4 acc[4][8];
#pragma unroll
            for (int i = 0; i < 4; ++i)
#pragma unroll
                for (int j = 0; j < 8; ++j) acc[i][j] = (f32x4){0.f, 0.f, 0.f, 0.f};
#pragma unroll
            for (int ks = 0; ks < 4; ++ks) {
                bf16x8 af[4];
#pragma unroll
                for (int i = 0; i < 4; ++i) af[i] = *(const bf16x8*)(Qh + (size_t)(i * 16 + fr) * 2048 + ks * 32 + fq * 8);
#pragma unroll
                for (int jh = 0; jh < 2; ++jh) {
                    bf16x8 bfr[4];
#pragma unroll
                    for (int j = 0; j < 4; ++j) bfr[j] = *(const bf16x8*)(Kh + (size_t)((jh * 4 + j) * 16 + fr) * 128 + ks * 32 + fq * 8);
#pragma unroll
                    for (int i = 0; i < 4; ++i)
#pragma unroll
                        for (int j = 0; j < 4; ++j) acc[i][jh * 4 + j] = MFMA16(bfr[j], af[i], acc[i][jh * 4 + j]);
                    __builtin_amdgcn_sched_barrier(0);
                }
            }
#pragma unroll
            for (int i = 0; i < 4; ++i)
#pragma unroll
                for (int j = 0; j < 8; ++j) {
                    unsigned* d = S32 + (i * 16 + fr) * 257 + hh * 128 + half * 64 + j * 8 + fq * 2;
                    d[0] = pk_f16(acc[i][j][0], acc[i][j][1]); d[1] = pk_f16(acc[i][j][2], acc[i][j][3]);
                }
        }
        vsync(smem);
        int a[16];
#pragma unroll
        for (int i = 0; i < 16; ++i) a[i] = (int)0x80000000;
        {
            const unsigned* sr = S32 + lane * 257 + hh * 128 + half * 64;
#pragma unroll 2
            for (int i = 0; i < 64; ++i) {
                const unsigned w = sr[i];
                const int k0 = (h2key(w & 0xffffu) << 7) | (2 * i), k1 = (h2key(w >> 16) << 7) | (2 * i + 1);
                INS16(a, k0); INS16(a, k1);
            }
        }
        vsync(smem);
#pragma unroll
        for (int i = 0; i < 16; ++i) TT[((lane * 2 + hh) * 2 + half) * 16 + i] = a[i];
        vsync(smem);
        if (tid < 128) {
            const int tk = tid & 63, h2 = tid >> 6, hd = hp * 2 + h2;
            const int* t1 = TT + ((tk * 2 + h2) * 2) * 16; const int* t2 = t1 + 16;
            float f1[16], f2[16];
#pragma unroll
            for (int i = 0; i < 16; ++i) { f1[i] = key2h(t1[i] >> 7); f2[i] = key2h(t2[i] >> 7); }
            int c[16];
#pragma unroll
            for (int i = 0; i < 16; ++i) c[i] = (int)0x80000000;
            CandLoop<0, 0>::run(c, f1, f2);
            float sc[16], e[16], sum = 0.f; int ex[16];
#pragma unroll
            for (int i = 0; i < 16; ++i) {
                sc[i] = key2f(c[i] & ~255);
                const int code = c[i] & 255;
                ex[i] = (t1[code >> 4] & 127) * 128 + (t2[code & 15] & 127);
            }
#pragma unroll
            for (int i = 0; i < 16; ++i) { e[i] = __expf(sc[i] - sc[0]); sum += e[i]; }
            const float inv = 1.0f / sum;
            int4* ep = (int4*)(eidx + (size_t)(tok0 + tk) * 128 + hd * 16); float4* gp = (float4*)(gw + (size_t)(tok0 + tk) * 128 + hd * 16);
#pragma unroll
            for (int i = 0; i < 4; ++i) { ep[i] = make_int4(ex[4 * i], ex[4 * i + 1], ex[4 * i + 2], ex[4 * i + 3]); gp[i] = make_float4(e[4 * i] * inv, e[4 * i + 1] * inv, e[4 * i + 2] * inv, e[4 * i + 3] * inv); }
        }
        vsync(smem);
    }
}

__device__ __forceinline__ float dot16_fp8(const float (&h)[16], const int4& u) {
    const int w[4] = {u.x, u.y, u.z, u.w};
    f32x2_t a = {0.f, 0.f};
#pragma unroll
    for (int i = 0; i < 4; ++i) {
        const f32x2_t lo = __builtin_amdgcn_cvt_pk_f32_fp8(w[i], false), hi = __builtin_amdgcn_cvt_pk_f32_fp8(w[i], true);
        const f32x2_t h0 = {h[4 * i], h[4 * i + 1]}, h1 = {h[4 * i + 2], h[4 * i + 3]};
        a = __builtin_elementwise_fma(lo, h0, a); a = __builtin_elementwise_fma(hi, h1, a);
    }
    return a.x + a.y;
}
__device__ __forceinline__ void axpy16_fp8(float (&o)[16], float c, const int4& v) {
    const int w[4] = {v.x, v.y, v.z, v.w};
#pragma unroll
    for (int i = 0; i < 4; ++i) {
        const f32x2_t lo = __builtin_amdgcn_cvt_pk_f32_fp8(w[i], false), hi = __builtin_amdgcn_cvt_pk_f32_fp8(w[i], true);
        o[4 * i] += c * lo.x; o[4 * i + 1] += c * lo.y; o[4 * i + 2] += c * hi.x; o[4 * i + 3] += c * hi.y;
    }
}

typedef _Float16 h2_t __attribute__((ext_vector_type(2)));
__device__ __forceinline__ float dot32_fp4(const h2_t (&h)[16], const int4& u) {
    const unsigned w[4] = {(unsigned)u.x, (unsigned)u.y, (unsigned)u.z, (unsigned)u.w};
    float a0 = 0.f, a1 = 0.f;
#pragma unroll
    for (int i = 0; i < 4; ++i) {
        a0 = __builtin_amdgcn_fdot2(__builtin_bit_cast(h2_t, __builtin_amdgcn_cvt_scalef32_pk_f16_fp4(w[i], 1.0f, 0)), h[4 * i], a0, false);
        a1 = __builtin_amdgcn_fdot2(__builtin_bit_cast(h2_t, __builtin_amdgcn_cvt_scalef32_pk_f16_fp4(w[i], 1.0f, 1)), h[4 * i + 1], a1, false);
        a0 = __builtin_amdgcn_fdot2(__builtin_bit_cast(h2_t, __builtin_amdgcn_cvt_scalef32_pk_f16_fp4(w[i], 1.0f, 2)), h[4 * i + 2], a0, false);
        a1 = __builtin_amdgcn_fdot2(__builtin_bit_cast(h2_t, __builtin_amdgcn_cvt_scalef32_pk_f16_fp4(w[i], 1.0f, 3)), h[4 * i + 3], a1, false);
    }
    return a0 + a1;
}
typedef int v8i_t __attribute__((ext_vector_type(8)));
typedef int i32x4_t __attribute__((ext_vector_type(4)));
typedef int i32x2_t __attribute__((ext_vector_type(2)));
constexpr float PU_XS = 4.0f;
constexpr int PU_WAVE_LDS = 16384 + 2048;
__device__ __forceinline__ void glds16(const void* g, unsigned lds_addr) {
    unsigned sv_;
    asm volatile("s_mov_b32 %0, m0\n\ts_mov_b32 m0, %2\n\ts_nop 0\n\tglobal_load_lds_dwordx4 %1, off\n\ts_mov_b32 m0, %0" : "=&s"(sv_) : "v"(g), "s"(lds_addr) : "memory");
}
__device__ void phase_pu(const Params& p, int l, int slice, int grank_base, int gsz, char* smem512) {
    int tid_ = threadIdx.x; asm volatile("" : "+v"(tid_));
    asm volatile("" : "+s"(slice), "+s"(grank_base), "+s"(gsz));
    const int lane = tid_ & 63, wid = __builtin_amdgcn_readfirstlane(tid_ >> 6), n16 = lane & 15, q4 = lane >> 4;
    const char* U4 = p.ws + OFF_UB + ((size_t)(l * 4 + slice) * NE) * 128 + 16 * ((lane & 7) ^ (lane >> 3));
    const char* msrc = lane < 32 ? (p.ws + OFF_Y + 16 * lane) : (p.ws + OFF_H + (size_t)slice * 512 + 16 * (lane - 32));
    const size_t mstep = lane < 32 ? 512 : 2048;
    float* part = (float*)(p.ws + OFF_Z) + (size_t)slice * T * 128 + 16 * q4 + n16;
    const int stride = gsz * 4;
    LAS char* wl = (LAS char*)smem512 + wid * PU_WAVE_LDS;
    const unsigned wla = (unsigned)(size_t)wl;
    const int boff = n16 * 128 + 16 * (q4 ^ (n16 & 7));
    const int ioff = 4 * (lane >> 3);
#define PU_META(tok_, mb_) glds16(msrc + (size_t)(tok_) * mstep, wla + 16384u + (unsigned)(mb_))
#define PU_IDS(id_, mb_, h_) do { _Pragma("unroll") for (int i_ = 0; i_ < 8; ++i_) id_[i_] = *(const LAS int*)(wl + 16384 + (mb_) + 256 * (h_) + ioff + 32 * i_); } while (0)
#define PU_DMA(id_, h_) do { _Pragma("unroll") for (int i_ = 0; i_ < 8; ++i_) glds16(U4 + (size_t)id_[i_] * 128, wla + (unsigned)((h_) * 8192 + i_ * 1024)); } while (0)
#define PU_HALF(h_) do { i32x4_t b0_[4], b1_[4]; \
        _Pragma("unroll") for (int m_ = 0; m_ < 4; ++m_) { b0_[m_] = *(const LAS i32x4_t*)(wl + (h_) * 8192 + m_ * 2048 + boff); b1_[m_] = *(const LAS i32x4_t*)(wl + (h_) * 8192 + m_ * 2048 + (boff ^ 64)); } \
        _Pragma("unroll") for (int m_ = 0; m_ < 4; ++m_) { \
        const v8i_t B0 = {b0_[m_][0], b0_[m_][1], b0_[m_][2], b0_[m_][3], 0, 0, 0, 0}, B1 = {b1_[m_][0], b1_[m_][1], b1_[m_][2], b1_[m_][3], 0, 0, 0, 0}; \
        acc[(h_) * 4 + m_] = __builtin_amdgcn_mfma_scale_f32_16x16x128_f8f6f4(A0, B0, acc[(h_) * 4 + m_], 0, 4, 0, 0, 0, 0); \
        acc[(h_) * 4 + m_] = __builtin_amdgcn_mfma_scale_f32_16x16x128_f8f6f4(A1, B1, acc[(h_) * 4 + m_], 0, 4, 0, 0, 0, 0); } } while (0)
    const int tok0 = grank_base * 4 + wid;
    if (tok0 >= T) return;
    const int nit = (T - tok0 + stride - 1) / stride;
    int tok = tok0, tok1 = min(tok0 + stride, T - 1);
    int idA[8], idB[8];
    PU_META(tok, 0); PU_META(tok1, 1024);
    asm volatile("s_waitcnt vmcnt(0)" ::: "memory");
    PU_IDS(idA, 0, 0); PU_IDS(idB, 0, 1);
    PU_DMA(idA, 0);
#pragma nounroll
    for (int it = 0; it < nit; ++it) {
        const int mbc = (it & 1) * 1024, mbn = 1024 - mbc;
        __builtin_amdgcn_sched_barrier(0);
        PU_DMA(idB, 1);
        asm volatile("s_waitcnt vmcnt(8)" ::: "memory");
        __builtin_amdgcn_sched_barrier(0);
        { const i32x2_t xr = *(const LAS i32x2_t*)(wl + 16384 + mbc + 512 + 8 * lane);
          const float f0 = fminf(fmaxf(bf2f((unsigned)xr[0] & 0xffffu) * PU_XS, -448.f), 448.f), f1 = fminf(fmaxf(bf2f((unsigned)xr[0] >> 16) * PU_XS, -448.f), 448.f),
                      f2 = fminf(fmaxf(bf2f((unsigned)xr[1] & 0xffffu) * PU_XS, -448.f), 448.f), f3 = fminf(fmaxf(bf2f((unsigned)xr[1] >> 16) * PU_XS, -448.f), 448.f);
          int w = __builtin_amdgcn_cvt_pk_fp8_f32(f0, f1, 0, false); w = __builtin_amdgcn_cvt_pk_fp8_f32(f2, f3, w, true);
          *(LAS int*)(wl + 16384 + mbc + 512 + 4 * lane) = w; }
        PU_IDS(idA, mbn, 0);
        asm volatile("s_waitcnt lgkmcnt(0)" ::: "memory");
        const LAS char* xb = wl + 16384 + mbc + 512 + 16 * q4;
        const i32x4_t a00 = *(const LAS i32x4_t*)(xb), a01 = *(const LAS i32x4_t*)(xb + 64), a10 = *(const LAS i32x4_t*)(xb + 128), a11 = *(const LAS i32x4_t*)(xb + 192);
        const v8i_t A0 = {a00[0], a00[1], a00[2], a00[3], a01[0], a01[1], a01[2], a01[3]}, A1 = {a10[0], a10[1], a10[2], a10[3], a11[0], a11[1], a11[2], a11[3]};
        f32x4 acc[8];
#pragma unroll
        for (int m = 0; m < 8; ++m) acc[m] = (f32x4){0.f, 0.f, 0.f, 0.f};
        PU_HALF(0);
        asm volatile("s_waitcnt lgkmcnt(0)" ::: "memory");
        __builtin_amdgcn_sched_barrier(0);
        const int tok2 = min(tok1 + stride, T - 1);
        PU_DMA(idA, 0);
        PU_META(tok2, mbc);
        asm volatile("s_waitcnt vmcnt(9)" ::: "memory");
        __builtin_amdgcn_sched_barrier(0);
        PU_IDS(idB, mbn, 1);
        PU_HALF(1);
        __builtin_amdgcn_sched_barrier(0);
        float s0 = acc[0][0], s1 = acc[4][0];
        s0 = q4 == 1 ? acc[1][0] : s0; s1 = q4 == 1 ? acc[5][0] : s1;
        s0 = q4 == 2 ? acc[2][0] : s0; s1 = q4 == 2 ? acc[6][0] : s1;
        s0 = q4 == 3 ? acc[3][0] : s0; s1 = q4 == 3 ? acc[7][0] : s1;
        float* pr = part + (size_t)tok * 128;
        pr[0] = s0 * (1.0f / PU_XS); pr[64] = s1 * (1.0f / PU_XS);
        tok = tok1; tok1 = tok2;
    }
    asm volatile("s_waitcnt vmcnt(0)" ::: "memory");
#undef PU_META
#undef PU_IDS
#undef PU_DMA
#undef PU_HALF
}
__device__ void phase_pc(const Params& p, int l, int bid, int nb) {
    const int tid_ = otid(); const int lane = tid_ & 63, wid = tid_ >> 6;
    const int* eidx = (const int*)(p.ws + OFF_Y); const float* gw = (const float*)(p.ws + OFF_Y + (size_t)T * 128 * 4);
    unsigned char* crec = (unsigned char*)(p.ws + OFF_Y + (size_t)T * 128 * 8);
    const float* part = (const float*)(p.ws + OFF_Z);
    const float* usc = (const float*)(p.ws + OFF_USC) + (size_t)l * NE; const float* vsc = (const float*)(p.ws + OFF_VSC) + (size_t)l * NE;
    constexpr int NU = 2;
    for (int tok0 = bid * 4 + wid; tok0 < T; tok0 += nb * 4 * NU) {
        int tk[NU]; bool ok[NU];
#pragma unroll
        for (int u = 0; u < NU; ++u) { ok[u] = tok0 + u * nb * 4 < T; tk[u] = ok[u] ? tok0 + u * nb * 4 : tok0; }
        int e[NU][2]; float g[NU][2], a[NU][2][4];
#pragma unroll
        for (int u = 0; u < NU; ++u)
#pragma unroll
            for (int hh = 0; hh < 2; ++hh) { const size_t j = (size_t)tk[u] * 128 + hh * 64 + lane; e[u][hh] = eidx[j]; g[u][hh] = gw[j];
#pragma unroll
                for (int sl = 0; sl < 4; ++sl) a[u][hh][sl] = part[(size_t)sl * T * 128 + j]; }
        float us[NU][2], vs[NU][2];
#pragma unroll
        for (int u = 0; u < NU; ++u)
#pragma unroll
            for (int hh = 0; hh < 2; ++hh) { us[u][hh] = usc[e[u][hh]]; vs[u][hh] = vsc[e[u][hh]]; }
#pragma unroll
        for (int u = 0; u < NU; ++u) {
            float c[2];
#pragma unroll
            for (int hh = 0; hh < 2; ++hh) c[hh] = g[u][hh] * gelu_f(((a[u][hh][0] + a[u][hh][1]) + (a[u][hh][2] + a[u][hh][3])) * us[u][hh]) * vs[u][hh];
            float m = fmaxf(fabsf(c[0]), fabsf(c[1]));
#pragma unroll
            for (int o = 32; o >= 1; o >>= 1) m = fmaxf(m, __shfl_xor(m, o));
            const float S = (m > 1e-30f) ? 256.0f / m : 1.0f;
            unsigned char* rec = crec + (size_t)tk[u] * 512;
#pragma unroll
            for (int hh = 0; hh < 2; ++hh) {
                const float cs = c[hh] * S;
                const int hi = __builtin_amdgcn_cvt_pk_fp8_f32(cs, 0.f, 0, false) & 0xff;
                const float r = (cs - __builtin_amdgcn_cvt_f32_fp8(hi, 0)) * 16.0f;
                const int lo = __builtin_amdgcn_cvt_pk_fp8_f32(r, 0.f, 0, false) & 0xff;
                if (ok[u]) { rec[hh * 64 + lane] = (unsigned char)hi; rec[128 + hh * 64 + lane] = (unsigned char)lo; }
            }
            if (lane == 0 && ok[u]) *(float*)(rec + 256) = 1.0f / S;
        }
    }
}
__device__ void phase_pv(const Params& p, int l, int slice, int grank_base, int gsz, char* smem512) {
    int tid_ = threadIdx.x; asm volatile("" : "+v"(tid_));
    asm volatile("" : "+s"(slice), "+s"(grank_base), "+s"(gsz));
    const int lane = tid_ & 63, wid = __builtin_amdgcn_readfirstlane(tid_ >> 6), n16 = lane & 15, q4 = lane >> 4;
    const char* V4e = p.ws + OFF_VB + ((size_t)(l * 4 + slice) * NE) * 128 + 16 * ((lane & 7) ^ (lane >> 4));
    const char* V4o = p.ws + OFF_VB + ((size_t)(l * 4 + slice) * NE) * 128 + 16 * ((lane & 7) ^ (lane >> 4) ^ 4);
    const char* msrc = lane < 32 ? (p.ws + OFF_Y + 16 * lane) : (p.ws + OFF_Y + (size_t)T * 128 * 8 + 16 * (lane - 32));
    bf16_t* Sout = (bf16_t*)(p.ws + OFF_Z) + slice * 256 + 4 * lane;
    const int stride = gsz * 4;
    LAS char* wl = (LAS char*)smem512 + wid * PU_WAVE_LDS;
    const unsigned wla = (unsigned)(size_t)wl;
    const int ioff = 4 * (lane >> 3);
    const int rowb = (q4 >> 1) * 8192 + (32 * (q4 & 1) + n16) * 128;
    int vad[8];
#pragma unroll
    for (int jj = 0; jj < 8; ++jj) vad[jj] = rowb + ((16 * jj) ^ (16 * (n16 >> 1)));
    const int aoff = 16384 + 512 + 128 * (n16 & 1) + 16 * q4;
#define PV_META(tok_, mb_) glds16(msrc + (size_t)(tok_) * 512, wla + 16384u + (unsigned)(mb_))
#define PV_IDS(id_, mb_) do { _Pragma("unroll") for (int i_ = 0; i_ < 16; ++i_) id_[i_] = *(const LAS int*)(wl + 16384 + (mb_) + ioff + 32 * i_); } while (0)
#define PV_DMA(id_) do { _Pragma("unroll") for (int i_ = 0; i_ < 16; ++i_) glds16(((i_ & 1) ? V4o : V4e) + (size_t)id_[i_] * 128, wla + (unsigned)(i_ * 1024)); } while (0)
    const int tok0 = grank_base * 4 + wid;
    if (tok0 >= T) return;
    const int nit = (T - tok0 + stride - 1) / stride;
    int tok = tok0, tok1 = min(tok0 + stride, T - 1);
    int idv[16];
    PV_META(tok, 0);
    asm volatile("s_waitcnt vmcnt(0)" ::: "memory");
    PV_IDS(idv, 0);
    asm volatile("s_waitcnt lgkmcnt(0)" ::: "memory");
    PV_DMA(idv);
    PV_META(tok1, 1024);
#pragma nounroll
    for (int it = 0; it < nit; ++it) {
        const int mbc = (it & 1) * 1024, mbn = 1024 - mbc;
        __builtin_amdgcn_sched_barrier(0);
        asm volatile("s_waitcnt vmcnt(1)" ::: "memory");
        __builtin_amdgcn_sched_barrier(0);
        const i32x4_t a0 = *(const LAS i32x4_t*)(wl + mbc + aoff), a1 = *(const LAS i32x4_t*)(wl + mbc + aoff + 64);
        const float invS = *(const LAS float*)(wl + 16384 + mbc + 512 + 256);
        const v8i_t A = {a0[0], a0[1], a0[2], a0[3], a1[0], a1[1], a1[2], a1[3]};
        i32x2_t bt[16][2];
#pragma unroll
        for (int j = 0; j < 16; ++j) {
            bt[j][0] = __builtin_amdgcn_ds_read_tr4_b64_v2i32((LAS i32x2_t*)(wl + vad[j >> 1] + 8 * (j & 1)));
            bt[j][1] = __builtin_amdgcn_ds_read_tr4_b64_v2i32((LAS i32x2_t*)(wl + vad[j >> 1] + 8 * (j & 1) + 2048));
        }
        asm volatile("s_waitcnt vmcnt(0)" ::: "memory");
        PV_IDS(idv, mbn);
        asm volatile("s_waitcnt lgkmcnt(0)" ::: "memory");
        __builtin_amdgcn_sched_barrier(0);
        PV_DMA(idv);
        __builtin_amdgcn_sched_barrier(0);
        f32x4 acc[16];
#pragma unroll
        for (int j = 0; j < 16; ++j) {
            const v8i_t B = {bt[j][0][0], bt[j][0][1], bt[j][1][0], bt[j][1][1], 0, 0, 0, 0};
            acc[j] = __builtin_amdgcn_mfma_scale_f32_16x16x128_f8f6f4(A, B, (f32x4){0.f, 0.f, 0.f, 0.f}, 0, 4, 0, 0, 0, 0);
        }
        float v0 = acc[0][0] + acc[0][1] * 0.0625f, v1 = acc[1][0] + acc[1][1] * 0.0625f, v2 = acc[2][0] + acc[2][1] * 0.0625f, v3 = acc[3][0] + acc[3][1] * 0.0625f;
#pragma unroll
        for (int qq = 1; qq < 4; ++qq) {
            v0 = q4 == qq ? acc[4 * qq][0] + acc[4 * qq][1] * 0.0625f : v0; v1 = q4 == qq ? acc[4 * qq + 1][0] + acc[4 * qq + 1][1] * 0.0625f : v1;
            v2 = q4 == qq ? acc[4 * qq + 2][0] + acc[4 * qq + 2][1] * 0.0625f : v2; v3 = q4 == qq ? acc[4 * qq + 3][0] + acc[4 * qq + 3][1] * 0.0625f : v3;
        }
        LAS float* tb = (LAS float*)(wl + 16384 + mbc);
        tb[64 * q4 + n16] = v0; tb[64 * q4 + 16 + n16] = v1; tb[64 * q4 + 32 + n16] = v2; tb[64 * q4 + 48 + n16] = v3;
        asm volatile("s_waitcnt lgkmcnt(0)" ::: "memory");
        const f32x4 o = *(const LAS f32x4*)(tb + 4 * lane);
        *(uint2*)(Sout + (size_t)tok * D) = make_uint2(pk_bf16(o[0] * invS, o[1] * invS), pk_bf16(o[2] * invS, o[3] * invS));
        asm volatile("s_waitcnt lgkmcnt(0)" ::: "memory");
        __builtin_amdgcn_sched_barrier(0);
        const int tok2 = min(tok1 + stride, T - 1);
        PV_META(tok2, mbc);
        tok = tok1; tok1 = tok2;
    }
    asm volatile("s_waitcnt vmcnt(0)" ::: "memory");
#undef PV_META
#undef PV_IDS
#undef PV_DMA
}
__device__ void phase_final_norm(const Params& p, int bid, int nb) {
    const int tid_ = otid(); const int lane = tid_ & 63, wid = tid_ >> 6;
    const bf16_t* sadd = (const bf16_t*)(p.ws + OFF_Z); const float* g2l = (const float*)(p.ws + OFF_MOD) + (size_t)(NL - 1) * NB * 6144 + 5 * D;
    constexpr int NU = 2;
    for (int tok0 = bid * 4 + wid; tok0 < T; tok0 += nb * 4 * NU) {
        int tk[NU]; bool ok[NU];
#pragma unroll
        for (int u = 0; u < NU; ++u) { ok[u] = tok0 + u * nb * 4 < T; tk[u] = ok[u] ? tok0 + u * nb * 4 : tok0; }
        uint2 xw[NU][4], sw[NU][4]; float4 g2[NU][4];
#pragma unroll
        for (int u = 0; u < NU; ++u)
#pragma unroll
            for (int i = 0; i < 4; ++i) { const size_t o = (size_t)tk[u] * D + i * 256 + lane * 4;
                xw[u][i] = *(const uint2*)((const bf16_t*)(p.ws + OFF_XR) + o); sw[u][i] = *(const uint2*)(sadd + o); g2[u][i] = *(const float4*)(g2l + (size_t)(tk[u] / SEQ) * 6144 + i * 256 + lane * 4); }
#pragma unroll
        for (int u = 0; u < NU; ++u) {
            float4 v[4]; float ss = 0.f;
#pragma unroll
            for (int i = 0; i < 4; ++i) { const uint2 w = xw[u][i], s_ = sw[u][i]; const float4 g_ = g2[u][i];
                v[i] = make_float4(bf2f(w.x & 0xffffu) + g_.x * bf2f(s_.x & 0xffffu), bf2f(w.x >> 16) + g_.y * bf2f(s_.x >> 16), bf2f(w.y & 0xffffu) + g_.z * bf2f(s_.y & 0xffffu), bf2f(w.y >> 16) + g_.w * bf2f(s_.y >> 16));
                ss += v[i].x * v[i].x + v[i].y * v[i].y + v[i].z * v[i].z + v[i].w * v[i].w; }
            const float rstd = rsqrtf(wave_sum(ss) * (1.0f / D) + EPS);
            float* xr = p.out + (size_t)tk[u] * D;
#pragma unroll
            for (int i = 0; i < 4; ++i) { const float4 g = *(const float4*)(p.final_g + i * 256 + lane * 4);
                if (ok[u]) *(float4*)(xr + i * 256 + lane * 4) = make_float4(v[i].x * rstd * g.x, v[i].y * rstd * g.y, v[i].z * rstd * g.z, v[i].w * rstd * g.w); }
        }
    }
}

#define XB_TMO      128
#define XB_XCNT(j)  (256  + 64 * (j))
#define XB_XSUB(j)  (1280 + 64 * (j))
#define XB_XGEN(j)  (2304 + 64 * (j))
#define XB_TOP      3328
#define XB_TOPGEN   3392
#define XCD_BAR_WORDS 3456
#define XB_SPIN_CAP (1u << 22)
__device__ __forceinline__ unsigned xb_ld(unsigned* p)              { return __hip_atomic_load(p, __ATOMIC_RELAXED, __HIP_MEMORY_SCOPE_AGENT); }
__device__ __forceinline__ unsigned xb_add(unsigned* p, unsigned v) { return __hip_atomic_fetch_add(p, v, __ATOMIC_RELAXED, __HIP_MEMORY_SCOPE_AGENT); }
__device__ __forceinline__ unsigned xb_xcc_id() { return (unsigned)__builtin_amdgcn_s_getreg((3 << 11) | 20) & 0xFu; }
#define XB_SPIN(cond, bar) do { unsigned _sp = 0; while (cond) { __builtin_amdgcn_s_sleep(1); \
    if ((++_sp & 255u) == 0u) { if (xb_ld(&(bar)[XB_TMO])) break; if (_sp > XB_SPIN_CAP) { atomicAdd(&(bar)[XB_TMO], 1u); break; } } } } while (0)
__device__ __forceinline__ void xcd_barrier_post(unsigned* bar, volatile LAS unsigned* st) {
    if (threadIdx.x == 0) { const unsigned x = xb_xcc_id(); st[3] = x; st[2] = xb_add(&bar[XB_XCNT(x)], 1u); }
}
__device__ __forceinline__ void xcd_barrier_complete(unsigned* bar, unsigned x, unsigned& nloc, unsigned& nx) {
    const unsigned G = gridDim.x * gridDim.y * gridDim.z;
    unsigned sum, cnt, mine, sp = 0u;
    for (;;) {
        sum = 0u; cnt = 0u; mine = 0u;
#pragma unroll
        for (unsigned j = 0; j < 16; ++j) { const unsigned c = xb_ld(&bar[XB_XCNT(j)]); sum += c; cnt += (c > 0u) ? 1u : 0u; mine = (j == x) ? c : mine; }
        if (sum == G) break;
        __builtin_amdgcn_s_sleep(1);
        if ((++sp & 255u) == 0u) { if (xb_ld(&bar[XB_TMO])) break; if (sp > XB_SPIN_CAP) { atomicAdd(&bar[XB_TMO], 1u); break; } }
    }
    nloc = mine > 0u ? mine : 1u; nx = cnt > 0u ? cnt : 1u;
}
__device__ __forceinline__ void xcd_barrier(unsigned* bar, volatile LAS unsigned* st) {
    asm volatile("s_waitcnt vmcnt(0)" ::: "memory");
    __syncthreads();
    int t0_ = threadIdx.x; asm volatile("" : "+v"(t0_));
    if (t0_ == 0) {
        __builtin_amdgcn_s_waitcnt(0);
        unsigned nloc = st[0], nx = st[1]; const unsigned x = st[3];
        if (nloc == 0u) { xcd_barrier_complete(bar, x, nloc, nx); st[0] = nloc; st[1] = nx; }
        const unsigned old = xb_add(&bar[XB_XSUB(x)], 1u);
        const unsigned gen = old / nloc;
        if (old + 1u == (gen + 1u) * nloc) {
            __builtin_amdgcn_fence(__ATOMIC_RELEASE, "agent");
            asm volatile("s_waitcnt vmcnt(0)" ::: "memory");
            const unsigned og = xb_add(&bar[XB_TOP], 1u);
            const unsigned tg = og / nx;
            if (og + 1u == (tg + 1u) * nx) xb_add(&bar[XB_TOPGEN], 1u);
            else XB_SPIN(xb_ld(&bar[XB_TOPGEN]) == tg, bar);
            __builtin_amdgcn_fence(__ATOMIC_ACQUIRE, "agent");
            xb_add(&bar[XB_XGEN(x)], 1u);
            asm volatile("s_waitcnt vmcnt(0)" ::: "memory");
        } else {
            XB_SPIN(xb_ld(&bar[XB_XGEN(x)]) == gen, bar);
            __builtin_amdgcn_fence(__ATOMIC_ACQUIRE, "agent");
            asm volatile("s_waitcnt vmcnt(0)" ::: "memory");
        }
    }
    __syncthreads();
}

#if MEGA
#if PROBE_A >= 0
#define TSTAMP(i) do { if (blockIdx.x == 0 && threadIdx.x == 0) ts[i] = __builtin_amdgcn_s_memrealtime(); } while (0)
#else
#define TSTAMP(i) do { } while (0)
#endif
__global__ void __launch_bounds__(512, 2) mega_kernel(Params p) {
    __shared__ __attribute__((aligned(16))) char smem[2 * SMEM_BYTES + 32];
#if PROBE_A >= 0
    __shared__ unsigned long long ts[26];
#endif
#if COOP
    cg::grid_group grid = cg::this_grid();
#endif
    const int vb = threadIdx.x >> 8;
    const int bid = blockIdx.x * 2 + vb, nb = gridDim.x * 2;
    char* smv = smem + vb * SMEM_BYTES;
    unsigned* bar = (unsigned*)(p.ws + OFF_BAR);
    volatile LAS unsigned* xst = (volatile LAS unsigned*)(smem + 2 * SMEM_BYTES);
#define GBAR() xcd_barrier((unsigned*)(p.ws + OFF_BAR), (volatile LAS unsigned*)(smem + 2 * SMEM_BYTES))
    if (threadIdx.x == 0) { xst[0] = 0u; xst[1] = 0u; xst[2] = 0u; xst[3] = 0u; xst[4] = 0u; xst[5] = 0u; }
    __syncthreads();
#if COOP
    if (blockIdx.x == 0) for (int i = threadIdx.x; i < XCD_BAR_WORDS; i += 512) bar[i] = 0u;
    TSTAMP(0);
    phase_prep(p, smv, bid, nb);
    grid.sync();
    xcd_barrier_post(bar, xst);
#else
    __syncthreads();
    xcd_barrier_post(bar, xst);
    TSTAMP(0);
    phase_prep(p, smv, bid, nb);
    GBAR();
#endif
    TSTAMP(1);
    phase_norm<false, false, 2>(p.x, p.norm1_g, (const float*)(p.ws + OFF_MOD), 0, D, (bf16_t*)(p.ws + OFF_H), bid, nb, nullptr, nullptr, (bf16_t*)(p.ws + OFF_XR)); GBAR();
    int slice4, grank4; const int gsz4 = (int)gridDim.x / 4 * 2;
    {
        const unsigned myx = xst[3], myrank = xst[2];
        unsigned pre = 0;
#pragma unroll
        for (unsigned j = 0; j < 16; ++j) { const unsigned c = xb_ld(&bar[XB_XCNT(j)]); pre += (j < myx) ? c : 0u; }
        const int gi = __builtin_amdgcn_readfirstlane((int)(pre + myrank));
        slice4 = gi / ((int)gridDim.x / 4); grank4 = (gi % ((int)gridDim.x / 4)) * 2;
    }
#pragma nounroll
    for (int l = 0; l < NL; ++l) {
        TSTAMP(2 + 11 * l); phase_gemm1(p, l, smem); GBAR();
        TSTAMP(3 + 11 * l); phase_mix(p, l, smv, bid, nb); GBAR();
        TSTAMP(4 + 11 * l); phase_fftb(p, l, smv, bid, nb); GBAR();
        TSTAMP(5 + 11 * l); phase_gemm2(p, l, smem); GBAR();
        TSTAMP(6 + 11 * l); phase_norm<true, false, 2>(p.ws + OFF_XR, p.norm2_g + l * D, (const float*)(p.ws + OFF_MOD) + (size_t)l * NB * 6144, 3 * D, 4 * D, (bf16_t*)(p.ws + OFF_H), bid, nb); GBAR();
        TSTAMP(7 + 11 * l); phase_gemm3(p, l, smem); GBAR();
        TSTAMP(8 + 11 * l); phase_topk(p, l, smv, bid, nb); GBAR();
        TSTAMP(9 + 11 * l); phase_pu(p, l, slice4, grank4, gsz4, smem); GBAR();
        TSTAMP(10 + 11 * l); phase_pc(p, l, bid, nb); GBAR();
        TSTAMP(11 + 11 * l); phase_pv(p, l, slice4, grank4, gsz4, smem); GBAR();
        TSTAMP(12 + 11 * l);
        if (l + 1 < NL) { phase_norm<true, true>(p.ws + OFF_XR, p.norm1_g + (l + 1) * D, (const float*)(p.ws + OFF_MOD) + (size_t)(l + 1) * NB * 6144, 0, D, (bf16_t*)(p.ws + OFF_H), bid, nb,
                                                 (const bf16_t*)(p.ws + OFF_Z), (const float*)(p.ws + OFF_MOD) + (size_t)l * NB * 6144 + 5 * D); GBAR(); }
        else phase_final_norm(p, bid, nb);
    }
#undef GBAR
    TSTAMP(24);
#if PROBE_A >= 0
    if (bid == 0 && threadIdx.x == 0) p.out[0] += (float)(ts[PROBE_B] - ts[PROBE_A]) * 0.01f / PROBE_DIV;
#endif
}
#endif

extern "C" void kernel_launch(void* const* d_in, const int* in_sizes, int n_in, void* d_out, int out_size, void* d_ws, size_t ws_size, hipStream_t stream) {
    (void)in_sizes; (void)n_in; (void)out_size;
    if (ws_size < OFF_END) { fprintf(stderr, "workspace too small: %zu < %zu\n", ws_size, (size_t)OFF_END); return; }
    Params p{};
    p.x = (const float*)d_in[0]; p.c = (const float*)d_in[1]; p.mod_w = (const float*)d_in[2]; p.mod_b = (const float*)d_in[3]; p.norm1_g = (const float*)d_in[4];
    p.w_in = (const float*)d_in[5]; p.gmlp_ws = (const float*)d_in[6]; p.gmlp_bs = (const float*)d_in[7]; p.fnet_w = (const float*)d_in[8]; p.fnet_b = (const float*)d_in[9];
    p.gain_a = (const float*)d_in[10]; p.gain_b = (const float*)d_in[11]; p.w_out = (const float*)d_in[12]; p.norm2_g = (const float*)d_in[13]; p.wq = (const float*)d_in[14];
    p.k1 = (const float*)d_in[15]; p.k2 = (const float*)d_in[16]; p.pu = (const float*)d_in[17]; p.pv = (const float*)d_in[18]; p.final_g = (const float*)d_in[19];
    p.out = (float*)d_out; p.ws = (char*)d_ws;
#if MEGA
    static int grid_blocks = 0;
    if (!grid_blocks) {
        int dev = 0, cus = 0, per_cu = 0;
        hipGetDevice(&dev);
        hipDeviceGetAttribute(&cus, hipDeviceAttributeMultiprocessorCount, dev);
        hipOccupancyMaxActiveBlocksPerMultiprocessor(&per_cu, mega_kernel, 512, 0);
        if (per_cu > 1) per_cu = 1;
        grid_blocks = (cus * per_cu) / 8 * 8;
    }
    void* args[] = {&p};
    hipError_t e = hipLaunchCooperativeKernel((void*)mega_kernel, dim3(grid_blocks), dim3(512), args, 0, stream);
    if (e != hipSuccess) fprintf(stderr, "cooperative launch failed: %s (grid %d)\n", hipGetErrorString(e), grid_blocks);
#endif
}
```

```cpp
#include <hip/hip_runtime.h>
#include <hip/hip_cooperative_groups.h>
#include <cstdio>
#include <cstdint>
namespace cg = cooperative_groups;

#ifndef MEGA
#define MEGA 1
#endif
#ifndef COOP
#define COOP 1
#endif
#ifndef PROBE_A
#define PROBE_A -1
#define PROBE_B 0
#define PROBE_DIV 10.0f
#endif

typedef unsigned short bf16_t;
typedef short bf16x8 __attribute__((ext_vector_type(8)));
typedef float f32x4 __attribute__((ext_vector_type(4)));
typedef __bf16 bf16x2_t __attribute__((ext_vector_type(2)));

constexpr int D = 1024, NB = 8, SEQ = 4096, T = NB * SEQ, NL = 2;
constexpr int NZ = 2048;
constexpr int NE = 16384;
constexpr float EPS = 1e-6f;

constexpr size_t OFF_MOD  = 0;
constexpr size_t OFF_W1T  = OFF_MOD  + (size_t)NL * NB * 6144 * 4;
constexpr size_t OFF_W2T  = OFF_W1T  + (size_t)NL * 2048 * 1024 * 2;
constexpr size_t OFF_WQT  = OFF_W2T  + (size_t)NL * 1024 * 1024 * 2;
constexpr size_t OFF_K12  = OFF_WQT  + (size_t)NL * 2048 * 1024 * 2;
constexpr size_t OFF_WSB  = OFF_K12  + (size_t)NL * 8 * 256 * 128 * 2;
constexpr size_t OFF_DA   = OFF_WSB  + (size_t)NL * 8 * 128 * 128 * 2;
constexpr size_t OFF_DB   = OFF_DA   + 128 * 128 * 2;
constexpr size_t OFF_TW   = OFF_DB   + 64 * 128 * 2;
constexpr size_t OFF_SSQA = OFF_TW   + 64 * 64 * 8;
constexpr size_t OFF_SSQB = OFF_SSQA + (size_t)T * 8 * 4;
constexpr size_t OFF_UB   = OFF_SSQB + (size_t)T * 8 * 4;
constexpr size_t OFF_VB   = OFF_UB   + (size_t)NL * NE * 1024;
constexpr size_t OFF_USC  = OFF_VB   + (size_t)NL * NE * 1024;
constexpr size_t OFF_VSC  = OFF_USC  + (size_t)NL * NE * 4;
constexpr size_t OFF_H    = OFF_VSC  + (size_t)NL * NE * 4;
constexpr size_t OFF_Z    = OFF_H    + (size_t)T * 1024 * 2;
constexpr size_t OFF_Y    = OFF_Z    + (size_t)T * 2048 * 2;
constexpr size_t OFF_BAR  = OFF_Y    + (size_t)T * 1024 * 2;
constexpr size_t OFF_XR   = OFF_BAR  + 16384;
constexpr size_t OFF_END  = OFF_XR   + (size_t)T * 1024 * 2;

struct Params {
    const float* x; const float* c; const float* mod_w; const float* mod_b; const float* norm1_g; const float* w_in;
    const float* gmlp_ws; const float* gmlp_bs; const float* fnet_w; const float* fnet_b; const float* gain_a; const float* gain_b;
    const float* w_out; const float* norm2_g; const float* wq; const float* k1; const float* k2; const float* pu; const float* pv; const float* final_g;
    float* out; char* ws;
};

constexpr int SMEM_BYTES = 73984;

__device__ __forceinline__ float bf2f(unsigned v) { return __uint_as_float(v << 16); }
typedef float f32x2_t __attribute__((ext_vector_type(2)));
__device__ __forceinline__ unsigned pk_bf16(float lo, float hi) { const f32x2_t v = {lo, hi}; return __builtin_bit_cast(unsigned, __builtin_convertvector(v, bf16x2_t)); }
__device__ __forceinline__ bf16_t f2bf(float f) { return (bf16_t)(pk_bf16(f, 0.f) & 0xffffu); }
__device__ __forceinline__ float gelu_f(float v) {
    const float t = __builtin_amdgcn_rcpf(fabsf(v) * 0.2316418882f + 1.0f);
    float q = t * 0.5307027145f + (-0.7265760135f); q = q * t + 0.7107068705f; q = q * t + (-0.142248368f); q = q * t + 0.127414796f; q = q * t;
    const float m = v * (q * __builtin_amdgcn_exp2f(v * v * (-0.72134752044f)));
    return v < 0.f ? m : v - m;
}
__device__ __forceinline__ int med3i(int a, int b, int c) { return max(min(a, b), min(max(a, b), c)); }
__device__ __forceinline__ int f2key(float f) { int b = __float_as_int(f); return b ^ ((b >> 31) & 0x7fffffff); }
__device__ __forceinline__ float key2f(int k) { return __int_as_float(k ^ ((k >> 31) & 0x7fffffff)); }
__device__ __forceinline__ float wave_sum(float v) {
#pragma unroll
    for (int o = 32; o >= 1; o >>= 1) v += __shfl_xor(v, o);
    return v;
}
__device__ __forceinline__ int otid() { int t = threadIdx.x & 255; asm volatile("" : "+v"(t)); return t; }
__device__ __forceinline__ void vsync(char* smem_v) {
    const int vb_ = threadIdx.x >> 8;
    volatile __attribute__((address_space(3))) unsigned* cnt = (volatile __attribute__((address_space(3))) unsigned*)(smem_v + (2 - vb_) * SMEM_BYTES + 16) + vb_;
    asm volatile("s_waitcnt lgkmcnt(0)" ::: "memory");
    unsigned target = 0u;
    if ((threadIdx.x & 63) == 0) target = (__hip_atomic_fetch_add((__attribute__((address_space(3))) unsigned*)cnt, 1u, __ATOMIC_RELAXED, __HIP_MEMORY_SCOPE_WORKGROUP) / 4u + 1u) * 4u;
    target = __builtin_amdgcn_readfirstlane(target);
    while (*cnt < target) __builtin_amdgcn_s_sleep(1);
    asm volatile("" ::: "memory");
}
#define MFMA16(a, b, c) __builtin_amdgcn_mfma_f32_16x16x32_bf16((a), (b), (c), 0, 0, 0)

__device__ void transpose_tile(const float* __restrict__ src, int ld, int k0, int n0, bf16_t* __restrict__ dst  , int dn0,
                               const float* __restrict__ kscale, float* tile  ) {
    const int tid = otid();
#pragma unroll
    for (int i = 0; i < 4; ++i) {
        const int r = (tid >> 4) + 16 * i, c4 = (tid & 15) * 4;
        const float4 v = *(const float4*)(src + (size_t)(k0 + r) * ld + n0 + c4);
        const float s = kscale ? kscale[k0 + r] : 1.0f;
        tile[r * 65 + c4 + 0] = v.x * s; tile[r * 65 + c4 + 1] = v.y * s; tile[r * 65 + c4 + 2] = v.z * s; tile[r * 65 + c4 + 3] = v.w * s;
    }
    __syncthreads();
    {
        const int n = tid >> 2, ks = (tid & 3) * 16;
        unsigned w[8];
#pragma unroll
        for (int j = 0; j < 8; ++j) w[j] = pk_bf16(tile[(ks + 2 * j) * 65 + n], tile[(ks + 2 * j + 1) * 65 + n]);
        uint4* d = (uint4*)(dst + (size_t)(dn0 + n) * 1024 + k0 + ks);
        d[0] = make_uint4(w[0], w[1], w[2], w[3]); d[1] = make_uint4(w[4], w[5], w[6], w[7]);
    }
    __syncthreads();
}

__device__ void phase_prep(const Params& p, char* smem, int bid_, int nb_) {
    const int tid = otid();
    char* ws = p.ws;
    const bool split = (nb_ % 4 == 0);
    const bool convgrp = split && ((bid_ >> 1) & 1);
    const int bid = split ? (((bid_ >> 2) << 1) | (bid_ & 1)) : bid_, nb = split ? (nb_ >> 1) : nb_;
    const int gtid = bid * 256 + tid, gsz = nb * 256;
    if (!convgrp) {
    {
        float* sc = (float*)smem;
        float* red = (float*)(smem + 32768);
        for (int i = tid; i < 8192; i += 256) { const float v = p.c[i]; sc[i] = v / (1.0f + __expf(-v)); }
        __syncthreads();
        float* mod = (float*)(ws + OFF_MOD);
        for (int rd_ = 0; rd_ < (NL * 192 + nb - 1) / nb; ++rd_) { const int item = min(bid + rd_ * nb, NL * 192 - 1);
            const int l = item / 192, n0 = (item % 192) * 32, nn = tid & 31, kq = tid >> 5;
            float acc[8];
#pragma unroll
            for (int b = 0; b < 8; ++b) acc[b] = 0.f;
            const float* W = p.mod_w + (size_t)l * 1024 * 6144 + n0 + nn;
#pragma nounroll
            for (int k0 = kq; k0 < 1024; k0 += 128) {
                float w[16];
#pragma unroll
                for (int u = 0; u < 16; ++u) w[u] = W[(size_t)(k0 + 8 * u) * 6144];
#pragma unroll
                for (int u = 0; u < 16; ++u)
#pragma unroll
                    for (int b = 0; b < 8; ++b) acc[b] += sc[b * 1024 + k0 + 8 * u] * w[u];
            }
#pragma unroll
            for (int b = 0; b < 8; ++b) red[(kq * 8 + b) * 32 + nn] = acc[b];
            __syncthreads();
            {
                const int b = tid >> 5;
                float s = 0.f;
#pragma unroll
                for (int q = 0; q < 8; ++q) s += red[(q * 8 + b) * 32 + nn];
                mod[((size_t)l * NB + b) * 6144 + n0 + nn] = s + p.mod_b[l * 6144 + n0 + nn];
            }
            __syncthreads();
        }
    }
    {
        float* tile = (float*)smem;
        for (int rd_ = 0; rd_ < (NL * 1024 + nb - 1) / nb; ++rd_) { const int item = min(bid + rd_ * nb, NL * 1024 - 1);
            const int l = item / 1024, r = item % 1024;
            if (r < 256) {
                const int kt = r / 16, nt = r % 16;
                transpose_tile(p.w_in + (size_t)l * 1024 * 1536, 1536, kt * 64, nt * 64, (bf16_t*)(ws + OFF_W1T) + (size_t)l * 2048 * 1024, nt * 64, nullptr, tile);
            } else if (r < 512) {
                const int rr = r - 256, kt = rr / 16, nt = rr % 16;
                const float* gk = (kt < 8) ? (p.gain_a + l * 512) : (p.gain_b + l * 512 - 512);
                transpose_tile(p.w_out + (size_t)l * 1024 * 1024, 1024, kt * 64, nt * 64, (bf16_t*)(ws + OFF_W2T) + (size_t)l * 1024 * 1024, nt * 64, gk, tile);
            } else {
                const int rr = r - 512, kt = rr / 32, nt = rr % 32;
                transpose_tile(p.wq + (size_t)l * 1024 * 2048, 2048, kt * 64, nt * 64, (bf16_t*)(ws + OFF_WQT) + (size_t)l * 2048 * 1024, nt * 64, nullptr, tile);
            }
        }
    }
    {
        float* fws = (float*)smem;
        float* Ms  = (float*)(smem + 16384);
        float* wt  = (float*)(smem + 49152);
        float* cs  = (float*)(smem + 49152 + 16640);
        for (int rd_ = 0; rd_ < (NL * 8 * 16 + nb - 1) / nb; ++rd_) { const int item = min(bid + rd_ * nb, NL * 8 * 16 - 1);
            const int l = item / 128, g = (item % 128) / 16, kt = item % 16;
            if (tid < 64) { float s, c; sincospif((float)tid / 32.0f, &s, &c); cs[tid] = c; cs[64 + tid] = s; }
            for (int i = tid; i < 4096; i += 256) fws[i] = p.fnet_w[((size_t)l * 8 + g) * 4096 + i];
#pragma unroll
            for (int i = 0; i < 4; ++i) {
                const int r = (tid >> 4) + 16 * i, c4 = (tid & 15) * 4;
                const float4 v = *(const float4*)(p.w_in + (size_t)l * 1024 * 1536 + (size_t)(kt * 64 + r) * 1536 + 1024 + g * 64 + c4);
                wt[r * 65 + c4] = v.x; wt[r * 65 + c4 + 1] = v.y; wt[r * 65 + c4 + 2] = v.z; wt[r * 65 + c4 + 3] = v.w;
            }
            __syncthreads();
            {
                const int d = tid >> 2, r0 = (tid & 3) * 32;
                const bool im = r0 >= 64; const int e0 = r0 & 63;
                float acc[32];
#pragma unroll
                for (int e = 0; e < 32; ++e) acc[e] = 0.f;
                for (int j = 0; j < 64; ++j) {
                    const int ph = (d * j) & 63;
                    const float t = im ? -cs[64 + ph] : cs[ph];
#pragma unroll
                    for (int e = 0; e < 32; ++e) acc[e] += t * fws[j * 64 + e0 + e];
                }
#pragma unroll
                for (int e = 0; e < 32; ++e) Ms[d * 128 + r0 + e] = acc[e];
            }
            __syncthreads();
            {
                const int r = tid >> 1, kk0 = (tid & 1) * 32;
                float acc[32];
#pragma unroll
                for (int k = 0; k < 32; ++k) acc[k] = 0.f;
                for (int d = 0; d < 64; ++d) {
                    const float m = Ms[d * 128 + r];
#pragma unroll
                    for (int k = 0; k < 32; ++k) acc[k] += wt[(kk0 + k) * 65 + d] * m;
                }
                bf16_t* dst = (bf16_t*)(ws + OFF_W1T) + (size_t)l * 2048 * 1024 + (size_t)(1024 + g * 128 + r) * 1024 + kt * 64 + kk0;
#pragma unroll
                for (int q = 0; q < 4; ++q)
                    ((uint4*)dst)[q] = make_uint4(pk_bf16(acc[q * 8], acc[q * 8 + 1]), pk_bf16(acc[q * 8 + 2], acc[q * 8 + 3]), pk_bf16(acc[q * 8 + 4], acc[q * 8 + 5]), pk_bf16(acc[q * 8 + 6], acc[q * 8 + 7]));
            }
            __syncthreads();
        }
    }
    {
        bf16_t* k12 = (bf16_t*)(ws + OFF_K12);
        for (int i = gtid; i < NL * 8 * 256 * 128; i += gsz) {
            const int d = i & 127, n = (i >> 7) & 255, h = (i >> 15) & 7, l = i >> 18;
            const float* src = (n < 128) ? p.k1 : p.k2;
            k12[i] = f2bf(src[(((size_t)l * 8 + h) * 128 + (n & 127)) * 128 + d]);
        }
        bf16_t* wsb = (bf16_t*)(ws + OFF_WSB);
        for (int i = gtid; i < NL * 8 * 128 * 128; i += gsz) wsb[i] = f2bf(p.gmlp_ws[i]);
        bf16_t* DA = (bf16_t*)(ws + OFF_DA);
        for (int i = gtid; i < 128 * 128; i += gsz) {
            const int m = i >> 7, kk = i & 127, ro = m >> 6, k1 = m & 63, ri = kk >> 6, a = kk & 63;
            float s, c; sincospif((float)((a * k1) & 63) / 32.0f, &s, &c);
            const float v = (ro == ri) ? c : (ro == 0 ? s : -s);
            DA[i] = f2bf(v);
        }
        bf16_t* DB = (bf16_t*)(ws + OFF_DB);
        for (int i = gtid; i < 64 * 128; i += gsz) {
            const int k2 = i >> 7, kk = i & 127, ri = kk >> 6, b = kk & 63;
            float s, c; sincospif((float)((b * k2) & 63) / 32.0f, &s, &c);
            DB[i] = f2bf(ri ? s : c);
        }
        float2* tw = (float2*)(ws + OFF_TW);
        for (int i = gtid; i < 64 * 64; i += gsz) {
            const int bp = i >> 6, k1 = i & 63;
            float s, c; sincospif((float)(bp * k1) / 2048.0f, &s, &c);
            tw[i] = make_float2(c, s);
        }
    }
    }
    if (convgrp || !split) {
        {
            const int lane = tid & 63, wv = gtid >> 6, nwv = gsz >> 6;
            const int R = 2 * NL * NE;
#pragma nounroll
            for (int r0 = wv; r0 < R; r0 += 4 * nwv) {
                float4 v[4][4];
#pragma unroll
                for (int t = 0; t < 4; ++t) {
                    const int r = (r0 + t * nwv < R) ? r0 + t * nwv : r0;
                    const int tbl = r / (NL * NE), row = r % (NL * NE);
                    const float* src = (tbl ? p.pv : p.pu) + (size_t)row * 1024 + lane * 16;
#pragma unroll
                    for (int i = 0; i < 4; ++i) v[t][i] = ((const float4*)src)[i];
                }
                __builtin_amdgcn_sched_barrier(0);
#pragma unroll
                for (int t = 0; t < 4; ++t) {
                    const int r = r0 + t * nwv;
                    if (r >= R) break;
                    const int tbl = r / (NL * NE), row = r % (NL * NE);
                    float m = 0.f;
#pragma unroll
                    for (int i = 0; i < 4; ++i) m = fmaxf(m, fmaxf(fmaxf(fabsf(v[t][i].x), fabsf(v[t][i].y)), fmaxf(fabsf(v[t][i].z), fabsf(v[t][i].w))));
#pragma unroll
                    for (int o = 32; o >= 1; o >>= 1) m = fmaxf(m, __shfl_xor(m, o));
                    const float qmax = 6.0f;
                    const float sc = (m > 0.f) ? qmax / m : 1.0f, inv = (m > 0.f) ? m / qmax : 1.0f;
                    const int lyr = row / NE, ex = row % NE;
                    if (true) {
                        unsigned w0 = 0u, w1 = 0u;
                        w0 = __builtin_amdgcn_cvt_scalef32_pk_fp4_f32(w0, v[t][0].x * sc, v[t][0].y * sc, 1.0f, 0); w0 = __builtin_amdgcn_cvt_scalef32_pk_fp4_f32(w0, v[t][0].z * sc, v[t][0].w * sc, 1.0f, 1);
                        w0 = __builtin_amdgcn_cvt_scalef32_pk_fp4_f32(w0, v[t][1].x * sc, v[t][1].y * sc, 1.0f, 2); w0 = __builtin_amdgcn_cvt_scalef32_pk_fp4_f32(w0, v[t][1].z * sc, v[t][1].w * sc, 1.0f, 3);
                        w1 = __builtin_amdgcn_cvt_scalef32_pk_fp4_f32(w1, v[t][2].x * sc, v[t][2].y * sc, 1.0f, 0); w1 = __builtin_amdgcn_cvt_scalef32_pk_fp4_f32(w1, v[t][2].z * sc, v[t][2].w * sc, 1.0f, 1);
                        w1 = __builtin_amdgcn_cvt_scalef32_pk_fp4_f32(w1, v[t][3].x * sc, v[t][3].y * sc, 1.0f, 2); w1 = __builtin_amdgcn_cvt_scalef32_pk_fp4_f32(w1, v[t][3].z * sc, v[t][3].w * sc, 1.0f, 3);
                        *(uint2*)(ws + (tbl ? OFF_VB : OFF_UB) + ((size_t)(lyr * 4 + (lane >> 4)) * NE + ex) * 128 + (lane & 15) * 8) = make_uint2(w0, w1);
                    } else {
                        int w[4];
#pragma unroll
                        for (int i = 0; i < 4; ++i) { w[i] = __builtin_amdgcn_cvt_pk_fp8_f32(v[t][i].x * sc, v[t][i].y * sc, 0, false); w[i] = __builtin_amdgcn_cvt_pk_fp8_f32(v[t][i].z * sc, v[t][i].w * sc, w[i], true); }
                        *(int4*)(ws + OFF_UB + ((size_t)(lyr * 8 + (lane >> 3)) * NE + ex) * 128 + (lane & 7) * 16) = make_int4(w[0], w[1], w[2], w[3]);
                    }
                    if (lane == 0) ((float*)(ws + (tbl ? OFF_VSC : OFF_USC)))[row] = inv;
                    __builtin_amdgcn_sched_barrier(0);
                }
            }
        }
    }
}

template <bool SRC_BF16, bool ADD = false, int NU = 2>
__device__ void phase_norm(const void* xsrc_, const float* __restrict__ g, const float* __restrict__ modl  , int sh_off, int scl_off,
                           bf16_t* __restrict__ hout, int bid, int nb, const bf16_t* __restrict__ sadd = nullptr, const float* __restrict__ g2l = nullptr, bf16_t* __restrict__ xcopy = nullptr) {
    const int tid_ = otid(); const int lane = tid_ & 63, wid = tid_ >> 6;
    for (int tok0 = bid * 4 + wid; tok0 < T; tok0 += nb * 4 * NU) {
        int tk[NU]; bool ok[NU];
#pragma unroll
        for (int u = 0; u < NU; ++u) { ok[u] = tok0 + u * nb * 4 < T; tk[u] = ok[u] ? tok0 + u * nb * 4 : tok0; }
        float4 v[NU][4]; uint2 xw[NU][4], sw[NU][4]; float4 g2[NU][4];
#pragma unroll
        for (int u = 0; u < NU; ++u)
#pragma unroll
            for (int i = 0; i < 4; ++i) {
                const size_t o = (size_t)tk[u] * D + i * 256 + lane * 4;
                if (SRC_BF16) xw[u][i] = *(const uint2*)((const bf16_t*)xsrc_ + o); else v[u][i] = *(const float4*)((const float*)xsrc_ + o);
                if (ADD) { sw[u][i] = *(const uint2*)(sadd + o); g2[u][i] = *(const float4*)(g2l + (size_t)(tk[u] / SEQ) * 6144 + i * 256 + lane * 4); }
            }
        float ss[NU];
#pragma unroll
        for (int u = 0; u < NU; ++u) { ss[u] = 0.f;
#pragma unroll
            for (int i = 0; i < 4; ++i) {
                if (SRC_BF16) v[u][i] = make_float4(bf2f(xw[u][i].x & 0xffffu), bf2f(xw[u][i].x >> 16), bf2f(xw[u][i].y & 0xffffu), bf2f(xw[u][i].y >> 16));
                if (ADD) { const uint2 s_ = sw[u][i]; const float4 g_ = g2[u][i];
                    const unsigned r0 = pk_bf16(v[u][i].x + g_.x * bf2f(s_.x & 0xffffu), v[u][i].y + g_.y * bf2f(s_.x >> 16)), r1 = pk_bf16(v[u][i].z + g_.z * bf2f(s_.y & 0xffffu), v[u][i].w + g_.w * bf2f(s_.y >> 16));
                    if (ok[u]) *(uint2*)((bf16_t*)xsrc_ + (size_t)tk[u] * D + i * 256 + lane * 4) = make_uint2(r0, r1);
                    v[u][i] = make_float4(bf2f(r0 & 0xffffu), bf2f(r0 >> 16), bf2f(r1 & 0xffffu), bf2f(r1 >> 16)); }
                if (!SRC_BF16 && xcopy != nullptr && ok[u]) *(uint2*)(xcopy + (size_t)tk[u] * D + i * 256 + lane * 4) = make_uint2(pk_bf16(v[u][i].x, v[u][i].y), pk_bf16(v[u][i].z, v[u][i].w));
                ss[u] += v[u][i].x * v[u][i].x + v[u][i].y * v[u][i].y + v[u][i].z * v[u][i].z + v[u][i].w * v[u][i].w;
            }
        }
#pragma unroll
        for (int u = 0; u < NU; ++u) {
            const float rstd = rsqrtf(wave_sum(ss[u]) * (1.0f / D) + EPS);
            const float* mb = modl + (size_t)(tk[u] / SEQ) * 6144;
#pragma unroll
            for (int i = 0; i < 4; ++i) {
                const int cidx = i * 256 + lane * 4;
                const float4 gg = *(const float4*)(g + cidx), sh = *(const float4*)(mb + sh_off + cidx), sc = *(const float4*)(mb + scl_off + cidx);
                const float o0 = v[u][i].x * rstd * gg.x * (1.0f + sc.x) + sh.x, o1 = v[u][i].y * rstd * gg.y * (1.0f + sc.y) + sh.y;
                const float o2 = v[u][i].z * rstd * gg.z * (1.0f + sc.z) + sh.z, o3 = v[u][i].w * rstd * gg.w * (1.0f + sc.w) + sh.w;
                if (ok[u]) *(uint2*)(hout + (size_t)tk[u] * D + cidx) = make_uint2(pk_bf16(o0, o1), pk_bf16(o2, o3));
            }
        }
    }
}

namespace pg8 {
#define PG8_LAS __attribute__((address_space(3)))
typedef unsigned short bf16_t;
typedef short bf16x8 __attribute__((ext_vector_type(8)));
typedef float f32x4 __attribute__((ext_vector_type(4)));
typedef unsigned u32x4 __attribute__((ext_vector_type(4)));
constexpr int BM = 256, BK = 64, HALF = 128, HTB = HALF * BK * 2  , STAGE_BYTES = 8 * HTB, NXCD = 8, WGM = 8;

__host__ __device__ __forceinline__ int lds_byte(int r, int c) { const int st = (r >> 4) * 2 + (c >> 5), rr = r & 15, cc = c & 31, ob = rr * 64 + cc * 2; return st * 1024 + (ob ^ (((ob >> 9) & 1) << 5)); }
__host__ __device__ __forceinline__ void stage_rc(int b, int& R, int& C) { const int st = b / 1024, sb = b % 1024, swz = sb ^ (((sb >> 9) & 1) << 5); R = (st >> 1) * 16 + swz / 64; C = (st & 1) * 32 + (swz % 64) / 2; }
__host__ __device__ __forceinline__ int perm32(int rho) { const int n = rho >> 4, i = rho & 15; return 8 * (i >> 2) + 4 * n + (i & 3); }

struct Unit { int pm, pn; };
struct Gemm { const bf16_t* A; const bf16_t* Bt; int M, N, K; };

struct StaticOrder {
    int nM, nN, nwg, G, c;
    __host__ __device__ void init(int M, int N, int G_, int c_) { nM = M / BM; nN = N / BM; nwg = nM * nN; G = G_; c = c_; }
    __host__ __device__ bool next(int i, Unit& u) const {
        const long L = (long)i * G + c; if (L >= nwg) return false;
        int wgid = (int)L; { const int q = nwg / NXCD, r = nwg % NXCD, xcd = wgid % NXCD, off = wgid / NXCD; wgid = (xcd < r ? xcd * (q + 1) : r * (q + 1) + (xcd - r) * q) + off; }
        const int nig = WGM * nN, gid = wgid / nig, fm = gid * WGM, gsz = (nM - fm) < WGM ? (nM - fm) : WGM;
        u.pm = fm + ((wgid % nig) % gsz); u.pn = (wgid % nig) / gsz; return true;
    }
    __device__ __forceinline__ void a_ready(const Unit&) const {}
    __device__ __forceinline__ void done(const Unit&) const {}
};

template <class Epi, class Sched, class MidK, bool STAMP = false>
__device__ __forceinline__ void gemm_phase(PG8_LAS unsigned char* lds, const Gemm g, const Sched& S, const Epi& E, const MidK& MK, int midt, unsigned long long* stamps) {
    int tid_ = threadIdx.x; asm volatile("" : "+v"(tid_));
    const int tid = tid_, wid = __builtin_amdgcn_readfirstlane(tid >> 6), lane = tid & 63, wr = wid >> 2, wc = wid & 3, fr = lane & 15, fq = lane >> 4;
    const int K = g.K, nt = K / BK;
    int ts_lo = 0, ts_hi = 0, nts = 0; const unsigned long long rt_entry = STAMP ? (unsigned long long)wall_clock64() : 0ull;
#define PG8_STAMP() do { if (STAMP && wid == 0 && nts < 64) { const unsigned long long _c = (unsigned long long)clock64(); \
        ts_lo = (lane == nts) ? (int)(unsigned)_c : ts_lo; ts_hi = (lane == nts) ? (int)(unsigned)(_c >> 32) : ts_hi; ++nts; } } while (0)
    PG8_STAMP();
    unsigned voffA[2], voffB[2];
#pragma unroll
    for (int i = 0; i < 2; ++i) { int R, C; stage_rc(tid * 16 + i * 8192, R, C); const int Rb = Epi::PERM ? ((R & ~31) + perm32(R & 31)) : R;
        voffA[i] = (unsigned)(R * K + C) * 2u; voffB[i] = (unsigned)(Rb * K + C) * 2u; }
    const size_t kstep = (size_t)(BK * 2);
    const size_t hstep = (size_t)HALF * K * 2;
    const size_t tstep = 2 * hstep;
    const unsigned ldsw = (unsigned)wid * 1024u;
    const int aoff = lds_byte(wr * 64 + fr, fq * 8), boff = lds_byte(wc * 32 + fr, fq * 8);
#define PG8_SA(b, h) (((b) * 2 + (h)) * HTB)
#define PG8_SB(b, h) ((4 + (b) * 2 + (h)) * HTB)
#define PG8_STAGE(bufoff, gbase, voff) do { _Pragma("unroll") for (int _i = 0; _i < 2; ++_i) \
        __builtin_amdgcn_global_load_lds((const unsigned*)((const char*)(gbase) + (voff)[_i]), (PG8_LAS unsigned*)(lds + (bufoff) + ldsw + _i * 8192), 16, 0, 0); } while (0)
#define PG8_LDA(dst, b, h) do { _Pragma("unroll") for (int m = 0; m < 4; ++m) _Pragma("unroll") for (int k = 0; k < 2; ++k) dst[m][k] = *(const PG8_LAS bf16x8*)(lds + PG8_SA(b, h) + aoff + m * 2048 + k * 1024); } while (0)
#define PG8_LDB(dst, b, h) do { _Pragma("unroll") for (int n = 0; n < 2; ++n) _Pragma("unroll") for (int k = 0; k < 2; ++k) dst[n][k] = *(const PG8_LAS bf16x8*)(lds + PG8_SB(b, h) + boff + n * 2048 + k * 1024); } while (0)
#define PG8_MMA(ai, bj, At, Bt) do { __builtin_amdgcn_s_setprio(1); _Pragma("unroll") for (int m = 0; m < 4; ++m) _Pragma("unroll") for (int n = 0; n < 2; ++n) _Pragma("unroll") for (int k = 0; k < 2; ++k) \
        acc[ai][bj][m][n] = __builtin_amdgcn_mfma_f32_16x16x32_bf16(Bt[n][k], At[m][k], acc[ai][bj][m][n], 0, 0, 0); __builtin_amdgcn_s_setprio(0); } while (0)
#define PG8_WAIT_V(n) asm volatile("s_waitcnt vmcnt(" #n ")" ::: "memory")
#define PG8_WAIT_L(n) asm volatile("s_waitcnt lgkmcnt(" #n ")" ::: "memory")
#define PG8_BAR __builtin_amdgcn_s_barrier()
#define PG8_SCHED __builtin_amdgcn_sched_barrier(0)
    Unit cur, nxt; int ui = 0;
    if (!S.next(0, cur)) return;
    f32x4 acc[2][2][4][2];
#pragma unroll
    for (int a = 0; a < 2; ++a)
#pragma unroll
        for (int b = 0; b < 2; ++b)
#pragma unroll
            for (int m = 0; m < 4; ++m)
#pragma unroll
                for (int n = 0; n < 2; ++n) acc[a][b][m][n] = (f32x4){0.f, 0.f, 0.f, 0.f};
    bf16x8 At[4][2], B0[2][2], B1[2][2];
    const char* cA = (const char*)g.A + (size_t)cur.pm * tstep; const char* cB = (const char*)g.Bt + (size_t)cur.pn * tstep;
    S.a_ready(cur);
    PG8_STAGE(PG8_SB(0, 0), cB, voffB); PG8_STAGE(PG8_SA(0, 0), cA, voffA); PG8_STAGE(PG8_SB(0, 1), cB + hstep, voffB); PG8_STAGE(PG8_SA(0, 1), cA + hstep, voffA);
    if (wr == 1) PG8_BAR;
    PG8_WAIT_V(4); PG8_BAR;
    PG8_STAGE(PG8_SB(1, 0), cB + kstep, voffB); PG8_STAGE(PG8_SA(1, 0), cA + kstep, voffA); PG8_STAGE(PG8_SB(1, 1), cB + hstep + kstep, voffB);
    PG8_WAIT_V(6); PG8_BAR;
    PG8_STAMP();
    for (;;) {
        const bool has_next = S.next(ui + 1, nxt);
        const char* nA = has_next ? (const char*)g.A + (size_t)nxt.pm * tstep : cA; const char* nB = has_next ? (const char*)g.Bt + (size_t)nxt.pn * tstep : cB;
        for (int t = 0; t < nt; t += 2) {
            const bool last = (t == nt - 2);
            if (t == midt) {
#pragma unroll
                for (int ai = 0; ai < 2; ++ai)
#pragma unroll
                    for (int m = 0; m < 4; ++m) { const float s_ = MK(ui, ai * HALF + wr * 64 + m * 16 + fr);
#pragma unroll
                        for (int bj = 0; bj < 2; ++bj)
#pragma unroll
                            for (int n = 0; n < 2; ++n) acc[ai][bj][m][n] *= s_;
                        __builtin_amdgcn_sched_barrier(0); }
            }
            const char* a1 = cA + (size_t)(t + 1) * kstep;
            const char* a2 = last ? nA : cA + (size_t)(t + 2) * kstep; const char* b2 = last ? nB : cB + (size_t)(t + 2) * kstep;
            const char* a3 = a2 + kstep; const char* b3 = b2 + kstep;
            if (last && has_next) S.a_ready(nxt);
            PG8_LDB(B0, 0, 0); PG8_SCHED; PG8_LDA(At, 0, 0); PG8_STAGE(PG8_SA(1, 1), a1 + hstep, voffA);
            PG8_WAIT_L(8); PG8_BAR; PG8_WAIT_L(0); PG8_MMA(0, 0, At, B0); PG8_BAR; PG8_SCHED;
            PG8_LDB(B1, 0, 1); PG8_STAGE(PG8_SB(0, 0), b2, voffB);
            PG8_BAR; PG8_WAIT_L(0); PG8_MMA(0, 1, At, B1); PG8_BAR;
            PG8_LDA(At, 0, 1); PG8_STAGE(PG8_SA(0, 0), a2, voffA);
            PG8_BAR; PG8_WAIT_L(0); PG8_MMA(1, 0, At, B0); PG8_BAR; PG8_SCHED;
            PG8_STAGE(PG8_SB(0, 1), b2 + hstep, voffB);
            PG8_WAIT_V(6); PG8_BAR; PG8_MMA(1, 1, At, B1); PG8_BAR;
            PG8_LDB(B0, 1, 0); PG8_SCHED; PG8_LDA(At, 1, 0); PG8_STAGE(PG8_SA(0, 1), a2 + hstep, voffA);
            PG8_WAIT_L(8); PG8_BAR; PG8_WAIT_L(0); PG8_MMA(0, 0, At, B0); PG8_BAR; PG8_SCHED;
            PG8_LDB(B1, 1, 1); PG8_STAGE(PG8_SB(1, 0), b3, voffB);
            PG8_BAR; PG8_WAIT_L(0); PG8_MMA(0, 1, At, B1); PG8_BAR;
            PG8_LDA(At, 1, 1); PG8_STAGE(PG8_SA(1, 0), a3, voffA);
            PG8_BAR; PG8_WAIT_L(0); PG8_MMA(1, 0, At, B0); PG8_BAR; PG8_SCHED;
            PG8_STAGE(PG8_SB(1, 1), b3 + hstep, voffB);
            PG8_WAIT_V(6); PG8_BAR; PG8_MMA(1, 1, At, B1); PG8_BAR;
        }
        PG8_STAMP();
        if constexpr (!Epi::AFTER_DRAIN) { E(acc, cur, wr, wc, fr, fq, ui); S.done(cur); }
        PG8_STAMP();
        if (!has_next) break;
#pragma unroll
        for (int a = 0; a < 2; ++a)
#pragma unroll
            for (int b = 0; b < 2; ++b)
#pragma unroll
                for (int m = 0; m < 4; ++m)
#pragma unroll
                    for (int n = 0; n < 2; ++n) acc[a][b][m][n] = (f32x4){0.f, 0.f, 0.f, 0.f};
        cur = nxt; cA = nA; cB = nB; ++ui;
    }
    PG8_WAIT_V(0);
    if (wr == 0) PG8_BAR;
    PG8_BAR;
    if constexpr (Epi::AFTER_DRAIN) { E.fused(acc, cur, wr, wc, fr, fq, lds, wid, lane); S.done(cur); }
    PG8_STAMP();
    if (STAMP && wid == 0) { stamps[lane] = lane < nts ? (((unsigned long long)(unsigned)ts_hi << 32) | (unsigned)ts_lo) : 0ull;
        if (lane == 62) stamps[62] = rt_entry; if (lane == 63) stamps[63] = (unsigned long long)wall_clock64(); }
#undef PG8_STAMP
#undef PG8_SA
#undef PG8_SB
#undef PG8_STAGE
#undef PG8_LDA
#undef PG8_LDB
#undef PG8_MMA
#undef PG8_WAIT_V
#undef PG8_WAIT_L
#undef PG8_BAR
#undef PG8_SCHED
}
}

struct NoMid { __device__ __forceinline__ float operator()(int, int) const { return 1.0f; } };
#define LAS __attribute__((address_space(3)))
struct EpiZ {
    static constexpr bool PERM = true, AFTER_DRAIN = false;
    bf16_t* Z;
    __device__ __forceinline__ void operator()(const f32x4 (&acc)[2][2][4][2], const pg8::Unit& u, int wr, int wc, int fr, int fq, int) const {
        const int row0 = u.pm * 256 + wr * 64 + fr, col0 = u.pn * 256 + wc * 32 + 8 * fq; const bool act = u.pn < 4;
#pragma unroll
        for (int ai = 0; ai < 2; ++ai)
#pragma unroll
            for (int m = 0; m < 4; ++m) { bf16_t* rowp = Z + (size_t)(row0 + ai * 128 + m * 16) * NZ + col0;
#pragma unroll
                for (int bj = 0; bj < 2; ++bj) { f32x4 a = acc[ai][bj][m][0], b = acc[ai][bj][m][1];
                    if (act) { a = (f32x4){gelu_f(a[0]), gelu_f(a[1]), gelu_f(a[2]), gelu_f(a[3])}; b = (f32x4){gelu_f(b[0]), gelu_f(b[1]), gelu_f(b[2]), gelu_f(b[3])}; }
                    *(uint4*)(rowp + bj * 128) = make_uint4(pk_bf16(a[0], a[1]), pk_bf16(a[2], a[3]), pk_bf16(b[0], b[1]), pk_bf16(b[2], b[3])); }
                __builtin_amdgcn_sched_barrier(0); }
    }
};
struct EpiQ {
    static constexpr bool PERM = true, AFTER_DRAIN = false;
    bf16_t* Q;
    __device__ __forceinline__ void operator()(const f32x4 (&acc)[2][2][4][2], const pg8::Unit& u, int wr, int wc, int fr, int fq, int) const {
        const int row0 = u.pm * 256 + wr * 64 + fr, col0 = u.pn * 256 + wc * 32 + 8 * fq;
#pragma unroll
        for (int ai = 0; ai < 2; ++ai)
#pragma unroll
            for (int m = 0; m < 4; ++m) { bf16_t* rowp = Q + (size_t)(row0 + ai * 128 + m * 16) * 2048 + col0;
#pragma unroll
                for (int bj = 0; bj < 2; ++bj) { const f32x4 a = acc[ai][bj][m][0], b = acc[ai][bj][m][1];
                    *(uint4*)(rowp + bj * 128) = make_uint4(pk_bf16(a[0], a[1]), pk_bf16(a[2], a[3]), pk_bf16(b[0], b[1]), pk_bf16(b[2], b[3])); } }
    }
};
__device__ __forceinline__ float rstd512(const float* s, int row) {
    const float4 a = *(const float4*)(s + (size_t)row * 8), b = *(const float4*)(s + (size_t)row * 8 + 4);
    return rsqrtf(((a.x + a.y) + (a.z + a.w) + (b.x + b.y) + (b.z + b.w)) * (1.0f / 512.0f) + EPS);
}
struct MidY { const LAS float* tab; __device__ __forceinline__ float operator()(int ui, int r) const { return tab[(2 * ui) * 256 + r]; } };
struct EpiX {
    static constexpr bool PERM = true, AFTER_DRAIN = false;
    bf16_t* XR; const LAS float* tab; const float* gate;
    __device__ __forceinline__ void operator()(const f32x4 (&acc)[2][2][4][2], const pg8::Unit& u, int wr, int wc, int fr, int fq, int ui) const {
        const int r0 = wr * 64 + fr, row0 = u.pm * 256 + r0, col0 = u.pn * 256 + wc * 32 + 8 * fq;
        const float* gp = gate + (size_t)((u.pm * 256) / SEQ) * 6144 + col0;
        bf16_t* xp = XR + (size_t)row0 * D + col0;
        float4 g[2][2];
#pragma unroll
        for (int bj = 0; bj < 2; ++bj) { g[bj][0] = *(const float4*)(gp + bj * 128); g[bj][1] = *(const float4*)(gp + bj * 128 + 4); }
#pragma unroll
        for (int ai = 0; ai < 2; ++ai) {
            uint4 xw[4][2];
#pragma unroll
            for (int m = 0; m < 4; ++m)
#pragma unroll
                for (int bj = 0; bj < 2; ++bj) xw[m][bj] = *(const uint4*)(xp + (size_t)(ai * 128 + m * 16) * D + bj * 128);
            __builtin_amdgcn_sched_barrier(0);
#pragma unroll
            for (int m = 0; m < 4; ++m) { const float rb = tab[(2 * ui + 1) * 256 + r0 + ai * 128 + m * 16];
#pragma unroll
                for (int bj = 0; bj < 2; ++bj) { const f32x4 a = acc[ai][bj][m][0], b = acc[ai][bj][m][1]; const uint4 w = xw[m][bj]; const float4 g0 = g[bj][0], g1 = g[bj][1];
                    *(uint4*)(xp + (size_t)(ai * 128 + m * 16) * D + bj * 128) =
                        make_uint4(pk_bf16(bf2f(w.x & 0xffffu) + g0.x * rb * a[0], bf2f(w.x >> 16) + g0.y * rb * a[1]), pk_bf16(bf2f(w.y & 0xffffu) + g0.z * rb * a[2], bf2f(w.y >> 16) + g0.w * rb * a[3]),
                                   pk_bf16(bf2f(w.z & 0xffffu) + g1.x * rb * b[0], bf2f(w.z >> 16) + g1.y * rb * b[1]), pk_bf16(bf2f(w.w & 0xffffu) + g1.z * rb * b[2], bf2f(w.w >> 16) + g1.w * rb * b[3])); }
                __builtin_amdgcn_sched_barrier(0); }
        }
    }
};
__device__ void phase_gemm1(const Params& p, int l, char* smem512) {
    pg8::Gemm g; g.A = (const pg8::bf16_t*)(p.ws + OFF_H); g.Bt = (const pg8::bf16_t*)(p.ws + OFF_W1T) + (size_t)l * 2048 * 1024; g.M = T; g.N = NZ; g.K = D;
    int G_ = (int)gridDim.x, c_ = (int)blockIdx.x; asm volatile("" : "+s"(G_), "+s"(c_));
    pg8::StaticOrder S; S.init(T, NZ, G_, c_);
    EpiZ E; E.Z = (bf16_t*)(p.ws + OFF_Z);
    pg8::gemm_phase<EpiZ, pg8::StaticOrder, NoMid>((PG8_LAS unsigned char*)smem512, g, S, E, NoMid(), -1, nullptr);
}
__device__ void phase_gemm2(const Params& p, int l, char* smem512) {
    pg8::Gemm g; g.A = (const pg8::bf16_t*)(p.ws + OFF_Y); g.Bt = (const pg8::bf16_t*)(p.ws + OFF_W2T) + (size_t)l * 1024 * 1024; g.M = T; g.N = D; g.K = D;
    int G_ = (int)gridDim.x, c_ = (int)blockIdx.x; asm volatile("" : "+s"(G_), "+s"(c_));
    pg8::StaticOrder S; S.init(T, D, G_, c_);
    LAS float* tab = (LAS float*)((LAS char*)smem512 + pg8::STAGE_BYTES);
    {
        const float* ssa = (const float*)(p.ws + OFF_SSQA); const float* ssb = (const float*)(p.ws + OFF_SSQB);
        pg8::Unit u;
        int t0_ = threadIdx.x; asm volatile("" : "+v"(t0_));
#pragma nounroll
        for (int i = 0; i < 8 && S.next(i, u); ++i)
            for (int r = t0_; r < 256; r += 512) { const float ra = rstd512(ssa, u.pm * 256 + r), rb = rstd512(ssb, u.pm * 256 + r); tab[(2 * i) * 256 + r] = ra / rb; tab[(2 * i + 1) * 256 + r] = rb; }
        __syncthreads();
    }
    MidY MK; MK.tab = tab;
    EpiX E; E.XR = (bf16_t*)(p.ws + OFF_XR); E.tab = tab; E.gate = (const float*)(p.ws + OFF_MOD) + (size_t)l * NB * 6144 + 2 * D;
    pg8::gemm_phase<EpiX, pg8::StaticOrder, MidY>((PG8_LAS unsigned char*)smem512, g, S, E, MK, 8, nullptr);
}
__device__ void phase_gemm3(const Params& p, int l, char* smem512) {
    pg8::Gemm g; g.A = (const pg8::bf16_t*)(p.ws + OFF_H); g.Bt = (const pg8::bf16_t*)(p.ws + OFF_WQT) + (size_t)l * 2048 * 1024; g.M = T; g.N = 2048; g.K = D;
    int G_ = (int)gridDim.x, c_ = (int)blockIdx.x; asm volatile("" : "+s"(G_), "+s"(c_));
    pg8::StaticOrder S; S.init(T, 2048, G_, c_);
    EpiQ E; E.Q = (bf16_t*)(p.ws + OFF_Z);
    pg8::gemm_phase<EpiQ, pg8::StaticOrder, NoMid>((PG8_LAS unsigned char*)smem512, g, S, E, NoMid(), -1, nullptr);
}

constexpr int TP = 136;
__device__ __forceinline__ void st_load(const bf16_t* __restrict__ base, size_t row_stride, uint4 (&v)[4]) {
    const int tid = otid(), r = tid >> 2, part = tid & 3, ri = part >> 1, c0 = (part & 1) * 32;
    const uint4* src = (const uint4*)(base + (size_t)r * row_stride + ri * 64 + c0);
#pragma unroll
    for (int i = 0; i < 4; ++i) v[i] = src[i];
}
__device__ __forceinline__ void st_store(const uint4 (&v)[4], bf16_t* dT) {
    const int tid = otid(), r = tid >> 2, part = tid & 3, ri = part >> 1, c0 = (part & 1) * 32;
#pragma unroll
    for (int i = 0; i < 4; ++i) {
        const unsigned w[4] = {v[i].x, v[i].y, v[i].z, v[i].w};
#pragma unroll
        for (int j = 0; j < 4; ++j) {
            dT[(c0 + i * 8 + j * 2) * TP + ri * 64 + r] = (bf16_t)(w[j] & 0xffffu);
            dT[(c0 + i * 8 + j * 2 + 1) * TP + ri * 64 + r] = (bf16_t)(w[j] >> 16);
        }
    }
}

__device__ void phase_mix_gmlp(const Params& p, int l, char* smem, int bid, int nb) {
    const int tid = otid(), lane = tid & 63, wid = tid >> 6, fr = lane & 15, fq = lane >> 4;
    bf16_t* vnT = (bf16_t*)smem;
    const bf16_t* Z = (const bf16_t*)(p.ws + OFF_Z);
    bf16_t* Y = (bf16_t*)(p.ws + OFF_Y);
    float* ssa = (float*)(p.ws + OFF_SSQA);
    const int q = tid >> 1, half = tid & 1, d0 = half * 32, p0 = wid * 32;
    const int nrd = (2048 + nb - 1) / nb;
    uint4 zn[4];
    { const int item = min(bid, 2047); const int h = item & 7, c = (item >> 3) & 31, b = item >> 8;
      const uint4* src = (const uint4*)(Z + (size_t)(b * SEQ + c * 128 + q) * NZ + 512 + h * 64 + d0);
#pragma unroll
      for (int i = 0; i < 4; ++i) zn[i] = src[i]; }
    for (int rd_ = 0; rd_ < nrd; ++rd_) {
        const int item = min(bid + rd_ * nb, 2047);
        const int h = item & 7, c = (item >> 3) & 31, b = item >> 8, tok0 = b * SEQ + c * 128;
        const bf16_t* Wsb = (const bf16_t*)(p.ws + OFF_WSB) + ((size_t)l * 8 + h) * 128 * 128;
        bf16x8 af[4][2];
#pragma unroll
        for (int ks = 0; ks < 4; ++ks)
#pragma unroll
            for (int i = 0; i < 2; ++i) af[ks][i] = *(const bf16x8*)(Wsb + (size_t)(p0 + i * 16 + fr) * 128 + ks * 32 + fq * 8);
        uint2 uu[2][4]; float bsv[2];
#pragma unroll
        for (int i = 0; i < 2; ++i) { const int pp = p0 + i * 16 + fr; bsv[i] = p.gmlp_bs[((size_t)l * 8 + h) * 128 + pp];
#pragma unroll
            for (int j = 0; j < 4; ++j) uu[i][j] = *(const uint2*)(Z + (size_t)(tok0 + pp) * NZ + h * 64 + j * 16 + fq * 4); }
        {
            float f[32];
#pragma unroll
            for (int i = 0; i < 4; ++i) { const uint4 v = zn[i]; const unsigned w[4] = {v.x, v.y, v.z, v.w};
#pragma unroll
                for (int j = 0; j < 4; ++j) { f[i * 8 + j * 2] = bf2f(w[j] & 0xffffu); f[i * 8 + j * 2 + 1] = bf2f(w[j] >> 16); } }
            float s_ = 0.f;
#pragma unroll
            for (int i = 0; i < 32; ++i) s_ += f[i];
            s_ += __shfl_xor(s_, 1);
            const float mean = s_ * (1.0f / 64.0f);
            float qv = 0.f;
#pragma unroll
            for (int i = 0; i < 32; ++i) { f[i] -= mean; qv += f[i] * f[i]; }
            qv += __shfl_xor(qv, 1);
            const float rstd = rsqrtf(qv * (1.0f / 64.0f) + EPS);
#pragma unroll
            for (int i = 0; i < 32; ++i) vnT[(d0 + i) * TP + q] = f2bf(f[i] * rstd);
        }
        {
            const int itn = min(bid + (rd_ + 1) * nb, 2047); const int hn = itn & 7, cn = (itn >> 3) & 31, bn = itn >> 8;
            const uint4* src = (const uint4*)(Z + (size_t)(bn * SEQ + cn * 128 + q) * NZ + 512 + hn * 64 + d0);
#pragma unroll
            for (int i = 0; i < 4; ++i) zn[i] = src[i];
        }
        __syncthreads();
        f32x4 acc[2][4];
#pragma unroll
        for (int i = 0; i < 2; ++i)
#pragma unroll
            for (int j = 0; j < 4; ++j) acc[i][j] = (f32x4){0.f, 0.f, 0.f, 0.f};
#pragma unroll
        for (int ks = 0; ks < 4; ++ks) {
            bf16x8 bfr[4];
#pragma unroll
            for (int j = 0; j < 4; ++j) bfr[j] = *(const bf16x8*)(vnT + (j * 16 + fr) * TP + ks * 32 + fq * 8);
#pragma unroll
            for (int i = 0; i < 2; ++i)
#pragma unroll
                for (int j = 0; j < 4; ++j) acc[i][j] = MFMA16(bfr[j], af[ks][i], acc[i][j]);
        }
#pragma unroll
        for (int i = 0; i < 2; ++i) {
            const int pp = p0 + i * 16 + fr, tok = tok0 + pp;
            float ss = 0.f;
#pragma unroll
            for (int j = 0; j < 4; ++j) {
                const int d = j * 16 + fq * 4;
                const float y0 = bf2f(uu[i][j].x & 0xffffu) * (acc[i][j][0] + bsv[i]), y1 = bf2f(uu[i][j].x >> 16) * (acc[i][j][1] + bsv[i]);
                const float y2 = bf2f(uu[i][j].y & 0xffffu) * (acc[i][j][2] + bsv[i]), y3 = bf2f(uu[i][j].y >> 16) * (acc[i][j][3] + bsv[i]);
                ss += y0 * y0 + y1 * y1 + y2 * y2 + y3 * y3;
                *(uint2*)(Y + (size_t)tok * D + h * 64 + d) = make_uint2(pk_bf16(y0, y1), pk_bf16(y2, y3));
            }
            ss += __shfl_xor(ss, 16); ss += __shfl_xor(ss, 32);
            if (fq == 0) ssa[(size_t)tok * 8 + h] = ss;
        }
        __syncthreads();
    }
}

__device__ void phase_mix_ffta(const Params& p, char* smem, int bid, int nb) {
    const int tid = otid(), lane = tid & 63, wid = tid >> 6, fr = lane & 15, fq = lane >> 4;
    bf16_t* dT = (bf16_t*)smem;
    const bf16_t* Z = (const bf16_t*)(p.ws + OFF_Z);
    const bf16_t* DA = (const bf16_t*)(p.ws + OFF_DA);
    bf16x8 af[4][2];
#pragma unroll
    for (int ks = 0; ks < 4; ++ks)
#pragma unroll
        for (int i = 0; i < 2; ++i) af[ks][i] = *(const bf16x8*)(DA + (size_t)(i * 64 + wid * 16 + fr) * 128 + ks * 32 + fq * 8);
    const int nrd = (4096 + nb - 1) / nb;
    uint4 vn[4];
    { const int item = min(bid, 4095); const int bp = item & 63, g = (item >> 6) & 7, b = item >> 9;
      st_load(Z + (size_t)(b * SEQ + bp) * NZ + 1024 + g * 128, (size_t)64 * NZ, vn); }
    for (int rd_ = 0; rd_ < nrd; ++rd_) {
        const int item = min(bid + rd_ * nb, 4095);
        const int bp = item & 63, g = (item >> 6) & 7, b = item >> 9;
        const int k1 = wid * 16 + fr;
        const float2 cs = ((const float2*)(p.ws + OFF_TW))[bp * 64 + k1];
        st_store(vn, dT);
        { const int itn = min(bid + (rd_ + 1) * nb, 4095); const int bpn = itn & 63, gn = (itn >> 6) & 7, bn = itn >> 9;
          st_load(Z + (size_t)(bn * SEQ + bpn) * NZ + 1024 + gn * 128, (size_t)64 * NZ, vn); }
        __syncthreads();
        f32x4 acc[2][4];
#pragma unroll
        for (int i = 0; i < 2; ++i)
#pragma unroll
            for (int j = 0; j < 4; ++j) acc[i][j] = (f32x4){0.f, 0.f, 0.f, 0.f};
#pragma unroll
        for (int ks = 0; ks < 4; ++ks) {
            bf16x8 bfr[4];
#pragma unroll
            for (int j = 0; j < 4; ++j) bfr[j] = *(const bf16x8*)(dT + (j * 16 + fr) * TP + ks * 32 + fq * 8);
#pragma unroll
            for (int i = 0; i < 2; ++i)
#pragma unroll
                for (int j = 0; j < 4; ++j) acc[i][j] = MFMA16(bfr[j], af[ks][i], acc[i][j]);
        }
        bf16_t* Yb = (bf16_t*)(p.ws + OFF_H) + ((((size_t)(b * 8 + g) * 64 + k1) * 64 + bp) * 128);
#pragma unroll
        for (int j = 0; j < 4; ++j) {
            const int ch = j * 16 + fq * 4;
            float yr[4], yi[4];
#pragma unroll
            for (int e = 0; e < 4; ++e) { const float r = acc[0][j][e], im = acc[1][j][e]; yr[e] = r * cs.x + im * cs.y; yi[e] = im * cs.x - r * cs.y; }
            *(uint2*)(Yb + ch) = make_uint2(pk_bf16(yr[0], yr[1]), pk_bf16(yr[2], yr[3]));
            *(uint2*)(Yb + 64 + ch) = make_uint2(pk_bf16(yi[0], yi[1]), pk_bf16(yi[2], yi[3]));
        }
        __syncthreads();
    }
}

__device__ void phase_mix(const Params& p, int l, char* smem, int bid, int nb) {
    phase_mix_gmlp(p, l, smem, bid, nb);
    phase_mix_ffta(p, smem, bid, nb);
}

__device__ void phase_fftb(const Params& p, int l, char* smem, int bid, int nb) {
    const int tid = otid(), lane = tid & 63, wid = tid >> 6, fr = lane & 15, fq = lane >> 4;
    bf16_t* dT = (bf16_t*)smem;
    const bf16_t* DB = (const bf16_t*)(p.ws + OFF_DB);
    bf16_t* Y = (bf16_t*)(p.ws + OFF_Y);
    float* ssb = (float*)(p.ws + OFF_SSQB);
    bf16x8 af[4];
#pragma unroll
    for (int ks = 0; ks < 4; ++ks) af[ks] = *(const bf16x8*)(DB + (size_t)(wid * 16 + fr) * 128 + ks * 32 + fq * 8);
    const int nrd = (4096 + nb - 1) / nb;
    uint4 vn[4];
    { const int item = min(bid, 4095); const int k1 = item & 63, g = (item >> 6) & 7, b = item >> 9;
      st_load((const bf16_t*)(p.ws + OFF_H) + (((size_t)(b * 8 + g) * 64 + k1) * 64) * 128, 128, vn); }
    for (int rd_ = 0; rd_ < nrd; ++rd_) { const int item = min(bid + rd_ * nb, 4096 - 1);
        const int k1 = item & 63, g = (item >> 6) & 7, b = item >> 9;
        float4 fb[4];
#pragma unroll
        for (int j = 0; j < 4; ++j) fb[j] = *(const float4*)(p.fnet_b + ((size_t)l * 8 + g) * 64 + j * 16 + fq * 4);
        st_store(vn, dT);
        { const int itn = min(bid + (rd_ + 1) * nb, 4095); const int k1n = itn & 63, gn = (itn >> 6) & 7, bn = itn >> 9;
          st_load((const bf16_t*)(p.ws + OFF_H) + (((size_t)(bn * 8 + gn) * 64 + k1n) * 64) * 128, 128, vn); }
        __syncthreads();
        f32x4 acc[4];
#pragma unroll
        for (int j = 0; j < 4; ++j) acc[j] = (f32x4){0.f, 0.f, 0.f, 0.f};
#pragma unroll
        for (int ks = 0; ks < 4; ++ks) {
#pragma unroll
            for (int j = 0; j < 4; ++j) { const bf16x8 bfr = *(const bf16x8*)(dT + (j * 16 + fr) * TP + ks * 32 + fq * 8); acc[j] = MFMA16(bfr, af[ks], acc[j]); }
        }
        const int k2 = wid * 16 + fr, tok = b * SEQ + k1 + 64 * k2;
        float ss = 0.f;
#pragma unroll
        for (int j = 0; j < 4; ++j) {
            const int ch = j * 16 + fq * 4;
            const float y0 = acc[j][0] * (1.0f / 512.0f) + fb[j].x, y1 = acc[j][1] * (1.0f / 512.0f) + fb[j].y, y2 = acc[j][2] * (1.0f / 512.0f) + fb[j].z, y3 = acc[j][3] * (1.0f / 512.0f) + fb[j].w;
            ss += y0 * y0 + y1 * y1 + y2 * y2 + y3 * y3;
            *(uint2*)(Y + (size_t)tok * D + 512 + g * 64 + ch) = make_uint2(pk_bf16(y0, y1), pk_bf16(y2, y3));
        }
        ss += __shfl_xor(ss, 16); ss += __shfl_xor(ss, 32);
        if (fq == 0) ssb[(size_t)tok * 8 + g] = ss;
        __syncthreads();
    }
}

#define INS16(a, v) do { a[15] = med3i(a[14], a[15], v); a[14] = med3i(a[13], a[14], v); a[13] = med3i(a[12], a[13], v); a[12] = med3i(a[11], a[12], v); \
    a[11] = med3i(a[10], a[11], v); a[10] = med3i(a[9], a[10], v); a[9] = med3i(a[8], a[9], v); a[8] = med3i(a[7], a[8], v); a[7] = med3i(a[6], a[7], v); \
    a[6] = med3i(a[5], a[6], v); a[5] = med3i(a[4], a[5], v); a[4] = med3i(a[3], a[4], v); a[3] = med3i(a[2], a[3], v); a[2] = med3i(a[1], a[2], v); \
    a[1] = med3i(a[0], a[1], v); a[0] = max(a[0], v); } while (0)

template <int I, int J> struct CandLoop {
    static __device__ __forceinline__ void run(int (&a)[16], const float (&f1)[16], const float (&f2)[16]) {
        if constexpr ((I + 1) * (J + 1) <= 16) { const int key = (f2key(f1[I] + f2[J]) & ~255) | (I * 16 + J); INS16(a, key); }
        if constexpr (J + 1 < 16) CandLoop<I, J + 1>::run(a, f1, f2);
        else if constexpr (I + 1 < 16) CandLoop<I + 1, 0>::run(a, f1, f2);
    }
};

typedef _Float16 f16x2_t __attribute__((ext_vector_type(2)));
__device__ __forceinline__ unsigned pk_f16(float lo, float hi) { const f16x2_t v = {(_Float16)lo, (_Float16)hi}; return __builtin_bit_cast(unsigned, v); }
__device__ __forceinline__ int h2key(unsigned bits16) { const int b = (int)(short)bits16; return b ^ ((b >> 15) & 0x7fff); }
__device__ __forceinline__ float key2h(int k) { const int b = k ^ ((k >> 15) & 0x7fff); return (float)__builtin_bit_cast(_Float16, (unsigned short)(b & 0xffff)); }

__device__ void phase_topk(const Params& p, int l, char* smem, int bid, int nb) {
    const int tid = otid(), lane = tid & 63, wid = tid >> 6, fr = lane & 15, fq = lane >> 4;
    unsigned* S32 = (unsigned*)smem;
    int* TT = (int*)smem;
    const bf16_t* Q = (const bf16_t*)(p.ws + OFF_Z);
    int* eidx = (int*)(p.ws + OFF_Y); float* gw = (float*)(p.ws + OFF_Y + (size_t)T * 128 * 4);
    const int hh = wid >> 1, half = wid & 1;
    for (int rd_ = 0; rd_ < (((T / 64) * 4) + nb - 1) / nb; ++rd_) { const int item = min(bid + rd_ * nb, ((T / 64) * 4) - 1);
        const int hp = item & 3, tok0 = (item >> 2) * 64, h = hp * 2 + hh;
        const bf16_t* Kh = (const bf16_t*)(p.ws + OFF_K12) + (((size_t)l * 8 + h) * 256 + half * 128) * 128;
        const bf16_t* Qh = Q + (size_t)tok0 * 2048 + h * 256 + half * 128;
        {
            f32x4 acc[4][8];
#pragma unroll
            for (int i = 0; i < 4; ++i)
#pragma unroll
                for (int j = 0; j < 8; ++j) acc[i][j] = (f32x4){0.f, 0.f, 0.f, 0.f};
#pragma unroll
            for (int ks = 0; ks < 4; ++ks) {
                bf16x8 af[4];
#pragma unroll
                for (int i = 0; i < 4; ++i) af[i] = *(const bf16x8*)(Qh + (size_t)(i * 16 + fr) * 2048 + ks * 32 + fq * 8);
#pragma unroll
                for (int jh = 0; jh < 2; ++jh) {
                    bf16x8 bfr[4];
#pragma unroll
                    for (int j = 0; j < 4; ++j) bfr[j] = *(const bf16x8*)(Kh + (size_t)((jh * 4 + j) * 16 + fr) * 128 + ks * 32 + fq * 8);
#pragma unroll
                    for (int i = 0; i < 4; ++i)
#pragma unroll
                        for (int j = 0; j < 4; ++j) acc[i][jh * 4 + j] = MFMA16(bfr[j], af[i], acc[i][jh * 4 + j]);
                    __builtin_amdgcn_sched_barrier(0);
                }
            }
#pragma unroll
            for (int i = 0; i < 4; ++i)
#pragma unroll
                for (int j = 0; j < 8; ++j) {
                    unsigned* d = S32 + (i * 16 + fr) * 257 + hh * 128 + half * 64 + j * 8 + fq * 2;
                    d[0] = pk_f16(acc[i][j][0], acc[i][j][1]); d[1] = pk_f16(acc[i][j][2], acc[i][j][3]);
                }
        }
        vsync(smem);
        int a[16];
#pragma unroll
        for (int i = 0; i < 16; ++i) a[i] = (int)0x80000000;
        {
            const unsigned* sr = S32 + lane * 257 + hh * 128 + half * 64;
#pragma unroll 2
            for (int i = 0; i < 64; ++i) {
                const unsigned w = sr[i];
                const int k0 = (h2key(w & 0xffffu) << 7) | (2 * i), k1 = (h2key(w >> 16) << 7) | (2 * i + 1);
                INS16(a, k0); INS16(a, k1);
            }
        }
        vsync(smem);
#pragma unroll
        for (int i = 0; i < 16; ++i) TT[((lane * 2 + hh) * 2 + half) * 16 + i] = a[i];
        vsync(smem);
        if (tid < 128) {
            const int tk = tid & 63, h2 = tid >> 6, hd = hp * 2 + h2;
            const int* t1 = TT + ((tk * 2 + h2) * 2) * 16; const int* t2 = t1 + 16;
            float f1[16], f2[16];
#pragma unroll
            for (int i = 0; i < 16; ++i) { f1[i] = key2h(t1[i] >> 7); f2[i] = key2h(t2[i] >> 7); }
            int c[16];
#pragma unroll
            for (int i = 0; i < 16; ++i) c[i] = (int)0x80000000;
            CandLoop<0, 0>::run(c, f1, f2);
            float sc[16], e[16], sum = 0.f; int ex[16];
#pragma unroll
            for (int i = 0; i < 16; ++i) {
                sc[i] = key2f(c[i] & ~255);
                const int code = c[i] & 255;
                ex[i] = (t1[code >> 4] & 127) * 128 + (t2[code & 15] & 127);
            }
#pragma unroll
            for (int i = 0; i < 16; ++i) { e[i] = __expf(sc[i] - sc[0]); sum += e[i]; }
            const float inv = 1.0f / sum;
            int4* ep = (int4*)(eidx + (size_t)(tok0 + tk) * 128 + hd * 16); float4* gp = (float4*)(gw + (size_t)(tok0 + tk) * 128 + hd * 16);
#pragma unroll
            for (int i = 0; i < 4; ++i) { ep[i] = make_int4(ex[4 * i], ex[4 * i + 1], ex[4 * i + 2], ex[4 * i + 3]); gp[i] = make_float4(e[4 * i] * inv, e[4 * i + 1] * inv, e[4 * i + 2] * inv, e[4 * i + 3] * inv); }
        }
        vsync(smem);
    }
}

__device__ __forceinline__ float dot16_fp8(const float (&h)[16], const int4& u) {
    const int w[4] = {u.x, u.y, u.z, u.w};
    f32x2_t a = {0.f, 0.f};
#pragma unroll
    for (int i = 0; i < 4; ++i) {
        const f32x2_t lo = __builtin_amdgcn_cvt_pk_f32_fp8(w[i], false), hi = __builtin_amdgcn_cvt_pk_f32_fp8(w[i], true);
        const f32x2_t h0 = {h[4 * i], h[4 * i + 1]}, h1 = {h[4 * i + 2], h[4 * i + 3]};
        a = __builtin_elementwise_fma(lo, h0, a); a = __builtin_elementwise_fma(hi, h1, a);
    }
    return a.x + a.y;
}
__device__ __forceinline__ void axpy16_fp8(float (&o)[16], float c, const int4& v) {
    const int w[4] = {v.x, v.y, v.z, v.w};
#pragma unroll
    for (int i = 0; i < 4; ++i) {
        const f32x2_t lo = __builtin_amdgcn_cvt_pk_f32_fp8(w[i], false), hi = __builtin_amdgcn_cvt_pk_f32_fp8(w[i], true);
        o[4 * i] += c * lo.x; o[4 * i + 1] += c * lo.y; o[4 * i + 2] += c * hi.x; o[4 * i + 3] += c * hi.y;
    }
}

typedef _Float16 h2_t __attribute__((ext_vector_type(2)));
__device__ __forceinline__ float dot32_fp4(const h2_t (&h)[16], const int4& u) {
    const unsigned w[4] = {(unsigned)u.x, (unsigned)u.y, (unsigned)u.z, (unsigned)u.w};
    float a0 = 0.f, a1 = 0.f;
#pragma unroll
    for (int i = 0; i < 4; ++i) {
        a0 = __builtin_amdgcn_fdot2(__builtin_bit_cast(h2_t, __builtin_amdgcn_cvt_scalef32_pk_f16_fp4(w[i], 1.0f, 0)), h[4 * i], a0, false);
        a1 = __builtin_amdgcn_fdot2(__builtin_bit_cast(h2_t, __builtin_amdgcn_cvt_scalef32_pk_f16_fp4(w[i], 1.0f, 1)), h[4 * i + 1], a1, false);
        a0 = __builtin_amdgcn_fdot2(__builtin_bit_cast(h2_t, __builtin_amdgcn_cvt_scalef32_pk_f16_fp4(w[i], 1.0f, 2)), h[4 * i + 2], a0, false);
        a1 = __builtin_amdgcn_fdot2(__builtin_bit_cast(h2_t, __builtin_amdgcn_cvt_scalef32_pk_f16_fp4(w[i], 1.0f, 3)), h[4 * i + 3], a1, false);
    }
    return a0 + a1;
}
typedef int v8i_t __attribute__((ext_vector_type(8)));
typedef int i32x4_t __attribute__((ext_vector_type(4)));
typedef int i32x2_t __attribute__((ext_vector_type(2)));
constexpr float PU_XS = 4.0f;
constexpr int PU_WAVE_LDS = 16384 + 2048;
__device__ __forceinline__ void glds16(const void* g, unsigned lds_addr) {
    unsigned sv_;
    asm volatile("s_mov_b32 %0, m0\n\ts_mov_b32 m0, %2\n\ts_nop 0\n\tglobal_load_lds_dwordx4 %1, off\n\ts_mov_b32 m0, %0" : "=&s"(sv_) : "v"(g), "s"(lds_addr) : "memory");
}
__device__ void phase_pu(const Params& p, int l, int slice, int grank_base, int gsz, char* smem512) {
    int tid_ = threadIdx.x; asm volatile("" : "+v"(tid_));
    asm volatile("" : "+s"(slice), "+s"(grank_base), "+s"(gsz));
    const int lane = tid_ & 63, wid = __builtin_amdgcn_readfirstlane(tid_ >> 6), n16 = lane & 15, q4 = lane >> 4;
    const char* U4 = p.ws + OFF_UB + ((size_t)(l * 4 + slice) * NE) * 128 + 16 * ((lane & 7) ^ (lane >> 3));
    const char* msrc = lane < 32 ? (p.ws + OFF_Y + 16 * lane) : (p.ws + OFF_H + (size_t)slice * 512 + 16 * (lane - 32));
    const size_t mstep = lane < 32 ? 512 : 2048;
    float* part = (float*)(p.ws + OFF_Z) + (size_t)slice * T * 128 + 16 * q4 + n16;
    const int stride = gsz * 4;
    LAS char* wl = (LAS char*)smem512 + wid * PU_WAVE_LDS;
    const unsigned wla = (unsigned)(size_t)wl;
    const int boff = n16 * 128 + 16 * (q4 ^ (n16 & 7));
    const int ioff = 4 * (lane >> 3);
#define PU_META(tok_, mb_) glds16(msrc + (size_t)(tok_) * mstep, wla + 16384u + (unsigned)(mb_))
#define PU_IDS(id_, mb_, h_) do { _Pragma("unroll") for (int i_ = 0; i_ < 8; ++i_) id_[i_] = *(const LAS int*)(wl + 16384 + (mb_) + 256 * (h_) + ioff + 32 * i_); } while (0)
#define PU_DMA(id_, h_) do { _Pragma("unroll") for (int i_ = 0; i_ < 8; ++i_) glds16(U4 + (size_t)id_[i_] * 128, wla + (unsigned)((h_) * 8192 + i_ * 1024)); } while (0)
#define PU_HALF(h_) do { i32x4_t b0_[4], b1_[4]; \
        _Pragma("unroll") for (int m_ = 0; m_ < 4; ++m_) { b0_[m_] = *(const LAS i32x4_t*)(wl + (h_) * 8192 + m_ * 2048 + boff); b1_[m_] = *(const LAS i32x4_t*)(wl + (h_) * 8192 + m_ * 2048 + (boff ^ 64)); } \
        _Pragma("unroll") for (int m_ = 0; m_ < 4; ++m_) { \
        const v8i_t B0 = {b0_[m_][0], b0_[m_][1], b0_[m_][2], b0_[m_][3], 0, 0, 0, 0}, B1 = {b1_[m_][0], b1_[m_][1], b1_[m_][2], b1_[m_][3], 0, 0, 0, 0}; \
        acc[(h_) * 4 + m_] = __builtin_amdgcn_mfma_scale_f32_16x16x128_f8f6f4(A0, B0, acc[(h_) * 4 + m_], 0, 4, 0, 0, 0, 0); \
        acc[(h_) * 4 + m_] = __builtin_amdgcn_mfma_scale_f32_16x16x128_f8f6f4(A1, B1, acc[(h_) * 4 + m_], 0, 4, 0, 0, 0, 0); } } while (0)
    const int tok0 = grank_base * 4 + wid;
    if (tok0 >= T) return;
    const int nit = (T - tok0 + stride - 1) / stride;
    int tok = tok0, tok1 = min(tok0 + stride, T - 1);
    int idA[8], idB[8];
    PU_META(tok, 0); PU_META(tok1, 1024);
    asm volatile("s_waitcnt vmcnt(0)" ::: "memory");
    PU_IDS(idA, 0, 0); PU_IDS(idB, 0, 1);
    PU_DMA(idA, 0);
#pragma nounroll
    for (int it = 0; it < nit; ++it) {
        const int mbc = (it & 1) * 1024, mbn = 1024 - mbc;
        __builtin_amdgcn_sched_barrier(0);
        PU_DMA(idB, 1);
        asm volatile("s_waitcnt vmcnt(8)" ::: "memory");
        __builtin_amdgcn_sched_barrier(0);
        { const i32x2_t xr = *(const LAS i32x2_t*)(wl + 16384 + mbc + 512 + 8 * lane);
          const float f0 = fminf(fmaxf(bf2f((unsigned)xr[0] & 0xffffu) * PU_XS, -448.f), 448.f), f1 = fminf(fmaxf(bf2f((unsigned)xr[0] >> 16) * PU_XS, -448.f), 448.f),
                      f2 = fminf(fmaxf(bf2f((unsigned)xr[1] & 0xffffu) * PU_XS, -448.f), 448.f), f3 = fminf(fmaxf(bf2f((unsigned)xr[1] >> 16) * PU_XS, -448.f), 448.f);
          int w = __builtin_amdgcn_cvt_pk_fp8_f32(f0, f1, 0, false); w = __builtin_amdgcn_cvt_pk_fp8_f32(f2, f3, w, true);
          *(LAS int*)(wl + 16384 + mbc + 512 + 4 * lane) = w; }
        PU_IDS(idA, mbn, 0);
        asm volatile("s_waitcnt lgkmcnt(0)" ::: "memory");
        const LAS char* xb = wl + 16384 + mbc + 512 + 16 * q4;
        const i32x4_t a00 = *(const LAS i32x4_t*)(xb), a01 = *(const LAS i32x4_t*)(xb + 64), a10 = *(const LAS i32x4_t*)(xb + 128), a11 = *(const LAS i32x4_t*)(xb + 192);
        const v8i_t A0 = {a00[0], a00[1], a00[2], a00[3], a01[0], a01[1], a01[2], a01[3]}, A1 = {a10[0], a10[1], a10[2], a10[3], a11[0], a11[1], a11[2], a11[3]};
        f32x4 acc[8];
#pragma unroll
        for (int m = 0; m < 8; ++m) acc[m] = (f32x4){0.f, 0.f, 0.f, 0.f};
        PU_HALF(0);
        asm volatile("s_waitcnt lgkmcnt(0)" ::: "memory");
        __builtin_amdgcn_sched_barrier(0);
        const int tok2 = min(tok1 + stride, T - 1);
        PU_DMA(idA, 0);
        PU_META(tok2, mbc);
        asm volatile("s_waitcnt vmcnt(9)" ::: "memory");
        __builtin_amdgcn_sched_barrier(0);
        PU_IDS(idB, mbn, 1);
        PU_HALF(1);
        __builtin_amdgcn_sched_barrier(0);
        float s0 = acc[0][0], s1 = acc[4][0];
        s0 = q4 == 1 ? acc[1][0] : s0; s1 = q4 == 1 ? acc[5][0] : s1;
        s0 = q4 == 2 ? acc[2][0] : s0; s1 = q4 == 2 ? acc[6][0] : s1;
        s0 = q4 == 3 ? acc[3][0] : s0; s1 = q4 == 3 ? acc[7][0] : s1;
        float* pr = part + (size_t)tok * 128;
        pr[0] = s0 * (1.0f / PU_XS); pr[64] = s1 * (1.0f / PU_XS);
        tok = tok1; tok1 = tok2;
    }
    asm volatile("s_waitcnt vmcnt(0)" ::: "memory");
#undef PU_META
#undef PU_IDS
#undef PU_DMA
#undef PU_HALF
}
__device__ void phase_pc(const Params& p, int l, int bid, int nb) {
    const int tid_ = otid(); const int lane = tid_ & 63, wid = tid_ >> 6;
    const int* eidx = (const int*)(p.ws + OFF_Y); const float* gw = (const float*)(p.ws + OFF_Y + (size_t)T * 128 * 4);
    unsigned char* crec = (unsigned char*)(p.ws + OFF_Y + (size_t)T * 128 * 8);
    const float* part = (const float*)(p.ws + OFF_Z);
    const float* usc = (const float*)(p.ws + OFF_USC) + (size_t)l * NE; const float* vsc = (const float*)(p.ws + OFF_VSC) + (size_t)l * NE;
    constexpr int NU = 2;
    for (int tok0 = bid * 4 + wid; tok0 < T; tok0 += nb * 4 * NU) {
        int tk[NU]; bool ok[NU];
#pragma unroll
        for (int u = 0; u < NU; ++u) { ok[u] = tok0 + u * nb * 4 < T; tk[u] = ok[u] ? tok0 + u * nb * 4 : tok0; }
        int e[NU][2]; float g[NU][2], a[NU][2][4];
#pragma unroll
        for (int u = 0; u < NU; ++u)
#pragma unroll
            for (int hh = 0; hh < 2; ++hh) { const size_t j = (size_t)tk[u] * 128 + hh * 64 + lane; e[u][hh] = eidx[j]; g[u][hh] = gw[j];
#pragma unroll
                for (int sl = 0; sl < 4; ++sl) a[u][hh][sl] = part[(size_t)sl * T * 128 + j]; }
        float us[NU][2], vs[NU][2];
#pragma unroll
        for (int u = 0; u < NU; ++u)
#pragma unroll
            for (int hh = 0; hh < 2; ++hh) { us[u][hh] = usc[e[u][hh]]; vs[u][hh] = vsc[e[u][hh]]; }
#pragma unroll
        for (int u = 0; u < NU; ++u) {
            float c[2];
#pragma unroll
            for (int hh = 0; hh < 2; ++hh) c[hh] = g[u][hh] * gelu_f(((a[u][hh][0] + a[u][hh][1]) + (a[u][hh][2] + a[u][hh][3])) * us[u][hh]) * vs[u][hh];
            float m = fmaxf(fabsf(c[0]), fabsf(c[1]));
#pragma unroll
            for (int o = 32; o >= 1; o >>= 1) m = fmaxf(m, __shfl_xor(m, o));
            const float S = (m > 1e-30f) ? 256.0f / m : 1.0f;
            unsigned char* rec = crec + (size_t)tk[u] * 512;
#pragma unroll
            for (int hh = 0; hh < 2; ++hh) {
                const float cs = c[hh] * S;
                const int hi = __builtin_amdgcn_cvt_pk_fp8_f32(cs, 0.f, 0, false) & 0xff;
                const float r = (cs - __builtin_amdgcn_cvt_f32_fp8(hi, 0)) * 16.0f;
                const int lo = __builtin_amdgcn_cvt_pk_fp8_f32(r, 0.f, 0, false) & 0xff;
                if (ok[u]) { rec[hh * 64 + lane] = (unsigned char)hi; rec[128 + hh * 64 + lane] = (unsigned char)lo; }
            }
            if (lane == 0 && ok[u]) *(float*)(rec + 256) = 1.0f / S;
        }
    }
}
__device__ void phase_pv(const Params& p, int l, int slice, int grank_base, int gsz, char* smem512) {
    int tid_ = threadIdx.x; asm volatile("" : "+v"(tid_));
    asm volatile("" : "+s"(slice), "+s"(grank_base), "+s"(gsz));
    const int lane = tid_ & 63, wid = __builtin_amdgcn_readfirstlane(tid_ >> 6), n16 = lane & 15, q4 = lane >> 4;
    const char* V4e = p.ws + OFF_VB + ((size_t)(l * 4 + slice) * NE) * 128 + 16 * ((lane & 7) ^ (lane >> 4));
    const char* V4o = p.ws + OFF_VB + ((size_t)(l * 4 + slice) * NE) * 128 + 16 * ((lane & 7) ^ (lane >> 4) ^ 4);
    const char* msrc = lane < 32 ? (p.ws + OFF_Y + 16 * lane) : (p.ws + OFF_Y + (size_t)T * 128 * 8 + 16 * (lane - 32));
    bf16_t* Sout = (bf16_t*)(p.ws + OFF_Z) + slice * 256 + 4 * lane;
    const int stride = gsz * 4;
    LAS char* wl = (LAS char*)smem512 + wid * PU_WAVE_LDS;
    const unsigned wla = (unsigned)(size_t)wl;
    const int ioff = 4 * (lane >> 3);
    const int rowb = (q4 >> 1) * 8192 + (32 * (q4 & 1) + n16) * 128;
    int vad[8];
#pragma unroll
    for (int jj = 0; jj < 8; ++jj) vad[jj] = rowb + ((16 * jj) ^ (16 * (n16 >> 1)));
    const int aoff = 16384 + 512 + 128 * (n16 & 1) + 16 * q4;
#define PV_META(tok_, mb_) glds16(msrc + (size_t)(tok_) * 512, wla + 16384u + (unsigned)(mb_))
#define PV_IDS(id_, mb_) do { _Pragma("unroll") for (int i_ = 0; i_ < 16; ++i_) id_[i_] = *(const LAS int*)(wl + 16384 + (mb_) + ioff + 32 * i_); } while (0)
#define PV_DMA(id_) do { _Pragma("unroll") for (int i_ = 0; i_ < 16; ++i_) glds16(((i_ & 1) ? V4o : V4e) + (size_t)id_[i_] * 128, wla + (unsigned)(i_ * 1024)); } while (0)
    const int tok0 = grank_base * 4 + wid;
    if (tok0 >= T) return;
    const int nit = (T - tok0 + stride - 1) / stride;
    int tok = tok0, tok1 = min(tok0 + stride, T - 1);
    int idv[16];
    PV_META(tok, 0);
    asm volatile("s_waitcnt vmcnt(0)" ::: "memory");
    PV_IDS(idv, 0);
    asm volatile("s_waitcnt lgkmcnt(0)" ::: "memory");
    PV_DMA(idv);
    PV_META(tok1, 1024);
#pragma nounroll
    for (int it = 0; it < nit; ++it) {
        const int mbc = (it & 1) * 1024, mbn = 1024 - mbc;
        __builtin_amdgcn_sched_barrier(0);
        asm volatile("s_waitcnt vmcnt(1)" ::: "memory");
        __builtin_amdgcn_sched_barrier(0);
        const i32x4_t a0 = *(const LAS i32x4_t*)(wl + mbc + aoff), a1 = *(const LAS i32x4_t*)(wl + mbc + aoff + 64);
        const float invS = *(const LAS float*)(wl + 16384 + mbc + 512 + 256);
        const v8i_t A = {a0[0], a0[1], a0[2], a0[3], a1[0], a1[1], a1[2], a1[3]};
        i32x2_t bt[16][2];
#pragma unroll
        for (int j = 0; j < 16; ++j) {
            bt[j][0] = __builtin_amdgcn_ds_read_tr4_b64_v2i32((LAS i32x2_t*)(wl + vad[j >> 1] + 8 * (j & 1)));
            bt[j][1] = __builtin_amdgcn_ds_read_tr4_b64_v2i32((LAS i32x2_t*)(wl + vad[j >> 1] + 8 * (j & 1) + 2048));
        }
        asm volatile("s_waitcnt vmcnt(0)" ::: "memory");
        PV_IDS(idv, mbn);
        asm volatile("s_waitcnt lgkmcnt(0)" ::: "memory");
        __builtin_amdgcn_sched_barrier(0);
        PV_DMA(idv);
        __builtin_amdgcn_sched_barrier(0);
        f32x4 acc[16];
#pragma unroll
        for (int j = 0; j < 16; ++j) {
            const v8i_t B = {bt[j][0][0], bt[j][0][1], bt[j][1][0], bt[j][1][1], 0, 0, 0, 0};
            acc[j] = __builtin_amdgcn_mfma_scale_f32_16x16x128_f8f6f4(A, B, (f32x4){0.f, 0.f, 0.f, 0.f}, 0, 4, 0, 0, 0, 0);
        }
        float v0 = acc[0][0] + acc[0][1] * 0.0625f, v1 = acc[1][0] + acc[1][1] * 0.0625f, v2 = acc[2][0] + acc[2][1] * 0.0625f, v3 = acc[3][0] + acc[3][1] * 0.0625f;
#pragma unroll
        for (int qq = 1; qq < 4; ++qq) {
            v0 = q4 == qq ? acc[4 * qq][0] + acc[4 * qq][1] * 0.0625f : v0; v1 = q4 == qq ? acc[4 * qq + 1][0] + acc[4 * qq + 1][1] * 0.0625f : v1;
            v2 = q4 == qq ? acc[4 * qq + 2][0] + acc[4 * qq + 2][1] * 0.0625f : v2; v3 = q4 == qq ? acc[4 * qq + 3][0] + acc[4 * qq + 3][1] * 0.0625f : v3;
        }
        LAS float* tb = (LAS float*)(wl + 16384 + mbc);
        tb[64 * q4 + n16] = v0; tb[64 * q4 + 16 + n16] = v1; tb[64 * q4 + 32 + n16] = v2; tb[64 * q4 + 48 + n16] = v3;
        asm volatile("s_waitcnt lgkmcnt(0)" ::: "memory");
        const f32x4 o = *(const LAS f32x4*)(tb + 4 * lane);
        *(uint2*)(Sout + (size_t)tok * D) = make_uint2(pk_bf16(o[0] * invS, o[1] * invS), pk_bf16(o[2] * invS, o[3] * invS));
        asm volatile("s_waitcnt lgkmcnt(0)" ::: "memory");
        __builtin_amdgcn_sched_barrier(0);
        const int tok2 = min(tok1 + stride, T - 1);
        PV_META(tok2, mbc);
        tok = tok1; tok1 = tok2;
    }
    asm volatile("s_waitcnt vmcnt(0)" ::: "memory");
#undef PV_META
#undef PV_IDS
#undef PV_DMA
}
__device__ void phase_final_norm(const Params& p, int bid, int nb) {
    const int tid_ = otid(); const int lane = tid_ & 63, wid = tid_ >> 6;
    const bf16_t* sadd = (const bf16_t*)(p.ws + OFF_Z); const float* g2l = (const float*)(p.ws + OFF_MOD) + (size_t)(NL - 1) * NB * 6144 + 5 * D;
    constexpr int NU = 2;
    for (int tok0 = bid * 4 + wid; tok0 < T; tok0 += nb * 4 * NU) {
        int tk[NU]; bool ok[NU];
#pragma unroll
        for (int u = 0; u < NU; ++u) { ok[u] = tok0 + u * nb * 4 < T; tk[u] = ok[u] ? tok0 + u * nb * 4 : tok0; }
        uint2 xw[NU][4], sw[NU][4]; float4 g2[NU][4];
#pragma unroll
        for (int u = 0; u < NU; ++u)
#pragma unroll
            for (int i = 0; i < 4; ++i) { const size_t o = (size_t)tk[u] * D + i * 256 + lane * 4;
                xw[u][i] = *(const uint2*)((const bf16_t*)(p.ws + OFF_XR) + o); sw[u][i] = *(const uint2*)(sadd + o); g2[u][i] = *(const float4*)(g2l + (size_t)(tk[u] / SEQ) * 6144 + i * 256 + lane * 4); }
#pragma unroll
        for (int u = 0; u < NU; ++u) {
            float4 v[4]; float ss = 0.f;
#pragma unroll
            for (int i = 0; i < 4; ++i) { const uint2 w = xw[u][i], s_ = sw[u][i]; const float4 g_ = g2[u][i];
                v[i] = make_float4(bf2f(w.x & 0xffffu) + g_.x * bf2f(s_.x & 0xffffu), bf2f(w.x >> 16) + g_.y * bf2f(s_.x >> 16), bf2f(w.y & 0xffffu) + g_.z * bf2f(s_.y & 0xffffu), bf2f(w.y >> 16) + g_.w * bf2f(s_.y >> 16));
                ss += v[i].x * v[i].x + v[i].y * v[i].y + v[i].z * v[i].z + v[i].w * v[i].w; }
            const float rstd = rsqrtf(wave_sum(ss) * (1.0f / D) + EPS);
            float* xr = p.out + (size_t)tk[u] * D;
#pragma unroll
            for (int i = 0; i < 4; ++i) { const float4 g = *(const float4*)(p.final_g + i * 256 + lane * 4);
                if (ok[u]) *(float4*)(xr + i * 256 + lane * 4) = make_float4(v[i].x * rstd * g.x, v[i].y * rstd * g.y, v[i].z * rstd * g.z, v[i].w * rstd * g.w); }
        }
    }
}

#define XB_TMO      128
#define XB_XCNT(j)  (256  + 64 * (j))
#define XB_XSUB(j)  (1280 + 64 * (j))
#define XB_XGEN(j)  (2304 + 64 * (j))
#define XB_TOP      3328
#define XB_TOPGEN   3392
#define XCD_BAR_WORDS 3456
#define XB_SPIN_CAP (1u << 22)
__device__ __forceinline__ unsigned xb_ld(unsigned* p)              { return __hip_atomic_load(p, __ATOMIC_RELAXED, __HIP_MEMORY_SCOPE_AGENT); }
__device__ __forceinline__ unsigned xb_add(unsigned* p, unsigned v) { return __hip_atomic_fetch_add(p, v, __ATOMIC_RELAXED, __HIP_MEMORY_SCOPE_AGENT); }
__device__ __forceinline__ unsigned xb_xcc_id() { return (unsigned)__builtin_amdgcn_s_getreg((3 << 11) | 20) & 0xFu; }
#define XB_SPIN(cond, bar) do { unsigned _sp = 0; while (cond) { __builtin_amdgcn_s_sleep(1); \
    if ((++_sp & 255u) == 0u) { if (xb_ld(&(bar)[XB_TMO])) break; if (_sp > XB_SPIN_CAP) { atomicAdd(&(bar)[XB_TMO], 1u); break; } } } } while (0)
__device__ __forceinline__ void xcd_barrier_post(unsigned* bar, volatile LAS unsigned* st) {
    if (threadIdx.x == 0) { const unsigned x = xb_xcc_id(); st[3] = x; st[2] = xb_add(&bar[XB_XCNT(x)], 1u); }
}
__device__ __forceinline__ void xcd_barrier_complete(unsigned* bar, unsigned x, unsigned& nloc, unsigned& nx) {
    const unsigned G = gridDim.x * gridDim.y * gridDim.z;
    unsigned sum, cnt, mine, sp = 0u;
    for (;;) {
        sum = 0u; cnt = 0u; mine = 0u;
#pragma unroll
        for (unsigned j = 0; j < 16; ++j) { const unsigned c = xb_ld(&bar[XB_XCNT(j)]); sum += c; cnt += (c > 0u) ? 1u : 0u; mine = (j == x) ? c : mine; }
        if (sum == G) break;
        __builtin_amdgcn_s_sleep(1);
        if ((++sp & 255u) == 0u) { if (xb_ld(&bar[XB_TMO])) break; if (sp > XB_SPIN_CAP) { atomicAdd(&bar[XB_TMO], 1u); break; } }
    }
    nloc = mine > 0u ? mine : 1u; nx = cnt > 0u ? cnt : 1u;
}
__device__ __forceinline__ void xcd_barrier(unsigned* bar, volatile LAS unsigned* st) {
    asm volatile("s_waitcnt vmcnt(0)" ::: "memory");
    __syncthreads();
    int t0_ = threadIdx.x; asm volatile("" : "+v"(t0_));
    if (t0_ == 0) {
        __builtin_amdgcn_s_waitcnt(0);
        unsigned nloc = st[0], nx = st[1]; const unsigned x = st[3];
        if (nloc == 0u) { xcd_barrier_complete(bar, x, nloc, nx); st[0] = nloc; st[1] = nx; }
        const unsigned old = xb_add(&bar[XB_XSUB(x)], 1u);
        const unsigned gen = old / nloc;
        if (old + 1u == (gen + 1u) * nloc) {
            __builtin_amdgcn_fence(__ATOMIC_RELEASE, "agent");
            asm volatile("s_waitcnt vmcnt(0)" ::: "memory");
            const unsigned og = xb_add(&bar[XB_TOP], 1u);
            const unsigned tg = og / nx;
            if (og + 1u == (tg + 1u) * nx) xb_add(&bar[XB_TOPGEN], 1u);
            else XB_SPIN(xb_ld(&bar[XB_TOPGEN]) == tg, bar);
            __builtin_amdgcn_fence(__ATOMIC_ACQUIRE, "agent");
            xb_add(&bar[XB_XGEN(x)], 1u);
            asm volatile("s_waitcnt vmcnt(0)" ::: "memory");
        } else {
            XB_SPIN(xb_ld(&bar[XB_XGEN(x)]) == gen, bar);
            __builtin_amdgcn_fence(__ATOMIC_ACQUIRE, "agent");
            asm volatile("s_waitcnt vmcnt(0)" ::: "memory");
        }
    }
    __syncthreads();
}

#if MEGA
#if PROBE_A >= 0
#define TSTAMP(i) do { if (blockIdx.x == 0 && threadIdx.x == 0) ts[i] = __builtin_amdgcn_s_memrealtime(); } while (0)
#else
#define TSTAMP(i) do { } while (0)
#endif
__global__ void __launch_bounds__(512, 2) mega_kernel(Params p) {
    __shared__ __attribute__((aligned(16))) char smem[2 * SMEM_BYTES + 32];
#if PROBE_A >= 0
    __shared__ unsigned long long ts[26];
#endif
#if COOP
    cg::grid_group grid = cg::this_grid();
#endif
    const int vb = __builtin_amdgcn_readfirstlane((int)(threadIdx.x >> 8));
    const int bid = blockIdx.x * 2 + vb, nb = gridDim.x * 2;
    char* smv = smem + vb * SMEM_BYTES;
    unsigned* bar = (unsigned*)(p.ws + OFF_BAR);
    volatile LAS unsigned* xst = (volatile LAS unsigned*)(smem + 2 * SMEM_BYTES);
#define GBAR() xcd_barrier((unsigned*)(p.ws + OFF_BAR), (volatile LAS unsigned*)(smem + 2 * SMEM_BYTES))
    if (threadIdx.x == 0) { xst[0] = 0u; xst[1] = 0u; xst[2] = 0u; xst[3] = 0u; xst[4] = 0u; xst[5] = 0u; }
    __syncthreads();
#if COOP
    if (blockIdx.x == 0) for (int i = threadIdx.x; i < XCD_BAR_WORDS; i += 512) bar[i] = 0u;
    TSTAMP(0);
    phase_prep(p, smv, bid, nb);
    grid.sync();
    xcd_barrier_post(bar, xst);
#else
    __syncthreads();
    xcd_barrier_post(bar, xst);
    TSTAMP(0);
    phase_prep(p, smv, bid, nb);
    GBAR();
#endif
    TSTAMP(1);
    phase_norm<false, false, 2>(p.x, p.norm1_g, (const float*)(p.ws + OFF_MOD), 0, D, (bf16_t*)(p.ws + OFF_H), bid, nb, nullptr, nullptr, (bf16_t*)(p.ws + OFF_XR)); GBAR();
    int slice4, grank4; const int gsz4 = (int)gridDim.x / 4 * 2;
    {
        const unsigned myx = xst[3], myrank = xst[2];
        unsigned pre = 0;
#pragma unroll
        for (unsigned j = 0; j < 16; ++j) { const unsigned c = xb_ld(&bar[XB_XCNT(j)]); pre += (j < myx) ? c : 0u; }
        const int gi = __builtin_amdgcn_readfirstlane((int)(pre + myrank));
        slice4 = gi / ((int)gridDim.x / 4); grank4 = (gi % ((int)gridDim.x / 4)) * 2;
    }
#pragma nounroll
    for (int l = 0; l < NL; ++l) {
        TSTAMP(2 + 11 * l); phase_gemm1(p, l, smem); GBAR();
        TSTAMP(3 + 11 * l); phase_mix(p, l, smv, bid, nb); GBAR();
        TSTAMP(4 + 11 * l); phase_fftb(p, l, smv, bid, nb); GBAR();
        TSTAMP(5 + 11 * l); phase_gemm2(p, l, smem); GBAR();
        TSTAMP(6 + 11 * l); phase_norm<true, false, 2>(p.ws + OFF_XR, p.norm2_g + l * D, (const float*)(p.ws + OFF_MOD) + (size_t)l * NB * 6144, 3 * D, 4 * D, (bf16_t*)(p.ws + OFF_H), bid, nb); GBAR();
        TSTAMP(7 + 11 * l); phase_gemm3(p, l, smem); GBAR();
        TSTAMP(8 + 11 * l); phase_topk(p, l, smv, bid, nb); GBAR();
        TSTAMP(9 + 11 * l); phase_pu(p, l, slice4, grank4, gsz4, smem); GBAR();
        TSTAMP(10 + 11 * l); phase_pc(p, l, bid, nb); GBAR();
        TSTAMP(11 + 11 * l); phase_pv(p, l, slice4, grank4, gsz4, smem); GBAR();
        TSTAMP(12 + 11 * l);
        if (l + 1 < NL) { phase_norm<true, true>(p.ws + OFF_XR, p.norm1_g + (l + 1) * D, (const float*)(p.ws + OFF_MOD) + (size_t)(l + 1) * NB * 6144, 0, D, (bf16_t*)(p.ws + OFF_H), bid, nb,
                                                 (const bf16_t*)(p.ws + OFF_Z), (const float*)(p.ws + OFF_MOD) + (size_t)l * NB * 6144 + 5 * D); GBAR(); }
        else phase_final_norm(p, bid, nb);
    }
#undef GBAR
    TSTAMP(24);
#if PROBE_A >= 0
    if (bid == 0 && threadIdx.x == 0) p.out[0] += (float)(ts[PROBE_B] - ts[PROBE_A]) * 0.01f / PROBE_DIV;
#endif
}
#endif

extern "C" void kernel_launch(void* const* d_in, const int* in_sizes, int n_in, void* d_out, int out_size, void* d_ws, size_t ws_size, hipStream_t stream) {
    (void)in_sizes; (void)n_in; (void)out_size;
    if (ws_size < OFF_END) { fprintf(stderr, "workspace too small: %zu < %zu\n", ws_size, (size_t)OFF_END); return; }
    Params p{};
    p.x = (const float*)d_in[0]; p.c = (const float*)d_in[1]; p.mod_w = (const float*)d_in[2]; p.mod_b = (const float*)d_in[3]; p.norm1_g = (const float*)d_in[4];
    p.w_in = (const float*)d_in[5]; p.gmlp_ws = (const float*)d_in[6]; p.gmlp_bs = (const float*)d_in[7]; p.fnet_w = (const float*)d_in[8]; p.fnet_b = (const float*)d_in[9];
    p.gain_a = (const float*)d_in[10]; p.gain_b = (const float*)d_in[11]; p.w_out = (const float*)d_in[12]; p.norm2_g = (const float*)d_in[13]; p.wq = (const float*)d_in[14];
    p.k1 = (const float*)d_in[15]; p.k2 = (const float*)d_in[16]; p.pu = (const float*)d_in[17]; p.pv = (const float*)d_in[18]; p.final_g = (const float*)d_in[19];
    p.out = (float*)d_out; p.ws = (char*)d_ws;
#if MEGA
    static int grid_blocks = 0;
    if (!grid_blocks) {
        int dev = 0, cus = 0, per_cu = 0;
        hipGetDevice(&dev);
        hipDeviceGetAttribute(&cus, hipDeviceAttributeMultiprocessorCount, dev);
        hipOccupancyMaxActiveBlocksPerMultiprocessor(&per_cu, mega_kernel, 512, 0);
        if (per_cu > 1) per_cu = 1;
        grid_blocks = (cus * per_cu) / 8 * 8;
    }
    void* args[] = {&p};
    hipError_t e = hipLaunchCooperativeKernel((void*)mega_kernel, dim3(grid_blocks), dim3(512), args, 0, stream);
    if (e != hipSuccess) fprintf(stderr, "cooperative launch failed: %s (grid %d)\n", hipGetErrorString(e), grid_blocks);
#endif
}
```

```cpp
#include <hip/hip_runtime.h>
#include <hip/hip_cooperative_groups.h>
#include <cstdio>
#include <cstdint>
namespace cg = cooperative_groups;

#ifndef MEGA
#define MEGA 1
#endif
#ifndef COOP
#define COOP 1
#endif
#ifndef PROBE_A
#define PROBE_A -1
#define PROBE_B 0
#define PROBE_DIV 10.0f
#endif

typedef unsigned short bf16_t;
typedef short bf16x8 __attribute__((ext_vector_type(8)));
typedef float f32x4 __attribute__((ext_vector_type(4)));
typedef __bf16 bf16x2_t __attribute__((ext_vector_type(2)));

constexpr int D = 1024, NB = 8, SEQ = 4096, T = NB * SEQ, NL = 2;
constexpr int NZ = 2048;
constexpr int NE = 16384;
constexpr float EPS = 1e-6f;

constexpr size_t OFF_MOD  = 0;
constexpr size_t OFF_W1T  = OFF_MOD  + (size_t)NL * NB * 6144 * 4;
constexpr size_t OFF_W2T  = OFF_W1T  + (size_t)NL * 2048 * 1024 * 2;
constexpr size_t OFF_WQT  = OFF_W2T  + (size_t)NL * 1024 * 1024 * 2;
constexpr size_t OFF_K12  = OFF_WQT  + (size_t)NL * 2048 * 1024 * 2;
constexpr size_t OFF_WSB  = OFF_K12  + (size_t)NL * 8 * 256 * 128 * 2;
constexpr size_t OFF_DA   = OFF_WSB  + (size_t)NL * 8 * 128 * 128 * 2;
constexpr size_t OFF_DB   = OFF_DA   + 128 * 128 * 2;
constexpr size_t OFF_TW   = OFF_DB   + 64 * 128 * 2;
constexpr size_t OFF_SSQA = OFF_TW   + 64 * 64 * 8;
constexpr size_t OFF_SSQB = OFF_SSQA + (size_t)T * 8 * 4;
constexpr size_t OFF_UB   = OFF_SSQB + (size_t)T * 8 * 4;
constexpr size_t OFF_VB   = OFF_UB   + (size_t)NL * NE * 1024;
constexpr size_t OFF_USC  = OFF_VB   + (size_t)NL * NE * 1024;
constexpr size_t OFF_VSC  = OFF_USC  + (size_t)NL * NE * 4;
constexpr size_t OFF_H    = OFF_VSC  + (size_t)NL * NE * 4;
constexpr size_t OFF_Z    = OFF_H    + (size_t)T * 1024 * 2;
constexpr size_t OFF_Y    = OFF_Z    + (size_t)T * 2048 * 2;
constexpr size_t OFF_BAR  = OFF_Y    + (size_t)T * 1024 * 2;
constexpr size_t OFF_XR   = OFF_BAR  + 16384;
constexpr size_t OFF_END  = OFF_XR   + (size_t)T * 1024 * 2;

struct Params {
    const float* x; const float* c; const float* mod_w; const float* mod_b; const float* norm1_g; const float* w_in;
    const float* gmlp_ws; const float* gmlp_bs; const float* fnet_w; const float* fnet_b; const float* gain_a; const float* gain_b;
    const float* w_out; const float* norm2_g; const float* wq; const float* k1; const float* k2; const float* pu; const float* pv; const float* final_g;
    float* out; char* ws;
};

constexpr int SMEM_BYTES = 73984;

__device__ __forceinline__ float bf2f(unsigned v) { return __uint_as_float(v << 16); }
typedef float f32x2_t __attribute__((ext_vector_type(2)));
__device__ __forceinline__ unsigned pk_bf16(float lo, float hi) { const f32x2_t v = {lo, hi}; return __builtin_bit_cast(unsigned, __builtin_convertvector(v, bf16x2_t)); }
__device__ __forceinline__ bf16_t f2bf(float f) { return (bf16_t)(pk_bf16(f, 0.f) & 0xffffu); }
__device__ __forceinline__ float gelu_f(float v) {
    const float t = __builtin_amdgcn_rcpf(fabsf(v) * 0.2316418882f + 1.0f);
    float q = t * 0.5307027145f + (-0.7265760135f); q = q * t + 0.7107068705f; q = q * t + (-0.142248368f); q = q * t + 0.127414796f; q = q * t;
    const float m = v * (q * __builtin_amdgcn_exp2f(v * v * (-0.72134752044f)));
    return v < 0.f ? m : v - m;
}
__device__ __forceinline__ int med3i(int a, int b, int c) { return max(min(a, b), min(max(a, b), c)); }
__device__ __forceinline__ int f2key(float f) { int b = __float_as_int(f); return b ^ ((b >> 31) & 0x7fffffff); }
__device__ __forceinline__ float key2f(int k) { return __int_as_float(k ^ ((k >> 31) & 0x7fffffff)); }
__device__ __forceinline__ float wave_sum(float v) {
#pragma unroll
    for (int o = 32; o >= 1; o >>= 1) v += __shfl_xor(v, o);
    return v;
}
__device__ __forceinline__ int otid() { int t = threadIdx.x & 255; asm volatile("" : "+v"(t)); return t; }
__device__ __forceinline__ void vsync(char* smem_v) {
    const int vb_ = threadIdx.x >> 8;
    volatile __attribute__((address_space(3))) unsigned* cnt = (volatile __attribute__((address_space(3))) unsigned*)(smem_v + (2 - vb_) * SMEM_BYTES + 16) + vb_;
    asm volatile("s_waitcnt lgkmcnt(0)" ::: "memory");
    unsigned target = 0u;
    if ((threadIdx.x & 63) == 0) target = (__hip_atomic_fetch_add((__attribute__((address_space(3))) unsigned*)cnt, 1u, __ATOMIC_RELAXED, __HIP_MEMORY_SCOPE_WORKGROUP) / 4u + 1u) * 4u;
    target = __builtin_amdgcn_readfirstlane(target);
    while (*cnt < target) __builtin_amdgcn_s_sleep(1);
    asm volatile("" ::: "memory");
}
#define MFMA16(a, b, c) __builtin_amdgcn_mfma_f32_16x16x32_bf16((a), (b), (c), 0, 0, 0)

__device__ void transpose_tile(const float* __restrict__ src, int ld, int k0, int n0, bf16_t* __restrict__ dst  , int dn0,
                               const float* __restrict__ kscale, float* tile  ) {
    const int tid = otid();
#pragma unroll
    for (int i = 0; i < 4; ++i) {
        const int r = (tid >> 4) + 16 * i, c4 = (tid & 15) * 4;
        const float4 v = *(const float4*)(src + (size_t)(k0 + r) * ld + n0 + c4);
        const float s = kscale ? kscale[k0 + r] : 1.0f;
        tile[r * 65 + c4 + 0] = v.x * s; tile[r * 65 + c4 + 1] = v.y * s; tile[r * 65 + c4 + 2] = v.z * s; tile[r * 65 + c4 + 3] = v.w * s;
    }
    __syncthreads();
    {
        const int n = tid >> 2, ks = (tid & 3) * 16;
        unsigned w[8];
#pragma unroll
        for (int j = 0; j < 8; ++j) w[j] = pk_bf16(tile[(ks + 2 * j) * 65 + n], tile[(ks + 2 * j + 1) * 65 + n]);
        uint4* d = (uint4*)(dst + (size_t)(dn0 + n) * 1024 + k0 + ks);
        d[0] = make_uint4(w[0], w[1], w[2], w[3]); d[1] = make_uint4(w[4], w[5], w[6], w[7]);
    }
    __syncthreads();
}

__device__ void phase_prep(const Params& p, char* smem, int bid_, int nb_) {
    const int tid = otid();
    char* ws = p.ws;
    const int wg_ = bid_ >> 1, nwg_ = nb_ >> 1;
    const bool split = (nb_ % 2 == 0) && nwg_ >= 3;
    const int w5_ = wg_ % 5, r5_ = nwg_ % 5;
    const bool convgrp = split && (w5_ == 1 || w5_ == 3);
    const int ncv_ = 2 * (nwg_ / 5) + (r5_ > 1) + (r5_ > 3);
    const int cvb_ = 2 * (wg_ / 5) + (w5_ > 1) + (w5_ > 3);
    const int bid = split ? (2 * (convgrp ? cvb_ : wg_ - cvb_) + (bid_ & 1)) : bid_, nb = split ? 2 * (convgrp ? ncv_ : nwg_ - ncv_) : nb_;
    const int gtid = bid * 256 + tid, gsz = nb * 256;
    if (!convgrp) {
    {
        float* sc = (float*)smem;
        float* red = (float*)(smem + 32768);
        for (int i = tid; i < 8192; i += 256) { const float v = p.c[i]; sc[i] = v / (1.0f + __expf(-v)); }
        __syncthreads();
        float* mod = (float*)(ws + OFF_MOD);
        for (int rd_ = 0; rd_ < (NL * 192 + nb - 1) / nb; ++rd_) { const int item = min(bid + rd_ * nb, NL * 192 - 1);
            const int l = item / 192, n0 = (item % 192) * 32, nn = tid & 31, kq = tid >> 5;
            float acc[8];
#pragma unroll
            for (int b = 0; b < 8; ++b) acc[b] = 0.f;
            const float* W = p.mod_w + (size_t)l * 1024 * 6144 + n0 + nn;
#pragma nounroll
            for (int k0 = kq; k0 < 1024; k0 += 512) {
                float w[64];
#pragma unroll
                for (int u = 0; u < 64; ++u) w[u] = W[(size_t)(k0 + 8 * u) * 6144];
#pragma unroll
                for (int u = 0; u < 64; ++u)
#pragma unroll
                    for (int b = 0; b < 8; ++b) acc[b] += sc[b * 1024 + k0 + 8 * u] * w[u];
            }
#pragma unroll
            for (int b = 0; b < 8; ++b) red[(kq * 8 + b) * 32 + nn] = acc[b];
            __syncthreads();
            {
                const int b = tid >> 5;
                float s = 0.f;
#pragma unroll
                for (int q = 0; q < 8; ++q) s += red[(q * 8 + b) * 32 + nn];
                mod[((size_t)l * NB + b) * 6144 + n0 + nn] = s + p.mod_b[l * 6144 + n0 + nn];
            }
            __syncthreads();
        }
    }
    {
        float* tile = (float*)smem;
        for (int rd_ = 0; rd_ < (NL * 1024 + nb - 1) / nb; ++rd_) { const int item = min(bid + rd_ * nb, NL * 1024 - 1);
            const int l = item / 1024, r = item % 1024;
            if (r < 256) {
                const int kt = r / 16, nt = r % 16;
                transpose_tile(p.w_in + (size_t)l * 1024 * 1536, 1536, kt * 64, nt * 64, (bf16_t*)(ws + OFF_W1T) + (size_t)l * 2048 * 1024, nt * 64, nullptr, tile);
            } else if (r < 512) {
                const int rr = r - 256, kt = rr / 16, nt = rr % 16;
                const float* gk = (kt < 8) ? (p.gain_a + l * 512) : (p.gain_b + l * 512 - 512);
                transpose_tile(p.w_out + (size_t)l * 1024 * 1024, 1024, kt * 64, nt * 64, (bf16_t*)(ws + OFF_W2T) + (size_t)l * 1024 * 1024, nt * 64, gk, tile);
            } else {
                const int rr = r - 512, kt = rr / 32, nt = rr % 32;
                transpose_tile(p.wq + (size_t)l * 1024 * 2048, 2048, kt * 64, nt * 64, (bf16_t*)(ws + OFF_WQT) + (size_t)l * 2048 * 1024, nt * 64, nullptr, tile);
            }
        }
    }
    {
        float* fws = (float*)smem;
        float* Ms  = (float*)(smem + 16384);
        float* wt  = (float*)(smem + 49152);
        float* cs  = (float*)(smem + 49152 + 17408);
        for (int rd_ = 0; rd_ < (NL * 8 * 16 + nb - 1) / nb; ++rd_) { const int item = min(bid + rd_ * nb, NL * 8 * 16 - 1);
            const int l = item / 128, g = (item % 128) / 16, kt = item % 16;
            if (tid < 64) { float s, c; sincospif((float)tid / 32.0f, &s, &c); cs[tid] = c; cs[64 + tid] = s; }
            for (int i = tid; i < 4096; i += 256) fws[i] = p.fnet_w[((size_t)l * 8 + g) * 4096 + i];
#pragma unroll
            for (int i = 0; i < 4; ++i) {
                const int r = (tid >> 4) + 16 * i, c4 = (tid & 15) * 4;
                const float4 v = *(const float4*)(p.w_in + (size_t)l * 1024 * 1536 + (size_t)(kt * 64 + r) * 1536 + 1024 + g * 64 + c4);
                wt[c4 * 68 + r] = v.x; wt[(c4 + 1) * 68 + r] = v.y; wt[(c4 + 2) * 68 + r] = v.z; wt[(c4 + 3) * 68 + r] = v.w;
            }
            __syncthreads();
            {
                const int d = tid >> 2, r0 = (tid & 3) * 32;
                const bool im = r0 >= 64; const int e0 = r0 & 63;
                float acc[32];
#pragma unroll
                for (int e = 0; e < 32; ++e) acc[e] = 0.f;
#pragma unroll 4
                for (int j = 0; j < 64; ++j) {
                    const int ph = (d * j) & 63;
                    const float t = im ? -cs[64 + ph] : cs[ph];
#pragma unroll
                    for (int e = 0; e < 32; ++e) acc[e] += t * fws[j * 64 + e0 + e];
                }
#pragma unroll
                for (int e = 0; e < 32; ++e) Ms[d * 128 + r0 + e] = acc[e];
            }
            __syncthreads();
            {
                const int r = tid >> 1, kk0 = (tid & 1) * 32;
                float acc[32];
#pragma unroll
                for (int k = 0; k < 32; ++k) acc[k] = 0.f;
#pragma unroll 4
                for (int d = 0; d < 64; ++d) {
                    const float m = Ms[d * 128 + r];
                    const float4* wp = (const float4*)(wt + d * 68 + kk0);
#pragma unroll
                    for (int k4 = 0; k4 < 8; ++k4) { const float4 w4 = wp[k4]; acc[4 * k4] += w4.x * m; acc[4 * k4 + 1] += w4.y * m; acc[4 * k4 + 2] += w4.z * m; acc[4 * k4 + 3] += w4.w * m; }
                }
                bf16_t* dst = (bf16_t*)(ws + OFF_W1T) + (size_t)l * 2048 * 1024 + (size_t)(1024 + g * 128 + r) * 1024 + kt * 64 + kk0;
#pragma unroll
                for (int q = 0; q < 4; ++q)
                    ((uint4*)dst)[q] = make_uint4(pk_bf16(acc[q * 8], acc[q * 8 + 1]), pk_bf16(acc[q * 8 + 2], acc[q * 8 + 3]), pk_bf16(acc[q * 8 + 4], acc[q * 8 + 5]), pk_bf16(acc[q * 8 + 6], acc[q * 8 + 7]));
            }
            __syncthreads();
        }
    }
    {
        bf16_t* k12 = (bf16_t*)(ws + OFF_K12);
        for (int i = gtid; i < NL * 8 * 256 * 128; i += gsz) {
            const int d = i & 127, n = (i >> 7) & 255, h = (i >> 15) & 7, l = i >> 18;
            const float* src = (n < 128) ? p.k1 : p.k2;
            k12[i] = f2bf(src[(((size_t)l * 8 + h) * 128 + (n & 127)) * 128 + d]);
        }
        bf16_t* wsb = (bf16_t*)(ws + OFF_WSB);
        for (int i = gtid; i < NL * 8 * 128 * 128; i += gsz) wsb[i] = f2bf(p.gmlp_ws[i]);
        bf16_t* DA = (bf16_t*)(ws + OFF_DA);
        for (int i = gtid; i < 128 * 128; i += gsz) {
            const int m = i >> 7, kk = i & 127, ro = m >> 6, k1 = m & 63, ri = kk >> 6, a = kk & 63;
            float s, c; sincospif((float)((a * k1) & 63) / 32.0f, &s, &c);
            const float v = (ro == ri) ? c : (ro == 0 ? s : -s);
            DA[i] = f2bf(v);
        }
        bf16_t* DB = (bf16_t*)(ws + OFF_DB);
        for (int i = gtid; i < 64 * 128; i += gsz) {
            const int k2 = i >> 7, kk = i & 127, ri = kk >> 6, b = kk & 63;
            float s, c; sincospif((float)((b * k2) & 63) / 32.0f, &s, &c);
            DB[i] = f2bf(ri ? s : c);
        }
        float2* tw = (float2*)(ws + OFF_TW);
        for (int i = gtid; i < 64 * 64; i += gsz) {
            const int bp = i >> 6, k1 = i & 63;
            float s, c; sincospif((float)(bp * k1) / 2048.0f, &s, &c);
            tw[i] = make_float2(c, s);
        }
    }
    }
    if (convgrp || !split) {
        {
            const int lane = tid & 63, wv = gtid >> 6, nwv = gsz >> 6;
            const int R = 2 * NL * NE;
#pragma nounroll
            for (int r0 = wv; r0 < R; r0 += 4 * nwv) {
                float4 v[4][4];
#pragma unroll
                for (int t = 0; t < 4; ++t) {
                    const int r = (r0 + t * nwv < R) ? r0 + t * nwv : r0;
                    const int tbl = r / (NL * NE), row = r % (NL * NE);
                    const float* src = (tbl ? p.pv : p.pu) + (size_t)row * 1024 + lane * 16;
#pragma unroll
                    for (int i = 0; i < 4; ++i) v[t][i] = ((const float4*)src)[i];
                }
                __builtin_amdgcn_sched_barrier(0);
#pragma unroll
                for (int t = 0; t < 4; ++t) {
                    const int r = r0 + t * nwv;
                    if (r >= R) break;
                    const int tbl = r / (NL * NE), row = r % (NL * NE);
                    float m = 0.f;
#pragma unroll
                    for (int i = 0; i < 4; ++i) m = fmaxf(m, fmaxf(fmaxf(fabsf(v[t][i].x), fabsf(v[t][i].y)), fmaxf(fabsf(v[t][i].z), fabsf(v[t][i].w))));
#pragma unroll
                    for (int o = 32; o >= 1; o >>= 1) m = fmaxf(m, __shfl_xor(m, o));
                    const float qmax = 6.0f;
                    const float sc = (m > 0.f) ? qmax / m : 1.0f, inv = (m > 0.f) ? m / qmax : 1.0f;
                    const int lyr = row / NE, ex = row % NE;
                    if (true) {
                        unsigned w0 = 0u, w1 = 0u;
                        w0 = __builtin_amdgcn_cvt_scalef32_pk_fp4_f32(w0, v[t][0].x * sc, v[t][0].y * sc, 1.0f, 0); w0 = __builtin_amdgcn_cvt_scalef32_pk_fp4_f32(w0, v[t][0].z * sc, v[t][0].w * sc, 1.0f, 1);
                        w0 = __builtin_amdgcn_cvt_scalef32_pk_fp4_f32(w0, v[t][1].x * sc, v[t][1].y * sc, 1.0f, 2); w0 = __builtin_amdgcn_cvt_scalef32_pk_fp4_f32(w0, v[t][1].z * sc, v[t][1].w * sc, 1.0f, 3);
                        w1 = __builtin_amdgcn_cvt_scalef32_pk_fp4_f32(w1, v[t][2].x * sc, v[t][2].y * sc, 1.0f, 0); w1 = __builtin_amdgcn_cvt_scalef32_pk_fp4_f32(w1, v[t][2].z * sc, v[t][2].w * sc, 1.0f, 1);
                        w1 = __builtin_amdgcn_cvt_scalef32_pk_fp4_f32(w1, v[t][3].x * sc, v[t][3].y * sc, 1.0f, 2); w1 = __builtin_amdgcn_cvt_scalef32_pk_fp4_f32(w1, v[t][3].z * sc, v[t][3].w * sc, 1.0f, 3);
                        *(uint2*)(ws + (tbl ? OFF_VB : OFF_UB) + ((size_t)(lyr * 4 + (lane >> 4)) * NE + ex) * 128 + (lane & 15) * 8) = make_uint2(w0, w1);
                    } else {
                        int w[4];
#pragma unroll
                        for (int i = 0; i < 4; ++i) { w[i] = __builtin_amdgcn_cvt_pk_fp8_f32(v[t][i].x * sc, v[t][i].y * sc, 0, false); w[i] = __builtin_amdgcn_cvt_pk_fp8_f32(v[t][i].z * sc, v[t][i].w * sc, w[i], true); }
                        *(int4*)(ws + OFF_UB + ((size_t)(lyr * 8 + (lane >> 3)) * NE + ex) * 128 + (lane & 7) * 16) = make_int4(w[0], w[1], w[2], w[3]);
                    }
                    if (lane == 0) ((float*)(ws + (tbl ? OFF_VSC : OFF_USC)))[row] = inv;
                    __builtin_amdgcn_sched_barrier(0);
                }
            }
        }
    }
}

template <bool SRC_BF16, bool ADD = false, int NU = 2>
__device__ void phase_norm(const void* xsrc_, const float* __restrict__ g, const float* __restrict__ modl  , int sh_off, int scl_off,
                           bf16_t* __restrict__ hout, int bid, int nb, const bf16_t* __restrict__ sadd = nullptr, const float* __restrict__ g2l = nullptr, bf16_t* __restrict__ xcopy = nullptr) {
    const int tid_ = otid(); const int lane = tid_ & 63, wid = tid_ >> 6;
    for (int tok0 = bid * 4 + wid; tok0 < T; tok0 += nb * 4 * NU) {
        int tk[NU]; bool ok[NU];
#pragma unroll
        for (int u = 0; u < NU; ++u) { ok[u] = tok0 + u * nb * 4 < T; tk[u] = ok[u] ? tok0 + u * nb * 4 : tok0; }
        float4 v[NU][4]; uint2 xw[NU][4], sw[NU][4]; float4 g2[NU][4];
#pragma unroll
        for (int u = 0; u < NU; ++u)
#pragma unroll
            for (int i = 0; i < 4; ++i) {
                const size_t o = (size_t)tk[u] * D + i * 256 + lane * 4;
                if (SRC_BF16) xw[u][i] = *(const uint2*)((const bf16_t*)xsrc_ + o); else v[u][i] = *(const float4*)((const float*)xsrc_ + o);
                if (ADD) { sw[u][i] = *(const uint2*)(sadd + o); g2[u][i] = *(const float4*)(g2l + (size_t)(tk[u] / SEQ) * 6144 + i * 256 + lane * 4); }
            }
        float ss[NU];
#pragma unroll
        for (int u = 0; u < NU; ++u) { ss[u] = 0.f;
#pragma unroll
            for (int i = 0; i < 4; ++i) {
                if (SRC_BF16) v[u][i] = make_float4(bf2f(xw[u][i].x & 0xffffu), bf2f(xw[u][i].x >> 16), bf2f(xw[u][i].y & 0xffffu), bf2f(xw[u][i].y >> 16));
                if (ADD) { const uint2 s_ = sw[u][i]; const float4 g_ = g2[u][i];
                    const unsigned r0 = pk_bf16(v[u][i].x + g_.x * bf2f(s_.x & 0xffffu), v[u][i].y + g_.y * bf2f(s_.x >> 16)), r1 = pk_bf16(v[u][i].z + g_.z * bf2f(s_.y & 0xffffu), v[u][i].w + g_.w * bf2f(s_.y >> 16));
                    if (ok[u]) *(uint2*)((bf16_t*)xsrc_ + (size_t)tk[u] * D + i * 256 + lane * 4) = make_uint2(r0, r1);
                    v[u][i] = make_float4(bf2f(r0 & 0xffffu), bf2f(r0 >> 16), bf2f(r1 & 0xffffu), bf2f(r1 >> 16)); }
                if (!SRC_BF16 && xcopy != nullptr && ok[u]) *(uint2*)(xcopy + (size_t)tk[u] * D + i * 256 + lane * 4) = make_uint2(pk_bf16(v[u][i].x, v[u][i].y), pk_bf16(v[u][i].z, v[u][i].w));
                ss[u] += v[u][i].x * v[u][i].x + v[u][i].y * v[u][i].y + v[u][i].z * v[u][i].z + v[u][i].w * v[u][i].w;
            }
        }
#pragma unroll
        for (int u = 0; u < NU; ++u) {
            const float rstd = rsqrtf(wave_sum(ss[u]) * (1.0f / D) + EPS);
            const float* mb = modl + (size_t)(tk[u] / SEQ) * 6144;
#pragma unroll
            for (int i = 0; i < 4; ++i) {
                const int cidx = i * 256 + lane * 4;
                const float4 gg = *(const float4*)(g + cidx), sh = *(const float4*)(mb + sh_off + cidx), sc = *(const float4*)(mb + scl_off + cidx);
                const float o0 = v[u][i].x * rstd * gg.x * (1.0f + sc.x) + sh.x, o1 = v[u][i].y * rstd * gg.y * (1.0f + sc.y) + sh.y;
                const float o2 = v[u][i].z * rstd * gg.z * (1.0f + sc.z) + sh.z, o3 = v[u][i].w * rstd * gg.w * (1.0f + sc.w) + sh.w;
                if (ok[u]) *(uint2*)(hout + (size_t)tk[u] * D + cidx) = make_uint2(pk_bf16(o0, o1), pk_bf16(o2, o3));
            }
        }
    }
}

template <bool ADD>
__device__ void phase_norm16(bf16_t* xsrc, const float* __restrict__ g, const float* __restrict__ modl  , int sh_off, int scl_off,
                             bf16_t* __restrict__ hout, int bid, int nb, const bf16_t* __restrict__ sadd = nullptr, const float* __restrict__ g2l = nullptr) {
    const int tid_ = otid(); const int lane = tid_ & 63, wid = tid_ >> 6;
    constexpr int NU = 2;
    for (int tok0 = bid * 4 + wid; tok0 < T; tok0 += nb * 4 * NU) {
        int tk[NU]; bool ok[NU];
#pragma unroll
        for (int u = 0; u < NU; ++u) { ok[u] = tok0 + u * nb * 4 < T; tk[u] = ok[u] ? tok0 + u * nb * 4 : tok0; }
        uint4 xw[NU][2], sw[NU][2]; float4 g2[NU][2][2];
#pragma unroll
        for (int u = 0; u < NU; ++u)
#pragma unroll
            for (int i = 0; i < 2; ++i) {
                const size_t o = (size_t)tk[u] * D + i * 512 + lane * 8;
                xw[u][i] = *(const uint4*)(xsrc + o);
                if (ADD) { sw[u][i] = *(const uint4*)(sadd + o); const float* gp = g2l + (size_t)(tk[u] / SEQ) * 6144 + i * 512 + lane * 8; g2[u][i][0] = *(const float4*)gp; g2[u][i][1] = *(const float4*)(gp + 4); }
            }
        float v[NU][2][8], ss[NU];
#pragma unroll
        for (int u = 0; u < NU; ++u) { ss[u] = 0.f;
#pragma unroll
            for (int i = 0; i < 2; ++i) {
                const unsigned w[4] = {xw[u][i].x, xw[u][i].y, xw[u][i].z, xw[u][i].w};
#pragma unroll
                for (int k = 0; k < 4; ++k) { v[u][i][2 * k] = bf2f(w[k] & 0xffffu); v[u][i][2 * k + 1] = bf2f(w[k] >> 16); }
                if (ADD) {
                    const unsigned s_[4] = {sw[u][i].x, sw[u][i].y, sw[u][i].z, sw[u][i].w};
                    const float gg[8] = {g2[u][i][0].x, g2[u][i][0].y, g2[u][i][0].z, g2[u][i][0].w, g2[u][i][1].x, g2[u][i][1].y, g2[u][i][1].z, g2[u][i][1].w};
                    unsigned r[4];
#pragma unroll
                    for (int k = 0; k < 4; ++k) { r[k] = pk_bf16(v[u][i][2 * k] + gg[2 * k] * bf2f(s_[k] & 0xffffu), v[u][i][2 * k + 1] + gg[2 * k + 1] * bf2f(s_[k] >> 16));
                        v[u][i][2 * k] = bf2f(r[k] & 0xffffu); v[u][i][2 * k + 1] = bf2f(r[k] >> 16); }
                    if (ok[u]) *(uint4*)(xsrc + (size_t)tk[u] * D + i * 512 + lane * 8) = make_uint4(r[0], r[1], r[2], r[3]);
                }
#pragma unroll
                for (int k = 0; k < 8; ++k) ss[u] += v[u][i][k] * v[u][i][k];
            }
        }
#pragma unroll
        for (int u = 0; u < NU; ++u) {
            const float rstd = rsqrtf(wave_sum(ss[u]) * (1.0f / D) + EPS);
            const float* mb = modl + (size_t)(tk[u] / SEQ) * 6144;
#pragma unroll
            for (int i = 0; i < 2; ++i) {
                const int cidx = i * 512 + lane * 8;
                unsigned o[4];
#pragma unroll
                for (int hk = 0; hk < 2; ++hk) {
                    const float4 gg = *(const float4*)(g + cidx + 4 * hk), sh = *(const float4*)(mb + sh_off + cidx + 4 * hk), sc = *(const float4*)(mb + scl_off + cidx + 4 * hk);
                    o[2 * hk]     = pk_bf16(v[u][i][4 * hk] * rstd * gg.x * (1.0f + sc.x) + sh.x, v[u][i][4 * hk + 1] * rstd * gg.y * (1.0f + sc.y) + sh.y);
                    o[2 * hk + 1] = pk_bf16(v[u][i][4 * hk + 2] * rstd * gg.z * (1.0f + sc.z) + sh.z, v[u][i][4 * hk + 3] * rstd * gg.w * (1.0f + sc.w) + sh.w);
                }
                if (ok[u]) *(uint4*)(hout + (size_t)tk[u] * D + cidx) = make_uint4(o[0], o[1], o[2], o[3]);
            }
        }
    }
}

namespace pg8 {
#define PG8_LAS __attribute__((address_space(3)))
typedef unsigned short bf16_t;
typedef short bf16x8 __attribute__((ext_vector_type(8)));
typedef float f32x4 __attribute__((ext_vector_type(4)));
typedef unsigned u32x4 __attribute__((ext_vector_type(4)));
constexpr int BM = 256, BK = 64, HALF = 128, HTB = HALF * BK * 2  , STAGE_BYTES = 8 * HTB, NXCD = 8, WGM = 4;

__host__ __device__ __forceinline__ int lds_byte(int r, int c) { const int st = (r >> 4) * 2 + (c >> 5), rr = r & 15, cc = c & 31, ob = rr * 64 + cc * 2; return st * 1024 + (ob ^ (((ob >> 9) & 1) << 5)); }
__host__ __device__ __forceinline__ void stage_rc(int b, int& R, int& C) { const int st = b / 1024, sb = b % 1024, swz = sb ^ (((sb >> 9) & 1) << 5); R = (st >> 1) * 16 + swz / 64; C = (st & 1) * 32 + (swz % 64) / 2; }
__host__ __device__ __forceinline__ int perm32(int rho) { const int n = rho >> 4, i = rho & 15; return 8 * (i >> 2) + 4 * n + (i & 3); }

struct Unit { int pm, pn; };
struct Gemm { const bf16_t* A; const bf16_t* Bt; int M, N, K; };

struct StaticOrder {
    int nM, nN, nwg, G, c;
    __host__ __device__ void init(int M, int N, int G_, int c_) { nM = M / BM; nN = N / BM; nwg = nM * nN; G = G_; c = c_; }
    __host__ __device__ bool next(int i, Unit& u) const {
        const long L = (long)i * G + c; if (L >= nwg) return false;
        int wgid = (int)L; { const int q = nwg / NXCD, r = nwg % NXCD, xcd = wgid % NXCD, off = wgid / NXCD; wgid = (xcd < r ? xcd * (q + 1) : r * (q + 1) + (xcd - r) * q) + off; }
        const int nig = WGM * nN, gid = wgid / nig, fm = gid * WGM, gsz = (nM - fm) < WGM ? (nM - fm) : WGM;
        u.pm = fm + ((wgid % nig) % gsz); u.pn = (wgid % nig) / gsz; return true;
    }
    __device__ __forceinline__ void a_ready(const Unit&) const {}
    __device__ __forceinline__ void done(const Unit&) const {}
};

template <class Epi, class Sched, class MidK, bool STAMP = false>
__device__ __forceinline__ void gemm_phase(PG8_LAS unsigned char* lds, const Gemm g, const Sched& S, const Epi& E, const MidK& MK, int midt, unsigned long long* stamps) {
    int tid_ = threadIdx.x; asm volatile("" : "+v"(tid_));
    const int tid = tid_, wid = __builtin_amdgcn_readfirstlane(tid >> 6), lane = tid & 63, wr = wid >> 2, wc = wid & 3, fr = lane & 15, fq = lane >> 4;
    const int K = g.K, nt = K / BK;
    int ts_lo = 0, ts_hi = 0, nts = 0; const unsigned long long rt_entry = STAMP ? (unsigned long long)wall_clock64() : 0ull;
#define PG8_STAMP() do { if (STAMP && wid == 0 && nts < 64) { const unsigned long long _c = (unsigned long long)clock64(); \
        ts_lo = (lane == nts) ? (int)(unsigned)_c : ts_lo; ts_hi = (lane == nts) ? (int)(unsigned)(_c >> 32) : ts_hi; ++nts; } } while (0)
    PG8_STAMP();
    unsigned voffA[2], voffB[2];
#pragma unroll
    for (int i = 0; i < 2; ++i) { int R, C; stage_rc(tid * 16 + i * 8192, R, C); const int Rb = Epi::PERM ? ((R & ~31) + perm32(R & 31)) : R;
        voffA[i] = (unsigned)(R * K + C) * 2u; voffB[i] = (unsigned)(Rb * K + C) * 2u; }
    const size_t kstep = (size_t)(BK * 2);
    const size_t hstep = (size_t)HALF * K * 2;
    const size_t tstep = 2 * hstep;
    const unsigned ldsw = (unsigned)wid * 1024u;
    const int aoff = lds_byte(wr * 64 + fr, fq * 8), boff = lds_byte(wc * 32 + fr, fq * 8);
#define PG8_SA(b, h) (((b) * 2 + (h)) * HTB)
#define PG8_SB(b, h) ((4 + (b) * 2 + (h)) * HTB)
#define PG8_STAGE(bufoff, gbase, voff) do { _Pragma("unroll") for (int _i = 0; _i < 2; ++_i) \
        __builtin_amdgcn_global_load_lds((const unsigned*)((const char*)(gbase) + (voff)[_i]), (PG8_LAS unsigned*)(lds + (bufoff) + ldsw + _i * 8192), 16, 0, 0); } while (0)
#define PG8_LDA(dst, b, h) do { _Pragma("unroll") for (int m = 0; m < 4; ++m) _Pragma("unroll") for (int k = 0; k < 2; ++k) dst[m][k] = *(const PG8_LAS bf16x8*)(lds + PG8_SA(b, h) + aoff + m * 2048 + k * 1024); } while (0)
#define PG8_LDB(dst, b, h) do { _Pragma("unroll") for (int n = 0; n < 2; ++n) _Pragma("unroll") for (int k = 0; k < 2; ++k) dst[n][k] = *(const PG8_LAS bf16x8*)(lds + PG8_SB(b, h) + boff + n * 2048 + k * 1024); } while (0)
#define PG8_MMA(ai, bj, At, Bt) do { __builtin_amdgcn_s_setprio(1); _Pragma("unroll") for (int m = 0; m < 4; ++m) _Pragma("unroll") for (int n = 0; n < 2; ++n) _Pragma("unroll") for (int k = 0; k < 2; ++k) \
        acc[ai][bj][m][n] = __builtin_amdgcn_mfma_f32_16x16x32_bf16(Bt[n][k], At[m][k], acc[ai][bj][m][n], 0, 0, 0); __builtin_amdgcn_s_setprio(0); } while (0)
#define PG8_WAIT_V(n) asm volatile("s_waitcnt vmcnt(" #n ")" ::: "memory")
#define PG8_WAIT_L(n) asm volatile("s_waitcnt lgkmcnt(" #n ")" ::: "memory")
#define PG8_BAR __builtin_amdgcn_s_barrier()
#define PG8_SCHED __builtin_amdgcn_sched_barrier(0)
    Unit cur, nxt; int ui = 0;
    if (!S.next(0, cur)) return;
    f32x4 acc[2][2][4][2];
#pragma unroll
    for (int a = 0; a < 2; ++a)
#pragma unroll
        for (int b = 0; b < 2; ++b)
#pragma unroll
            for (int m = 0; m < 4; ++m)
#pragma unroll
                for (int n = 0; n < 2; ++n) acc[a][b][m][n] = (f32x4){0.f, 0.f, 0.f, 0.f};
    bf16x8 At[4][2], B0[2][2], B1[2][2];
    const char* cA = (const char*)g.A + (size_t)cur.pm * tstep; const char* cB = (const char*)g.Bt + (size_t)cur.pn * tstep;
    S.a_ready(cur);
    PG8_STAGE(PG8_SB(0, 0), cB, voffB); PG8_STAGE(PG8_SA(0, 0), cA, voffA); PG8_STAGE(PG8_SB(0, 1), cB + hstep, voffB); PG8_STAGE(PG8_SA(0, 1), cA + hstep, voffA);
    if (wr == 1) PG8_BAR;
    PG8_WAIT_V(4); PG8_BAR;
    PG8_STAGE(PG8_SB(1, 0), cB + kstep, voffB); PG8_STAGE(PG8_SA(1, 0), cA + kstep, voffA); PG8_STAGE(PG8_SB(1, 1), cB + hstep + kstep, voffB);
    PG8_WAIT_V(6); PG8_BAR;
    PG8_STAMP();
    for (;;) {
        const bool has_next = S.next(ui + 1, nxt);
        const char* nA = has_next ? (const char*)g.A + (size_t)nxt.pm * tstep : cA; const char* nB = has_next ? (const char*)g.Bt + (size_t)nxt.pn * tstep : cB;
        for (int t = 0; t < nt; t += 2) {
            const bool last = (t == nt - 2);
            if (t == midt) {
#pragma unroll
                for (int ai = 0; ai < 2; ++ai)
#pragma unroll
                    for (int m = 0; m < 4; ++m) { const float s_ = MK(ui, ai * HALF + wr * 64 + m * 16 + fr);
#pragma unroll
                        for (int bj = 0; bj < 2; ++bj)
#pragma unroll
                            for (int n = 0; n < 2; ++n) acc[ai][bj][m][n] *= s_;
                        __builtin_amdgcn_sched_barrier(0); }
            }
            const char* a1 = cA + (size_t)(t + 1) * kstep;
            const char* a2 = last ? nA : cA + (size_t)(t + 2) * kstep; const char* b2 = last ? nB : cB + (size_t)(t + 2) * kstep;
            const char* a3 = a2 + kstep; const char* b3 = b2 + kstep;
            if (last && has_next) S.a_ready(nxt);
            PG8_LDB(B0, 0, 0); PG8_SCHED; PG8_LDA(At, 0, 0); PG8_STAGE(PG8_SA(1, 1), a1 + hstep, voffA);
            PG8_WAIT_L(8); PG8_BAR; PG8_WAIT_L(0); PG8_MMA(0, 0, At, B0); PG8_BAR; PG8_SCHED;
            PG8_LDB(B1, 0, 1); PG8_STAGE(PG8_SB(0, 0), b2, voffB);
            PG8_BAR; PG8_WAIT_L(0); PG8_MMA(0, 1, At, B1); PG8_BAR;
            PG8_LDA(At, 0, 1); PG8_STAGE(PG8_SA(0, 0), a2, voffA);
            PG8_BAR; PG8_WAIT_L(0); PG8_MMA(1, 0, At, B0); PG8_BAR; PG8_SCHED;
            PG8_STAGE(PG8_SB(0, 1), b2 + hstep, voffB);
            PG8_WAIT_V(6); PG8_BAR; PG8_MMA(1, 1, At, B1); PG8_BAR;
            PG8_LDB(B0, 1, 0); PG8_SCHED; PG8_LDA(At, 1, 0); PG8_STAGE(PG8_SA(0, 1), a2 + hstep, voffA);
            PG8_WAIT_L(8); PG8_BAR; PG8_WAIT_L(0); PG8_MMA(0, 0, At, B0); PG8_BAR; PG8_SCHED;
            PG8_LDB(B1, 1, 1); PG8_STAGE(PG8_SB(1, 0), b3, voffB);
            PG8_BAR; PG8_WAIT_L(0); PG8_MMA(0, 1, At, B1); PG8_BAR;
            PG8_LDA(At, 1, 1); PG8_STAGE(PG8_SA(1, 0), a3, voffA);
            PG8_BAR; PG8_WAIT_L(0); PG8_MMA(1, 0, At, B0); PG8_BAR; PG8_SCHED;
            PG8_STAGE(PG8_SB(1, 1), b3 + hstep, voffB);
            PG8_WAIT_V(6); PG8_BAR; PG8_MMA(1, 1, At, B1); PG8_BAR;
        }
        PG8_STAMP();
        if constexpr (!Epi::AFTER_DRAIN) { E(acc, cur, wr, wc, fr, fq, ui); S.done(cur); }
        PG8_STAMP();
        if (!has_next) break;
#pragma unroll
        for (int a = 0; a < 2; ++a)
#pragma unroll
            for (int b = 0; b < 2; ++b)
#pragma unroll
                for (int m = 0; m < 4; ++m)
#pragma unroll
                    for (int n = 0; n < 2; ++n) acc[a][b][m][n] = (f32x4){0.f, 0.f, 0.f, 0.f};
        cur = nxt; cA = nA; cB = nB; ++ui;
    }
    PG8_WAIT_V(0);
    if (wr == 0) PG8_BAR;
    PG8_BAR;
    if constexpr (Epi::AFTER_DRAIN) { E.fused(acc, cur, wr, wc, fr, fq, lds, wid, lane); S.done(cur); }
    PG8_STAMP();
    if (STAMP && wid == 0) { stamps[lane] = lane < nts ? (((unsigned long long)(unsigned)ts_hi << 32) | (unsigned)ts_lo) : 0ull;
        if (lane == 62) stamps[62] = rt_entry; if (lane == 63) stamps[63] = (unsigned long long)wall_clock64(); }
#undef PG8_STAMP
#undef PG8_SA
#undef PG8_SB
#undef PG8_STAGE
#undef PG8_LDA
#undef PG8_LDB
#undef PG8_MMA
#undef PG8_WAIT_V
#undef PG8_WAIT_L
#undef PG8_BAR
#undef PG8_SCHED
}
}

struct NoMid { __device__ __forceinline__ float operator()(int, int) const { return 1.0f; } };
#define LAS __attribute__((address_space(3)))
struct EpiZ {
    static constexpr bool PERM = true, AFTER_DRAIN = false;
    bf16_t* Z;
    __device__ __forceinline__ void operator()(const f32x4 (&acc)[2][2][4][2], const pg8::Unit& u, int wr, int wc, int fr, int fq, int) const {
        const int row0 = u.pm * 256 + wr * 64 + fr, col0 = u.pn * 256 + wc * 32 + 8 * fq; const bool act = u.pn < 4;
#pragma unroll
        for (int ai = 0; ai < 2; ++ai)
#pragma unroll
            for (int m = 0; m < 4; ++m) { bf16_t* rowp = Z + (size_t)(row0 + ai * 128 + m * 16) * NZ + col0;
#pragma unroll
                for (int bj = 0; bj < 2; ++bj) { f32x4 a = acc[ai][bj][m][0], b = acc[ai][bj][m][1];
                    if (act) { a = (f32x4){gelu_f(a[0]), gelu_f(a[1]), gelu_f(a[2]), gelu_f(a[3])}; b = (f32x4){gelu_f(b[0]), gelu_f(b[1]), gelu_f(b[2]), gelu_f(b[3])}; }
                    *(uint4*)(rowp + bj * 128) = make_uint4(pk_bf16(a[0], a[1]), pk_bf16(a[2], a[3]), pk_bf16(b[0], b[1]), pk_bf16(b[2], b[3])); }
                __builtin_amdgcn_sched_barrier(0); }
    }
};
struct EpiQ {
    static constexpr bool PERM = true, AFTER_DRAIN = false;
    bf16_t* Q;
    __device__ __forceinline__ void operator()(const f32x4 (&acc)[2][2][4][2], const pg8::Unit& u, int wr, int wc, int fr, int fq, int) const {
        const int row0 = u.pm * 256 + wr * 64 + fr, col0 = u.pn * 256 + wc * 32 + 8 * fq;
#pragma unroll
        for (int ai = 0; ai < 2; ++ai)
#pragma unroll
            for (int m = 0; m < 4; ++m) { bf16_t* rowp = Q + (size_t)(row0 + ai * 128 + m * 16) * 2048 + col0;
#pragma unroll
                for (int bj = 0; bj < 2; ++bj) { const f32x4 a = acc[ai][bj][m][0], b = acc[ai][bj][m][1];
                    *(uint4*)(rowp + bj * 128) = make_uint4(pk_bf16(a[0], a[1]), pk_bf16(a[2], a[3]), pk_bf16(b[0], b[1]), pk_bf16(b[2], b[3])); } }
    }
};
__device__ __forceinline__ float rstd512(const float* s, int row) {
    const float4 a = *(const float4*)(s + (size_t)row * 8), b = *(const float4*)(s + (size_t)row * 8 + 4);
    return rsqrtf(((a.x + a.y) + (a.z + a.w) + (b.x + b.y) + (b.z + b.w)) * (1.0f / 512.0f) + EPS);
}
struct MidY { const LAS float* tab; __device__ __forceinline__ float operator()(int ui, int r) const { return tab[(2 * ui) * 256 + r]; } };
struct EpiX {
    static constexpr bool PERM = true, AFTER_DRAIN = false;
    bf16_t* XR; const LAS float* tab; const float* gate;
    __device__ __forceinline__ void operator()(const f32x4 (&acc)[2][2][4][2], const pg8::Unit& u, int wr, int wc, int fr, int fq, int ui) const {
        const int r0 = wr * 64 + fr, row0 = u.pm * 256 + r0, col0 = u.pn * 256 + wc * 32 + 8 * fq;
        const float* gp = gate + (size_t)((u.pm * 256) / SEQ) * 6144 + col0;
        bf16_t* xp = XR + (size_t)row0 * D + col0;
        float4 g[2][2];
#pragma unroll
        for (int bj = 0; bj < 2; ++bj) { g[bj][0] = *(const float4*)(gp + bj * 128); g[bj][1] = *(const float4*)(gp + bj * 128 + 4); }
#pragma unroll
        for (int ai = 0; ai < 2; ++ai) {
            uint4 xw[4][2];
#pragma unroll
            for (int m = 0; m < 4; ++m)
#pragma unroll
                for (int bj = 0; bj < 2; ++bj) xw[m][bj] = *(const uint4*)(xp + (size_t)(ai * 128 + m * 16) * D + bj * 128);
            __builtin_amdgcn_sched_barrier(0);
#pragma unroll
            for (int m = 0; m < 4; ++m) { const float rb = tab[(2 * ui + 1) * 256 + r0 + ai * 128 + m * 16];
#pragma unroll
                for (int bj = 0; bj < 2; ++bj) { const f32x4 a = acc[ai][bj][m][0], b = acc[ai][bj][m][1]; const uint4 w = xw[m][bj]; const float4 g0 = g[bj][0], g1 = g[bj][1];
                    *(uint4*)(xp + (size_t)(ai * 128 + m * 16) * D + bj * 128) =
                        make_uint4(pk_bf16(bf2f(w.x & 0xffffu) + g0.x * rb * a[0], bf2f(w.x >> 16) + g0.y * rb * a[1]), pk_bf16(bf2f(w.y & 0xffffu) + g0.z * rb * a[2], bf2f(w.y >> 16) + g0.w * rb * a[3]),
                                   pk_bf16(bf2f(w.z & 0xffffu) + g1.x * rb * b[0], bf2f(w.z >> 16) + g1.y * rb * b[1]), pk_bf16(bf2f(w.w & 0xffffu) + g1.z * rb * b[2], bf2f(w.w >> 16) + g1.w * rb * b[3])); }
                __builtin_amdgcn_sched_barrier(0); }
        }
    }
};
__device__ void phase_gemm1(const Params& p, int l, char* smem512) {
    pg8::Gemm g; g.A = (const pg8::bf16_t*)(p.ws + OFF_H); g.Bt = (const pg8::bf16_t*)(p.ws + OFF_W1T) + (size_t)l * 2048 * 1024; g.M = T; g.N = NZ; g.K = D;
    int G_ = (int)gridDim.x, c_ = (int)blockIdx.x; asm volatile("" : "+s"(G_), "+s"(c_));
    pg8::StaticOrder S; S.init(T, NZ, G_, c_);
    EpiZ E; E.Z = (bf16_t*)(p.ws + OFF_Z);
    pg8::gemm_phase<EpiZ, pg8::StaticOrder, NoMid>((PG8_LAS unsigned char*)smem512, g, S, E, NoMid(), -1, nullptr);
}
__device__ void phase_gemm2(const Params& p, int l, char* smem512) {
    pg8::Gemm g; g.A = (const pg8::bf16_t*)(p.ws + OFF_Y); g.Bt = (const pg8::bf16_t*)(p.ws + OFF_W2T) + (size_t)l * 1024 * 1024; g.M = T; g.N = D; g.K = D;
    int G_ = (int)gridDim.x, c_ = (int)blockIdx.x; asm volatile("" : "+s"(G_), "+s"(c_));
    pg8::StaticOrder S; S.init(T, D, G_, c_);
    LAS float* tab = (LAS float*)((LAS char*)smem512 + pg8::STAGE_BYTES);
    {
        const float* ssa = (const float*)(p.ws + OFF_SSQA); const float* ssb = (const float*)(p.ws + OFF_SSQB);
        pg8::Unit u;
        int t0_ = threadIdx.x; asm volatile("" : "+v"(t0_));
#pragma nounroll
        for (int i = 0; i < 8 && S.next(i, u); ++i)
            for (int r = t0_; r < 256; r += 512) { const float ra = rstd512(ssa, u.pm * 256 + r), rb = rstd512(ssb, u.pm * 256 + r); tab[(2 * i) * 256 + r] = ra / rb; tab[(2 * i + 1) * 256 + r] = rb; }
        __syncthreads();
    }
    MidY MK; MK.tab = tab;
    EpiX E; E.XR = (bf16_t*)(p.ws + OFF_XR); E.tab = tab; E.gate = (const float*)(p.ws + OFF_MOD) + (size_t)l * NB * 6144 + 2 * D;
    pg8::gemm_phase<EpiX, pg8::StaticOrder, MidY>((PG8_LAS unsigned char*)smem512, g, S, E, MK, 8, nullptr);
}
__device__ void phase_gemm3(const Params& p, int l, char* smem512) {
    pg8::Gemm g; g.A = (const pg8::bf16_t*)(p.ws + OFF_H); g.Bt = (const pg8::bf16_t*)(p.ws + OFF_WQT) + (size_t)l * 2048 * 1024; g.M = T; g.N = 2048; g.K = D;
    int G_ = (int)gridDim.x, c_ = (int)blockIdx.x; asm volatile("" : "+s"(G_), "+s"(c_));
    pg8::StaticOrder S; S.init(T, 2048, G_, c_);
    EpiQ E; E.Q = (bf16_t*)(p.ws + OFF_Z);
    pg8::gemm_phase<EpiQ, pg8::StaticOrder, NoMid>((PG8_LAS unsigned char*)smem512, g, S, E, NoMid(), -1, nullptr);
}

constexpr int TP = 136;
__device__ __forceinline__ void st_load(const bf16_t* __restrict__ base, size_t row_stride, uint4 (&v)[4]) {
    const int tid = otid(), r = tid >> 2, part = tid & 3, ri = part >> 1, c0 = (part & 1) * 32;
    const uint4* src = (const uint4*)(base + (size_t)r * row_stride + ri * 64 + c0);
#pragma unroll
    for (int i = 0; i < 4; ++i) v[i] = src[i];
}
__device__ __forceinline__ void st_store(const uint4 (&v)[4], bf16_t* dT) {
    const int tid = otid(), r = tid >> 2, part = tid & 3, ri = part >> 1, c0 = (part & 1) * 32;
#pragma unroll
    for (int i = 0; i < 4; ++i) {
        const unsigned w[4] = {v[i].x, v[i].y, v[i].z, v[i].w};
#pragma unroll
        for (int j = 0; j < 4; ++j) {
            dT[(c0 + i * 8 + j * 2) * TP + ri * 64 + r] = (bf16_t)(w[j] & 0xffffu);
            dT[(c0 + i * 8 + j * 2 + 1) * TP + ri * 64 + r] = (bf16_t)(w[j] >> 16);
        }
    }
}

__device__ __forceinline__ uint4 widen_pair(uint2 a, uint2 b) {
    const auto rx = __builtin_amdgcn_permlane16_swap(a.x, b.x, false, false); const auto ry = __builtin_amdgcn_permlane16_swap(a.y, b.y, false, false);
    return make_uint4(rx[0], ry[0], rx[1], ry[1]);
}
__device__ void phase_mix_gmlp(const Params& p, int l, char* smem, int bid, int nb) {
    const int tid = otid(), lane = tid & 63, wid = tid >> 6, fr = lane & 15, fq = lane >> 4;
    const bf16_t* Z = (const bf16_t*)(p.ws + OFF_Z);
    bf16_t* Y = (bf16_t*)(p.ws + OFF_Y);
    float* ssa = (float*)(p.ws + OFF_SSQA);
    const int q = tid >> 1, half = tid & 1, d0 = half * 32, p0 = wid * 32;
    const int nrd = (2048 + nb - 1) / nb;
    uint4 zn[4];
    { const int item = min(bid, 2047); const int h = item & 7, c = (item >> 3) & 31, b = item >> 8;
      const uint4* src = (const uint4*)(Z + (size_t)(b * SEQ + c * 128 + q) * NZ + 512 + h * 64 + d0);
#pragma unroll
      for (int i = 0; i < 4; ++i) zn[i] = src[i]; }
    for (int rd_ = 0; rd_ < nrd; ++rd_) {
        const int item = min(bid + rd_ * nb, 2047);
        const int h = item & 7, c = (item >> 3) & 31, b = item >> 8, tok0 = b * SEQ + c * 128;
        bf16_t* vnT = (bf16_t*)(smem + (rd_ & 1) * (64 * TP * 2));
        const bf16_t* Wsb = (const bf16_t*)(p.ws + OFF_WSB) + ((size_t)l * 8 + h) * 128 * 128;
        bf16x8 af[4][2];
#pragma unroll
        for (int ks = 0; ks < 4; ++ks)
#pragma unroll
            for (int i = 0; i < 2; ++i) af[ks][i] = *(const bf16x8*)(Wsb + (size_t)(p0 + i * 16 + fr) * 128 + ks * 32 + fq * 8);
        uint2 uu[2][4]; float bsv[2];
#pragma unroll
        for (int i = 0; i < 2; ++i) { const int pp = p0 + i * 16 + fr; bsv[i] = p.gmlp_bs[((size_t)l * 8 + h) * 128 + pp];
#pragma unroll
            for (int j = 0; j < 4; ++j) uu[i][j] = *(const uint2*)(Z + (size_t)(tok0 + pp) * NZ + h * 64 + j * 16 + fq * 4); }
        {
            float f[32];
#pragma unroll
            for (int i = 0; i < 4; ++i) { const uint4 v = zn[i]; const unsigned w[4] = {v.x, v.y, v.z, v.w};
#pragma unroll
                for (int j = 0; j < 4; ++j) { f[i * 8 + j * 2] = bf2f(w[j] & 0xffffu); f[i * 8 + j * 2 + 1] = bf2f(w[j] >> 16); } }
            float s_ = 0.f;
#pragma unroll
            for (int i = 0; i < 32; ++i) s_ += f[i];
            s_ += __shfl_xor(s_, 1);
            const float mean = s_ * (1.0f / 64.0f);
            float qv = 0.f;
#pragma unroll
            for (int i = 0; i < 32; ++i) { f[i] -= mean; qv += f[i] * f[i]; }
            qv += __shfl_xor(qv, 1);
            const float rstd = rsqrtf(qv * (1.0f / 64.0f) + EPS);
#pragma unroll
            for (int i = 0; i < 32; ++i) vnT[(d0 + i) * TP + q] = f2bf(f[i] * rstd);
        }
        {
            const int itn = min(bid + (rd_ + 1) * nb, 2047); const int hn = itn & 7, cn = (itn >> 3) & 31, bn = itn >> 8;
            const uint4* src = (const uint4*)(Z + (size_t)(bn * SEQ + cn * 128 + q) * NZ + 512 + hn * 64 + d0);
#pragma unroll
            for (int i = 0; i < 4; ++i) zn[i] = src[i];
        }
        __syncthreads();
        f32x4 acc[2][4];
#pragma unroll
        for (int i = 0; i < 2; ++i)
#pragma unroll
            for (int j = 0; j < 4; ++j) acc[i][j] = (f32x4){0.f, 0.f, 0.f, 0.f};
#pragma unroll
        for (int ks = 0; ks < 4; ++ks) {
            bf16x8 bfr[4];
#pragma unroll
            for (int j = 0; j < 4; ++j) bfr[j] = *(const bf16x8*)(vnT + (j * 16 + fr) * TP + ks * 32 + fq * 8);
#pragma unroll
            for (int i = 0; i < 2; ++i)
#pragma unroll
                for (int j = 0; j < 4; ++j) acc[i][j] = MFMA16(bfr[j], af[ks][i], acc[i][j]);
        }
#pragma unroll
        for (int i = 0; i < 2; ++i) {
            const int pp = p0 + i * 16 + fr, tok = tok0 + pp;
            float ss = 0.f;
            uint2 pk[4];
#pragma unroll
            for (int j = 0; j < 4; ++j) {
                const float y0 = bf2f(uu[i][j].x & 0xffffu) * (acc[i][j][0] + bsv[i]), y1 = bf2f(uu[i][j].x >> 16) * (acc[i][j][1] + bsv[i]);
                const float y2 = bf2f(uu[i][j].y & 0xffffu) * (acc[i][j][2] + bsv[i]), y3 = bf2f(uu[i][j].y >> 16) * (acc[i][j][3] + bsv[i]);
                ss += y0 * y0 + y1 * y1 + y2 * y2 + y3 * y3;
                pk[j] = make_uint2(pk_bf16(y0, y1), pk_bf16(y2, y3));
            }
#pragma unroll
            for (int j = 0; j < 4; j += 2)
                *(uint4*)(Y + (size_t)tok * D + h * 64 + ((fq & 1) ? (j + 1) * 16 + (fq - 1) * 4 : j * 16 + fq * 4)) = widen_pair(pk[j], pk[j + 1]);
            ss += __shfl_xor(ss, 16); ss += __shfl_xor(ss, 32);
            if (fq == 0) ssa[(size_t)tok * 8 + h] = ss;
        }
    }
}

__device__ void phase_mix_ffta(const Params& p, char* smem, int bid, int nb) {
    const int tid = otid(), lane = tid & 63, wid = tid >> 6, fr = lane & 15, fq = lane >> 4;
    const bf16_t* Z = (const bf16_t*)(p.ws + OFF_Z);
    const bf16_t* DA = (const bf16_t*)(p.ws + OFF_DA);
    bf16x8 af[4][2];
#pragma unroll
    for (int ks = 0; ks < 4; ++ks)
#pragma unroll
        for (int i = 0; i < 2; ++i) af[ks][i] = *(const bf16x8*)(DA + (size_t)(i * 64 + wid * 16 + fr) * 128 + ks * 32 + fq * 8);
    const int nrd = (4096 + nb - 1) / nb;
    uint4 vn[4];
    { const int item = min(bid, 4095); const int bp = item & 63, g = (item >> 6) & 7, b = item >> 9;
      st_load(Z + (size_t)(b * SEQ + bp) * NZ + 1024 + g * 128, (size_t)64 * NZ, vn); }
    for (int rd_ = 0; rd_ < nrd; ++rd_) {
        const int item = min(bid + rd_ * nb, 4095);
        const int bp = item & 63, g = (item >> 6) & 7, b = item >> 9;
        const int k1 = wid * 16 + fr;
        bf16_t* dT = (bf16_t*)(smem + (rd_ & 1) * (64 * TP * 2));
        const float2 cs = ((const float2*)(p.ws + OFF_TW))[bp * 64 + k1];
        st_store(vn, dT);
        { const int itn = min(bid + (rd_ + 1) * nb, 4095); const int bpn = itn & 63, gn = (itn >> 6) & 7, bn = itn >> 9;
          st_load(Z + (size_t)(bn * SEQ + bpn) * NZ + 1024 + gn * 128, (size_t)64 * NZ, vn); }
        __syncthreads();
        f32x4 acc[2][4];
#pragma unroll
        for (int i = 0; i < 2; ++i)
#pragma unroll
            for (int j = 0; j < 4; ++j) acc[i][j] = (f32x4){0.f, 0.f, 0.f, 0.f};
#pragma unroll
        for (int ks = 0; ks < 4; ++ks) {
            bf16x8 bfr[4];
#pragma unroll
            for (int j = 0; j < 4; ++j) bfr[j] = *(const bf16x8*)(dT + (j * 16 + fr) * TP + ks * 32 + fq * 8);
#pragma unroll
            for (int i = 0; i < 2; ++i)
#pragma unroll
                for (int j = 0; j < 4; ++j) acc[i][j] = MFMA16(bfr[j], af[ks][i], acc[i][j]);
        }
        bf16_t* Yb = (bf16_t*)(p.ws + OFF_H) + ((((size_t)(b * 8 + g) * 64 + k1) * 64 + bp) * 128);
        uint2 pr[4], pi[4];
#pragma unroll
        for (int j = 0; j < 4; ++j) {
            float yr[4], yi[4];
#pragma unroll
            for (int e = 0; e < 4; ++e) { const float r = acc[0][j][e], im = acc[1][j][e]; yr[e] = r * cs.x + im * cs.y; yi[e] = im * cs.x - r * cs.y; }
            pr[j] = make_uint2(pk_bf16(yr[0], yr[1]), pk_bf16(yr[2], yr[3]));
            pi[j] = make_uint2(pk_bf16(yi[0], yi[1]), pk_bf16(yi[2], yi[3]));
        }
#pragma unroll
        for (int j = 0; j < 4; j += 2) {
            const int ch = (fq & 1) ? (j + 1) * 16 + (fq - 1) * 4 : j * 16 + fq * 4;
            *(uint4*)(Yb + ch) = widen_pair(pr[j], pr[j + 1]);
            *(uint4*)(Yb + 64 + ch) = widen_pair(pi[j], pi[j + 1]);
        }
    }
}

__device__ void phase_mix(const Params& p, int l, char* smem, int bid, int nb) {
    phase_mix_gmlp(p, l, smem, bid, nb);
    phase_mix_ffta(p, smem, bid, nb);
}

__device__ void phase_fftb(const Params& p, int l, char* smem, int bid, int nb) {
    const int tid = otid(), lane = tid & 63, wid = tid >> 6, fr = lane & 15, fq = lane >> 4;
    const bf16_t* DB = (const bf16_t*)(p.ws + OFF_DB);
    bf16_t* Y = (bf16_t*)(p.ws + OFF_Y);
    float* ssb = (float*)(p.ws + OFF_SSQB);
    bf16x8 af[4];
#pragma unroll
    for (int ks = 0; ks < 4; ++ks) af[ks] = *(const bf16x8*)(DB + (size_t)(wid * 16 + fr) * 128 + ks * 32 + fq * 8);
    const int nrd = (4096 + nb - 1) / nb;
    uint4 vn[4];
    { const int item = min(bid, 4095); const int k1 = item & 63, g = (item >> 6) & 7, b = item >> 9;
      st_load((const bf16_t*)(p.ws + OFF_H) + (((size_t)(b * 8 + g) * 64 + k1) * 64) * 128, 128, vn); }
    for (int rd_ = 0; rd_ < nrd; ++rd_) { const int item = min(bid + rd_ * nb, 4096 - 1);
        const int k1 = item & 63, g = (item >> 6) & 7, b = item >> 9;
        bf16_t* dT = (bf16_t*)(smem + (rd_ & 1) * (64 * TP * 2));
        float4 fb[4];
#pragma unroll
        for (int j = 0; j < 4; ++j) fb[j] = *(const float4*)(p.fnet_b + ((size_t)l * 8 + g) * 64 + j * 16 + fq * 4);
        st_store(vn, dT);
        { const int itn = min(bid + (rd_ + 1) * nb, 4095); const int k1n = itn & 63, gn = (itn >> 6) & 7, bn = itn >> 9;
          st_load((const bf16_t*)(p.ws + OFF_H) + (((size_t)(bn * 8 + gn) * 64 + k1n) * 64) * 128, 128, vn); }
        __syncthreads();
        f32x4 acc[4];
#pragma unroll
        for (int j = 0; j < 4; ++j) acc[j] = (f32x4){0.f, 0.f, 0.f, 0.f};
#pragma unroll
        for (int ks = 0; ks < 4; ++ks) {
#pragma unroll
            for (int j = 0; j < 4; ++j) { const bf16x8 bfr = *(const bf16x8*)(dT + (j * 16 + fr) * TP + ks * 32 + fq * 8); acc[j] = MFMA16(bfr, af[ks], acc[j]); }
        }
        const int k2 = wid * 16 + fr, tok = b * SEQ + k1 + 64 * k2;
        float ss = 0.f;
        uint2 pk[4];
#pragma unroll
        for (int j = 0; j < 4; ++j) {
            const float y0 = acc[j][0] * (1.0f / 512.0f) + fb[j].x, y1 = acc[j][1] * (1.0f / 512.0f) + fb[j].y, y2 = acc[j][2] * (1.0f / 512.0f) + fb[j].z, y3 = acc[j][3] * (1.0f / 512.0f) + fb[j].w;
            ss += y0 * y0 + y1 * y1 + y2 * y2 + y3 * y3;
            pk[j] = make_uint2(pk_bf16(y0, y1), pk_bf16(y2, y3));
        }
#pragma unroll
        for (int j = 0; j < 4; j += 2)
            *(uint4*)(Y + (size_t)tok * D + 512 + g * 64 + ((fq & 1) ? (j + 1) * 16 + (fq - 1) * 4 : j * 16 + fq * 4)) = widen_pair(pk[j], pk[j + 1]);
        ss += __shfl_xor(ss, 16); ss += __shfl_xor(ss, 32);
        if (fq == 0) ssb[(size_t)tok * 8 + g] = ss;
    }
}

#define INS16(a, v) do { a[15] = med3i(a[14], a[15], v); a[14] = med3i(a[13], a[14], v); a[13] = med3i(a[12], a[13], v); a[12] = med3i(a[11], a[12], v); \
    a[11] = med3i(a[10], a[11], v); a[10] = med3i(a[9], a[10], v); a[9] = med3i(a[8], a[9], v); a[8] = med3i(a[7], a[8], v); a[7] = med3i(a[6], a[7], v); \
    a[6] = med3i(a[5], a[6], v); a[5] = med3i(a[4], a[5], v); a[4] = med3i(a[3], a[4], v); a[3] = med3i(a[2], a[3], v); a[2] = med3i(a[1], a[2], v); \
    a[1] = med3i(a[0], a[1], v); a[0] = max(a[0], v); } while (0)

template <int I, int J> struct CandLoop {
    static __device__ __forceinline__ void run(int (&a)[16], const float (&f1)[16], const float (&f2)[16]) {
        if constexpr ((I + 1) * (J + 1) <= 16) { const int key = (f2key(f1[I] + f2[J]) & ~255) | (I * 16 + J); INS16(a, key); }
        if constexpr (J + 1 < 16) CandLoop<I, J + 1>::run(a, f1, f2);
        else if constexpr (I + 1 < 16) CandLoop<I + 1, 0>::run(a, f1, f2);
    }
};

typedef _Float16 f16x2_t __attribute__((ext_vector_type(2)));
__device__ __forceinline__ unsigned pk_f16(float lo, float hi) { const f16x2_t v = {(_Float16)lo, (_Float16)hi}; return __builtin_bit_cast(unsigned, v); }
__device__ __forceinline__ int h2key(unsigned bits16) { const int b = (int)(short)bits16; return b ^ ((b >> 15) & 0x7fff); }
__device__ __forceinline__ float key2h(int k) { const int b = k ^ ((k >> 15) & 0x7fff); return (float)__builtin_bit_cast(_Float16, (unsigned short)(b & 0xffff)); }

__device__ void phase_topk(const Params& p, int l, char* smem, int bid, int nb) {
    const int tid = otid(), lane = tid & 63, wid = tid >> 6, fr = lane & 15, fq = lane >> 4;
    unsigned* S32 = (unsigned*)smem;
    const bf16_t* Q = (const bf16_t*)(p.ws + OFF_Z);
    unsigned short* eidx = (unsigned short*)(p.ws + OFF_Y); _Float16* gw = (_Float16*)(p.ws + OFF_Y + (size_t)T * 128 * 4);
    const int hh = wid >> 1, half = wid & 1;
    for (int rd_ = 0; rd_ < (((T / 64) * 4) + nb - 1) / nb; ++rd_) { const int item = min(bid + rd_ * nb, ((T / 64) * 4) - 1);
        const int hp = item & 3, tok0 = (item >> 2) * 64, h = hp * 2 + hh;
        const bf16_t* Kh = (const bf16_t*)(p.ws + OFF_K12) + (((size_t)l * 8 + h) * 256 + half * 128) * 128;
        const bf16_t* Qh = Q + (size_t)tok0 * 2048 + h * 256 + half * 128;
        {
            f32x4 acc[4][8];
#pragma unroll
            for (int i = 0; i < 4; ++i)
#pragma unroll
                for (int j = 0; j < 8; ++j) acc[i][j] = (f32x4){0.f, 0.f, 0.f, 0.f};
#pragma unroll
            for (int ks = 0; ks < 4; ++ks) {
                bf16x8 af[4];
#pragma unroll
                for (int i = 0; i < 4; ++i) af[i] = *(const bf16x8*)(Qh + (size_t)(i * 16 + fr) * 2048 + ks * 32 + fq * 8);
#pragma unroll
                for (int jh = 0; jh < 2; ++jh) {
                    bf16x8 bfr[4];
#pragma unroll
                    for (int j = 0; j < 4; ++j) bfr[j] = *(const bf16x8*)(Kh + (size_t)((jh * 4 + j) * 16 + fr) * 128 + ks * 32 + fq * 8);
#pragma unroll
                    for (int i = 0; i < 4; ++i)
#pragma unroll
                        for (int j = 0; j < 4; ++j) acc[i][jh * 4 + j] = MFMA16(bfr[j], af[i], acc[i][jh * 4 + j]);
                    __builtin_amdgcn_sched_barrier(0);
                }
            }
#pragma unroll
            for (int i = 0; i < 4; ++i)
#pragma unroll
                for (int j = 0; j < 8; ++j) {
                    unsigned* d = S32 + (i * 16 + fr) * 257 + hh * 128 + half * 64 + j * 8 + fq * 2;
                    d[0] = pk_f16(acc[i][j][0], acc[i][j][1]); d[1] = pk_f16(acc[i][j][2], acc[i][j][3]);
                }
        }
        int a[16];
#pragma unroll
        for (int i = 0; i < 16; ++i) a[i] = (int)0x80000000;
        {
            const unsigned* sr = S32 + lane * 257 + hh * 128 + half * 64;
#pragma unroll 2
            for (int i = 0; i < 64; ++i) {
                const unsigned w = sr[i];
                const int k0 = (h2key(w & 0xffffu) << 7) | (2 * i), k1 = (h2key(w >> 16) << 7) | (2 * i + 1);
                INS16(a, k0); INS16(a, k1);
            }
        }
        {
            int* tw = (int*)(S32 + lane * 257 + hh * 128 + half * 64);
#pragma unroll
            for (int i = 0; i < 16; ++i) tw[i] = a[i];
        }
        vsync(smem);
        if (tid < 128) {
            const int tk = tid & 63, h2 = tid >> 6, hd = hp * 2 + h2;
            const int* t1 = (const int*)(S32 + tk * 257 + h2 * 128); const int* t2 = t1 + 64;
            float f1[16], f2[16];
#pragma unroll
            for (int i = 0; i < 16; ++i) { f1[i] = key2h(t1[i] >> 7); f2[i] = key2h(t2[i] >> 7); }
            int c[16];
#pragma unroll
            for (int i = 0; i < 16; ++i) c[i] = (int)0x80000000;
            CandLoop<0, 0>::run(c, f1, f2);
            float sc[16], e[16], sum = 0.f; int ex[16];
#pragma unroll
            for (int i = 0; i < 16; ++i) {
                sc[i] = key2f(c[i] & ~255);
                const int code = c[i] & 255;
                ex[i] = (t1[code >> 4] & 127) * 128 + (t2[code & 15] & 127);
            }
#pragma unroll
            for (int i = 0; i < 16; ++i) { e[i] = __expf(sc[i] - sc[0]); sum += e[i]; }
            const float inv = 1.0f / sum;
            uint4* ep = (uint4*)(eidx + (size_t)(tok0 + tk) * 128 + hd * 16); uint4* gp = (uint4*)(gw + (size_t)(tok0 + tk) * 128 + hd * 16);
#pragma unroll
            for (int i = 0; i < 2; ++i) ep[i] = make_uint4((unsigned)ex[8 * i] | ((unsigned)ex[8 * i + 1] << 16), (unsigned)ex[8 * i + 2] | ((unsigned)ex[8 * i + 3] << 16),
                                                           (unsigned)ex[8 * i + 4] | ((unsigned)ex[8 * i + 5] << 16), (unsigned)ex[8 * i + 6] | ((unsigned)ex[8 * i + 7] << 16));
#pragma unroll
            for (int i = 0; i < 2; ++i) gp[i] = make_uint4(pk_f16(e[8 * i] * inv, e[8 * i + 1] * inv), pk_f16(e[8 * i + 2] * inv, e[8 * i + 3] * inv), pk_f16(e[8 * i + 4] * inv, e[8 * i + 5] * inv), pk_f16(e[8 * i + 6] * inv, e[8 * i + 7] * inv));
        }
        vsync(smem);
    }
}

__device__ __forceinline__ float dot16_fp8(const float (&h)[16], const int4& u) {
    const int w[4] = {u.x, u.y, u.z, u.w};
    f32x2_t a = {0.f, 0.f};
#pragma unroll
    for (int i = 0; i < 4; ++i) {
        const f32x2_t lo = __builtin_amdgcn_cvt_pk_f32_fp8(w[i], false), hi = __builtin_amdgcn_cvt_pk_f32_fp8(w[i], true);
        const f32x2_t h0 = {h[4 * i], h[4 * i + 1]}, h1 = {h[4 * i + 2], h[4 * i + 3]};
        a = __builtin_elementwise_fma(lo, h0, a); a = __builtin_elementwise_fma(hi, h1, a);
    }
    return a.x + a.y;
}
__device__ __forceinline__ void axpy16_fp8(float (&o)[16], float c, const int4& v) {
    const int w[4] = {v.x, v.y, v.z, v.w};
#pragma unroll
    for (int i = 0; i < 4; ++i) {
        const f32x2_t lo = __builtin_amdgcn_cvt_pk_f32_fp8(w[i], false), hi = __builtin_amdgcn_cvt_pk_f32_fp8(w[i], true);
        o[4 * i] += c * lo.x; o[4 * i + 1] += c * lo.y; o[4 * i + 2] += c * hi.x; o[4 * i + 3] += c * hi.y;
    }
}

typedef _Float16 h2_t __attribute__((ext_vector_type(2)));
__device__ __forceinline__ float dot32_fp4(const h2_t (&h)[16], const int4& u) {
    const unsigned w[4] = {(unsigned)u.x, (unsigned)u.y, (unsigned)u.z, (unsigned)u.w};
    float a0 = 0.f, a1 = 0.f;
#pragma unroll
    for (int i = 0; i < 4; ++i) {
        a0 = __builtin_amdgcn_fdot2(__builtin_bit_cast(h2_t, __builtin_amdgcn_cvt_scalef32_pk_f16_fp4(w[i], 1.0f, 0)), h[4 * i], a0, false);
        a1 = __builtin_amdgcn_fdot2(__builtin_bit_cast(h2_t, __builtin_amdgcn_cvt_scalef32_pk_f16_fp4(w[i], 1.0f, 1)), h[4 * i + 1], a1, false);
        a0 = __builtin_amdgcn_fdot2(__builtin_bit_cast(h2_t, __builtin_amdgcn_cvt_scalef32_pk_f16_fp4(w[i], 1.0f, 2)), h[4 * i + 2], a0, false);
        a1 = __builtin_amdgcn_fdot2(__builtin_bit_cast(h2_t, __builtin_amdgcn_cvt_scalef32_pk_f16_fp4(w[i], 1.0f, 3)), h[4 * i + 3], a1, false);
    }
    return a0 + a1;
}
typedef int v8i_t __attribute__((ext_vector_type(8)));
typedef int i32x4_t __attribute__((ext_vector_type(4)));
typedef int i32x2_t __attribute__((ext_vector_type(2)));
constexpr float PU_XS = 4.0f;
constexpr int PU_WAVE_LDS = 16384 + 2048;
__device__ __forceinline__ void glds16(const void* g, unsigned lds_addr) {
    unsigned sv_;
    asm volatile("s_mov_b32 %0, m0\n\ts_mov_b32 m0, %2\n\ts_nop 0\n\tglobal_load_lds_dwordx4 %1, off\n\ts_mov_b32 m0, %0" : "=&s"(sv_) : "v"(g), "s"(lds_addr) : "memory");
}
__device__ void phase_pu(const Params& p, int l, int slice, int grank_base, int gsz, char* smem512) {
    int tid_ = threadIdx.x; asm volatile("" : "+v"(tid_));
    asm volatile("" : "+s"(slice), "+s"(grank_base), "+s"(gsz));
    const int lane = tid_ & 63, wid = __builtin_amdgcn_readfirstlane(tid_ >> 6), n16 = lane & 15, q4 = lane >> 4;
    const char* U4 = p.ws + OFF_UB + ((size_t)(l * 4 + slice) * NE) * 128 + 16 * ((lane & 7) ^ (lane >> 3));
    const char* msrc = lane < 32 ? (p.ws + OFF_Y + 16 * lane) : (p.ws + OFF_H + (size_t)slice * 512 + 16 * (lane - 32));
    const size_t mstep = lane < 32 ? 256 : 2048;
    _Float16* part = (_Float16*)(p.ws + OFF_Z) + (size_t)slice * T * 128 + 16 * q4 + n16;
    const int stride = gsz * 4;
    LAS char* wl = (LAS char*)smem512 + wid * PU_WAVE_LDS;
    const unsigned wla = (unsigned)(size_t)wl;
    const int boff = n16 * 128 + 16 * (q4 ^ (n16 & 7));
    const int ioff = 4 * (lane >> 3);
#define PU_META(tok_, mb_) glds16(msrc + (size_t)(tok_) * mstep, wla + 16384u + (unsigned)(mb_))
#define PU_IDS(id_, mb_, h_) do { _Pragma("unroll") for (int i_ = 0; i_ < 8; ++i_) id_[i_] = (int)*(const LAS unsigned short*)(wl + 16384 + (mb_) + 128 * (h_) + (ioff >> 1) + 16 * i_); } while (0)
#define PU_DMA(id_, h_) do { _Pragma("unroll") for (int i_ = 0; i_ < 8; ++i_) glds16(U4 + (size_t)id_[i_] * 128, wla + (unsigned)((h_) * 8192 + i_ * 1024)); } while (0)
#define PU_HALF(h_) do { i32x4_t b0_[4], b1_[4]; \
        _Pragma("unroll") for (int m_ = 0; m_ < 4; ++m_) { b0_[m_] = *(const LAS i32x4_t*)(wl + (h_) * 8192 + m_ * 2048 + boff); b1_[m_] = *(const LAS i32x4_t*)(wl + (h_) * 8192 + m_ * 2048 + (boff ^ 64)); } \
        _Pragma("unroll") for (int m_ = 0; m_ < 4; ++m_) { \
        const v8i_t B0 = {b0_[m_][0], b0_[m_][1], b0_[m_][2], b0_[m_][3], 0, 0, 0, 0}, B1 = {b1_[m_][0], b1_[m_][1], b1_[m_][2], b1_[m_][3], 0, 0, 0, 0}; \
        acc[(h_) * 4 + m_] = __builtin_amdgcn_mfma_scale_f32_16x16x128_f8f6f4(A0, B0, acc[(h_) * 4 + m_], 0, 4, 0, 0, 0, 0); \
        acc[(h_) * 4 + m_] = __builtin_amdgcn_mfma_scale_f32_16x16x128_f8f6f4(A1, B1, acc[(h_) * 4 + m_], 0, 4, 0, 0, 0, 0); } } while (0)
    const int tok0 = grank_base * 4 + wid;
    if (tok0 >= T) return;
    const int nit = (T - tok0 + stride - 1) / stride;
    int tok = tok0, tok1 = min(tok0 + stride, T - 1);
    int idA[8], idB[8];
    PU_META(tok, 0); PU_META(tok1, 1024);
    asm volatile("s_waitcnt vmcnt(0)" ::: "memory");
    PU_IDS(idA, 0, 0); PU_IDS(idB, 0, 1);
    PU_DMA(idA, 0);
#pragma nounroll
    for (int it = 0; it < nit; ++it) {
        const int mbc = (it & 1) * 1024, mbn = 1024 - mbc;
        __builtin_amdgcn_sched_barrier(0);
        PU_DMA(idB, 1);
        asm volatile("s_waitcnt vmcnt(8)" ::: "memory");
        __builtin_amdgcn_sched_barrier(0);
        { const i32x2_t xr = *(const LAS i32x2_t*)(wl + 16384 + mbc + 512 + 8 * lane);
          const float f0 = fminf(fmaxf(bf2f((unsigned)xr[0] & 0xffffu) * PU_XS, -448.f), 448.f), f1 = fminf(fmaxf(bf2f((unsigned)xr[0] >> 16) * PU_XS, -448.f), 448.f),
                      f2 = fminf(fmaxf(bf2f((unsigned)xr[1] & 0xffffu) * PU_XS, -448.f), 448.f), f3 = fminf(fmaxf(bf2f((unsigned)xr[1] >> 16) * PU_XS, -448.f), 448.f);
          int w = __builtin_amdgcn_cvt_pk_fp8_f32(f0, f1, 0, false); w = __builtin_amdgcn_cvt_pk_fp8_f32(f2, f3, w, true);
          *(LAS int*)(wl + 16384 + mbc + 512 + 4 * lane) = w; }
        PU_IDS(idA, mbn, 0);
        asm volatile("s_waitcnt lgkmcnt(0)" ::: "memory");
        const LAS char* xb = wl + 16384 + mbc + 512 + 16 * q4;
        const i32x4_t a00 = *(const LAS i32x4_t*)(xb), a01 = *(const LAS i32x4_t*)(xb + 64), a10 = *(const LAS i32x4_t*)(xb + 128), a11 = *(const LAS i32x4_t*)(xb + 192);
        const v8i_t A0 = {a00[0], a00[1], a00[2], a00[3], a01[0], a01[1], a01[2], a01[3]}, A1 = {a10[0], a10[1], a10[2], a10[3], a11[0], a11[1], a11[2], a11[3]};
        f32x4 acc[8];
#pragma unroll
        for (int m = 0; m < 8; ++m) acc[m] = (f32x4){0.f, 0.f, 0.f, 0.f};
        PU_HALF(0);
        asm volatile("s_waitcnt lgkmcnt(0)" ::: "memory");
        __builtin_amdgcn_sched_barrier(0);
        const int tok2 = min(tok1 + stride, T - 1);
        PU_DMA(idA, 0);
        PU_META(tok2, mbc);
        asm volatile("s_waitcnt vmcnt(9)" ::: "memory");
        __builtin_amdgcn_sched_barrier(0);
        PU_IDS(idB, mbn, 1);
        PU_HALF(1);
        __builtin_amdgcn_sched_barrier(0);
        float s0 = acc[0][0], s1 = acc[4][0];
        s0 = q4 == 1 ? acc[1][0] : s0; s1 = q4 == 1 ? acc[5][0] : s1;
        s0 = q4 == 2 ? acc[2][0] : s0; s1 = q4 == 2 ? acc[6][0] : s1;
        s0 = q4 == 3 ? acc[3][0] : s0; s1 = q4 == 3 ? acc[7][0] : s1;
        _Float16* pr = part + (size_t)tok * 128;
        pr[0] = (_Float16)(s0 * (1.0f / PU_XS)); pr[64] = (_Float16)(s1 * (1.0f / PU_XS));
        tok = tok1; tok1 = tok2;
    }
    asm volatile("s_waitcnt vmcnt(0)" ::: "memory");
#undef PU_META
#undef PU_IDS
#undef PU_DMA
#undef PU_HALF
}
__device__ void phase_pc(const Params& p, int l, int bid, int nb) {
    const int tid_ = otid(); const int lane = tid_ & 63, wid = tid_ >> 6, hl = lane & 31, hw = lane >> 5;
    const unsigned short* eidx = (const unsigned short*)(p.ws + OFF_Y); const _Float16* gw = (const _Float16*)(p.ws + OFF_Y + (size_t)T * 128 * 4);
    unsigned char* crec = (unsigned char*)(p.ws + OFF_Y + (size_t)T * 128 * 8);
    const _Float16* part = (const _Float16*)(p.ws + OFF_Z);
    const float* usc = (const float*)(p.ws + OFF_USC) + (size_t)l * NE; const float* vsc = (const float*)(p.ws + OFF_VSC) + (size_t)l * NE;
    constexpr int NU = 2;
    for (int tok0 = (bid * 4 + wid) * 2 + hw; tok0 < T; tok0 += nb * 8 * NU) {
        int tk[NU]; bool ok[NU];
#pragma unroll
        for (int u = 0; u < NU; ++u) { ok[u] = tok0 + u * nb * 8 < T; tk[u] = ok[u] ? tok0 + u * nb * 8 : tok0; }
        int4 e[NU]; float4 g[NU], a[NU][4];
#pragma unroll
        for (int u = 0; u < NU; ++u) { const size_t j = (size_t)tk[u] * 128 + hl * 4; { const uint2 ew = *(const uint2*)(eidx + j); e[u] = make_int4((int)(ew.x & 0xffffu), (int)(ew.x >> 16), (int)(ew.y & 0xffffu), (int)(ew.y >> 16)); } { typedef _Float16 h4g_t __attribute__((ext_vector_type(4))); const h4g_t gv = *(const h4g_t*)(gw + j); g[u] = make_float4((float)gv[0], (float)gv[1], (float)gv[2], (float)gv[3]); }
#pragma unroll
            for (int sl = 0; sl < 4; ++sl) { typedef _Float16 h4_t __attribute__((ext_vector_type(4))); const h4_t hv = *(const h4_t*)(part + (size_t)sl * T * 128 + j);
                a[u][sl] = make_float4((float)hv[0], (float)hv[1], (float)hv[2], (float)hv[3]); } }
        float us[NU][4], vs[NU][4];
#pragma unroll
        for (int u = 0; u < NU; ++u) { const int ee[4] = {e[u].x, e[u].y, e[u].z, e[u].w};
#pragma unroll
            for (int k = 0; k < 4; ++k) { us[u][k] = usc[ee[k]]; vs[u][k] = vsc[ee[k]]; } }
#pragma unroll
        for (int u = 0; u < NU; ++u) {
            const float gg[4] = {g[u].x, g[u].y, g[u].z, g[u].w};
            const float aa[4] = {(a[u][0].x + a[u][1].x) + (a[u][2].x + a[u][3].x), (a[u][0].y + a[u][1].y) + (a[u][2].y + a[u][3].y), (a[u][0].z + a[u][1].z) + (a[u][2].z + a[u][3].z), (a[u][0].w + a[u][1].w) + (a[u][2].w + a[u][3].w)};
            float c[4], m = 0.f;
#pragma unroll
            for (int k = 0; k < 4; ++k) { c[k] = gg[k] * gelu_f(aa[k] * us[u][k]) * vs[u][k]; m = fmaxf(m, fabsf(c[k])); }
#pragma unroll
            for (int o = 16; o >= 1; o >>= 1) m = fmaxf(m, __shfl_xor(m, o));
            const float S = (m > 1e-30f) ? 256.0f / m : 1.0f;
            float cs[4], r[4]; int hi, lo;
#pragma unroll
            for (int k = 0; k < 4; ++k) cs[k] = c[k] * S;
            hi = __builtin_amdgcn_cvt_pk_fp8_f32(cs[0], cs[1], 0, false); hi = __builtin_amdgcn_cvt_pk_fp8_f32(cs[2], cs[3], hi, true);
            { const f32x2_t h01 = __builtin_amdgcn_cvt_pk_f32_fp8(hi, false), h23 = __builtin_amdgcn_cvt_pk_f32_fp8(hi, true);
              r[0] = (cs[0] - h01.x) * 16.0f; r[1] = (cs[1] - h01.y) * 16.0f; r[2] = (cs[2] - h23.x) * 16.0f; r[3] = (cs[3] - h23.y) * 16.0f; }
            lo = __builtin_amdgcn_cvt_pk_fp8_f32(r[0], r[1], 0, false); lo = __builtin_amdgcn_cvt_pk_fp8_f32(r[2], r[3], lo, true);
            unsigned char* rec = crec + (size_t)tk[u] * 512;
            if (ok[u]) { *(int*)(rec + 4 * hl) = hi; *(int*)(rec + 128 + 4 * hl) = lo; if (hl == 0) *(float*)(rec + 256) = 1.0f / S; }
        }
    }
}
__device__ void phase_pv(const Params& p, int l, int slice, int grank_base, int gsz, char* smem512) {
    int tid_ = threadIdx.x; asm volatile("" : "+v"(tid_));
    asm volatile("" : "+s"(slice), "+s"(grank_base), "+s"(gsz));
    const int lane = tid_ & 63, wid = __builtin_amdgcn_readfirstlane(tid_ >> 6), n16 = lane & 15, q4 = lane >> 4;
    const char* V4e = p.ws + OFF_VB + ((size_t)(l * 4 + slice) * NE) * 128 + 16 * ((lane & 7) ^ (lane >> 4));
    const char* V4o = p.ws + OFF_VB + ((size_t)(l * 4 + slice) * NE) * 128 + 16 * ((lane & 7) ^ (lane >> 4) ^ 4);
    const char* msrc = lane < 32 ? (p.ws + OFF_Y + 16 * lane) : (p.ws + OFF_Y + (size_t)T * 128 * 8 + 16 * (lane - 32));
    const size_t mstep = lane < 32 ? 256 : 512;
    bf16_t* Sout = (bf16_t*)(p.ws + OFF_Z) + slice * 256 + 4 * lane;
    const int stride = gsz * 4;
    LAS char* wl = (LAS char*)smem512 + wid * PU_WAVE_LDS;
    const unsigned wla = (unsigned)(size_t)wl;
    const int ioff = 4 * (lane >> 3);
    const int rowb = (q4 >> 1) * 8192 + (32 * (q4 & 1) + n16) * 128;
    int vad[8];
#pragma unroll
    for (int jj = 0; jj < 8; ++jj) vad[jj] = rowb + ((16 * jj) ^ (16 * (n16 >> 1)));
    const int aoff = 16384 + 512 + 128 * (n16 & 1) + 16 * q4;
#define PV_META(tok_, mb_) glds16(msrc + (size_t)(tok_) * mstep, wla + 16384u + (unsigned)(mb_))
#define PV_IDS(id_, mb_) do { _Pragma("unroll") for (int i_ = 0; i_ < 16; ++i_) id_[i_] = (int)*(const LAS unsigned short*)(wl + 16384 + (mb_) + (ioff >> 1) + 16 * i_); } while (0)
#define PV_DMA(id_) do { _Pragma("unroll") for (int i_ = 0; i_ < 16; ++i_) glds16(((i_ & 1) ? V4o : V4e) + (size_t)id_[i_] * 128, wla + (unsigned)(i_ * 1024)); } while (0)
    const int tok0 = grank_base * 4 + wid;
    if (tok0 >= T) return;
    const int nit = (T - tok0 + stride - 1) / stride;
    int tok = tok0, tok1 = min(tok0 + stride, T - 1);
    int idv[16];
    PV_META(tok, 0);
    asm volatile("s_waitcnt vmcnt(0)" ::: "memory");
    PV_IDS(idv, 0);
    asm volatile("s_waitcnt lgkmcnt(0)" ::: "memory");
    PV_DMA(idv);
    PV_META(tok1, 1024);
#pragma nounroll
    for (int it = 0; it < nit; ++it) {
        const int mbc = (it & 1) * 1024, mbn = 1024 - mbc;
        __builtin_amdgcn_sched_barrier(0);
        asm volatile("s_waitcnt vmcnt(1)" ::: "memory");
        __builtin_amdgcn_sched_barrier(0);
        const i32x4_t a0 = *(const LAS i32x4_t*)(wl + mbc + aoff), a1 = *(const LAS i32x4_t*)(wl + mbc + aoff + 64);
        const float invS = *(const LAS float*)(wl + 16384 + mbc + 512 + 256);
        const v8i_t A = {a0[0], a0[1], a0[2], a0[3], a1[0], a1[1], a1[2], a1[3]};
        i32x2_t bt[16][2];
#pragma unroll
        for (int j = 0; j < 16; ++j) {
            bt[j][0] = __builtin_amdgcn_ds_read_tr4_b64_v2i32((LAS i32x2_t*)(wl + vad[j >> 1] + 8 * (j & 1)));
            bt[j][1] = __builtin_amdgcn_ds_read_tr4_b64_v2i32((LAS i32x2_t*)(wl + vad[j >> 1] + 8 * (j & 1) + 2048));
        }
        asm volatile("s_waitcnt vmcnt(0)" ::: "memory");
        PV_IDS(idv, mbn);
        asm volatile("s_waitcnt lgkmcnt(0)" ::: "memory");
        __builtin_amdgcn_sched_barrier(0);
        PV_DMA(idv);
        __builtin_amdgcn_sched_barrier(0);
        f32x4 acc[16];
#pragma unroll
        for (int j = 0; j < 16; ++j) {
            const v8i_t B = {bt[j][0][0], bt[j][0][1], bt[j][1][0], bt[j][1][1], 0, 0, 0, 0};
            acc[j] = __builtin_amdgcn_mfma_scale_f32_16x16x128_f8f6f4(A, B, (f32x4){0.f, 0.f, 0.f, 0.f}, 0, 4, 0, 0, 0, 0);
        }
        float v0 = acc[0][0] + acc[0][1] * 0.0625f, v1 = acc[1][0] + acc[1][1] * 0.0625f, v2 = acc[2][0] + acc[2][1] * 0.0625f, v3 = acc[3][0] + acc[3][1] * 0.0625f;
#pragma unroll
        for (int qq = 1; qq < 4; ++qq) {
            v0 = q4 == qq ? acc[4 * qq][0] + acc[4 * qq][1] * 0.0625f : v0; v1 = q4 == qq ? acc[4 * qq + 1][0] + acc[4 * qq + 1][1] * 0.0625f : v1;
            v2 = q4 == qq ? acc[4 * qq + 2][0] + acc[4 * qq + 2][1] * 0.0625f : v2; v3 = q4 == qq ? acc[4 * qq + 3][0] + acc[4 * qq + 3][1] * 0.0625f : v3;
        }
        LAS float* tb = (LAS float*)(wl + 16384 + mbc);
        tb[64 * q4 + n16] = v0; tb[64 * q4 + 16 + n16] = v1; tb[64 * q4 + 32 + n16] = v2; tb[64 * q4 + 48 + n16] = v3;
        asm volatile("s_waitcnt lgkmcnt(0)" ::: "memory");
        const f32x4 o = *(const LAS f32x4*)(tb + 4 * lane);
        *(uint2*)(Sout + (size_t)tok * D) = make_uint2(pk_bf16(o[0] * invS, o[1] * invS), pk_bf16(o[2] * invS, o[3] * invS));
        asm volatile("s_waitcnt lgkmcnt(0)" ::: "memory");
        __builtin_amdgcn_sched_barrier(0);
        const int tok2 = min(tok1 + stride, T - 1);
        PV_META(tok2, mbc);
        tok = tok1; tok1 = tok2;
    }
    asm volatile("s_waitcnt vmcnt(0)" ::: "memory");
#undef PV_META
#undef PV_IDS
#undef PV_DMA
}
__device__ void phase_final_norm(const Params& p, int bid, int nb) {
    const int tid_ = otid(); const int lane = tid_ & 63, wid = tid_ >> 6;
    const bf16_t* sadd = (const bf16_t*)(p.ws + OFF_Z); const float* g2l = (const float*)(p.ws + OFF_MOD) + (size_t)(NL - 1) * NB * 6144 + 5 * D;
    constexpr int NU = 2;
    for (int tok0 = bid * 4 + wid; tok0 < T; tok0 += nb * 4 * NU) {
        int tk[NU]; bool ok[NU];
#pragma unroll
        for (int u = 0; u < NU; ++u) { ok[u] = tok0 + u * nb * 4 < T; tk[u] = ok[u] ? tok0 + u * nb * 4 : tok0; }
        uint2 xw[NU][4], sw[NU][4]; float4 g2[NU][4];
#pragma unroll
        for (int u = 0; u < NU; ++u)
#pragma unroll
            for (int i = 0; i < 4; ++i) { const size_t o = (size_t)tk[u] * D + i * 256 + lane * 4;
                xw[u][i] = *(const uint2*)((const bf16_t*)(p.ws + OFF_XR) + o); sw[u][i] = *(const uint2*)(sadd + o); g2[u][i] = *(const float4*)(g2l + (size_t)(tk[u] / SEQ) * 6144 + i * 256 + lane * 4); }
#pragma unroll
        for (int u = 0; u < NU; ++u) {
            float4 v[4]; float ss = 0.f;
#pragma unroll
            for (int i = 0; i < 4; ++i) { const uint2 w = xw[u][i], s_ = sw[u][i]; const float4 g_ = g2[u][i];
                v[i] = make_float4(bf2f(w.x & 0xffffu) + g_.x * bf2f(s_.x & 0xffffu), bf2f(w.x >> 16) + g_.y * bf2f(s_.x >> 16), bf2f(w.y & 0xffffu) + g_.z * bf2f(s_.y & 0xffffu), bf2f(w.y >> 16) + g_.w * bf2f(s_.y >> 16));
                ss += v[i].x * v[i].x + v[i].y * v[i].y + v[i].z * v[i].z + v[i].w * v[i].w; }
            const float rstd = rsqrtf(wave_sum(ss) * (1.0f / D) + EPS);
            float* xr = p.out + (size_t)tk[u] * D;
#pragma unroll
            for (int i = 0; i < 4; ++i) { const float4 g = *(const float4*)(p.final_g + i * 256 + lane * 4);
                if (ok[u]) *(float4*)(xr + i * 256 + lane * 4) = make_float4(v[i].x * rstd * g.x, v[i].y * rstd * g.y, v[i].z * rstd * g.z, v[i].w * rstd * g.w); }
        }
    }
}

#define XB_TMO      128
#define XB_XCNT(j)  (256  + 64 * (j))
#define XB_XSUB(j)  (1280 + 64 * (j))
#define XB_XGEN(j)  (2304 + 64 * (j))
#define XB_TOP      3328
#define XB_TOPGEN   3392
#define XCD_BAR_WORDS 3456
#define XB_SPIN_CAP (1u << 22)
__device__ __forceinline__ unsigned xb_ld(unsigned* p)              { return __hip_atomic_load(p, __ATOMIC_RELAXED, __HIP_MEMORY_SCOPE_AGENT); }
__device__ __forceinline__ unsigned xb_add(unsigned* p, unsigned v) { return __hip_atomic_fetch_add(p, v, __ATOMIC_RELAXED, __HIP_MEMORY_SCOPE_AGENT); }
__device__ __forceinline__ unsigned xb_xcc_id() { return (unsigned)__builtin_amdgcn_s_getreg((3 << 11) | 20) & 0xFu; }
#define XB_SPIN(cond, bar) do { unsigned _sp = 0; while (cond) { __builtin_amdgcn_s_sleep(1); \
    if ((++_sp & 255u) == 0u) { if (xb_ld(&(bar)[XB_TMO])) break; if (_sp > XB_SPIN_CAP) { atomicAdd(&(bar)[XB_TMO], 1u); break; } } } } while (0)
__device__ __forceinline__ void xcd_barrier_post(unsigned* bar, volatile LAS unsigned* st) {
    if (threadIdx.x == 0) { const unsigned x = xb_xcc_id(); st[3] = x; st[2] = xb_add(&bar[XB_XCNT(x)], 1u); }
}
__device__ __forceinline__ void xcd_barrier_complete(unsigned* bar, unsigned x, unsigned& nloc, unsigned& nx) {
    const unsigned G = gridDim.x * gridDim.y * gridDim.z;
    unsigned sum, cnt, mine, sp = 0u;
    for (;;) {
        sum = 0u; cnt = 0u; mine = 0u;
#pragma unroll
        for (unsigned j = 0; j < 16; ++j) { const unsigned c = xb_ld(&bar[XB_XCNT(j)]); sum += c; cnt += (c > 0u) ? 1u : 0u; mine = (j == x) ? c : mine; }
        if (sum == G) break;
        __builtin_amdgcn_s_sleep(1);
        if ((++sp & 255u) == 0u) { if (xb_ld(&bar[XB_TMO])) break; if (sp > XB_SPIN_CAP) { atomicAdd(&bar[XB_TMO], 1u); break; } }
    }
    nloc = mine > 0u ? mine : 1u; nx = cnt > 0u ? cnt : 1u;
}
__device__ __forceinline__ void xcd_barrier(unsigned* bar, volatile LAS unsigned* st) {
    asm volatile("s_waitcnt vmcnt(0)" ::: "memory");
    __syncthreads();
    int t0_ = threadIdx.x; asm volatile("" : "+v"(t0_));
    if (t0_ == 0) {
        __builtin_amdgcn_s_waitcnt(0);
        unsigned nloc = st[0], nx = st[1]; const unsigned x = st[3];
        if (nloc == 0u) { xcd_barrier_complete(bar, x, nloc, nx); st[0] = nloc; st[1] = nx; }
        const unsigned old = xb_add(&bar[XB_XSUB(x)], 1u);
        const unsigned gen = old / nloc;
        if (old + 1u == (gen + 1u) * nloc) {
            __builtin_amdgcn_fence(__ATOMIC_RELEASE, "agent");
            asm volatile("s_waitcnt vmcnt(0)" ::: "memory");
            const unsigned og = xb_add(&bar[XB_TOP], 1u);
            const unsigned tgt = (og / nx + 1u) * nx;
            __builtin_amdgcn_fence(__ATOMIC_ACQUIRE, "agent");
            if (og + 1u != tgt) XB_SPIN((int)(xb_ld(&bar[XB_TOP]) - tgt) < 0, bar);
            xb_add(&bar[XB_XGEN(x)], 1u);
            asm volatile("s_waitcnt vmcnt(0)" ::: "memory");
        } else {
            __builtin_amdgcn_fence(__ATOMIC_ACQUIRE, "agent");
            XB_SPIN(xb_ld(&bar[XB_XGEN(x)]) == gen, bar);
            asm volatile("s_waitcnt vmcnt(0)" ::: "memory");
        }
    }
    __syncthreads();
}

#if MEGA
#if PROBE_A >= 0
#define TSTAMP(i) do { if (blockIdx.x == 0 && threadIdx.x == 0) ts[i] = __builtin_amdgcn_s_memrealtime(); } while (0)
#else
#define TSTAMP(i) do { } while (0)
#endif
__global__ void __launch_bounds__(512, 2) mega_kernel(Params p) {
    __shared__ __attribute__((aligned(16))) char smem[2 * SMEM_BYTES + 32];
#if PROBE_A >= 0
    __shared__ unsigned long long ts[26];
#endif
#if COOP
    cg::grid_group grid = cg::this_grid();
#endif
    const int vb = __builtin_amdgcn_readfirstlane((int)(threadIdx.x >> 8));
    const int bid = blockIdx.x * 2 + vb, nb = gridDim.x * 2;
    char* smv = smem + vb * SMEM_BYTES;
    unsigned* bar = (unsigned*)(p.ws + OFF_BAR);
    volatile LAS unsigned* xst = (volatile LAS unsigned*)(smem + 2 * SMEM_BYTES);
#define GBAR() xcd_barrier((unsigned*)(p.ws + OFF_BAR), (volatile LAS unsigned*)(smem + 2 * SMEM_BYTES))
    if (threadIdx.x == 0) { xst[0] = 0u; xst[1] = 0u; xst[2] = 0u; xst[3] = 0u; xst[4] = 0u; xst[5] = 0u; }
    __syncthreads();
#if COOP
    if (blockIdx.x == 0) for (int i = threadIdx.x; i < XCD_BAR_WORDS; i += 512) bar[i] = 0u;
    TSTAMP(0);
    phase_prep(p, smv, bid, nb);
    grid.sync();
    xcd_barrier_post(bar, xst);
#else
    __syncthreads();
    xcd_barrier_post(bar, xst);
    TSTAMP(0);
    phase_prep(p, smv, bid, nb);
    GBAR();
#endif
    TSTAMP(1);
    phase_norm<false, false, 2>(p.x, p.norm1_g, (const float*)(p.ws + OFF_MOD), 0, D, (bf16_t*)(p.ws + OFF_H), bid, nb, nullptr, nullptr, (bf16_t*)(p.ws + OFF_XR)); GBAR();
    int slice4, grank4; const int gsz4 = (int)gridDim.x / 4 * 2;
    {
        const unsigned myx = xst[3], myrank = xst[2];
        unsigned pre = 0;
#pragma unroll
        for (unsigned j = 0; j < 16; ++j) { const unsigned c = xb_ld(&bar[XB_XCNT(j)]); pre += (j < myx) ? c : 0u; }
        const int gi = __builtin_amdgcn_readfirstlane((int)(pre + myrank));
        slice4 = gi / ((int)gridDim.x / 4); grank4 = (gi % ((int)gridDim.x / 4)) * 2;
    }
#pragma nounroll
    for (int l = 0; l < NL; ++l) {
        TSTAMP(2 + 11 * l); phase_gemm1(p, l, smem); GBAR();
        TSTAMP(3 + 11 * l); phase_mix(p, l, smv, bid, nb); GBAR();
        TSTAMP(4 + 11 * l); phase_fftb(p, l, smv, bid, nb); GBAR();
        TSTAMP(5 + 11 * l); phase_gemm2(p, l, smem); GBAR();
        TSTAMP(6 + 11 * l); phase_norm16<false>((bf16_t*)(p.ws + OFF_XR), p.norm2_g + l * D, (const float*)(p.ws + OFF_MOD) + (size_t)l * NB * 6144, 3 * D, 4 * D, (bf16_t*)(p.ws + OFF_H), bid, nb); GBAR();
        TSTAMP(7 + 11 * l); phase_gemm3(p, l, smem); GBAR();
        TSTAMP(8 + 11 * l); phase_topk(p, l, smv, bid, nb); GBAR();
        TSTAMP(9 + 11 * l); phase_pu(p, l, slice4, grank4, gsz4, smem); GBAR();
        TSTAMP(10 + 11 * l); phase_pc(p, l, bid, nb); GBAR();
        TSTAMP(11 + 11 * l); phase_pv(p, l, slice4, grank4, gsz4, smem); GBAR();
        TSTAMP(12 + 11 * l);
        if (l + 1 < NL) { phase_norm16<true>((bf16_t*)(p.ws + OFF_XR), p.norm1_g + (l + 1) * D, (const float*)(p.ws + OFF_MOD) + (size_t)(l + 1) * NB * 6144, 0, D, (bf16_t*)(p.ws + OFF_H), bid, nb,
                                                 (const bf16_t*)(p.ws + OFF_Z), (const float*)(p.ws + OFF_MOD) + (size_t)l * NB * 6144 + 5 * D); GBAR(); }
        else phase_final_norm(p, bid, nb);
    }
#undef GBAR
    TSTAMP(24);
#if PROBE_A >= 0
    if (bid == 0 && threadIdx.x == 0) p.out[0] += (float)(ts[PROBE_B] - ts[PROBE_A]) * 0.01f / PROBE_DIV;
#endif
}
#endif

extern "C" void kernel_launch(void* const* d_in, const int* in_sizes, int n_in, void* d_out, int out_size, void* d_ws, size_t ws_size, hipStream_t stream) {
    (void)in_sizes; (void)n_in; (void)out_size;
    if (ws_size < OFF_END) { fprintf(stderr, "workspace too small: %zu < %zu\n", ws_size, (size_t)OFF_END); return; }
    Params p{};
    p.x = (const float*)d_in[0]; p.c = (const float*)d_in[1]; p.mod_w = (const float*)d_in[2]; p.mod_b = (const float*)d_in[3]; p.norm1_g = (const float*)d_in[4];
    p.w_in = (const float*)d_in[5]; p.gmlp_ws = (const float*)d_in[6]; p.gmlp_bs = (const float*)d_in[7]; p.fnet_w = (const float*)d_in[8]; p.fnet_b = (const float*)d_in[9];
    p.gain_a = (const float*)d_in[10]; p.gain_b = (const float*)d_in[11]; p.w_out = (const float*)d_in[12]; p.norm2_g = (const float*)d_in[13]; p.wq = (const float*)d_in[14];
    p.k1 = (const float*)d_in[15]; p.k2 = (const float*)d_in[16]; p.pu = (const float*)d_in[17]; p.pv = (const float*)d_in[18]; p.final_g = (const float*)d_in[19];
    p.out = (float*)d_out; p.ws = (char*)d_ws;
#if MEGA
    static int grid_blocks = 0;
    if (!grid_blocks) {
        int dev = 0, cus = 0, per_cu = 0;
        hipGetDevice(&dev);
        hipDeviceGetAttribute(&cus, hipDeviceAttributeMultiprocessorCount, dev);
        hipOccupancyMaxActiveBlocksPerMultiprocessor(&per_cu, mega_kernel, 512, 0);
        if (per_cu > 1) per_cu = 1;
        grid_blocks = (cus * per_cu) / 8 * 8;
    }
    void* args[] = {&p};
    hipError_t e = hipLaunchCooperativeKernel((void*)mega_kernel, dim3(grid_blocks), dim3(512), args, 0, stream);
    if (e != hipSuccess) fprintf(stderr, "cooperative launch failed: %s (grid %d)\n", hipGetErrorString(e), grid_blocks);
#endif
}
```
